# Optimizing an MI355X kernel written in HIP

```python
import math
import jax, jax.numpy as jnp
from jax import lax
import numpy as np

D_MODEL = 2048
BATCH = 8
SEQ = 2048
DEPTH = 1

SGU_WIDTH = D_MODEL // 2
SGU_CHUNK = 128
SGU_GROUPS = 8
SGU_GROUP_DIM = SGU_WIDTH // SGU_GROUPS
HY_WIDTH = D_MODEL // 2
HY_ORDER = 2
HY_SHORT = 3
HY_EMB = 33
HY_BANDS = (HY_EMB - 1) // 2
HY_FILTER_HIDDEN = 64
HY_DIRS = 2
HY_DECAY_TARGET = 1e-2
HY_FAST_DECAY = 0.3
HY_SLOW_DECAY = 1.5
HY_FILTER_INIT_SCALE = 0.05
N_BRANCHES = 2
D_FF = 4 * D_MODEL
IN_WIDTH = 2 * SGU_WIDTH + (HY_ORDER + 1) * HY_WIDTH + N_BRANCHES * D_MODEL
N_MOD = 6
DEEPNORM_ALPHA = (2.0 * DEPTH) ** 0.25
DEEPNORM_BETA = (8.0 * DEPTH) ** -0.25
LN_EPS = 1e-5

kernel_name = "hybrid_gmlp_hyena_deepnorm_adaln_block"


def layer_norm(x, g, b):
    xf = x.astype(jnp.float32)
    mu = jnp.mean(xf, axis=-1, keepdims=True)
    var = jnp.mean(jnp.square(xf - mu), axis=-1, keepdims=True)
    y = (xf - mu) * lax.rsqrt(var + LN_EPS) * g.astype(jnp.float32) + b.astype(jnp.float32)
    return y.astype(x.dtype)


def spatial_gating(u, v, ln_g, ln_b, w_s, b_s):
    bsz, s, _ = v.shape
    n_chunks = s // SGU_CHUNK
    vn = layer_norm(v, ln_g, ln_b).reshape(bsz, n_chunks, SGU_CHUNK, SGU_GROUPS, SGU_GROUP_DIM)
    mixed = jnp.einsum('gqp,bnpgc->bnqgc', w_s, vn) + b_s.T[None, None, :, :, None]
    return u * mixed.reshape(bsz, s, SGU_WIDTH)


def short_conv(z, w, b):
    s = z.shape[1]
    pad = HY_SHORT // 2
    zp = jnp.pad(z, ((0, 0), (pad, HY_SHORT - 1 - pad), (0, 0)))
    return sum(w[j] * zp[:, j:j + s] for j in range(HY_SHORT)) + b


def hyena_filters(L, w1, b1, w2, b2, freq, w3):
    f32 = jnp.float32
    t = jnp.linspace(0.0, 1.0, L, dtype=f32)[:, None]
    omega = 2.0 * math.pi * jnp.arange(L, dtype=f32)[:, None] / L
    bands = jnp.linspace(1e-4, HY_BANDS - 1, HY_BANDS, dtype=f32)[None, :]
    feats = jnp.concatenate([t, jnp.cos(bands * omega), -jnp.sin(bands * omega)], axis=-1)
    fr = freq.astype(f32)
    h = jnp.sin(fr * (feats @ w1.astype(f32) + b1.astype(f32)))
    h = jnp.sin(fr * (h @ w2.astype(f32) + b2.astype(f32)))
    h = h @ w3.astype(f32)
    min_decay = math.log(HY_DECAY_TARGET) / HY_SLOW_DECAY
    max_decay = math.log(HY_DECAY_TARGET) / HY_FAST_DECAY
    deltas = jnp.abs(jnp.linspace(min_decay, max_decay, HY_WIDTH, dtype=f32))
    window = jnp.exp(-t * deltas)
    return h.reshape(L, HY_DIRS, HY_ORDER, HY_WIDTH) * window[:, None, None, :]


def two_sided_spectrum(h_fwd, h_bwd):
    L, ch = h_fwd.shape
    k = jnp.concatenate([h_fwd.at[0].add(h_bwd[0]), jnp.zeros((1, ch), h_fwd.dtype), h_bwd[:0:-1]], axis=0)
    return jnp.fft.rfft(k, axis=0)


def fft_long_conv(u, k_spec, skip):
    L = u.shape[1]
    uf = u.astype(jnp.float32)
    y = jnp.fft.irfft(jnp.fft.rfft(uf, n=2 * L, axis=1) * k_spec[None], n=2 * L, axis=1)[:, :L]
    return (y + uf * skip.astype(jnp.float32)).astype(u.dtype)


def hyena(z, conv_w, conv_b, w1, b1, w2, b2, freq, w3, skip):
    z = short_conv(z, conv_w, conv_b)
    v, x1, x2 = jnp.split(z, HY_ORDER + 1, axis=-1)
    filt = hyena_filters(z.shape[1], w1, b1, w2, b2, freq, w3)
    y = v
    for n, gate in enumerate((x1, x2)):
        k_spec = two_sided_spectrum(filt[:, 0, n], filt[:, 1, n])
        y = gate * fft_long_conv(y, k_spec, skip[n])
    return y


def setup_inputs(seed: int = 0) -> dict:
    key = jax.random.key(seed)
    keys = iter(jax.random.split(key, 40))
    D = D_MODEL
    L = DEPTH

    def nrm(shape, scale):
        return jax.random.normal(next(keys), shape, jnp.float32) * scale

    return {
        "x": nrm((BATCH, SEQ, D), 1.0),
        "c": nrm((BATCH, D), 1.0),
        "w_ada": nrm((L, D, N_MOD * D), 0.5 * D ** -0.5),
        "b_ada": nrm((L, N_MOD * D), 0.02),
        "w_in": nrm((L, D, IN_WIDTH), D ** -0.5),
        "b_in": nrm((L, IN_WIDTH), 0.02),
        "sgu_ln_g": 1.0 + nrm((L, SGU_WIDTH), 0.05),
        "sgu_ln_b": nrm((L, SGU_WIDTH), 0.02),
        "sgu_w": nrm((L, SGU_GROUPS, SGU_CHUNK, SGU_CHUNK), SGU_CHUNK ** -0.5),
        "sgu_b": 1.0 + nrm((L, SGU_GROUPS, SGU_CHUNK), 0.1),
        "hy_conv_w": nrm((L, HY_SHORT, (HY_ORDER + 1) * HY_WIDTH), HY_SHORT ** -0.5),
        "hy_conv_b": nrm((L, (HY_ORDER + 1) * HY_WIDTH), 0.02),
        "hy_w1": nrm((L, HY_EMB, HY_FILTER_HIDDEN), HY_EMB ** -0.5),
        "hy_b1": nrm((L, HY_FILTER_HIDDEN), 0.1),
        "hy_w2": nrm((L, HY_FILTER_HIDDEN, HY_FILTER_HIDDEN), HY_FILTER_HIDDEN ** -0.5),
        "hy_b2": nrm((L, HY_FILTER_HIDDEN), 0.1),
        "hy_freq": 1.0 + nrm((L, HY_FILTER_HIDDEN), 0.1),
        "hy_w3": nrm((L, HY_FILTER_HIDDEN, HY_DIRS * HY_ORDER * HY_WIDTH), HY_FILTER_INIT_SCALE * HY_FILTER_HIDDEN ** -0.5),
        "hy_skip": nrm((L, HY_ORDER, HY_WIDTH), 0.5),
        "w_branch_a": nrm((L, SGU_WIDTH, D), DEEPNORM_BETA * SGU_WIDTH ** -0.5),
        "w_branch_b": nrm((L, HY_WIDTH, D), DEEPNORM_BETA * HY_WIDTH ** -0.5),
        "w_o": nrm((L, D, D), DEEPNORM_BETA * D ** -0.5),
        "b_o": nrm((L, D), 0.02),
        "ln1_g": 1.0 + nrm((L, D), 0.05),
        "ln1_b": nrm((L, D), 0.02),
        "w_m1": nrm((L, D, D_FF), DEEPNORM_BETA * D ** -0.5),
        "b_m1": nrm((L, D_FF), 0.02),
        "w_m2": nrm((L, D_FF, D), DEEPNORM_BETA * D_FF ** -0.5),
        "b_m2": nrm((L, D), 0.02),
        "ln2_g": 1.0 + nrm((L, D), 0.05),
        "ln2_b": nrm((L, D), 0.02),
    }


def reference(x, c, w_ada, b_ada, w_in, b_in, sgu_ln_g, sgu_ln_b, sgu_w, sgu_b,
              hy_conv_w, hy_conv_b, hy_w1, hy_b1, hy_w2, hy_b2, hy_freq, hy_w3, hy_skip,
              w_branch_a, w_branch_b, w_o, b_o, ln1_g, ln1_b,
              w_m1, b_m1, w_m2, b_m2, ln2_g, ln2_b):
    split_pts = [SGU_WIDTH, 2 * SGU_WIDTH, 2 * SGU_WIDTH + (HY_ORDER + 1) * HY_WIDTH]
    cond = jax.nn.silu(c)
    for l in range(DEPTH):
        mod = (cond @ w_ada[l] + b_ada[l])[:, None, :]
        sh1, sc1, g1, sh2, sc2, g2 = jnp.split(mod, N_MOD, axis=-1)

        h = x * (1.0 + sc1) + sh1
        z = h @ w_in[l] + b_in[l]
        z_u, z_v, z_h, z_g = jnp.split(z, split_pts, axis=-1)
        y_a = spatial_gating(jax.nn.gelu(z_u, approximate=False), jax.nn.gelu(z_v, approximate=False),
                             sgu_ln_g[l], sgu_ln_b[l], sgu_w[l], sgu_b[l]) @ w_branch_a[l]
        y_b = hyena(z_h, hy_conv_w[l], hy_conv_b[l], hy_w1[l], hy_b1[l], hy_w2[l], hy_b2[l],
                    hy_freq[l], hy_w3[l], hy_skip[l]) @ w_branch_b[l]
        gate_a, gate_b = jnp.split(jax.nn.sigmoid(z_g), N_BRANCHES, axis=-1)
        mix = (gate_a * y_a + gate_b * y_b) @ w_o[l] + b_o[l]
        x = layer_norm(DEEPNORM_ALPHA * x + g1 * mix, ln1_g[l], ln1_b[l])

        h = x * (1.0 + sc2) + sh2
        f = jnp.square(jax.nn.relu(h @ w_m1[l] + b_m1[l])) @ w_m2[l] + b_m2[l]
        x = layer_norm(DEEPNORM_ALPHA * x + g2 * f, ln2_g[l], ln2_b[l])
    return x
```

```cpp
#include <hip/hip_runtime.h>
#include <hip/hip_cooperative_groups.h>
#include <cstdio>
#include <cstdint>
namespace cg = cooperative_groups;

namespace pg8 {
#define PG8_LAS __attribute__((address_space(3)))
typedef unsigned short bf16_t;
typedef short bf16x8 __attribute__((ext_vector_type(8)));
typedef float f32x4 __attribute__((ext_vector_type(4)));
typedef unsigned u32x4 __attribute__((ext_vector_type(4)));
typedef float f32x2 __attribute__((ext_vector_type(2)));
constexpr int BM = 256, BK = 64, HALF = 128, HTB = HALF * BK * 2  , STAGE_BYTES = 8 * HTB, NXCD = 8, WGM = 8;

__host__ __device__ __forceinline__ int lds_byte(int r, int c) { const int st = (r >> 4) * 2 + (c >> 5), rr = r & 15, cc = c & 31, ob = rr * 64 + cc * 2; return st * 1024 + (ob ^ (((ob >> 9) & 1) << 5)); }
__host__ __device__ __forceinline__ void stage_rc(int b, int& R, int& C) { const int st = b / 1024, sb = b % 1024, swz = sb ^ (((sb >> 9) & 1) << 5); R = (st >> 1) * 16 + swz / 64; C = (st & 1) * 32 + (swz % 64) / 2; }
__host__ __device__ __forceinline__ int perm32(int rho) { const int n = rho >> 4, i = rho & 15; return 8 * (i >> 2) + 4 * n + (i & 3); }

struct Unit { int pm, pn; };
struct Gemm { const bf16_t* A; const bf16_t* Bt; int M, N, K; };

struct StaticOrder {
    int nM, nN, nwg, G, c;
    __host__ __device__ void init(int M, int N, int G_, int c_) { nM = M / BM; nN = N / BM; nwg = nM * nN; G = G_; c = c_; }
    __host__ __device__ bool next(int i, Unit& u) const {
        const long L = (long)i * G + c; if (L >= nwg) return false;
        int wgid = (int)L; { const int q = nwg / NXCD, r = nwg % NXCD, xcd = wgid % NXCD, off = wgid / NXCD; wgid = (xcd < r ? xcd * (q + 1) : r * (q + 1) + (xcd - r) * q) + off; }
        const int nig = WGM * nN, gid = wgid / nig, fm = gid * WGM, gsz = (nM - fm) < WGM ? (nM - fm) : WGM;
        u.pm = fm + ((wgid % nig) % gsz); u.pn = (wgid % nig) / gsz; return true;
    }
    __device__ __forceinline__ void a_ready(const Unit&) const {}
    __device__ __forceinline__ void done(const Unit&) const {}
};

__device__ __forceinline__ unsigned cvt_pk_bf16(float lo, float hi) { unsigned r; asm volatile("v_cvt_pk_bf16_f32 %0, %1, %2" : "=v"(r) : "v"(lo), "v"(hi)); return r; }
__device__ __forceinline__ f32x2 gelu_pk(f32x2 v) {
    const f32x2 av = __builtin_elementwise_abs(v), d = av * 0.2316418882f + 1.0f;
    f32x2 t; t.x = __builtin_amdgcn_rcpf(d.x); t.y = __builtin_amdgcn_rcpf(d.y);
    f32x2 q = t * 0.5307027145f + (-0.7265760135f); q = q * t + 0.7107068705f; q = q * t + (-0.142248368f); q = q * t + 0.127414796f; q = q * t;
    const f32x2 s = (v * v) * (-0.72134752044f);
    f32x2 e; e.x = __builtin_amdgcn_exp2f(s.x); e.y = __builtin_amdgcn_exp2f(s.y);
    const f32x2 m = v * (q * e), r = v - m;
    f32x2 o; o.x = v.x < 0.f ? m.x : r.x; o.y = v.y < 0.f ? m.y : r.y; return o;
}
__device__ __forceinline__ float bf_lo(unsigned w) { return __uint_as_float(w << 16); }
__device__ __forceinline__ float bf_hi(unsigned w) { return __uint_as_float(w & 0xffff0000u); }
__device__ __forceinline__ float sigmoid_f(float x) { return __builtin_amdgcn_rcpf(1.0f + __expf(-x)); }
}

constexpr int DM = 2048, NBATCH = 8, SEQ = 2048, MTOK = NBATCH * SEQ;
constexpr int SGUW = 1024, HYW = 1024, DFF = 8192, INW = 9216, MODW = 6 * DM;
constexpr float LN_EPS = 1e-5f;
constexpr float DN_ALPHA = 1.189207115002721f;

namespace pg8 {

struct EpiG1 {
    static constexpr bool PERM = true, AFTER_DRAIN = false, MID = false;
    bf16_t* U; bf16_t* V; bf16_t* G; const float* b_in; float* statsV;
    __device__ __forceinline__ void mid(f32x4 (&)[2][2][4][2], const Unit&, int, int, int, int) const {}
    __device__ __forceinline__ void operator()(const f32x4 (&acc)[2][2][4][2], const Unit& u, int wr, int wc, int fr, int fq) const {
        const int row0 = u.pm * BM + wr * 64 + fr; const int pn = u.pn;
        int kind, ldc, colt, bcol; bf16_t* base;
        if (pn < 4) { kind = 0; base = U; ldc = SGUW; colt = pn * 256; bcol = pn * 256; }
        else if (pn < 8) { kind = 1; base = V; ldc = SGUW; colt = (pn - 4) * 256; bcol = pn * 256; }
        else { kind = 2; base = G; ldc = 2 * DM; colt = (pn - 8) * 256; bcol = 5120 + (pn - 8) * 256; }
        const int cl = wc * 32 + 8 * fq;
        f32x4 bv[2][2];
#pragma unroll
        for (int bj = 0; bj < 2; ++bj)
#pragma unroll
            for (int n = 0; n < 2; ++n) bv[bj][n] = *(const f32x4*)(b_in + bcol + cl + bj * HALF + 4 * n);
#pragma unroll
        for (int ai = 0; ai < 2; ++ai)
#pragma unroll
            for (int m = 0; m < 4; ++m) {
                const int row = row0 + ai * HALF + m * 16;
                bf16_t* rowp = base + (size_t)row * ldc + colt + cl;
                float s = 0.f, q = 0.f;
#pragma unroll
                for (int bj = 0; bj < 2; ++bj) {
                    f32x4 v0 = acc[ai][bj][m][0] + bv[bj][0], v1 = acc[ai][bj][m][1] + bv[bj][1];
                    if (kind < 2) {
                        f32x2 a = gelu_pk((f32x2){v0[0], v0[1]}), b = gelu_pk((f32x2){v0[2], v0[3]}), c = gelu_pk((f32x2){v1[0], v1[1]}), d = gelu_pk((f32x2){v1[2], v1[3]});
                        v0 = (f32x4){a.x, a.y, b.x, b.y}; v1 = (f32x4){c.x, c.y, d.x, d.y};
                    } else {
                        v0 = (f32x4){sigmoid_f(v0[0]), sigmoid_f(v0[1]), sigmoid_f(v0[2]), sigmoid_f(v0[3])};
                        v1 = (f32x4){sigmoid_f(v1[0]), sigmoid_f(v1[1]), sigmoid_f(v1[2]), sigmoid_f(v1[3])};
                    }
                    u32x4 w; w.x = cvt_pk_bf16(v0[0], v0[1]); w.y = cvt_pk_bf16(v0[2], v0[3]); w.z = cvt_pk_bf16(v1[0], v1[1]); w.w = cvt_pk_bf16(v1[2], v1[3]);
                    *(u32x4*)(rowp + bj * HALF) = w;
                    if (kind == 1) {
                        const float e0 = bf_lo(w.x), e1 = bf_hi(w.x), e2 = bf_lo(w.y), e3 = bf_hi(w.y), e4 = bf_lo(w.z), e5 = bf_hi(w.z), e6 = bf_lo(w.w), e7 = bf_hi(w.w);
                        s += ((e0 + e1) + (e2 + e3)) + ((e4 + e5) + (e6 + e7));
                        q += ((e0 * e0 + e1 * e1) + (e2 * e2 + e3 * e3)) + ((e4 * e4 + e5 * e5) + (e6 * e6 + e7 * e7));
                    }
                }
                if (kind == 1) {
                    s += __shfl_xor(s, 16); s += __shfl_xor(s, 32); q += __shfl_xor(q, 16); q += __shfl_xor(q, 32);
                    if (fq == 0) *(f32x2*)(statsV + ((size_t)row * 16 + (pn - 4) * 4 + wc) * 2) = (f32x2){s, q};
                }
            }
    }
};

struct EpiG1T {
    static constexpr bool PERM = true, AFTER_DRAIN = false, MID = false;
    bf16_t* ZHT; const float* b_in;
    __device__ __forceinline__ void mid(f32x4 (&)[2][2][4][2], const Unit&, int, int, int, int) const {}
    __device__ __forceinline__ void operator()(const f32x4 (&acc)[2][2][4][2], const Unit& u, int wr, int wc, int fr, int fq) const {
        const int row0 = u.pm * BM + wr * 64 + fr; const int col0 = u.pn * BM + wc * 32 + 8 * fq;
#pragma unroll
        for (int ai = 0; ai < 2; ++ai)
#pragma unroll
            for (int m = 0; m < 4; ++m) {
                const int row = row0 + ai * HALF + m * 16; const float bb = b_in[2048 + row];
                bf16_t* rowp = ZHT + (size_t)row * MTOK + col0;
#pragma unroll
                for (int bj = 0; bj < 2; ++bj) {
                    const f32x4 v0 = acc[ai][bj][m][0] + bb, v1 = acc[ai][bj][m][1] + bb;
                    u32x4 w; w.x = cvt_pk_bf16(v0[0], v0[1]); w.y = cvt_pk_bf16(v0[2], v0[3]); w.z = cvt_pk_bf16(v1[0], v1[1]); w.w = cvt_pk_bf16(v1[2], v1[3]);
                    *(u32x4*)(rowp + bj * HALF) = w;
                }
            }
    }
};

struct EpiG2 {
    static constexpr bool PERM = true, AFTER_DRAIN = false, MID = true;
    const bf16_t* G; bf16_t* O;
    __device__ __forceinline__ void mid(f32x4 (&acc)[2][2][4][2], const Unit& u, int wr, int wc, int fr, int fq) const {
        int row0 = u.pm * BM + wr * 64 + fr, col0 = u.pn * BM + wc * 32 + 8 * fq;
        asm volatile("" : "+v"(row0), "+v"(col0));
#pragma unroll
        for (int ai = 0; ai < 2; ++ai)
#pragma unroll
            for (int m = 0; m < 4; ++m) {
                const bf16_t* gp = G + (size_t)(row0 + ai * HALF + m * 16) * (2 * DM) + col0;
#pragma unroll
                for (int bj = 0; bj < 2; ++bj) {
                    const u32x4 ga = *(const u32x4*)(gp + bj * HALF), gb = *(const u32x4*)(gp + DM + bj * HALF);
                    f32x4 r0, r1;
                    r0[0] = bf_lo(ga.x) * __builtin_amdgcn_rcpf(bf_lo(gb.x)); r0[1] = bf_hi(ga.x) * __builtin_amdgcn_rcpf(bf_hi(gb.x));
                    r0[2] = bf_lo(ga.y) * __builtin_amdgcn_rcpf(bf_lo(gb.y)); r0[3] = bf_hi(ga.y) * __builtin_amdgcn_rcpf(bf_hi(gb.y));
                    r1[0] = bf_lo(ga.z) * __builtin_amdgcn_rcpf(bf_lo(gb.z)); r1[1] = bf_hi(ga.z) * __builtin_amdgcn_rcpf(bf_hi(gb.z));
                    r1[2] = bf_lo(ga.w) * __builtin_amdgcn_rcpf(bf_lo(gb.w)); r1[3] = bf_hi(ga.w) * __builtin_amdgcn_rcpf(bf_hi(gb.w));
                    acc[ai][bj][m][0] *= r0; acc[ai][bj][m][1] *= r1;
                }
            }
    }
    __device__ __forceinline__ void operator()(const f32x4 (&acc)[2][2][4][2], const Unit& u, int wr, int wc, int fr, int fq) const {
        const int row0 = u.pm * BM + wr * 64 + fr, col0 = u.pn * BM + wc * 32 + 8 * fq;
#pragma unroll
        for (int ai = 0; ai < 2; ++ai)
#pragma unroll
            for (int m = 0; m < 4; ++m) {
                const int row = row0 + ai * HALF + m * 16;
                const bf16_t* gp = G + (size_t)row * (2 * DM) + DM + col0;
                bf16_t* op = O + (size_t)row * DM + col0;
#pragma unroll
                for (int bj = 0; bj < 2; ++bj) {
                    const u32x4 gb = *(const u32x4*)(gp + bj * HALF);
                    const f32x4 a0 = acc[ai][bj][m][0], a1 = acc[ai][bj][m][1];
                    u32x4 w; w.x = cvt_pk_bf16(a0[0] * bf_lo(gb.x), a0[1] * bf_hi(gb.x)); w.y = cvt_pk_bf16(a0[2] * bf_lo(gb.y), a0[3] * bf_hi(gb.y));
                    w.z = cvt_pk_bf16(a1[0] * bf_lo(gb.z), a1[1] * bf_hi(gb.z)); w.w = cvt_pk_bf16(a1[2] * bf_lo(gb.w), a1[3] * bf_hi(gb.w));
                    *(u32x4*)(op + bj * HALF) = w;
                }
            }
    }
};

template <bool FIRST> struct EpiRes {
    static constexpr bool PERM = false, AFTER_DRAIN = false, MID = false;
    const float* X;
    float* R;
    const float* gate;
    const float* bias;
    const float* lng; const float* lnb; const float* MU;
    float* stats;
    __device__ __forceinline__ void mid(f32x4 (&)[2][2][4][2], const Unit&, int, int, int, int) const {}
    __device__ __forceinline__ void operator()(const f32x4 (&acc)[2][2][4][2], const Unit& u, int wr, int wc, int fr, int fq) const {
        int row0 = u.pm * BM + wr * 64 + fr, col0 = u.pn * BM + wc * 32 + 4 * fq; const int b = u.pm >> 3;
        asm volatile("" : "+v"(row0), "+v"(col0));
        const float* gp = gate + (size_t)b * MODW + col0; const float* bp = bias + col0;
#pragma unroll
        for (int ai = 0; ai < 2; ++ai)
#pragma unroll
            for (int m = 0; m < 4; ++m) {
                const int row = row0 + ai * HALF + m * 16;
                float s = 0.f, q = 0.f; f32x2 mr = (f32x2){0.f, 1.f};
                if (!FIRST) mr = *(const f32x2*)(MU + (size_t)row * 2);
                float* rp = R + (size_t)row * DM + col0; const float* xp = X + (size_t)row * DM + col0;
#pragma unroll
                for (int bj = 0; bj < 2; ++bj)
#pragma unroll
                    for (int n = 0; n < 2; ++n) {
                        const int co = bj * HALF + n * 16;
                        const f32x4 gv = *(const f32x4*)(gp + co), bv = *(const f32x4*)(bp + co);
                        f32x4 base;
                        if (FIRST) base = *(const f32x4*)(xp + co);
                        else { const f32x4 rv = *(const f32x4*)(rp + co); base = (rv - mr.x) * mr.y * *(const f32x4*)(lng + col0 + co) + *(const f32x4*)(lnb + col0 + co); }
                        const f32x4 o = base * DN_ALPHA + gv * (acc[ai][bj][m][n] + bv);
                        *(f32x4*)(rp + co) = o;
                        s += (o[0] + o[1]) + (o[2] + o[3]); q += (o[0] * o[0] + o[1] * o[1]) + (o[2] * o[2] + o[3] * o[3]);
                    }
                s += __shfl_xor(s, 16); s += __shfl_xor(s, 32); q += __shfl_xor(q, 16); q += __shfl_xor(q, 32);
                if (fq == 0) *(f32x2*)(stats + ((size_t)row * 32 + u.pn * 4 + wc) * 2) = (f32x2){s, q};
                asm volatile("" ::: "memory");
            }
    }
};

struct EpiG4 {
    static constexpr bool PERM = true, AFTER_DRAIN = false, MID = false;
    bf16_t* O; const float* bias;
    __device__ __forceinline__ void mid(f32x4 (&)[2][2][4][2], const Unit&, int, int, int, int) const {}
    __device__ __forceinline__ void operator()(const f32x4 (&acc)[2][2][4][2], const Unit& u, int wr, int wc, int fr, int fq) const {
        const int row0 = u.pm * BM + wr * 64 + fr, col0 = u.pn * BM + wc * 32 + 8 * fq;
        f32x4 bv[2][2];
#pragma unroll
        for (int bj = 0; bj < 2; ++bj)
#pragma unroll
            for (int n = 0; n < 2; ++n) bv[bj][n] = *(const f32x4*)(bias + col0 + bj * HALF + 4 * n);
#pragma unroll
        for (int ai = 0; ai < 2; ++ai)
#pragma unroll
            for (int m = 0; m < 4; ++m) {
                bf16_t* rowp = O + (size_t)(row0 + ai * HALF + m * 16) * DFF + col0;
#pragma unroll
                for (int bj = 0; bj < 2; ++bj) {
                    f32x4 v0 = acc[ai][bj][m][0] + bv[bj][0], v1 = acc[ai][bj][m][1] + bv[bj][1];
                    v0 = __builtin_elementwise_max(v0, (f32x4){0.f, 0.f, 0.f, 0.f}); v1 = __builtin_elementwise_max(v1, (f32x4){0.f, 0.f, 0.f, 0.f});
                    v0 = v0 * v0; v1 = v1 * v1;
                    u32x4 w; w.x = cvt_pk_bf16(v0[0], v0[1]); w.y = cvt_pk_bf16(v0[2], v0[3]); w.z = cvt_pk_bf16(v1[0], v1[1]); w.w = cvt_pk_bf16(v1[2], v1[3]);
                    *(u32x4*)(rowp + bj * HALF) = w;
                }
            }
    }
};
}
namespace pg8 {
template <class Epi, class Sched, bool ALIGN_EPI = false, bool SP2 = false>
__device__ __forceinline__ void gemm_phase(PG8_LAS unsigned char* lds, const Gemm g, const Sched& S, const Epi& E) {
    const int tid = threadIdx.x, wid = __builtin_amdgcn_readfirstlane(tid >> 6), lane = tid & 63, wr = wid >> 2, wc = wid & 3, fr = lane & 15, fq = lane >> 4;
    const int K = g.K, nt = K / BK;
    unsigned voffA[2], voffB[2];
#pragma unroll
    for (int i = 0; i < 2; ++i) { int R, C; stage_rc(tid * 16 + i * 8192, R, C); const int Rb = Epi::PERM ? ((R & ~31) + perm32(R & 31)) : R;
        voffA[i] = (unsigned)(R * K + C) * 2u; voffB[i] = (unsigned)(Rb * K + C) * 2u; }
    const size_t kstep = (size_t)(BK * 2);
    const size_t hstep = (size_t)HALF * K * 2;
    const size_t tstep = 2 * hstep;
    const unsigned ldsw = (unsigned)wid * 1024u;
    const int aoff = lds_byte(wr * 64 + fr, fq * 8), boff = lds_byte(wc * 32 + fr, fq * 8);
#define PG8_SA(b, h) (((b) * 2 + (h)) * HTB)
#define PG8_SB(b, h) ((4 + (b) * 2 + (h)) * HTB)
#define PG8_STAGE(bufoff, gbase, voff) do { _Pragma("unroll") for (int _i = 0; _i < 2; ++_i) \
        __builtin_amdgcn_global_load_lds((const unsigned*)((const char*)(gbase) + (voff)[_i]), (PG8_LAS unsigned*)(lds + (bufoff) + ldsw + _i * 8192), 16, 0, 0); } while (0)
#define PG8_LDA(dst, b, h) do { _Pragma("unroll") for (int m = 0; m < 4; ++m) _Pragma("unroll") for (int k = 0; k < 2; ++k) dst[m][k] = *(const PG8_LAS bf16x8*)(lds + PG8_SA(b, h) + aoff + m * 2048 + k * 1024); } while (0)
#define PG8_LDB(dst, b, h) do { _Pragma("unroll") for (int n = 0; n < 2; ++n) _Pragma("unroll") for (int k = 0; k < 2; ++k) dst[n][k] = *(const PG8_LAS bf16x8*)(lds + PG8_SB(b, h) + boff + n * 2048 + k * 1024); } while (0)
#define PG8_MMA(ai, bj, At, Bt) do { __builtin_amdgcn_s_setprio(1); _Pragma("unroll") for (int m = 0; m < 4; ++m) _Pragma("unroll") for (int n = 0; n < 2; ++n) _Pragma("unroll") for (int k = 0; k < 2; ++k) \
        acc[ai][bj][m][n] = __builtin_amdgcn_mfma_f32_16x16x32_bf16(Bt[n][k], At[m][k], acc[ai][bj][m][n], 0, 0, 0); __builtin_amdgcn_s_setprio(0); } while (0)
#define PG8_WAIT_V(n) asm volatile("s_waitcnt vmcnt(" #n ")" ::: "memory")
#define PG8_WAIT_L(n) asm volatile("s_waitcnt lgkmcnt(" #n ")" ::: "memory")
#define PG8_BAR __builtin_amdgcn_s_barrier()
#define PG8_SCHED __builtin_amdgcn_sched_barrier(0)
    Unit cur, nxt; int ui = 0;
    if (!S.next(0, cur)) return;
    f32x4 acc[2][2][4][2];
#pragma unroll
    for (int a = 0; a < 2; ++a)
#pragma unroll
        for (int b = 0; b < 2; ++b)
#pragma unroll
            for (int m = 0; m < 4; ++m)
#pragma unroll
                for (int n = 0; n < 2; ++n) acc[a][b][m][n] = (f32x4){0.f, 0.f, 0.f, 0.f};
    bf16x8 At[4][2], B0[2][2], B1[2][2];
    const char* cA = (const char*)g.A + (size_t)cur.pm * tstep; const char* cB = (const char*)g.Bt + (size_t)cur.pn * tstep;
    S.a_ready(cur);
    if constexpr (SP2) {
        PG8_STAGE(PG8_SB(0, 0), cB, voffB); PG8_STAGE(PG8_SB(0, 1), cB + hstep, voffB); PG8_STAGE(PG8_SA(0, 0), cA, voffA); PG8_STAGE(PG8_SA(0, 1), cA + hstep, voffA);
        if (wr == 1) PG8_BAR;
        PG8_WAIT_V(2); PG8_BAR;
        PG8_STAGE(PG8_SB(1, 0), cB + kstep, voffB); PG8_STAGE(PG8_SA(1, 0), cA + kstep, voffA); PG8_STAGE(PG8_SB(1, 1), cB + hstep + kstep, voffB);
        PG8_WAIT_V(6); PG8_BAR;
    } else {
        PG8_STAGE(PG8_SB(0, 0), cB, voffB); PG8_STAGE(PG8_SA(0, 0), cA, voffA); PG8_STAGE(PG8_SB(0, 1), cB + hstep, voffB); PG8_STAGE(PG8_SA(0, 1), cA + hstep, voffA);
        if (wr == 1) PG8_BAR;
        PG8_WAIT_V(4); PG8_BAR;
        PG8_STAGE(PG8_SB(1, 0), cB + kstep, voffB); PG8_STAGE(PG8_SA(1, 0), cA + kstep, voffA); PG8_STAGE(PG8_SB(1, 1), cB + hstep + kstep, voffB);
        PG8_WAIT_V(6); PG8_BAR;
    }
    for (;;) {
        const bool has_next = S.next(ui + 1, nxt);
        const char* nA = has_next ? (const char*)g.A + (size_t)nxt.pm * tstep : cA; const char* nB = has_next ? (const char*)g.Bt + (size_t)nxt.pn * tstep : cB;
        for (int t = 0; t < nt; t += 2) {
            const bool last = (t == nt - 2);
            const char* a1 = cA + (size_t)(t + 1) * kstep;
            const char* a2 = last ? nA : cA + (size_t)(t + 2) * kstep; const char* b2 = last ? nB : cB + (size_t)(t + 2) * kstep;
            const char* a3 = a2 + kstep; const char* b3 = b2 + kstep;
            if (last && has_next) S.a_ready(nxt);
            if constexpr (Epi::MID) { if (t == (nt >> 1)) E.mid(acc, cur, wr, wc, fr, fq); }
            if constexpr (SP2) {
            PG8_LDB(B0, 0, 0); PG8_LDB(B1, 0, 1); PG8_SCHED; PG8_LDA(At, 0, 0); PG8_STAGE(PG8_SA(1, 1), a1 + hstep, voffA);
            PG8_WAIT_V(8); PG8_WAIT_L(0); PG8_BAR; PG8_MMA(0, 0, At, B0); PG8_MMA(0, 1, At, B1); PG8_BAR; PG8_SCHED;
            PG8_LDA(At, 0, 1); PG8_STAGE(PG8_SB(0, 0), b2, voffB); PG8_STAGE(PG8_SB(0, 1), b2 + hstep, voffB); PG8_STAGE(PG8_SA(0, 0), a2, voffA);
            PG8_WAIT_V(8); PG8_WAIT_L(0); PG8_BAR; PG8_MMA(1, 0, At, B0); PG8_MMA(1, 1, At, B1); PG8_BAR; PG8_SCHED;
            PG8_LDB(B0, 1, 0); PG8_LDB(B1, 1, 1); PG8_SCHED; PG8_LDA(At, 1, 0); PG8_STAGE(PG8_SA(0, 1), a2 + hstep, voffA);
            PG8_WAIT_V(8); PG8_WAIT_L(0); PG8_BAR; PG8_MMA(0, 0, At, B0); PG8_MMA(0, 1, At, B1); PG8_BAR; PG8_SCHED;
            PG8_LDA(At, 1, 1); PG8_STAGE(PG8_SB(1, 0), b3, voffB); PG8_STAGE(PG8_SB(1, 1), b3 + hstep, voffB); PG8_STAGE(PG8_SA(1, 0), a3, voffA);
            PG8_WAIT_V(8); PG8_WAIT_L(0); PG8_BAR; PG8_MMA(1, 0, At, B0); PG8_MMA(1, 1, At, B1); PG8_BAR; PG8_SCHED;
            } else {
            PG8_LDB(B0, 0, 0); PG8_SCHED; PG8_LDA(At, 0, 0); PG8_STAGE(PG8_SA(1, 1), a1 + hstep, voffA);
            PG8_WAIT_L(8); PG8_BAR; PG8_WAIT_L(0); PG8_MMA(0, 0, At, B0); PG8_BAR; PG8_SCHED;
            PG8_LDB(B1, 0, 1); PG8_STAGE(PG8_SB(0, 0), b2, voffB);
            PG8_BAR; PG8_WAIT_L(0); PG8_MMA(0, 1, At, B1); PG8_BAR;
            PG8_LDA(At, 0, 1); PG8_STAGE(PG8_SA(0, 0), a2, voffA);
            PG8_BAR; PG8_WAIT_L(0); PG8_MMA(1, 0, At, B0); PG8_BAR; PG8_SCHED;
            PG8_STAGE(PG8_SB(0, 1), b2 + hstep, voffB);
            PG8_WAIT_V(6); PG8_BAR; PG8_MMA(1, 1, At, B1); PG8_BAR;
            PG8_LDB(B0, 1, 0); PG8_SCHED; PG8_LDA(At, 1, 0); PG8_STAGE(PG8_SA(0, 1), a2 + hstep, voffA);
            PG8_WAIT_L(8); PG8_BAR; PG8_WAIT_L(0); PG8_MMA(0, 0, At, B0); PG8_BAR; PG8_SCHED;
            PG8_LDB(B1, 1, 1); PG8_STAGE(PG8_SB(1, 0), b3, voffB);
            PG8_BAR; PG8_WAIT_L(0); PG8_MMA(0, 1, At, B1); PG8_BAR;
            PG8_LDA(At, 1, 1); PG8_STAGE(PG8_SA(1, 0), a3, voffA);
            PG8_BAR; PG8_WAIT_L(0); PG8_MMA(1, 0, At, B0); PG8_BAR; PG8_SCHED;
            PG8_STAGE(PG8_SB(1, 1), b3 + hstep, voffB);
            PG8_WAIT_V(6); PG8_BAR; PG8_MMA(1, 1, At, B1); PG8_BAR;
            }
        }
        if constexpr (ALIGN_EPI) { if (wr == 0) PG8_BAR; }
        if constexpr (!Epi::AFTER_DRAIN) { E(acc, cur, wr, wc, fr, fq); S.done(cur); }
        if (!has_next) break;
#pragma unroll
        for (int a = 0; a < 2; ++a)
#pragma unroll
            for (int b = 0; b < 2; ++b)
#pragma unroll
                for (int m = 0; m < 4; ++m)
#pragma unroll
                    for (int n = 0; n < 2; ++n) acc[a][b][m][n] = (f32x4){0.f, 0.f, 0.f, 0.f};
        cur = nxt; cA = nA; cB = nB; ++ui;
        if constexpr (ALIGN_EPI) { if (wr == 1) PG8_BAR; }
    }
    PG8_WAIT_V(0);
    if constexpr (!ALIGN_EPI) { if (wr == 0) PG8_BAR; }
    PG8_BAR;
    if constexpr (Epi::AFTER_DRAIN) { E.fused(acc, cur, wr, wc, fr, fq, lds, wid, lane); S.done(cur); }
#undef PG8_SA
#undef PG8_SB
#undef PG8_STAGE
#undef PG8_LDA
#undef PG8_LDB
#undef PG8_MMA
#undef PG8_WAIT_V
#undef PG8_WAIT_L
#undef PG8_BAR
#undef PG8_SCHED
}
}

constexpr size_t MiB = 1u << 20;
constexpr size_t WS_CTL = 0;
constexpr size_t WS_MOD = 1 * MiB;
constexpr size_t WS_STV = 2 * MiB;
constexpr size_t WS_ST1 = 4 * MiB;
constexpr size_t WS_ST2 = 8 * MiB;
constexpr size_t WS_MU1 = 12 * MiB;
constexpr size_t WS_WIN = 16 * MiB;
constexpr size_t WS_WAB = 52 * MiB;
constexpr size_t WS_WO = 60 * MiB;
constexpr size_t WS_FILT = 68 * MiB;
constexpr size_t WS_WM2 = 68 * MiB;
constexpr size_t WS_H = 100 * MiB;
constexpr size_t WS_U = 164 * MiB;
constexpr size_t WS_V = 196 * MiB;
constexpr size_t WS_MERGED = 164 * MiB;
constexpr size_t WS_ZHT = 228 * MiB;
constexpr size_t WS_G = 324 * MiB;
constexpr size_t WS_AFF = 164 * MiB;
constexpr size_t WS_WM1 = 420 * MiB;
constexpr size_t WS_END = 452 * MiB;

constexpr int NWAVES = 8;
constexpr int LDS_BYTES = 147456;

#define GAS __attribute__((address_space(1)))
#define LAS __attribute__((address_space(3)))
typedef unsigned short bf16;
typedef unsigned v4u __attribute__((ext_vector_type(4)));
typedef unsigned v2u __attribute__((ext_vector_type(2)));
typedef float f32x4 __attribute__((ext_vector_type(4)));
typedef float f32x2 __attribute__((ext_vector_type(2)));
#define LDS_WAIT() asm volatile("s_waitcnt lgkmcnt(0)" ::: "memory")

__device__ __forceinline__ unsigned f2bf(float f) { unsigned u = __builtin_bit_cast(unsigned, f); return (u + 0x7fffu + ((u >> 16) & 1u)) >> 16; }
__device__ __forceinline__ unsigned pk2(float lo, float hi) { return f2bf(lo) | (f2bf(hi) << 16); }
__device__ __forceinline__ float bflo(unsigned w) { return __uint_as_float(w << 16); }
__device__ __forceinline__ float bfhi(unsigned w) { return __uint_as_float(w & 0xffff0000u); }
__device__ __forceinline__ float bf1(bf16 h) { return __uint_as_float((unsigned)h << 16); }
__device__ __forceinline__ float wave_sum(float v) {
#pragma unroll
    for (int o = 1; o < 64; o <<= 1) v += __shfl_xor(v, o);
    return v;
}

struct Args { const float* in[31]; float* out; unsigned char* ws; int ph_lo, ph_hi; };

struct Frame {
    LAS unsigned char* lds;
    int tid, lane, wave, G;
    const float* const* in; float* out; unsigned char* ws;
};
enum { I_X = 0, I_C, I_WADA, I_BADA, I_WIN, I_BIN, I_SLNG, I_SLNB, I_SW, I_SB, I_HCW, I_HCB, I_HW1, I_HB1, I_HW2, I_HB2, I_HFREQ, I_HW3, I_HSKIP,
       I_WA, I_WB, I_WO, I_BO, I_LN1G, I_LN1B, I_WM1, I_BM1, I_WM2, I_BM2, I_LN2G, I_LN2B };

__device__ __forceinline__ void transpose_item(const float* W, int N, bf16* WT, int ldk, int koff, int n0, int row0, int k0, LAS float* scr, int lane) {
#pragma unroll 8
    for (int i = 0; i < 32; ++i) { const int kk = 2 * i + (lane >> 5); scr[kk * 33 + (lane & 31)] = W[(size_t)(k0 + kk) * N + n0 + (lane & 31)]; }
    LDS_WAIT(); asm volatile("" ::: "memory");
    const int c = lane & 7;
#pragma unroll
    for (int j = 0; j < 4; ++j) { const int n = (lane >> 3) + 8 * j; const LAS float* s = scr + (8 * c) * 33 + n;
        v4u o; o.x = pk2(s[0 * 33], s[1 * 33]); o.y = pk2(s[2 * 33], s[3 * 33]); o.z = pk2(s[4 * 33], s[5 * 33]); o.w = pk2(s[6 * 33], s[7 * 33]);
        *(GAS v4u*)(WT + (size_t)(row0 + n) * ldk + koff + k0 + 8 * c) = o; }
    LDS_WAIT(); asm volatile("" ::: "memory");
}
__device__ __forceinline__ void transpose_matrix(Frame& F, const float* W, int K, int N, bf16* WT, int ldk, int koff, int remap_win, int gw, int NGW) {
    LAS float* scr = (LAS float*)(F.lds + F.wave * 16384);
    const int nblk = N / 32, nitems = (K / 64) * nblk;
    for (int it = gw; it < nitems; it += NGW) {
        const int kb = it / nblk, nb = it % nblk, n0 = nb * 32; int row0 = n0;
        if (remap_win) row0 = (n0 < 2048) ? n0 : (n0 < 5120 ? n0 - 2048 + 6144 : n0 - 5120 + 2048);
        transpose_item(W, N, WT, ldk, koff, n0, row0, kb * 64, scr, F.lane);
    }
}

__device__ __forceinline__ void p0_mod(Frame& F) {
    LAS float* condS = (LAS float*)F.lds;
    LAS float* red = (LAS float*)(F.lds + 65536);
    const float* c = F.in[I_C]; const float* w_ada = F.in[I_WADA]; const float* b_ada = F.in[I_BADA];
    float* mod = (float*)(F.ws + WS_MOD);
    const int tid = F.tid;
    for (int item = blockIdx.x; item < MODW / 64; item += F.G) {
        for (int i = tid; i < NBATCH * DM; i += NWAVES * 64) { const float v = c[i]; condS[i] = v / (1.0f + __expf(-v)); }
        __syncthreads();
        const int cq = tid & 15, kq = tid >> 4, col0 = item * 64;
        f32x4 acc[8];
#pragma unroll
        for (int b = 0; b < 8; ++b) acc[b] = (f32x4){0.f, 0.f, 0.f, 0.f};
        const float* wp = w_ada + (size_t)kq * MODW + col0 + cq * 4;
        for (int k = kq; k < DM; k += 32, wp += (size_t)32 * MODW) {
            const f32x4 w = *(const f32x4*)wp;
#pragma unroll
            for (int b = 0; b < 8; ++b) acc[b] += w * condS[b * DM + k];
        }
#pragma unroll
        for (int b = 0; b < 8; ++b) *(LAS f32x4*)(red + (kq * 8 + b) * 64 + cq * 4) = acc[b];
        __syncthreads();
        { const int b = tid >> 6, col = tid & 63; float s = 0.f;
#pragma unroll 8
          for (int k2 = 0; k2 < 32; ++k2) s += red[(k2 * 8 + b) * 64 + col];
          mod[(size_t)b * MODW + col0 + col] = s + b_ada[col0 + col]; }
        __syncthreads();
    }
}

__device__ __forceinline__ void p0_filter(Frame& F) {
    LAS float* featS = (LAS float*)F.lds;
    LAS float* h1S = featS + 8 * 64;
    LAS float* h2S = h1S + 8 * 64;
    const float* w1 = F.in[I_HW1]; const float* b1 = F.in[I_HB1]; const float* w2 = F.in[I_HW2]; const float* b2 = F.in[I_HB2];
    const float* freq = F.in[I_HFREQ]; const float* w3 = F.in[I_HW3];
    float* FILT = (float*)(F.ws + WS_FILT);
    const int tid = F.tid, lane = F.lane, wave = F.wave;
    const float min_decay = -3.0701134573253943f, max_decay = -15.350567286626972f;
    for (int item = blockIdx.x; item < SEQ / 8; item += F.G) {
        const int l = item * 8 + wave;
        const float tl = (float)l / (float)(SEQ - 1), omega = 6.283185307179586f * (float)l / (float)SEQ;
        float f = 0.f;
        if (lane == 0) f = tl;
        else if (lane <= 16) { const float band = 1e-4f + (float)(lane - 1) * ((15.0f - 1e-4f) / 15.0f); f = cosf(band * omega); }
        else if (lane <= 32) { const float band = 1e-4f + (float)(lane - 17) * ((15.0f - 1e-4f) / 15.0f); f = -sinf(band * omega); }
        featS[wave * 64 + lane] = f;
        __syncthreads();
        float a = b1[lane];
        for (int i = 0; i < 33; ++i) a += featS[wave * 64 + i] * w1[i * 64 + lane];
        h1S[wave * 64 + lane] = sinf(freq[lane] * a);
        __syncthreads();
        a = b2[lane];
        for (int i = 0; i < 64; ++i) a += h1S[wave * 64 + i] * w2[i * 64 + lane];
        h2S[wave * 64 + lane] = sinf(freq[lane] * a);
        __syncthreads();
        for (int jj = 0; jj < 8; ++jj) {
            const int j = tid + 512 * jj;
            float acc[8];
#pragma unroll
            for (int p = 0; p < 8; ++p) acc[p] = 0.f;
            for (int i = 0; i < 64; ++i) { const float w = w3[(size_t)i * 4096 + j];
#pragma unroll
                for (int p = 0; p < 8; ++p) acc[p] += h2S[p * 64 + i] * w; }
            const int ch = j & 1023; const float delta = fabsf(min_decay + (float)ch * ((max_decay - min_decay) / 1023.0f));
#pragma unroll
            for (int p = 0; p < 8; ++p) { const float tp = (float)(item * 8 + p) / (float)(SEQ - 1); acc[p] *= expf(-tp * delta); }
            float* o = FILT + (size_t)j * SEQ + item * 8;
            *(f32x4*)o = (f32x4){acc[0], acc[1], acc[2], acc[3]}; *(f32x4*)(o + 4) = (f32x4){acc[4], acc[5], acc[6], acc[7]};
        }
        __syncthreads();
    }
}

__device__ __forceinline__ void p1_modulate(Frame& F) {
    const float* x = F.in[I_X]; const float* mod = (const float*)(F.ws + WS_MOD); bf16* H = (bf16*)(F.ws + WS_H);
    const size_t nvec = (size_t)MTOK * DM / 8, stride = (size_t)F.G * NWAVES * 64;
    for (size_t i = (size_t)blockIdx.x * (NWAVES * 64) + F.tid; i < nvec; i += stride) {
        const int row = (int)(i >> 8), col = (int)(i & 255) * 8, b = row >> 11;
        const f32x4 x0 = *(const f32x4*)(x + (size_t)row * DM + col), x1 = *(const f32x4*)(x + (size_t)row * DM + col + 4);
        const float* mp = mod + (size_t)b * MODW + col;
        const f32x4 sh0 = *(const f32x4*)mp, sh1 = *(const f32x4*)(mp + 4), sc0 = *(const f32x4*)(mp + DM), sc1 = *(const f32x4*)(mp + DM + 4);
        const f32x4 h0 = x0 * (sc0 + 1.0f) + sh0, h1 = x1 * (sc1 + 1.0f) + sh1;
        v4u o; o.x = pk2(h0[0], h0[1]); o.y = pk2(h0[2], h0[3]); o.z = pk2(h1[0], h1[1]); o.w = pk2(h1[2], h1[3]);
        *(v4u*)(H + (size_t)row * DM + col) = o;
    }
}

__device__ __forceinline__ void p3_sgu(Frame& F) {
    LAS float* vnS = (LAS float*)F.lds;
    LAS float* stS = (LAS float*)(F.lds + 65536);
    const bf16* U = (const bf16*)(F.ws + WS_U); const bf16* V = (const bf16*)(F.ws + WS_V); bf16* AB = (bf16*)(F.ws + WS_H);
    const float* stv = (const float*)(F.ws + WS_STV);
    const float* lng = F.in[I_SLNG]; const float* lnb = F.in[I_SLNB]; const float* sw = F.in[I_SW]; const float* sb = F.in[I_SB];
    const int tid = F.tid;
    for (int item = blockIdx.x; item < 1024; item += F.G) {
        const int b = item >> 7, n = (item >> 3) & 15, g = item & 7, tok0 = b * SEQ + n * 128;
        if (tid < 128) { float s = 0.f, q = 0.f; const float* sp = stv + (size_t)(tok0 + tid) * 32;
            for (int i = 0; i < 16; ++i) { s += sp[2 * i]; q += sp[2 * i + 1]; }
            const float mean = s * (1.0f / 1024.0f); float var = q * (1.0f / 1024.0f) - mean * mean; var = var > 0.f ? var : 0.f;
            stS[2 * tid] = mean; stS[2 * tid + 1] = 1.0f / sqrtf(var + LN_EPS); }
        __syncthreads();
        { const int p = tid >> 2, cseg = (tid & 3) * 32; const float mean = stS[2 * p], rstd = stS[2 * p + 1];
          const bf16* vp = V + (size_t)(tok0 + p) * SGUW + g * 128 + cseg;
#pragma unroll
          for (int k = 0; k < 4; ++k) { const v4u w = *(const v4u*)(vp + 8 * k); const int ch = g * 128 + cseg + 8 * k;
              const float e[8] = {bflo(w.x), bfhi(w.x), bflo(w.y), bfhi(w.y), bflo(w.z), bfhi(w.z), bflo(w.w), bfhi(w.w)};
#pragma unroll
              for (int i = 0; i < 8; ++i) vnS[p * 128 + cseg + 8 * k + i] = (e[i] - mean) * rstd * lng[ch + i] + lnb[ch + i]; } }
        __syncthreads();
        { const int q = tid >> 2, cs = (tid & 3) * 32;
          f32x4 acc[8];
#pragma unroll
          for (int i = 0; i < 8; ++i) acc[i] = (f32x4){0.f, 0.f, 0.f, 0.f};
          const float* wrow = sw + (size_t)(g * 128 + q) * 128;
          for (int p = 0; p < 128; ++p) { const float wv = wrow[p];
#pragma unroll
              for (int i = 0; i < 8; ++i) acc[i] += *(const LAS f32x4*)(vnS + p * 128 + cs + 4 * i) * wv; }
          const float bs = sb[g * 128 + q];
          const bf16* up = U + (size_t)(tok0 + q) * SGUW + g * 128 + cs; bf16* op = AB + (size_t)(tok0 + q) * DM + g * 128 + cs;
#pragma unroll
          for (int k = 0; k < 4; ++k) { const v4u w = *(const v4u*)(up + 8 * k); const f32x4 a0 = acc[2 * k] + bs, a1 = acc[2 * k + 1] + bs;
              v4u o; o.x = pk2(bflo(w.x) * a0[0], bfhi(w.x) * a0[1]); o.y = pk2(bflo(w.y) * a0[2], bfhi(w.y) * a0[3]);
              o.z = pk2(bflo(w.z) * a1[0], bfhi(w.z) * a1[1]); o.w = pk2(bflo(w.w) * a1[2], bfhi(w.w) * a1[3]);
              *(v4u*)(op + 8 * k) = o; } }
        __syncthreads();
    }
}

__device__ __forceinline__ float sconv(const bf16* ZHT, const float* cw, const float* cb, int ch, int b, int t) {
    const bf16* zp = ZHT + (size_t)ch * MTOK + b * SEQ;
    const float z0 = t > 0 ? bf1(zp[t - 1]) : 0.f, z1 = bf1(zp[t]), z2 = t < SEQ - 1 ? bf1(zp[t + 1]) : 0.f;
    return cw[ch] * z0 + cw[3072 + ch] * z1 + cw[6144 + ch] * z2 + cb[ch];
}
__device__ __forceinline__ void p3_hyena(Frame& F) {
    LAS float* Us = (LAS float*)F.lds;
    LAS float* KF = (LAS float*)(F.lds + 65536);
    const bf16* ZHT = (const bf16*)(F.ws + WS_ZHT); const float* FILT = (const float*)(F.ws + WS_FILT); bf16* AB = (bf16*)(F.ws + WS_H);
    const float* cw = F.in[I_HCW]; const float* cb = F.in[I_HCB]; const float* skip = F.in[I_HSKIP];
    const int tid = F.tid;
    for (int item = blockIdx.x; item < HYW; item += F.G) {
        const int c = item;
        for (int i = tid; i < NBATCH * SEQ; i += NWAVES * 64) { const int b = i >> 11, t = i & 2047; Us[t * 8 + b] = sconv(ZHT, cw, cb, c, b, t); }
        for (int n = 0; n < 2; ++n) {
            const float* hf = FILT + (size_t)((0 * 2 + n) * 1024 + c) * SEQ; const float* hb = FILT + (size_t)((1 * 2 + n) * 1024 + c) * SEQ;
            for (int i = tid; i < 4095; i += NWAVES * 64) { const int lag = i - 2047; KF[i] = lag > 0 ? hf[lag] : (lag == 0 ? hf[0] + hb[0] : hb[-lag]); }
            __syncthreads();
            f32x4 acc[4][2];
#pragma unroll
            for (int ti = 0; ti < 4; ++ti) { acc[ti][0] = (f32x4){0.f, 0.f, 0.f, 0.f}; acc[ti][1] = (f32x4){0.f, 0.f, 0.f, 0.f}; }
            const LAS float* kp = KF + tid + 2047;
            for (int s = 0; s < SEQ; ++s) {
                const f32x4 u0 = *(const LAS f32x4*)(Us + s * 8), u1 = *(const LAS f32x4*)(Us + s * 8 + 4);
#pragma unroll
                for (int ti = 0; ti < 4; ++ti) { const float kv = kp[512 * ti - s]; acc[ti][0] += u0 * kv; acc[ti][1] += u1 * kv; }
            }
            __syncthreads();
            const float sk = skip[n * 1024 + c];
#pragma unroll
            for (int ti = 0; ti < 4; ++ti) { const int t = tid + 512 * ti;
#pragma unroll
                for (int b = 0; b < 8; ++b) {
                    const float uv = Us[t * 8 + b], gate = sconv(ZHT, cw, cb, (n + 1) * 1024 + c, b, t);
                    const float y = gate * (acc[ti][b >> 2][b & 3] + sk * uv);
                    if (n == 0) Us[t * 8 + b] = y; else AB[(size_t)(b * SEQ + t) * DM + 1024 + c] = (bf16)f2bf(y);
                } }
            __syncthreads();
        }
    }
}

template <bool FINAL> __device__ __forceinline__ void ln_rows(Frame& F) {
    float* R = F.out; const float* st = (const float*)(F.ws + (FINAL ? WS_ST2 : WS_ST1)); float* MU = (float*)(F.ws + WS_MU1);
    const float* mod = (const float*)(F.ws + WS_MOD); bf16* H2 = (bf16*)(F.ws + WS_H);
    const float* lng = F.in[FINAL ? I_LN2G : I_LN1G]; const float* lnb = F.in[FINAL ? I_LN2B : I_LN1B];
    const int gw = blockIdx.x * NWAVES + F.wave, NGW = F.G * NWAVES, lane = F.lane;
    for (int row = gw; row < MTOK; row += NGW) {
        float s = 0.f, q = 0.f; if (lane < 32) { const f32x2 p = *(const f32x2*)(st + ((size_t)row * 32 + lane) * 2); s = p.x; q = p.y; }
        s = wave_sum(s); q = wave_sum(q);
        const float mean = s * (1.0f / DM); float var = q * (1.0f / DM) - mean * mean; var = var > 0.f ? var : 0.f; const float rstd = 1.0f / sqrtf(var + LN_EPS);
        if (!FINAL && lane == 0) *(f32x2*)(MU + (size_t)row * 2) = (f32x2){mean, rstd};
        const int b = row >> 11; float* rp = R + (size_t)row * DM;
#pragma unroll
        for (int j = 0; j < 8; ++j) { const int col = 4 * lane + 256 * j;
            const f32x4 v = *(const f32x4*)(rp + col); const f32x4 y = (v - mean) * rstd * *(const f32x4*)(lng + col) + *(const f32x4*)(lnb + col);
            if (FINAL) *(f32x4*)(rp + col) = y;
            else { const float* mp = mod + (size_t)b * MODW + col; const f32x4 h = y * (*(const f32x4*)(mp + 4 * DM) + 1.0f) + *(const f32x4*)(mp + 3 * DM);
                   v2u o; o.x = pk2(h[0], h[1]); o.y = pk2(h[2], h[3]); *(v2u*)(H2 + (size_t)row * DM + col) = o; } }
    }
}

#define GRID_SYNC() do { __builtin_amdgcn_fence(__ATOMIC_RELEASE, "agent"); cg::this_grid().sync(); __builtin_amdgcn_fence(__ATOMIC_ACQUIRE, "agent"); asm volatile("s_waitcnt vmcnt(0)" ::: "memory"); __syncthreads(); } while (0)

__global__ void __launch_bounds__(NWAVES * 64, 2) fwd_megakernel(Args args) {
    extern __shared__ __attribute__((aligned(16))) unsigned char lds[];
    Frame F;
    F.lds = (LAS unsigned char*)lds;
    F.tid = threadIdx.x; F.lane = F.tid & 63; F.wave = __builtin_amdgcn_readfirstlane(F.tid >> 6); F.G = gridDim.x;
    F.in = args.in; F.out = args.out; F.ws = args.ws;
    unsigned char* ws = args.ws;
    const int lo = args.ph_lo, hi = args.ph_hi;
#define IN(k) (lo <= (k) && (k) < hi)
#define BOTH(k) (IN(k) && IN((k) + 1))
    const int gw = blockIdx.x * NWAVES + F.wave, NGW = F.G * NWAVES;

    if (IN(0)) {
        p0_mod(F);
        transpose_matrix(F, F.in[I_WIN], DM, INW, (bf16*)(ws + WS_WIN), DM, 0, 1, gw, NGW);
        transpose_matrix(F, F.in[I_WA], SGUW, DM, (bf16*)(ws + WS_WAB), DM, 0, 0, gw, NGW);
        transpose_matrix(F, F.in[I_WB], HYW, DM, (bf16*)(ws + WS_WAB), DM, 1024, 0, gw, NGW);
        transpose_matrix(F, F.in[I_WO], DM, DM, (bf16*)(ws + WS_WO), DM, 0, 0, gw, NGW);
        __syncthreads();
        p0_filter(F);
        if (BOTH(0)) GRID_SYNC();
    }
    if (IN(1)) { p1_modulate(F); if (BOTH(1)) GRID_SYNC(); }
    if (IN(2)) {
        { pg8::Gemm g{(const pg8::bf16_t*)(ws + WS_H), (const pg8::bf16_t*)(ws + WS_WIN), MTOK, 6144, DM}; pg8::StaticOrder S; S.init(MTOK, 6144, F.G, (int)blockIdx.x);
          pg8::EpiG1 E{(pg8::bf16_t*)(ws + WS_U), (pg8::bf16_t*)(ws + WS_V), (pg8::bf16_t*)(ws + WS_G), F.in[I_BIN], (float*)(ws + WS_STV)};
          pg8::gemm_phase<pg8::EpiG1, pg8::StaticOrder, true, true>(F.lds, g, S, E); }
        __syncthreads();
        { pg8::Gemm g{(const pg8::bf16_t*)(ws + WS_WIN) + (size_t)6144 * DM, (const pg8::bf16_t*)(ws + WS_H), 3072, MTOK, DM}; pg8::StaticOrder S; S.init(3072, MTOK, F.G, (int)blockIdx.x);
          pg8::EpiG1T E{(pg8::bf16_t*)(ws + WS_ZHT), F.in[I_BIN]};
          pg8::gemm_phase<pg8::EpiG1T, pg8::StaticOrder, true, true>(F.lds, g, S, E); }
        if (BOTH(2)) GRID_SYNC();
    }
    if (IN(3)) { __syncthreads(); p3_sgu(F); p3_hyena(F); if (BOTH(3)) GRID_SYNC(); }
    if (IN(4)) {
        pg8::Gemm g{(const pg8::bf16_t*)(ws + WS_H), (const pg8::bf16_t*)(ws + WS_WAB), MTOK, DM, DM}; pg8::StaticOrder S; S.init(MTOK, DM, F.G, (int)blockIdx.x);
        pg8::EpiG2 E{(const pg8::bf16_t*)(ws + WS_G), (pg8::bf16_t*)(ws + WS_MERGED)};
        pg8::gemm_phase<pg8::EpiG2, pg8::StaticOrder, true, true>(F.lds, g, S, E);
        if (BOTH(4)) GRID_SYNC();
    }
    if (IN(5)) {
        pg8::Gemm g{(const pg8::bf16_t*)(ws + WS_MERGED), (const pg8::bf16_t*)(ws + WS_WO), MTOK, DM, DM}; pg8::StaticOrder S; S.init(MTOK, DM, F.G, (int)blockIdx.x);
        pg8::EpiRes<true> E{F.in[I_X], F.out, (const float*)(ws + WS_MOD) + 2 * DM, F.in[I_BO], nullptr, nullptr, nullptr, (float*)(ws + WS_ST1)};
        pg8::gemm_phase<pg8::EpiRes<true>, pg8::StaticOrder, true, true>(F.lds, g, S, E);
        if (BOTH(5)) GRID_SYNC();
    }
    if (IN(6)) {
        __syncthreads();
        ln_rows<false>(F);
        transpose_matrix(F, F.in[I_WM1], DM, DFF, (bf16*)(ws + WS_WM1), DM, 0, 0, gw, NGW);
        transpose_matrix(F, F.in[I_WM2], DFF, DM, (bf16*)(ws + WS_WM2), DFF, 0, 0, gw, NGW);
        if (BOTH(6)) GRID_SYNC();
    }
    if (IN(7)) {
        __syncthreads();
        pg8::Gemm g{(const pg8::bf16_t*)(ws + WS_H), (const pg8::bf16_t*)(ws + WS_WM1), MTOK, DFF, DM}; pg8::StaticOrder S; S.init(MTOK, DFF, F.G, (int)blockIdx.x);
        pg8::EpiG4 E{(pg8::bf16_t*)(ws + WS_AFF), F.in[I_BM1]};
        pg8::gemm_phase<pg8::EpiG4, pg8::StaticOrder, true, true>(F.lds, g, S, E);
        if (BOTH(7)) GRID_SYNC();
    }
    if (IN(8)) {
        pg8::Gemm g{(const pg8::bf16_t*)(ws + WS_AFF), (const pg8::bf16_t*)(ws + WS_WM2), MTOK, DM, DFF}; pg8::StaticOrder S; S.init(MTOK, DM, F.G, (int)blockIdx.x);
        pg8::EpiRes<false> E{nullptr, F.out, (const float*)(ws + WS_MOD) + 5 * DM, F.in[I_BM2], F.in[I_LN1G], F.in[I_LN1B], (const float*)(ws + WS_MU1), (float*)(ws + WS_ST2)};
        pg8::gemm_phase<pg8::EpiRes<false>, pg8::StaticOrder, true, true>(F.lds, g, S, E);
        if (BOTH(8)) GRID_SYNC();
    }
    if (IN(9)) { ln_rows<true>(F); }
#undef IN
#undef BOTH
}

constexpr int N_PHASES = 10;
#ifndef MK_N_LAUNCHES
#define MK_N_LAUNCHES 1
#endif
extern "C" void kernel_launch(void* const* d_in, const int* in_sizes, int n_in, void* d_out, int out_size, void* d_ws, size_t ws_size, hipStream_t stream) {
    static int grid = 0;
    if (grid == 0) {
        if (n_in != 31 || in_sizes[0] != MTOK * DM || out_size != MTOK * DM || ws_size < WS_END) {
            fprintf(stderr, "kernel_launch: unexpected problem: n_in %d in0 %d out %d ws %zu (need %zu)\n", n_in, n_in > 0 ? in_sizes[0] : -1, out_size, ws_size, (size_t)WS_END); grid = -1; return; }
        int dev = 0, cus = 0, per_cu = 0;
        if (hipGetDevice(&dev) != hipSuccess || hipDeviceGetAttribute(&cus, hipDeviceAttributeMultiprocessorCount, dev) != hipSuccess) { grid = -1; return; }
        if (hipFuncSetAttribute((const void*)fwd_megakernel, hipFuncAttributeMaxDynamicSharedMemorySize, LDS_BYTES) != hipSuccess) { fprintf(stderr, "kernel_launch: hipFuncSetAttribute failed\n"); grid = -1; return; }
        if (hipOccupancyMaxActiveBlocksPerMultiprocessor(&per_cu, (const void*)fwd_megakernel, NWAVES * 64, LDS_BYTES) != hipSuccess || per_cu < 1) { fprintf(stderr, "kernel_launch: occupancy query says %d\n", per_cu); per_cu = 1; }
        (void)hipGetLastError();
        grid = cus;
    }
    if (grid < 0) return;
    Args a{};
    for (int i = 0; i < 31; ++i) a.in[i] = (const float*)d_in[i];
    a.out = (float*)d_out; a.ws = (unsigned char*)d_ws;
    if (MK_N_LAUNCHES == 1) {
        a.ph_lo = 0; a.ph_hi = N_PHASES;
        void* kargs[] = {&a};
        hipError_t e = hipLaunchCooperativeKernel((const void*)fwd_megakernel, dim3(grid), dim3(NWAVES * 64), kargs, LDS_BYTES, stream);
        if (e != hipSuccess) fprintf(stderr, "kernel_launch: cooperative launch failed: %s (grid %d)\n", hipGetErrorString(e), grid);
    } else {
        for (int p = 0; p < N_PHASES; ++p) { a.ph_lo = p; a.ph_hi = p + 1; hipLaunchKernelGGL(fwd_megakernel, dim3(grid), dim3(NWAVES * 64), LDS_BYTES, stream, a); }
    }
}
```

```cpp
#include <hip/hip_runtime.h>
#include <cstdio>
#include <cstdint>

namespace pg8 {
#define PG8_LAS __attribute__((address_space(3)))
typedef unsigned short bf16_t;
typedef short bf16x8 __attribute__((ext_vector_type(8)));
typedef float f32x4 __attribute__((ext_vector_type(4)));
typedef unsigned u32x4 __attribute__((ext_vector_type(4)));
typedef float f32x2 __attribute__((ext_vector_type(2)));
constexpr int BM = 256, BK = 64, HALF = 128, HTB = HALF * BK * 2  , STAGE_BYTES = 8 * HTB, NXCD = 8, WGM = 8;

__host__ __device__ __forceinline__ int lds_byte(int r, int c) { const int st = (r >> 4) * 2 + (c >> 5), rr = r & 15, cc = c & 31, ob = rr * 64 + cc * 2; return st * 1024 + (ob ^ (((ob >> 9) & 1) << 5)); }
__host__ __device__ __forceinline__ void stage_rc(int b, int& R, int& C) { const int st = b / 1024, sb = b % 1024, swz = sb ^ (((sb >> 9) & 1) << 5); R = (st >> 1) * 16 + swz / 64; C = (st & 1) * 32 + (swz % 64) / 2; }
__host__ __device__ __forceinline__ int perm32(int rho) { const int n = rho >> 4, i = rho & 15; return 8 * (i >> 2) + 4 * n + (i & 3); }

struct Unit { int pm, pn; };
struct Gemm { const bf16_t* A; const bf16_t* Bt; int M, N, K; };

struct StaticOrder {
    int nM, nN, nwg, G, c;
    __host__ __device__ void init(int M, int N, int G_, int c_) { nM = M / BM; nN = N / BM; nwg = nM * nN; G = G_; c = c_; }
    __host__ __device__ bool next(int i, Unit& u) const {
        const long L = (long)i * G + c; if (L >= nwg) return false;
        int wgid = (int)L; { const int q = nwg / NXCD, r = nwg % NXCD, xcd = wgid % NXCD, off = wgid / NXCD; wgid = (xcd < r ? xcd * (q + 1) : r * (q + 1) + (xcd - r) * q) + off; }
        const int nig = WGM * nN, gid = wgid / nig, fm = gid * WGM, gsz = (nM - fm) < WGM ? (nM - fm) : WGM;
        u.pm = fm + ((wgid % nig) % gsz); u.pn = (wgid % nig) / gsz; return true;
    }
    __device__ __forceinline__ void a_ready(const Unit&) const {}
    __device__ __forceinline__ void done(const Unit&) const {}
};

__device__ __forceinline__ unsigned cvt_pk_bf16(float lo, float hi) { unsigned r; asm volatile("v_cvt_pk_bf16_f32 %0, %1, %2" : "=v"(r) : "v"(lo), "v"(hi)); return r; }
__device__ __forceinline__ f32x2 gelu_pk(f32x2 v) {
    const f32x2 av = __builtin_elementwise_abs(v), d = av * 0.2316418882f + 1.0f;
    f32x2 t; t.x = __builtin_amdgcn_rcpf(d.x); t.y = __builtin_amdgcn_rcpf(d.y);
    f32x2 q = t * 0.5307027145f + (-0.7265760135f); q = q * t + 0.7107068705f; q = q * t + (-0.142248368f); q = q * t + 0.127414796f; q = q * t;
    const f32x2 s = (v * v) * (-0.72134752044f);
    f32x2 e; e.x = __builtin_amdgcn_exp2f(s.x); e.y = __builtin_amdgcn_exp2f(s.y);
    const f32x2 m = v * (q * e), r = v - m;
    f32x2 o; o.x = v.x < 0.f ? m.x : r.x; o.y = v.y < 0.f ? m.y : r.y; return o;
}
__device__ __forceinline__ float bf_lo(unsigned w) { return __uint_as_float(w << 16); }
__device__ __forceinline__ float bf_hi(unsigned w) { return __uint_as_float(w & 0xffff0000u); }
__device__ __forceinline__ float sigmoid_f(float x) { return __builtin_amdgcn_rcpf(1.0f + __expf(-x)); }
}

constexpr int DM = 2048, NBATCH = 8, SEQ = 2048, MTOK = NBATCH * SEQ;
constexpr int SGUW = 1024, HYW = 1024, DFF = 8192, INW = 9216, MODW = 6 * DM;
constexpr float LN_EPS = 1e-5f;
constexpr float DN_ALPHA = 1.189207115002721f;

namespace pg8 {

struct EpiG1 {
    static constexpr bool PERM = true, AFTER_DRAIN = false, MID = false;
    bf16_t* U; bf16_t* V; bf16_t* G; const float* b_in; float* statsV;
    __device__ __forceinline__ void mid(f32x4 (&)[2][2][4][2], const Unit&, int, int, int, int) const {}
    __device__ __forceinline__ void operator()(const f32x4 (&acc)[2][2][4][2], const Unit& u, int wr, int wc, int fr, int fq) const {
        const int row0 = u.pm * BM + wr * 64 + fr; const int pn = u.pn;
        int kind, ldc, colt, bcol; bf16_t* base;
        if (pn < 4) { kind = 0; base = U; ldc = SGUW; colt = pn * 256; bcol = pn * 256; }
        else if (pn < 8) { kind = 1; base = V; ldc = SGUW; colt = (pn - 4) * 256; bcol = pn * 256; }
        else { kind = 2; base = G; ldc = 2 * DM; colt = (pn - 8) * 256; bcol = 5120 + (pn - 8) * 256; }
        const int cl = wc * 32 + 8 * fq;
        f32x4 bv[2][2];
#pragma unroll
        for (int bj = 0; bj < 2; ++bj)
#pragma unroll
            for (int n = 0; n < 2; ++n) bv[bj][n] = *(const f32x4*)(b_in + bcol + cl + bj * HALF + 4 * n);
#pragma unroll
        for (int ai = 0; ai < 2; ++ai)
#pragma unroll
            for (int m = 0; m < 4; ++m) {
                const int row = row0 + ai * HALF + m * 16;
                bf16_t* rowp = base + (size_t)row * ldc + colt + cl;
                float s = 0.f, q = 0.f;
#pragma unroll
                for (int bj = 0; bj < 2; ++bj) {
                    f32x4 v0 = acc[ai][bj][m][0] + bv[bj][0], v1 = acc[ai][bj][m][1] + bv[bj][1];
                    if (kind < 2) {
                        f32x2 a = gelu_pk((f32x2){v0[0], v0[1]}), b = gelu_pk((f32x2){v0[2], v0[3]}), c = gelu_pk((f32x2){v1[0], v1[1]}), d = gelu_pk((f32x2){v1[2], v1[3]});
                        v0 = (f32x4){a.x, a.y, b.x, b.y}; v1 = (f32x4){c.x, c.y, d.x, d.y};
                    } else {
                        v0 = (f32x4){sigmoid_f(v0[0]), sigmoid_f(v0[1]), sigmoid_f(v0[2]), sigmoid_f(v0[3])};
                        v1 = (f32x4){sigmoid_f(v1[0]), sigmoid_f(v1[1]), sigmoid_f(v1[2]), sigmoid_f(v1[3])};
                    }
                    u32x4 w; w.x = cvt_pk_bf16(v0[0], v0[1]); w.y = cvt_pk_bf16(v0[2], v0[3]); w.z = cvt_pk_bf16(v1[0], v1[1]); w.w = cvt_pk_bf16(v1[2], v1[3]);
                    *(u32x4*)(rowp + bj * HALF) = w;
                    if (kind == 1) {
                        const float e0 = bf_lo(w.x), e1 = bf_hi(w.x), e2 = bf_lo(w.y), e3 = bf_hi(w.y), e4 = bf_lo(w.z), e5 = bf_hi(w.z), e6 = bf_lo(w.w), e7 = bf_hi(w.w);
                        s += ((e0 + e1) + (e2 + e3)) + ((e4 + e5) + (e6 + e7));
                        q += ((e0 * e0 + e1 * e1) + (e2 * e2 + e3 * e3)) + ((e4 * e4 + e5 * e5) + (e6 * e6 + e7 * e7));
                    }
                }
                if (kind == 1) {
                    s += __shfl_xor(s, 16); s += __shfl_xor(s, 32); q += __shfl_xor(q, 16); q += __shfl_xor(q, 32);
                    if (fq == 0) *(f32x2*)(statsV + ((size_t)row * 16 + (pn - 4) * 4 + wc) * 2) = (f32x2){s, q};
                }
            }
    }
};

struct EpiG1T {
    static constexpr bool PERM = true, AFTER_DRAIN = false, MID = false;
    bf16_t* ZHT; const float* b_in;
    __device__ __forceinline__ void mid(f32x4 (&)[2][2][4][2], const Unit&, int, int, int, int) const {}
    __device__ __forceinline__ void operator()(const f32x4 (&acc)[2][2][4][2], const Unit& u, int wr, int wc, int fr, int fq) const {
        const int row0 = u.pm * BM + wr * 64 + fr; const int col0 = u.pn * BM + wc * 32 + 8 * fq;
#pragma unroll
        for (int ai = 0; ai < 2; ++ai)
#pragma unroll
            for (int m = 0; m < 4; ++m) {
                const int row = row0 + ai * HALF + m * 16; const float bb = b_in[2048 + row];
                bf16_t* rowp = ZHT + (size_t)row * MTOK + col0;
#pragma unroll
                for (int bj = 0; bj < 2; ++bj) {
                    const f32x4 v0 = acc[ai][bj][m][0] + bb, v1 = acc[ai][bj][m][1] + bb;
                    u32x4 w; w.x = cvt_pk_bf16(v0[0], v0[1]); w.y = cvt_pk_bf16(v0[2], v0[3]); w.z = cvt_pk_bf16(v1[0], v1[1]); w.w = cvt_pk_bf16(v1[2], v1[3]);
                    *(u32x4*)(rowp + bj * HALF) = w;
                }
            }
    }
};

struct EpiG2 {
    static constexpr bool PERM = true, AFTER_DRAIN = false, MID = true;
    const bf16_t* G; bf16_t* O;
    __device__ __forceinline__ void mid(f32x4 (&acc)[2][2][4][2], const Unit& u, int wr, int wc, int fr, int fq) const {
        int row0 = u.pm * BM + wr * 64 + fr, col0 = u.pn * BM + wc * 32 + 8 * fq;
        asm volatile("" : "+v"(row0), "+v"(col0));
#pragma unroll
        for (int ai = 0; ai < 2; ++ai)
#pragma unroll
            for (int m = 0; m < 4; ++m) {
                const bf16_t* gp = G + (size_t)(row0 + ai * HALF + m * 16) * (2 * DM) + col0;
#pragma unroll
                for (int bj = 0; bj < 2; ++bj) {
                    const u32x4 ga = *(const u32x4*)(gp + bj * HALF), gb = *(const u32x4*)(gp + DM + bj * HALF);
                    f32x4 r0, r1;
                    r0[0] = bf_lo(ga.x) * __builtin_amdgcn_rcpf(bf_lo(gb.x)); r0[1] = bf_hi(ga.x) * __builtin_amdgcn_rcpf(bf_hi(gb.x));
                    r0[2] = bf_lo(ga.y) * __builtin_amdgcn_rcpf(bf_lo(gb.y)); r0[3] = bf_hi(ga.y) * __builtin_amdgcn_rcpf(bf_hi(gb.y));
                    r1[0] = bf_lo(ga.z) * __builtin_amdgcn_rcpf(bf_lo(gb.z)); r1[1] = bf_hi(ga.z) * __builtin_amdgcn_rcpf(bf_hi(gb.z));
                    r1[2] = bf_lo(ga.w) * __builtin_amdgcn_rcpf(bf_lo(gb.w)); r1[3] = bf_hi(ga.w) * __builtin_amdgcn_rcpf(bf_hi(gb.w));
                    acc[ai][bj][m][0] *= r0; acc[ai][bj][m][1] *= r1;
                }
            }
    }
    __device__ __forceinline__ void operator()(const f32x4 (&acc)[2][2][4][2], const Unit& u, int wr, int wc, int fr, int fq) const {
        const int row0 = u.pm * BM + wr * 64 + fr, col0 = u.pn * BM + wc * 32 + 8 * fq;
#pragma unroll
        for (int ai = 0; ai < 2; ++ai)
#pragma unroll
            for (int m = 0; m < 4; ++m) {
                const int row = row0 + ai * HALF + m * 16;
                const bf16_t* gp = G + (size_t)row * (2 * DM) + DM + col0;
                bf16_t* op = O + (size_t)row * DM + col0;
#pragma unroll
                for (int bj = 0; bj < 2; ++bj) {
                    const u32x4 gb = *(const u32x4*)(gp + bj * HALF);
                    const f32x4 a0 = acc[ai][bj][m][0], a1 = acc[ai][bj][m][1];
                    u32x4 w; w.x = cvt_pk_bf16(a0[0] * bf_lo(gb.x), a0[1] * bf_hi(gb.x)); w.y = cvt_pk_bf16(a0[2] * bf_lo(gb.y), a0[3] * bf_hi(gb.y));
                    w.z = cvt_pk_bf16(a1[0] * bf_lo(gb.z), a1[1] * bf_hi(gb.z)); w.w = cvt_pk_bf16(a1[2] * bf_lo(gb.w), a1[3] * bf_hi(gb.w));
                    *(u32x4*)(op + bj * HALF) = w;
                }
            }
    }
};

template <bool FIRST> struct EpiRes {
    static constexpr bool PERM = false, AFTER_DRAIN = false, MID = false;
    const float* X;
    float* R;
    const float* gate;
    const float* bias;
    const float* lng; const float* lnb; const float* MU;
    float* stats;
    __device__ __forceinline__ void mid(f32x4 (&)[2][2][4][2], const Unit&, int, int, int, int) const {}
    __device__ __forceinline__ void operator()(const f32x4 (&acc)[2][2][4][2], const Unit& u, int wr, int wc, int fr, int fq) const {
        int row0 = u.pm * BM + wr * 64 + fr, col0 = u.pn * BM + wc * 32 + 4 * fq; const int b = u.pm >> 3;
        asm volatile("" : "+v"(row0), "+v"(col0));
        const float* gp = gate + (size_t)b * MODW + col0; const float* bp = bias + col0;
#pragma unroll
        for (int ai = 0; ai < 2; ++ai)
#pragma unroll
            for (int m = 0; m < 4; ++m) {
                const int row = row0 + ai * HALF + m * 16;
                float s = 0.f, q = 0.f; f32x2 mr = (f32x2){0.f, 1.f};
                if (!FIRST) mr = *(const f32x2*)(MU + (size_t)row * 2);
                float* rp = R + (size_t)row * DM + col0; const float* xp = X + (size_t)row * DM + col0;
#pragma unroll
                for (int bj = 0; bj < 2; ++bj)
#pragma unroll
                    for (int n = 0; n < 2; ++n) {
                        const int co = bj * HALF + n * 16;
                        const f32x4 gv = *(const f32x4*)(gp + co), bv = *(const f32x4*)(bp + co);
                        f32x4 base;
                        if (FIRST) base = *(const f32x4*)(xp + co);
                        else { const f32x4 rv = *(const f32x4*)(rp + co); base = (rv - mr.x) * mr.y * *(const f32x4*)(lng + col0 + co) + *(const f32x4*)(lnb + col0 + co); }
                        const f32x4 o = base * DN_ALPHA + gv * (acc[ai][bj][m][n] + bv);
                        *(f32x4*)(rp + co) = o;
                        s += (o[0] + o[1]) + (o[2] + o[3]); q += (o[0] * o[0] + o[1] * o[1]) + (o[2] * o[2] + o[3] * o[3]);
                    }
                s += __shfl_xor(s, 16); s += __shfl_xor(s, 32); q += __shfl_xor(q, 16); q += __shfl_xor(q, 32);
                if (fq == 0) *(f32x2*)(stats + ((size_t)row * 32 + u.pn * 4 + wc) * 2) = (f32x2){s, q};
                asm volatile("" ::: "memory");
            }
    }
};

struct EpiG4 {
    static constexpr bool PERM = true, AFTER_DRAIN = false, MID = false;
    bf16_t* O; const float* bias;
    __device__ __forceinline__ void mid(f32x4 (&)[2][2][4][2], const Unit&, int, int, int, int) const {}
    __device__ __forceinline__ void operator()(const f32x4 (&acc)[2][2][4][2], const Unit& u, int wr, int wc, int fr, int fq) const {
        const int row0 = u.pm * BM + wr * 64 + fr, col0 = u.pn * BM + wc * 32 + 8 * fq;
        f32x4 bv[2][2];
#pragma unroll
        for (int bj = 0; bj < 2; ++bj)
#pragma unroll
            for (int n = 0; n < 2; ++n) bv[bj][n] = *(const f32x4*)(bias + col0 + bj * HALF + 4 * n);
#pragma unroll
        for (int ai = 0; ai < 2; ++ai)
#pragma unroll
            for (int m = 0; m < 4; ++m) {
                bf16_t* rowp = O + (size_t)(row0 + ai * HALF + m * 16) * DFF + col0;
#pragma unroll
                for (int bj = 0; bj < 2; ++bj) {
                    f32x4 v0 = acc[ai][bj][m][0] + bv[bj][0], v1 = acc[ai][bj][m][1] + bv[bj][1];
                    v0 = __builtin_elementwise_max(v0, (f32x4){0.f, 0.f, 0.f, 0.f}); v1 = __builtin_elementwise_max(v1, (f32x4){0.f, 0.f, 0.f, 0.f});
                    v0 = v0 * v0; v1 = v1 * v1;
                    u32x4 w; w.x = cvt_pk_bf16(v0[0], v0[1]); w.y = cvt_pk_bf16(v0[2], v0[3]); w.z = cvt_pk_bf16(v1[0], v1[1]); w.w = cvt_pk_bf16(v1[2], v1[3]);
                    *(u32x4*)(rowp + bj * HALF) = w;
                }
            }
    }
};
}
namespace pg8 {
template <class Epi, class Sched, bool ALIGN_EPI = false, bool SP2 = false>
__device__ __forceinline__ void gemm_phase(PG8_LAS unsigned char* lds, const Gemm g, const Sched& S, const Epi& E) {
    const int tid = threadIdx.x, wid = __builtin_amdgcn_readfirstlane(tid >> 6), lane = tid & 63, wr = wid >> 2, wc = wid & 3, fr = lane & 15, fq = lane >> 4;
    const int K = g.K, nt = K / BK;
    unsigned voffA[2], voffB[2];
#pragma unroll
    for (int i = 0; i < 2; ++i) { int R, C; stage_rc(tid * 16 + i * 8192, R, C); const int Rb = Epi::PERM ? ((R & ~31) + perm32(R & 31)) : R;
        voffA[i] = (unsigned)(R * K + C) * 2u; voffB[i] = (unsigned)(Rb * K + C) * 2u; }
    const size_t kstep = (size_t)(BK * 2);
    const size_t hstep = (size_t)HALF * K * 2;
    const size_t tstep = 2 * hstep;
    const unsigned ldsw = (unsigned)wid * 1024u;
    const int aoff = lds_byte(wr * 64 + fr, fq * 8), boff = lds_byte(wc * 32 + fr, fq * 8);
#define PG8_SA(b, h) (((b) * 2 + (h)) * HTB)
#define PG8_SB(b, h) ((4 + (b) * 2 + (h)) * HTB)
#define PG8_STAGE(bufoff, gbase, voff) do { _Pragma("unroll") for (int _i = 0; _i < 2; ++_i) \
        __builtin_amdgcn_global_load_lds((const unsigned*)((const char*)(gbase) + (voff)[_i]), (PG8_LAS unsigned*)(lds + (bufoff) + ldsw + _i * 8192), 16, 0, 0); } while (0)
#define PG8_LDA(dst, b, h) do { _Pragma("unroll") for (int m = 0; m < 4; ++m) _Pragma("unroll") for (int k = 0; k < 2; ++k) dst[m][k] = *(const PG8_LAS bf16x8*)(lds + PG8_SA(b, h) + aoff + m * 2048 + k * 1024); } while (0)
#define PG8_LDB(dst, b, h) do { _Pragma("unroll") for (int n = 0; n < 2; ++n) _Pragma("unroll") for (int k = 0; k < 2; ++k) dst[n][k] = *(const PG8_LAS bf16x8*)(lds + PG8_SB(b, h) + boff + n * 2048 + k * 1024); } while (0)
#define PG8_MMA(ai, bj, At, Bt) do { __builtin_amdgcn_s_setprio(1); _Pragma("unroll") for (int m = 0; m < 4; ++m) _Pragma("unroll") for (int n = 0; n < 2; ++n) _Pragma("unroll") for (int k = 0; k < 2; ++k) \
        acc[ai][bj][m][n] = __builtin_amdgcn_mfma_f32_16x16x32_bf16(Bt[n][k], At[m][k], acc[ai][bj][m][n], 0, 0, 0); __builtin_amdgcn_s_setprio(0); } while (0)
#define PG8_WAIT_V(n) asm volatile("s_waitcnt vmcnt(" #n ")" ::: "memory")
#define PG8_WAIT_L(n) asm volatile("s_waitcnt lgkmcnt(" #n ")" ::: "memory")
#define PG8_BAR __builtin_amdgcn_s_barrier()
#define PG8_SCHED __builtin_amdgcn_sched_barrier(0)
    Unit cur, nxt; int ui = 0;
    if (!S.next(0, cur)) return;
    f32x4 acc[2][2][4][2];
#pragma unroll
    for (int a = 0; a < 2; ++a)
#pragma unroll
        for (int b = 0; b < 2; ++b)
#pragma unroll
            for (int m = 0; m < 4; ++m)
#pragma unroll
                for (int n = 0; n < 2; ++n) acc[a][b][m][n] = (f32x4){0.f, 0.f, 0.f, 0.f};
    bf16x8 At[4][2], B0[2][2], B1[2][2];
    const char* cA = (const char*)g.A + (size_t)cur.pm * tstep; const char* cB = (const char*)g.Bt + (size_t)cur.pn * tstep;
    S.a_ready(cur);
    if constexpr (SP2) {
        PG8_STAGE(PG8_SB(0, 0), cB, voffB); PG8_STAGE(PG8_SB(0, 1), cB + hstep, voffB); PG8_STAGE(PG8_SA(0, 0), cA, voffA); PG8_STAGE(PG8_SA(0, 1), cA + hstep, voffA);
        if (wr == 1) PG8_BAR;
        PG8_WAIT_V(2); PG8_BAR;
        PG8_STAGE(PG8_SB(1, 0), cB + kstep, voffB); PG8_STAGE(PG8_SA(1, 0), cA + kstep, voffA); PG8_STAGE(PG8_SB(1, 1), cB + hstep + kstep, voffB);
        PG8_WAIT_V(6); PG8_BAR;
    } else {
        PG8_STAGE(PG8_SB(0, 0), cB, voffB); PG8_STAGE(PG8_SA(0, 0), cA, voffA); PG8_STAGE(PG8_SB(0, 1), cB + hstep, voffB); PG8_STAGE(PG8_SA(0, 1), cA + hstep, voffA);
        if (wr == 1) PG8_BAR;
        PG8_WAIT_V(4); PG8_BAR;
        PG8_STAGE(PG8_SB(1, 0), cB + kstep, voffB); PG8_STAGE(PG8_SA(1, 0), cA + kstep, voffA); PG8_STAGE(PG8_SB(1, 1), cB + hstep + kstep, voffB);
        PG8_WAIT_V(6); PG8_BAR;
    }
    for (;;) {
        const bool has_next = S.next(ui + 1, nxt);
        const char* nA = has_next ? (const char*)g.A + (size_t)nxt.pm * tstep : cA; const char* nB = has_next ? (const char*)g.Bt + (size_t)nxt.pn * tstep : cB;
        for (int t = 0; t < nt; t += 2) {
            const bool last = (t == nt - 2);
            const char* a1 = cA + (size_t)(t + 1) * kstep;
            const char* a2 = last ? nA : cA + (size_t)(t + 2) * kstep; const char* b2 = last ? nB : cB + (size_t)(t + 2) * kstep;
            const char* a3 = a2 + kstep; const char* b3 = b2 + kstep;
            if (last && has_next) S.a_ready(nxt);
            if constexpr (Epi::MID) { if (t == (nt >> 1)) E.mid(acc, cur, wr, wc, fr, fq); }
            if constexpr (SP2) {
            PG8_LDB(B0, 0, 0); PG8_LDB(B1, 0, 1); PG8_SCHED; PG8_LDA(At, 0, 0); PG8_STAGE(PG8_SA(1, 1), a1 + hstep, voffA);
            PG8_WAIT_V(8); PG8_WAIT_L(0); PG8_BAR; PG8_MMA(0, 0, At, B0); PG8_MMA(0, 1, At, B1); PG8_BAR; PG8_SCHED;
            PG8_LDA(At, 0, 1); PG8_STAGE(PG8_SB(0, 0), b2, voffB); PG8_STAGE(PG8_SB(0, 1), b2 + hstep, voffB); PG8_STAGE(PG8_SA(0, 0), a2, voffA);
            PG8_WAIT_V(8); PG8_WAIT_L(0); PG8_BAR; PG8_MMA(1, 0, At, B0); PG8_MMA(1, 1, At, B1); PG8_BAR; PG8_SCHED;
            PG8_LDB(B0, 1, 0); PG8_LDB(B1, 1, 1); PG8_SCHED; PG8_LDA(At, 1, 0); PG8_STAGE(PG8_SA(0, 1), a2 + hstep, voffA);
            PG8_WAIT_V(8); PG8_WAIT_L(0); PG8_BAR; PG8_MMA(0, 0, At, B0); PG8_MMA(0, 1, At, B1); PG8_BAR; PG8_SCHED;
            PG8_LDA(At, 1, 1); PG8_STAGE(PG8_SB(1, 0), b3, voffB); PG8_STAGE(PG8_SB(1, 1), b3 + hstep, voffB); PG8_STAGE(PG8_SA(1, 0), a3, voffA);
            PG8_WAIT_V(8); PG8_WAIT_L(0); PG8_BAR; PG8_MMA(1, 0, At, B0); PG8_MMA(1, 1, At, B1); PG8_BAR; PG8_SCHED;
            } else {
            PG8_LDB(B0, 0, 0); PG8_SCHED; PG8_LDA(At, 0, 0); PG8_STAGE(PG8_SA(1, 1), a1 + hstep, voffA);
            PG8_WAIT_L(8); PG8_BAR; PG8_WAIT_L(0); PG8_MMA(0, 0, At, B0); PG8_BAR; PG8_SCHED;
            PG8_LDB(B1, 0, 1); PG8_STAGE(PG8_SB(0, 0), b2, voffB);
            PG8_BAR; PG8_WAIT_L(0); PG8_MMA(0, 1, At, B1); PG8_BAR;
            PG8_LDA(At, 0, 1); PG8_STAGE(PG8_SA(0, 0), a2, voffA);
            PG8_BAR; PG8_WAIT_L(0); PG8_MMA(1, 0, At, B0); PG8_BAR; PG8_SCHED;
            PG8_STAGE(PG8_SB(0, 1), b2 + hstep, voffB);
            PG8_WAIT_V(6); PG8_BAR; PG8_MMA(1, 1, At, B1); PG8_BAR;
            PG8_LDB(B0, 1, 0); PG8_SCHED; PG8_LDA(At, 1, 0); PG8_STAGE(PG8_SA(0, 1), a2 + hstep, voffA);
            PG8_WAIT_L(8); PG8_BAR; PG8_WAIT_L(0); PG8_MMA(0, 0, At, B0); PG8_BAR; PG8_SCHED;
            PG8_LDB(B1, 1, 1); PG8_STAGE(PG8_SB(1, 0), b3, voffB);
            PG8_BAR; PG8_WAIT_L(0); PG8_MMA(0, 1, At, B1); PG8_BAR;
            PG8_LDA(At, 1, 1); PG8_STAGE(PG8_SA(1, 0), a3, voffA);
            PG8_BAR; PG8_WAIT_L(0); PG8_MMA(1, 0, At, B0); PG8_BAR; PG8_SCHED;
            PG8_STAGE(PG8_SB(1, 1), b3 + hstep, voffB);
            PG8_WAIT_V(6); PG8_BAR; PG8_MMA(1, 1, At, B1); PG8_BAR;
            }
        }
        if constexpr (ALIGN_EPI) { if (wr == 0) PG8_BAR; }
        if constexpr (!Epi::AFTER_DRAIN) { E(acc, cur, wr, wc, fr, fq); S.done(cur); }
        if (!has_next) break;
#pragma unroll
        for (int a = 0; a < 2; ++a)
#pragma unroll
            for (int b = 0; b < 2; ++b)
#pragma unroll
                for (int m = 0; m < 4; ++m)
#pragma unroll
                    for (int n = 0; n < 2; ++n) acc[a][b][m][n] = (f32x4){0.f, 0.f, 0.f, 0.f};
        cur = nxt; cA = nA; cB = nB; ++ui;
        if constexpr (ALIGN_EPI) { if (wr == 1) PG8_BAR; }
    }
    PG8_WAIT_V(0);
    if constexpr (!ALIGN_EPI) { if (wr == 0) PG8_BAR; }
    PG8_BAR;
    if constexpr (Epi::AFTER_DRAIN) { E.fused(acc, cur, wr, wc, fr, fq, lds, wid, lane); S.done(cur); }
#undef PG8_SA
#undef PG8_SB
#undef PG8_STAGE
#undef PG8_LDA
#undef PG8_LDB
#undef PG8_MMA
#undef PG8_WAIT_V
#undef PG8_WAIT_L
#undef PG8_BAR
#undef PG8_SCHED
}
}

constexpr size_t MiB = 1u << 20;
constexpr size_t WS_CTL = 0;
constexpr size_t WS_MOD = 1 * MiB;
constexpr size_t WS_STV = 2 * MiB;
constexpr size_t WS_ST1 = 4 * MiB;
constexpr size_t WS_ST2 = 8 * MiB;
constexpr size_t WS_MU1 = 12 * MiB;
constexpr size_t WS_WIN = 16 * MiB;
constexpr size_t WS_WAB = 52 * MiB;
constexpr size_t WS_WO = 60 * MiB;
constexpr size_t WS_FILT = 68 * MiB;
constexpr size_t WS_WM2 = 68 * MiB;
constexpr size_t WS_H = 100 * MiB;
constexpr size_t WS_U = 164 * MiB;
constexpr size_t WS_V = 196 * MiB;
constexpr size_t WS_MERGED = 164 * MiB;
constexpr size_t WS_ZHT = 228 * MiB;
constexpr size_t WS_G = 324 * MiB;
constexpr size_t WS_AFF = 164 * MiB;
constexpr size_t WS_WM1 = 420 * MiB;
constexpr size_t WS_END = 452 * MiB;

constexpr int NWAVES = 8;
constexpr int LDS_BYTES = 147456;

#define GAS __attribute__((address_space(1)))
#define LAS __attribute__((address_space(3)))
typedef unsigned short bf16;
typedef unsigned v4u __attribute__((ext_vector_type(4)));
typedef unsigned v2u __attribute__((ext_vector_type(2)));
typedef float f32x4 __attribute__((ext_vector_type(4)));
typedef float f32x2 __attribute__((ext_vector_type(2)));
#define LDS_WAIT() asm volatile("s_waitcnt lgkmcnt(0)" ::: "memory")

__device__ __forceinline__ unsigned f2bf(float f) { unsigned u = __builtin_bit_cast(unsigned, f); return (u + 0x7fffu + ((u >> 16) & 1u)) >> 16; }
__device__ __forceinline__ unsigned pk2(float lo, float hi) { return f2bf(lo) | (f2bf(hi) << 16); }
__device__ __forceinline__ float bflo(unsigned w) { return __uint_as_float(w << 16); }
__device__ __forceinline__ float bfhi(unsigned w) { return __uint_as_float(w & 0xffff0000u); }
__device__ __forceinline__ float bf1(bf16 h) { return __uint_as_float((unsigned)h << 16); }
__device__ __forceinline__ float wave_sum(float v) {
#pragma unroll
    for (int o = 1; o < 64; o <<= 1) v += __shfl_xor(v, o);
    return v;
}

struct Args { const float* in[31]; float* out; unsigned char* ws; int ph_lo, ph_hi; };

struct Frame {
    LAS unsigned char* lds;
    int tid, lane, wave, G;
    const float* const* in; float* out; unsigned char* ws;
};
enum { I_X = 0, I_C, I_WADA, I_BADA, I_WIN, I_BIN, I_SLNG, I_SLNB, I_SW, I_SB, I_HCW, I_HCB, I_HW1, I_HB1, I_HW2, I_HB2, I_HFREQ, I_HW3, I_HSKIP,
       I_WA, I_WB, I_WO, I_BO, I_LN1G, I_LN1B, I_WM1, I_BM1, I_WM2, I_BM2, I_LN2G, I_LN2B };

__device__ __forceinline__ void transpose_item(const float* W, int N, bf16* WT, int ldk, int koff, int n0, int row0, int k0, LAS float* scr, int lane) {
#pragma unroll 8
    for (int i = 0; i < 32; ++i) { const int kk = 2 * i + (lane >> 5); scr[kk * 33 + (lane & 31)] = W[(size_t)(k0 + kk) * N + n0 + (lane & 31)]; }
    LDS_WAIT(); asm volatile("" ::: "memory");
    const int c = lane & 7;
#pragma unroll
    for (int j = 0; j < 4; ++j) { const int n = (lane >> 3) + 8 * j; const LAS float* s = scr + (8 * c) * 33 + n;
        v4u o; o.x = pk2(s[0 * 33], s[1 * 33]); o.y = pk2(s[2 * 33], s[3 * 33]); o.z = pk2(s[4 * 33], s[5 * 33]); o.w = pk2(s[6 * 33], s[7 * 33]);
        *(GAS v4u*)(WT + (size_t)(row0 + n) * ldk + koff + k0 + 8 * c) = o; }
    LDS_WAIT(); asm volatile("" ::: "memory");
}
__device__ __forceinline__ void transpose_matrix(Frame& F, const float* W, int K, int N, bf16* WT, int ldk, int koff, int remap_win, int gw, int NGW) {
    LAS float* scr = (LAS float*)(F.lds + F.wave * 16384);
    const int nblk = N / 32, nitems = (K / 64) * nblk;
    for (int it = gw; it < nitems; it += NGW) {
        const int kb = it / nblk, nb = it % nblk, n0 = nb * 32; int row0 = n0;
        if (remap_win) row0 = (n0 < 2048) ? n0 : (n0 < 5120 ? n0 - 2048 + 6144 : n0 - 5120 + 2048);
        transpose_item(W, N, WT, ldk, koff, n0, row0, kb * 64, scr, F.lane);
    }
}

__device__ __forceinline__ void p0_mod(Frame& F) {
    LAS float* condS = (LAS float*)F.lds;
    LAS float* red = (LAS float*)(F.lds + 65536);
    const float* c = F.in[I_C]; const float* w_ada = F.in[I_WADA]; const float* b_ada = F.in[I_BADA];
    float* mod = (float*)(F.ws + WS_MOD);
    const int tid = F.tid;
    for (int item = blockIdx.x; item < MODW / 64; item += F.G) {
        for (int i = tid; i < NBATCH * DM; i += NWAVES * 64) { const float v = c[i]; condS[i] = v / (1.0f + __expf(-v)); }
        __syncthreads();
        const int cq = tid & 15, kq = tid >> 4, col0 = item * 64;
        f32x4 acc[8];
#pragma unroll
        for (int b = 0; b < 8; ++b) acc[b] = (f32x4){0.f, 0.f, 0.f, 0.f};
        const float* wp = w_ada + (size_t)kq * MODW + col0 + cq * 4;
        for (int k = kq; k < DM; k += 32, wp += (size_t)32 * MODW) {
            const f32x4 w = *(const f32x4*)wp;
#pragma unroll
            for (int b = 0; b < 8; ++b) acc[b] += w * condS[b * DM + k];
        }
#pragma unroll
        for (int b = 0; b < 8; ++b) *(LAS f32x4*)(red + (kq * 8 + b) * 64 + cq * 4) = acc[b];
        __syncthreads();
        { const int b = tid >> 6, col = tid & 63; float s = 0.f;
#pragma unroll 8
          for (int k2 = 0; k2 < 32; ++k2) s += red[(k2 * 8 + b) * 64 + col];
          mod[(size_t)b * MODW + col0 + col] = s + b_ada[col0 + col]; }
        __syncthreads();
    }
}

__device__ __forceinline__ void p0_filter(Frame& F) {
    LAS float* featS = (LAS float*)F.lds;
    LAS float* h1S = featS + 8 * 64;
    LAS float* h2S = h1S + 8 * 64;
    const float* w1 = F.in[I_HW1]; const float* b1 = F.in[I_HB1]; const float* w2 = F.in[I_HW2]; const float* b2 = F.in[I_HB2];
    const float* freq = F.in[I_HFREQ]; const float* w3 = F.in[I_HW3];
    float* FILT = (float*)(F.ws + WS_FILT);
    const int tid = F.tid, lane = F.lane, wave = F.wave;
    const float min_decay = -3.0701134573253943f, max_decay = -15.350567286626972f;
    for (int item = blockIdx.x; item < SEQ / 8; item += F.G) {
        const int l = item * 8 + wave;
        const float tl = (float)l / (float)(SEQ - 1), omega = 6.283185307179586f * (float)l / (float)SEQ;
        float f = 0.f;
        if (lane == 0) f = tl;
        else if (lane <= 16) { const float band = 1e-4f + (float)(lane - 1) * ((15.0f - 1e-4f) / 15.0f); f = cosf(band * omega); }
        else if (lane <= 32) { const float band = 1e-4f + (float)(lane - 17) * ((15.0f - 1e-4f) / 15.0f); f = -sinf(band * omega); }
        featS[wave * 64 + lane] = f;
        __syncthreads();
        float a = b1[lane];
        for (int i = 0; i < 33; ++i) a += featS[wave * 64 + i] * w1[i * 64 + lane];
        h1S[wave * 64 + lane] = sinf(freq[lane] * a);
        __syncthreads();
        a = b2[lane];
        for (int i = 0; i < 64; ++i) a += h1S[wave * 64 + i] * w2[i * 64 + lane];
        h2S[wave * 64 + lane] = sinf(freq[lane] * a);
        __syncthreads();
        for (int jj = 0; jj < 8; ++jj) {
            const int j = tid + 512 * jj;
            float acc[8];
#pragma unroll
            for (int p = 0; p < 8; ++p) acc[p] = 0.f;
            for (int i = 0; i < 64; ++i) { const float w = w3[(size_t)i * 4096 + j];
#pragma unroll
                for (int p = 0; p < 8; ++p) acc[p] += h2S[p * 64 + i] * w; }
            const int ch = j & 1023; const float delta = fabsf(min_decay + (float)ch * ((max_decay - min_decay) / 1023.0f));
#pragma unroll
            for (int p = 0; p < 8; ++p) { const float tp = (float)(item * 8 + p) / (float)(SEQ - 1); acc[p] *= expf(-tp * delta); }
            float* o = FILT + (size_t)j * SEQ + item * 8;
            *(f32x4*)o = (f32x4){acc[0], acc[1], acc[2], acc[3]}; *(f32x4*)(o + 4) = (f32x4){acc[4], acc[5], acc[6], acc[7]};
        }
        __syncthreads();
    }
}

__device__ __forceinline__ void p1_modulate(Frame& F) {
    const float* x = F.in[I_X]; const float* mod = (const float*)(F.ws + WS_MOD); bf16* H = (bf16*)(F.ws + WS_H);
    const size_t nvec = (size_t)MTOK * DM / 8, stride = (size_t)F.G * NWAVES * 64;
    for (size_t i = (size_t)blockIdx.x * (NWAVES * 64) + F.tid; i < nvec; i += stride) {
        const int row = (int)(i >> 8), col = (int)(i & 255) * 8, b = row >> 11;
        const f32x4 x0 = *(const f32x4*)(x + (size_t)row * DM + col), x1 = *(const f32x4*)(x + (size_t)row * DM + col + 4);
        const float* mp = mod + (size_t)b * MODW + col;
        const f32x4 sh0 = *(const f32x4*)mp, sh1 = *(const f32x4*)(mp + 4), sc0 = *(const f32x4*)(mp + DM), sc1 = *(const f32x4*)(mp + DM + 4);
        const f32x4 h0 = x0 * (sc0 + 1.0f) + sh0, h1 = x1 * (sc1 + 1.0f) + sh1;
        v4u o; o.x = pk2(h0[0], h0[1]); o.y = pk2(h0[2], h0[3]); o.z = pk2(h1[0], h1[1]); o.w = pk2(h1[2], h1[3]);
        *(v4u*)(H + (size_t)row * DM + col) = o;
    }
}

__device__ __forceinline__ void p3_sgu(Frame& F) {
    LAS float* vnS = (LAS float*)F.lds;
    LAS float* stS = (LAS float*)(F.lds + 65536);
    const bf16* U = (const bf16*)(F.ws + WS_U); const bf16* V = (const bf16*)(F.ws + WS_V); bf16* AB = (bf16*)(F.ws + WS_H);
    const float* stv = (const float*)(F.ws + WS_STV);
    const float* lng = F.in[I_SLNG]; const float* lnb = F.in[I_SLNB]; const float* sw = F.in[I_SW]; const float* sb = F.in[I_SB];
    const int tid = F.tid;
    for (int item = blockIdx.x; item < 1024; item += F.G) {
        const int b = item >> 7, n = (item >> 3) & 15, g = item & 7, tok0 = b * SEQ + n * 128;
        if (tid < 128) { float s = 0.f, q = 0.f; const float* sp = stv + (size_t)(tok0 + tid) * 32;
            for (int i = 0; i < 16; ++i) { s += sp[2 * i]; q += sp[2 * i + 1]; }
            const float mean = s * (1.0f / 1024.0f); float var = q * (1.0f / 1024.0f) - mean * mean; var = var > 0.f ? var : 0.f;
            stS[2 * tid] = mean; stS[2 * tid + 1] = 1.0f / sqrtf(var + LN_EPS); }
        __syncthreads();
        { const int p = tid >> 2, cseg = (tid & 3) * 32; const float mean = stS[2 * p], rstd = stS[2 * p + 1];
          const bf16* vp = V + (size_t)(tok0 + p) * SGUW + g * 128 + cseg;
#pragma unroll
          for (int k = 0; k < 4; ++k) { const v4u w = *(const v4u*)(vp + 8 * k); const int ch = g * 128 + cseg + 8 * k;
              const float e[8] = {bflo(w.x), bfhi(w.x), bflo(w.y), bfhi(w.y), bflo(w.z), bfhi(w.z), bflo(w.w), bfhi(w.w)};
#pragma unroll
              for (int i = 0; i < 8; ++i) vnS[p * 128 + cseg + 8 * k + i] = (e[i] - mean) * rstd * lng[ch + i] + lnb[ch + i]; } }
        __syncthreads();
        { const int q = tid >> 2, cs = (tid & 3) * 32;
          f32x4 acc[8];
#pragma unroll
          for (int i = 0; i < 8; ++i) acc[i] = (f32x4){0.f, 0.f, 0.f, 0.f};
          const float* wrow = sw + (size_t)(g * 128 + q) * 128;
          for (int p = 0; p < 128; ++p) { const float wv = wrow[p];
#pragma unroll
              for (int i = 0; i < 8; ++i) acc[i] += *(const LAS f32x4*)(vnS + p * 128 + cs + 4 * i) * wv; }
          const float bs = sb[g * 128 + q];
          const bf16* up = U + (size_t)(tok0 + q) * SGUW + g * 128 + cs; bf16* op = AB + (size_t)(tok0 + q) * DM + g * 128 + cs;
#pragma unroll
          for (int k = 0; k < 4; ++k) { const v4u w = *(const v4u*)(up + 8 * k); const f32x4 a0 = acc[2 * k] + bs, a1 = acc[2 * k + 1] + bs;
              v4u o; o.x = pk2(bflo(w.x) * a0[0], bfhi(w.x) * a0[1]); o.y = pk2(bflo(w.y) * a0[2], bfhi(w.y) * a0[3]);
              o.z = pk2(bflo(w.z) * a1[0], bfhi(w.z) * a1[1]); o.w = pk2(bflo(w.w) * a1[2], bfhi(w.w) * a1[3]);
              *(v4u*)(op + 8 * k) = o; } }
        __syncthreads();
    }
}

__device__ __forceinline__ float sconv(const bf16* ZHT, const float* cw, const float* cb, int ch, int b, int t) {
    const bf16* zp = ZHT + (size_t)ch * MTOK + b * SEQ;
    const float z0 = t > 0 ? bf1(zp[t - 1]) : 0.f, z1 = bf1(zp[t]), z2 = t < SEQ - 1 ? bf1(zp[t + 1]) : 0.f;
    return cw[ch] * z0 + cw[3072 + ch] * z1 + cw[6144 + ch] * z2 + cb[ch];
}
__device__ __forceinline__ void p3_hyena(Frame& F) {
    LAS float* Us = (LAS float*)F.lds;
    LAS float* KF = (LAS float*)(F.lds + 65536);
    const bf16* ZHT = (const bf16*)(F.ws + WS_ZHT); const float* FILT = (const float*)(F.ws + WS_FILT); bf16* AB = (bf16*)(F.ws + WS_H);
    const float* cw = F.in[I_HCW]; const float* cb = F.in[I_HCB]; const float* skip = F.in[I_HSKIP];
    const int tid = F.tid;
    for (int item = blockIdx.x; item < HYW; item += F.G) {
        const int c = item;
        for (int i = tid; i < NBATCH * SEQ; i += NWAVES * 64) { const int b = i >> 11, t = i & 2047; Us[t * 8 + b] = sconv(ZHT, cw, cb, c, b, t); }
        for (int n = 0; n < 2; ++n) {
            const float* hf = FILT + (size_t)((0 * 2 + n) * 1024 + c) * SEQ; const float* hb = FILT + (size_t)((1 * 2 + n) * 1024 + c) * SEQ;
            for (int i = tid; i < 4095; i += NWAVES * 64) { const int lag = i - 2047; KF[i] = lag > 0 ? hf[lag] : (lag == 0 ? hf[0] + hb[0] : hb[-lag]); }
            __syncthreads();
            f32x4 acc[4][2];
#pragma unroll
            for (int ti = 0; ti < 4; ++ti) { acc[ti][0] = (f32x4){0.f, 0.f, 0.f, 0.f}; acc[ti][1] = (f32x4){0.f, 0.f, 0.f, 0.f}; }
            const LAS float* kp = KF + tid + 2047;
            for (int s = 0; s < SEQ; ++s) {
                const f32x4 u0 = *(const LAS f32x4*)(Us + s * 8), u1 = *(const LAS f32x4*)(Us + s * 8 + 4);
#pragma unroll
                for (int ti = 0; ti < 4; ++ti) { const float kv = kp[512 * ti - s]; acc[ti][0] += u0 * kv; acc[ti][1] += u1 * kv; }
            }
            __syncthreads();
            const float sk = skip[n * 1024 + c];
#pragma unroll
            for (int ti = 0; ti < 4; ++ti) { const int t = tid + 512 * ti;
#pragma unroll
                for (int b = 0; b < 8; ++b) {
                    const float uv = Us[t * 8 + b], gate = sconv(ZHT, cw, cb, (n + 1) * 1024 + c, b, t);
                    const float y = gate * (acc[ti][b >> 2][b & 3] + sk * uv);
                    if (n == 0) Us[t * 8 + b] = y; else AB[(size_t)(b * SEQ + t) * DM + 1024 + c] = (bf16)f2bf(y);
                } }
            __syncthreads();
        }
    }
}

template <bool FINAL> __device__ __forceinline__ void ln_rows(Frame& F) {
    float* R = F.out; const float* st = (const float*)(F.ws + (FINAL ? WS_ST2 : WS_ST1)); float* MU = (float*)(F.ws + WS_MU1);
    const float* mod = (const float*)(F.ws + WS_MOD); bf16* H2 = (bf16*)(F.ws + WS_H);
    const float* lng = F.in[FINAL ? I_LN2G : I_LN1G]; const float* lnb = F.in[FINAL ? I_LN2B : I_LN1B];
    const int gw = blockIdx.x * NWAVES + F.wave, NGW = F.G * NWAVES, lane = F.lane;
    for (int row = gw; row < MTOK; row += NGW) {
        float s = 0.f, q = 0.f; if (lane < 32) { const f32x2 p = *(const f32x2*)(st + ((size_t)row * 32 + lane) * 2); s = p.x; q = p.y; }
        s = wave_sum(s); q = wave_sum(q);
        const float mean = s * (1.0f / DM); float var = q * (1.0f / DM) - mean * mean; var = var > 0.f ? var : 0.f; const float rstd = 1.0f / sqrtf(var + LN_EPS);
        if (!FINAL && lane == 0) *(f32x2*)(MU + (size_t)row * 2) = (f32x2){mean, rstd};
        const int b = row >> 11; float* rp = R + (size_t)row * DM;
#pragma unroll
        for (int j = 0; j < 8; ++j) { const int col = 4 * lane + 256 * j;
            const f32x4 v = *(const f32x4*)(rp + col); const f32x4 y = (v - mean) * rstd * *(const f32x4*)(lng + col) + *(const f32x4*)(lnb + col);
            if (FINAL) *(f32x4*)(rp + col) = y;
            else { const float* mp = mod + (size_t)b * MODW + col; const f32x4 h = y * (*(const f32x4*)(mp + 4 * DM) + 1.0f) + *(const f32x4*)(mp + 3 * DM);
                   v2u o; o.x = pk2(h[0], h[1]); o.y = pk2(h[2], h[3]); *(v2u*)(H2 + (size_t)row * DM + col) = o; } }
    }
}

typedef GAS unsigned gu32;
#define RLX_AGENT __ATOMIC_RELAXED, __HIP_MEMORY_SCOPE_AGENT
constexpr int LDSCTL_OFF = 131072, MISC_OFF = LDSCTL_OFF + 320;
constexpr int CW_BAR = 4096;
constexpr size_t CTL_ZERO_BYTES = 65536;
#define XB_TMO      128
#define XB_XCNT(j)  (256  + 64 * (j))
#define XB_XSUB(j)  (1280 + 64 * (j))
#define XB_XGEN(j)  (2304 + 64 * (j))
#define XB_TOP      3328
#define XB_TOPGEN   3392
#define XCD_BAR_WORDS 3456
#define XB_SPIN_CAP (1u << 18)

__device__ __forceinline__ unsigned xb_ld(unsigned* p)              { return __hip_atomic_load(p, __ATOMIC_RELAXED, __HIP_MEMORY_SCOPE_AGENT); }
__device__ __forceinline__ unsigned xb_add(unsigned* p, unsigned v) { return __hip_atomic_fetch_add(p, v, __ATOMIC_RELAXED, __HIP_MEMORY_SCOPE_AGENT); }
__device__ __forceinline__ unsigned xb_xcc_id() { return (unsigned)__builtin_amdgcn_s_getreg((3 << 11) | 20) & 0xFu; }
#define XB_SPIN(cond, bar) do { unsigned _sp = 0; while (cond) { __builtin_amdgcn_s_sleep(1); \
    if ((++_sp & 255u) == 0u) { if (xb_ld(&(bar)[XB_TMO])) break; if (_sp > XB_SPIN_CAP) { atomicAdd(&(bar)[XB_TMO], 1u); break; } } } } while (0)

struct XcdBarrier {
    unsigned* bar; unsigned x;
    volatile LAS unsigned* st;
};

__device__ __forceinline__ XcdBarrier xcd_barrier_post(unsigned* bar, volatile LAS unsigned* st) {
    XcdBarrier b; b.bar = bar; b.x = xb_xcc_id(); b.st = st;
    if (threadIdx.x == 0) (void)xb_add(&bar[XB_XCNT(b.x)], 1u);
    return b;
}
__device__ __forceinline__ void xcd_barrier_complete(unsigned* bar, unsigned x, unsigned& nloc, unsigned& nx) {
    const unsigned G = gridDim.x * gridDim.y * gridDim.z;
    unsigned sum, cnt, mine, sp = 0u;
    for (;;) {
        sum = 0u; cnt = 0u; mine = 0u;
#pragma unroll
        for (unsigned j = 0; j < 16; ++j) { const unsigned c = xb_ld(&bar[XB_XCNT(j)]); sum += c; cnt += (c > 0u) ? 1u : 0u; mine = (j == x) ? c : mine; }
        if (sum == G) break;
        __builtin_amdgcn_s_sleep(1);
        if ((++sp & 255u) == 0u) { if (xb_ld(&bar[XB_TMO])) break; if (sp > XB_SPIN_CAP) { atomicAdd(&bar[XB_TMO], 1u); break; } }
    }
    nloc = mine > 0u ? mine : 1u; nx = cnt > 0u ? cnt : 1u;
}

__device__ __forceinline__ void xcd_barrier(const XcdBarrier& b) {
    asm volatile("s_waitcnt vmcnt(0)" ::: "memory");
    __syncthreads();
    if (threadIdx.x == 0) {
        unsigned* bar = b.bar;
        __builtin_amdgcn_s_waitcnt(0);
        unsigned nloc = b.st[0], nx = b.st[1];
        if (nloc == 0u) { xcd_barrier_complete(bar, b.x, nloc, nx); b.st[0] = nloc; b.st[1] = nx; }
        const unsigned old = xb_add(&bar[XB_XSUB(b.x)], 1u);
        const unsigned gen = old / nloc;
        if (old + 1u == (gen + 1u) * nloc) {
            __builtin_amdgcn_fence(__ATOMIC_RELEASE, "agent");
            asm volatile("s_waitcnt vmcnt(0)" ::: "memory");
            const unsigned og = xb_add(&bar[XB_TOP], 1u);
            const unsigned tg = og / nx;
            if (og + 1u == (tg + 1u) * nx) xb_add(&bar[XB_TOPGEN], 1u);
            else XB_SPIN(xb_ld(&bar[XB_TOPGEN]) == tg, bar);
            __builtin_amdgcn_fence(__ATOMIC_ACQUIRE, "agent");
            xb_add(&bar[XB_XGEN(b.x)], 1u);
            asm volatile("s_waitcnt vmcnt(0)" ::: "memory");
        } else {
            XB_SPIN(xb_ld(&bar[XB_XGEN(b.x)]) == gen, bar);
            __builtin_amdgcn_fence(__ATOMIC_ACQUIRE, "agent");
            asm volatile("s_waitcnt vmcnt(0)" ::: "memory");
        }
    }
    __syncthreads();
}

#define GRID_SYNC() xcd_barrier(bar)

__global__ void __launch_bounds__(NWAVES * 64, 2) fwd_megakernel(Args args) {
    extern __shared__ __attribute__((aligned(16))) unsigned char lds[];
    Frame F;
    F.lds = (LAS unsigned char*)lds;
    F.tid = threadIdx.x; F.lane = F.tid & 63; F.wave = __builtin_amdgcn_readfirstlane(F.tid >> 6); F.G = gridDim.x;
    F.in = args.in; F.out = args.out; F.ws = args.ws;
    for (int u = F.tid; u < (LDS_BYTES - LDSCTL_OFF) / 4; u += NWAVES * 64) ((LAS unsigned*)(F.lds + LDSCTL_OFF))[u] = 0u;
    __syncthreads();
    XcdBarrier bar = xcd_barrier_post((unsigned*)(args.ws + WS_CTL) + CW_BAR, (volatile LAS unsigned*)(F.lds + MISC_OFF) + 8);
    unsigned char* ws = args.ws;
    const int lo = args.ph_lo, hi = args.ph_hi;
#define IN(k) (lo <= (k) && (k) < hi)
#define BOTH(k) (IN(k) && IN((k) + 1))
    const int gw = blockIdx.x * NWAVES + F.wave, NGW = F.G * NWAVES;

    if (IN(0)) {
        p0_mod(F);
        transpose_matrix(F, F.in[I_WIN], DM, INW, (bf16*)(ws + WS_WIN), DM, 0, 1, gw, NGW);
        transpose_matrix(F, F.in[I_WA], SGUW, DM, (bf16*)(ws + WS_WAB), DM, 0, 0, gw, NGW);
        transpose_matrix(F, F.in[I_WB], HYW, DM, (bf16*)(ws + WS_WAB), DM, 1024, 0, gw, NGW);
        transpose_matrix(F, F.in[I_WO], DM, DM, (bf16*)(ws + WS_WO), DM, 0, 0, gw, NGW);
        __syncthreads();
        p0_filter(F);
        if (BOTH(0)) GRID_SYNC();
    }
    if (IN(1)) { p1_modulate(F); if (BOTH(1)) GRID_SYNC(); }
    if (IN(2)) {
        { pg8::Gemm g{(const pg8::bf16_t*)(ws + WS_H), (const pg8::bf16_t*)(ws + WS_WIN), MTOK, 6144, DM}; pg8::StaticOrder S; S.init(MTOK, 6144, F.G, (int)blockIdx.x);
          pg8::EpiG1 E{(pg8::bf16_t*)(ws + WS_U), (pg8::bf16_t*)(ws + WS_V), (pg8::bf16_t*)(ws + WS_G), F.in[I_BIN], (float*)(ws + WS_STV)};
          pg8::gemm_phase<pg8::EpiG1, pg8::StaticOrder, true, true>(F.lds, g, S, E); }
        __syncthreads();
        { pg8::Gemm g{(const pg8::bf16_t*)(ws + WS_WIN) + (size_t)6144 * DM, (const pg8::bf16_t*)(ws + WS_H), 3072, MTOK, DM}; pg8::StaticOrder S; S.init(3072, MTOK, F.G, (int)blockIdx.x);
          pg8::EpiG1T E{(pg8::bf16_t*)(ws + WS_ZHT), F.in[I_BIN]};
          pg8::gemm_phase<pg8::EpiG1T, pg8::StaticOrder, true, true>(F.lds, g, S, E); }
        if (BOTH(2)) GRID_SYNC();
    }
    if (IN(3)) { __syncthreads(); p3_sgu(F); p3_hyena(F); if (BOTH(3)) GRID_SYNC(); }
    if (IN(4)) {
        pg8::Gemm g{(const pg8::bf16_t*)(ws + WS_H), (const pg8::bf16_t*)(ws + WS_WAB), MTOK, DM, DM}; pg8::StaticOrder S; S.init(MTOK, DM, F.G, (int)blockIdx.x);
        pg8::EpiG2 E{(const pg8::bf16_t*)(ws + WS_G), (pg8::bf16_t*)(ws + WS_MERGED)};
        pg8::gemm_phase<pg8::EpiG2, pg8::StaticOrder, true, true>(F.lds, g, S, E);
        if (BOTH(4)) GRID_SYNC();
    }
    if (IN(5)) {
        pg8::Gemm g{(const pg8::bf16_t*)(ws + WS_MERGED), (const pg8::bf16_t*)(ws + WS_WO), MTOK, DM, DM}; pg8::StaticOrder S; S.init(MTOK, DM, F.G, (int)blockIdx.x);
        pg8::EpiRes<true> E{F.in[I_X], F.out, (const float*)(ws + WS_MOD) + 2 * DM, F.in[I_BO], nullptr, nullptr, nullptr, (float*)(ws + WS_ST1)};
        pg8::gemm_phase<pg8::EpiRes<true>, pg8::StaticOrder, true, true>(F.lds, g, S, E);
        if (BOTH(5)) GRID_SYNC();
    }
    if (IN(6)) {
        __syncthreads();
        ln_rows<false>(F);
        transpose_matrix(F, F.in[I_WM1], DM, DFF, (bf16*)(ws + WS_WM1), DM, 0, 0, gw, NGW);
        transpose_matrix(F, F.in[I_WM2], DFF, DM, (bf16*)(ws + WS_WM2), DFF, 0, 0, gw, NGW);
        if (BOTH(6)) GRID_SYNC();
    }
    if (IN(7)) {
        __syncthreads();
        pg8::Gemm g{(const pg8::bf16_t*)(ws + WS_H), (const pg8::bf16_t*)(ws + WS_WM1), MTOK, DFF, DM}; pg8::StaticOrder S; S.init(MTOK, DFF, F.G, (int)blockIdx.x);
        pg8::EpiG4 E{(pg8::bf16_t*)(ws + WS_AFF), F.in[I_BM1]};
        pg8::gemm_phase<pg8::EpiG4, pg8::StaticOrder, true, true>(F.lds, g, S, E);
        if (BOTH(7)) GRID_SYNC();
    }
    if (IN(8)) {
        pg8::Gemm g{(const pg8::bf16_t*)(ws + WS_AFF), (const pg8::bf16_t*)(ws + WS_WM2), MTOK, DM, DFF}; pg8::StaticOrder S; S.init(MTOK, DM, F.G, (int)blockIdx.x);
        pg8::EpiRes<false> E{nullptr, F.out, (const float*)(ws + WS_MOD) + 5 * DM, F.in[I_BM2], F.in[I_LN1G], F.in[I_LN1B], (const float*)(ws + WS_MU1), (float*)(ws + WS_ST2)};
        pg8::gemm_phase<pg8::EpiRes<false>, pg8::StaticOrder, true, true>(F.lds, g, S, E);
        if (BOTH(8)) GRID_SYNC();
    }
    if (IN(9)) { ln_rows<true>(F); }
#undef IN
#undef BOTH
}

constexpr int N_PHASES = 10;
#ifndef MK_N_LAUNCHES
#define MK_N_LAUNCHES 1
#endif
extern "C" void kernel_launch(void* const* d_in, const int* in_sizes, int n_in, void* d_out, int out_size, void* d_ws, size_t ws_size, hipStream_t stream) {
    static int grid = 0;
    if (grid == 0) {
        if (n_in != 31 || in_sizes[0] != MTOK * DM || out_size != MTOK * DM || ws_size < WS_END) {
            fprintf(stderr, "kernel_launch: unexpected problem: n_in %d in0 %d out %d ws %zu (need %zu)\n", n_in, n_in > 0 ? in_sizes[0] : -1, out_size, ws_size, (size_t)WS_END); grid = -1; return; }
        int dev = 0, cus = 0, per_cu = 0;
        if (hipGetDevice(&dev) != hipSuccess || hipDeviceGetAttribute(&cus, hipDeviceAttributeMultiprocessorCount, dev) != hipSuccess) { grid = -1; return; }
        if (hipFuncSetAttribute((const void*)fwd_megakernel, hipFuncAttributeMaxDynamicSharedMemorySize, LDS_BYTES) != hipSuccess) { fprintf(stderr, "kernel_launch: hipFuncSetAttribute failed\n"); grid = -1; return; }
        if (hipOccupancyMaxActiveBlocksPerMultiprocessor(&per_cu, (const void*)fwd_megakernel, NWAVES * 64, LDS_BYTES) != hipSuccess || per_cu < 1) { fprintf(stderr, "kernel_launch: occupancy query says %d\n", per_cu); per_cu = 1; }
        (void)hipGetLastError();
        grid = cus;
    }
    if (grid < 0) return;
    if (hipMemsetAsync((char*)d_ws + WS_CTL, 0, CTL_ZERO_BYTES, stream) != hipSuccess) { fprintf(stderr, "kernel_launch: memset failed\n"); return; }
    Args a{};
    for (int i = 0; i < 31; ++i) a.in[i] = (const float*)d_in[i];
    a.out = (float*)d_out; a.ws = (unsigned char*)d_ws;
    if (MK_N_LAUNCHES == 1) {
        a.ph_lo = 0; a.ph_hi = N_PHASES;
        void* kargs[] = {&a};
        hipError_t e = hipLaunchCooperativeKernel((const void*)fwd_megakernel, dim3(grid), dim3(NWAVES * 64), kargs, LDS_BYTES, stream);
        if (e != hipSuccess) fprintf(stderr, "kernel_launch: cooperative launch failed: %s (grid %d)\n", hipGetErrorString(e), grid);
    } else {
        for (int p = 0; p < N_PHASES; ++p) { a.ph_lo = p; a.ph_hi = p + 1; hipLaunchKernelGGL(fwd_megakernel, dim3(grid), dim3(NWAVES * 64), LDS_BYTES, stream, a); }
    }
}
```

```cpp
#include <hip/hip_runtime.h>
#include <cstdio>
#include <cstdint>

namespace pg8 {
#define PG8_LAS __attribute__((address_space(3)))
typedef unsigned short bf16_t;
typedef short bf16x8 __attribute__((ext_vector_type(8)));
typedef float f32x4 __attribute__((ext_vector_type(4)));
typedef unsigned u32x4 __attribute__((ext_vector_type(4)));
typedef float f32x2 __attribute__((ext_vector_type(2)));
constexpr int BM = 256, BK = 64, HALF = 128, HTB = HALF * BK * 2  , STAGE_BYTES = 8 * HTB, NXCD = 8, WGM = 8;

__host__ __device__ __forceinline__ int lds_byte(int r, int c) { const int st = (r >> 4) * 2 + (c >> 5), rr = r & 15, cc = c & 31, ob = rr * 64 + cc * 2; return st * 1024 + (ob ^ (((ob >> 9) & 1) << 5)); }
__host__ __device__ __forceinline__ void stage_rc(int b, int& R, int& C) { const int st = b / 1024, sb = b % 1024, swz = sb ^ (((sb >> 9) & 1) << 5); R = (st >> 1) * 16 + swz / 64; C = (st & 1) * 32 + (swz % 64) / 2; }
__host__ __device__ __forceinline__ int perm32(int rho) { const int n = rho >> 4, i = rho & 15; return 8 * (i >> 2) + 4 * n + (i & 3); }

struct Unit { int pm, pn; };
struct Gemm { const bf16_t* A; const bf16_t* Bt; int M, N, K; };

struct StaticOrder {
    int nM, nN, nwg, G, c;
    __host__ __device__ void init(int M, int N, int G_, int c_) { nM = M / BM; nN = N / BM; nwg = nM * nN; G = G_; c = c_; }
    __host__ __device__ bool next(int i, Unit& u) const {
        const long L = (long)i * G + c; if (L >= nwg) return false;
        int wgid = (int)L; { const int q = nwg / NXCD, r = nwg % NXCD, xcd = wgid % NXCD, off = wgid / NXCD; wgid = (xcd < r ? xcd * (q + 1) : r * (q + 1) + (xcd - r) * q) + off; }
        const int nig = WGM * nN, gid = wgid / nig, fm = gid * WGM, gsz = (nM - fm) < WGM ? (nM - fm) : WGM;
        u.pm = fm + ((wgid % nig) % gsz); u.pn = (wgid % nig) / gsz; return true;
    }
    __device__ __forceinline__ void a_ready(const Unit&) const {}
    __device__ __forceinline__ void done(const Unit&) const {}
};

__device__ __forceinline__ unsigned cvt_pk_bf16(float lo, float hi) { unsigned r; asm volatile("v_cvt_pk_bf16_f32 %0, %1, %2" : "=v"(r) : "v"(lo), "v"(hi)); return r; }
__device__ __forceinline__ f32x2 gelu_pk(f32x2 v) {
    const f32x2 av = __builtin_elementwise_abs(v), d = av * 0.2316418882f + 1.0f;
    f32x2 t; t.x = __builtin_amdgcn_rcpf(d.x); t.y = __builtin_amdgcn_rcpf(d.y);
    f32x2 q = t * 0.5307027145f + (-0.7265760135f); q = q * t + 0.7107068705f; q = q * t + (-0.142248368f); q = q * t + 0.127414796f; q = q * t;
    const f32x2 s = (v * v) * (-0.72134752044f);
    f32x2 e; e.x = __builtin_amdgcn_exp2f(s.x); e.y = __builtin_amdgcn_exp2f(s.y);
    const f32x2 m = v * (q * e), r = v - m;
    f32x2 o; o.x = v.x < 0.f ? m.x : r.x; o.y = v.y < 0.f ? m.y : r.y; return o;
}
__device__ __forceinline__ float bf_lo(unsigned w) { return __uint_as_float(w << 16); }
__device__ __forceinline__ float bf_hi(unsigned w) { return __uint_as_float(w & 0xffff0000u); }
__device__ __forceinline__ float sigmoid_f(float x) { return __builtin_amdgcn_rcpf(1.0f + __expf(-x)); }
}

constexpr int DM = 2048, NBATCH = 8, SEQ = 2048, MTOK = NBATCH * SEQ;
constexpr int SGUW = 1024, HYW = 1024, DFF = 8192, INW = 9216, MODW = 6 * DM;
constexpr float LN_EPS = 1e-5f;
constexpr float DN_ALPHA = 1.189207115002721f;

namespace pg8 {

struct EpiG1 {
    static constexpr bool PERM = true, AFTER_DRAIN = false, MID = false;
    bf16_t* U; bf16_t* V; bf16_t* G; const float* b_in; float* statsV;
    __device__ __forceinline__ void mid(f32x4 (&)[2][2][4][2], const Unit&, int, int, int, int) const {}
    __device__ __forceinline__ void operator()(const f32x4 (&acc)[2][2][4][2], const Unit& u, int wr, int wc, int fr, int fq) const {
        const int row0 = u.pm * BM + wr * 64 + fr; const int pn = u.pn;
        int kind, ldc, colt, bcol; bf16_t* base;
        if (pn < 4) { kind = 0; base = U; ldc = SGUW; colt = pn * 256; bcol = pn * 256; }
        else if (pn < 8) { kind = 1; base = V; ldc = SGUW; colt = (pn - 4) * 256; bcol = pn * 256; }
        else { kind = 2; base = G; ldc = 2 * DM; colt = (pn - 8) * 256; bcol = 5120 + (pn - 8) * 256; }
        const int cl = wc * 32 + 8 * fq;
        f32x4 bv[2][2];
#pragma unroll
        for (int bj = 0; bj < 2; ++bj)
#pragma unroll
            for (int n = 0; n < 2; ++n) bv[bj][n] = *(const f32x4*)(b_in + bcol + cl + bj * HALF + 4 * n);
#pragma unroll
        for (int ai = 0; ai < 2; ++ai)
#pragma unroll
            for (int m = 0; m < 4; ++m) {
                const int row = row0 + ai * HALF + m * 16;
                bf16_t* rowp = base + (size_t)row * ldc + colt + cl;
                float s = 0.f, q = 0.f;
#pragma unroll
                for (int bj = 0; bj < 2; ++bj) {
                    f32x4 v0 = acc[ai][bj][m][0] + bv[bj][0], v1 = acc[ai][bj][m][1] + bv[bj][1];
                    if (kind < 2) {
                        f32x2 a = gelu_pk((f32x2){v0[0], v0[1]}), b = gelu_pk((f32x2){v0[2], v0[3]}), c = gelu_pk((f32x2){v1[0], v1[1]}), d = gelu_pk((f32x2){v1[2], v1[3]});
                        v0 = (f32x4){a.x, a.y, b.x, b.y}; v1 = (f32x4){c.x, c.y, d.x, d.y};
                    } else {
                        v0 = (f32x4){sigmoid_f(v0[0]), sigmoid_f(v0[1]), sigmoid_f(v0[2]), sigmoid_f(v0[3])};
                        v1 = (f32x4){sigmoid_f(v1[0]), sigmoid_f(v1[1]), sigmoid_f(v1[2]), sigmoid_f(v1[3])};
                    }
                    u32x4 w; w.x = cvt_pk_bf16(v0[0], v0[1]); w.y = cvt_pk_bf16(v0[2], v0[3]); w.z = cvt_pk_bf16(v1[0], v1[1]); w.w = cvt_pk_bf16(v1[2], v1[3]);
                    *(u32x4*)(rowp + bj * HALF) = w;
                    if (kind == 1) {
                        const float e0 = bf_lo(w.x), e1 = bf_hi(w.x), e2 = bf_lo(w.y), e3 = bf_hi(w.y), e4 = bf_lo(w.z), e5 = bf_hi(w.z), e6 = bf_lo(w.w), e7 = bf_hi(w.w);
                        s += ((e0 + e1) + (e2 + e3)) + ((e4 + e5) + (e6 + e7));
                        q += ((e0 * e0 + e1 * e1) + (e2 * e2 + e3 * e3)) + ((e4 * e4 + e5 * e5) + (e6 * e6 + e7 * e7));
                    }
                }
                if (kind == 1) {
                    s += __shfl_xor(s, 16); s += __shfl_xor(s, 32); q += __shfl_xor(q, 16); q += __shfl_xor(q, 32);
                    if (fq == 0) *(f32x2*)(statsV + ((size_t)row * 16 + (pn - 4) * 4 + wc) * 2) = (f32x2){s, q};
                }
            }
    }
};

struct EpiG1T {
    static constexpr bool PERM = true, AFTER_DRAIN = false, MID = false;
    bf16_t* ZHT; const float* b_in;
    __device__ __forceinline__ void mid(f32x4 (&)[2][2][4][2], const Unit&, int, int, int, int) const {}
    __device__ __forceinline__ void operator()(const f32x4 (&acc)[2][2][4][2], const Unit& u, int wr, int wc, int fr, int fq) const {
        const int row0 = u.pm * BM + wr * 64 + fr; const int col0 = u.pn * BM + wc * 32 + 8 * fq;
#pragma unroll
        for (int ai = 0; ai < 2; ++ai)
#pragma unroll
            for (int m = 0; m < 4; ++m) {
                const int row = row0 + ai * HALF + m * 16; const float bb = b_in[2048 + row];
                bf16_t* rowp = ZHT + (size_t)row * MTOK + col0;
#pragma unroll
                for (int bj = 0; bj < 2; ++bj) {
                    const f32x4 v0 = acc[ai][bj][m][0] + bb, v1 = acc[ai][bj][m][1] + bb;
                    u32x4 w; w.x = cvt_pk_bf16(v0[0], v0[1]); w.y = cvt_pk_bf16(v0[2], v0[3]); w.z = cvt_pk_bf16(v1[0], v1[1]); w.w = cvt_pk_bf16(v1[2], v1[3]);
                    *(u32x4*)(rowp + bj * HALF) = w;
                }
            }
    }
};

struct EpiG2 {
    static constexpr bool PERM = true, AFTER_DRAIN = false, MID = true;
    const bf16_t* G; bf16_t* O;
    __device__ __forceinline__ void mid(f32x4 (&acc)[2][2][4][2], const Unit& u, int wr, int wc, int fr, int fq) const {
        int row0 = u.pm * BM + wr * 64 + fr, col0 = u.pn * BM + wc * 32 + 8 * fq;
        asm volatile("" : "+v"(row0), "+v"(col0));
#pragma unroll
        for (int ai = 0; ai < 2; ++ai)
#pragma unroll
            for (int m = 0; m < 4; ++m) {
                const bf16_t* gp = G + (size_t)(row0 + ai * HALF + m * 16) * (2 * DM) + col0;
#pragma unroll
                for (int bj = 0; bj < 2; ++bj) {
                    const u32x4 ga = *(const u32x4*)(gp + bj * HALF), gb = *(const u32x4*)(gp + DM + bj * HALF);
                    f32x4 r0, r1;
                    r0[0] = bf_lo(ga.x) * __builtin_amdgcn_rcpf(bf_lo(gb.x)); r0[1] = bf_hi(ga.x) * __builtin_amdgcn_rcpf(bf_hi(gb.x));
                    r0[2] = bf_lo(ga.y) * __builtin_amdgcn_rcpf(bf_lo(gb.y)); r0[3] = bf_hi(ga.y) * __builtin_amdgcn_rcpf(bf_hi(gb.y));
                    r1[0] = bf_lo(ga.z) * __builtin_amdgcn_rcpf(bf_lo(gb.z)); r1[1] = bf_hi(ga.z) * __builtin_amdgcn_rcpf(bf_hi(gb.z));
                    r1[2] = bf_lo(ga.w) * __builtin_amdgcn_rcpf(bf_lo(gb.w)); r1[3] = bf_hi(ga.w) * __builtin_amdgcn_rcpf(bf_hi(gb.w));
                    acc[ai][bj][m][0] *= r0; acc[ai][bj][m][1] *= r1;
                }
            }
    }
    __device__ __forceinline__ void operator()(const f32x4 (&acc)[2][2][4][2], const Unit& u, int wr, int wc, int fr, int fq) const {
        const int row0 = u.pm * BM + wr * 64 + fr, col0 = u.pn * BM + wc * 32 + 8 * fq;
#pragma unroll
        for (int ai = 0; ai < 2; ++ai)
#pragma unroll
            for (int m = 0; m < 4; ++m) {
                const int row = row0 + ai * HALF + m * 16;
                const bf16_t* gp = G + (size_t)row * (2 * DM) + DM + col0;
                bf16_t* op = O + (size_t)row * DM + col0;
#pragma unroll
                for (int bj = 0; bj < 2; ++bj) {
                    const u32x4 gb = *(const u32x4*)(gp + bj * HALF);
                    const f32x4 a0 = acc[ai][bj][m][0], a1 = acc[ai][bj][m][1];
                    u32x4 w; w.x = cvt_pk_bf16(a0[0] * bf_lo(gb.x), a0[1] * bf_hi(gb.x)); w.y = cvt_pk_bf16(a0[2] * bf_lo(gb.y), a0[3] * bf_hi(gb.y));
                    w.z = cvt_pk_bf16(a1[0] * bf_lo(gb.z), a1[1] * bf_hi(gb.z)); w.w = cvt_pk_bf16(a1[2] * bf_lo(gb.w), a1[3] * bf_hi(gb.w));
                    *(u32x4*)(op + bj * HALF) = w;
                }
            }
    }
};

template <bool FIRST> struct EpiRes {
    static constexpr bool PERM = false, AFTER_DRAIN = false, MID = false;
    const float* X;
    float* R;
    const float* gate;
    const float* bias;
    const float* lng; const float* lnb; const float* MU;
    float* stats;
    __device__ __forceinline__ void mid(f32x4 (&)[2][2][4][2], const Unit&, int, int, int, int) const {}
    __device__ __forceinline__ void operator()(const f32x4 (&acc)[2][2][4][2], const Unit& u, int wr, int wc, int fr, int fq) const {
        int row0 = u.pm * BM + wr * 64 + fr, col0 = u.pn * BM + wc * 32 + 4 * fq; const int b = u.pm >> 3;
        asm volatile("" : "+v"(row0), "+v"(col0));
        const float* gp = gate + (size_t)b * MODW + col0; const float* bp = bias + col0;
#pragma unroll
        for (int ai = 0; ai < 2; ++ai)
#pragma unroll
            for (int m = 0; m < 4; ++m) {
                const int row = row0 + ai * HALF + m * 16;
                float s = 0.f, q = 0.f; f32x2 mr = (f32x2){0.f, 1.f};
                if (!FIRST) mr = *(const f32x2*)(MU + (size_t)row * 2);
                float* rp = R + (size_t)row * DM + col0; const float* xp = X + (size_t)row * DM + col0;
#pragma unroll
                for (int bj = 0; bj < 2; ++bj)
#pragma unroll
                    for (int n = 0; n < 2; ++n) {
                        const int co = bj * HALF + n * 16;
                        const f32x4 gv = *(const f32x4*)(gp + co), bv = *(const f32x4*)(bp + co);
                        f32x4 base;
                        if (FIRST) base = *(const f32x4*)(xp + co);
                        else { const f32x4 rv = *(const f32x4*)(rp + co); base = (rv - mr.x) * mr.y * *(const f32x4*)(lng + col0 + co) + *(const f32x4*)(lnb + col0 + co); }
                        const f32x4 o = base * DN_ALPHA + gv * (acc[ai][bj][m][n] + bv);
                        *(f32x4*)(rp + co) = o;
                        s += (o[0] + o[1]) + (o[2] + o[3]); q += (o[0] * o[0] + o[1] * o[1]) + (o[2] * o[2] + o[3] * o[3]);
                    }
                s += __shfl_xor(s, 16); s += __shfl_xor(s, 32); q += __shfl_xor(q, 16); q += __shfl_xor(q, 32);
                if (fq == 0) *(f32x2*)(stats + ((size_t)row * 32 + u.pn * 4 + wc) * 2) = (f32x2){s, q};
                asm volatile("" ::: "memory");
            }
    }
};

struct EpiG4 {
    static constexpr bool PERM = true, AFTER_DRAIN = false, MID = false;
    bf16_t* O; const float* bias;
    __device__ __forceinline__ void mid(f32x4 (&)[2][2][4][2], const Unit&, int, int, int, int) const {}
    __device__ __forceinline__ void operator()(const f32x4 (&acc)[2][2][4][2], const Unit& u, int wr, int wc, int fr, int fq) const {
        const int row0 = u.pm * BM + wr * 64 + fr, col0 = u.pn * BM + wc * 32 + 8 * fq;
        f32x4 bv[2][2];
#pragma unroll
        for (int bj = 0; bj < 2; ++bj)
#pragma unroll
            for (int n = 0; n < 2; ++n) bv[bj][n] = *(const f32x4*)(bias + col0 + bj * HALF + 4 * n);
#pragma unroll
        for (int ai = 0; ai < 2; ++ai)
#pragma unroll
            for (int m = 0; m < 4; ++m) {
                bf16_t* rowp = O + (size_t)(row0 + ai * HALF + m * 16) * DFF + col0;
#pragma unroll
                for (int bj = 0; bj < 2; ++bj) {
                    f32x4 v0 = acc[ai][bj][m][0] + bv[bj][0], v1 = acc[ai][bj][m][1] + bv[bj][1];
                    v0 = __builtin_elementwise_max(v0, (f32x4){0.f, 0.f, 0.f, 0.f}); v1 = __builtin_elementwise_max(v1, (f32x4){0.f, 0.f, 0.f, 0.f});
                    v0 = v0 * v0; v1 = v1 * v1;
                    u32x4 w; w.x = cvt_pk_bf16(v0[0], v0[1]); w.y = cvt_pk_bf16(v0[2], v0[3]); w.z = cvt_pk_bf16(v1[0], v1[1]); w.w = cvt_pk_bf16(v1[2], v1[3]);
                    *(u32x4*)(rowp + bj * HALF) = w;
                }
            }
    }
};
}
namespace pg8 {
template <class Epi, class Sched, bool ALIGN_EPI = false, bool SP2 = false>
__device__ __forceinline__ void gemm_phase(PG8_LAS unsigned char* lds, const Gemm g, const Sched& S, const Epi& E) {
    const int tid = threadIdx.x, wid = __builtin_amdgcn_readfirstlane(tid >> 6), lane = tid & 63, wr = wid >> 2, wc = wid & 3, fr = lane & 15, fq = lane >> 4;
    const int K = g.K, nt = K / BK;
    unsigned voffA[2], voffB[2];
#pragma unroll
    for (int i = 0; i < 2; ++i) { int R, C; stage_rc(tid * 16 + i * 8192, R, C); const int Rb = Epi::PERM ? ((R & ~31) + perm32(R & 31)) : R;
        voffA[i] = (unsigned)(R * K + C) * 2u; voffB[i] = (unsigned)(Rb * K + C) * 2u; }
    const size_t kstep = (size_t)(BK * 2);
    const size_t hstep = (size_t)HALF * K * 2;
    const size_t tstep = 2 * hstep;
    const unsigned ldsw = (unsigned)wid * 1024u;
    const int aoff = lds_byte(wr * 64 + fr, fq * 8), boff = lds_byte(wc * 32 + fr, fq * 8);
#define PG8_SA(b, h) (((b) * 2 + (h)) * HTB)
#define PG8_SB(b, h) ((4 + (b) * 2 + (h)) * HTB)
#define PG8_STAGE(bufoff, gbase, voff) do { _Pragma("unroll") for (int _i = 0; _i < 2; ++_i) \
        __builtin_amdgcn_global_load_lds((const unsigned*)((const char*)(gbase) + (voff)[_i]), (PG8_LAS unsigned*)(lds + (bufoff) + ldsw + _i * 8192), 16, 0, 0); } while (0)
#define PG8_LDA(dst, b, h) do { _Pragma("unroll") for (int m = 0; m < 4; ++m) _Pragma("unroll") for (int k = 0; k < 2; ++k) dst[m][k] = *(const PG8_LAS bf16x8*)(lds + PG8_SA(b, h) + aoff + m * 2048 + k * 1024); } while (0)
#define PG8_LDB(dst, b, h) do { _Pragma("unroll") for (int n = 0; n < 2; ++n) _Pragma("unroll") for (int k = 0; k < 2; ++k) dst[n][k] = *(const PG8_LAS bf16x8*)(lds + PG8_SB(b, h) + boff + n * 2048 + k * 1024); } while (0)
#define PG8_MMA(ai, bj, At, Bt) do { __builtin_amdgcn_s_setprio(1); _Pragma("unroll") for (int m = 0; m < 4; ++m) _Pragma("unroll") for (int n = 0; n < 2; ++n) _Pragma("unroll") for (int k = 0; k < 2; ++k) \
        acc[ai][bj][m][n] = __builtin_amdgcn_mfma_f32_16x16x32_bf16(Bt[n][k], At[m][k], acc[ai][bj][m][n], 0, 0, 0); __builtin_amdgcn_s_setprio(0); } while (0)
#define PG8_WAIT_V(n) asm volatile("s_waitcnt vmcnt(" #n ")" ::: "memory")
#define PG8_WAIT_L(n) asm volatile("s_waitcnt lgkmcnt(" #n ")" ::: "memory")
#define PG8_BAR __builtin_amdgcn_s_barrier()
#define PG8_SCHED __builtin_amdgcn_sched_barrier(0)
    Unit cur, nxt; int ui = 0;
    if (!S.next(0, cur)) return;
    f32x4 acc[2][2][4][2];
#pragma unroll
    for (int a = 0; a < 2; ++a)
#pragma unroll
        for (int b = 0; b < 2; ++b)
#pragma unroll
            for (int m = 0; m < 4; ++m)
#pragma unroll
                for (int n = 0; n < 2; ++n) acc[a][b][m][n] = (f32x4){0.f, 0.f, 0.f, 0.f};
    bf16x8 At[4][2], B0[2][2], B1[2][2];
    const char* cA = (const char*)g.A + (size_t)cur.pm * tstep; const char* cB = (const char*)g.Bt + (size_t)cur.pn * tstep;
    S.a_ready(cur);
    if constexpr (SP2) {
        PG8_STAGE(PG8_SB(0, 0), cB, voffB); PG8_STAGE(PG8_SB(0, 1), cB + hstep, voffB); PG8_STAGE(PG8_SA(0, 0), cA, voffA); PG8_STAGE(PG8_SA(0, 1), cA + hstep, voffA);
        if (wr == 1) PG8_BAR;
        PG8_WAIT_V(2); PG8_BAR;
        PG8_STAGE(PG8_SB(1, 0), cB + kstep, voffB); PG8_STAGE(PG8_SA(1, 0), cA + kstep, voffA); PG8_STAGE(PG8_SB(1, 1), cB + hstep + kstep, voffB);
        PG8_WAIT_V(6); PG8_BAR;
    } else {
        PG8_STAGE(PG8_SB(0, 0), cB, voffB); PG8_STAGE(PG8_SA(0, 0), cA, voffA); PG8_STAGE(PG8_SB(0, 1), cB + hstep, voffB); PG8_STAGE(PG8_SA(0, 1), cA + hstep, voffA);
        if (wr == 1) PG8_BAR;
        PG8_WAIT_V(4); PG8_BAR;
        PG8_STAGE(PG8_SB(1, 0), cB + kstep, voffB); PG8_STAGE(PG8_SA(1, 0), cA + kstep, voffA); PG8_STAGE(PG8_SB(1, 1), cB + hstep + kstep, voffB);
        PG8_WAIT_V(6); PG8_BAR;
    }
    for (;;) {
        const bool has_next = S.next(ui + 1, nxt);
        const char* nA = has_next ? (const char*)g.A + (size_t)nxt.pm * tstep : cA; const char* nB = has_next ? (const char*)g.Bt + (size_t)nxt.pn * tstep : cB;
        for (int t = 0; t < nt; t += 2) {
            const bool last = (t == nt - 2);
            const char* a1 = cA + (size_t)(t + 1) * kstep;
            const char* a2 = last ? nA : cA + (size_t)(t + 2) * kstep; const char* b2 = last ? nB : cB + (size_t)(t + 2) * kstep;
            const char* a3 = a2 + kstep; const char* b3 = b2 + kstep;
            if (last && has_next) S.a_ready(nxt);
            if constexpr (Epi::MID) { if (t == (nt >> 1)) E.mid(acc, cur, wr, wc, fr, fq); }
            if constexpr (SP2) {
            PG8_LDB(B0, 0, 0); PG8_LDB(B1, 0, 1); PG8_SCHED; PG8_LDA(At, 0, 0); PG8_STAGE(PG8_SA(1, 1), a1 + hstep, voffA);
            PG8_WAIT_V(8); PG8_WAIT_L(0); PG8_BAR; PG8_MMA(0, 0, At, B0); PG8_MMA(0, 1, At, B1); PG8_BAR; PG8_SCHED;
            PG8_LDA(At, 0, 1); PG8_STAGE(PG8_SB(0, 0), b2, voffB); PG8_STAGE(PG8_SB(0, 1), b2 + hstep, voffB); PG8_STAGE(PG8_SA(0, 0), a2, voffA);
            PG8_WAIT_V(8); PG8_WAIT_L(0); PG8_BAR; PG8_MMA(1, 0, At, B0); PG8_MMA(1, 1, At, B1); PG8_BAR; PG8_SCHED;
            PG8_LDB(B0, 1, 0); PG8_LDB(B1, 1, 1); PG8_SCHED; PG8_LDA(At, 1, 0); PG8_STAGE(PG8_SA(0, 1), a2 + hstep, voffA);
            PG8_WAIT_V(8); PG8_WAIT_L(0); PG8_BAR; PG8_MMA(0, 0, At, B0); PG8_MMA(0, 1, At, B1); PG8_BAR; PG8_SCHED;
            PG8_LDA(At, 1, 1); PG8_STAGE(PG8_SB(1, 0), b3, voffB); PG8_STAGE(PG8_SB(1, 1), b3 + hstep, voffB); PG8_STAGE(PG8_SA(1, 0), a3, voffA);
            PG8_WAIT_V(8); PG8_WAIT_L(0); PG8_BAR; PG8_MMA(1, 0, At, B0); PG8_MMA(1, 1, At, B1); PG8_BAR; PG8_SCHED;
            } else {
            PG8_LDB(B0, 0, 0); PG8_SCHED; PG8_LDA(At, 0, 0); PG8_STAGE(PG8_SA(1, 1), a1 + hstep, voffA);
            PG8_WAIT_L(8); PG8_BAR; PG8_WAIT_L(0); PG8_MMA(0, 0, At, B0); PG8_BAR; PG8_SCHED;
            PG8_LDB(B1, 0, 1); PG8_STAGE(PG8_SB(0, 0), b2, voffB);
            PG8_BAR; PG8_WAIT_L(0); PG8_MMA(0, 1, At, B1); PG8_BAR;
            PG8_LDA(At, 0, 1); PG8_STAGE(PG8_SA(0, 0), a2, voffA);
            PG8_BAR; PG8_WAIT_L(0); PG8_MMA(1, 0, At, B0); PG8_BAR; PG8_SCHED;
            PG8_STAGE(PG8_SB(0, 1), b2 + hstep, voffB);
            PG8_WAIT_V(6); PG8_BAR; PG8_MMA(1, 1, At, B1); PG8_BAR;
            PG8_LDB(B0, 1, 0); PG8_SCHED; PG8_LDA(At, 1, 0); PG8_STAGE(PG8_SA(0, 1), a2 + hstep, voffA);
            PG8_WAIT_L(8); PG8_BAR; PG8_WAIT_L(0); PG8_MMA(0, 0, At, B0); PG8_BAR; PG8_SCHED;
            PG8_LDB(B1, 1, 1); PG8_STAGE(PG8_SB(1, 0), b3, voffB);
            PG8_BAR; PG8_WAIT_L(0); PG8_MMA(0, 1, At, B1); PG8_BAR;
            PG8_LDA(At, 1, 1); PG8_STAGE(PG8_SA(1, 0), a3, voffA);
            PG8_BAR; PG8_WAIT_L(0); PG8_MMA(1, 0, At, B0); PG8_BAR; PG8_SCHED;
            PG8_STAGE(PG8_SB(1, 1), b3 + hstep, voffB);
            PG8_WAIT_V(6); PG8_BAR; PG8_MMA(1, 1, At, B1); PG8_BAR;
            }
        }
        if constexpr (ALIGN_EPI) { if (wr == 0) PG8_BAR; }
        if constexpr (!Epi::AFTER_DRAIN) { E(acc, cur, wr, wc, fr, fq); S.done(cur); }
        if (!has_next) break;
#pragma unroll
        for (int a = 0; a < 2; ++a)
#pragma unroll
            for (int b = 0; b < 2; ++b)
#pragma unroll
                for (int m = 0; m < 4; ++m)
#pragma unroll
                    for (int n = 0; n < 2; ++n) acc[a][b][m][n] = (f32x4){0.f, 0.f, 0.f, 0.f};
        cur = nxt; cA = nA; cB = nB; ++ui;
        if constexpr (ALIGN_EPI) { if (wr == 1) PG8_BAR; }
    }
    PG8_WAIT_V(0);
    if constexpr (!ALIGN_EPI) { if (wr == 0) PG8_BAR; }
    PG8_BAR;
    if constexpr (Epi::AFTER_DRAIN) { E.fused(acc, cur, wr, wc, fr, fq, lds, wid, lane); S.done(cur); }
#undef PG8_SA
#undef PG8_SB
#undef PG8_STAGE
#undef PG8_LDA
#undef PG8_LDB
#undef PG8_MMA
#undef PG8_WAIT_V
#undef PG8_WAIT_L
#undef PG8_BAR
#undef PG8_SCHED
}
}

constexpr size_t MiB = 1u << 20;
constexpr size_t WS_CTL = 0;
constexpr size_t WS_MOD = 1 * MiB;
constexpr size_t WS_STV = 2 * MiB;
constexpr size_t WS_ST1 = 4 * MiB;
constexpr size_t WS_ST2 = 8 * MiB;
constexpr size_t WS_MU1 = 12 * MiB;
constexpr size_t WS_WIN = 16 * MiB;
constexpr size_t WS_WAB = 52 * MiB;
constexpr size_t WS_WO = 60 * MiB;
constexpr size_t WS_FILT = 68 * MiB;
constexpr size_t WS_WM2 = 68 * MiB;
constexpr size_t WS_H = 100 * MiB;
constexpr size_t WS_U = 164 * MiB;
constexpr size_t WS_V = 196 * MiB;
constexpr size_t WS_MERGED = 164 * MiB;
constexpr size_t WS_ZHT = 228 * MiB;
constexpr size_t WS_G = 324 * MiB;
constexpr size_t WS_AFF = 164 * MiB;
constexpr size_t WS_WM1 = 420 * MiB;
constexpr size_t WS_END = 452 * MiB;

constexpr int NWAVES = 8;
constexpr int LDS_BYTES = 147456;

#define GAS __attribute__((address_space(1)))
#define LAS __attribute__((address_space(3)))
typedef unsigned short bf16;
typedef unsigned v4u __attribute__((ext_vector_type(4)));
typedef unsigned v2u __attribute__((ext_vector_type(2)));
typedef float f32x4 __attribute__((ext_vector_type(4)));
typedef float f32x2 __attribute__((ext_vector_type(2)));
#define LDS_WAIT() asm volatile("s_waitcnt lgkmcnt(0)" ::: "memory")

__device__ __forceinline__ unsigned f2bf(float f) { unsigned u = __builtin_bit_cast(unsigned, f); return (u + 0x7fffu + ((u >> 16) & 1u)) >> 16; }
__device__ __forceinline__ unsigned pk2(float lo, float hi) { return f2bf(lo) | (f2bf(hi) << 16); }
__device__ __forceinline__ float bflo(unsigned w) { return __uint_as_float(w << 16); }
__device__ __forceinline__ float bfhi(unsigned w) { return __uint_as_float(w & 0xffff0000u); }
__device__ __forceinline__ float bf1(bf16 h) { return __uint_as_float((unsigned)h << 16); }
__device__ __forceinline__ float wave_sum(float v) {
#pragma unroll
    for (int o = 1; o < 64; o <<= 1) v += __shfl_xor(v, o);
    return v;
}

struct Args { const float* in[31]; float* out; unsigned char* ws; int ph_lo, ph_hi; };

struct Frame {
    LAS unsigned char* lds;
    int tid, lane, wave, G;
    const float* const* in; float* out; unsigned char* ws;
};
enum { I_X = 0, I_C, I_WADA, I_BADA, I_WIN, I_BIN, I_SLNG, I_SLNB, I_SW, I_SB, I_HCW, I_HCB, I_HW1, I_HB1, I_HW2, I_HB2, I_HFREQ, I_HW3, I_HSKIP,
       I_WA, I_WB, I_WO, I_BO, I_LN1G, I_LN1B, I_WM1, I_BM1, I_WM2, I_BM2, I_LN2G, I_LN2B };

__device__ __forceinline__ void transpose_item(const float* W, int N, bf16* WT, int ldk, int koff, int n0, int row0, int k0, LAS float* scr, int lane) {
#pragma unroll 8
    for (int i = 0; i < 32; ++i) { const int kk = 2 * i + (lane >> 5); scr[kk * 33 + (lane & 31)] = W[(size_t)(k0 + kk) * N + n0 + (lane & 31)]; }
    LDS_WAIT(); asm volatile("" ::: "memory");
    const int c = lane & 7;
#pragma unroll
    for (int j = 0; j < 4; ++j) { const int n = (lane >> 3) + 8 * j; const LAS float* s = scr + (8 * c) * 33 + n;
        v4u o; o.x = pk2(s[0 * 33], s[1 * 33]); o.y = pk2(s[2 * 33], s[3 * 33]); o.z = pk2(s[4 * 33], s[5 * 33]); o.w = pk2(s[6 * 33], s[7 * 33]);
        *(GAS v4u*)(WT + (size_t)(row0 + n) * ldk + koff + k0 + 8 * c) = o; }
    LDS_WAIT(); asm volatile("" ::: "memory");
}
__device__ __forceinline__ void transpose_matrix(Frame& F, const float* W, int K, int N, bf16* WT, int ldk, int koff, int remap_win, int gw, int NGW) {
    LAS float* scr = (LAS float*)(F.lds + F.wave * 16384);
    const int nblk = N / 32, nitems = (K / 64) * nblk;
    for (int it = gw; it < nitems; it += NGW) {
        const int kb = it / nblk, nb = it % nblk, n0 = nb * 32; int row0 = n0;
        if (remap_win) row0 = (n0 < 2048) ? n0 : (n0 < 5120 ? n0 - 2048 + 6144 : n0 - 5120 + 2048);
        transpose_item(W, N, WT, ldk, koff, n0, row0, kb * 64, scr, F.lane);
    }
}

__device__ __forceinline__ void p0_mod(Frame& F) {
    LAS float* condS = (LAS float*)F.lds;
    LAS float* red = (LAS float*)(F.lds + 65536);
    const float* c = F.in[I_C]; const float* w_ada = F.in[I_WADA]; const float* b_ada = F.in[I_BADA];
    float* mod = (float*)(F.ws + WS_MOD);
    const int tid = F.tid;
    for (int item = blockIdx.x; item < MODW / 64; item += F.G) {
        for (int i = tid; i < NBATCH * DM; i += NWAVES * 64) { const float v = c[i]; condS[i] = v / (1.0f + __expf(-v)); }
        __syncthreads();
        const int cq = tid & 15, kq = tid >> 4, col0 = item * 64;
        f32x4 acc[8];
#pragma unroll
        for (int b = 0; b < 8; ++b) acc[b] = (f32x4){0.f, 0.f, 0.f, 0.f};
        const float* wp = w_ada + (size_t)kq * MODW + col0 + cq * 4;
        for (int k = kq; k < DM; k += 32, wp += (size_t)32 * MODW) {
            const f32x4 w = *(const f32x4*)wp;
#pragma unroll
            for (int b = 0; b < 8; ++b) acc[b] += w * condS[b * DM + k];
        }
#pragma unroll
        for (int b = 0; b < 8; ++b) *(LAS f32x4*)(red + (kq * 8 + b) * 64 + cq * 4) = acc[b];
        __syncthreads();
        { const int b = tid >> 6, col = tid & 63; float s = 0.f;
#pragma unroll 8
          for (int k2 = 0; k2 < 32; ++k2) s += red[(k2 * 8 + b) * 64 + col];
          mod[(size_t)b * MODW + col0 + col] = s + b_ada[col0 + col]; }
        __syncthreads();
    }
}

__device__ __forceinline__ void p0_filter(Frame& F) {
    LAS float* featS = (LAS float*)F.lds;
    LAS float* h1S = featS + 8 * 64;
    LAS float* h2S = h1S + 8 * 64;
    const float* w1 = F.in[I_HW1]; const float* b1 = F.in[I_HB1]; const float* w2 = F.in[I_HW2]; const float* b2 = F.in[I_HB2];
    const float* freq = F.in[I_HFREQ]; const float* w3 = F.in[I_HW3];
    float* FILT = (float*)(F.ws + WS_FILT);
    const int tid = F.tid, lane = F.lane, wave = F.wave;
    const float min_decay = -3.0701134573253943f, max_decay = -15.350567286626972f;
    for (int item = blockIdx.x; item < SEQ / 8; item += F.G) {
        const int l = item * 8 + wave;
        const float tl = (float)l / (float)(SEQ - 1), omega = 6.283185307179586f * (float)l / (float)SEQ;
        float f = 0.f;
        if (lane == 0) f = tl;
        else if (lane <= 16) { const float band = 1e-4f + (float)(lane - 1) * ((15.0f - 1e-4f) / 15.0f); f = cosf(band * omega); }
        else if (lane <= 32) { const float band = 1e-4f + (float)(lane - 17) * ((15.0f - 1e-4f) / 15.0f); f = -sinf(band * omega); }
        featS[wave * 64 + lane] = f;
        __syncthreads();
        float a = b1[lane];
        for (int i = 0; i < 33; ++i) a += featS[wave * 64 + i] * w1[i * 64 + lane];
        h1S[wave * 64 + lane] = sinf(freq[lane] * a);
        __syncthreads();
        a = b2[lane];
        for (int i = 0; i < 64; ++i) a += h1S[wave * 64 + i] * w2[i * 64 + lane];
        h2S[wave * 64 + lane] = sinf(freq[lane] * a);
        __syncthreads();
        for (int jj = 0; jj < 8; ++jj) {
            const int j = tid + 512 * jj;
            float acc[8];
#pragma unroll
            for (int p = 0; p < 8; ++p) acc[p] = 0.f;
            for (int i = 0; i < 64; ++i) { const float w = w3[(size_t)i * 4096 + j];
#pragma unroll
                for (int p = 0; p < 8; ++p) acc[p] += h2S[p * 64 + i] * w; }
            const int ch = j & 1023; const float delta = fabsf(min_decay + (float)ch * ((max_decay - min_decay) / 1023.0f));
#pragma unroll
            for (int p = 0; p < 8; ++p) { const float tp = (float)(item * 8 + p) / (float)(SEQ - 1); acc[p] *= expf(-tp * delta); }
            float* o = FILT + (size_t)j * SEQ + item * 8;
            *(f32x4*)o = (f32x4){acc[0], acc[1], acc[2], acc[3]}; *(f32x4*)(o + 4) = (f32x4){acc[4], acc[5], acc[6], acc[7]};
        }
        __syncthreads();
    }
}

__device__ __forceinline__ void p1_modulate(Frame& F) {
    const float* x = F.in[I_X]; const float* mod = (const float*)(F.ws + WS_MOD); bf16* H = (bf16*)(F.ws + WS_H);
    const size_t nvec = (size_t)MTOK * DM / 8, stride = (size_t)F.G * NWAVES * 64;
    for (size_t i = (size_t)blockIdx.x * (NWAVES * 64) + F.tid; i < nvec; i += stride) {
        const int row = (int)(i >> 8), col = (int)(i & 255) * 8, b = row >> 11;
        const f32x4 x0 = *(const f32x4*)(x + (size_t)row * DM + col), x1 = *(const f32x4*)(x + (size_t)row * DM + col + 4);
        const float* mp = mod + (size_t)b * MODW + col;
        const f32x4 sh0 = *(const f32x4*)mp, sh1 = *(const f32x4*)(mp + 4), sc0 = *(const f32x4*)(mp + DM), sc1 = *(const f32x4*)(mp + DM + 4);
        const f32x4 h0 = x0 * (sc0 + 1.0f) + sh0, h1 = x1 * (sc1 + 1.0f) + sh1;
        v4u o; o.x = pk2(h0[0], h0[1]); o.y = pk2(h0[2], h0[3]); o.z = pk2(h1[0], h1[1]); o.w = pk2(h1[2], h1[3]);
        *(v4u*)(H + (size_t)row * DM + col) = o;
    }
}

__device__ __forceinline__ void p3_sgu(Frame& F) {
    LAS float* vnS = (LAS float*)F.lds;
    LAS float* stS = (LAS float*)(F.lds + 65536);
    const bf16* U = (const bf16*)(F.ws + WS_U); const bf16* V = (const bf16*)(F.ws + WS_V); bf16* AB = (bf16*)(F.ws + WS_H);
    const float* stv = (const float*)(F.ws + WS_STV);
    const float* lng = F.in[I_SLNG]; const float* lnb = F.in[I_SLNB]; const float* sw = F.in[I_SW]; const float* sb = F.in[I_SB];
    const int tid = F.tid;
    for (int item = blockIdx.x; item < 1024; item += F.G) {
        const int b = item >> 7, n = (item >> 3) & 15, g = item & 7, tok0 = b * SEQ + n * 128;
        if (tid < 128) { float s = 0.f, q = 0.f; const float* sp = stv + (size_t)(tok0 + tid) * 32;
            for (int i = 0; i < 16; ++i) { s += sp[2 * i]; q += sp[2 * i + 1]; }
            const float mean = s * (1.0f / 1024.0f); float var = q * (1.0f / 1024.0f) - mean * mean; var = var > 0.f ? var : 0.f;
            stS[2 * tid] = mean; stS[2 * tid + 1] = 1.0f / sqrtf(var + LN_EPS); }
        __syncthreads();
        { const int p = tid >> 2, cseg = (tid & 3) * 32; const float mean = stS[2 * p], rstd = stS[2 * p + 1];
          const bf16* vp = V + (size_t)(tok0 + p) * SGUW + g * 128 + cseg;
#pragma unroll
          for (int k = 0; k < 4; ++k) { const v4u w = *(const v4u*)(vp + 8 * k); const int ch = g * 128 + cseg + 8 * k;
              const float e[8] = {bflo(w.x), bfhi(w.x), bflo(w.y), bfhi(w.y), bflo(w.z), bfhi(w.z), bflo(w.w), bfhi(w.w)};
#pragma unroll
              for (int i = 0; i < 8; ++i) vnS[p * 128 + cseg + 8 * k + i] = (e[i] - mean) * rstd * lng[ch + i] + lnb[ch + i]; } }
        __syncthreads();
        { const int q = tid >> 2, cs = (tid & 3) * 32;
          f32x4 acc[8];
#pragma unroll
          for (int i = 0; i < 8; ++i) acc[i] = (f32x4){0.f, 0.f, 0.f, 0.f};
          const float* wrow = sw + (size_t)(g * 128 + q) * 128;
          for (int p = 0; p < 128; ++p) { const float wv = wrow[p];
#pragma unroll
              for (int i = 0; i < 8; ++i) acc[i] += *(const LAS f32x4*)(vnS + p * 128 + cs + 4 * i) * wv; }
          const float bs = sb[g * 128 + q];
          const bf16* up = U + (size_t)(tok0 + q) * SGUW + g * 128 + cs; bf16* op = AB + (size_t)(tok0 + q) * DM + g * 128 + cs;
#pragma unroll
          for (int k = 0; k < 4; ++k) { const v4u w = *(const v4u*)(up + 8 * k); const f32x4 a0 = acc[2 * k] + bs, a1 = acc[2 * k + 1] + bs;
              v4u o; o.x = pk2(bflo(w.x) * a0[0], bfhi(w.x) * a0[1]); o.y = pk2(bflo(w.y) * a0[2], bfhi(w.y) * a0[3]);
              o.z = pk2(bflo(w.z) * a1[0], bfhi(w.z) * a1[1]); o.w = pk2(bflo(w.w) * a1[2], bfhi(w.w) * a1[3]);
              *(v4u*)(op + 8 * k) = o; } }
        __syncthreads();
    }
}

__device__ __forceinline__ float sconv(const bf16* ZHT, const float* cw, const float* cb, int ch, int b, int t) {
    const bf16* zp = ZHT + (size_t)ch * MTOK + b * SEQ;
    const float z0 = t > 0 ? bf1(zp[t - 1]) : 0.f, z1 = bf1(zp[t]), z2 = t < SEQ - 1 ? bf1(zp[t + 1]) : 0.f;
    return cw[ch] * z0 + cw[3072 + ch] * z1 + cw[6144 + ch] * z2 + cb[ch];
}
__device__ __forceinline__ void p3_hyena(Frame& F) {
    LAS float* Us = (LAS float*)F.lds;
    LAS float* KF = (LAS float*)(F.lds + 65536);
    const bf16* ZHT = (const bf16*)(F.ws + WS_ZHT); const float* FILT = (const float*)(F.ws + WS_FILT); bf16* AB = (bf16*)(F.ws + WS_H);
    const float* cw = F.in[I_HCW]; const float* cb = F.in[I_HCB]; const float* skip = F.in[I_HSKIP];
    const int tid = F.tid;
    for (int item = blockIdx.x; item < HYW; item += F.G) {
        const int c = item;
        for (int i = tid; i < NBATCH * SEQ; i += NWAVES * 64) { const int b = i >> 11, t = i & 2047; Us[t * 8 + b] = sconv(ZHT, cw, cb, c, b, t); }
        for (int n = 0; n < 2; ++n) {
            const float* hf = FILT + (size_t)((0 * 2 + n) * 1024 + c) * SEQ; const float* hb = FILT + (size_t)((1 * 2 + n) * 1024 + c) * SEQ;
            for (int i = tid; i < 4095; i += NWAVES * 64) { const int lag = i - 2047; KF[i] = lag > 0 ? hf[lag] : (lag == 0 ? hf[0] + hb[0] : hb[-lag]); }
            __syncthreads();
            f32x4 acc[4][2];
#pragma unroll
            for (int ti = 0; ti < 4; ++ti) { acc[ti][0] = (f32x4){0.f, 0.f, 0.f, 0.f}; acc[ti][1] = (f32x4){0.f, 0.f, 0.f, 0.f}; }
            const LAS float* kp = KF + tid + 2047;
            for (int s = 0; s < SEQ; ++s) {
                const f32x4 u0 = *(const LAS f32x4*)(Us + s * 8), u1 = *(const LAS f32x4*)(Us + s * 8 + 4);
#pragma unroll
                for (int ti = 0; ti < 4; ++ti) { const float kv = kp[512 * ti - s]; acc[ti][0] += u0 * kv; acc[ti][1] += u1 * kv; }
            }
            __syncthreads();
            const float sk = skip[n * 1024 + c];
#pragma unroll
            for (int ti = 0; ti < 4; ++ti) { const int t = tid + 512 * ti;
#pragma unroll
                for (int b = 0; b < 8; ++b) {
                    const float uv = Us[t * 8 + b], gate = sconv(ZHT, cw, cb, (n + 1) * 1024 + c, b, t);
                    const float y = gate * (acc[ti][b >> 2][b & 3] + sk * uv);
                    if (n == 0) Us[t * 8 + b] = y; else AB[(size_t)(b * SEQ + t) * DM + 1024 + c] = (bf16)f2bf(y);
                } }
            __syncthreads();
        }
    }
}

#ifndef HYFFT_HD
#define HYFFT_HD __device__ __forceinline__
#define HYFFT_LAS __attribute__((address_space(3)))
#endif
typedef float hy_c32 __attribute__((ext_vector_type(2)));
HYFFT_HD int hy_padi(int i) { return i + (i >> 3); }
HYFFT_HD int hy_rev(int x) { return ((x & 7) << 9) | (((x >> 3) & 7) << 6) | (((x >> 6) & 7) << 3) | ((x >> 9) & 7); }

template <bool INV> HYFFT_HD void hy_dft8(float (&re)[8], float (&im)[8]) {
    const float h = 0.70710678118654752f;
    float ar[4], ai[4], br[4], bi[4];
#pragma unroll
    for (int m = 0; m < 4; ++m) { ar[m] = re[m] + re[m + 4]; ai[m] = im[m] + im[m + 4]; br[m] = re[m] - re[m + 4]; bi[m] = im[m] - im[m + 4]; }
    { float x = br[1], y = bi[1]; if (!INV) { br[1] = h * (x + y); bi[1] = h * (y - x); } else { br[1] = h * (x - y); bi[1] = h * (y + x); } }
    { float x = br[2], y = bi[2]; if (!INV) { br[2] = y; bi[2] = -x; } else { br[2] = -y; bi[2] = x; } }
    { float x = br[3], y = bi[3]; if (!INV) { br[3] = h * (y - x); bi[3] = -h * (x + y); } else { br[3] = -h * (x + y); bi[3] = h * (x - y); } }
#pragma unroll
    for (int s = 0; s < 2; ++s) {
        float* cr = s ? br : ar; float* ci = s ? bi : ai;
        const float e0r = cr[0] + cr[2], e0i = ci[0] + ci[2], e1r = cr[0] - cr[2], e1i = ci[0] - ci[2];
        const float o0r = cr[1] + cr[3], o0i = ci[1] + ci[3]; const float dr = cr[1] - cr[3], di = ci[1] - ci[3];
        float o1r, o1i; if (!INV) { o1r = di; o1i = -dr; } else { o1r = -di; o1i = dr; }
        re[0 + s] = e0r + o0r; im[0 + s] = e0i + o0i;
        re[2 + s] = e1r + o1r; im[2 + s] = e1i + o1i;
        re[4 + s] = e0r - o0r; im[4 + s] = e0i - o0i;
        re[6 + s] = e1r - o1r; im[6 + s] = e1i - o1i;
    }
}
template <bool CONJ> HYFFT_HD void hy_twiddle(float (&re)[8], float (&im)[8], float wr, float wi) {
    if (CONJ) wi = -wi;
    const float w2r = wr * wr - wi * wi, w2i = 2.f * wr * wi;
    const float w3r = w2r * wr - w2i * wi, w3i = w2r * wi + w2i * wr;
    const float w4r = w2r * w2r - w2i * w2i, w4i = 2.f * w2r * w2i;
    const float w5r = w4r * wr - w4i * wi, w5i = w4r * wi + w4i * wr;
    const float w6r = w3r * w3r - w3i * w3i, w6i = 2.f * w3r * w3i;
    const float w7r = w4r * w3r - w4i * w3i, w7i = w4r * w3i + w4i * w3r;
    const float pr[8] = {1.f, wr, w2r, w3r, w4r, w5r, w6r, w7r}, pi[8] = {0.f, wi, w2i, w3i, w4i, w5i, w6i, w7i};
#pragma unroll
    for (int k = 1; k < 8; ++k) { const float x = re[k], y = im[k]; re[k] = x * pr[k] - y * pi[k]; im[k] = x * pi[k] + y * pr[k]; }
}
template <int L, class BP, class TP> HYFFT_HD void hy_fwd_store(BP buf, TP tw, int j, float (&re)[8], float (&im)[8]) {
    constexpr int S = L / 8; const int blk = j / S, q = j % S, base = blk * L + q;
    hy_dft8<false>(re, im);
    if (L > 8) { const hy_c32 w = tw[q * (4096 / L)]; hy_twiddle<false>(re, im, w.x, w.y); }
#pragma unroll
    for (int k = 0; k < 8; ++k) buf[hy_padi(base + k * S)] = (hy_c32){re[k], im[k]};
}
template <int L, class BP> HYFFT_HD void hy_load8(BP buf, int j, float (&re)[8], float (&im)[8]) {
    constexpr int S = L / 8; const int blk = j / S, q = j % S, base = blk * L + q;
#pragma unroll
    for (int k = 0; k < 8; ++k) { const hy_c32 v = buf[hy_padi(base + k * S)]; re[k] = v.x; im[k] = v.y; }
}
template <int L, class BP, class TP> HYFFT_HD void hy_fwd_stage(BP buf, TP tw, int j) { float re[8], im[8]; hy_load8<L>(buf, j, re, im); hy_fwd_store<L>(buf, tw, j, re, im); }
template <int L, class BP, class TP> HYFFT_HD void hy_inv_regs(BP buf, TP tw, int j, float (&re)[8], float (&im)[8]) {
    constexpr int S = L / 8; const int q = j % S;
    hy_load8<L>(buf, j, re, im);
    if (L > 8) { const hy_c32 w = tw[q * (4096 / L)]; hy_twiddle<true>(re, im, w.x, w.y); }
    hy_dft8<true>(re, im);
}
template <int L, class BP, class TP> HYFFT_HD void hy_inv_stage(BP buf, TP tw, int j) {
    constexpr int S = L / 8; const int blk = j / S, q = j % S, base = blk * L + q;
    float re[8], im[8]; hy_inv_regs<L>(buf, tw, j, re, im);
#pragma unroll
    for (int k = 0; k < 8; ++k) buf[hy_padi(base + k * S)] = (hy_c32){re[k], im[k]};
}
template <class BP, class KP> HYFFT_HD void hy_mid_stage(BP buf, KP K, int j) {
    float re[8], im[8]; hy_load8<8>(buf, j, re, im);
    hy_dft8<false>(re, im);
#pragma unroll
    for (int k = 0; k < 8; ++k) { const hy_c32 kv = K[hy_padi(8 * j + k)]; const float x = re[k], y = im[k]; re[k] = x * kv.x - y * kv.y; im[k] = x * kv.y + y * kv.x; }
    hy_dft8<true>(re, im);
#pragma unroll
    for (int k = 0; k < 8; ++k) buf[hy_padi(8 * j + k)] = (hy_c32){re[k], im[k]};
}
template <class BP> HYFFT_HD void hy_last_fwd(BP buf, int j) {
    float re[8], im[8]; hy_load8<8>(buf, j, re, im); hy_dft8<false>(re, im);
#pragma unroll
    for (int k = 0; k < 8; ++k) buf[hy_padi(8 * j + k)] = (hy_c32){re[k], im[k]};
}
template <class BP, class KP> HYFFT_HD void hy_separate(BP Z, KP K1, KP K2, int j) {
    const float sc = 0.5f / 4096.0f;
#pragma unroll
    for (int r = 0; r < 8; ++r) {
        const int p = j + 512 * r, f = hy_rev(p), g = (4096 - f) & 4095, p2 = hy_rev(g);
        const hy_c32 a = Z[hy_padi(p)], b = Z[hy_padi(p2)];
        K1[hy_padi(p)] = (hy_c32){(a.x + b.x) * sc, (a.y - b.y) * sc};
        K2[hy_padi(p)] = (hy_c32){(a.y + b.y) * sc, (b.x - a.x) * sc};
    }
}

constexpr int HY_BUF = 0, HY_K1 = 36864, HY_K2 = 73728, HY_TW = 110592;
__device__ __forceinline__ float sconv3(const bf16* zp, int t, float w0, float w1, float w2, float cb) {
    const float z0 = t > 0 ? bf1(zp[t - 1]) : 0.f, z1 = bf1(zp[t]), z2 = t < SEQ - 1 ? bf1(zp[t + 1]) : 0.f;
    return w0 * z0 + w1 * z1 + w2 * z2 + cb;
}
__device__ __forceinline__ void p3_hyena_fft(Frame& F) {
    LAS hy_c32* BUF = (LAS hy_c32*)(F.lds + HY_BUF); LAS hy_c32* K1 = (LAS hy_c32*)(F.lds + HY_K1); LAS hy_c32* K2 = (LAS hy_c32*)(F.lds + HY_K2);
    LAS hy_c32* TW = (LAS hy_c32*)(F.lds + HY_TW);
    const bf16* ZHT = (const bf16*)(F.ws + WS_ZHT); const float* FILT = (const float*)(F.ws + WS_FILT); bf16* AB = (bf16*)(F.ws + WS_H);
    const float* cw = F.in[I_HCW]; const float* cb = F.in[I_HCB]; const float* skip = F.in[I_HSKIP];
    const int j = F.tid;
    { float sn, cs; sincosf(-6.283185307179586f * (float)j / 4096.0f, &sn, &cs); TW[j] = (hy_c32){cs, sn}; }
    __syncthreads();
    for (int item = blockIdx.x; item < HYW; item += F.G) {
        const int c = item;
        float re[8], im[8];
        {
            const float* hf0 = FILT + (size_t)(0 * 1024 + c) * SEQ; const float* hf1 = FILT + (size_t)(1 * 1024 + c) * SEQ;
            const float* hb0 = FILT + (size_t)(2 * 1024 + c) * SEQ; const float* hb1 = FILT + (size_t)(3 * 1024 + c) * SEQ;
#pragma unroll
            for (int m = 0; m < 4; ++m) { const int i = j + 512 * m; re[m] = hf0[i]; im[m] = hf1[i]; }
            if (j == 0) { re[0] += hb0[0]; im[0] += hb1[0]; }
#pragma unroll
            for (int m = 4; m < 8; ++m) { const int i = j + 512 * m; const bool z = (i == 2048); const int r = z ? 0 : 4096 - i; const float a = hb0[r], b = hb1[r]; re[m] = z ? 0.f : a; im[m] = z ? 0.f : b; }
            hy_fwd_store<4096>(BUF, TW, j, re, im); __syncthreads();
            hy_fwd_stage<512>(BUF, TW, j); __syncthreads();
            hy_fwd_stage<64>(BUF, TW, j); __syncthreads();
            hy_last_fwd(BUF, j); __syncthreads();
            hy_separate(BUF, K1, K2, j); __syncthreads();
        }
        const float vw0 = cw[c], vw1 = cw[3072 + c], vw2 = cw[6144 + c], vcb = cb[c];
        const float aw0 = cw[1024 + c], aw1 = cw[3072 + 1024 + c], aw2 = cw[6144 + 1024 + c], acb = cb[1024 + c];
        const float bw0 = cw[2048 + c], bw1 = cw[3072 + 2048 + c], bw2 = cw[6144 + 2048 + c], bcb = cb[2048 + c];
        const float sk0 = skip[c], sk1 = skip[1024 + c];
        for (int p = 0; p < 4; ++p) {
            const bf16* zv0 = ZHT + (size_t)c * MTOK + (2 * p) * SEQ; const bf16* zv1 = zv0 + SEQ;
            const bf16* za0 = ZHT + (size_t)(1024 + c) * MTOK + (2 * p) * SEQ; const bf16* za1 = za0 + SEQ;
            const bf16* zb0 = ZHT + (size_t)(2048 + c) * MTOK + (2 * p) * SEQ; const bf16* zb1 = zb0 + SEQ;
            float v0[4], v1[4], g0[4], g1[4];
#pragma unroll
            for (int m = 0; m < 4; ++m) { const int t = j + 512 * m; v0[m] = sconv3(zv0, t, vw0, vw1, vw2, vcb); v1[m] = sconv3(zv1, t, vw0, vw1, vw2, vcb);
                g0[m] = sconv3(za0, t, aw0, aw1, aw2, acb); g1[m] = sconv3(za1, t, aw0, aw1, aw2, acb); }
#pragma unroll
            for (int m = 0; m < 4; ++m) { re[m] = v0[m]; im[m] = v1[m]; re[m + 4] = 0.f; im[m + 4] = 0.f; }
            hy_fwd_store<4096>(BUF, TW, j, re, im); __syncthreads();
            hy_fwd_stage<512>(BUF, TW, j); __syncthreads();
            hy_fwd_stage<64>(BUF, TW, j); __syncthreads();
            hy_mid_stage(BUF, K1, j); __syncthreads();
            hy_inv_stage<64>(BUF, TW, j); __syncthreads();
            hy_inv_stage<512>(BUF, TW, j); __syncthreads();
            hy_inv_regs<4096>(BUF, TW, j, re, im);
#pragma unroll
            for (int m = 0; m < 4; ++m) { v0[m] = g0[m] * (re[m] + sk0 * v0[m]); v1[m] = g1[m] * (im[m] + sk0 * v1[m]); }
#pragma unroll
            for (int m = 0; m < 4; ++m) { const int t = j + 512 * m; g0[m] = sconv3(zb0, t, bw0, bw1, bw2, bcb); g1[m] = sconv3(zb1, t, bw0, bw1, bw2, bcb); }
#pragma unroll
            for (int m = 0; m < 4; ++m) { re[m] = v0[m]; im[m] = v1[m]; re[m + 4] = 0.f; im[m + 4] = 0.f; }
            hy_fwd_store<4096>(BUF, TW, j, re, im); __syncthreads();
            hy_fwd_stage<512>(BUF, TW, j); __syncthreads();
            hy_fwd_stage<64>(BUF, TW, j); __syncthreads();
            hy_mid_stage(BUF, K2, j); __syncthreads();
            hy_inv_stage<64>(BUF, TW, j); __syncthreads();
            hy_inv_stage<512>(BUF, TW, j); __syncthreads();
            hy_inv_regs<4096>(BUF, TW, j, re, im);
#pragma unroll
            for (int m = 0; m < 4; ++m) { const int t = j + 512 * m;
                const float y0 = g0[m] * (re[m] + sk1 * v0[m]), y1 = g1[m] * (im[m] + sk1 * v1[m]);
                AB[(size_t)((2 * p) * SEQ + t) * DM + 1024 + c] = (bf16)f2bf(y0); AB[(size_t)((2 * p + 1) * SEQ + t) * DM + 1024 + c] = (bf16)f2bf(y1); }
        }
        __syncthreads();
    }
}

template <bool FINAL> __device__ __forceinline__ void ln_rows(Frame& F) {
    float* R = F.out; const float* st = (const float*)(F.ws + (FINAL ? WS_ST2 : WS_ST1)); float* MU = (float*)(F.ws + WS_MU1);
    const float* mod = (const float*)(F.ws + WS_MOD); bf16* H2 = (bf16*)(F.ws + WS_H);
    const float* lng = F.in[FINAL ? I_LN2G : I_LN1G]; const float* lnb = F.in[FINAL ? I_LN2B : I_LN1B];
    const int gw = blockIdx.x * NWAVES + F.wave, NGW = F.G * NWAVES, lane = F.lane;
    for (int row = gw; row < MTOK; row += NGW) {
        float s = 0.f, q = 0.f; if (lane < 32) { const f32x2 p = *(const f32x2*)(st + ((size_t)row * 32 + lane) * 2); s = p.x; q = p.y; }
        s = wave_sum(s); q = wave_sum(q);
        const float mean = s * (1.0f / DM); float var = q * (1.0f / DM) - mean * mean; var = var > 0.f ? var : 0.f; const float rstd = 1.0f / sqrtf(var + LN_EPS);
        if (!FINAL && lane == 0) *(f32x2*)(MU + (size_t)row * 2) = (f32x2){mean, rstd};
        const int b = row >> 11; float* rp = R + (size_t)row * DM;
#pragma unroll
        for (int j = 0; j < 8; ++j) { const int col = 4 * lane + 256 * j;
            const f32x4 v = *(const f32x4*)(rp + col); const f32x4 y = (v - mean) * rstd * *(const f32x4*)(lng + col) + *(const f32x4*)(lnb + col);
            if (FINAL) *(f32x4*)(rp + col) = y;
            else { const float* mp = mod + (size_t)b * MODW + col; const f32x4 h = y * (*(const f32x4*)(mp + 4 * DM) + 1.0f) + *(const f32x4*)(mp + 3 * DM);
                   v2u o; o.x = pk2(h[0], h[1]); o.y = pk2(h[2], h[3]); *(v2u*)(H2 + (size_t)row * DM + col) = o; } }
    }
}

typedef GAS unsigned gu32;
#define RLX_AGENT __ATOMIC_RELAXED, __HIP_MEMORY_SCOPE_AGENT
constexpr int LDSCTL_OFF = 131072, MISC_OFF = LDSCTL_OFF + 320;
constexpr int CW_BAR = 4096;
constexpr size_t CTL_ZERO_BYTES = 65536;
#define XB_TMO      128
#define XB_XCNT(j)  (256  + 64 * (j))
#define XB_XSUB(j)  (1280 + 64 * (j))
#define XB_XGEN(j)  (2304 + 64 * (j))
#define XB_TOP      3328
#define XB_TOPGEN   3392
#define XCD_BAR_WORDS 3456
#define XB_SPIN_CAP (1u << 18)

__device__ __forceinline__ unsigned xb_ld(unsigned* p)              { return __hip_atomic_load(p, __ATOMIC_RELAXED, __HIP_MEMORY_SCOPE_AGENT); }
__device__ __forceinline__ unsigned xb_add(unsigned* p, unsigned v) { return __hip_atomic_fetch_add(p, v, __ATOMIC_RELAXED, __HIP_MEMORY_SCOPE_AGENT); }
__device__ __forceinline__ unsigned xb_xcc_id() { return (unsigned)__builtin_amdgcn_s_getreg((3 << 11) | 20) & 0xFu; }
#define XB_SPIN(cond, bar) do { unsigned _sp = 0; while (cond) { __builtin_amdgcn_s_sleep(1); \
    if ((++_sp & 255u) == 0u) { if (xb_ld(&(bar)[XB_TMO])) break; if (_sp > XB_SPIN_CAP) { atomicAdd(&(bar)[XB_TMO], 1u); break; } } } } while (0)

struct XcdBarrier {
    unsigned* bar; unsigned x;
    volatile LAS unsigned* st;
};

__device__ __forceinline__ XcdBarrier xcd_barrier_post(unsigned* bar, volatile LAS unsigned* st) {
    XcdBarrier b; b.bar = bar; b.x = xb_xcc_id(); b.st = st;
    if (threadIdx.x == 0) (void)xb_add(&bar[XB_XCNT(b.x)], 1u);
    return b;
}
__device__ __forceinline__ void xcd_barrier_complete(unsigned* bar, unsigned x, unsigned& nloc, unsigned& nx) {
    const unsigned G = gridDim.x * gridDim.y * gridDim.z;
    unsigned sum, cnt, mine, sp = 0u;
    for (;;) {
        sum = 0u; cnt = 0u; mine = 0u;
#pragma unroll
        for (unsigned j = 0; j < 16; ++j) { const unsigned c = xb_ld(&bar[XB_XCNT(j)]); sum += c; cnt += (c > 0u) ? 1u : 0u; mine = (j == x) ? c : mine; }
        if (sum == G) break;
        __builtin_amdgcn_s_sleep(1);
        if ((++sp & 255u) == 0u) { if (xb_ld(&bar[XB_TMO])) break; if (sp > XB_SPIN_CAP) { atomicAdd(&bar[XB_TMO], 1u); break; } }
    }
    nloc = mine > 0u ? mine : 1u; nx = cnt > 0u ? cnt : 1u;
}

__device__ __forceinline__ void xcd_barrier(const XcdBarrier& b) {
    asm volatile("s_waitcnt vmcnt(0)" ::: "memory");
    __syncthreads();
    if (threadIdx.x == 0) {
        unsigned* bar = b.bar;
        __builtin_amdgcn_s_waitcnt(0);
        unsigned nloc = b.st[0], nx = b.st[1];
        if (nloc == 0u) { xcd_barrier_complete(bar, b.x, nloc, nx); b.st[0] = nloc; b.st[1] = nx; }
        const unsigned old = xb_add(&bar[XB_XSUB(b.x)], 1u);
        const unsigned gen = old / nloc;
        if (old + 1u == (gen + 1u) * nloc) {
            __builtin_amdgcn_fence(__ATOMIC_RELEASE, "agent");
            asm volatile("s_waitcnt vmcnt(0)" ::: "memory");
            const unsigned og = xb_add(&bar[XB_TOP], 1u);
            const unsigned tg = og / nx;
            if (og + 1u == (tg + 1u) * nx) xb_add(&bar[XB_TOPGEN], 1u);
            else XB_SPIN(xb_ld(&bar[XB_TOPGEN]) == tg, bar);
            __builtin_amdgcn_fence(__ATOMIC_ACQUIRE, "agent");
            xb_add(&bar[XB_XGEN(b.x)], 1u);
            asm volatile("s_waitcnt vmcnt(0)" ::: "memory");
        } else {
            XB_SPIN(xb_ld(&bar[XB_XGEN(b.x)]) == gen, bar);
            __builtin_amdgcn_fence(__ATOMIC_ACQUIRE, "agent");
            asm volatile("s_waitcnt vmcnt(0)" ::: "memory");
        }
    }
    __syncthreads();
}

#define GRID_SYNC() xcd_barrier(bar)

__global__ void __launch_bounds__(NWAVES * 64, 2) fwd_megakernel(Args args) {
    extern __shared__ __attribute__((aligned(16))) unsigned char lds[];
    Frame F;
    F.lds = (LAS unsigned char*)lds;
    F.tid = threadIdx.x; F.lane = F.tid & 63; F.wave = __builtin_amdgcn_readfirstlane(F.tid >> 6); F.G = gridDim.x;
    F.in = args.in; F.out = args.out; F.ws = args.ws;
    for (int u = F.tid; u < (LDS_BYTES - LDSCTL_OFF) / 4; u += NWAVES * 64) ((LAS unsigned*)(F.lds + LDSCTL_OFF))[u] = 0u;
    __syncthreads();
    XcdBarrier bar = xcd_barrier_post((unsigned*)(args.ws + WS_CTL) + CW_BAR, (volatile LAS unsigned*)(F.lds + MISC_OFF) + 8);
    unsigned char* ws = args.ws;
    const int lo = args.ph_lo, hi = args.ph_hi;
#define IN(k) (lo <= (k) && (k) < hi)
#define BOTH(k) (IN(k) && IN((k) + 1))
    const int gw = blockIdx.x * NWAVES + F.wave, NGW = F.G * NWAVES;

    if (IN(0)) {
        p0_mod(F);
        transpose_matrix(F, F.in[I_WIN], DM, INW, (bf16*)(ws + WS_WIN), DM, 0, 1, gw, NGW);
        transpose_matrix(F, F.in[I_WA], SGUW, DM, (bf16*)(ws + WS_WAB), DM, 0, 0, gw, NGW);
        transpose_matrix(F, F.in[I_WB], HYW, DM, (bf16*)(ws + WS_WAB), DM, 1024, 0, gw, NGW);
        transpose_matrix(F, F.in[I_WO], DM, DM, (bf16*)(ws + WS_WO), DM, 0, 0, gw, NGW);
        __syncthreads();
        p0_filter(F);
        if (BOTH(0)) GRID_SYNC();
    }
    if (IN(1)) { p1_modulate(F); if (BOTH(1)) GRID_SYNC(); }
    if (IN(2)) {
        { pg8::Gemm g{(const pg8::bf16_t*)(ws + WS_H), (const pg8::bf16_t*)(ws + WS_WIN), MTOK, 6144, DM}; pg8::StaticOrder S; S.init(MTOK, 6144, F.G, (int)blockIdx.x);
          pg8::EpiG1 E{(pg8::bf16_t*)(ws + WS_U), (pg8::bf16_t*)(ws + WS_V), (pg8::bf16_t*)(ws + WS_G), F.in[I_BIN], (float*)(ws + WS_STV)};
          pg8::gemm_phase<pg8::EpiG1, pg8::StaticOrder, true, true>(F.lds, g, S, E); }
        __syncthreads();
        { pg8::Gemm g{(const pg8::bf16_t*)(ws + WS_WIN) + (size_t)6144 * DM, (const pg8::bf16_t*)(ws + WS_H), 3072, MTOK, DM}; pg8::StaticOrder S; S.init(3072, MTOK, F.G, (int)blockIdx.x);
          pg8::EpiG1T E{(pg8::bf16_t*)(ws + WS_ZHT), F.in[I_BIN]};
          pg8::gemm_phase<pg8::EpiG1T, pg8::StaticOrder, true, true>(F.lds, g, S, E); }
        if (BOTH(2)) GRID_SYNC();
    }
    if (IN(3)) { __syncthreads(); p3_sgu(F); p3_hyena_fft(F); if (BOTH(3)) GRID_SYNC(); }
    if (IN(4)) {
        pg8::Gemm g{(const pg8::bf16_t*)(ws + WS_H), (const pg8::bf16_t*)(ws + WS_WAB), MTOK, DM, DM}; pg8::StaticOrder S; S.init(MTOK, DM, F.G, (int)blockIdx.x);
        pg8::EpiG2 E{(const pg8::bf16_t*)(ws + WS_G), (pg8::bf16_t*)(ws + WS_MERGED)};
        pg8::gemm_phase<pg8::EpiG2, pg8::StaticOrder, true, true>(F.lds, g, S, E);
        if (BOTH(4)) GRID_SYNC();
    }
    if (IN(5)) {
        pg8::Gemm g{(const pg8::bf16_t*)(ws + WS_MERGED), (const pg8::bf16_t*)(ws + WS_WO), MTOK, DM, DM}; pg8::StaticOrder S; S.init(MTOK, DM, F.G, (int)blockIdx.x);
        pg8::EpiRes<true> E{F.in[I_X], F.out, (const float*)(ws + WS_MOD) + 2 * DM, F.in[I_BO], nullptr, nullptr, nullptr, (float*)(ws + WS_ST1)};
        pg8::gemm_phase<pg8::EpiRes<true>, pg8::StaticOrder, true, true>(F.lds, g, S, E);
        if (BOTH(5)) GRID_SYNC();
    }
    if (IN(6)) {
        __syncthreads();
        ln_rows<false>(F);
        transpose_matrix(F, F.in[I_WM1], DM, DFF, (bf16*)(ws + WS_WM1), DM, 0, 0, gw, NGW);
        transpose_matrix(F, F.in[I_WM2], DFF, DM, (bf16*)(ws + WS_WM2), DFF, 0, 0, gw, NGW);
        if (BOTH(6)) GRID_SYNC();
    }
    if (IN(7)) {
        __syncthreads();
        pg8::Gemm g{(const pg8::bf16_t*)(ws + WS_H), (const pg8::bf16_t*)(ws + WS_WM1), MTOK, DFF, DM}; pg8::StaticOrder S; S.init(MTOK, DFF, F.G, (int)blockIdx.x);
        pg8::EpiG4 E{(pg8::bf16_t*)(ws + WS_AFF), F.in[I_BM1]};
        pg8::gemm_phase<pg8::EpiG4, pg8::StaticOrder, true, true>(F.lds, g, S, E);
        if (BOTH(7)) GRID_SYNC();
    }
    if (IN(8)) {
        pg8::Gemm g{(const pg8::bf16_t*)(ws + WS_AFF), (const pg8::bf16_t*)(ws + WS_WM2), MTOK, DM, DFF}; pg8::StaticOrder S; S.init(MTOK, DM, F.G, (int)blockIdx.x);
        pg8::EpiRes<false> E{nullptr, F.out, (const float*)(ws + WS_MOD) + 5 * DM, F.in[I_BM2], F.in[I_LN1G], F.in[I_LN1B], (const float*)(ws + WS_MU1), (float*)(ws + WS_ST2)};
        pg8::gemm_phase<pg8::EpiRes<false>, pg8::StaticOrder, true, true>(F.lds, g, S, E);
        if (BOTH(8)) GRID_SYNC();
    }
    if (IN(9)) { ln_rows<true>(F); }
#undef IN
#undef BOTH
}

constexpr int N_PHASES = 10;
#ifndef MK_N_LAUNCHES
#define MK_N_LAUNCHES 1
#endif
extern "C" void kernel_launch(void* const* d_in, const int* in_sizes, int n_in, void* d_out, int out_size, void* d_ws, size_t ws_size, hipStream_t stream) {
    static int grid = 0;
    if (grid == 0) {
        if (n_in != 31 || in_sizes[0] != MTOK * DM || out_size != MTOK * DM || ws_size < WS_END) {
            fprintf(stderr, "kernel_launch: unexpected problem: n_in %d in0 %d out %d ws %zu (need %zu)\n", n_in, n_in > 0 ? in_sizes[0] : -1, out_size, ws_size, (size_t)WS_END); grid = -1; return; }
        int dev = 0, cus = 0, per_cu = 0;
        if (hipGetDevice(&dev) != hipSuccess || hipDeviceGetAttribute(&cus, hipDeviceAttributeMultiprocessorCount, dev) != hipSuccess) { grid = -1; return; }
        if (hipFuncSetAttribute((const void*)fwd_megakernel, hipFuncAttributeMaxDynamicSharedMemorySize, LDS_BYTES) != hipSuccess) { fprintf(stderr, "kernel_launch: hipFuncSetAttribute failed\n"); grid = -1; return; }
        if (hipOccupancyMaxActiveBlocksPerMultiprocessor(&per_cu, (const void*)fwd_megakernel, NWAVES * 64, LDS_BYTES) != hipSuccess || per_cu < 1) { fprintf(stderr, "kernel_launch: occupancy query says %d\n", per_cu); per_cu = 1; }
        (void)hipGetLastError();
        grid = cus;
    }
    if (grid < 0) return;
    if (hipMemsetAsync((char*)d_ws + WS_CTL, 0, CTL_ZERO_BYTES, stream) != hipSuccess) { fprintf(stderr, "kernel_launch: memset failed\n"); return; }
    Args a{};
    for (int i = 0; i < 31; ++i) a.in[i] = (const float*)d_in[i];
    a.out = (float*)d_out; a.ws = (unsigned char*)d_ws;
    if (MK_N_LAUNCHES == 1) {
        a.ph_lo = 0; a.ph_hi = N_PHASES;
        void* kargs[] = {&a};
        hipError_t e = hipLaunchCooperativeKernel((const void*)fwd_megakernel, dim3(grid), dim3(NWAVES * 64), kargs, LDS_BYTES, stream);
        if (e != hipSuccess) fprintf(stderr, "kernel_launch: cooperative launch failed: %s (grid %d)\n", hipGetErrorString(e), grid);
    } else {
        for (int p = 0; p < N_PHASES; ++p) { a.ph_lo = p; a.ph_hi = p + 1; hipLaunchKernelGGL(fwd_megakernel, dim3(grid), dim3(NWAVES * 64), LDS_BYTES, stream, a); }
    }
}
```

```cpp
#include <hip/hip_runtime.h>
#include <cstdio>
#include <cstdint>

namespace pg8 {
#define PG8_LAS __attribute__((address_space(3)))
typedef unsigned short bf16_t;
typedef short bf16x8 __attribute__((ext_vector_type(8)));
typedef float f32x4 __attribute__((ext_vector_type(4)));
typedef unsigned u32x4 __attribute__((ext_vector_type(4)));
typedef float f32x2 __attribute__((ext_vector_type(2)));
constexpr int BM = 256, BK = 64, HALF = 128, HTB = HALF * BK * 2  , STAGE_BYTES = 8 * HTB, NXCD = 8, WGM = 8;

__host__ __device__ __forceinline__ int lds_byte(int r, int c) { const int st = (r >> 4) * 2 + (c >> 5), rr = r & 15, cc = c & 31, ob = rr * 64 + cc * 2; return st * 1024 + (ob ^ (((ob >> 9) & 1) << 5)); }
__host__ __device__ __forceinline__ void stage_rc(int b, int& R, int& C) { const int st = b / 1024, sb = b % 1024, swz = sb ^ (((sb >> 9) & 1) << 5); R = (st >> 1) * 16 + swz / 64; C = (st & 1) * 32 + (swz % 64) / 2; }
__host__ __device__ __forceinline__ int perm32(int rho) { const int n = rho >> 4, i = rho & 15; return 8 * (i >> 2) + 4 * n + (i & 3); }

struct Unit { int pm, pn; };
struct Gemm { const bf16_t* A; const bf16_t* Bt; int M, N, K; };

struct StaticOrder {
    int nM, nN, nwg, G, c;
    __host__ __device__ void init(int M, int N, int G_, int c_) { nM = M / BM; nN = N / BM; nwg = nM * nN; G = G_; c = c_; }
    __host__ __device__ bool next(int i, Unit& u) const {
        const long L = (long)i * G + c; if (L >= nwg) return false;
        int wgid = (int)L; { const int q = nwg / NXCD, r = nwg % NXCD, xcd = wgid % NXCD, off = wgid / NXCD; wgid = (xcd < r ? xcd * (q + 1) : r * (q + 1) + (xcd - r) * q) + off; }
        const int nig = WGM * nN, gid = wgid / nig, fm = gid * WGM, gsz = (nM - fm) < WGM ? (nM - fm) : WGM;
        u.pm = fm + ((wgid % nig) % gsz); u.pn = (wgid % nig) / gsz; return true;
    }
    __device__ __forceinline__ void a_ready(const Unit&) const {}
    __device__ __forceinline__ void done(const Unit&) const {}
};

__device__ __forceinline__ unsigned cvt_pk_bf16(float lo, float hi) { unsigned r; asm volatile("v_cvt_pk_bf16_f32 %0, %1, %2" : "=v"(r) : "v"(lo), "v"(hi)); return r; }
__device__ __forceinline__ f32x2 gelu_pk(f32x2 v) {
    const f32x2 av = __builtin_elementwise_abs(v), d = av * 0.2316418882f + 1.0f;
    f32x2 t; t.x = __builtin_amdgcn_rcpf(d.x); t.y = __builtin_amdgcn_rcpf(d.y);
    f32x2 q = t * 0.5307027145f + (-0.7265760135f); q = q * t + 0.7107068705f; q = q * t + (-0.142248368f); q = q * t + 0.127414796f; q = q * t;
    const f32x2 s = (v * v) * (-0.72134752044f);
    f32x2 e; e.x = __builtin_amdgcn_exp2f(s.x); e.y = __builtin_amdgcn_exp2f(s.y);
    const f32x2 m = v * (q * e), r = v - m;
    f32x2 o; o.x = v.x < 0.f ? m.x : r.x; o.y = v.y < 0.f ? m.y : r.y; return o;
}
__device__ __forceinline__ float bf_lo(unsigned w) { return __uint_as_float(w << 16); }
__device__ __forceinline__ float bf_hi(unsigned w) { return __uint_as_float(w & 0xffff0000u); }
__device__ __forceinline__ float sigmoid_f(float x) { return __builtin_amdgcn_rcpf(1.0f + __expf(-x)); }
}

constexpr int DM = 2048, NBATCH = 8, SEQ = 2048, MTOK = NBATCH * SEQ;
constexpr int SGUW = 1024, HYW = 1024, DFF = 8192, INW = 9216, MODW = 6 * DM;
constexpr float LN_EPS = 1e-5f;
constexpr float DN_ALPHA = 1.189207115002721f;

namespace pg8 {

struct EpiG1 {
    static constexpr bool PERM = true, AFTER_DRAIN = false, MID = false;
    bf16_t* U; bf16_t* G; const float* b_in;
    __device__ __forceinline__ void mid(f32x4 (&)[2][2][4][2], const Unit&, int, int, int, int) const {}
    __device__ __forceinline__ void operator()(const f32x4 (&acc)[2][2][4][2], const Unit& u, int wr, int wc, int fr, int fq) const {
        const int row0 = u.pm * BM + wr * 64 + fr; const int pn = u.pn;
        int ldc, colt, bcol; bf16_t* base; const bool isu = pn < 4;
        if (isu) { base = U; ldc = SGUW; colt = pn * 256; bcol = pn * 256; }
        else { base = G; ldc = 2 * DM; colt = (pn - 4) * 256; bcol = 5120 + (pn - 4) * 256; }
        const int cl = wc * 32 + 8 * fq;
        f32x4 bv[2][2];
#pragma unroll
        for (int bj = 0; bj < 2; ++bj)
#pragma unroll
            for (int n = 0; n < 2; ++n) bv[bj][n] = *(const f32x4*)(b_in + bcol + cl + bj * HALF + 4 * n);
#pragma unroll
        for (int ai = 0; ai < 2; ++ai)
#pragma unroll
            for (int m = 0; m < 4; ++m) {
                const int row = row0 + ai * HALF + m * 16;
                bf16_t* rowp = base + (size_t)row * ldc + colt + cl;
#pragma unroll
                for (int bj = 0; bj < 2; ++bj) {
                    f32x4 v0 = acc[ai][bj][m][0] + bv[bj][0], v1 = acc[ai][bj][m][1] + bv[bj][1];
                    if (isu) {
                        f32x2 a = gelu_pk((f32x2){v0[0], v0[1]}), b = gelu_pk((f32x2){v0[2], v0[3]}), c = gelu_pk((f32x2){v1[0], v1[1]}), d = gelu_pk((f32x2){v1[2], v1[3]});
                        v0 = (f32x4){a.x, a.y, b.x, b.y}; v1 = (f32x4){c.x, c.y, d.x, d.y};
                    } else {
                        v0 = (f32x4){sigmoid_f(v0[0]), sigmoid_f(v0[1]), sigmoid_f(v0[2]), sigmoid_f(v0[3])};
                        v1 = (f32x4){sigmoid_f(v1[0]), sigmoid_f(v1[1]), sigmoid_f(v1[2]), sigmoid_f(v1[3])};
                    }
                    u32x4 w; w.x = cvt_pk_bf16(v0[0], v0[1]); w.y = cvt_pk_bf16(v0[2], v0[3]); w.z = cvt_pk_bf16(v1[0], v1[1]); w.w = cvt_pk_bf16(v1[2], v1[3]);
                    *(u32x4*)(rowp + bj * HALF) = w;
                }
            }
    }
};

struct EpiG1T {
    static constexpr bool PERM = true, AFTER_DRAIN = false, MID = false;
    bf16_t* VT; bf16_t* ZHT; const float* b_in; float* statsV;
    __device__ __forceinline__ void mid(f32x4 (&)[2][2][4][2], const Unit&, int, int, int, int) const {}
    __device__ __forceinline__ void operator()(const f32x4 (&acc)[2][2][4][2], const Unit& u, int wr, int wc, int fr, int fq) const {
        const int col0 = u.pn * BM + wc * 32 + 8 * fq; const bool isv = u.pm < 4;
        const int rowt = (isv ? u.pm : u.pm - 4) * BM + wr * 64 + fr;
        bf16_t* base = isv ? VT : ZHT; const float* bp = b_in + (isv ? 1024 : 2048);
#pragma unroll
        for (int ai = 0; ai < 2; ++ai) {
            float s[2][8], q[2][8];
#pragma unroll
            for (int bj = 0; bj < 2; ++bj)
#pragma unroll
                for (int e = 0; e < 8; ++e) { s[bj][e] = 0.f; q[bj][e] = 0.f; }
#pragma unroll
            for (int m = 0; m < 4; ++m) {
                const int row = rowt + ai * HALF + m * 16; const float bb = bp[row];
                bf16_t* rowp = base + (size_t)row * MTOK + col0;
#pragma unroll
                for (int bj = 0; bj < 2; ++bj) {
                    f32x4 v0 = acc[ai][bj][m][0] + bb, v1 = acc[ai][bj][m][1] + bb;
                    if (isv) {
                        f32x2 a = gelu_pk((f32x2){v0[0], v0[1]}), b = gelu_pk((f32x2){v0[2], v0[3]}), c = gelu_pk((f32x2){v1[0], v1[1]}), d = gelu_pk((f32x2){v1[2], v1[3]});
                        v0 = (f32x4){a.x, a.y, b.x, b.y}; v1 = (f32x4){c.x, c.y, d.x, d.y};
                    }
                    u32x4 w; w.x = cvt_pk_bf16(v0[0], v0[1]); w.y = cvt_pk_bf16(v0[2], v0[3]); w.z = cvt_pk_bf16(v1[0], v1[1]); w.w = cvt_pk_bf16(v1[2], v1[3]);
                    *(u32x4*)(rowp + bj * HALF) = w;
                    if (isv) {
                        const float e0 = bf_lo(w.x), e1 = bf_hi(w.x), e2 = bf_lo(w.y), e3 = bf_hi(w.y), e4 = bf_lo(w.z), e5 = bf_hi(w.z), e6 = bf_lo(w.w), e7 = bf_hi(w.w);
                        s[bj][0] += e0; s[bj][1] += e1; s[bj][2] += e2; s[bj][3] += e3; s[bj][4] += e4; s[bj][5] += e5; s[bj][6] += e6; s[bj][7] += e7;
                        q[bj][0] += e0 * e0; q[bj][1] += e1 * e1; q[bj][2] += e2 * e2; q[bj][3] += e3 * e3; q[bj][4] += e4 * e4; q[bj][5] += e5 * e5; q[bj][6] += e6 * e6; q[bj][7] += e7 * e7;
                    }
                }
            }
            if (isv) {
                const int slot = u.pm * 4 + ai * 2 + wr;
#pragma unroll
                for (int bj = 0; bj < 2; ++bj)
#pragma unroll
                    for (int e = 0; e < 8; ++e) {
                        float a = s[bj][e], b = q[bj][e];
                        a += __shfl_xor(a, 1); b += __shfl_xor(b, 1); a += __shfl_xor(a, 2); b += __shfl_xor(b, 2);
                        a += __shfl_xor(a, 4); b += __shfl_xor(b, 4); a += __shfl_xor(a, 8); b += __shfl_xor(b, 8);
                        if (fr == 0) *(f32x2*)(statsV + ((size_t)(col0 + bj * HALF + e) * 16 + slot) * 2) = (f32x2){a, b};
                    }
            }
        }
    }
};

struct EpiG2 {
    static constexpr bool PERM = true, AFTER_DRAIN = false, MID = true;
    const bf16_t* G; bf16_t* O;
    __device__ __forceinline__ void mid(f32x4 (&acc)[2][2][4][2], const Unit& u, int wr, int wc, int fr, int fq) const {
        int row0 = u.pm * BM + wr * 64 + fr, col0 = u.pn * BM + wc * 32 + 8 * fq;
        asm volatile("" : "+v"(row0), "+v"(col0));
#pragma unroll
        for (int ai = 0; ai < 2; ++ai)
#pragma unroll
            for (int m = 0; m < 4; ++m) {
                const bf16_t* gp = G + (size_t)(row0 + ai * HALF + m * 16) * (2 * DM) + col0;
#pragma unroll
                for (int bj = 0; bj < 2; ++bj) {
                    const u32x4 ga = *(const u32x4*)(gp + bj * HALF), gb = *(const u32x4*)(gp + DM + bj * HALF);
                    f32x4 r0, r1;
                    r0[0] = bf_lo(ga.x) * __builtin_amdgcn_rcpf(bf_lo(gb.x)); r0[1] = bf_hi(ga.x) * __builtin_amdgcn_rcpf(bf_hi(gb.x));
                    r0[2] = bf_lo(ga.y) * __builtin_amdgcn_rcpf(bf_lo(gb.y)); r0[3] = bf_hi(ga.y) * __builtin_amdgcn_rcpf(bf_hi(gb.y));
                    r1[0] = bf_lo(ga.z) * __builtin_amdgcn_rcpf(bf_lo(gb.z)); r1[1] = bf_hi(ga.z) * __builtin_amdgcn_rcpf(bf_hi(gb.z));
                    r1[2] = bf_lo(ga.w) * __builtin_amdgcn_rcpf(bf_lo(gb.w)); r1[3] = bf_hi(ga.w) * __builtin_amdgcn_rcpf(bf_hi(gb.w));
                    acc[ai][bj][m][0] *= r0; acc[ai][bj][m][1] *= r1;
                }
            }
    }
    __device__ __forceinline__ void operator()(const f32x4 (&acc)[2][2][4][2], const Unit& u, int wr, int wc, int fr, int fq) const {
        const int row0 = u.pm * BM + wr * 64 + fr, col0 = u.pn * BM + wc * 32 + 8 * fq;
#pragma unroll
        for (int ai = 0; ai < 2; ++ai)
#pragma unroll
            for (int m = 0; m < 4; ++m) {
                const int row = row0 + ai * HALF + m * 16;
                const bf16_t* gp = G + (size_t)row * (2 * DM) + DM + col0;
                bf16_t* op = O + (size_t)row * DM + col0;
#pragma unroll
                for (int bj = 0; bj < 2; ++bj) {
                    const u32x4 gb = *(const u32x4*)(gp + bj * HALF);
                    const f32x4 a0 = acc[ai][bj][m][0], a1 = acc[ai][bj][m][1];
                    u32x4 w; w.x = cvt_pk_bf16(a0[0] * bf_lo(gb.x), a0[1] * bf_hi(gb.x)); w.y = cvt_pk_bf16(a0[2] * bf_lo(gb.y), a0[3] * bf_hi(gb.y));
                    w.z = cvt_pk_bf16(a1[0] * bf_lo(gb.z), a1[1] * bf_hi(gb.z)); w.w = cvt_pk_bf16(a1[2] * bf_lo(gb.w), a1[3] * bf_hi(gb.w));
                    *(u32x4*)(op + bj * HALF) = w;
                }
            }
    }
};

template <bool FIRST> struct EpiRes {
    static constexpr bool PERM = false, AFTER_DRAIN = false, MID = false;
    const float* X;
    float* R;
    const float* gate;
    const float* bias;
    const float* lng; const float* lnb; const float* MU;
    float* stats;
    __device__ __forceinline__ void mid(f32x4 (&)[2][2][4][2], const Unit&, int, int, int, int) const {}
    __device__ __forceinline__ void operator()(const f32x4 (&acc)[2][2][4][2], const Unit& u, int wr, int wc, int fr, int fq) const {
        int row0 = u.pm * BM + wr * 64 + fr, col0 = u.pn * BM + wc * 32 + 4 * fq; const int b = u.pm >> 3;
        asm volatile("" : "+v"(row0), "+v"(col0));
        const float* gp = gate + (size_t)b * MODW + col0; const float* bp = bias + col0;
#pragma unroll
        for (int ai = 0; ai < 2; ++ai)
#pragma unroll
            for (int m = 0; m < 4; ++m) {
                const int row = row0 + ai * HALF + m * 16;
                float s = 0.f, q = 0.f; f32x2 mr = (f32x2){0.f, 1.f};
                if (!FIRST) mr = *(const f32x2*)(MU + (size_t)row * 2);
                float* rp = R + (size_t)row * DM + col0; const float* xp = X + (size_t)row * DM + col0;
#pragma unroll
                for (int bj = 0; bj < 2; ++bj)
#pragma unroll
                    for (int n = 0; n < 2; ++n) {
                        const int co = bj * HALF + n * 16;
                        const f32x4 gv = *(const f32x4*)(gp + co), bv = *(const f32x4*)(bp + co);
                        f32x4 base;
                        if (FIRST) base = *(const f32x4*)(xp + co);
                        else { const f32x4 rv = *(const f32x4*)(rp + co); base = (rv - mr.x) * mr.y * *(const f32x4*)(lng + col0 + co) + *(const f32x4*)(lnb + col0 + co); }
                        const f32x4 o = base * DN_ALPHA + gv * (acc[ai][bj][m][n] + bv);
                        *(f32x4*)(rp + co) = o;
                        s += (o[0] + o[1]) + (o[2] + o[3]); q += (o[0] * o[0] + o[1] * o[1]) + (o[2] * o[2] + o[3] * o[3]);
                    }
                s += __shfl_xor(s, 16); s += __shfl_xor(s, 32); q += __shfl_xor(q, 16); q += __shfl_xor(q, 32);
                if (fq == 0) *(f32x2*)(stats + ((size_t)row * 32 + u.pn * 4 + wc) * 2) = (f32x2){s, q};
                asm volatile("" ::: "memory");
            }
    }
};

struct EpiG4 {
    static constexpr bool PERM = true, AFTER_DRAIN = false, MID = false;
    bf16_t* O; const float* bias;
    __device__ __forceinline__ void mid(f32x4 (&)[2][2][4][2], const Unit&, int, int, int, int) const {}
    __device__ __forceinline__ void operator()(const f32x4 (&acc)[2][2][4][2], const Unit& u, int wr, int wc, int fr, int fq) const {
        const int row0 = u.pm * BM + wr * 64 + fr, col0 = u.pn * BM + wc * 32 + 8 * fq;
        f32x4 bv[2][2];
#pragma unroll
        for (int bj = 0; bj < 2; ++bj)
#pragma unroll
            for (int n = 0; n < 2; ++n) bv[bj][n] = *(const f32x4*)(bias + col0 + bj * HALF + 4 * n);
#pragma unroll
        for (int ai = 0; ai < 2; ++ai)
#pragma unroll
            for (int m = 0; m < 4; ++m) {
                bf16_t* rowp = O + (size_t)(row0 + ai * HALF + m * 16) * DFF + col0;
#pragma unroll
                for (int bj = 0; bj < 2; ++bj) {
                    f32x4 v0 = acc[ai][bj][m][0] + bv[bj][0], v1 = acc[ai][bj][m][1] + bv[bj][1];
                    v0 = __builtin_elementwise_max(v0, (f32x4){0.f, 0.f, 0.f, 0.f}); v1 = __builtin_elementwise_max(v1, (f32x4){0.f, 0.f, 0.f, 0.f});
                    v0 = v0 * v0; v1 = v1 * v1;
                    u32x4 w; w.x = cvt_pk_bf16(v0[0], v0[1]); w.y = cvt_pk_bf16(v0[2], v0[3]); w.z = cvt_pk_bf16(v1[0], v1[1]); w.w = cvt_pk_bf16(v1[2], v1[3]);
                    *(u32x4*)(rowp + bj * HALF) = w;
                }
            }
    }
};
}
namespace pg8 {
template <class Epi, class Sched, bool ALIGN_EPI = false, bool SP2 = false>
__device__ __forceinline__ void gemm_phase(PG8_LAS unsigned char* lds, const Gemm g, const Sched& S, const Epi& E) {
    const int tid = threadIdx.x, wid = __builtin_amdgcn_readfirstlane(tid >> 6), lane = tid & 63, wr = wid >> 2, wc = wid & 3, fr = lane & 15, fq = lane >> 4;
    const int K = g.K, nt = K / BK;
    unsigned voffA[2], voffB[2];
#pragma unroll
    for (int i = 0; i < 2; ++i) { int R, C; stage_rc(tid * 16 + i * 8192, R, C); const int Rb = Epi::PERM ? ((R & ~31) + perm32(R & 31)) : R;
        voffA[i] = (unsigned)(R * K + C) * 2u; voffB[i] = (unsigned)(Rb * K + C) * 2u; }
    const size_t kstep = (size_t)(BK * 2);
    const size_t hstep = (size_t)HALF * K * 2;
    const size_t tstep = 2 * hstep;
    const unsigned ldsw = (unsigned)wid * 1024u;
    const int aoff = lds_byte(wr * 64 + fr, fq * 8), boff = lds_byte(wc * 32 + fr, fq * 8);
#define PG8_SA(b, h) (((b) * 2 + (h)) * HTB)
#define PG8_SB(b, h) ((4 + (b) * 2 + (h)) * HTB)
#define PG8_STAGE(bufoff, gbase, voff) do { _Pragma("unroll") for (int _i = 0; _i < 2; ++_i) \
        __builtin_amdgcn_global_load_lds((const unsigned*)((const char*)(gbase) + (voff)[_i]), (PG8_LAS unsigned*)(lds + (bufoff) + ldsw + _i * 8192), 16, 0, 0); } while (0)
#define PG8_LDA(dst, b, h) do { _Pragma("unroll") for (int m = 0; m < 4; ++m) _Pragma("unroll") for (int k = 0; k < 2; ++k) dst[m][k] = *(const PG8_LAS bf16x8*)(lds + PG8_SA(b, h) + aoff + m * 2048 + k * 1024); } while (0)
#define PG8_LDB(dst, b, h) do { _Pragma("unroll") for (int n = 0; n < 2; ++n) _Pragma("unroll") for (int k = 0; k < 2; ++k) dst[n][k] = *(const PG8_LAS bf16x8*)(lds + PG8_SB(b, h) + boff + n * 2048 + k * 1024); } while (0)
#define PG8_MMA(ai, bj, At, Bt) do { __builtin_amdgcn_s_setprio(1); _Pragma("unroll") for (int m = 0; m < 4; ++m) _Pragma("unroll") for (int n = 0; n < 2; ++n) _Pragma("unroll") for (int k = 0; k < 2; ++k) \
        acc[ai][bj][m][n] = __builtin_amdgcn_mfma_f32_16x16x32_bf16(Bt[n][k], At[m][k], acc[ai][bj][m][n], 0, 0, 0); __builtin_amdgcn_s_setprio(0); } while (0)
#define PG8_WAIT_V(n) asm volatile("s_waitcnt vmcnt(" #n ")" ::: "memory")
#define PG8_WAIT_L(n) asm volatile("s_waitcnt lgkmcnt(" #n ")" ::: "memory")
#define PG8_BAR __builtin_amdgcn_s_barrier()
#define PG8_SCHED __builtin_amdgcn_sched_barrier(0)
    Unit cur, nxt; int ui = 0;
    if (!S.next(0, cur)) return;
    f32x4 acc[2][2][4][2];
#pragma unroll
    for (int a = 0; a < 2; ++a)
#pragma unroll
        for (int b = 0; b < 2; ++b)
#pragma unroll
            for (int m = 0; m < 4; ++m)
#pragma unroll
                for (int n = 0; n < 2; ++n) acc[a][b][m][n] = (f32x4){0.f, 0.f, 0.f, 0.f};
    bf16x8 At[4][2], B0[2][2], B1[2][2];
    const char* cA = (const char*)g.A + (size_t)cur.pm * tstep; const char* cB = (const char*)g.Bt + (size_t)cur.pn * tstep;
    S.a_ready(cur);
    if constexpr (SP2) {
        PG8_STAGE(PG8_SB(0, 0), cB, voffB); PG8_STAGE(PG8_SB(0, 1), cB + hstep, voffB); PG8_STAGE(PG8_SA(0, 0), cA, voffA); PG8_STAGE(PG8_SA(0, 1), cA + hstep, voffA);
        if (wr == 1) PG8_BAR;
        PG8_WAIT_V(2); PG8_BAR;
        PG8_STAGE(PG8_SB(1, 0), cB + kstep, voffB); PG8_STAGE(PG8_SA(1, 0), cA + kstep, voffA); PG8_STAGE(PG8_SB(1, 1), cB + hstep + kstep, voffB);
        PG8_WAIT_V(6); PG8_BAR;
    } else {
        PG8_STAGE(PG8_SB(0, 0), cB, voffB); PG8_STAGE(PG8_SA(0, 0), cA, voffA); PG8_STAGE(PG8_SB(0, 1), cB + hstep, voffB); PG8_STAGE(PG8_SA(0, 1), cA + hstep, voffA);
        if (wr == 1) PG8_BAR;
        PG8_WAIT_V(4); PG8_BAR;
        PG8_STAGE(PG8_SB(1, 0), cB + kstep, voffB); PG8_STAGE(PG8_SA(1, 0), cA + kstep, voffA); PG8_STAGE(PG8_SB(1, 1), cB + hstep + kstep, voffB);
        PG8_WAIT_V(6); PG8_BAR;
    }
    for (;;) {
        const bool has_next = S.next(ui + 1, nxt);
        const char* nA = has_next ? (const char*)g.A + (size_t)nxt.pm * tstep : cA; const char* nB = has_next ? (const char*)g.Bt + (size_t)nxt.pn * tstep : cB;
        for (int t = 0; t < nt; t += 2) {
            const bool last = (t == nt - 2);
            const char* a1 = cA + (size_t)(t + 1) * kstep;
            const char* a2 = last ? nA : cA + (size_t)(t + 2) * kstep; const char* b2 = last ? nB : cB + (size_t)(t + 2) * kstep;
            const char* a3 = a2 + kstep; const char* b3 = b2 + kstep;
            if (last && has_next) S.a_ready(nxt);
            if constexpr (Epi::MID) { if (t == (nt >> 1)) E.mid(acc, cur, wr, wc, fr, fq); }
            if constexpr (SP2) {
            PG8_LDB(B0, 0, 0); PG8_LDB(B1, 0, 1); PG8_SCHED; PG8_LDA(At, 0, 0); PG8_STAGE(PG8_SA(1, 1), a1 + hstep, voffA);
            PG8_WAIT_V(8); PG8_WAIT_L(0); PG8_BAR; PG8_MMA(0, 0, At, B0); PG8_MMA(0, 1, At, B1); PG8_BAR; PG8_SCHED;
            PG8_LDA(At, 0, 1); PG8_STAGE(PG8_SB(0, 0), b2, voffB); PG8_STAGE(PG8_SB(0, 1), b2 + hstep, voffB); PG8_STAGE(PG8_SA(0, 0), a2, voffA);
            PG8_WAIT_V(8); PG8_WAIT_L(0); PG8_BAR; PG8_MMA(1, 0, At, B0); PG8_MMA(1, 1, At, B1); PG8_BAR; PG8_SCHED;
            PG8_LDB(B0, 1, 0); PG8_LDB(B1, 1, 1); PG8_SCHED; PG8_LDA(At, 1, 0); PG8_STAGE(PG8_SA(0, 1), a2 + hstep, voffA);
            PG8_WAIT_V(8); PG8_WAIT_L(0); PG8_BAR; PG8_MMA(0, 0, At, B0); PG8_MMA(0, 1, At, B1); PG8_BAR; PG8_SCHED;
            PG8_LDA(At, 1, 1); PG8_STAGE(PG8_SB(1, 0), b3, voffB); PG8_STAGE(PG8_SB(1, 1), b3 + hstep, voffB); PG8_STAGE(PG8_SA(1, 0), a3, voffA);
            PG8_WAIT_V(8); PG8_WAIT_L(0); PG8_BAR; PG8_MMA(1, 0, At, B0); PG8_MMA(1, 1, At, B1); PG8_BAR; PG8_SCHED;
            } else {
            PG8_LDB(B0, 0, 0); PG8_SCHED; PG8_LDA(At, 0, 0); PG8_STAGE(PG8_SA(1, 1), a1 + hstep, voffA);
            PG8_WAIT_L(8); PG8_BAR; PG8_WAIT_L(0); PG8_MMA(0, 0, At, B0); PG8_BAR; PG8_SCHED;
            PG8_LDB(B1, 0, 1); PG8_STAGE(PG8_SB(0, 0), b2, voffB);
            PG8_BAR; PG8_WAIT_L(0); PG8_MMA(0, 1, At, B1); PG8_BAR;
            PG8_LDA(At, 0, 1); PG8_STAGE(PG8_SA(0, 0), a2, voffA);
            PG8_BAR; PG8_WAIT_L(0); PG8_MMA(1, 0, At, B0); PG8_BAR; PG8_SCHED;
            PG8_STAGE(PG8_SB(0, 1), b2 + hstep, voffB);
            PG8_WAIT_V(6); PG8_BAR; PG8_MMA(1, 1, At, B1); PG8_BAR;
            PG8_LDB(B0, 1, 0); PG8_SCHED; PG8_LDA(At, 1, 0); PG8_STAGE(PG8_SA(0, 1), a2 + hstep, voffA);
            PG8_WAIT_L(8); PG8_BAR; PG8_WAIT_L(0); PG8_MMA(0, 0, At, B0); PG8_BAR; PG8_SCHED;
            PG8_LDB(B1, 1, 1); PG8_STAGE(PG8_SB(1, 0), b3, voffB);
            PG8_BAR; PG8_WAIT_L(0); PG8_MMA(0, 1, At, B1); PG8_BAR;
            PG8_LDA(At, 1, 1); PG8_STAGE(PG8_SA(1, 0), a3, voffA);
            PG8_BAR; PG8_WAIT_L(0); PG8_MMA(1, 0, At, B0); PG8_BAR; PG8_SCHED;
            PG8_STAGE(PG8_SB(1, 1), b3 + hstep, voffB);
            PG8_WAIT_V(6); PG8_BAR; PG8_MMA(1, 1, At, B1); PG8_BAR;
            }
        }
        if constexpr (ALIGN_EPI) { if (wr == 0) PG8_BAR; }
        if constexpr (!Epi::AFTER_DRAIN) { E(acc, cur, wr, wc, fr, fq); S.done(cur); }
        if (!has_next) break;
#pragma unroll
        for (int a = 0; a < 2; ++a)
#pragma unroll
            for (int b = 0; b < 2; ++b)
#pragma unroll
                for (int m = 0; m < 4; ++m)
#pragma unroll
                    for (int n = 0; n < 2; ++n) acc[a][b][m][n] = (f32x4){0.f, 0.f, 0.f, 0.f};
        cur = nxt; cA = nA; cB = nB; ++ui;
        if constexpr (ALIGN_EPI) { if (wr == 1) PG8_BAR; }
    }
    PG8_WAIT_V(0);
    if constexpr (!ALIGN_EPI) { if (wr == 0) PG8_BAR; }
    PG8_BAR;
    if constexpr (Epi::AFTER_DRAIN) { E.fused(acc, cur, wr, wc, fr, fq, lds, wid, lane); S.done(cur); }
#undef PG8_SA
#undef PG8_SB
#undef PG8_STAGE
#undef PG8_LDA
#undef PG8_LDB
#undef PG8_MMA
#undef PG8_WAIT_V
#undef PG8_WAIT_L
#undef PG8_BAR
#undef PG8_SCHED
}
}

constexpr size_t MiB = 1u << 20;
constexpr size_t WS_CTL = 0;
constexpr size_t WS_MOD = 1 * MiB;
constexpr size_t WS_STV = 2 * MiB;
constexpr size_t WS_ST1 = 4 * MiB;
constexpr size_t WS_ST2 = 8 * MiB;
constexpr size_t WS_MU1 = 12 * MiB;
constexpr size_t WS_SGW = 13 * MiB;
constexpr size_t WS_WIN = 16 * MiB;
constexpr size_t WS_WAB = 52 * MiB;
constexpr size_t WS_WO = 60 * MiB;
constexpr size_t WS_FILT = 68 * MiB;
constexpr size_t WS_WM2 = 68 * MiB;
constexpr size_t WS_H = 100 * MiB;
constexpr size_t WS_U = 164 * MiB;
constexpr size_t WS_V = 196 * MiB;
constexpr size_t WS_MERGED = 164 * MiB;
constexpr size_t WS_ZHT = 228 * MiB;
constexpr size_t WS_G = 324 * MiB;
constexpr size_t WS_AFF = 164 * MiB;
constexpr size_t WS_WM1 = 420 * MiB;
constexpr size_t WS_END = 452 * MiB;

constexpr int NWAVES = 8;
constexpr int LDS_BYTES = 147456;

#define GAS __attribute__((address_space(1)))
#define LAS __attribute__((address_space(3)))
typedef unsigned short bf16;
typedef unsigned v4u __attribute__((ext_vector_type(4)));
typedef unsigned v2u __attribute__((ext_vector_type(2)));
typedef float f32x4 __attribute__((ext_vector_type(4)));
typedef float f32x2 __attribute__((ext_vector_type(2)));
#define LDS_WAIT() asm volatile("s_waitcnt lgkmcnt(0)" ::: "memory")

__device__ __forceinline__ unsigned f2bf(float f) { unsigned u = __builtin_bit_cast(unsigned, f); return (u + 0x7fffu + ((u >> 16) & 1u)) >> 16; }
__device__ __forceinline__ unsigned pk2(float lo, float hi) { return f2bf(lo) | (f2bf(hi) << 16); }
__device__ __forceinline__ float bflo(unsigned w) { return __uint_as_float(w << 16); }
__device__ __forceinline__ float bfhi(unsigned w) { return __uint_as_float(w & 0xffff0000u); }
__device__ __forceinline__ float bf1(bf16 h) { return __uint_as_float((unsigned)h << 16); }
__device__ __forceinline__ float wave_sum(float v) {
#pragma unroll
    for (int o = 1; o < 64; o <<= 1) v += __shfl_xor(v, o);
    return v;
}

struct Args { const float* in[31]; float* out; unsigned char* ws; int ph_lo, ph_hi; };

struct Frame {
    LAS unsigned char* lds;
    int tid, lane, wave, G;
    const float* const* in; float* out; unsigned char* ws;
};
enum { I_X = 0, I_C, I_WADA, I_BADA, I_WIN, I_BIN, I_SLNG, I_SLNB, I_SW, I_SB, I_HCW, I_HCB, I_HW1, I_HB1, I_HW2, I_HB2, I_HFREQ, I_HW3, I_HSKIP,
       I_WA, I_WB, I_WO, I_BO, I_LN1G, I_LN1B, I_WM1, I_BM1, I_WM2, I_BM2, I_LN2G, I_LN2B };

__device__ __forceinline__ void transpose_item(const float* W, int N, bf16* WT, int ldk, int koff, int n0, int row0, int k0, LAS float* scr, int lane) {
#pragma unroll 8
    for (int i = 0; i < 32; ++i) { const int kk = 2 * i + (lane >> 5); scr[kk * 33 + (lane & 31)] = W[(size_t)(k0 + kk) * N + n0 + (lane & 31)]; }
    LDS_WAIT(); asm volatile("" ::: "memory");
    const int c = lane & 7;
#pragma unroll
    for (int j = 0; j < 4; ++j) { const int n = (lane >> 3) + 8 * j; const LAS float* s = scr + (8 * c) * 33 + n;
        v4u o; o.x = pk2(s[0 * 33], s[1 * 33]); o.y = pk2(s[2 * 33], s[3 * 33]); o.z = pk2(s[4 * 33], s[5 * 33]); o.w = pk2(s[6 * 33], s[7 * 33]);
        *(GAS v4u*)(WT + (size_t)(row0 + n) * ldk + koff + k0 + 8 * c) = o; }
    LDS_WAIT(); asm volatile("" ::: "memory");
}
__device__ __forceinline__ void transpose_matrix(Frame& F, const float* W, int K, int N, bf16* WT, int ldk, int koff, int remap_win, int gw, int NGW) {
    LAS float* scr = (LAS float*)(F.lds + F.wave * 16384);
    const int nblk = N / 32, nitems = (K / 64) * nblk;
    for (int it = gw; it < nitems; it += NGW) {
        const int kb = it / nblk, nb = it % nblk, n0 = nb * 32; int row0 = n0;
        if (remap_win) row0 = (n0 < 1024) ? n0 : (n0 < 2048 ? n0 - 1024 + 5120 : (n0 < 5120 ? n0 - 2048 + 6144 : n0 - 5120 + 1024));
        transpose_item(W, N, WT, ldk, koff, n0, row0, kb * 64, scr, F.lane);
    }
}

__device__ __forceinline__ void p0_mod(Frame& F) {
    LAS float* condS = (LAS float*)F.lds;
    LAS float* red = (LAS float*)(F.lds + 65536);
    const float* c = F.in[I_C]; const float* w_ada = F.in[I_WADA]; const float* b_ada = F.in[I_BADA];
    float* mod = (float*)(F.ws + WS_MOD);
    const int tid = F.tid;
    for (int item = blockIdx.x; item < MODW / 64; item += F.G) {
        for (int i = tid; i < NBATCH * DM; i += NWAVES * 64) { const float v = c[i]; condS[i] = v / (1.0f + __expf(-v)); }
        __syncthreads();
        const int cq = tid & 15, kq = tid >> 4, col0 = item * 64;
        f32x4 acc[8];
#pragma unroll
        for (int b = 0; b < 8; ++b) acc[b] = (f32x4){0.f, 0.f, 0.f, 0.f};
        const float* wp = w_ada + (size_t)kq * MODW + col0 + cq * 4;
        for (int k = kq; k < DM; k += 32, wp += (size_t)32 * MODW) {
            const f32x4 w = *(const f32x4*)wp;
#pragma unroll
            for (int b = 0; b < 8; ++b) acc[b] += w * condS[b * DM + k];
        }
#pragma unroll
        for (int b = 0; b < 8; ++b) *(LAS f32x4*)(red + (kq * 8 + b) * 64 + cq * 4) = acc[b];
        __syncthreads();
        { const int b = tid >> 6, col = tid & 63; float s = 0.f;
#pragma unroll 8
          for (int k2 = 0; k2 < 32; ++k2) s += red[(k2 * 8 + b) * 64 + col];
          mod[(size_t)b * MODW + col0 + col] = s + b_ada[col0 + col]; }
        __syncthreads();
    }
}

__device__ __forceinline__ void p0_filter(Frame& F) {
    LAS float* featS = (LAS float*)F.lds;
    LAS float* h1S = featS + 8 * 64;
    LAS float* h2S = h1S + 8 * 64;
    const float* w1 = F.in[I_HW1]; const float* b1 = F.in[I_HB1]; const float* w2 = F.in[I_HW2]; const float* b2 = F.in[I_HB2];
    const float* freq = F.in[I_HFREQ]; const float* w3 = F.in[I_HW3];
    float* FILT = (float*)(F.ws + WS_FILT);
    const int tid = F.tid, lane = F.lane, wave = F.wave;
    const float min_decay = -3.0701134573253943f, max_decay = -15.350567286626972f;
    for (int item = blockIdx.x; item < SEQ / 8; item += F.G) {
        const int l = item * 8 + wave;
        const float tl = (float)l / (float)(SEQ - 1), omega = 6.283185307179586f * (float)l / (float)SEQ;
        float f = 0.f;
        if (lane == 0) f = tl;
        else if (lane <= 16) { const float band = 1e-4f + (float)(lane - 1) * ((15.0f - 1e-4f) / 15.0f); f = cosf(band * omega); }
        else if (lane <= 32) { const float band = 1e-4f + (float)(lane - 17) * ((15.0f - 1e-4f) / 15.0f); f = -sinf(band * omega); }
        featS[wave * 64 + lane] = f;
        __syncthreads();
        float a = b1[lane];
        for (int i = 0; i < 33; ++i) a += featS[wave * 64 + i] * w1[i * 64 + lane];
        h1S[wave * 64 + lane] = sinf(freq[lane] * a);
        __syncthreads();
        a = b2[lane];
        for (int i = 0; i < 64; ++i) a += h1S[wave * 64 + i] * w2[i * 64 + lane];
        h2S[wave * 64 + lane] = sinf(freq[lane] * a);
        __syncthreads();
        for (int jj = 0; jj < 8; ++jj) {
            const int j = tid + 512 * jj;
            float acc[8];
#pragma unroll
            for (int p = 0; p < 8; ++p) acc[p] = 0.f;
            for (int i = 0; i < 64; ++i) { const float w = w3[(size_t)i * 4096 + j];
#pragma unroll
                for (int p = 0; p < 8; ++p) acc[p] += h2S[p * 64 + i] * w; }
            const int ch = j & 1023; const float delta = fabsf(min_decay + (float)ch * ((max_decay - min_decay) / 1023.0f));
#pragma unroll
            for (int p = 0; p < 8; ++p) { const float tp = (float)(item * 8 + p) / (float)(SEQ - 1); acc[p] *= expf(-tp * delta); }
            float* o = FILT + (size_t)j * SEQ + item * 8;
            *(f32x4*)o = (f32x4){acc[0], acc[1], acc[2], acc[3]}; *(f32x4*)(o + 4) = (f32x4){acc[4], acc[5], acc[6], acc[7]};
        }
        __syncthreads();
    }
}

__device__ __forceinline__ void p1_modulate(Frame& F) {
    const float* x = F.in[I_X]; const float* mod = (const float*)(F.ws + WS_MOD); bf16* H = (bf16*)(F.ws + WS_H);
    const size_t nvec = (size_t)MTOK * DM / 8, stride = (size_t)F.G * NWAVES * 64;
    for (size_t i = (size_t)blockIdx.x * (NWAVES * 64) + F.tid; i < nvec; i += stride) {
        const int row = (int)(i >> 8), col = (int)(i & 255) * 8, b = row >> 11;
        const f32x4 x0 = *(const f32x4*)(x + (size_t)row * DM + col), x1 = *(const f32x4*)(x + (size_t)row * DM + col + 4);
        const float* mp = mod + (size_t)b * MODW + col;
        const f32x4 sh0 = *(const f32x4*)mp, sh1 = *(const f32x4*)(mp + 4), sc0 = *(const f32x4*)(mp + DM), sc1 = *(const f32x4*)(mp + DM + 4);
        const f32x4 h0 = x0 * (sc0 + 1.0f) + sh0, h1 = x1 * (sc1 + 1.0f) + sh1;
        v4u o; o.x = pk2(h0[0], h0[1]); o.y = pk2(h0[2], h0[3]); o.z = pk2(h1[0], h1[1]); o.w = pk2(h1[2], h1[3]);
        *(v4u*)(H + (size_t)row * DM + col) = o;
    }
}

typedef short sg_bf16x8 __attribute__((ext_vector_type(8)));
typedef float sg_f32x16 __attribute__((ext_vector_type(16)));
constexpr int SG_VT = 0, SG_LD = 136, SG_ST = 36864;
__device__ __forceinline__ void p3_sgu(Frame& F) {
    LAS bf16* vnT = (LAS bf16*)(F.lds + SG_VT); LAS float* stS = (LAS float*)(F.lds + SG_ST);
    const bf16* U = (const bf16*)(F.ws + WS_U); const bf16* VT = (const bf16*)(F.ws + WS_V); bf16* AB = (bf16*)(F.ws + WS_H);
    const bf16* Wb = (const bf16*)(F.ws + WS_SGW); const float* stv = (const float*)(F.ws + WS_STV);
    const float* lng = F.in[I_SLNG]; const float* lnb = F.in[I_SLNB]; const float* sb = F.in[I_SB];
    const int tid = F.tid, lane = F.lane, w = F.wave, r = lane & 31, h = lane >> 5;
    for (int item = blockIdx.x; item < 1024; item += F.G) {
        const int b = item >> 7, n = (item >> 3) & 15, g = item & 7, tok0 = b * SEQ + n * 128;
        if (tid < 128) { float s = 0.f, q = 0.f; const float* sp = stv + (size_t)(tok0 + tid) * 32;
#pragma unroll
            for (int i = 0; i < 16; ++i) { const f32x2 pr = *(const f32x2*)(sp + 2 * i); s += pr.x; q += pr.y; }
            const float mean = s * (1.0f / 1024.0f); float var = q * (1.0f / 1024.0f) - mean * mean; var = var > 0.f ? var : 0.f;
            *(LAS f32x2*)(stS + 2 * tid) = (f32x2){mean, 1.0f / sqrtf(var + LN_EPS)}; }
        __syncthreads();
        { const int c = tid >> 2, pseg = (tid & 3) * 32, ch = g * 128 + c; const float gg = lng[ch], bb = lnb[ch];
          const bf16* vp = VT + (size_t)ch * MTOK + tok0 + pseg;
          v4u wv[4];
#pragma unroll
          for (int k = 0; k < 4; ++k) wv[k] = *(const v4u*)(vp + 8 * k);
#pragma unroll
          for (int k = 0; k < 4; ++k) {
              const float e[8] = {bflo(wv[k].x), bfhi(wv[k].x), bflo(wv[k].y), bfhi(wv[k].y), bflo(wv[k].z), bfhi(wv[k].z), bflo(wv[k].w), bfhi(wv[k].w)};
              float o[8];
#pragma unroll
              for (int i = 0; i < 8; i += 2) { const f32x4 st = *(const LAS f32x4*)(stS + 2 * (pseg + 8 * k + i));
                  o[i] = (e[i] - st[0]) * st[1] * gg + bb; o[i + 1] = (e[i + 1] - st[2]) * st[3] * gg + bb; }
              v4u pk; pk.x = pk2(o[0], o[1]); pk.y = pk2(o[2], o[3]); pk.z = pk2(o[4], o[5]); pk.w = pk2(o[6], o[7]);
              *(LAS v4u*)(vnT + c * SG_LD + pseg + 8 * k) = pk; } }
        const int q0 = 32 * (w >> 1), ct0 = 2 * (w & 1);
        sg_bf16x8 af[8];
#pragma unroll
        for (int kk = 0; kk < 8; ++kk) af[kk] = *(const sg_bf16x8*)(Wb + (size_t)(g * 128 + q0 + r) * 128 + 16 * kk + 8 * h);
        __syncthreads();
        sg_f32x16 acc[2];
#pragma unroll
        for (int ct = 0; ct < 2; ++ct)
#pragma unroll
            for (int i = 0; i < 16; ++i) acc[ct][i] = 0.f;
#pragma unroll
        for (int kk = 0; kk < 8; ++kk)
#pragma unroll
            for (int ct = 0; ct < 2; ++ct) {
                const sg_bf16x8 bf = *(const LAS sg_bf16x8*)(vnT + ((ct0 + ct) * 32 + r) * SG_LD + 16 * kk + 8 * h);
                acc[ct] = __builtin_amdgcn_mfma_f32_32x32x16_bf16(af[kk], bf, acc[ct], 0, 0, 0);
            }
#pragma unroll
        for (int ct = 0; ct < 2; ++ct) {
            const int c = (ct0 + ct) * 32 + r;
#pragma unroll
            for (int rg = 0; rg < 16; ++rg) {
                const int q = q0 + (rg & 3) + 8 * (rg >> 2) + 4 * h;
                const float uv = bf1(U[(size_t)(tok0 + q) * SGUW + g * 128 + c]);
                AB[(size_t)(tok0 + q) * DM + g * 128 + c] = (bf16)f2bf(uv * (acc[ct][rg] + sb[g * 128 + q]));
            }
        }
        __syncthreads();
    }
}

__device__ __forceinline__ float sconv(const bf16* ZHT, const float* cw, const float* cb, int ch, int b, int t) {
    const bf16* zp = ZHT + (size_t)ch * MTOK + b * SEQ;
    const float z0 = t > 0 ? bf1(zp[t - 1]) : 0.f, z1 = bf1(zp[t]), z2 = t < SEQ - 1 ? bf1(zp[t + 1]) : 0.f;
    return cw[ch] * z0 + cw[3072 + ch] * z1 + cw[6144 + ch] * z2 + cb[ch];
}
__device__ __forceinline__ void p3_hyena(Frame& F) {
    LAS float* Us = (LAS float*)F.lds;
    LAS float* KF = (LAS float*)(F.lds + 65536);
    const bf16* ZHT = (const bf16*)(F.ws + WS_ZHT); const float* FILT = (const float*)(F.ws + WS_FILT); bf16* AB = (bf16*)(F.ws + WS_H);
    const float* cw = F.in[I_HCW]; const float* cb = F.in[I_HCB]; const float* skip = F.in[I_HSKIP];
    const int tid = F.tid;
    for (int item = blockIdx.x; item < HYW; item += F.G) {
        const int c = item;
        for (int i = tid; i < NBATCH * SEQ; i += NWAVES * 64) { const int b = i >> 11, t = i & 2047; Us[t * 8 + b] = sconv(ZHT, cw, cb, c, b, t); }
        for (int n = 0; n < 2; ++n) {
            const float* hf = FILT + (size_t)((0 * 2 + n) * 1024 + c) * SEQ; const float* hb = FILT + (size_t)((1 * 2 + n) * 1024 + c) * SEQ;
            for (int i = tid; i < 4095; i += NWAVES * 64) { const int lag = i - 2047; KF[i] = lag > 0 ? hf[lag] : (lag == 0 ? hf[0] + hb[0] : hb[-lag]); }
            __syncthreads();
            f32x4 acc[4][2];
#pragma unroll
            for (int ti = 0; ti < 4; ++ti) { acc[ti][0] = (f32x4){0.f, 0.f, 0.f, 0.f}; acc[ti][1] = (f32x4){0.f, 0.f, 0.f, 0.f}; }
            const LAS float* kp = KF + tid + 2047;
            for (int s = 0; s < SEQ; ++s) {
                const f32x4 u0 = *(const LAS f32x4*)(Us + s * 8), u1 = *(const LAS f32x4*)(Us + s * 8 + 4);
#pragma unroll
                for (int ti = 0; ti < 4; ++ti) { const float kv = kp[512 * ti - s]; acc[ti][0] += u0 * kv; acc[ti][1] += u1 * kv; }
            }
            __syncthreads();
            const float sk = skip[n * 1024 + c];
#pragma unroll
            for (int ti = 0; ti < 4; ++ti) { const int t = tid + 512 * ti;
#pragma unroll
                for (int b = 0; b < 8; ++b) {
                    const float uv = Us[t * 8 + b], gate = sconv(ZHT, cw, cb, (n + 1) * 1024 + c, b, t);
                    const float y = gate * (acc[ti][b >> 2][b & 3] + sk * uv);
                    if (n == 0) Us[t * 8 + b] = y; else AB[(size_t)(b * SEQ + t) * DM + 1024 + c] = (bf16)f2bf(y);
                } }
            __syncthreads();
        }
    }
}

#ifndef HYFFT_HD
#define HYFFT_HD __device__ __forceinline__
#define HYFFT_LAS __attribute__((address_space(3)))
#endif
typedef float hy_c32 __attribute__((ext_vector_type(2)));
HYFFT_HD int hy_padi(int i) { return i + (i >> 3); }
HYFFT_HD int hy_rev(int x) { return ((x & 7) << 9) | (((x >> 3) & 7) << 6) | (((x >> 6) & 7) << 3) | ((x >> 9) & 7); }

template <bool INV> HYFFT_HD void hy_dft8(float (&re)[8], float (&im)[8]) {
    const float h = 0.70710678118654752f;
    float ar[4], ai[4], br[4], bi[4];
#pragma unroll
    for (int m = 0; m < 4; ++m) { ar[m] = re[m] + re[m + 4]; ai[m] = im[m] + im[m + 4]; br[m] = re[m] - re[m + 4]; bi[m] = im[m] - im[m + 4]; }
    { float x = br[1], y = bi[1]; if (!INV) { br[1] = h * (x + y); bi[1] = h * (y - x); } else { br[1] = h * (x - y); bi[1] = h * (y + x); } }
    { float x = br[2], y = bi[2]; if (!INV) { br[2] = y; bi[2] = -x; } else { br[2] = -y; bi[2] = x; } }
    { float x = br[3], y = bi[3]; if (!INV) { br[3] = h * (y - x); bi[3] = -h * (x + y); } else { br[3] = -h * (x + y); bi[3] = h * (x - y); } }
#pragma unroll
    for (int s = 0; s < 2; ++s) {
        float* cr = s ? br : ar; float* ci = s ? bi : ai;
        const float e0r = cr[0] + cr[2], e0i = ci[0] + ci[2], e1r = cr[0] - cr[2], e1i = ci[0] - ci[2];
        const float o0r = cr[1] + cr[3], o0i = ci[1] + ci[3]; const float dr = cr[1] - cr[3], di = ci[1] - ci[3];
        float o1r, o1i; if (!INV) { o1r = di; o1i = -dr; } else { o1r = -di; o1i = dr; }
        re[0 + s] = e0r + o0r; im[0 + s] = e0i + o0i;
        re[2 + s] = e1r + o1r; im[2 + s] = e1i + o1i;
        re[4 + s] = e0r - o0r; im[4 + s] = e0i - o0i;
        re[6 + s] = e1r - o1r; im[6 + s] = e1i - o1i;
    }
}
template <bool CONJ> HYFFT_HD void hy_twiddle(float (&re)[8], float (&im)[8], float wr, float wi) {
    if (CONJ) wi = -wi;
    const float w2r = wr * wr - wi * wi, w2i = 2.f * wr * wi;
    const float w3r = w2r * wr - w2i * wi, w3i = w2r * wi + w2i * wr;
    const float w4r = w2r * w2r - w2i * w2i, w4i = 2.f * w2r * w2i;
    const float w5r = w4r * wr - w4i * wi, w5i = w4r * wi + w4i * wr;
    const float w6r = w3r * w3r - w3i * w3i, w6i = 2.f * w3r * w3i;
    const float w7r = w4r * w3r - w4i * w3i, w7i = w4r * w3i + w4i * w3r;
    const float pr[8] = {1.f, wr, w2r, w3r, w4r, w5r, w6r, w7r}, pi[8] = {0.f, wi, w2i, w3i, w4i, w5i, w6i, w7i};
#pragma unroll
    for (int k = 1; k < 8; ++k) { const float x = re[k], y = im[k]; re[k] = x * pr[k] - y * pi[k]; im[k] = x * pi[k] + y * pr[k]; }
}
template <int L, class BP, class TP> HYFFT_HD void hy_fwd_store(BP buf, TP tw, int j, float (&re)[8], float (&im)[8]) {
    constexpr int S = L / 8; const int blk = j / S, q = j % S, base = blk * L + q;
    hy_dft8<false>(re, im);
    if (L > 8) { const hy_c32 w = tw[q * (4096 / L)]; hy_twiddle<false>(re, im, w.x, w.y); }
#pragma unroll
    for (int k = 0; k < 8; ++k) buf[hy_padi(base + k * S)] = (hy_c32){re[k], im[k]};
}
template <int L, class BP> HYFFT_HD void hy_load8(BP buf, int j, float (&re)[8], float (&im)[8]) {
    constexpr int S = L / 8; const int blk = j / S, q = j % S, base = blk * L + q;
#pragma unroll
    for (int k = 0; k < 8; ++k) { const hy_c32 v = buf[hy_padi(base + k * S)]; re[k] = v.x; im[k] = v.y; }
}
template <int L, class BP, class TP> HYFFT_HD void hy_fwd_stage(BP buf, TP tw, int j) { float re[8], im[8]; hy_load8<L>(buf, j, re, im); hy_fwd_store<L>(buf, tw, j, re, im); }
template <int L, class BP, class TP> HYFFT_HD void hy_inv_regs(BP buf, TP tw, int j, float (&re)[8], float (&im)[8]) {
    constexpr int S = L / 8; const int q = j % S;
    hy_load8<L>(buf, j, re, im);
    if (L > 8) { const hy_c32 w = tw[q * (4096 / L)]; hy_twiddle<true>(re, im, w.x, w.y); }
    hy_dft8<true>(re, im);
}
template <int L, class BP, class TP> HYFFT_HD void hy_inv_stage(BP buf, TP tw, int j) {
    constexpr int S = L / 8; const int blk = j / S, q = j % S, base = blk * L + q;
    float re[8], im[8]; hy_inv_regs<L>(buf, tw, j, re, im);
#pragma unroll
    for (int k = 0; k < 8; ++k) buf[hy_padi(base + k * S)] = (hy_c32){re[k], im[k]};
}
template <class BP, class KP> HYFFT_HD void hy_mid_stage(BP buf, KP K, int j) {
    float re[8], im[8]; hy_load8<8>(buf, j, re, im);
    hy_dft8<false>(re, im);
#pragma unroll
    for (int k = 0; k < 8; ++k) { const hy_c32 kv = K[hy_padi(8 * j + k)]; const float x = re[k], y = im[k]; re[k] = x * kv.x - y * kv.y; im[k] = x * kv.y + y * kv.x; }
    hy_dft8<true>(re, im);
#pragma unroll
    for (int k = 0; k < 8; ++k) buf[hy_padi(8 * j + k)] = (hy_c32){re[k], im[k]};
}
template <class BP> HYFFT_HD void hy_last_fwd(BP buf, int j) {
    float re[8], im[8]; hy_load8<8>(buf, j, re, im); hy_dft8<false>(re, im);
#pragma unroll
    for (int k = 0; k < 8; ++k) buf[hy_padi(8 * j + k)] = (hy_c32){re[k], im[k]};
}
template <class BP, class KP> HYFFT_HD void hy_separate(BP Z, KP K1, KP K2, int j) {
    const float sc = 0.5f / 4096.0f;
#pragma unroll
    for (int r = 0; r < 8; ++r) {
        const int p = j + 512 * r, f = hy_rev(p), g = (4096 - f) & 4095, p2 = hy_rev(g);
        const hy_c32 a = Z[hy_padi(p)], b = Z[hy_padi(p2)];
        K1[hy_padi(p)] = (hy_c32){(a.x + b.x) * sc, (a.y - b.y) * sc};
        K2[hy_padi(p)] = (hy_c32){(a.y + b.y) * sc, (b.x - a.x) * sc};
    }
}

constexpr int HY_BUF = 0, HY_K1 = 36864, HY_K2 = 73728, HY_TW = 110592;
__device__ __forceinline__ float sconv3(const bf16* zp, int t, float w0, float w1, float w2, float cb) {
    const float z0 = t > 0 ? bf1(zp[t - 1]) : 0.f, z1 = bf1(zp[t]), z2 = t < SEQ - 1 ? bf1(zp[t + 1]) : 0.f;
    return w0 * z0 + w1 * z1 + w2 * z2 + cb;
}
__device__ __forceinline__ void p3_hyena_fft(Frame& F) {
    LAS hy_c32* BUF = (LAS hy_c32*)(F.lds + HY_BUF); LAS hy_c32* K1 = (LAS hy_c32*)(F.lds + HY_K1); LAS hy_c32* K2 = (LAS hy_c32*)(F.lds + HY_K2);
    LAS hy_c32* TW = (LAS hy_c32*)(F.lds + HY_TW);
    const bf16* ZHT = (const bf16*)(F.ws + WS_ZHT); const float* FILT = (const float*)(F.ws + WS_FILT); bf16* AB = (bf16*)(F.ws + WS_H);
    const float* cw = F.in[I_HCW]; const float* cb = F.in[I_HCB]; const float* skip = F.in[I_HSKIP];
    const int j = F.tid;
    { float sn, cs; sincosf(-6.283185307179586f * (float)j / 4096.0f, &sn, &cs); TW[j] = (hy_c32){cs, sn}; }
    __syncthreads();
    for (int item = blockIdx.x; item < HYW; item += F.G) {
        const int c = item;
        float re[8], im[8];
        {
            const float* hf0 = FILT + (size_t)(0 * 1024 + c) * SEQ; const float* hf1 = FILT + (size_t)(1 * 1024 + c) * SEQ;
            const float* hb0 = FILT + (size_t)(2 * 1024 + c) * SEQ; const float* hb1 = FILT + (size_t)(3 * 1024 + c) * SEQ;
#pragma unroll
            for (int m = 0; m < 4; ++m) { const int i = j + 512 * m; re[m] = hf0[i]; im[m] = hf1[i]; }
            if (j == 0) { re[0] += hb0[0]; im[0] += hb1[0]; }
#pragma unroll
            for (int m = 4; m < 8; ++m) { const int i = j + 512 * m; const bool z = (i == 2048); const int r = z ? 0 : 4096 - i; const float a = hb0[r], b = hb1[r]; re[m] = z ? 0.f : a; im[m] = z ? 0.f : b; }
            hy_fwd_store<4096>(BUF, TW, j, re, im); __syncthreads();
            hy_fwd_stage<512>(BUF, TW, j); __syncthreads();
            hy_fwd_stage<64>(BUF, TW, j); __syncthreads();
            hy_last_fwd(BUF, j); __syncthreads();
            hy_separate(BUF, K1, K2, j); __syncthreads();
        }
        const float vw0 = cw[c], vw1 = cw[3072 + c], vw2 = cw[6144 + c], vcb = cb[c];
        const float aw0 = cw[1024 + c], aw1 = cw[3072 + 1024 + c], aw2 = cw[6144 + 1024 + c], acb = cb[1024 + c];
        const float bw0 = cw[2048 + c], bw1 = cw[3072 + 2048 + c], bw2 = cw[6144 + 2048 + c], bcb = cb[2048 + c];
        const float sk0 = skip[c], sk1 = skip[1024 + c];
        for (int p = 0; p < 4; ++p) {
            const bf16* zv0 = ZHT + (size_t)c * MTOK + (2 * p) * SEQ; const bf16* zv1 = zv0 + SEQ;
            const bf16* za0 = ZHT + (size_t)(1024 + c) * MTOK + (2 * p) * SEQ; const bf16* za1 = za0 + SEQ;
            const bf16* zb0 = ZHT + (size_t)(2048 + c) * MTOK + (2 * p) * SEQ; const bf16* zb1 = zb0 + SEQ;
            float v0[4], v1[4], g0[4], g1[4];
#pragma unroll
            for (int m = 0; m < 4; ++m) { const int t = j + 512 * m; v0[m] = sconv3(zv0, t, vw0, vw1, vw2, vcb); v1[m] = sconv3(zv1, t, vw0, vw1, vw2, vcb);
                g0[m] = sconv3(za0, t, aw0, aw1, aw2, acb); g1[m] = sconv3(za1, t, aw0, aw1, aw2, acb); }
#pragma unroll
            for (int m = 0; m < 4; ++m) { re[m] = v0[m]; im[m] = v1[m]; re[m + 4] = 0.f; im[m + 4] = 0.f; }
            hy_fwd_store<4096>(BUF, TW, j, re, im); __syncthreads();
            hy_fwd_stage<512>(BUF, TW, j); __syncthreads();
            hy_fwd_stage<64>(BUF, TW, j); __syncthreads();
            hy_mid_stage(BUF, K1, j); __syncthreads();
            hy_inv_stage<64>(BUF, TW, j); __syncthreads();
            hy_inv_stage<512>(BUF, TW, j); __syncthreads();
            hy_inv_regs<4096>(BUF, TW, j, re, im);
#pragma unroll
            for (int m = 0; m < 4; ++m) { v0[m] = g0[m] * (re[m] + sk0 * v0[m]); v1[m] = g1[m] * (im[m] + sk0 * v1[m]); }
#pragma unroll
            for (int m = 0; m < 4; ++m) { const int t = j + 512 * m; g0[m] = sconv3(zb0, t, bw0, bw1, bw2, bcb); g1[m] = sconv3(zb1, t, bw0, bw1, bw2, bcb); }
#pragma unroll
            for (int m = 0; m < 4; ++m) { re[m] = v0[m]; im[m] = v1[m]; re[m + 4] = 0.f; im[m + 4] = 0.f; }
            hy_fwd_store<4096>(BUF, TW, j, re, im); __syncthreads();
            hy_fwd_stage<512>(BUF, TW, j); __syncthreads();
            hy_fwd_stage<64>(BUF, TW, j); __syncthreads();
            hy_mid_stage(BUF, K2, j); __syncthreads();
            hy_inv_stage<64>(BUF, TW, j); __syncthreads();
            hy_inv_stage<512>(BUF, TW, j); __syncthreads();
            hy_inv_regs<4096>(BUF, TW, j, re, im);
#pragma unroll
            for (int m = 0; m < 4; ++m) { const int t = j + 512 * m;
                const float y0 = g0[m] * (re[m] + sk1 * v0[m]), y1 = g1[m] * (im[m] + sk1 * v1[m]);
                AB[(size_t)((2 * p) * SEQ + t) * DM + 1024 + c] = (bf16)f2bf(y0); AB[(size_t)((2 * p + 1) * SEQ + t) * DM + 1024 + c] = (bf16)f2bf(y1); }
        }
        __syncthreads();
    }
}

template <bool FINAL> __device__ __forceinline__ void ln_rows(Frame& F) {
    float* R = F.out; const float* st = (const float*)(F.ws + (FINAL ? WS_ST2 : WS_ST1)); float* MU = (float*)(F.ws + WS_MU1);
    const float* mod = (const float*)(F.ws + WS_MOD); bf16* H2 = (bf16*)(F.ws + WS_H);
    const float* lng = F.in[FINAL ? I_LN2G : I_LN1G]; const float* lnb = F.in[FINAL ? I_LN2B : I_LN1B];
    const int gw = blockIdx.x * NWAVES + F.wave, NGW = F.G * NWAVES, lane = F.lane;
    for (int row = gw; row < MTOK; row += NGW) {
        float s = 0.f, q = 0.f; if (lane < 32) { const f32x2 p = *(const f32x2*)(st + ((size_t)row * 32 + lane) * 2); s = p.x; q = p.y; }
        s = wave_sum(s); q = wave_sum(q);
        const float mean = s * (1.0f / DM); float var = q * (1.0f / DM) - mean * mean; var = var > 0.f ? var : 0.f; const float rstd = 1.0f / sqrtf(var + LN_EPS);
        if (!FINAL && lane == 0) *(f32x2*)(MU + (size_t)row * 2) = (f32x2){mean, rstd};
        const int b = row >> 11; float* rp = R + (size_t)row * DM;
#pragma unroll
        for (int j = 0; j < 8; ++j) { const int col = 4 * lane + 256 * j;
            const f32x4 v = *(const f32x4*)(rp + col); const f32x4 y = (v - mean) * rstd * *(const f32x4*)(lng + col) + *(const f32x4*)(lnb + col);
            if (FINAL) *(f32x4*)(rp + col) = y;
            else { const float* mp = mod + (size_t)b * MODW + col; const f32x4 h = y * (*(const f32x4*)(mp + 4 * DM) + 1.0f) + *(const f32x4*)(mp + 3 * DM);
                   v2u o; o.x = pk2(h[0], h[1]); o.y = pk2(h[2], h[3]); *(v2u*)(H2 + (size_t)row * DM + col) = o; } }
    }
}

typedef GAS unsigned gu32;
#define RLX_AGENT __ATOMIC_RELAXED, __HIP_MEMORY_SCOPE_AGENT
constexpr int LDSCTL_OFF = 131072, MISC_OFF = LDSCTL_OFF + 320;
constexpr int CW_BAR = 4096;
constexpr size_t CTL_ZERO_BYTES = 65536;
#define XB_TMO      128
#define XB_XCNT(j)  (256  + 64 * (j))
#define XB_XSUB(j)  (1280 + 64 * (j))
#define XB_XGEN(j)  (2304 + 64 * (j))
#define XB_TOP      3328
#define XB_TOPGEN   3392
#define XCD_BAR_WORDS 3456
#define XB_SPIN_CAP (1u << 18)

__device__ __forceinline__ unsigned xb_ld(unsigned* p)              { return __hip_atomic_load(p, __ATOMIC_RELAXED, __HIP_MEMORY_SCOPE_AGENT); }
__device__ __forceinline__ unsigned xb_add(unsigned* p, unsigned v) { return __hip_atomic_fetch_add(p, v, __ATOMIC_RELAXED, __HIP_MEMORY_SCOPE_AGENT); }
__device__ __forceinline__ unsigned xb_xcc_id() { return (unsigned)__builtin_amdgcn_s_getreg((3 << 11) | 20) & 0xFu; }
#define XB_SPIN(cond, bar) do { unsigned _sp = 0; while (cond) { __builtin_amdgcn_s_sleep(1); \
    if ((++_sp & 255u) == 0u) { if (xb_ld(&(bar)[XB_TMO])) break; if (_sp > XB_SPIN_CAP) { atomicAdd(&(bar)[XB_TMO], 1u); break; } } } } while (0)

struct XcdBarrier {
    unsigned* bar; unsigned x;
    volatile LAS unsigned* st;
};

__device__ __forceinline__ XcdBarrier xcd_barrier_post(unsigned* bar, volatile LAS unsigned* st) {
    XcdBarrier b; b.bar = bar; b.x = xb_xcc_id(); b.st = st;
    if (threadIdx.x == 0) (void)xb_add(&bar[XB_XCNT(b.x)], 1u);
    return b;
}
__device__ __forceinline__ void xcd_barrier_complete(unsigned* bar, unsigned x, unsigned& nloc, unsigned& nx) {
    const unsigned G = gridDim.x * gridDim.y * gridDim.z;
    unsigned sum, cnt, mine, sp = 0u;
    for (;;) {
        sum = 0u; cnt = 0u; mine = 0u;
#pragma unroll
        for (unsigned j = 0; j < 16; ++j) { const unsigned c = xb_ld(&bar[XB_XCNT(j)]); sum += c; cnt += (c > 0u) ? 1u : 0u; mine = (j == x) ? c : mine; }
        if (sum == G) break;
        __builtin_amdgcn_s_sleep(1);
        if ((++sp & 255u) == 0u) { if (xb_ld(&bar[XB_TMO])) break; if (sp > XB_SPIN_CAP) { atomicAdd(&bar[XB_TMO], 1u); break; } }
    }
    nloc = mine > 0u ? mine : 1u; nx = cnt > 0u ? cnt : 1u;
}

__device__ __forceinline__ void xcd_barrier(const XcdBarrier& b) {
    asm volatile("s_waitcnt vmcnt(0)" ::: "memory");
    __syncthreads();
    if (threadIdx.x == 0) {
        unsigned* bar = b.bar;
        __builtin_amdgcn_s_waitcnt(0);
        unsigned nloc = b.st[0], nx = b.st[1];
        if (nloc == 0u) { xcd_barrier_complete(bar, b.x, nloc, nx); b.st[0] = nloc; b.st[1] = nx; }
        const unsigned old = xb_add(&bar[XB_XSUB(b.x)], 1u);
        const unsigned gen = old / nloc;
        if (old + 1u == (gen + 1u) * nloc) {
            __builtin_amdgcn_fence(__ATOMIC_RELEASE, "agent");
            asm volatile("s_waitcnt vmcnt(0)" ::: "memory");
            const unsigned og = xb_add(&bar[XB_TOP], 1u);
            const unsigned tg = og / nx;
            if (og + 1u == (tg + 1u) * nx) xb_add(&bar[XB_TOPGEN], 1u);
            else XB_SPIN(xb_ld(&bar[XB_TOPGEN]) == tg, bar);
            __builtin_amdgcn_fence(__ATOMIC_ACQUIRE, "agent");
            xb_add(&bar[XB_XGEN(b.x)], 1u);
            asm volatile("s_waitcnt vmcnt(0)" ::: "memory");
        } else {
            XB_SPIN(xb_ld(&bar[XB_XGEN(b.x)]) == gen, bar);
            __builtin_amdgcn_fence(__ATOMIC_ACQUIRE, "agent");
            asm volatile("s_waitcnt vmcnt(0)" ::: "memory");
        }
    }
    __syncthreads();
}

#define GRID_SYNC() xcd_barrier(bar)

__global__ void __launch_bounds__(NWAVES * 64, 2) fwd_megakernel(Args args) {
    extern __shared__ __attribute__((aligned(16))) unsigned char lds[];
    Frame F;
    F.lds = (LAS unsigned char*)lds;
    F.tid = threadIdx.x; F.lane = F.tid & 63; F.wave = __builtin_amdgcn_readfirstlane(F.tid >> 6); F.G = gridDim.x;
    F.in = args.in; F.out = args.out; F.ws = args.ws;
    for (int u = F.tid; u < (LDS_BYTES - LDSCTL_OFF) / 4; u += NWAVES * 64) ((LAS unsigned*)(F.lds + LDSCTL_OFF))[u] = 0u;
    __syncthreads();
    XcdBarrier bar = xcd_barrier_post((unsigned*)(args.ws + WS_CTL) + CW_BAR, (volatile LAS unsigned*)(F.lds + MISC_OFF) + 8);
    unsigned char* ws = args.ws;
    const int lo = args.ph_lo, hi = args.ph_hi;
#define IN(k) (lo <= (k) && (k) < hi)
#define BOTH(k) (IN(k) && IN((k) + 1))
    const int gw = blockIdx.x * NWAVES + F.wave, NGW = F.G * NWAVES;

    if (IN(0)) {
        p0_mod(F);
        transpose_matrix(F, F.in[I_WIN], DM, INW, (bf16*)(ws + WS_WIN), DM, 0, 1, gw, NGW);
        transpose_matrix(F, F.in[I_WA], SGUW, DM, (bf16*)(ws + WS_WAB), DM, 0, 0, gw, NGW);
        transpose_matrix(F, F.in[I_WB], HYW, DM, (bf16*)(ws + WS_WAB), DM, 1024, 0, gw, NGW);
        transpose_matrix(F, F.in[I_WO], DM, DM, (bf16*)(ws + WS_WO), DM, 0, 0, gw, NGW);
        { const float* sw = F.in[I_SW]; bf16* sgw = (bf16*)(ws + WS_SGW);
          for (int i = blockIdx.x * (NWAVES * 64) + F.tid; i < 8 * 128 * 128 / 2; i += F.G * NWAVES * 64) { const f32x2 v = *(const f32x2*)(sw + 2 * i); *(unsigned*)(sgw + 2 * i) = pk2(v.x, v.y); } }
        __syncthreads();
        p0_filter(F);
        if (BOTH(0)) GRID_SYNC();
    }
    if (IN(1)) { p1_modulate(F); if (BOTH(1)) GRID_SYNC(); }
    if (IN(2)) {
        { pg8::Gemm g{(const pg8::bf16_t*)(ws + WS_H), (const pg8::bf16_t*)(ws + WS_WIN), MTOK, 5120, DM}; pg8::StaticOrder S; S.init(MTOK, 5120, F.G, (int)blockIdx.x);
          pg8::EpiG1 E{(pg8::bf16_t*)(ws + WS_U), (pg8::bf16_t*)(ws + WS_G), F.in[I_BIN]};
          pg8::gemm_phase<pg8::EpiG1, pg8::StaticOrder, true, true>(F.lds, g, S, E); }
        __syncthreads();
        { pg8::Gemm g{(const pg8::bf16_t*)(ws + WS_WIN) + (size_t)5120 * DM, (const pg8::bf16_t*)(ws + WS_H), 4096, MTOK, DM}; pg8::StaticOrder S; S.init(4096, MTOK, F.G, (int)blockIdx.x);
          pg8::EpiG1T E{(pg8::bf16_t*)(ws + WS_V), (pg8::bf16_t*)(ws + WS_ZHT), F.in[I_BIN], (float*)(ws + WS_STV)};
          pg8::gemm_phase<pg8::EpiG1T, pg8::StaticOrder, true, true>(F.lds, g, S, E); }
        if (BOTH(2)) GRID_SYNC();
    }
    if (IN(3)) { __syncthreads(); p3_sgu(F); p3_hyena_fft(F); if (BOTH(3)) GRID_SYNC(); }
    if (IN(4)) {
        pg8::Gemm g{(const pg8::bf16_t*)(ws + WS_H), (const pg8::bf16_t*)(ws + WS_WAB), MTOK, DM, DM}; pg8::StaticOrder S; S.init(MTOK, DM, F.G, (int)blockIdx.x);
        pg8::EpiG2 E{(const pg8::bf16_t*)(ws + WS_G), (pg8::bf16_t*)(ws + WS_MERGED)};
        pg8::gemm_phase<pg8::EpiG2, pg8::StaticOrder, true, true>(F.lds, g, S, E);
        if (BOTH(4)) GRID_SYNC();
    }
    if (IN(5)) {
        pg8::Gemm g{(const pg8::bf16_t*)(ws + WS_MERGED), (const pg8::bf16_t*)(ws + WS_WO), MTOK, DM, DM}; pg8::StaticOrder S; S.init(MTOK, DM, F.G, (int)blockIdx.x);
        pg8::EpiRes<true> E{F.in[I_X], F.out, (const float*)(ws + WS_MOD) + 2 * DM, F.in[I_BO], nullptr, nullptr, nullptr, (float*)(ws + WS_ST1)};
        pg8::gemm_phase<pg8::EpiRes<true>, pg8::StaticOrder, true, true>(F.lds, g, S, E);
        if (BOTH(5)) GRID_SYNC();
    }
    if (IN(6)) {
        __syncthreads();
        ln_rows<false>(F);
        transpose_matrix(F, F.in[I_WM1], DM, DFF, (bf16*)(ws + WS_WM1), DM, 0, 0, gw, NGW);
        transpose_matrix(F, F.in[I_WM2], DFF, DM, (bf16*)(ws + WS_WM2), DFF, 0, 0, gw, NGW);
        if (BOTH(6)) GRID_SYNC();
    }
    if (IN(7)) {
        __syncthreads();
        pg8::Gemm g{(const pg8::bf16_t*)(ws + WS_H), (const pg8::bf16_t*)(ws + WS_WM1), MTOK, DFF, DM}; pg8::StaticOrder S; S.init(MTOK, DFF, F.G, (int)blockIdx.x);
        pg8::EpiG4 E{(pg8::bf16_t*)(ws + WS_AFF), F.in[I_BM1]};
        pg8::gemm_phase<pg8::EpiG4, pg8::StaticOrder, true, true>(F.lds, g, S, E);
        if (BOTH(7)) GRID_SYNC();
    }
    if (IN(8)) {
        pg8::Gemm g{(const pg8::bf16_t*)(ws + WS_AFF), (const pg8::bf16_t*)(ws + WS_WM2), MTOK, DM, DFF}; pg8::StaticOrder S; S.init(MTOK, DM, F.G, (int)blockIdx.x);
        pg8::EpiRes<false> E{nullptr, F.out, (const float*)(ws + WS_MOD) + 5 * DM, F.in[I_BM2], F.in[I_LN1G], F.in[I_LN1B], (const float*)(ws + WS_MU1), (float*)(ws + WS_ST2)};
        pg8::gemm_phase<pg8::EpiRes<false>, pg8::StaticOrder, true, true>(F.lds, g, S, E);
        if (BOTH(8)) GRID_SYNC();
    }
    if (IN(9)) { ln_rows<true>(F); }
#undef IN
#undef BOTH
}

constexpr int N_PHASES = 10;
#ifndef MK_N_LAUNCHES
#define MK_N_LAUNCHES 1
#endif
extern "C" void kernel_launch(void* const* d_in, const int* in_sizes, int n_in, void* d_out, int out_size, void* d_ws, size_t ws_size, hipStream_t stream) {
    static int grid = 0;
    if (grid == 0) {
        if (n_in != 31 || in_sizes[0] != MTOK * DM || out_size != MTOK * DM || ws_size < WS_END) {
            fprintf(stderr, "kernel_launch: unexpected problem: n_in %d in0 %d out %d ws %zu (need %zu)\n", n_in, n_in > 0 ? in_sizes[0] : -1, out_size, ws_size, (size_t)WS_END); grid = -1; return; }
        int dev = 0, cus = 0, per_cu = 0;
        if (hipGetDevice(&dev) != hipSuccess || hipDeviceGetAttribute(&cus, hipDeviceAttributeMultiprocessorCount, dev) != hipSuccess) { grid = -1; return; }
        if (hipFuncSetAttribute((const void*)fwd_megakernel, hipFuncAttributeMaxDynamicSharedMemorySize, LDS_BYTES) != hipSuccess) { fprintf(stderr, "kernel_launch: hipFuncSetAttribute failed\n"); grid = -1; return; }
        if (hipOccupancyMaxActiveBlocksPerMultiprocessor(&per_cu, (const void*)fwd_megakernel, NWAVES * 64, LDS_BYTES) != hipSuccess || per_cu < 1) { fprintf(stderr, "kernel_launch: occupancy query says %d\n", per_cu); per_cu = 1; }
        (void)hipGetLastError();
        grid = cus;
    }
    if (grid < 0) return;
    if (hipMemsetAsync((char*)d_ws + WS_CTL, 0, CTL_ZERO_BYTES, stream) != hipSuccess) { fprintf(stderr, "kernel_launch: memset failed\n"); return; }
    Args a{};
    for (int i = 0; i < 31; ++i) a.in[i] = (const float*)d_in[i];
    a.out = (float*)d_out; a.ws = (unsigned char*)d_ws;
    if (MK_N_LAUNCHES == 1) {
        a.ph_lo = 0; a.ph_hi = N_PHASES;
        void* kargs[] = {&a};
        hipError_t e = hipLaunchCooperativeKernel((const void*)fwd_megakernel, dim3(grid), dim3(NWAVES * 64), kargs, LDS_BYTES, stream);
        if (e != hipSuccess) fprintf(stderr, "kernel_launch: cooperative launch failed: %s (grid %d)\n", hipGetErrorString(e), grid);
    } else {
        for (int p = 0; p < N_PHASES; ++p) { a.ph_lo = p; a.ph_hi = p + 1; hipLaunchKernelGGL(fwd_megakernel, dim3(grid), dim3(NWAVES * 64), LDS_BYTES, stream, a); }
    }
}
```

```cpp
#include <hip/hip_runtime.h>
#include <cstdio>
#include <cstdint>

namespace pg8 {
#define PG8_LAS __attribute__((address_space(3)))
typedef unsigned short bf16_t;
typedef short bf16x8 __attribute__((ext_vector_type(8)));
typedef float f32x4 __attribute__((ext_vector_type(4)));
typedef unsigned u32x4 __attribute__((ext_vector_type(4)));
typedef float f32x2 __attribute__((ext_vector_type(2)));
constexpr int BM = 256, BK = 64, HALF = 128, HTB = HALF * BK * 2  , STAGE_BYTES = 8 * HTB, NXCD = 8, WGM = 8;

__host__ __device__ __forceinline__ int lds_byte(int r, int c) { const int st = (r >> 4) * 2 + (c >> 5), rr = r & 15, cc = c & 31, ob = rr * 64 + cc * 2; return st * 1024 + (ob ^ (((ob >> 9) & 1) << 5)); }
__host__ __device__ __forceinline__ void stage_rc(int b, int& R, int& C) { const int st = b / 1024, sb = b % 1024, swz = sb ^ (((sb >> 9) & 1) << 5); R = (st >> 1) * 16 + swz / 64; C = (st & 1) * 32 + (swz % 64) / 2; }
__host__ __device__ __forceinline__ int perm32(int rho) { const int n = rho >> 4, i = rho & 15; return 8 * (i >> 2) + 4 * n + (i & 3); }

struct Unit { int pm, pn; };
struct Gemm { const bf16_t* A; const bf16_t* Bt; int M, N, K; };

struct StaticOrder {
    int nM, nN, nwg, G, c;
    __host__ __device__ void init(int M, int N, int G_, int c_) { nM = M / BM; nN = N / BM; nwg = nM * nN; G = G_; c = c_; }
    __host__ __device__ bool next(int i, Unit& u) const {
        const long L = (long)i * G + c; if (L >= nwg) return false;
        int wgid = (int)L; { const int q = nwg / NXCD, r = nwg % NXCD, xcd = wgid % NXCD, off = wgid / NXCD; wgid = (xcd < r ? xcd * (q + 1) : r * (q + 1) + (xcd - r) * q) + off; }
        const int nig = WGM * nN, gid = wgid / nig, fm = gid * WGM, gsz = (nM - fm) < WGM ? (nM - fm) : WGM;
        u.pm = fm + ((wgid % nig) % gsz); u.pn = (wgid % nig) / gsz; return true;
    }
    __device__ __forceinline__ void a_ready(const Unit&) const {}
    __device__ __forceinline__ void done(const Unit&) const {}
};

__device__ __forceinline__ unsigned cvt_pk_bf16(float lo, float hi) { unsigned r; asm volatile("v_cvt_pk_bf16_f32 %0, %1, %2" : "=v"(r) : "v"(lo), "v"(hi)); return r; }
__device__ __forceinline__ f32x2 gelu_pk(f32x2 v) {
    const f32x2 av = __builtin_elementwise_abs(v), d = av * 0.2316418882f + 1.0f;
    f32x2 t; t.x = __builtin_amdgcn_rcpf(d.x); t.y = __builtin_amdgcn_rcpf(d.y);
    f32x2 q = t * 0.5307027145f + (-0.7265760135f); q = q * t + 0.7107068705f; q = q * t + (-0.142248368f); q = q * t + 0.127414796f; q = q * t;
    const f32x2 s = (v * v) * (-0.72134752044f);
    f32x2 e; e.x = __builtin_amdgcn_exp2f(s.x); e.y = __builtin_amdgcn_exp2f(s.y);
    const f32x2 m = v * (q * e), r = v - m;
    f32x2 o; o.x = v.x < 0.f ? m.x : r.x; o.y = v.y < 0.f ? m.y : r.y; return o;
}
__device__ __forceinline__ float bf_lo(unsigned w) { return __uint_as_float(w << 16); }
__device__ __forceinline__ float bf_hi(unsigned w) { return __uint_as_float(w & 0xffff0000u); }
__device__ __forceinline__ float sigmoid_f(float x) { return __builtin_amdgcn_rcpf(1.0f + __expf(-x)); }
}

constexpr int DM = 2048, NBATCH = 8, SEQ = 2048, MTOK = NBATCH * SEQ;
constexpr int SGUW = 1024, HYW = 1024, DFF = 8192, INW = 9216, MODW = 6 * DM;
constexpr float LN_EPS = 1e-5f;
constexpr float DN_ALPHA = 1.189207115002721f;

namespace pg8 {

struct EpiG1 {
    static constexpr bool PERM = true, AFTER_DRAIN = false, MID = false;
    bf16_t* U; bf16_t* G; const float* b_in;
    __device__ __forceinline__ void mid(f32x4 (&)[2][2][4][2], const Unit&, int, int, int, int) const {}
    __device__ __forceinline__ void operator()(const f32x4 (&acc)[2][2][4][2], const Unit& u, int wr, int wc, int fr, int fq) const {
        const int row0 = u.pm * BM + wr * 64 + fr; const int pn = u.pn;
        int ldc, colt, bcol; bf16_t* base; const bool isu = pn < 4;
        if (isu) { base = U; ldc = SGUW; colt = pn * 256; bcol = pn * 256; }
        else { base = G; ldc = 2 * DM; colt = (pn - 4) * 256; bcol = 5120 + (pn - 4) * 256; }
        const int cl = wc * 32 + 8 * fq;
        f32x4 bv[2][2];
#pragma unroll
        for (int bj = 0; bj < 2; ++bj)
#pragma unroll
            for (int n = 0; n < 2; ++n) bv[bj][n] = *(const f32x4*)(b_in + bcol + cl + bj * HALF + 4 * n);
#pragma unroll
        for (int ai = 0; ai < 2; ++ai)
#pragma unroll
            for (int m = 0; m < 4; ++m) {
                const int row = row0 + ai * HALF + m * 16;
                bf16_t* rowp = base + (size_t)row * ldc + colt + cl;
#pragma unroll
                for (int bj = 0; bj < 2; ++bj) {
                    f32x4 v0 = acc[ai][bj][m][0] + bv[bj][0], v1 = acc[ai][bj][m][1] + bv[bj][1];
                    if (isu) {
                        f32x2 a = gelu_pk((f32x2){v0[0], v0[1]}), b = gelu_pk((f32x2){v0[2], v0[3]}), c = gelu_pk((f32x2){v1[0], v1[1]}), d = gelu_pk((f32x2){v1[2], v1[3]});
                        v0 = (f32x4){a.x, a.y, b.x, b.y}; v1 = (f32x4){c.x, c.y, d.x, d.y};
                    } else {
                        v0 = (f32x4){sigmoid_f(v0[0]), sigmoid_f(v0[1]), sigmoid_f(v0[2]), sigmoid_f(v0[3])};
                        v1 = (f32x4){sigmoid_f(v1[0]), sigmoid_f(v1[1]), sigmoid_f(v1[2]), sigmoid_f(v1[3])};
                    }
                    u32x4 w; w.x = cvt_pk_bf16(v0[0], v0[1]); w.y = cvt_pk_bf16(v0[2], v0[3]); w.z = cvt_pk_bf16(v1[0], v1[1]); w.w = cvt_pk_bf16(v1[2], v1[3]);
                    *(u32x4*)(rowp + bj * HALF) = w;
                }
            }
    }
};

struct EpiG1T {
    static constexpr bool PERM = true, AFTER_DRAIN = false, MID = false;
    bf16_t* VT; bf16_t* ZHT; const float* b_in; float* statsV;
    __device__ __forceinline__ void mid(f32x4 (&)[2][2][4][2], const Unit&, int, int, int, int) const {}
    __device__ __forceinline__ void operator()(const f32x4 (&acc)[2][2][4][2], const Unit& u, int wr, int wc, int fr, int fq) const {
        const int col0 = u.pn * BM + wc * 32 + 8 * fq; const bool isv = u.pm < 4;
        const int rowt = (isv ? u.pm : u.pm - 4) * BM + wr * 64 + fr;
        bf16_t* base = isv ? VT : ZHT; const float* bp = b_in + (isv ? 1024 : 2048);
#pragma unroll
        for (int ai = 0; ai < 2; ++ai) {
            float s[2][8], q[2][8];
#pragma unroll
            for (int bj = 0; bj < 2; ++bj)
#pragma unroll
                for (int e = 0; e < 8; ++e) { s[bj][e] = 0.f; q[bj][e] = 0.f; }
#pragma unroll
            for (int m = 0; m < 4; ++m) {
                const int row = rowt + ai * HALF + m * 16; const float bb = bp[row];
                bf16_t* rowp = base + (size_t)row * MTOK + col0;
#pragma unroll
                for (int bj = 0; bj < 2; ++bj) {
                    f32x4 v0 = acc[ai][bj][m][0] + bb, v1 = acc[ai][bj][m][1] + bb;
                    if (isv) {
                        f32x2 a = gelu_pk((f32x2){v0[0], v0[1]}), b = gelu_pk((f32x2){v0[2], v0[3]}), c = gelu_pk((f32x2){v1[0], v1[1]}), d = gelu_pk((f32x2){v1[2], v1[3]});
                        v0 = (f32x4){a.x, a.y, b.x, b.y}; v1 = (f32x4){c.x, c.y, d.x, d.y};
                    }
                    u32x4 w; w.x = cvt_pk_bf16(v0[0], v0[1]); w.y = cvt_pk_bf16(v0[2], v0[3]); w.z = cvt_pk_bf16(v1[0], v1[1]); w.w = cvt_pk_bf16(v1[2], v1[3]);
                    *(u32x4*)(rowp + bj * HALF) = w;
                    if (isv) {
                        const float e0 = bf_lo(w.x), e1 = bf_hi(w.x), e2 = bf_lo(w.y), e3 = bf_hi(w.y), e4 = bf_lo(w.z), e5 = bf_hi(w.z), e6 = bf_lo(w.w), e7 = bf_hi(w.w);
                        s[bj][0] += e0; s[bj][1] += e1; s[bj][2] += e2; s[bj][3] += e3; s[bj][4] += e4; s[bj][5] += e5; s[bj][6] += e6; s[bj][7] += e7;
                        q[bj][0] += e0 * e0; q[bj][1] += e1 * e1; q[bj][2] += e2 * e2; q[bj][3] += e3 * e3; q[bj][4] += e4 * e4; q[bj][5] += e5 * e5; q[bj][6] += e6 * e6; q[bj][7] += e7 * e7;
                    }
                }
            }
            if (isv) {
                const int slot = u.pm * 4 + ai * 2 + wr;
#pragma unroll
                for (int bj = 0; bj < 2; ++bj)
#pragma unroll
                    for (int e = 0; e < 8; ++e) {
                        float a = s[bj][e], b = q[bj][e];
                        a += __shfl_xor(a, 1); b += __shfl_xor(b, 1); a += __shfl_xor(a, 2); b += __shfl_xor(b, 2);
                        a += __shfl_xor(a, 4); b += __shfl_xor(b, 4); a += __shfl_xor(a, 8); b += __shfl_xor(b, 8);
                        if (fr == 0) *(f32x2*)(statsV + ((size_t)(col0 + bj * HALF + e) * 16 + slot) * 2) = (f32x2){a, b};
                    }
            }
        }
    }
};

struct EpiG2 {
    static constexpr bool PERM = true, AFTER_DRAIN = false, MID = true;
    const bf16_t* G; bf16_t* O;
    __device__ __forceinline__ void mid(f32x4 (&acc)[2][2][4][2], const Unit& u, int wr, int wc, int fr, int fq) const {
        int row0 = u.pm * BM + wr * 64 + fr, col0 = u.pn * BM + wc * 32 + 8 * fq;
        asm volatile("" : "+v"(row0), "+v"(col0));
#pragma unroll
        for (int ai = 0; ai < 2; ++ai)
#pragma unroll
            for (int m = 0; m < 4; ++m) {
                const bf16_t* gp = G + (size_t)(row0 + ai * HALF + m * 16) * (2 * DM) + col0;
#pragma unroll
                for (int bj = 0; bj < 2; ++bj) {
                    const u32x4 ga = *(const u32x4*)(gp + bj * HALF), gb = *(const u32x4*)(gp + DM + bj * HALF);
                    f32x4 r0, r1;
                    r0[0] = bf_lo(ga.x) * __builtin_amdgcn_rcpf(bf_lo(gb.x)); r0[1] = bf_hi(ga.x) * __builtin_amdgcn_rcpf(bf_hi(gb.x));
                    r0[2] = bf_lo(ga.y) * __builtin_amdgcn_rcpf(bf_lo(gb.y)); r0[3] = bf_hi(ga.y) * __builtin_amdgcn_rcpf(bf_hi(gb.y));
                    r1[0] = bf_lo(ga.z) * __builtin_amdgcn_rcpf(bf_lo(gb.z)); r1[1] = bf_hi(ga.z) * __builtin_amdgcn_rcpf(bf_hi(gb.z));
                    r1[2] = bf_lo(ga.w) * __builtin_amdgcn_rcpf(bf_lo(gb.w)); r1[3] = bf_hi(ga.w) * __builtin_amdgcn_rcpf(bf_hi(gb.w));
                    acc[ai][bj][m][0] *= r0; acc[ai][bj][m][1] *= r1;
                }
            }
    }
    __device__ __forceinline__ void operator()(const f32x4 (&acc)[2][2][4][2], const Unit& u, int wr, int wc, int fr, int fq) const {
        const int row0 = u.pm * BM + wr * 64 + fr, col0 = u.pn * BM + wc * 32 + 8 * fq;
#pragma unroll
        for (int ai = 0; ai < 2; ++ai)
#pragma unroll
            for (int m = 0; m < 4; ++m) {
                const int row = row0 + ai * HALF + m * 16;
                const bf16_t* gp = G + (size_t)row * (2 * DM) + DM + col0;
                bf16_t* op = O + (size_t)row * DM + col0;
#pragma unroll
                for (int bj = 0; bj < 2; ++bj) {
                    const u32x4 gb = *(const u32x4*)(gp + bj * HALF);
                    const f32x4 a0 = acc[ai][bj][m][0], a1 = acc[ai][bj][m][1];
                    u32x4 w; w.x = cvt_pk_bf16(a0[0] * bf_lo(gb.x), a0[1] * bf_hi(gb.x)); w.y = cvt_pk_bf16(a0[2] * bf_lo(gb.y), a0[3] * bf_hi(gb.y));
                    w.z = cvt_pk_bf16(a1[0] * bf_lo(gb.z), a1[1] * bf_hi(gb.z)); w.w = cvt_pk_bf16(a1[2] * bf_lo(gb.w), a1[3] * bf_hi(gb.w));
                    *(u32x4*)(op + bj * HALF) = w;
                }
            }
    }
};

template <bool FIRST> struct EpiRes {
    static constexpr bool PERM = false, AFTER_DRAIN = false, MID = false;
    const float* X;
    float* R;
    const float* gate;
    const float* bias;
    const float* lng; const float* lnb; const float* MU;
    float* stats;
    __device__ __forceinline__ void mid(f32x4 (&)[2][2][4][2], const Unit&, int, int, int, int) const {}
    __device__ __forceinline__ void operator()(const f32x4 (&acc)[2][2][4][2], const Unit& u, int wr, int wc, int fr, int fq) const {
        int row0 = u.pm * BM + wr * 64 + fr, col0 = u.pn * BM + wc * 32 + 4 * fq; const int b = u.pm >> 3;
        asm volatile("" : "+v"(row0), "+v"(col0));
        const float* gp = gate + (size_t)b * MODW + col0; const float* bp = bias + col0;
#pragma unroll
        for (int ai = 0; ai < 2; ++ai)
#pragma unroll
            for (int m = 0; m < 4; ++m) {
                const int row = row0 + ai * HALF + m * 16;
                float s = 0.f, q = 0.f; f32x2 mr = (f32x2){0.f, 1.f};
                if (!FIRST) mr = *(const f32x2*)(MU + (size_t)row * 2);
                float* rp = R + (size_t)row * DM + col0; const float* xp = X + (size_t)row * DM + col0;
#pragma unroll
                for (int bj = 0; bj < 2; ++bj)
#pragma unroll
                    for (int n = 0; n < 2; ++n) {
                        const int co = bj * HALF + n * 16;
                        const f32x4 gv = *(const f32x4*)(gp + co), bv = *(const f32x4*)(bp + co);
                        f32x4 base;
                        if (FIRST) base = *(const f32x4*)(xp + co);
                        else { const f32x4 rv = *(const f32x4*)(rp + co); base = (rv - mr.x) * mr.y * *(const f32x4*)(lng + col0 + co) + *(const f32x4*)(lnb + col0 + co); }
                        const f32x4 o = base * DN_ALPHA + gv * (acc[ai][bj][m][n] + bv);
                        *(f32x4*)(rp + co) = o;
                        s += (o[0] + o[1]) + (o[2] + o[3]); q += (o[0] * o[0] + o[1] * o[1]) + (o[2] * o[2] + o[3] * o[3]);
                    }
                s += __shfl_xor(s, 16); s += __shfl_xor(s, 32); q += __shfl_xor(q, 16); q += __shfl_xor(q, 32);
                if (fq == 0) *(f32x2*)(stats + ((size_t)row * 32 + u.pn * 4 + wc) * 2) = (f32x2){s, q};
                asm volatile("" ::: "memory");
            }
    }
};

struct EpiG4 {
    static constexpr bool PERM = true, AFTER_DRAIN = false, MID = false;
    bf16_t* O; const float* bias;
    __device__ __forceinline__ void mid(f32x4 (&)[2][2][4][2], const Unit&, int, int, int, int) const {}
    __device__ __forceinline__ void operator()(const f32x4 (&acc)[2][2][4][2], const Unit& u, int wr, int wc, int fr, int fq) const {
        const int row0 = u.pm * BM + wr * 64 + fr, col0 = u.pn * BM + wc * 32 + 8 * fq;
        f32x4 bv[2][2];
#pragma unroll
        for (int bj = 0; bj < 2; ++bj)
#pragma unroll
            for (int n = 0; n < 2; ++n) bv[bj][n] = *(const f32x4*)(bias + col0 + bj * HALF + 4 * n);
#pragma unroll
        for (int ai = 0; ai < 2; ++ai)
#pragma unroll
            for (int m = 0; m < 4; ++m) {
                bf16_t* rowp = O + (size_t)(row0 + ai * HALF + m * 16) * DFF + col0;
#pragma unroll
                for (int bj = 0; bj < 2; ++bj) {
                    f32x4 v0 = acc[ai][bj][m][0] + bv[bj][0], v1 = acc[ai][bj][m][1] + bv[bj][1];
                    v0 = __builtin_elementwise_max(v0, (f32x4){0.f, 0.f, 0.f, 0.f}); v1 = __builtin_elementwise_max(v1, (f32x4){0.f, 0.f, 0.f, 0.f});
                    v0 = v0 * v0; v1 = v1 * v1;
                    u32x4 w; w.x = cvt_pk_bf16(v0[0], v0[1]); w.y = cvt_pk_bf16(v0[2], v0[3]); w.z = cvt_pk_bf16(v1[0], v1[1]); w.w = cvt_pk_bf16(v1[2], v1[3]);
                    *(u32x4*)(rowp + bj * HALF) = w;
                }
            }
    }
};
}
namespace pg8 {
template <class Epi, class Sched, bool ALIGN_EPI = false, bool SP2 = false>
__device__ __forceinline__ void gemm_phase(PG8_LAS unsigned char* lds, const Gemm g, const Sched& S, const Epi& E) {
    const int tid = threadIdx.x, wid = __builtin_amdgcn_readfirstlane(tid >> 6), lane = tid & 63, wr = wid >> 2, wc = wid & 3, fr = lane & 15, fq = lane >> 4;
    const int K = g.K, nt = K / BK;
    unsigned voffA[2], voffB[2];
#pragma unroll
    for (int i = 0; i < 2; ++i) { int R, C; stage_rc(tid * 16 + i * 8192, R, C); const int Rb = Epi::PERM ? ((R & ~31) + perm32(R & 31)) : R;
        voffA[i] = (unsigned)(R * K + C) * 2u; voffB[i] = (unsigned)(Rb * K + C) * 2u; }
    const size_t kstep = (size_t)(BK * 2);
    const size_t hstep = (size_t)HALF * K * 2;
    const size_t tstep = 2 * hstep;
    const unsigned ldsw = (unsigned)wid * 1024u;
    const int aoff = lds_byte(wr * 64 + fr, fq * 8), boff = lds_byte(wc * 32 + fr, fq * 8);
#define PG8_SA(b, h) (((b) * 2 + (h)) * HTB)
#define PG8_SB(b, h) ((4 + (b) * 2 + (h)) * HTB)
#define PG8_STAGE(bufoff, gbase, voff) do { _Pragma("unroll") for (int _i = 0; _i < 2; ++_i) \
        __builtin_amdgcn_global_load_lds((const unsigned*)((const char*)(gbase) + (voff)[_i]), (PG8_LAS unsigned*)(lds + (bufoff) + ldsw + _i * 8192), 16, 0, 0); } while (0)
#define PG8_LDA(dst, b, h) do { _Pragma("unroll") for (int m = 0; m < 4; ++m) _Pragma("unroll") for (int k = 0; k < 2; ++k) dst[m][k] = *(const PG8_LAS bf16x8*)(lds + PG8_SA(b, h) + aoff + m * 2048 + k * 1024); } while (0)
#define PG8_LDB(dst, b, h) do { _Pragma("unroll") for (int n = 0; n < 2; ++n) _Pragma("unroll") for (int k = 0; k < 2; ++k) dst[n][k] = *(const PG8_LAS bf16x8*)(lds + PG8_SB(b, h) + boff + n * 2048 + k * 1024); } while (0)
#define PG8_MMA(ai, bj, At, Bt) do { __builtin_amdgcn_s_setprio(1); _Pragma("unroll") for (int m = 0; m < 4; ++m) _Pragma("unroll") for (int n = 0; n < 2; ++n) _Pragma("unroll") for (int k = 0; k < 2; ++k) \
        acc[ai][bj][m][n] = __builtin_amdgcn_mfma_f32_16x16x32_bf16(Bt[n][k], At[m][k], acc[ai][bj][m][n], 0, 0, 0); __builtin_amdgcn_s_setprio(0); } while (0)
#define PG8_WAIT_V(n) asm volatile("s_waitcnt vmcnt(" #n ")" ::: "memory")
#define PG8_WAIT_L(n) asm volatile("s_waitcnt lgkmcnt(" #n ")" ::: "memory")
#define PG8_BAR __builtin_amdgcn_s_barrier()
#define PG8_SCHED __builtin_amdgcn_sched_barrier(0)
    Unit cur, nxt; int ui = 0;
    if (!S.next(0, cur)) return;
    f32x4 acc[2][2][4][2];
#pragma unroll
    for (int a = 0; a < 2; ++a)
#pragma unroll
        for (int b = 0; b < 2; ++b)
#pragma unroll
            for (int m = 0; m < 4; ++m)
#pragma unroll
                for (int n = 0; n < 2; ++n) acc[a][b][m][n] = (f32x4){0.f, 0.f, 0.f, 0.f};
    bf16x8 At[4][2], B0[2][2], B1[2][2];
    const char* cA = (const char*)g.A + (size_t)cur.pm * tstep; const char* cB = (const char*)g.Bt + (size_t)cur.pn * tstep;
    S.a_ready(cur);
    if constexpr (SP2) {
        PG8_STAGE(PG8_SB(0, 0), cB, voffB); PG8_STAGE(PG8_SB(0, 1), cB + hstep, voffB); PG8_STAGE(PG8_SA(0, 0), cA, voffA); PG8_STAGE(PG8_SA(0, 1), cA + hstep, voffA);
        if (wr == 1) PG8_BAR;
        PG8_WAIT_V(2); PG8_BAR;
        PG8_STAGE(PG8_SB(1, 0), cB + kstep, voffB); PG8_STAGE(PG8_SA(1, 0), cA + kstep, voffA); PG8_STAGE(PG8_SB(1, 1), cB + hstep + kstep, voffB);
        PG8_WAIT_V(6); PG8_BAR;
    } else {
        PG8_STAGE(PG8_SB(0, 0), cB, voffB); PG8_STAGE(PG8_SA(0, 0), cA, voffA); PG8_STAGE(PG8_SB(0, 1), cB + hstep, voffB); PG8_STAGE(PG8_SA(0, 1), cA + hstep, voffA);
        if (wr == 1) PG8_BAR;
        PG8_WAIT_V(4); PG8_BAR;
        PG8_STAGE(PG8_SB(1, 0), cB + kstep, voffB); PG8_STAGE(PG8_SA(1, 0), cA + kstep, voffA); PG8_STAGE(PG8_SB(1, 1), cB + hstep + kstep, voffB);
        PG8_WAIT_V(6); PG8_BAR;
    }
    for (;;) {
        const bool has_next = S.next(ui + 1, nxt);
        const char* nA = has_next ? (const char*)g.A + (size_t)nxt.pm * tstep : cA; const char* nB = has_next ? (const char*)g.Bt + (size_t)nxt.pn * tstep : cB;
        for (int t = 0; t < nt; t += 2) {
            const bool last = (t == nt - 2);
            const char* a1 = cA + (size_t)(t + 1) * kstep;
            const char* a2 = last ? nA : cA + (size_t)(t + 2) * kstep; const char* b2 = last ? nB : cB + (size_t)(t + 2) * kstep;
            const char* a3 = a2 + kstep; const char* b3 = b2 + kstep;
            if (last && has_next) S.a_ready(nxt);
            if constexpr (Epi::MID) { if (t == (nt >> 1)) E.mid(acc, cur, wr, wc, fr, fq); }
            if constexpr (SP2) {
            PG8_LDB(B0, 0, 0); PG8_LDB(B1, 0, 1); PG8_SCHED; PG8_LDA(At, 0, 0); PG8_STAGE(PG8_SA(1, 1), a1 + hstep, voffA);
            PG8_WAIT_V(8); PG8_WAIT_L(0); PG8_BAR; PG8_MMA(0, 0, At, B0); PG8_MMA(0, 1, At, B1); PG8_BAR; PG8_SCHED;
            PG8_LDA(At, 0, 1); PG8_STAGE(PG8_SB(0, 0), b2, voffB); PG8_STAGE(PG8_SB(0, 1), b2 + hstep, voffB); PG8_STAGE(PG8_SA(0, 0), a2, voffA);
            PG8_WAIT_V(8); PG8_WAIT_L(0); PG8_BAR; PG8_MMA(1, 0, At, B0); PG8_MMA(1, 1, At, B1); PG8_BAR; PG8_SCHED;
            PG8_LDB(B0, 1, 0); PG8_LDB(B1, 1, 1); PG8_SCHED; PG8_LDA(At, 1, 0); PG8_STAGE(PG8_SA(0, 1), a2 + hstep, voffA);
            PG8_WAIT_V(8); PG8_WAIT_L(0); PG8_BAR; PG8_MMA(0, 0, At, B0); PG8_MMA(0, 1, At, B1); PG8_BAR; PG8_SCHED;
            PG8_LDA(At, 1, 1); PG8_STAGE(PG8_SB(1, 0), b3, voffB); PG8_STAGE(PG8_SB(1, 1), b3 + hstep, voffB); PG8_STAGE(PG8_SA(1, 0), a3, voffA);
            PG8_WAIT_V(8); PG8_WAIT_L(0); PG8_BAR; PG8_MMA(1, 0, At, B0); PG8_MMA(1, 1, At, B1); PG8_BAR; PG8_SCHED;
            } else {
            PG8_LDB(B0, 0, 0); PG8_SCHED; PG8_LDA(At, 0, 0); PG8_STAGE(PG8_SA(1, 1), a1 + hstep, voffA);
            PG8_WAIT_L(8); PG8_BAR; PG8_WAIT_L(0); PG8_MMA(0, 0, At, B0); PG8_BAR; PG8_SCHED;
            PG8_LDB(B1, 0, 1); PG8_STAGE(PG8_SB(0, 0), b2, voffB);
            PG8_BAR; PG8_WAIT_L(0); PG8_MMA(0, 1, At, B1); PG8_BAR;
            PG8_LDA(At, 0, 1); PG8_STAGE(PG8_SA(0, 0), a2, voffA);
            PG8_BAR; PG8_WAIT_L(0); PG8_MMA(1, 0, At, B0); PG8_BAR; PG8_SCHED;
            PG8_STAGE(PG8_SB(0, 1), b2 + hstep, voffB);
            PG8_WAIT_V(6); PG8_BAR; PG8_MMA(1, 1, At, B1); PG8_BAR;
            PG8_LDB(B0, 1, 0); PG8_SCHED; PG8_LDA(At, 1, 0); PG8_STAGE(PG8_SA(0, 1), a2 + hstep, voffA);
            PG8_WAIT_L(8); PG8_BAR; PG8_WAIT_L(0); PG8_MMA(0, 0, At, B0); PG8_BAR; PG8_SCHED;
            PG8_LDB(B1, 1, 1); PG8_STAGE(PG8_SB(1, 0), b3, voffB);
            PG8_BAR; PG8_WAIT_L(0); PG8_MMA(0, 1, At, B1); PG8_BAR;
            PG8_LDA(At, 1, 1); PG8_STAGE(PG8_SA(1, 0), a3, voffA);
            PG8_BAR; PG8_WAIT_L(0); PG8_MMA(1, 0, At, B0); PG8_BAR; PG8_SCHED;
            PG8_STAGE(PG8_SB(1, 1), b3 + hstep, voffB);
            PG8_WAIT_V(6); PG8_BAR; PG8_MMA(1, 1, At, B1); PG8_BAR;
            }
        }
        if constexpr (ALIGN_EPI) { if (wr == 0) PG8_BAR; }
        if constexpr (!Epi::AFTER_DRAIN) { E(acc, cur, wr, wc, fr, fq); S.done(cur); }
        if (!has_next) break;
#pragma unroll
        for (int a = 0; a < 2; ++a)
#pragma unroll
            for (int b = 0; b < 2; ++b)
#pragma unroll
                for (int m = 0; m < 4; ++m)
#pragma unroll
                    for (int n = 0; n < 2; ++n) acc[a][b][m][n] = (f32x4){0.f, 0.f, 0.f, 0.f};
        cur = nxt; cA = nA; cB = nB; ++ui;
        if constexpr (ALIGN_EPI) { if (wr == 1) PG8_BAR; }
    }
    PG8_WAIT_V(0);
    if constexpr (!ALIGN_EPI) { if (wr == 0) PG8_BAR; }
    PG8_BAR;
    if constexpr (Epi::AFTER_DRAIN) { E.fused(acc, cur, wr, wc, fr, fq, lds, wid, lane); S.done(cur); }
#undef PG8_SA
#undef PG8_SB
#undef PG8_STAGE
#undef PG8_LDA
#undef PG8_LDB
#undef PG8_MMA
#undef PG8_WAIT_V
#undef PG8_WAIT_L
#undef PG8_BAR
#undef PG8_SCHED
}
}

constexpr size_t MiB = 1u << 20;
constexpr size_t WS_CTL = 0;
constexpr size_t WS_MOD = 1 * MiB;
constexpr size_t WS_STV = 2 * MiB;
constexpr size_t WS_ST1 = 4 * MiB;
constexpr size_t WS_ST2 = 8 * MiB;
constexpr size_t WS_MU1 = 12 * MiB;
constexpr size_t WS_SGW = 13 * MiB;
constexpr size_t WS_WIN = 16 * MiB;
constexpr size_t WS_WAB = 52 * MiB;
constexpr size_t WS_WO = 60 * MiB;
constexpr size_t WS_FILT = 68 * MiB;
constexpr size_t WS_WM2 = 68 * MiB;
constexpr size_t WS_H = 100 * MiB;
constexpr size_t WS_U = 164 * MiB;
constexpr size_t WS_V = 196 * MiB;
constexpr size_t WS_MERGED = 164 * MiB;
constexpr size_t WS_ZHT = 228 * MiB;
constexpr size_t WS_G = 324 * MiB;
constexpr size_t WS_AFF = 164 * MiB;
constexpr size_t WS_WM1 = 420 * MiB;
constexpr size_t WS_END = 452 * MiB;

constexpr int NWAVES = 8;
constexpr int LDS_BYTES = 147456;

#define GAS __attribute__((address_space(1)))
#define LAS __attribute__((address_space(3)))
typedef unsigned short bf16;
typedef unsigned v4u __attribute__((ext_vector_type(4)));
typedef unsigned v2u __attribute__((ext_vector_type(2)));
typedef float f32x4 __attribute__((ext_vector_type(4)));
typedef float f32x2 __attribute__((ext_vector_type(2)));
#define LDS_WAIT() asm volatile("s_waitcnt lgkmcnt(0)" ::: "memory")

__device__ __forceinline__ unsigned f2bf(float f) { unsigned u = __builtin_bit_cast(unsigned, f); return (u + 0x7fffu + ((u >> 16) & 1u)) >> 16; }
__device__ __forceinline__ unsigned pk2(float lo, float hi) { return f2bf(lo) | (f2bf(hi) << 16); }
__device__ __forceinline__ float bflo(unsigned w) { return __uint_as_float(w << 16); }
__device__ __forceinline__ float bfhi(unsigned w) { return __uint_as_float(w & 0xffff0000u); }
__device__ __forceinline__ float bf1(bf16 h) { return __uint_as_float((unsigned)h << 16); }
__device__ __forceinline__ float wave_sum(float v) {
#pragma unroll
    for (int o = 1; o < 64; o <<= 1) v += __shfl_xor(v, o);
    return v;
}

struct Args { const float* in[31]; float* out; unsigned char* ws; int ph_lo, ph_hi; };

struct Frame {
    LAS unsigned char* lds;
    int tid, lane, wave, G;
    const float* const* in; float* out; unsigned char* ws;
};
enum { I_X = 0, I_C, I_WADA, I_BADA, I_WIN, I_BIN, I_SLNG, I_SLNB, I_SW, I_SB, I_HCW, I_HCB, I_HW1, I_HB1, I_HW2, I_HB2, I_HFREQ, I_HW3, I_HSKIP,
       I_WA, I_WB, I_WO, I_BO, I_LN1G, I_LN1B, I_WM1, I_BM1, I_WM2, I_BM2, I_LN2G, I_LN2B };

__device__ __forceinline__ void transpose_matrix(Frame& F, const float* W, int K, int N, bf16* WT, int ldk, int koff, int remap_win, int first, int nblocks) {
    LAS float* tile = (LAS float*)F.lds;
    const int tid = F.tid, nblk = N / 256, nitems = (K / 64) * nblk;
    const int lr = tid >> 6, lc = tid & 63;
    const int wc = tid & 7, wn = tid >> 3;
    for (int it = first; it < nitems; it += nblocks) {
        const int kb = it / nblk, nb = it % nblk, n0 = nb * 256, k0 = kb * 64; int row0 = n0;
        if (remap_win) row0 = (n0 < 1024) ? n0 : (n0 < 2048 ? n0 - 1024 + 5120 : (n0 < 5120 ? n0 - 2048 + 6144 : n0 - 5120 + 1024));
        f32x4 v[8];
#pragma unroll
        for (int i = 0; i < 8; ++i) v[i] = *(const f32x4*)(W + (size_t)(k0 + 8 * i + lr) * N + n0 + 4 * lc);
#pragma unroll
        for (int i = 0; i < 8; ++i) *(LAS f32x4*)(tile + (8 * i + lr) * 256 + ((lc ^ i) << 2)) = v[i];
        __syncthreads();
#pragma unroll
        for (int j = 0; j < 4; ++j) { const int n = wn + 64 * j; const LAS float* sp = tile + (8 * wc) * 256 + ((((n >> 2) ^ wc) << 2) | (n & 3));
            v4u o; o.x = pk2(sp[0 * 256], sp[1 * 256]); o.y = pk2(sp[2 * 256], sp[3 * 256]); o.z = pk2(sp[4 * 256], sp[5 * 256]); o.w = pk2(sp[6 * 256], sp[7 * 256]);
            *(GAS v4u*)(WT + (size_t)(row0 + n) * ldk + koff + k0 + 8 * wc) = o; }
        __syncthreads();
    }
}

__device__ __forceinline__ void p0_mod(Frame& F) {
    LAS float* condS = (LAS float*)F.lds;
    LAS float* red = (LAS float*)(F.lds + 65536);
    const float* c = F.in[I_C]; const float* w_ada = F.in[I_WADA]; const float* b_ada = F.in[I_BADA];
    float* mod = (float*)(F.ws + WS_MOD);
    const int tid = F.tid;
    for (int item = blockIdx.x; item < MODW / 48; item += F.G) {
        for (int i = tid; i < NBATCH * DM; i += NWAVES * 64) { const float v = c[i]; condS[i] = v / (1.0f + __expf(-v)); }
        __syncthreads();
        const int cq = tid % 12, kq = tid / 12, col0 = item * 48;
        if (kq < 32) {
            f32x4 acc[8];
#pragma unroll
            for (int b = 0; b < 8; ++b) acc[b] = (f32x4){0.f, 0.f, 0.f, 0.f};
            const float* wp = w_ada + (size_t)kq * MODW + col0 + cq * 4;
            for (int k = kq; k < DM; k += 256, wp += (size_t)256 * MODW) {
                f32x4 w[8];
#pragma unroll
                for (int u = 0; u < 8; ++u) w[u] = *(const f32x4*)(wp + (size_t)(32 * u) * MODW);
#pragma unroll
                for (int u = 0; u < 8; ++u)
#pragma unroll
                    for (int b = 0; b < 8; ++b) acc[b] += w[u] * condS[b * DM + k + 32 * u];
            }
#pragma unroll
            for (int b = 0; b < 8; ++b) *(LAS f32x4*)(red + (kq * 8 + b) * 48 + cq * 4) = acc[b];
        }
        __syncthreads();
        if (tid < 384) { const int b = tid / 48, col = tid % 48; float s = 0.f;
#pragma unroll 8
          for (int k2 = 0; k2 < 32; ++k2) s += red[(k2 * 8 + b) * 48 + col];
          mod[(size_t)b * MODW + col0 + col] = s + b_ada[col0 + col]; }
        __syncthreads();
    }
}

__device__ __forceinline__ void p0_filter(Frame& F) {
    LAS float* h2T = (LAS float*)F.lds;
    LAS float* scr = (LAS float*)(F.lds + 16384) + F.wave * 128;
    const float* w1 = F.in[I_HW1]; const float* b1 = F.in[I_HB1]; const float* w2 = F.in[I_HW2]; const float* b2 = F.in[I_HB2];
    const float* freq = F.in[I_HFREQ]; const float* w3 = F.in[I_HW3];
    float* FILT = (float*)(F.ws + WS_FILT);
    const int tid = F.tid, lane = F.lane, wave = F.wave;
    const float min_decay = -3.0701134573253943f, max_decay = -15.350567286626972f;
    for (int item = blockIdx.x; item < 256; item += F.G) {
        const int pb = item >> 3, cb = item & 7;
        const float fr = freq[lane], bb1 = b1[lane], bb2 = b2[lane];
        for (int pp = 0; pp < 8; ++pp) {
            const int pl = wave * 8 + pp, l = pb * 64 + pl;
            const float tl = (float)l / (float)(SEQ - 1), omega = 6.283185307179586f * (float)l / (float)SEQ;
            float f = 0.f;
            if (lane == 0) f = tl;
            else if (lane <= 16) { const float band = 1e-4f + (float)(lane - 1) * ((15.0f - 1e-4f) / 15.0f); f = cosf(band * omega); }
            else if (lane <= 32) { const float band = 1e-4f + (float)(lane - 17) * ((15.0f - 1e-4f) / 15.0f); f = -sinf(band * omega); }
            scr[lane] = f; LDS_WAIT(); asm volatile("" ::: "memory");
            float a = bb1;
            for (int i = 0; i < 33; ++i) a += scr[i] * w1[i * 64 + lane];
            scr[64 + lane] = sinf(fr * a); LDS_WAIT(); asm volatile("" ::: "memory");
            a = bb2;
            for (int i = 0; i < 64; ++i) a += scr[64 + i] * w2[i * 64 + lane];
            h2T[lane * 64 + pl] = sinf(fr * a); LDS_WAIT(); asm volatile("" ::: "memory");
        }
        __syncthreads();
        {
            const int cg = tid & 127, pg = tid >> 7, j0 = cb * 512 + cg * 4;
            f32x4 acc[16];
#pragma unroll
            for (int p = 0; p < 16; ++p) acc[p] = (f32x4){0.f, 0.f, 0.f, 0.f};
#pragma unroll 4
            for (int i = 0; i < 64; ++i) { const f32x4 w = *(const f32x4*)(w3 + (size_t)i * 4096 + j0);
#pragma unroll
                for (int p4 = 0; p4 < 4; ++p4) { const f32x4 hv = *(const LAS f32x4*)(h2T + i * 64 + pg * 16 + 4 * p4);
                    acc[4 * p4 + 0] += w * hv[0]; acc[4 * p4 + 1] += w * hv[1]; acc[4 * p4 + 2] += w * hv[2]; acc[4 * p4 + 3] += w * hv[3]; } }
            const int p0 = pb * 64 + pg * 16;
#pragma unroll
            for (int e = 0; e < 4; ++e) { const int j = j0 + e, ch = j & 1023; const float delta = fabsf(min_decay + (float)ch * ((max_decay - min_decay) / 1023.0f));
                float o[16];
#pragma unroll
                for (int p = 0; p < 16; ++p) { const float tp = (float)(p0 + p) / (float)(SEQ - 1); o[p] = acc[p][e] * expf(-tp * delta); }
                float* op = FILT + (size_t)j * SEQ + p0;
#pragma unroll
                for (int p4 = 0; p4 < 4; ++p4) *(f32x4*)(op + 4 * p4) = (f32x4){o[4 * p4], o[4 * p4 + 1], o[4 * p4 + 2], o[4 * p4 + 3]}; }
        }
        __syncthreads();
    }
}

__device__ __forceinline__ void p1_modulate(Frame& F) {
    const float* x = F.in[I_X]; const float* mod = (const float*)(F.ws + WS_MOD); bf16* H = (bf16*)(F.ws + WS_H);
    const size_t nvec = (size_t)MTOK * DM / 8, stride = (size_t)F.G * NWAVES * 64;
    for (size_t i = (size_t)blockIdx.x * (NWAVES * 64) + F.tid; i < nvec; i += stride) {
        const int row = (int)(i >> 8), col = (int)(i & 255) * 8, b = row >> 11;
        const f32x4 x0 = *(const f32x4*)(x + (size_t)row * DM + col), x1 = *(const f32x4*)(x + (size_t)row * DM + col + 4);
        const float* mp = mod + (size_t)b * MODW + col;
        const f32x4 sh0 = *(const f32x4*)mp, sh1 = *(const f32x4*)(mp + 4), sc0 = *(const f32x4*)(mp + DM), sc1 = *(const f32x4*)(mp + DM + 4);
        const f32x4 h0 = x0 * (sc0 + 1.0f) + sh0, h1 = x1 * (sc1 + 1.0f) + sh1;
        v4u o; o.x = pk2(h0[0], h0[1]); o.y = pk2(h0[2], h0[3]); o.z = pk2(h1[0], h1[1]); o.w = pk2(h1[2], h1[3]);
        *(v4u*)(H + (size_t)row * DM + col) = o;
    }
}

typedef short sg_bf16x8 __attribute__((ext_vector_type(8)));
typedef float sg_f32x16 __attribute__((ext_vector_type(16)));
constexpr int SG_VT = 0, SG_LD = 136, SG_ST = 36864;
__device__ __forceinline__ void p3_sgu(Frame& F) {
    LAS bf16* vnT = (LAS bf16*)(F.lds + SG_VT); LAS float* stS = (LAS float*)(F.lds + SG_ST);
    const bf16* U = (const bf16*)(F.ws + WS_U); const bf16* VT = (const bf16*)(F.ws + WS_V); bf16* AB = (bf16*)(F.ws + WS_H);
    const bf16* Wb = (const bf16*)(F.ws + WS_SGW); const float* stv = (const float*)(F.ws + WS_STV);
    const float* lng = F.in[I_SLNG]; const float* lnb = F.in[I_SLNB]; const float* sb = F.in[I_SB];
    const int tid = F.tid, lane = F.lane, w = F.wave, r = lane & 31, h = lane >> 5;
    for (int item = blockIdx.x; item < 1024; item += F.G) {
        const int b = item >> 7, n = (item >> 3) & 15, g = item & 7, tok0 = b * SEQ + n * 128;
        if (tid < 128) { float s = 0.f, q = 0.f; const float* sp = stv + (size_t)(tok0 + tid) * 32;
#pragma unroll
            for (int i = 0; i < 16; ++i) { const f32x2 pr = *(const f32x2*)(sp + 2 * i); s += pr.x; q += pr.y; }
            const float mean = s * (1.0f / 1024.0f); float var = q * (1.0f / 1024.0f) - mean * mean; var = var > 0.f ? var : 0.f;
            *(LAS f32x2*)(stS + 2 * tid) = (f32x2){mean, 1.0f / sqrtf(var + LN_EPS)}; }
        __syncthreads();
        { const int c = tid >> 2, pseg = (tid & 3) * 32, ch = g * 128 + c; const float gg = lng[ch], bb = lnb[ch];
          const bf16* vp = VT + (size_t)ch * MTOK + tok0 + pseg;
          v4u wv[4];
#pragma unroll
          for (int k = 0; k < 4; ++k) wv[k] = *(const v4u*)(vp + 8 * k);
#pragma unroll
          for (int k = 0; k < 4; ++k) {
              const float e[8] = {bflo(wv[k].x), bfhi(wv[k].x), bflo(wv[k].y), bfhi(wv[k].y), bflo(wv[k].z), bfhi(wv[k].z), bflo(wv[k].w), bfhi(wv[k].w)};
              float o[8];
#pragma unroll
              for (int i = 0; i < 8; i += 2) { const f32x4 st = *(const LAS f32x4*)(stS + 2 * (pseg + 8 * k + i));
                  o[i] = (e[i] - st[0]) * st[1] * gg + bb; o[i + 1] = (e[i + 1] - st[2]) * st[3] * gg + bb; }
              v4u pk; pk.x = pk2(o[0], o[1]); pk.y = pk2(o[2], o[3]); pk.z = pk2(o[4], o[5]); pk.w = pk2(o[6], o[7]);
              *(LAS v4u*)(vnT + c * SG_LD + pseg + 8 * k) = pk; } }
        const int q0 = 32 * (w >> 1), ct0 = 2 * (w & 1);
        sg_bf16x8 af[8];
#pragma unroll
        for (int kk = 0; kk < 8; ++kk) af[kk] = *(const sg_bf16x8*)(Wb + (size_t)(g * 128 + q0 + r) * 128 + 16 * kk + 8 * h);
        __syncthreads();
        sg_f32x16 acc[2];
#pragma unroll
        for (int ct = 0; ct < 2; ++ct)
#pragma unroll
            for (int i = 0; i < 16; ++i) acc[ct][i] = 0.f;
#pragma unroll
        for (int kk = 0; kk < 8; ++kk)
#pragma unroll
            for (int ct = 0; ct < 2; ++ct) {
                const sg_bf16x8 bf = *(const LAS sg_bf16x8*)(vnT + ((ct0 + ct) * 32 + r) * SG_LD + 16 * kk + 8 * h);
                acc[ct] = __builtin_amdgcn_mfma_f32_32x32x16_bf16(af[kk], bf, acc[ct], 0, 0, 0);
            }
#pragma unroll
        for (int ct = 0; ct < 2; ++ct) {
            const int c = (ct0 + ct) * 32 + r;
#pragma unroll
            for (int rg = 0; rg < 16; ++rg) {
                const int q = q0 + (rg & 3) + 8 * (rg >> 2) + 4 * h;
                const float uv = bf1(U[(size_t)(tok0 + q) * SGUW + g * 128 + c]);
                AB[(size_t)(tok0 + q) * DM + g * 128 + c] = (bf16)f2bf(uv * (acc[ct][rg] + sb[g * 128 + q]));
            }
        }
        __syncthreads();
    }
}

__device__ __forceinline__ float sconv(const bf16* ZHT, const float* cw, const float* cb, int ch, int b, int t) {
    const bf16* zp = ZHT + (size_t)ch * MTOK + b * SEQ;
    const float z0 = t > 0 ? bf1(zp[t - 1]) : 0.f, z1 = bf1(zp[t]), z2 = t < SEQ - 1 ? bf1(zp[t + 1]) : 0.f;
    return cw[ch] * z0 + cw[3072 + ch] * z1 + cw[6144 + ch] * z2 + cb[ch];
}
__device__ __forceinline__ void p3_hyena(Frame& F) {
    LAS float* Us = (LAS float*)F.lds;
    LAS float* KF = (LAS float*)(F.lds + 65536);
    const bf16* ZHT = (const bf16*)(F.ws + WS_ZHT); const float* FILT = (const float*)(F.ws + WS_FILT); bf16* AB = (bf16*)(F.ws + WS_H);
    const float* cw = F.in[I_HCW]; const float* cb = F.in[I_HCB]; const float* skip = F.in[I_HSKIP];
    const int tid = F.tid;
    for (int item = blockIdx.x; item < HYW; item += F.G) {
        const int c = item;
        for (int i = tid; i < NBATCH * SEQ; i += NWAVES * 64) { const int b = i >> 11, t = i & 2047; Us[t * 8 + b] = sconv(ZHT, cw, cb, c, b, t); }
        for (int n = 0; n < 2; ++n) {
            const float* hf = FILT + (size_t)((0 * 2 + n) * 1024 + c) * SEQ; const float* hb = FILT + (size_t)((1 * 2 + n) * 1024 + c) * SEQ;
            for (int i = tid; i < 4095; i += NWAVES * 64) { const int lag = i - 2047; KF[i] = lag > 0 ? hf[lag] : (lag == 0 ? hf[0] + hb[0] : hb[-lag]); }
            __syncthreads();
            f32x4 acc[4][2];
#pragma unroll
            for (int ti = 0; ti < 4; ++ti) { acc[ti][0] = (f32x4){0.f, 0.f, 0.f, 0.f}; acc[ti][1] = (f32x4){0.f, 0.f, 0.f, 0.f}; }
            const LAS float* kp = KF + tid + 2047;
            for (int s = 0; s < SEQ; ++s) {
                const f32x4 u0 = *(const LAS f32x4*)(Us + s * 8), u1 = *(const LAS f32x4*)(Us + s * 8 + 4);
#pragma unroll
                for (int ti = 0; ti < 4; ++ti) { const float kv = kp[512 * ti - s]; acc[ti][0] += u0 * kv; acc[ti][1] += u1 * kv; }
            }
            __syncthreads();
            const float sk = skip[n * 1024 + c];
#pragma unroll
            for (int ti = 0; ti < 4; ++ti) { const int t = tid + 512 * ti;
#pragma unroll
                for (int b = 0; b < 8; ++b) {
                    const float uv = Us[t * 8 + b], gate = sconv(ZHT, cw, cb, (n + 1) * 1024 + c, b, t);
                    const float y = gate * (acc[ti][b >> 2][b & 3] + sk * uv);
                    if (n == 0) Us[t * 8 + b] = y; else AB[(size_t)(b * SEQ + t) * DM + 1024 + c] = (bf16)f2bf(y);
                } }
            __syncthreads();
        }
    }
}

#ifndef HYFFT_HD
#define HYFFT_HD __device__ __forceinline__
#define HYFFT_LAS __attribute__((address_space(3)))
#endif
typedef float hy_c32 __attribute__((ext_vector_type(2)));
HYFFT_HD int hy_padi(int i) { return i + (i >> 3); }
HYFFT_HD int hy_rev(int x) { return ((x & 7) << 9) | (((x >> 3) & 7) << 6) | (((x >> 6) & 7) << 3) | ((x >> 9) & 7); }

template <bool INV> HYFFT_HD void hy_dft8(float (&re)[8], float (&im)[8]) {
    const float h = 0.70710678118654752f;
    float ar[4], ai[4], br[4], bi[4];
#pragma unroll
    for (int m = 0; m < 4; ++m) { ar[m] = re[m] + re[m + 4]; ai[m] = im[m] + im[m + 4]; br[m] = re[m] - re[m + 4]; bi[m] = im[m] - im[m + 4]; }
    { float x = br[1], y = bi[1]; if (!INV) { br[1] = h * (x + y); bi[1] = h * (y - x); } else { br[1] = h * (x - y); bi[1] = h * (y + x); } }
    { float x = br[2], y = bi[2]; if (!INV) { br[2] = y; bi[2] = -x; } else { br[2] = -y; bi[2] = x; } }
    { float x = br[3], y = bi[3]; if (!INV) { br[3] = h * (y - x); bi[3] = -h * (x + y); } else { br[3] = -h * (x + y); bi[3] = h * (x - y); } }
#pragma unroll
    for (int s = 0; s < 2; ++s) {
        float* cr = s ? br : ar; float* ci = s ? bi : ai;
        const float e0r = cr[0] + cr[2], e0i = ci[0] + ci[2], e1r = cr[0] - cr[2], e1i = ci[0] - ci[2];
        const float o0r = cr[1] + cr[3], o0i = ci[1] + ci[3]; const float dr = cr[1] - cr[3], di = ci[1] - ci[3];
        float o1r, o1i; if (!INV) { o1r = di; o1i = -dr; } else { o1r = -di; o1i = dr; }
        re[0 + s] = e0r + o0r; im[0 + s] = e0i + o0i;
        re[2 + s] = e1r + o1r; im[2 + s] = e1i + o1i;
        re[4 + s] = e0r - o0r; im[4 + s] = e0i - o0i;
        re[6 + s] = e1r - o1r; im[6 + s] = e1i - o1i;
    }
}
template <bool CONJ> HYFFT_HD void hy_twiddle(float (&re)[8], float (&im)[8], float wr, float wi) {
    if (CONJ) wi = -wi;
    const float w2r = wr * wr - wi * wi, w2i = 2.f * wr * wi;
    const float w3r = w2r * wr - w2i * wi, w3i = w2r * wi + w2i * wr;
    const float w4r = w2r * w2r - w2i * w2i, w4i = 2.f * w2r * w2i;
    const float w5r = w4r * wr - w4i * wi, w5i = w4r * wi + w4i * wr;
    const float w6r = w3r * w3r - w3i * w3i, w6i = 2.f * w3r * w3i;
    const float w7r = w4r * w3r - w4i * w3i, w7i = w4r * w3i + w4i * w3r;
    const float pr[8] = {1.f, wr, w2r, w3r, w4r, w5r, w6r, w7r}, pi[8] = {0.f, wi, w2i, w3i, w4i, w5i, w6i, w7i};
#pragma unroll
    for (int k = 1; k < 8; ++k) { const float x = re[k], y = im[k]; re[k] = x * pr[k] - y * pi[k]; im[k] = x * pi[k] + y * pr[k]; }
}
template <int L, class BP, class TP> HYFFT_HD void hy_fwd_store(BP buf, TP tw, int j, float (&re)[8], float (&im)[8]) {
    constexpr int S = L / 8; const int blk = j / S, q = j % S, base = blk * L + q;
    hy_dft8<false>(re, im);
    if (L > 8) { const hy_c32 w = tw[q * (4096 / L)]; hy_twiddle<false>(re, im, w.x, w.y); }
#pragma unroll
    for (int k = 0; k < 8; ++k) buf[hy_padi(base + k * S)] = (hy_c32){re[k], im[k]};
}
template <int L, class BP> HYFFT_HD void hy_load8(BP buf, int j, float (&re)[8], float (&im)[8]) {
    constexpr int S = L / 8; const int blk = j / S, q = j % S, base = blk * L + q;
#pragma unroll
    for (int k = 0; k < 8; ++k) { const hy_c32 v = buf[hy_padi(base + k * S)]; re[k] = v.x; im[k] = v.y; }
}
template <int L, class BP, class TP> HYFFT_HD void hy_fwd_stage(BP buf, TP tw, int j) { float re[8], im[8]; hy_load8<L>(buf, j, re, im); hy_fwd_store<L>(buf, tw, j, re, im); }
template <int L, class BP, class TP> HYFFT_HD void hy_inv_regs(BP buf, TP tw, int j, float (&re)[8], float (&im)[8]) {
    constexpr int S = L / 8; const int q = j % S;
    hy_load8<L>(buf, j, re, im);
    if (L > 8) { const hy_c32 w = tw[q * (4096 / L)]; hy_twiddle<true>(re, im, w.x, w.y); }
    hy_dft8<true>(re, im);
}
template <int L, class BP, class TP> HYFFT_HD void hy_inv_stage(BP buf, TP tw, int j) {
    constexpr int S = L / 8; const int blk = j / S, q = j % S, base = blk * L + q;
    float re[8], im[8]; hy_inv_regs<L>(buf, tw, j, re, im);
#pragma unroll
    for (int k = 0; k < 8; ++k) buf[hy_padi(base + k * S)] = (hy_c32){re[k], im[k]};
}
template <class BP, class KP> HYFFT_HD void hy_mid_stage(BP buf, KP K, int j) {
    float re[8], im[8]; hy_load8<8>(buf, j, re, im);
    hy_dft8<false>(re, im);
#pragma unroll
    for (int k = 0; k < 8; ++k) { const hy_c32 kv = K[hy_padi(8 * j + k)]; const float x = re[k], y = im[k]; re[k] = x * kv.x - y * kv.y; im[k] = x * kv.y + y * kv.x; }
    hy_dft8<true>(re, im);
#pragma unroll
    for (int k = 0; k < 8; ++k) buf[hy_padi(8 * j + k)] = (hy_c32){re[k], im[k]};
}
template <class BP> HYFFT_HD void hy_last_fwd(BP buf, int j) {
    float re[8], im[8]; hy_load8<8>(buf, j, re, im); hy_dft8<false>(re, im);
#pragma unroll
    for (int k = 0; k < 8; ++k) buf[hy_padi(8 * j + k)] = (hy_c32){re[k], im[k]};
}
template <class BP, class KP> HYFFT_HD void hy_separate(BP Z, KP K1, KP K2, int j) {
    const float sc = 0.5f / 4096.0f;
#pragma unroll
    for (int r = 0; r < 8; ++r) {
        const int p = j + 512 * r, f = hy_rev(p), g = (4096 - f) & 4095, p2 = hy_rev(g);
        const hy_c32 a = Z[hy_padi(p)], b = Z[hy_padi(p2)];
        K1[hy_padi(p)] = (hy_c32){(a.x + b.x) * sc, (a.y - b.y) * sc};
        K2[hy_padi(p)] = (hy_c32){(a.y + b.y) * sc, (b.x - a.x) * sc};
    }
}

constexpr int HY_BUF = 0, HY_K1 = 36864, HY_K2 = 73728, HY_TW = 110592;
__device__ __forceinline__ float sconv3(const bf16* zp, int t, float w0, float w1, float w2, float cb) {
    const float z0 = t > 0 ? bf1(zp[t - 1]) : 0.f, z1 = bf1(zp[t]), z2 = t < SEQ - 1 ? bf1(zp[t + 1]) : 0.f;
    return w0 * z0 + w1 * z1 + w2 * z2 + cb;
}
__device__ __forceinline__ void p3_hyena_fft(Frame& F) {
    LAS hy_c32* BUF = (LAS hy_c32*)(F.lds + HY_BUF); LAS hy_c32* K1 = (LAS hy_c32*)(F.lds + HY_K1); LAS hy_c32* K2 = (LAS hy_c32*)(F.lds + HY_K2);
    LAS hy_c32* TW = (LAS hy_c32*)(F.lds + HY_TW);
    const bf16* ZHT = (const bf16*)(F.ws + WS_ZHT); const float* FILT = (const float*)(F.ws + WS_FILT); bf16* AB = (bf16*)(F.ws + WS_H);
    const float* cw = F.in[I_HCW]; const float* cb = F.in[I_HCB]; const float* skip = F.in[I_HSKIP];
    const int j = F.tid;
    { float sn, cs; sincosf(-6.283185307179586f * (float)j / 4096.0f, &sn, &cs); TW[j] = (hy_c32){cs, sn}; }
    __syncthreads();
    for (int item = blockIdx.x; item < HYW; item += F.G) {
        const int c = item;
        float re[8], im[8];
        {
            const float* hf0 = FILT + (size_t)(0 * 1024 + c) * SEQ; const float* hf1 = FILT + (size_t)(1 * 1024 + c) * SEQ;
            const float* hb0 = FILT + (size_t)(2 * 1024 + c) * SEQ; const float* hb1 = FILT + (size_t)(3 * 1024 + c) * SEQ;
#pragma unroll
            for (int m = 0; m < 4; ++m) { const int i = j + 512 * m; re[m] = hf0[i]; im[m] = hf1[i]; }
            if (j == 0) { re[0] += hb0[0]; im[0] += hb1[0]; }
#pragma unroll
            for (int m = 4; m < 8; ++m) { const int i = j + 512 * m; const bool z = (i == 2048); const int r = z ? 0 : 4096 - i; const float a = hb0[r], b = hb1[r]; re[m] = z ? 0.f : a; im[m] = z ? 0.f : b; }
            hy_fwd_store<4096>(BUF, TW, j, re, im); __syncthreads();
            hy_fwd_stage<512>(BUF, TW, j); __syncthreads();
            hy_fwd_stage<64>(BUF, TW, j); __syncthreads();
            hy_last_fwd(BUF, j); __syncthreads();
            hy_separate(BUF, K1, K2, j); __syncthreads();
        }
        const float vw0 = cw[c], vw1 = cw[3072 + c], vw2 = cw[6144 + c], vcb = cb[c];
        const float aw0 = cw[1024 + c], aw1 = cw[3072 + 1024 + c], aw2 = cw[6144 + 1024 + c], acb = cb[1024 + c];
        const float bw0 = cw[2048 + c], bw1 = cw[3072 + 2048 + c], bw2 = cw[6144 + 2048 + c], bcb = cb[2048 + c];
        const float sk0 = skip[c], sk1 = skip[1024 + c];
        for (int p = 0; p < 4; ++p) {
            const bf16* zv0 = ZHT + (size_t)c * MTOK + (2 * p) * SEQ; const bf16* zv1 = zv0 + SEQ;
            const bf16* za0 = ZHT + (size_t)(1024 + c) * MTOK + (2 * p) * SEQ; const bf16* za1 = za0 + SEQ;
            const bf16* zb0 = ZHT + (size_t)(2048 + c) * MTOK + (2 * p) * SEQ; const bf16* zb1 = zb0 + SEQ;
            float v0[4], v1[4], g0[4], g1[4];
#pragma unroll
            for (int m = 0; m < 4; ++m) { const int t = j + 512 * m; v0[m] = sconv3(zv0, t, vw0, vw1, vw2, vcb); v1[m] = sconv3(zv1, t, vw0, vw1, vw2, vcb);
                g0[m] = sconv3(za0, t, aw0, aw1, aw2, acb); g1[m] = sconv3(za1, t, aw0, aw1, aw2, acb); }
#pragma unroll
            for (int m = 0; m < 4; ++m) { re[m] = v0[m]; im[m] = v1[m]; re[m + 4] = 0.f; im[m + 4] = 0.f; }
            hy_fwd_store<4096>(BUF, TW, j, re, im); __syncthreads();
            hy_fwd_stage<512>(BUF, TW, j); __syncthreads();
            hy_fwd_stage<64>(BUF, TW, j); __syncthreads();
            hy_mid_stage(BUF, K1, j); __syncthreads();
            hy_inv_stage<64>(BUF, TW, j); __syncthreads();
            hy_inv_stage<512>(BUF, TW, j); __syncthreads();
            hy_inv_regs<4096>(BUF, TW, j, re, im);
#pragma unroll
            for (int m = 0; m < 4; ++m) { v0[m] = g0[m] * (re[m] + sk0 * v0[m]); v1[m] = g1[m] * (im[m] + sk0 * v1[m]); }
#pragma unroll
            for (int m = 0; m < 4; ++m) { const int t = j + 512 * m; g0[m] = sconv3(zb0, t, bw0, bw1, bw2, bcb); g1[m] = sconv3(zb1, t, bw0, bw1, bw2, bcb); }
#pragma unroll
            for (int m = 0; m < 4; ++m) { re[m] = v0[m]; im[m] = v1[m]; re[m + 4] = 0.f; im[m + 4] = 0.f; }
            hy_fwd_store<4096>(BUF, TW, j, re, im); __syncthreads();
            hy_fwd_stage<512>(BUF, TW, j); __syncthreads();
            hy_fwd_stage<64>(BUF, TW, j); __syncthreads();
            hy_mid_stage(BUF, K2, j); __syncthreads();
            hy_inv_stage<64>(BUF, TW, j); __syncthreads();
            hy_inv_stage<512>(BUF, TW, j); __syncthreads();
            hy_inv_regs<4096>(BUF, TW, j, re, im);
#pragma unroll
            for (int m = 0; m < 4; ++m) { const int t = j + 512 * m;
                const float y0 = g0[m] * (re[m] + sk1 * v0[m]), y1 = g1[m] * (im[m] + sk1 * v1[m]);
                AB[(size_t)((2 * p) * SEQ + t) * DM + 1024 + c] = (bf16)f2bf(y0); AB[(size_t)((2 * p + 1) * SEQ + t) * DM + 1024 + c] = (bf16)f2bf(y1); }
        }
        __syncthreads();
    }
}

template <bool FINAL> __device__ __forceinline__ void ln_rows(Frame& F) {
    float* R = F.out; const float* st = (const float*)(F.ws + (FINAL ? WS_ST2 : WS_ST1)); float* MU = (float*)(F.ws + WS_MU1);
    const float* mod = (const float*)(F.ws + WS_MOD); bf16* H2 = (bf16*)(F.ws + WS_H);
    const float* lng = F.in[FINAL ? I_LN2G : I_LN1G]; const float* lnb = F.in[FINAL ? I_LN2B : I_LN1B];
    const int gw = blockIdx.x * NWAVES + F.wave, NGW = F.G * NWAVES, lane = F.lane;
    for (int row = gw; row < MTOK; row += NGW) {
        float s = 0.f, q = 0.f; if (lane < 32) { const f32x2 p = *(const f32x2*)(st + ((size_t)row * 32 + lane) * 2); s = p.x; q = p.y; }
        s = wave_sum(s); q = wave_sum(q);
        const float mean = s * (1.0f / DM); float var = q * (1.0f / DM) - mean * mean; var = var > 0.f ? var : 0.f; const float rstd = 1.0f / sqrtf(var + LN_EPS);
        if (!FINAL && lane == 0) *(f32x2*)(MU + (size_t)row * 2) = (f32x2){mean, rstd};
        const int b = row >> 11; float* rp = R + (size_t)row * DM;
#pragma unroll
        for (int j = 0; j < 8; ++j) { const int col = 4 * lane + 256 * j;
            const f32x4 v = *(const f32x4*)(rp + col); const f32x4 y = (v - mean) * rstd * *(const f32x4*)(lng + col) + *(const f32x4*)(lnb + col);
            if (FINAL) *(f32x4*)(rp + col) = y;
            else { const float* mp = mod + (size_t)b * MODW + col; const f32x4 h = y * (*(const f32x4*)(mp + 4 * DM) + 1.0f) + *(const f32x4*)(mp + 3 * DM);
                   v2u o; o.x = pk2(h[0], h[1]); o.y = pk2(h[2], h[3]); *(v2u*)(H2 + (size_t)row * DM + col) = o; } }
    }
}

typedef GAS unsigned gu32;
#define RLX_AGENT __ATOMIC_RELAXED, __HIP_MEMORY_SCOPE_AGENT
constexpr int LDSCTL_OFF = 131072, MISC_OFF = LDSCTL_OFF + 320;
constexpr int CW_BAR = 4096;
constexpr size_t CTL_ZERO_BYTES = 65536;
#define XB_TMO      128
#define XB_XCNT(j)  (256  + 64 * (j))
#define XB_XSUB(j)  (1280 + 64 * (j))
#define XB_XGEN(j)  (2304 + 64 * (j))
#define XB_TOP      3328
#define XB_TOPGEN   3392
#define XCD_BAR_WORDS 3456
#define XB_SPIN_CAP (1u << 18)

__device__ __forceinline__ unsigned xb_ld(unsigned* p)              { return __hip_atomic_load(p, __ATOMIC_RELAXED, __HIP_MEMORY_SCOPE_AGENT); }
__device__ __forceinline__ unsigned xb_add(unsigned* p, unsigned v) { return __hip_atomic_fetch_add(p, v, __ATOMIC_RELAXED, __HIP_MEMORY_SCOPE_AGENT); }
__device__ __forceinline__ unsigned xb_xcc_id() { return (unsigned)__builtin_amdgcn_s_getreg((3 << 11) | 20) & 0xFu; }
#define XB_SPIN(cond, bar) do { unsigned _sp = 0; while (cond) { __builtin_amdgcn_s_sleep(1); \
    if ((++_sp & 255u) == 0u) { if (xb_ld(&(bar)[XB_TMO])) break; if (_sp > XB_SPIN_CAP) { atomicAdd(&(bar)[XB_TMO], 1u); break; } } } } while (0)

struct XcdBarrier {
    unsigned* bar; unsigned x;
    volatile LAS unsigned* st;
};

__device__ __forceinline__ XcdBarrier xcd_barrier_post(unsigned* bar, volatile LAS unsigned* st) {
    XcdBarrier b; b.bar = bar; b.x = xb_xcc_id(); b.st = st;
    if (threadIdx.x == 0) (void)xb_add(&bar[XB_XCNT(b.x)], 1u);
    return b;
}
__device__ __forceinline__ void xcd_barrier_complete(unsigned* bar, unsigned x, unsigned& nloc, unsigned& nx) {
    const unsigned G = gridDim.x * gridDim.y * gridDim.z;
    unsigned sum, cnt, mine, sp = 0u;
    for (;;) {
        sum = 0u; cnt = 0u; mine = 0u;
#pragma unroll
        for (unsigned j = 0; j < 16; ++j) { const unsigned c = xb_ld(&bar[XB_XCNT(j)]); sum += c; cnt += (c > 0u) ? 1u : 0u; mine = (j == x) ? c : mine; }
        if (sum == G) break;
        __builtin_amdgcn_s_sleep(1);
        if ((++sp & 255u) == 0u) { if (xb_ld(&bar[XB_TMO])) break; if (sp > XB_SPIN_CAP) { atomicAdd(&bar[XB_TMO], 1u); break; } }
    }
    nloc = mine > 0u ? mine : 1u; nx = cnt > 0u ? cnt : 1u;
}

__device__ __forceinline__ void xcd_barrier(const XcdBarrier& b) {
    asm volatile("s_waitcnt vmcnt(0)" ::: "memory");
    __syncthreads();
    if (threadIdx.x == 0) {
        unsigned* bar = b.bar;
        __builtin_amdgcn_s_waitcnt(0);
        unsigned nloc = b.st[0], nx = b.st[1];
        if (nloc == 0u) { xcd_barrier_complete(bar, b.x, nloc, nx); b.st[0] = nloc; b.st[1] = nx; }
        const unsigned old = xb_add(&bar[XB_XSUB(b.x)], 1u);
        const unsigned gen = old / nloc;
        if (old + 1u == (gen + 1u) * nloc) {
            __builtin_amdgcn_fence(__ATOMIC_RELEASE, "agent");
            asm volatile("s_waitcnt vmcnt(0)" ::: "memory");
            const unsigned og = xb_add(&bar[XB_TOP], 1u);
            const unsigned tg = og / nx;
            if (og + 1u == (tg + 1u) * nx) xb_add(&bar[XB_TOPGEN], 1u);
            else XB_SPIN(xb_ld(&bar[XB_TOPGEN]) == tg, bar);
            __builtin_amdgcn_fence(__ATOMIC_ACQUIRE, "agent");
            xb_add(&bar[XB_XGEN(b.x)], 1u);
            asm volatile("s_waitcnt vmcnt(0)" ::: "memory");
        } else {
            XB_SPIN(xb_ld(&bar[XB_XGEN(b.x)]) == gen, bar);
            __builtin_amdgcn_fence(__ATOMIC_ACQUIRE, "agent");
            asm volatile("s_waitcnt vmcnt(0)" ::: "memory");
        }
    }
    __syncthreads();
}

#define GRID_SYNC() xcd_barrier(bar)

__global__ void __launch_bounds__(NWAVES * 64, 2) fwd_megakernel(Args args) {
    extern __shared__ __attribute__((aligned(16))) unsigned char lds[];
    Frame F;
    F.lds = (LAS unsigned char*)lds;
    F.tid = threadIdx.x; F.lane = F.tid & 63; F.wave = __builtin_amdgcn_readfirstlane(F.tid >> 6); F.G = gridDim.x;
    F.in = args.in; F.out = args.out; F.ws = args.ws;
    for (int u = F.tid; u < (LDS_BYTES - LDSCTL_OFF) / 4; u += NWAVES * 64) ((LAS unsigned*)(F.lds + LDSCTL_OFF))[u] = 0u;
    __syncthreads();
    XcdBarrier bar = xcd_barrier_post((unsigned*)(args.ws + WS_CTL) + CW_BAR, (volatile LAS unsigned*)(F.lds + MISC_OFF) + 8);
    unsigned char* ws = args.ws;
    const int lo = args.ph_lo, hi = args.ph_hi;
#define IN(k) (lo <= (k) && (k) < hi)
#define BOTH(k) (IN(k) && IN((k) + 1))
    const int gw = blockIdx.x * NWAVES + F.wave, NGW = F.G * NWAVES;

    if (IN(0)) {
        p0_mod(F);
        transpose_matrix(F, F.in[I_WIN], DM, INW, (bf16*)(ws + WS_WIN), DM, 0, 1, (int)blockIdx.x, F.G);
        transpose_matrix(F, F.in[I_WA], SGUW, DM, (bf16*)(ws + WS_WAB), DM, 0, 0, (int)((blockIdx.x + 128) % F.G), F.G);
        transpose_matrix(F, F.in[I_WB], HYW, DM, (bf16*)(ws + WS_WAB), DM, 1024, 0, (int)blockIdx.x, F.G);
        transpose_matrix(F, F.in[I_WO], DM, DM, (bf16*)(ws + WS_WO), DM, 0, 0, (int)blockIdx.x, F.G);
        { const float* sw = F.in[I_SW]; bf16* sgw = (bf16*)(ws + WS_SGW);
          for (int i = blockIdx.x * (NWAVES * 64) + F.tid; i < 8 * 128 * 128 / 2; i += F.G * NWAVES * 64) { const f32x2 v = *(const f32x2*)(sw + 2 * i); *(unsigned*)(sgw + 2 * i) = pk2(v.x, v.y); } }
        __syncthreads();
        p0_filter(F);
        if (BOTH(0)) GRID_SYNC();
    }
    if (IN(1)) { p1_modulate(F); if (BOTH(1)) GRID_SYNC(); }
    if (IN(2)) {
        { pg8::Gemm g{(const pg8::bf16_t*)(ws + WS_H), (const pg8::bf16_t*)(ws + WS_WIN), MTOK, 5120, DM}; pg8::StaticOrder S; S.init(MTOK, 5120, F.G, (int)blockIdx.x);
          pg8::EpiG1 E{(pg8::bf16_t*)(ws + WS_U), (pg8::bf16_t*)(ws + WS_G), F.in[I_BIN]};
          pg8::gemm_phase<pg8::EpiG1, pg8::StaticOrder, true, true>(F.lds, g, S, E); }
        __syncthreads();
        { pg8::Gemm g{(const pg8::bf16_t*)(ws + WS_WIN) + (size_t)5120 * DM, (const pg8::bf16_t*)(ws + WS_H), 4096, MTOK, DM}; pg8::StaticOrder S; S.init(4096, MTOK, F.G, (int)blockIdx.x);
          pg8::EpiG1T E{(pg8::bf16_t*)(ws + WS_V), (pg8::bf16_t*)(ws + WS_ZHT), F.in[I_BIN], (float*)(ws + WS_STV)};
          pg8::gemm_phase<pg8::EpiG1T, pg8::StaticOrder, true, true>(F.lds, g, S, E); }
        if (BOTH(2)) GRID_SYNC();
    }
    if (IN(3)) { __syncthreads(); p3_sgu(F); p3_hyena_fft(F); if (BOTH(3)) GRID_SYNC(); }
    if (IN(4)) {
        pg8::Gemm g{(const pg8::bf16_t*)(ws + WS_H), (const pg8::bf16_t*)(ws + WS_WAB), MTOK, DM, DM}; pg8::StaticOrder S; S.init(MTOK, DM, F.G, (int)blockIdx.x);
        pg8::EpiG2 E{(const pg8::bf16_t*)(ws + WS_G), (pg8::bf16_t*)(ws + WS_MERGED)};
        pg8::gemm_phase<pg8::EpiG2, pg8::StaticOrder, true, true>(F.lds, g, S, E);
        if (BOTH(4)) GRID_SYNC();
    }
    if (IN(5)) {
        pg8::Gemm g{(const pg8::bf16_t*)(ws + WS_MERGED), (const pg8::bf16_t*)(ws + WS_WO), MTOK, DM, DM}; pg8::StaticOrder S; S.init(MTOK, DM, F.G, (int)blockIdx.x);
        pg8::EpiRes<true> E{F.in[I_X], F.out, (const float*)(ws + WS_MOD) + 2 * DM, F.in[I_BO], nullptr, nullptr, nullptr, (float*)(ws + WS_ST1)};
        pg8::gemm_phase<pg8::EpiRes<true>, pg8::StaticOrder, true, true>(F.lds, g, S, E);
        if (BOTH(5)) GRID_SYNC();
    }
    if (IN(6)) {
        __syncthreads();
        ln_rows<false>(F);
        __syncthreads();
        transpose_matrix(F, F.in[I_WM1], DM, DFF, (bf16*)(ws + WS_WM1), DM, 0, 0, (int)blockIdx.x, F.G);
        transpose_matrix(F, F.in[I_WM2], DFF, DM, (bf16*)(ws + WS_WM2), DFF, 0, 0, (int)blockIdx.x, F.G);
        if (BOTH(6)) GRID_SYNC();
    }
    if (IN(7)) {
        __syncthreads();
        pg8::Gemm g{(const pg8::bf16_t*)(ws + WS_H), (const pg8::bf16_t*)(ws + WS_WM1), MTOK, DFF, DM}; pg8::StaticOrder S; S.init(MTOK, DFF, F.G, (int)blockIdx.x);
        pg8::EpiG4 E{(pg8::bf16_t*)(ws + WS_AFF), F.in[I_BM1]};
        pg8::gemm_phase<pg8::EpiG4, pg8::StaticOrder, true, true>(F.lds, g, S, E);
        if (BOTH(7)) GRID_SYNC();
    }
    if (IN(8)) {
        pg8::Gemm g{(const pg8::bf16_t*)(ws + WS_AFF), (const pg8::bf16_t*)(ws + WS_WM2), MTOK, DM, DFF}; pg8::StaticOrder S; S.init(MTOK, DM, F.G, (int)blockIdx.x);
        pg8::EpiRes<false> E{nullptr, F.out, (const float*)(ws + WS_MOD) + 5 * DM, F.in[I_BM2], F.in[I_LN1G], F.in[I_LN1B], (const float*)(ws + WS_MU1), (float*)(ws + WS_ST2)};
        pg8::gemm_phase<pg8::EpiRes<false>, pg8::StaticOrder, true, true>(F.lds, g, S, E);
        if (BOTH(8)) GRID_SYNC();
    }
    if (IN(9)) { ln_rows<true>(F); }
#undef IN
#undef BOTH
}

constexpr int N_PHASES = 10;
#ifndef MK_N_LAUNCHES
#define MK_N_LAUNCHES 1
#endif
extern "C" void kernel_launch(void* const* d_in, const int* in_sizes, int n_in, void* d_out, int out_size, void* d_ws, size_t ws_size, hipStream_t stream) {
    static int grid = 0;
    if (grid == 0) {
        if (n_in != 31 || in_sizes[0] != MTOK * DM || out_size != MTOK * DM || ws_size < WS_END) {
            fprintf(stderr, "kernel_launch: unexpected problem: n_in %d in0 %d out %d ws %zu (need %zu)\n", n_in, n_in > 0 ? in_sizes[0] : -1, out_size, ws_size, (size_t)WS_END); grid = -1; return; }
        int dev = 0, cus = 0, per_cu = 0;
        if (hipGetDevice(&dev) != hipSuccess || hipDeviceGetAttribute(&cus, hipDeviceAttributeMultiprocessorCount, dev) != hipSuccess) { grid = -1; return; }
        if (hipFuncSetAttribute((const void*)fwd_megakernel, hipFuncAttributeMaxDynamicSharedMemorySize, LDS_BYTES) != hipSuccess) { fprintf(stderr, "kernel_launch: hipFuncSetAttribute failed\n"); grid = -1; return; }
        if (hipOccupancyMaxActiveBlocksPerMultiprocessor(&per_cu, (const void*)fwd_megakernel, NWAVES * 64, LDS_BYTES) != hipSuccess || per_cu < 1) { fprintf(stderr, "kernel_launch: occupancy query says %d\n", per_cu); per_cu = 1; }
        (void)hipGetLastError();
        grid = cus;
    }
    if (grid < 0) return;
    if (hipMemsetAsync((char*)d_ws + WS_CTL, 0, CTL_ZERO_BYTES, stream) != hipSuccess) { fprintf(stderr, "kernel_launch: memset failed\n"); return; }
    Args a{};
    for (int i = 0; i < 31; ++i) a.in[i] = (const float*)d_in[i];
    a.out = (float*)d_out; a.ws = (unsigned char*)d_ws;
    if (MK_N_LAUNCHES == 1) {
        a.ph_lo = 0; a.ph_hi = N_PHASES;
        void* kargs[] = {&a};
        hipError_t e = hipLaunchCooperativeKernel((const void*)fwd_megakernel, dim3(grid), dim3(NWAVES * 64), kargs, LDS_BYTES, stream);
        if (e != hipSuccess) fprintf(stderr, "kernel_launch: cooperative launch failed: %s (grid %d)\n", hipGetErrorString(e), grid);
    } else {
        for (int p = 0; p < N_PHASES; ++p) { a.ph_lo = p; a.ph_hi = p + 1; hipLaunchKernelGGL(fwd_megakernel, dim3(grid), dim3(NWAVES * 64), LDS_BYTES, stream, a); }
    }
}
```

```cpp
#include <hip/hip_runtime.h>
#include <cstdio>
#include <cstdint>

namespace pg8 {
#define PG8_LAS __attribute__((address_space(3)))
typedef unsigned short bf16_t;
typedef short bf16x8 __attribute__((ext_vector_type(8)));
typedef float f32x4 __attribute__((ext_vector_type(4)));
typedef unsigned u32x4 __attribute__((ext_vector_type(4)));
typedef float f32x2 __attribute__((ext_vector_type(2)));
constexpr int EPI_LDS_OFF = 132096;
constexpr int BM = 256, BK = 64, HALF = 128, HTB = HALF * BK * 2  , STAGE_BYTES = 8 * HTB, NXCD = 8, WGM = 8;

__host__ __device__ __forceinline__ int lds_byte(int r, int c) { const int st = (r >> 4) * 2 + (c >> 5), rr = r & 15, cc = c & 31, ob = rr * 64 + cc * 2; return st * 1024 + (ob ^ (((ob >> 9) & 1) << 5)); }
__host__ __device__ __forceinline__ void stage_rc(int b, int& R, int& C) { const int st = b / 1024, sb = b % 1024, swz = sb ^ (((sb >> 9) & 1) << 5); R = (st >> 1) * 16 + swz / 64; C = (st & 1) * 32 + (swz % 64) / 2; }
__host__ __device__ __forceinline__ int perm32(int rho) { const int n = rho >> 4, i = rho & 15; return 8 * (i >> 2) + 4 * n + (i & 3); }

struct Unit { int pm, pn; };
struct Gemm { const bf16_t* A; const bf16_t* Bt; int M, N, K; };

struct StaticOrder {
    int nM, nN, nwg, G, c;
    __host__ __device__ void init(int M, int N, int G_, int c_) { nM = M / BM; nN = N / BM; nwg = nM * nN; G = G_; c = c_; }
    __host__ __device__ bool next(int i, Unit& u) const {
        const long L = (long)i * G + c; if (L >= nwg) return false;
        int wgid = (int)L; { const int q = nwg / NXCD, r = nwg % NXCD, xcd = wgid % NXCD, off = wgid / NXCD; wgid = (xcd < r ? xcd * (q + 1) : r * (q + 1) + (xcd - r) * q) + off; }
        const int nig = WGM * nN, gid = wgid / nig, fm = gid * WGM, gsz = (nM - fm) < WGM ? (nM - fm) : WGM;
        u.pm = fm + ((wgid % nig) % gsz); u.pn = (wgid % nig) / gsz; return true;
    }
    __device__ __forceinline__ void a_ready(const Unit&) const {}
    __device__ __forceinline__ void done(const Unit&) const {}
};

__device__ __forceinline__ unsigned cvt_pk_bf16(float lo, float hi) { unsigned r; asm volatile("v_cvt_pk_bf16_f32 %0, %1, %2" : "=v"(r) : "v"(lo), "v"(hi)); return r; }
__device__ __forceinline__ f32x2 gelu_pk(f32x2 v) {
    const f32x2 av = __builtin_elementwise_abs(v), d = av * 0.2316418882f + 1.0f;
    f32x2 t; t.x = __builtin_amdgcn_rcpf(d.x); t.y = __builtin_amdgcn_rcpf(d.y);
    f32x2 q = t * 0.5307027145f + (-0.7265760135f); q = q * t + 0.7107068705f; q = q * t + (-0.142248368f); q = q * t + 0.127414796f; q = q * t;
    const f32x2 s = (v * v) * (-0.72134752044f);
    f32x2 e; e.x = __builtin_amdgcn_exp2f(s.x); e.y = __builtin_amdgcn_exp2f(s.y);
    const f32x2 m = v * (q * e), r = v - m;
    f32x2 o; o.x = v.x < 0.f ? m.x : r.x; o.y = v.y < 0.f ? m.y : r.y; return o;
}
__device__ __forceinline__ float bf_lo(unsigned w) { return __uint_as_float(w << 16); }
__device__ __forceinline__ float bf_hi(unsigned w) { return __uint_as_float(w & 0xffff0000u); }
__device__ __forceinline__ float sigmoid_f(float x) { return __builtin_amdgcn_rcpf(1.0f + __expf(-x)); }
}

constexpr int DM = 2048, NBATCH = 8, SEQ = 2048, MTOK = NBATCH * SEQ;
constexpr int SGUW = 1024, HYW = 1024, DFF = 8192, INW = 9216, MODW = 6 * DM;
constexpr float LN_EPS = 1e-5f;
constexpr float DN_ALPHA = 1.189207115002721f;

namespace pg8 {

struct EpiG1 {
    static constexpr bool PERM = true, AFTER_DRAIN = false, MID = false; static constexpr int SLOT_FLOATS = 256;
    bf16_t* U; bf16_t* G; const float* b_in;
    __device__ __forceinline__ void mid(f32x4 (&)[2][2][4][2], const Unit&, int, int, int, int) const {}
    __device__ __forceinline__ void preload(PG8_LAS float* slot, const Unit& u, int tid) const { if (tid < 256) slot[tid] = b_in[(u.pn < 4 ? u.pn * 256 : 5120 + (u.pn - 4) * 256) + tid]; }
    __device__ __forceinline__ void operator()(const f32x4 (&acc)[2][2][4][2], const Unit& u, int wr, int wc, int fr, int fq, const PG8_LAS float* slot) const {
        const int row0 = u.pm * BM + wr * 64 + fr; const int pn = u.pn;
        int ldc, colt; bf16_t* base; const bool isu = pn < 4;
        if (isu) { base = U; ldc = SGUW; colt = pn * 256; }
        else { base = G; ldc = 2 * DM; colt = (pn - 4) * 256; }
        const int cl = wc * 32 + 8 * fq;
        f32x4 bv[2][2];
#pragma unroll
        for (int bj = 0; bj < 2; ++bj)
#pragma unroll
            for (int n = 0; n < 2; ++n) bv[bj][n] = *(const PG8_LAS f32x4*)(slot + cl + bj * HALF + 4 * n);
#pragma unroll
        for (int ai = 0; ai < 2; ++ai)
#pragma unroll
            for (int m = 0; m < 4; ++m) {
                const int row = row0 + ai * HALF + m * 16;
                bf16_t* rowp = base + (size_t)row * ldc + colt + cl;
#pragma unroll
                for (int bj = 0; bj < 2; ++bj) {
                    f32x4 v0 = acc[ai][bj][m][0] + bv[bj][0], v1 = acc[ai][bj][m][1] + bv[bj][1];
                    if (isu) {
                        f32x2 a = gelu_pk((f32x2){v0[0], v0[1]}), b = gelu_pk((f32x2){v0[2], v0[3]}), c = gelu_pk((f32x2){v1[0], v1[1]}), d = gelu_pk((f32x2){v1[2], v1[3]});
                        v0 = (f32x4){a.x, a.y, b.x, b.y}; v1 = (f32x4){c.x, c.y, d.x, d.y};
                    } else {
                        v0 = (f32x4){sigmoid_f(v0[0]), sigmoid_f(v0[1]), sigmoid_f(v0[2]), sigmoid_f(v0[3])};
                        v1 = (f32x4){sigmoid_f(v1[0]), sigmoid_f(v1[1]), sigmoid_f(v1[2]), sigmoid_f(v1[3])};
                    }
                    u32x4 w; w.x = cvt_pk_bf16(v0[0], v0[1]); w.y = cvt_pk_bf16(v0[2], v0[3]); w.z = cvt_pk_bf16(v1[0], v1[1]); w.w = cvt_pk_bf16(v1[2], v1[3]);
                    *(u32x4*)(rowp + bj * HALF) = w;
                }
            }
    }
};

struct EpiG1T {
    static constexpr bool PERM = true, AFTER_DRAIN = false, MID = false;
    bf16_t* VT; bf16_t* ZHT; const float* b_in; float* statsV; static constexpr int SLOT_FLOATS = 256;
    __device__ __forceinline__ void mid(f32x4 (&)[2][2][4][2], const Unit&, int, int, int, int) const {}
    __device__ __forceinline__ void preload(PG8_LAS float* slot, const Unit& u, int tid) const { if (tid < 256) slot[tid] = b_in[1024 + u.pm * 256 + tid]; }
    __device__ __forceinline__ void operator()(const f32x4 (&acc)[2][2][4][2], const Unit& u, int wr, int wc, int fr, int fq, const PG8_LAS float* slot) const {
        const int col0 = u.pn * BM + wc * 32 + 8 * fq; const bool isv = u.pm < 4;
        const int rowt = (isv ? u.pm : u.pm - 4) * BM + wr * 64 + fr;
        bf16_t* base = isv ? VT : ZHT;
#pragma unroll
        for (int ai = 0; ai < 2; ++ai) {
            float s[2][8], q[2][8];
#pragma unroll
            for (int bj = 0; bj < 2; ++bj)
#pragma unroll
                for (int e = 0; e < 8; ++e) { s[bj][e] = 0.f; q[bj][e] = 0.f; }
#pragma unroll
            for (int m = 0; m < 4; ++m) {
                const int row = rowt + ai * HALF + m * 16; const float bb = slot[wr * 64 + fr + ai * HALF + m * 16];
                bf16_t* rowp = base + (size_t)row * MTOK + col0;
#pragma unroll
                for (int bj = 0; bj < 2; ++bj) {
                    f32x4 v0 = acc[ai][bj][m][0] + bb, v1 = acc[ai][bj][m][1] + bb;
                    if (isv) {
                        f32x2 a = gelu_pk((f32x2){v0[0], v0[1]}), b = gelu_pk((f32x2){v0[2], v0[3]}), c = gelu_pk((f32x2){v1[0], v1[1]}), d = gelu_pk((f32x2){v1[2], v1[3]});
                        v0 = (f32x4){a.x, a.y, b.x, b.y}; v1 = (f32x4){c.x, c.y, d.x, d.y};
                    }
                    u32x4 w; w.x = cvt_pk_bf16(v0[0], v0[1]); w.y = cvt_pk_bf16(v0[2], v0[3]); w.z = cvt_pk_bf16(v1[0], v1[1]); w.w = cvt_pk_bf16(v1[2], v1[3]);
                    *(u32x4*)(rowp + bj * HALF) = w;
                    if (isv) {
                        const float e0 = bf_lo(w.x), e1 = bf_hi(w.x), e2 = bf_lo(w.y), e3 = bf_hi(w.y), e4 = bf_lo(w.z), e5 = bf_hi(w.z), e6 = bf_lo(w.w), e7 = bf_hi(w.w);
                        s[bj][0] += e0; s[bj][1] += e1; s[bj][2] += e2; s[bj][3] += e3; s[bj][4] += e4; s[bj][5] += e5; s[bj][6] += e6; s[bj][7] += e7;
                        q[bj][0] += e0 * e0; q[bj][1] += e1 * e1; q[bj][2] += e2 * e2; q[bj][3] += e3 * e3; q[bj][4] += e4 * e4; q[bj][5] += e5 * e5; q[bj][6] += e6 * e6; q[bj][7] += e7 * e7;
                    }
                }
            }
            if (isv) {
                const int slot = u.pm * 4 + ai * 2 + wr;
#pragma unroll
                for (int bj = 0; bj < 2; ++bj)
#pragma unroll
                    for (int e = 0; e < 8; ++e) {
                        float a = s[bj][e], b = q[bj][e];
                        a += __shfl_xor(a, 1); b += __shfl_xor(b, 1); a += __shfl_xor(a, 2); b += __shfl_xor(b, 2);
                        a += __shfl_xor(a, 4); b += __shfl_xor(b, 4); a += __shfl_xor(a, 8); b += __shfl_xor(b, 8);
                        if (fr == 0) *(f32x2*)(statsV + ((size_t)(col0 + bj * HALF + e) * 16 + slot) * 2) = (f32x2){a, b};
                    }
            }
        }
    }
};

struct EpiG2 {
    static constexpr bool PERM = true, AFTER_DRAIN = false, MID = true;
    const bf16_t* G; bf16_t* O; static constexpr int SLOT_FLOATS = 0;
    __device__ __forceinline__ void preload(PG8_LAS float*, const Unit&, int) const {}
    __device__ __forceinline__ void mid(f32x4 (&acc)[2][2][4][2], const Unit& u, int wr, int wc, int fr, int fq) const {
        int row0 = u.pm * BM + wr * 64 + fr, col0 = u.pn * BM + wc * 32 + 8 * fq;
        asm volatile("" : "+v"(row0), "+v"(col0));
#pragma unroll
        for (int ai = 0; ai < 2; ++ai)
#pragma unroll
            for (int m = 0; m < 4; ++m) {
                const bf16_t* gp = G + (size_t)(row0 + ai * HALF + m * 16) * (2 * DM) + col0;
#pragma unroll
                for (int bj = 0; bj < 2; ++bj) {
                    const u32x4 ga = *(const u32x4*)(gp + bj * HALF), gb = *(const u32x4*)(gp + DM + bj * HALF);
                    f32x4 r0, r1;
                    r0[0] = bf_lo(ga.x) * __builtin_amdgcn_rcpf(bf_lo(gb.x)); r0[1] = bf_hi(ga.x) * __builtin_amdgcn_rcpf(bf_hi(gb.x));
                    r0[2] = bf_lo(ga.y) * __builtin_amdgcn_rcpf(bf_lo(gb.y)); r0[3] = bf_hi(ga.y) * __builtin_amdgcn_rcpf(bf_hi(gb.y));
                    r1[0] = bf_lo(ga.z) * __builtin_amdgcn_rcpf(bf_lo(gb.z)); r1[1] = bf_hi(ga.z) * __builtin_amdgcn_rcpf(bf_hi(gb.z));
                    r1[2] = bf_lo(ga.w) * __builtin_amdgcn_rcpf(bf_lo(gb.w)); r1[3] = bf_hi(ga.w) * __builtin_amdgcn_rcpf(bf_hi(gb.w));
                    acc[ai][bj][m][0] *= r0; acc[ai][bj][m][1] *= r1;
                }
            }
    }
    __device__ __forceinline__ void operator()(const f32x4 (&acc)[2][2][4][2], const Unit& u, int wr, int wc, int fr, int fq, const PG8_LAS float*) const {
        const int row0 = u.pm * BM + wr * 64 + fr, col0 = u.pn * BM + wc * 32 + 8 * fq;
#pragma unroll
        for (int ai = 0; ai < 2; ++ai)
#pragma unroll
            for (int m = 0; m < 4; ++m) {
                const int row = row0 + ai * HALF + m * 16;
                const bf16_t* gp = G + (size_t)row * (2 * DM) + DM + col0;
                bf16_t* op = O + (size_t)row * DM + col0;
#pragma unroll
                for (int bj = 0; bj < 2; ++bj) {
                    const u32x4 gb = *(const u32x4*)(gp + bj * HALF);
                    const f32x4 a0 = acc[ai][bj][m][0], a1 = acc[ai][bj][m][1];
                    u32x4 w; w.x = cvt_pk_bf16(a0[0] * bf_lo(gb.x), a0[1] * bf_hi(gb.x)); w.y = cvt_pk_bf16(a0[2] * bf_lo(gb.y), a0[3] * bf_hi(gb.y));
                    w.z = cvt_pk_bf16(a1[0] * bf_lo(gb.z), a1[1] * bf_hi(gb.z)); w.w = cvt_pk_bf16(a1[2] * bf_lo(gb.w), a1[3] * bf_hi(gb.w));
                    *(u32x4*)(op + bj * HALF) = w;
                }
            }
    }
};

template <bool FIRST> struct EpiRes {
    static constexpr bool PERM = false, AFTER_DRAIN = false, MID = false; static constexpr int SLOT_FLOATS = FIRST ? 512 : 1024;
    const float* X;
    float* R;
    const float* gate;
    const float* bias;
    const float* lng; const float* lnb; const float* MU;
    float* stats;
    __device__ __forceinline__ void mid(f32x4 (&)[2][2][4][2], const Unit&, int, int, int, int) const {}
    __device__ __forceinline__ void preload(PG8_LAS float* slot, const Unit& u, int tid) const {
        const int c = tid & 255, col = u.pn * BM + c;
        if (tid < 256) slot[c] = gate[(size_t)(u.pm >> 3) * MODW + col]; else slot[256 + c] = bias[col];
        if (!FIRST) { if (tid < 256) slot[512 + c] = DN_ALPHA * lng[col]; else slot[768 + c] = DN_ALPHA * lnb[col]; }
    }
    __device__ __forceinline__ void operator()(const f32x4 (&acc)[2][2][4][2], const Unit& u, int wr, int wc, int fr, int fq, const PG8_LAS float* slot) const {
        int row0 = u.pm * BM + wr * 64 + fr; const int cl = wc * 32 + 4 * fq; int col0 = u.pn * BM + cl;
        asm volatile("" : "+v"(row0), "+v"(col0));
        constexpr int RB = FIRST ? 2 : 1;
#pragma unroll
        for (int ab = 0; ab < 8 / RB; ++ab) {
            const int ai = (ab * RB) >> 2, mb = (ab * RB) & 3;
            f32x4 base[RB][2][2]; f32x2 mr[RB];
            int rowb = row0 + ai * HALF + mb * 16; asm volatile("" : "+v"(rowb));
#pragma unroll
            for (int mm = 0; mm < RB; ++mm) {
                const size_t off = (size_t)(rowb + mm * 16) * DM + col0;
                if (!FIRST) mr[mm] = *(const f32x2*)(MU + (size_t)(rowb + mm * 16) * 2);
#pragma unroll
                for (int bj = 0; bj < 2; ++bj)
#pragma unroll
                    for (int n = 0; n < 2; ++n) base[mm][bj][n] = FIRST ? *(const f32x4*)(X + off + bj * HALF + n * 16) : *(const f32x4*)(R + off + bj * HALF + n * 16);
            }
#pragma unroll
            for (int mm = 0; mm < RB; ++mm) {
                const int m = mb + mm;
                const int row = rowb + mm * 16; float* rp = R + (size_t)row * DM + col0;
                float s = 0.f, q = 0.f;
#pragma unroll
                for (int bj = 0; bj < 2; ++bj)
#pragma unroll
                    for (int n = 0; n < 2; ++n) {
                        const int co = bj * HALF + n * 16;
                        const f32x4 gv = *(const PG8_LAS f32x4*)(slot + cl + co), bv = *(const PG8_LAS f32x4*)(slot + 256 + cl + co);
                        f32x4 bs;
                        if (FIRST) bs = base[mm][bj][n] * DN_ALPHA;
                        else bs = (base[mm][bj][n] - mr[mm].x) * mr[mm].y * *(const PG8_LAS f32x4*)(slot + 512 + cl + co) + *(const PG8_LAS f32x4*)(slot + 768 + cl + co);
                        const f32x4 o = bs + gv * (acc[ai][bj][m][n] + bv);
                        *(f32x4*)(rp + co) = o;
                        s += (o[0] + o[1]) + (o[2] + o[3]); q += (o[0] * o[0] + o[1] * o[1]) + (o[2] * o[2] + o[3] * o[3]);
                    }
                s += __shfl_xor(s, 16); s += __shfl_xor(s, 32); q += __shfl_xor(q, 16); q += __shfl_xor(q, 32);
                if (fq == 0) *(f32x2*)(stats + ((size_t)row * 32 + u.pn * 4 + wc) * 2) = (f32x2){s, q};
            }
            asm volatile("" ::: "memory");
        }
    }
};

struct EpiG4 {
    static constexpr bool PERM = true, AFTER_DRAIN = false, MID = false; static constexpr int SLOT_FLOATS = 256;
    bf16_t* O; const float* bias;
    __device__ __forceinline__ void mid(f32x4 (&)[2][2][4][2], const Unit&, int, int, int, int) const {}
    __device__ __forceinline__ void preload(PG8_LAS float* slot, const Unit& u, int tid) const { if (tid < 256) slot[tid] = bias[u.pn * BM + tid]; }
    __device__ __forceinline__ void operator()(const f32x4 (&acc)[2][2][4][2], const Unit& u, int wr, int wc, int fr, int fq, const PG8_LAS float* slot) const {
        const int row0 = u.pm * BM + wr * 64 + fr, cl = wc * 32 + 8 * fq, col0 = u.pn * BM + cl;
        f32x4 bv[2][2];
#pragma unroll
        for (int bj = 0; bj < 2; ++bj)
#pragma unroll
            for (int n = 0; n < 2; ++n) bv[bj][n] = *(const PG8_LAS f32x4*)(slot + cl + bj * HALF + 4 * n);
#pragma unroll
        for (int ai = 0; ai < 2; ++ai)
#pragma unroll
            for (int m = 0; m < 4; ++m) {
                bf16_t* rowp = O + (size_t)(row0 + ai * HALF + m * 16) * DFF + col0;
#pragma unroll
                for (int bj = 0; bj < 2; ++bj) {
                    f32x4 v0 = acc[ai][bj][m][0] + bv[bj][0], v1 = acc[ai][bj][m][1] + bv[bj][1];
                    v0 = __builtin_elementwise_max(v0, (f32x4){0.f, 0.f, 0.f, 0.f}); v1 = __builtin_elementwise_max(v1, (f32x4){0.f, 0.f, 0.f, 0.f});
                    v0 = v0 * v0; v1 = v1 * v1;
                    u32x4 w; w.x = cvt_pk_bf16(v0[0], v0[1]); w.y = cvt_pk_bf16(v0[2], v0[3]); w.z = cvt_pk_bf16(v1[0], v1[1]); w.w = cvt_pk_bf16(v1[2], v1[3]);
                    *(u32x4*)(rowp + bj * HALF) = w;
                }
            }
    }
};
}
namespace pg8 {
template <class Epi, class Sched, bool ALIGN_EPI = false, bool SP2 = false>
__device__ __forceinline__ void gemm_phase(PG8_LAS unsigned char* lds, const Gemm g, const Sched& S, const Epi& E) {
    const int tid = threadIdx.x, wid = __builtin_amdgcn_readfirstlane(tid >> 6), lane = tid & 63, wr = wid >> 2, wc = wid & 3, fr = lane & 15, fq = lane >> 4;
    const int K = g.K, nt = K / BK;
    unsigned voffA[2], voffB[2];
#pragma unroll
    for (int i = 0; i < 2; ++i) { int R, C; stage_rc(tid * 16 + i * 8192, R, C); const int Rb = Epi::PERM ? ((R & ~31) + perm32(R & 31)) : R;
        voffA[i] = (unsigned)(R * K + C) * 2u; voffB[i] = (unsigned)(Rb * K + C) * 2u; }
    const size_t kstep = (size_t)(BK * 2);
    const size_t hstep = (size_t)HALF * K * 2;
    const size_t tstep = 2 * hstep;
    const unsigned ldsw = (unsigned)wid * 1024u;
    const int aoff = lds_byte(wr * 64 + fr, fq * 8), boff = lds_byte(wc * 32 + fr, fq * 8);
#define PG8_SA(b, h) (((b) * 2 + (h)) * HTB)
#define PG8_SB(b, h) ((4 + (b) * 2 + (h)) * HTB)
#define PG8_STAGE(bufoff, gbase, voff) do { _Pragma("unroll") for (int _i = 0; _i < 2; ++_i) \
        __builtin_amdgcn_global_load_lds((const unsigned*)((const char*)(gbase) + (voff)[_i]), (PG8_LAS unsigned*)(lds + (bufoff) + ldsw + _i * 8192), 16, 0, 0); } while (0)
#define PG8_LDA(dst, b, h) do { _Pragma("unroll") for (int m = 0; m < 4; ++m) _Pragma("unroll") for (int k = 0; k < 2; ++k) dst[m][k] = *(const PG8_LAS bf16x8*)(lds + PG8_SA(b, h) + aoff + m * 2048 + k * 1024); } while (0)
#define PG8_LDB(dst, b, h) do { _Pragma("unroll") for (int n = 0; n < 2; ++n) _Pragma("unroll") for (int k = 0; k < 2; ++k) dst[n][k] = *(const PG8_LAS bf16x8*)(lds + PG8_SB(b, h) + boff + n * 2048 + k * 1024); } while (0)
#define PG8_MMA(ai, bj, At, Bt) do { __builtin_amdgcn_s_setprio(1); _Pragma("unroll") for (int m = 0; m < 4; ++m) _Pragma("unroll") for (int n = 0; n < 2; ++n) _Pragma("unroll") for (int k = 0; k < 2; ++k) \
        acc[ai][bj][m][n] = __builtin_amdgcn_mfma_f32_16x16x32_bf16(Bt[n][k], At[m][k], acc[ai][bj][m][n], 0, 0, 0); __builtin_amdgcn_s_setprio(0); } while (0)
#define PG8_WAIT_V(n) asm volatile("s_waitcnt vmcnt(" #n ")" ::: "memory")
#define PG8_WAIT_L(n) asm volatile("s_waitcnt lgkmcnt(" #n ")" ::: "memory")
#define PG8_BAR __builtin_amdgcn_s_barrier()
#define PG8_SCHED __builtin_amdgcn_sched_barrier(0)
    Unit cur, nxt; int ui = 0;
    if (!S.next(0, cur)) return;
    {
        Unit pu; for (int i = 0; S.next(i, pu); ++i) E.preload((PG8_LAS float*)(lds + EPI_LDS_OFF) + i * Epi::SLOT_FLOATS, pu, tid);
        asm volatile("s_waitcnt vmcnt(0) lgkmcnt(0)" ::: "memory"); __builtin_amdgcn_s_barrier(); asm volatile("" ::: "memory");
    }
    f32x4 acc[2][2][4][2];
#pragma unroll
    for (int a = 0; a < 2; ++a)
#pragma unroll
        for (int b = 0; b < 2; ++b)
#pragma unroll
            for (int m = 0; m < 4; ++m)
#pragma unroll
                for (int n = 0; n < 2; ++n) acc[a][b][m][n] = (f32x4){0.f, 0.f, 0.f, 0.f};
    bf16x8 At[4][2], B0[2][2], B1[2][2];
    const char* cA = (const char*)g.A + (size_t)cur.pm * tstep; const char* cB = (const char*)g.Bt + (size_t)cur.pn * tstep;
    S.a_ready(cur);
    if constexpr (SP2) {
        PG8_STAGE(PG8_SB(0, 0), cB, voffB); PG8_STAGE(PG8_SB(0, 1), cB + hstep, voffB); PG8_STAGE(PG8_SA(0, 0), cA, voffA); PG8_STAGE(PG8_SA(0, 1), cA + hstep, voffA);
        if (wr == 1) PG8_BAR;
        PG8_WAIT_V(2); PG8_BAR;
        PG8_STAGE(PG8_SB(1, 0), cB + kstep, voffB); PG8_STAGE(PG8_SA(1, 0), cA + kstep, voffA); PG8_STAGE(PG8_SB(1, 1), cB + hstep + kstep, voffB);
        PG8_WAIT_V(6); PG8_BAR;
    } else {
        PG8_STAGE(PG8_SB(0, 0), cB, voffB); PG8_STAGE(PG8_SA(0, 0), cA, voffA); PG8_STAGE(PG8_SB(0, 1), cB + hstep, voffB); PG8_STAGE(PG8_SA(0, 1), cA + hstep, voffA);
        if (wr == 1) PG8_BAR;
        PG8_WAIT_V(4); PG8_BAR;
        PG8_STAGE(PG8_SB(1, 0), cB + kstep, voffB); PG8_STAGE(PG8_SA(1, 0), cA + kstep, voffA); PG8_STAGE(PG8_SB(1, 1), cB + hstep + kstep, voffB);
        PG8_WAIT_V(6); PG8_BAR;
    }
    for (;;) {
        const bool has_next = S.next(ui + 1, nxt);
        const char* nA = has_next ? (const char*)g.A + (size_t)nxt.pm * tstep : cA; const char* nB = has_next ? (const char*)g.Bt + (size_t)nxt.pn * tstep : cB;
        for (int t = 0; t < nt; t += 2) {
            const bool last = (t == nt - 2);
            const char* a1 = cA + (size_t)(t + 1) * kstep;
            const char* a2 = last ? nA : cA + (size_t)(t + 2) * kstep; const char* b2 = last ? nB : cB + (size_t)(t + 2) * kstep;
            const char* a3 = a2 + kstep; const char* b3 = b2 + kstep;
            if (last && has_next) S.a_ready(nxt);
            if constexpr (Epi::MID) { if (t == (nt >> 1)) E.mid(acc, cur, wr, wc, fr, fq); }
            if constexpr (SP2) {
            PG8_LDB(B0, 0, 0); PG8_LDB(B1, 0, 1); PG8_SCHED; PG8_LDA(At, 0, 0); PG8_STAGE(PG8_SA(1, 1), a1 + hstep, voffA);
            PG8_WAIT_V(8); PG8_WAIT_L(0); PG8_BAR; PG8_MMA(0, 0, At, B0); PG8_MMA(0, 1, At, B1); PG8_BAR; PG8_SCHED;
            PG8_LDA(At, 0, 1); PG8_STAGE(PG8_SB(0, 0), b2, voffB); PG8_STAGE(PG8_SB(0, 1), b2 + hstep, voffB); PG8_STAGE(PG8_SA(0, 0), a2, voffA);
            PG8_WAIT_V(8); PG8_WAIT_L(0); PG8_BAR; PG8_MMA(1, 0, At, B0); PG8_MMA(1, 1, At, B1); PG8_BAR; PG8_SCHED;
            PG8_LDB(B0, 1, 0); PG8_LDB(B1, 1, 1); PG8_SCHED; PG8_LDA(At, 1, 0); PG8_STAGE(PG8_SA(0, 1), a2 + hstep, voffA);
            PG8_WAIT_V(8); PG8_WAIT_L(0); PG8_BAR; PG8_MMA(0, 0, At, B0); PG8_MMA(0, 1, At, B1); PG8_BAR; PG8_SCHED;
            PG8_LDA(At, 1, 1); PG8_STAGE(PG8_SB(1, 0), b3, voffB); PG8_STAGE(PG8_SB(1, 1), b3 + hstep, voffB); PG8_STAGE(PG8_SA(1, 0), a3, voffA);
            PG8_WAIT_V(8); PG8_WAIT_L(0); PG8_BAR; PG8_MMA(1, 0, At, B0); PG8_MMA(1, 1, At, B1); PG8_BAR; PG8_SCHED;
            } else {
            PG8_LDB(B0, 0, 0); PG8_SCHED; PG8_LDA(At, 0, 0); PG8_STAGE(PG8_SA(1, 1), a1 + hstep, voffA);
            PG8_WAIT_L(8); PG8_BAR; PG8_WAIT_L(0); PG8_MMA(0, 0, At, B0); PG8_BAR; PG8_SCHED;
            PG8_LDB(B1, 0, 1); PG8_STAGE(PG8_SB(0, 0), b2, voffB);
            PG8_BAR; PG8_WAIT_L(0); PG8_MMA(0, 1, At, B1); PG8_BAR;
            PG8_LDA(At, 0, 1); PG8_STAGE(PG8_SA(0, 0), a2, voffA);
            PG8_BAR; PG8_WAIT_L(0); PG8_MMA(1, 0, At, B0); PG8_BAR; PG8_SCHED;
            PG8_STAGE(PG8_SB(0, 1), b2 + hstep, voffB);
            PG8_WAIT_V(6); PG8_BAR; PG8_MMA(1, 1, At, B1); PG8_BAR;
            PG8_LDB(B0, 1, 0); PG8_SCHED; PG8_LDA(At, 1, 0); PG8_STAGE(PG8_SA(0, 1), a2 + hstep, voffA);
            PG8_WAIT_L(8); PG8_BAR; PG8_WAIT_L(0); PG8_MMA(0, 0, At, B0); PG8_BAR; PG8_SCHED;
            PG8_LDB(B1, 1, 1); PG8_STAGE(PG8_SB(1, 0), b3, voffB);
            PG8_BAR; PG8_WAIT_L(0); PG8_MMA(0, 1, At, B1); PG8_BAR;
            PG8_LDA(At, 1, 1); PG8_STAGE(PG8_SA(1, 0), a3, voffA);
            PG8_BAR; PG8_WAIT_L(0); PG8_MMA(1, 0, At, B0); PG8_BAR; PG8_SCHED;
            PG8_STAGE(PG8_SB(1, 1), b3 + hstep, voffB);
            PG8_WAIT_V(6); PG8_BAR; PG8_MMA(1, 1, At, B1); PG8_BAR;
            }
        }
        if constexpr (ALIGN_EPI) { if (wr == 0) PG8_BAR; }
        if constexpr (!Epi::AFTER_DRAIN) { E(acc, cur, wr, wc, fr, fq, (const PG8_LAS float*)(lds + EPI_LDS_OFF) + ui * Epi::SLOT_FLOATS); S.done(cur); }
        if (!has_next) break;
#pragma unroll
        for (int a = 0; a < 2; ++a)
#pragma unroll
            for (int b = 0; b < 2; ++b)
#pragma unroll
                for (int m = 0; m < 4; ++m)
#pragma unroll
                    for (int n = 0; n < 2; ++n) acc[a][b][m][n] = (f32x4){0.f, 0.f, 0.f, 0.f};
        cur = nxt; cA = nA; cB = nB; ++ui;
        if constexpr (ALIGN_EPI) { if (wr == 1) PG8_BAR; }
    }
    PG8_WAIT_V(0);
    if constexpr (!ALIGN_EPI) { if (wr == 0) PG8_BAR; }
    PG8_BAR;
    if constexpr (Epi::AFTER_DRAIN) { E.fused(acc, cur, wr, wc, fr, fq, lds, wid, lane); S.done(cur); }
#undef PG8_SA
#undef PG8_SB
#undef PG8_STAGE
#undef PG8_LDA
#undef PG8_LDB
#undef PG8_MMA
#undef PG8_WAIT_V
#undef PG8_WAIT_L
#undef PG8_BAR
#undef PG8_SCHED
}
}

constexpr size_t MiB = 1u << 20;
constexpr size_t WS_CTL = 0;
constexpr size_t WS_MOD = 1 * MiB;
constexpr size_t WS_STV = 2 * MiB;
constexpr size_t WS_ST1 = 4 * MiB;
constexpr size_t WS_ST2 = 8 * MiB;
constexpr size_t WS_MU1 = 12 * MiB;
constexpr size_t WS_SGW = 13 * MiB;
constexpr size_t WS_WIN = 16 * MiB;
constexpr size_t WS_WAB = 52 * MiB;
constexpr size_t WS_WO = 60 * MiB;
constexpr size_t WS_FILT = 68 * MiB;
constexpr size_t WS_WM2 = 68 * MiB;
constexpr size_t WS_H = 100 * MiB;
constexpr size_t WS_U = 164 * MiB;
constexpr size_t WS_V = 196 * MiB;
constexpr size_t WS_MERGED = 164 * MiB;
constexpr size_t WS_ZHT = 228 * MiB;
constexpr size_t WS_G = 324 * MiB;
constexpr size_t WS_AFF = 164 * MiB;
constexpr size_t WS_WM1 = 420 * MiB;
constexpr size_t WS_END = 452 * MiB;

constexpr int NWAVES = 8;
constexpr int LDS_BYTES = 147456;

#define GAS __attribute__((address_space(1)))
#define LAS __attribute__((address_space(3)))
typedef unsigned short bf16;
typedef unsigned v4u __attribute__((ext_vector_type(4)));
typedef unsigned v2u __attribute__((ext_vector_type(2)));
typedef float f32x4 __attribute__((ext_vector_type(4)));
typedef float f32x2 __attribute__((ext_vector_type(2)));
#define LDS_WAIT() asm volatile("s_waitcnt lgkmcnt(0)" ::: "memory")

__device__ __forceinline__ unsigned f2bf(float f) { unsigned u = __builtin_bit_cast(unsigned, f); return (u + 0x7fffu + ((u >> 16) & 1u)) >> 16; }
__device__ __forceinline__ unsigned pk2(float lo, float hi) { return f2bf(lo) | (f2bf(hi) << 16); }
__device__ __forceinline__ float bflo(unsigned w) { return __uint_as_float(w << 16); }
__device__ __forceinline__ float bfhi(unsigned w) { return __uint_as_float(w & 0xffff0000u); }
__device__ __forceinline__ float bf1(bf16 h) { return __uint_as_float((unsigned)h << 16); }
__device__ __forceinline__ float wave_sum(float v) {
#pragma unroll
    for (int o = 1; o < 64; o <<= 1) v += __shfl_xor(v, o);
    return v;
}

struct Args { const float* in[31]; float* out; unsigned char* ws; int ph_lo, ph_hi; };

struct Frame {
    LAS unsigned char* lds;
    int tid, lane, wave, G;
    const float* const* in; float* out; unsigned char* ws;
};
enum { I_X = 0, I_C, I_WADA, I_BADA, I_WIN, I_BIN, I_SLNG, I_SLNB, I_SW, I_SB, I_HCW, I_HCB, I_HW1, I_HB1, I_HW2, I_HB2, I_HFREQ, I_HW3, I_HSKIP,
       I_WA, I_WB, I_WO, I_BO, I_LN1G, I_LN1B, I_WM1, I_BM1, I_WM2, I_BM2, I_LN2G, I_LN2B };

__device__ __forceinline__ void transpose_matrix(Frame& F, const float* W, int K, int N, bf16* WT, int ldk, int koff, int remap_win, int first, int nblocks) {
    LAS float* tile = (LAS float*)F.lds;
    const int tid = F.tid, nblk = N / 256, nitems = (K / 64) * nblk;
    const int lr = tid >> 6, lc = tid & 63;
    const int wc = tid & 7, wn = tid >> 3;
    for (int it = first; it < nitems; it += nblocks) {
        const int kb = it / nblk, nb = it % nblk, n0 = nb * 256, k0 = kb * 64; int row0 = n0;
        if (remap_win) row0 = (n0 < 1024) ? n0 : (n0 < 2048 ? n0 - 1024 + 5120 : (n0 < 5120 ? n0 - 2048 + 6144 : n0 - 5120 + 1024));
        f32x4 v[8];
#pragma unroll
        for (int i = 0; i < 8; ++i) v[i] = *(const f32x4*)(W + (size_t)(k0 + 8 * i + lr) * N + n0 + 4 * lc);
#pragma unroll
        for (int i = 0; i < 8; ++i) *(LAS f32x4*)(tile + (8 * i + lr) * 256 + ((lc ^ i) << 2)) = v[i];
        __syncthreads();
#pragma unroll
        for (int j = 0; j < 4; ++j) { const int n = wn + 64 * j; const LAS float* sp = tile + (8 * wc) * 256 + ((((n >> 2) ^ wc) << 2) | (n & 3));
            v4u o; o.x = pk2(sp[0 * 256], sp[1 * 256]); o.y = pk2(sp[2 * 256], sp[3 * 256]); o.z = pk2(sp[4 * 256], sp[5 * 256]); o.w = pk2(sp[6 * 256], sp[7 * 256]);
            *(GAS v4u*)(WT + (size_t)(row0 + n) * ldk + koff + k0 + 8 * wc) = o; }
        __syncthreads();
    }
}

__device__ __forceinline__ void p0_mod(Frame& F) {
    LAS float* condS = (LAS float*)F.lds;
    LAS float* red = (LAS float*)(F.lds + 65536);
    const float* c = F.in[I_C]; const float* w_ada = F.in[I_WADA]; const float* b_ada = F.in[I_BADA];
    float* mod = (float*)(F.ws + WS_MOD);
    const int tid = F.tid;
    for (int item = blockIdx.x; item < MODW / 48; item += F.G) {
        for (int i = tid; i < NBATCH * DM; i += NWAVES * 64) { const float v = c[i]; condS[i] = v / (1.0f + __expf(-v)); }
        __syncthreads();
        const int cq = tid % 12, kq = tid / 12, col0 = item * 48;
        if (kq < 32) {
            f32x4 acc[8];
#pragma unroll
            for (int b = 0; b < 8; ++b) acc[b] = (f32x4){0.f, 0.f, 0.f, 0.f};
            const float* wp = w_ada + (size_t)kq * MODW + col0 + cq * 4;
            for (int k = kq; k < DM; k += 256, wp += (size_t)256 * MODW) {
                f32x4 w[8];
#pragma unroll
                for (int u = 0; u < 8; ++u) w[u] = *(const f32x4*)(wp + (size_t)(32 * u) * MODW);
#pragma unroll
                for (int u = 0; u < 8; ++u)
#pragma unroll
                    for (int b = 0; b < 8; ++b) acc[b] += w[u] * condS[b * DM + k + 32 * u];
            }
#pragma unroll
            for (int b = 0; b < 8; ++b) *(LAS f32x4*)(red + (kq * 8 + b) * 48 + cq * 4) = acc[b];
        }
        __syncthreads();
        if (tid < 384) { const int b = tid / 48, col = tid % 48; float s = 0.f;
#pragma unroll 8
          for (int k2 = 0; k2 < 32; ++k2) s += red[(k2 * 8 + b) * 48 + col];
          mod[(size_t)b * MODW + col0 + col] = s + b_ada[col0 + col]; }
        __syncthreads();
    }
}

__device__ __forceinline__ void p0_filter(Frame& F) {
    LAS float* h2T = (LAS float*)F.lds;
    LAS float* scr = (LAS float*)(F.lds + 16384) + F.wave * 128;
    const float* w1 = F.in[I_HW1]; const float* b1 = F.in[I_HB1]; const float* w2 = F.in[I_HW2]; const float* b2 = F.in[I_HB2];
    const float* freq = F.in[I_HFREQ]; const float* w3 = F.in[I_HW3];
    float* FILT = (float*)(F.ws + WS_FILT);
    const int tid = F.tid, lane = F.lane, wave = F.wave;
    const float min_decay = -3.0701134573253943f, max_decay = -15.350567286626972f;
    for (int item = blockIdx.x; item < 256; item += F.G) {
        const int pb = item >> 3, cb = item & 7;
        const float fr = freq[lane], bb1 = b1[lane], bb2 = b2[lane];
        for (int pp = 0; pp < 8; ++pp) {
            const int pl = wave * 8 + pp, l = pb * 64 + pl;
            const float tl = (float)l / (float)(SEQ - 1), omega = 6.283185307179586f * (float)l / (float)SEQ;
            float f = 0.f;
            if (lane == 0) f = tl;
            else if (lane <= 16) { const float band = 1e-4f + (float)(lane - 1) * ((15.0f - 1e-4f) / 15.0f); f = cosf(band * omega); }
            else if (lane <= 32) { const float band = 1e-4f + (float)(lane - 17) * ((15.0f - 1e-4f) / 15.0f); f = -sinf(band * omega); }
            scr[lane] = f; LDS_WAIT(); asm volatile("" ::: "memory");
            float a = bb1;
            for (int i = 0; i < 33; ++i) a += scr[i] * w1[i * 64 + lane];
            scr[64 + lane] = sinf(fr * a); LDS_WAIT(); asm volatile("" ::: "memory");
            a = bb2;
            for (int i = 0; i < 64; ++i) a += scr[64 + i] * w2[i * 64 + lane];
            h2T[lane * 64 + pl] = sinf(fr * a); LDS_WAIT(); asm volatile("" ::: "memory");
        }
        __syncthreads();
        {
            const int cg = tid & 127, pg = tid >> 7, j0 = cb * 512 + cg * 4;
            f32x4 acc[16];
#pragma unroll
            for (int p = 0; p < 16; ++p) acc[p] = (f32x4){0.f, 0.f, 0.f, 0.f};
#pragma unroll 4
            for (int i = 0; i < 64; ++i) { const f32x4 w = *(const f32x4*)(w3 + (size_t)i * 4096 + j0);
#pragma unroll
                for (int p4 = 0; p4 < 4; ++p4) { const f32x4 hv = *(const LAS f32x4*)(h2T + i * 64 + pg * 16 + 4 * p4);
                    acc[4 * p4 + 0] += w * hv[0]; acc[4 * p4 + 1] += w * hv[1]; acc[4 * p4 + 2] += w * hv[2]; acc[4 * p4 + 3] += w * hv[3]; } }
            const int p0 = pb * 64 + pg * 16;
#pragma unroll
            for (int e = 0; e < 4; ++e) { const int j = j0 + e, ch = j & 1023; const float delta = fabsf(min_decay + (float)ch * ((max_decay - min_decay) / 1023.0f));
                float o[16];
#pragma unroll
                for (int p = 0; p < 16; ++p) { const float tp = (float)(p0 + p) / (float)(SEQ - 1); o[p] = acc[p][e] * expf(-tp * delta); }
                float* op = FILT + (size_t)j * SEQ + p0;
#pragma unroll
                for (int p4 = 0; p4 < 4; ++p4) *(f32x4*)(op + 4 * p4) = (f32x4){o[4 * p4], o[4 * p4 + 1], o[4 * p4 + 2], o[4 * p4 + 3]}; }
        }
        __syncthreads();
    }
}

__device__ __forceinline__ void p1_modulate(Frame& F) {
    const float* x = F.in[I_X]; const float* mod = (const float*)(F.ws + WS_MOD); bf16* H = (bf16*)(F.ws + WS_H);
    const size_t nvec = (size_t)MTOK * DM / 8, stride = (size_t)F.G * NWAVES * 64;
    for (size_t i = (size_t)blockIdx.x * (NWAVES * 64) + F.tid; i < nvec; i += stride) {
        const int row = (int)(i >> 8), col = (int)(i & 255) * 8, b = row >> 11;
        const f32x4 x0 = *(const f32x4*)(x + (size_t)row * DM + col), x1 = *(const f32x4*)(x + (size_t)row * DM + col + 4);
        const float* mp = mod + (size_t)b * MODW + col;
        const f32x4 sh0 = *(const f32x4*)mp, sh1 = *(const f32x4*)(mp + 4), sc0 = *(const f32x4*)(mp + DM), sc1 = *(const f32x4*)(mp + DM + 4);
        const f32x4 h0 = x0 * (sc0 + 1.0f) + sh0, h1 = x1 * (sc1 + 1.0f) + sh1;
        v4u o; o.x = pk2(h0[0], h0[1]); o.y = pk2(h0[2], h0[3]); o.z = pk2(h1[0], h1[1]); o.w = pk2(h1[2], h1[3]);
        *(v4u*)(H + (size_t)row * DM + col) = o;
    }
}

typedef short sg_bf16x8 __attribute__((ext_vector_type(8)));
typedef float sg_f32x16 __attribute__((ext_vector_type(16)));
constexpr int SG_VT = 0, SG_LD = 136, SG_ST = 36864;
__device__ __forceinline__ void p3_sgu(Frame& F) {
    LAS bf16* vnT = (LAS bf16*)(F.lds + SG_VT); LAS float* stS = (LAS float*)(F.lds + SG_ST);
    const bf16* U = (const bf16*)(F.ws + WS_U); const bf16* VT = (const bf16*)(F.ws + WS_V); bf16* AB = (bf16*)(F.ws + WS_H);
    const bf16* Wb = (const bf16*)(F.ws + WS_SGW); const float* stv = (const float*)(F.ws + WS_STV);
    const float* lng = F.in[I_SLNG]; const float* lnb = F.in[I_SLNB]; const float* sb = F.in[I_SB];
    const int tid = F.tid, lane = F.lane, w = F.wave, r = lane & 31, h = lane >> 5;
    for (int item = blockIdx.x; item < 1024; item += F.G) {
        const int b = item >> 7, n = (item >> 3) & 15, g = item & 7, tok0 = b * SEQ + n * 128;
        if (tid < 128) { float s = 0.f, q = 0.f; const float* sp = stv + (size_t)(tok0 + tid) * 32;
#pragma unroll
            for (int i = 0; i < 16; ++i) { const f32x2 pr = *(const f32x2*)(sp + 2 * i); s += pr.x; q += pr.y; }
            const float mean = s * (1.0f / 1024.0f); float var = q * (1.0f / 1024.0f) - mean * mean; var = var > 0.f ? var : 0.f;
            *(LAS f32x2*)(stS + 2 * tid) = (f32x2){mean, 1.0f / sqrtf(var + LN_EPS)}; }
        __syncthreads();
        { const int c = tid >> 2, pseg = (tid & 3) * 32, ch = g * 128 + c; const float gg = lng[ch], bb = lnb[ch];
          const bf16* vp = VT + (size_t)ch * MTOK + tok0 + pseg;
          v4u wv[4];
#pragma unroll
          for (int k = 0; k < 4; ++k) wv[k] = *(const v4u*)(vp + 8 * k);
#pragma unroll
          for (int k = 0; k < 4; ++k) {
              const float e[8] = {bflo(wv[k].x), bfhi(wv[k].x), bflo(wv[k].y), bfhi(wv[k].y), bflo(wv[k].z), bfhi(wv[k].z), bflo(wv[k].w), bfhi(wv[k].w)};
              float o[8];
#pragma unroll
              for (int i = 0; i < 8; i += 2) { const f32x4 st = *(const LAS f32x4*)(stS + 2 * (pseg + 8 * k + i));
                  o[i] = (e[i] - st[0]) * st[1] * gg + bb; o[i + 1] = (e[i + 1] - st[2]) * st[3] * gg + bb; }
              v4u pk; pk.x = pk2(o[0], o[1]); pk.y = pk2(o[2], o[3]); pk.z = pk2(o[4], o[5]); pk.w = pk2(o[6], o[7]);
              *(LAS v4u*)(vnT + c * SG_LD + pseg + 8 * k) = pk; } }
        const int q0 = 32 * (w >> 1), ct0 = 2 * (w & 1);
        sg_bf16x8 af[8];
#pragma unroll
        for (int kk = 0; kk < 8; ++kk) af[kk] = *(const sg_bf16x8*)(Wb + (size_t)(g * 128 + q0 + r) * 128 + 16 * kk + 8 * h);
        __syncthreads();
        sg_f32x16 acc[2];
#pragma unroll
        for (int ct = 0; ct < 2; ++ct)
#pragma unroll
            for (int i = 0; i < 16; ++i) acc[ct][i] = 0.f;
#pragma unroll
        for (int kk = 0; kk < 8; ++kk)
#pragma unroll
            for (int ct = 0; ct < 2; ++ct) {
                const sg_bf16x8 bf = *(const LAS sg_bf16x8*)(vnT + ((ct0 + ct) * 32 + r) * SG_LD + 16 * kk + 8 * h);
                acc[ct] = __builtin_amdgcn_mfma_f32_32x32x16_bf16(af[kk], bf, acc[ct], 0, 0, 0);
            }
#pragma unroll
        for (int ct = 0; ct < 2; ++ct) {
            const int c = (ct0 + ct) * 32 + r;
#pragma unroll
            for (int rg = 0; rg < 16; ++rg) {
                const int q = q0 + (rg & 3) + 8 * (rg >> 2) + 4 * h;
                const float uv = bf1(U[(size_t)(tok0 + q) * SGUW + g * 128 + c]);
                AB[(size_t)(tok0 + q) * DM + g * 128 + c] = (bf16)f2bf(uv * (acc[ct][rg] + sb[g * 128 + q]));
            }
        }
        __syncthreads();
    }
}

__device__ __forceinline__ float sconv(const bf16* ZHT, const float* cw, const float* cb, int ch, int b, int t) {
    const bf16* zp = ZHT + (size_t)ch * MTOK + b * SEQ;
    const float z0 = t > 0 ? bf1(zp[t - 1]) : 0.f, z1 = bf1(zp[t]), z2 = t < SEQ - 1 ? bf1(zp[t + 1]) : 0.f;
    return cw[ch] * z0 + cw[3072 + ch] * z1 + cw[6144 + ch] * z2 + cb[ch];
}
__device__ __forceinline__ void p3_hyena(Frame& F) {
    LAS float* Us = (LAS float*)F.lds;
    LAS float* KF = (LAS float*)(F.lds + 65536);
    const bf16* ZHT = (const bf16*)(F.ws + WS_ZHT); const float* FILT = (const float*)(F.ws + WS_FILT); bf16* AB = (bf16*)(F.ws + WS_H);
    const float* cw = F.in[I_HCW]; const float* cb = F.in[I_HCB]; const float* skip = F.in[I_HSKIP];
    const int tid = F.tid;
    for (int item = blockIdx.x; item < HYW; item += F.G) {
        const int c = item;
        for (int i = tid; i < NBATCH * SEQ; i += NWAVES * 64) { const int b = i >> 11, t = i & 2047; Us[t * 8 + b] = sconv(ZHT, cw, cb, c, b, t); }
        for (int n = 0; n < 2; ++n) {
            const float* hf = FILT + (size_t)((0 * 2 + n) * 1024 + c) * SEQ; const float* hb = FILT + (size_t)((1 * 2 + n) * 1024 + c) * SEQ;
            for (int i = tid; i < 4095; i += NWAVES * 64) { const int lag = i - 2047; KF[i] = lag > 0 ? hf[lag] : (lag == 0 ? hf[0] + hb[0] : hb[-lag]); }
            __syncthreads();
            f32x4 acc[4][2];
#pragma unroll
            for (int ti = 0; ti < 4; ++ti) { acc[ti][0] = (f32x4){0.f, 0.f, 0.f, 0.f}; acc[ti][1] = (f32x4){0.f, 0.f, 0.f, 0.f}; }
            const LAS float* kp = KF + tid + 2047;
            for (int s = 0; s < SEQ; ++s) {
                const f32x4 u0 = *(const LAS f32x4*)(Us + s * 8), u1 = *(const LAS f32x4*)(Us + s * 8 + 4);
#pragma unroll
                for (int ti = 0; ti < 4; ++ti) { const float kv = kp[512 * ti - s]; acc[ti][0] += u0 * kv; acc[ti][1] += u1 * kv; }
            }
            __syncthreads();
            const float sk = skip[n * 1024 + c];
#pragma unroll
            for (int ti = 0; ti < 4; ++ti) { const int t = tid + 512 * ti;
#pragma unroll
                for (int b = 0; b < 8; ++b) {
                    const float uv = Us[t * 8 + b], gate = sconv(ZHT, cw, cb, (n + 1) * 1024 + c, b, t);
                    const float y = gate * (acc[ti][b >> 2][b & 3] + sk * uv);
                    if (n == 0) Us[t * 8 + b] = y; else AB[(size_t)(b * SEQ + t) * DM + 1024 + c] = (bf16)f2bf(y);
                } }
            __syncthreads();
        }
    }
}

#ifndef HYFFT_HD
#define HYFFT_HD __device__ __forceinline__
#define HYFFT_LAS __attribute__((address_space(3)))
#endif
typedef float hy_c32 __attribute__((ext_vector_type(2)));
HYFFT_HD int hy_padi(int i) { return i + (i >> 3); }
HYFFT_HD int hy_rev(int x) { return ((x & 7) << 9) | (((x >> 3) & 7) << 6) | (((x >> 6) & 7) << 3) | ((x >> 9) & 7); }

template <bool INV> HYFFT_HD void hy_dft8(float (&re)[8], float (&im)[8]) {
    const float h = 0.70710678118654752f;
    float ar[4], ai[4], br[4], bi[4];
#pragma unroll
    for (int m = 0; m < 4; ++m) { ar[m] = re[m] + re[m + 4]; ai[m] = im[m] + im[m + 4]; br[m] = re[m] - re[m + 4]; bi[m] = im[m] - im[m + 4]; }
    { float x = br[1], y = bi[1]; if (!INV) { br[1] = h * (x + y); bi[1] = h * (y - x); } else { br[1] = h * (x - y); bi[1] = h * (y + x); } }
    { float x = br[2], y = bi[2]; if (!INV) { br[2] = y; bi[2] = -x; } else { br[2] = -y; bi[2] = x; } }
    { float x = br[3], y = bi[3]; if (!INV) { br[3] = h * (y - x); bi[3] = -h * (x + y); } else { br[3] = -h * (x + y); bi[3] = h * (x - y); } }
#pragma unroll
    for (int s = 0; s < 2; ++s) {
        float* cr = s ? br : ar; float* ci = s ? bi : ai;
        const float e0r = cr[0] + cr[2], e0i = ci[0] + ci[2], e1r = cr[0] - cr[2], e1i = ci[0] - ci[2];
        const float o0r = cr[1] + cr[3], o0i = ci[1] + ci[3]; const float dr = cr[1] - cr[3], di = ci[1] - ci[3];
        float o1r, o1i; if (!INV) { o1r = di; o1i = -dr; } else { o1r = -di; o1i = dr; }
        re[0 + s] = e0r + o0r; im[0 + s] = e0i + o0i;
        re[2 + s] = e1r + o1r; im[2 + s] = e1i + o1i;
        re[4 + s] = e0r - o0r; im[4 + s] = e0i - o0i;
        re[6 + s] = e1r - o1r; im[6 + s] = e1i - o1i;
    }
}
template <bool CONJ> HYFFT_HD void hy_twiddle(float (&re)[8], float (&im)[8], float wr, float wi) {
    if (CONJ) wi = -wi;
    const float w2r = wr * wr - wi * wi, w2i = 2.f * wr * wi;
    const float w3r = w2r * wr - w2i * wi, w3i = w2r * wi + w2i * wr;
    const float w4r = w2r * w2r - w2i * w2i, w4i = 2.f * w2r * w2i;
    const float w5r = w4r * wr - w4i * wi, w5i = w4r * wi + w4i * wr;
    const float w6r = w3r * w3r - w3i * w3i, w6i = 2.f * w3r * w3i;
    const float w7r = w4r * w3r - w4i * w3i, w7i = w4r * w3i + w4i * w3r;
    const float pr[8] = {1.f, wr, w2r, w3r, w4r, w5r, w6r, w7r}, pi[8] = {0.f, wi, w2i, w3i, w4i, w5i, w6i, w7i};
#pragma unroll
    for (int k = 1; k < 8; ++k) { const float x = re[k], y = im[k]; re[k] = x * pr[k] - y * pi[k]; im[k] = x * pi[k] + y * pr[k]; }
}
template <int L, class BP, class TP> HYFFT_HD void hy_fwd_store(BP buf, TP tw, int j, float (&re)[8], float (&im)[8]) {
    constexpr int S = L / 8; const int blk = j / S, q = j % S, base = blk * L + q;
    hy_dft8<false>(re, im);
    if (L > 8) { const hy_c32 w = tw[q * (4096 / L)]; hy_twiddle<false>(re, im, w.x, w.y); }
#pragma unroll
    for (int k = 0; k < 8; ++k) buf[hy_padi(base + k * S)] = (hy_c32){re[k], im[k]};
}
template <int L, class BP> HYFFT_HD void hy_load8(BP buf, int j, float (&re)[8], float (&im)[8]) {
    constexpr int S = L / 8; const int blk = j / S, q = j % S, base = blk * L + q;
#pragma unroll
    for (int k = 0; k < 8; ++k) { const hy_c32 v = buf[hy_padi(base + k * S)]; re[k] = v.x; im[k] = v.y; }
}
template <int L, class BP, class TP> HYFFT_HD void hy_fwd_stage(BP buf, TP tw, int j) { float re[8], im[8]; hy_load8<L>(buf, j, re, im); hy_fwd_store<L>(buf, tw, j, re, im); }
template <int L, class BP, class TP> HYFFT_HD void hy_inv_regs(BP buf, TP tw, int j, float (&re)[8], float (&im)[8]) {
    constexpr int S = L / 8; const int q = j % S;
    hy_load8<L>(buf, j, re, im);
    if (L > 8) { const hy_c32 w = tw[q * (4096 / L)]; hy_twiddle<true>(re, im, w.x, w.y); }
    hy_dft8<true>(re, im);
}
template <int L, class BP, class TP> HYFFT_HD void hy_inv_stage(BP buf, TP tw, int j) {
    constexpr int S = L / 8; const int blk = j / S, q = j % S, base = blk * L + q;
    float re[8], im[8]; hy_inv_regs<L>(buf, tw, j, re, im);
#pragma unroll
    for (int k = 0; k < 8; ++k) buf[hy_padi(base + k * S)] = (hy_c32){re[k], im[k]};
}
template <class BP, class KP> HYFFT_HD void hy_mid_stage(BP buf, KP K, int j) {
    float re[8], im[8]; hy_load8<8>(buf, j, re, im);
    hy_dft8<false>(re, im);
#pragma unroll
    for (int k = 0; k < 8; ++k) { const hy_c32 kv = K[hy_padi(8 * j + k)]; const float x = re[k], y = im[k]; re[k] = x * kv.x - y * kv.y; im[k] = x * kv.y + y * kv.x; }
    hy_dft8<true>(re, im);
#pragma unroll
    for (int k = 0; k < 8; ++k) buf[hy_padi(8 * j + k)] = (hy_c32){re[k], im[k]};
}
template <class BP> HYFFT_HD void hy_last_fwd(BP buf, int j) {
    float re[8], im[8]; hy_load8<8>(buf, j, re, im); hy_dft8<false>(re, im);
#pragma unroll
    for (int k = 0; k < 8; ++k) buf[hy_padi(8 * j + k)] = (hy_c32){re[k], im[k]};
}
template <class BP, class KP> HYFFT_HD void hy_separate(BP Z, KP K1, KP K2, int j) {
    const float sc = 0.5f / 4096.0f;
#pragma unroll
    for (int r = 0; r < 8; ++r) {
        const int p = j + 512 * r, f = hy_rev(p), g = (4096 - f) & 4095, p2 = hy_rev(g);
        const hy_c32 a = Z[hy_padi(p)], b = Z[hy_padi(p2)];
        K1[hy_padi(p)] = (hy_c32){(a.x + b.x) * sc, (a.y - b.y) * sc};
        K2[hy_padi(p)] = (hy_c32){(a.y + b.y) * sc, (b.x - a.x) * sc};
    }
}

constexpr int HY_BUF = 0, HY_K1 = 36864, HY_K2 = 73728, HY_TW = 110592;
struct Raw3 { bf16 a, b, c; };
__device__ __forceinline__ Raw3 raw3(const bf16* zp, int t) { Raw3 r; r.a = zp[t > 0 ? t - 1 : 0]; r.b = zp[t]; r.c = zp[t < SEQ - 1 ? t + 1 : SEQ - 1]; return r; }
__device__ __forceinline__ float sconv_raw(const Raw3& r, int t, float w0, float w1, float w2, float cb) {
    const float z0 = t > 0 ? bf1(r.a) : 0.f, z1 = bf1(r.b), z2 = t < SEQ - 1 ? bf1(r.c) : 0.f;
    return w0 * z0 + w1 * z1 + w2 * z2 + cb;
}
__device__ __forceinline__ void p3_hyena_fft(Frame& F) {
    LAS hy_c32* BUF = (LAS hy_c32*)(F.lds + HY_BUF); LAS hy_c32* K1 = (LAS hy_c32*)(F.lds + HY_K1); LAS hy_c32* K2 = (LAS hy_c32*)(F.lds + HY_K2);
    LAS hy_c32* TW = (LAS hy_c32*)(F.lds + HY_TW);
    const bf16* ZHT = (const bf16*)(F.ws + WS_ZHT); const float* FILT = (const float*)(F.ws + WS_FILT); bf16* AB = (bf16*)(F.ws + WS_H);
    const float* cw = F.in[I_HCW]; const float* cb = F.in[I_HCB]; const float* skip = F.in[I_HSKIP];
    const int j = F.tid;
    { float sn, cs; sincosf(-6.283185307179586f * (float)j / 4096.0f, &sn, &cs); TW[j] = (hy_c32){cs, sn}; }
    __syncthreads();
    for (int item = blockIdx.x; item < HYW; item += F.G) {
        const int c = item;
        float re[8], im[8];
        const bf16* zv = ZHT + (size_t)c * MTOK; const bf16* za = ZHT + (size_t)(1024 + c) * MTOK; const bf16* zb = ZHT + (size_t)(2048 + c) * MTOK;
        Raw3 rv0[4], rv1[4];
#pragma unroll
        for (int m = 0; m < 4; ++m) { rv0[m] = raw3(zv, j + 512 * m); rv1[m] = raw3(zv + SEQ, j + 512 * m); }
        {
            const float* hf0 = FILT + (size_t)(0 * 1024 + c) * SEQ; const float* hf1 = FILT + (size_t)(1 * 1024 + c) * SEQ;
            const float* hb0 = FILT + (size_t)(2 * 1024 + c) * SEQ; const float* hb1 = FILT + (size_t)(3 * 1024 + c) * SEQ;
#pragma unroll
            for (int m = 0; m < 4; ++m) { const int i = j + 512 * m; re[m] = hf0[i]; im[m] = hf1[i]; }
            if (j == 0) { re[0] += hb0[0]; im[0] += hb1[0]; }
#pragma unroll
            for (int m = 4; m < 8; ++m) { const int i = j + 512 * m; const bool z = (i == 2048); const int r = z ? 0 : 4096 - i; const float a = hb0[r], b = hb1[r]; re[m] = z ? 0.f : a; im[m] = z ? 0.f : b; }
            hy_fwd_store<4096>(BUF, TW, j, re, im); __syncthreads();
            hy_fwd_stage<512>(BUF, TW, j); __syncthreads();
            hy_fwd_stage<64>(BUF, TW, j); __syncthreads();
            hy_last_fwd(BUF, j); __syncthreads();
            hy_separate(BUF, K1, K2, j); __syncthreads();
        }
        const float vw0 = cw[c], vw1 = cw[3072 + c], vw2 = cw[6144 + c], vcb = cb[c];
        const float aw0 = cw[1024 + c], aw1 = cw[3072 + 1024 + c], aw2 = cw[6144 + 1024 + c], acb = cb[1024 + c];
        const float bw0 = cw[2048 + c], bw1 = cw[3072 + 2048 + c], bw2 = cw[6144 + 2048 + c], bcb = cb[2048 + c];
        const float sk0 = skip[c], sk1 = skip[1024 + c];
#pragma unroll 1
        for (int p = 0; p < 4; ++p) {
            const int boff = (2 * p) * SEQ;
            Raw3 rg0[4], rg1[4];
#pragma unroll
            for (int m = 0; m < 4; ++m) { rg0[m] = raw3(za + boff, j + 512 * m); rg1[m] = raw3(za + boff + SEQ, j + 512 * m); }
            float v0[4], v1[4];
#pragma unroll
            for (int m = 0; m < 4; ++m) { const int t = j + 512 * m; v0[m] = sconv_raw(rv0[m], t, vw0, vw1, vw2, vcb); v1[m] = sconv_raw(rv1[m], t, vw0, vw1, vw2, vcb); }
#pragma unroll
            for (int m = 0; m < 4; ++m) { re[m] = v0[m]; im[m] = v1[m]; re[m + 4] = 0.f; im[m + 4] = 0.f; }
            hy_fwd_store<4096>(BUF, TW, j, re, im); __syncthreads();
            hy_fwd_stage<512>(BUF, TW, j); __syncthreads();
            hy_fwd_stage<64>(BUF, TW, j); __syncthreads();
            hy_mid_stage(BUF, K1, j); __syncthreads();
            hy_inv_stage<64>(BUF, TW, j); __syncthreads();
            hy_inv_stage<512>(BUF, TW, j); __syncthreads();
            hy_inv_regs<4096>(BUF, TW, j, re, im);
#pragma unroll
            for (int m = 0; m < 4; ++m) { const int t = j + 512 * m;
                v0[m] = sconv_raw(rg0[m], t, aw0, aw1, aw2, acb) * (re[m] + sk0 * v0[m]); v1[m] = sconv_raw(rg1[m], t, aw0, aw1, aw2, acb) * (im[m] + sk0 * v1[m]); }
#pragma unroll
            for (int m = 0; m < 4; ++m) { rg0[m] = raw3(zb + boff, j + 512 * m); rg1[m] = raw3(zb + boff + SEQ, j + 512 * m); }
            { const int nb = (p < 3 ? boff + 2 * SEQ : 0);
#pragma unroll
              for (int m = 0; m < 4; ++m) { rv0[m] = raw3(zv + nb, j + 512 * m); rv1[m] = raw3(zv + nb + SEQ, j + 512 * m); } }
#pragma unroll
            for (int m = 0; m < 4; ++m) { re[m] = v0[m]; im[m] = v1[m]; re[m + 4] = 0.f; im[m + 4] = 0.f; }
            hy_fwd_store<4096>(BUF, TW, j, re, im); __syncthreads();
            hy_fwd_stage<512>(BUF, TW, j); __syncthreads();
            hy_fwd_stage<64>(BUF, TW, j); __syncthreads();
            hy_mid_stage(BUF, K2, j); __syncthreads();
            hy_inv_stage<64>(BUF, TW, j); __syncthreads();
            hy_inv_stage<512>(BUF, TW, j); __syncthreads();
            hy_inv_regs<4096>(BUF, TW, j, re, im);
#pragma unroll
            for (int m = 0; m < 4; ++m) { const int t = j + 512 * m;
                const float y0 = sconv_raw(rg0[m], t, bw0, bw1, bw2, bcb) * (re[m] + sk1 * v0[m]), y1 = sconv_raw(rg1[m], t, bw0, bw1, bw2, bcb) * (im[m] + sk1 * v1[m]);
                AB[(size_t)(boff + t) * DM + 1024 + c] = (bf16)f2bf(y0); AB[(size_t)(boff + SEQ + t) * DM + 1024 + c] = (bf16)f2bf(y1); }
        }
        __syncthreads();
    }
}

template <bool FINAL> __device__ __forceinline__ void ln_rows(Frame& F) {
    float* R = F.out; const float* st = (const float*)(F.ws + (FINAL ? WS_ST2 : WS_ST1)); float* MU = (float*)(F.ws + WS_MU1);
    const float* mod = (const float*)(F.ws + WS_MOD); bf16* H2 = (bf16*)(F.ws + WS_H);
    const float* lng = F.in[FINAL ? I_LN2G : I_LN1G]; const float* lnb = F.in[FINAL ? I_LN2B : I_LN1B];
    const int gw = blockIdx.x * NWAVES + F.wave, NGW = F.G * NWAVES, lane = F.lane;
    for (int row = gw; row < MTOK; row += NGW) {
        float s = 0.f, q = 0.f; if (lane < 32) { const f32x2 p = *(const f32x2*)(st + ((size_t)row * 32 + lane) * 2); s = p.x; q = p.y; }
        s = wave_sum(s); q = wave_sum(q);
        const float mean = s * (1.0f / DM); float var = q * (1.0f / DM) - mean * mean; var = var > 0.f ? var : 0.f; const float rstd = 1.0f / sqrtf(var + LN_EPS);
        if (!FINAL && lane == 0) *(f32x2*)(MU + (size_t)row * 2) = (f32x2){mean, rstd};
        const int b = row >> 11; float* rp = R + (size_t)row * DM;
#pragma unroll
        for (int j = 0; j < 8; ++j) { const int col = 4 * lane + 256 * j;
            const f32x4 v = *(const f32x4*)(rp + col); const f32x4 y = (v - mean) * rstd * *(const f32x4*)(lng + col) + *(const f32x4*)(lnb + col);
            if (FINAL) *(f32x4*)(rp + col) = y;
            else { const float* mp = mod + (size_t)b * MODW + col; const f32x4 h = y * (*(const f32x4*)(mp + 4 * DM) + 1.0f) + *(const f32x4*)(mp + 3 * DM);
                   v2u o; o.x = pk2(h[0], h[1]); o.y = pk2(h[2], h[3]); *(v2u*)(H2 + (size_t)row * DM + col) = o; } }
    }
}

typedef GAS unsigned gu32;
#define RLX_AGENT __ATOMIC_RELAXED, __HIP_MEMORY_SCOPE_AGENT
constexpr int LDSCTL_OFF = 131072, MISC_OFF = LDSCTL_OFF + 320;
constexpr int CW_BAR = 4096;
constexpr size_t CTL_ZERO_BYTES = 65536;
#define XB_TMO      128
#define XB_XCNT(j)  (256  + 64 * (j))
#define XB_XSUB(j)  (1280 + 64 * (j))
#define XB_XGEN(j)  (2304 + 64 * (j))
#define XB_TOP      3328
#define XB_TOPGEN   3392
#define XCD_BAR_WORDS 3456
#define XB_SPIN_CAP (1u << 18)

__device__ __forceinline__ unsigned xb_ld(unsigned* p)              { return __hip_atomic_load(p, __ATOMIC_RELAXED, __HIP_MEMORY_SCOPE_AGENT); }
__device__ __forceinline__ unsigned xb_add(unsigned* p, unsigned v) { return __hip_atomic_fetch_add(p, v, __ATOMIC_RELAXED, __HIP_MEMORY_SCOPE_AGENT); }
__device__ __forceinline__ unsigned xb_xcc_id() { return (unsigned)__builtin_amdgcn_s_getreg((3 << 11) | 20) & 0xFu; }
#define XB_SPIN(cond, bar) do { unsigned _sp = 0; while (cond) { __builtin_amdgcn_s_sleep(1); \
    if ((++_sp & 255u) == 0u) { if (xb_ld(&(bar)[XB_TMO])) break; if (_sp > XB_SPIN_CAP) { atomicAdd(&(bar)[XB_TMO], 1u); break; } } } } while (0)

struct XcdBarrier {
    unsigned* bar; unsigned x;
    volatile LAS unsigned* st;
};

__device__ __forceinline__ XcdBarrier xcd_barrier_post(unsigned* bar, volatile LAS unsigned* st) {
    XcdBarrier b; b.bar = bar; b.x = xb_xcc_id(); b.st = st;
    if (threadIdx.x == 0) (void)xb_add(&bar[XB_XCNT(b.x)], 1u);
    return b;
}
__device__ __forceinline__ void xcd_barrier_complete(unsigned* bar, unsigned x, unsigned& nloc, unsigned& nx) {
    const unsigned G = gridDim.x * gridDim.y * gridDim.z;
    unsigned sum, cnt, mine, sp = 0u;
    for (;;) {
        sum = 0u; cnt = 0u; mine = 0u;
#pragma unroll
        for (unsigned j = 0; j < 16; ++j) { const unsigned c = xb_ld(&bar[XB_XCNT(j)]); sum += c; cnt += (c > 0u) ? 1u : 0u; mine = (j == x) ? c : mine; }
        if (sum == G) break;
        __builtin_amdgcn_s_sleep(1);
        if ((++sp & 255u) == 0u) { if (xb_ld(&bar[XB_TMO])) break; if (sp > XB_SPIN_CAP) { atomicAdd(&bar[XB_TMO], 1u); break; } }
    }
    nloc = mine > 0u ? mine : 1u; nx = cnt > 0u ? cnt : 1u;
}

__device__ __forceinline__ void xcd_barrier(const XcdBarrier& b) {
    asm volatile("s_waitcnt vmcnt(0)" ::: "memory");
    __syncthreads();
    if (threadIdx.x == 0) {
        unsigned* bar = b.bar;
        __builtin_amdgcn_s_waitcnt(0);
        unsigned nloc = b.st[0], nx = b.st[1];
        if (nloc == 0u) { xcd_barrier_complete(bar, b.x, nloc, nx); b.st[0] = nloc; b.st[1] = nx; }
        const unsigned old = xb_add(&bar[XB_XSUB(b.x)], 1u);
        const unsigned gen = old / nloc;
        if (old + 1u == (gen + 1u) * nloc) {
            __builtin_amdgcn_fence(__ATOMIC_RELEASE, "agent");
            asm volatile("s_waitcnt vmcnt(0)" ::: "memory");
            const unsigned og = xb_add(&bar[XB_TOP], 1u);
            const unsigned tg = og / nx;
            if (og + 1u == (tg + 1u) * nx) xb_add(&bar[XB_TOPGEN], 1u);
            else XB_SPIN(xb_ld(&bar[XB_TOPGEN]) == tg, bar);
            __builtin_amdgcn_fence(__ATOMIC_ACQUIRE, "agent");
            xb_add(&bar[XB_XGEN(b.x)], 1u);
            asm volatile("s_waitcnt vmcnt(0)" ::: "memory");
        } else {
            XB_SPIN(xb_ld(&bar[XB_XGEN(b.x)]) == gen, bar);
            __builtin_amdgcn_fence(__ATOMIC_ACQUIRE, "agent");
            asm volatile("s_waitcnt vmcnt(0)" ::: "memory");
        }
    }
    __syncthreads();
}

#define GRID_SYNC() xcd_barrier(bar)

__global__ void __launch_bounds__(NWAVES * 64, 2) fwd_megakernel(Args args) {
    extern __shared__ __attribute__((aligned(16))) unsigned char lds[];
    Frame F;
    F.lds = (LAS unsigned char*)lds;
    F.tid = threadIdx.x; F.lane = F.tid & 63; F.wave = __builtin_amdgcn_readfirstlane(F.tid >> 6); F.G = gridDim.x;
    F.in = args.in; F.out = args.out; F.ws = args.ws;
    for (int u = F.tid; u < (LDS_BYTES - LDSCTL_OFF) / 4; u += NWAVES * 64) ((LAS unsigned*)(F.lds + LDSCTL_OFF))[u] = 0u;
    __syncthreads();
    XcdBarrier bar = xcd_barrier_post((unsigned*)(args.ws + WS_CTL) + CW_BAR, (volatile LAS unsigned*)(F.lds + MISC_OFF) + 8);
    unsigned char* ws = args.ws;
    const int lo = args.ph_lo, hi = args.ph_hi;
#define IN(k) (lo <= (k) && (k) < hi)
#define BOTH(k) (IN(k) && IN((k) + 1))
    const int gw = blockIdx.x * NWAVES + F.wave, NGW = F.G * NWAVES;

    if (IN(0)) {
        p0_mod(F);
        transpose_matrix(F, F.in[I_WIN], DM, INW, (bf16*)(ws + WS_WIN), DM, 0, 1, (int)blockIdx.x, F.G);
        transpose_matrix(F, F.in[I_WA], SGUW, DM, (bf16*)(ws + WS_WAB), DM, 0, 0, (int)((blockIdx.x + 128) % F.G), F.G);
        transpose_matrix(F, F.in[I_WB], HYW, DM, (bf16*)(ws + WS_WAB), DM, 1024, 0, (int)blockIdx.x, F.G);
        transpose_matrix(F, F.in[I_WO], DM, DM, (bf16*)(ws + WS_WO), DM, 0, 0, (int)blockIdx.x, F.G);
        { const float* sw = F.in[I_SW]; bf16* sgw = (bf16*)(ws + WS_SGW);
          for (int i = blockIdx.x * (NWAVES * 64) + F.tid; i < 8 * 128 * 128 / 2; i += F.G * NWAVES * 64) { const f32x2 v = *(const f32x2*)(sw + 2 * i); *(unsigned*)(sgw + 2 * i) = pk2(v.x, v.y); } }
        __syncthreads();
        p0_filter(F);
        if (BOTH(0)) GRID_SYNC();
    }
    if (IN(1)) { p1_modulate(F); if (BOTH(1)) GRID_SYNC(); }
    if (IN(2)) {
        { pg8::Gemm g{(const pg8::bf16_t*)(ws + WS_H), (const pg8::bf16_t*)(ws + WS_WIN), MTOK, 5120, DM}; pg8::StaticOrder S; S.init(MTOK, 5120, F.G, (int)blockIdx.x);
          pg8::EpiG1 E{(pg8::bf16_t*)(ws + WS_U), (pg8::bf16_t*)(ws + WS_G), F.in[I_BIN]};
          pg8::gemm_phase<pg8::EpiG1, pg8::StaticOrder, true, true>(F.lds, g, S, E); }
        __syncthreads();
        { pg8::Gemm g{(const pg8::bf16_t*)(ws + WS_WIN) + (size_t)5120 * DM, (const pg8::bf16_t*)(ws + WS_H), 4096, MTOK, DM}; pg8::StaticOrder S; S.init(4096, MTOK, F.G, (int)blockIdx.x);
          pg8::EpiG1T E{(pg8::bf16_t*)(ws + WS_V), (pg8::bf16_t*)(ws + WS_ZHT), F.in[I_BIN], (float*)(ws + WS_STV)};
          pg8::gemm_phase<pg8::EpiG1T, pg8::StaticOrder, true, true>(F.lds, g, S, E); }
        if (BOTH(2)) GRID_SYNC();
    }
    if (IN(3)) { __syncthreads(); p3_sgu(F); p3_hyena_fft(F); if (BOTH(3)) GRID_SYNC(); }
    if (IN(4)) {
        pg8::Gemm g{(const pg8::bf16_t*)(ws + WS_H), (const pg8::bf16_t*)(ws + WS_WAB), MTOK, DM, DM}; pg8::StaticOrder S; S.init(MTOK, DM, F.G, (int)blockIdx.x);
        pg8::EpiG2 E{(const pg8::bf16_t*)(ws + WS_G), (pg8::bf16_t*)(ws + WS_MERGED)};
        pg8::gemm_phase<pg8::EpiG2, pg8::StaticOrder, true, true>(F.lds, g, S, E);
        if (BOTH(4)) GRID_SYNC();
    }
    if (IN(5)) {
        pg8::Gemm g{(const pg8::bf16_t*)(ws + WS_MERGED), (const pg8::bf16_t*)(ws + WS_WO), MTOK, DM, DM}; pg8::StaticOrder S; S.init(MTOK, DM, F.G, (int)blockIdx.x);
        pg8::EpiRes<true> E{F.in[I_X], F.out, (const float*)(ws + WS_MOD) + 2 * DM, F.in[I_BO], nullptr, nullptr, nullptr, (float*)(ws + WS_ST1)};
        pg8::gemm_phase<pg8::EpiRes<true>, pg8::StaticOrder, true, true>(F.lds, g, S, E);
        if (BOTH(5)) GRID_SYNC();
    }
    if (IN(6)) {
        __syncthreads();
        ln_rows<false>(F);
        __syncthreads();
        transpose_matrix(F, F.in[I_WM1], DM, DFF, (bf16*)(ws + WS_WM1), DM, 0, 0, (int)blockIdx.x, F.G);
        transpose_matrix(F, F.in[I_WM2], DFF, DM, (bf16*)(ws + WS_WM2), DFF, 0, 0, (int)blockIdx.x, F.G);
        if (BOTH(6)) GRID_SYNC();
    }
    if (IN(7)) {
        __syncthreads();
        pg8::Gemm g{(const pg8::bf16_t*)(ws + WS_H), (const pg8::bf16_t*)(ws + WS_WM1), MTOK, DFF, DM}; pg8::StaticOrder S; S.init(MTOK, DFF, F.G, (int)blockIdx.x);
        pg8::EpiG4 E{(pg8::bf16_t*)(ws + WS_AFF), F.in[I_BM1]};
        pg8::gemm_phase<pg8::EpiG4, pg8::StaticOrder, true, true>(F.lds, g, S, E);
        if (BOTH(7)) GRID_SYNC();
    }
    if (IN(8)) {
        pg8::Gemm g{(const pg8::bf16_t*)(ws + WS_AFF), (const pg8::bf16_t*)(ws + WS_WM2), MTOK, DM, DFF}; pg8::StaticOrder S; S.init(MTOK, DM, F.G, (int)blockIdx.x);
        pg8::EpiRes<false> E{nullptr, F.out, (const float*)(ws + WS_MOD) + 5 * DM, F.in[I_BM2], F.in[I_LN1G], F.in[I_LN1B], (const float*)(ws + WS_MU1), (float*)(ws + WS_ST2)};
        pg8::gemm_phase<pg8::EpiRes<false>, pg8::StaticOrder, true, true>(F.lds, g, S, E);
        if (BOTH(8)) GRID_SYNC();
    }
    if (IN(9)) { ln_rows<true>(F); }
#undef IN
#undef BOTH
}

constexpr int N_PHASES = 10;
#ifndef MK_N_LAUNCHES
#define MK_N_LAUNCHES 1
#endif
extern "C" void kernel_launch(void* const* d_in, const int* in_sizes, int n_in, void* d_out, int out_size, void* d_ws, size_t ws_size, hipStream_t stream) {
    static int grid = 0;
    if (grid == 0) {
        if (n_in != 31 || in_sizes[0] != MTOK * DM || out_size != MTOK * DM || ws_size < WS_END) {
            fprintf(stderr, "kernel_launch: unexpected problem: n_in %d in0 %d out %d ws %zu (need %zu)\n", n_in, n_in > 0 ? in_sizes[0] : -1, out_size, ws_size, (size_t)WS_END); grid = -1; return; }
        int dev = 0, cus = 0, per_cu = 0;
        if (hipGetDevice(&dev) != hipSuccess || hipDeviceGetAttribute(&cus, hipDeviceAttributeMultiprocessorCount, dev) != hipSuccess) { grid = -1; return; }
        if (hipFuncSetAttribute((const void*)fwd_megakernel, hipFuncAttributeMaxDynamicSharedMemorySize, LDS_BYTES) != hipSuccess) { fprintf(stderr, "kernel_launch: hipFuncSetAttribute failed\n"); grid = -1; return; }
        if (hipOccupancyMaxActiveBlocksPerMultiprocessor(&per_cu, (const void*)fwd_megakernel, NWAVES * 64, LDS_BYTES) != hipSuccess || per_cu < 1) { fprintf(stderr, "kernel_launch: occupancy query says %d\n", per_cu); per_cu = 1; }
        (void)hipGetLastError();
        grid = cus;
    }
    if (grid < 0) return;
    if (hipMemsetAsync((char*)d_ws + WS_CTL, 0, CTL_ZERO_BYTES, stream) != hipSuccess) { fprintf(stderr, "kernel_launch: memset failed\n"); return; }
    Args a{};
    for (int i = 0; i < 31; ++i) a.in[i] = (const float*)d_in[i];
    a.out = (float*)d_out; a.ws = (unsigned char*)d_ws;
    if (MK_N_LAUNCHES == 1) {
        a.ph_lo = 0; a.ph_hi = N_PHASES;
        void* kargs[] = {&a};
        hipError_t e = hipLaunchCooperativeKernel((const void*)fwd_megakernel, dim3(grid), dim3(NWAVES * 64), kargs, LDS_BYTES, stream);
        if (e != hipSuccess) fprintf(stderr, "kernel_launch: cooperative launch failed: %s (grid %d)\n", hipGetErrorString(e), grid);
    } else {
        for (int p = 0; p < N_PHASES; ++p) { a.ph_lo = p; a.ph_hi = p + 1; hipLaunchKernelGGL(fwd_megakernel, dim3(grid), dim3(NWAVES * 64), LDS_BYTES, stream, a); }
    }
}
```

```cpp
#include <hip/hip_runtime.h>
#include <cstdio>
#include <cstdint>

namespace pg8 {
#define PG8_LAS __attribute__((address_space(3)))
typedef unsigned short bf16_t;
typedef short bf16x8 __attribute__((ext_vector_type(8)));
typedef float f32x4 __attribute__((ext_vector_type(4)));
typedef unsigned u32x4 __attribute__((ext_vector_type(4)));
typedef float f32x2 __attribute__((ext_vector_type(2)));
constexpr int EPI_LDS_OFF = 132096;
constexpr int BM = 256, BK = 64, HALF = 128, HTB = HALF * BK * 2  , STAGE_BYTES = 8 * HTB, NXCD = 8, WGM = 8;

__host__ __device__ __forceinline__ int lds_byte(int r, int c) { const int st = (r >> 4) * 2 + (c >> 5), rr = r & 15, cc = c & 31, ob = rr * 64 + cc * 2; return st * 1024 + (ob ^ (((ob >> 9) & 1) << 5)); }
__host__ __device__ __forceinline__ void stage_rc(int b, int& R, int& C) { const int st = b / 1024, sb = b % 1024, swz = sb ^ (((sb >> 9) & 1) << 5); R = (st >> 1) * 16 + swz / 64; C = (st & 1) * 32 + (swz % 64) / 2; }
__host__ __device__ __forceinline__ int perm32(int rho) { const int n = rho >> 4, i = rho & 15; return 8 * (i >> 2) + 4 * n + (i & 3); }

struct Unit { int pm, pn; };
struct Gemm { const bf16_t* A; const bf16_t* Bt; int M, N, K; };

struct StaticOrder {
    int nM, nN, nwg, G, c;
    __host__ __device__ void init(int M, int N, int G_, int c_) { nM = M / BM; nN = N / BM; nwg = nM * nN; G = G_; c = c_; }
    __host__ __device__ bool next(int i, Unit& u) const {
        const long L = (long)i * G + c; if (L >= nwg) return false;
        int wgid = (int)L; { const int q = nwg / NXCD, r = nwg % NXCD, xcd = wgid % NXCD, off = wgid / NXCD; wgid = (xcd < r ? xcd * (q + 1) : r * (q + 1) + (xcd - r) * q) + off; }
        const int nig = WGM * nN, gid = wgid / nig, fm = gid * WGM, gsz = (nM - fm) < WGM ? (nM - fm) : WGM;
        u.pm = fm + ((wgid % nig) % gsz); u.pn = (wgid % nig) / gsz; return true;
    }
    __device__ __forceinline__ void a_ready(const Unit&) const {}
    __device__ __forceinline__ void done(const Unit&) const {}
};

__device__ __forceinline__ unsigned cvt_pk_bf16(float lo, float hi) { unsigned r; asm volatile("v_cvt_pk_bf16_f32 %0, %1, %2" : "=v"(r) : "v"(lo), "v"(hi)); return r; }
__device__ __forceinline__ f32x2 gelu_pk(f32x2 v) {
    const f32x2 av = __builtin_elementwise_abs(v), d = av * 0.2316418882f + 1.0f;
    f32x2 t; t.x = __builtin_amdgcn_rcpf(d.x); t.y = __builtin_amdgcn_rcpf(d.y);
    f32x2 q = t * 0.5307027145f + (-0.7265760135f); q = q * t + 0.7107068705f; q = q * t + (-0.142248368f); q = q * t + 0.127414796f; q = q * t;
    const f32x2 s = (v * v) * (-0.72134752044f);
    f32x2 e; e.x = __builtin_amdgcn_exp2f(s.x); e.y = __builtin_amdgcn_exp2f(s.y);
    const f32x2 m = v * (q * e), r = v - m;
    f32x2 o; o.x = v.x < 0.f ? m.x : r.x; o.y = v.y < 0.f ? m.y : r.y; return o;
}
__device__ __forceinline__ float bf_lo(unsigned w) { return __uint_as_float(w << 16); }
__device__ __forceinline__ float bf_hi(unsigned w) { return __uint_as_float(w & 0xffff0000u); }
__device__ __forceinline__ float sigmoid_f(float x) { return __builtin_amdgcn_rcpf(1.0f + __expf(-x)); }
}

constexpr int DM = 2048, NBATCH = 8, SEQ = 2048, MTOK = NBATCH * SEQ;
constexpr int SGUW = 1024, HYW = 1024, DFF = 8192, INW = 9216, MODW = 6 * DM;
constexpr float LN_EPS = 1e-5f;
constexpr float DN_ALPHA = 1.189207115002721f;

namespace pg8 {

struct EpiG1 {
    static constexpr bool PERM = true, AFTER_DRAIN = false, MID = false; static constexpr int SLOT_FLOATS = 256;
    bf16_t* U; bf16_t* G; const float* b_in;
    __device__ __forceinline__ void mid(f32x4 (&)[2][2][4][2], const Unit&, int, int, int, int) const {}
    __device__ __forceinline__ void preload(PG8_LAS float* slot, const Unit& u, int tid) const { if (tid < 256) slot[tid] = b_in[(u.pn < 4 ? u.pn * 256 : 5120 + (u.pn - 4) * 256) + tid]; }
    __device__ __forceinline__ void operator()(const f32x4 (&acc)[2][2][4][2], const Unit& u, int wr, int wc, int fr, int fq, const PG8_LAS float* slot) const {
        const int row0 = u.pm * BM + wr * 64 + fr; const int pn = u.pn;
        int ldc, colt; bf16_t* base; const bool isu = pn < 4;
        if (isu) { base = U; ldc = SGUW; colt = pn * 256; }
        else { base = G; ldc = 2 * DM; colt = (pn - 4) * 256; }
        const int cl = wc * 32 + 8 * fq;
        f32x4 bv[2][2];
#pragma unroll
        for (int bj = 0; bj < 2; ++bj)
#pragma unroll
            for (int n = 0; n < 2; ++n) bv[bj][n] = *(const PG8_LAS f32x4*)(slot + cl + bj * HALF + 4 * n);
#pragma unroll
        for (int ai = 0; ai < 2; ++ai)
#pragma unroll
            for (int m = 0; m < 4; ++m) {
                const int row = row0 + ai * HALF + m * 16;
                bf16_t* rowp = base + (size_t)row * ldc + colt + cl;
#pragma unroll
                for (int bj = 0; bj < 2; ++bj) {
                    f32x4 v0 = acc[ai][bj][m][0] + bv[bj][0], v1 = acc[ai][bj][m][1] + bv[bj][1];
                    if (isu) {
                        f32x2 a = gelu_pk((f32x2){v0[0], v0[1]}), b = gelu_pk((f32x2){v0[2], v0[3]}), c = gelu_pk((f32x2){v1[0], v1[1]}), d = gelu_pk((f32x2){v1[2], v1[3]});
                        v0 = (f32x4){a.x, a.y, b.x, b.y}; v1 = (f32x4){c.x, c.y, d.x, d.y};
                    } else {
                        v0 = (f32x4){sigmoid_f(v0[0]), sigmoid_f(v0[1]), sigmoid_f(v0[2]), sigmoid_f(v0[3])};
                        v1 = (f32x4){sigmoid_f(v1[0]), sigmoid_f(v1[1]), sigmoid_f(v1[2]), sigmoid_f(v1[3])};
                    }
                    u32x4 w; w.x = cvt_pk_bf16(v0[0], v0[1]); w.y = cvt_pk_bf16(v0[2], v0[3]); w.z = cvt_pk_bf16(v1[0], v1[1]); w.w = cvt_pk_bf16(v1[2], v1[3]);
                    *(u32x4*)(rowp + bj * HALF) = w;
                }
            }
    }
};

struct EpiG1T {
    static constexpr bool PERM = true, AFTER_DRAIN = false, MID = false;
    bf16_t* VT; bf16_t* ZHT; const float* b_in; float* statsV; static constexpr int SLOT_FLOATS = 256;
    __device__ __forceinline__ void mid(f32x4 (&)[2][2][4][2], const Unit&, int, int, int, int) const {}
    __device__ __forceinline__ void preload(PG8_LAS float* slot, const Unit& u, int tid) const { if (tid < 256) slot[tid] = b_in[1024 + u.pm * 256 + tid]; }
    __device__ __forceinline__ void operator()(const f32x4 (&acc)[2][2][4][2], const Unit& u, int wr, int wc, int fr, int fq, const PG8_LAS float* slot) const {
        const int col0 = u.pn * BM + wc * 32 + 8 * fq; const bool isv = u.pm < 4;
        const int rowt = (isv ? u.pm : u.pm - 4) * BM + wr * 64 + fr;
        bf16_t* base = isv ? VT : ZHT;
#pragma unroll
        for (int ai = 0; ai < 2; ++ai) {
            float s[2][8], q[2][8];
#pragma unroll
            for (int bj = 0; bj < 2; ++bj)
#pragma unroll
                for (int e = 0; e < 8; ++e) { s[bj][e] = 0.f; q[bj][e] = 0.f; }
#pragma unroll
            for (int m = 0; m < 4; ++m) {
                const int row = rowt + ai * HALF + m * 16; const float bb = slot[wr * 64 + fr + ai * HALF + m * 16];
                bf16_t* rowp = base + (size_t)row * MTOK + col0;
#pragma unroll
                for (int bj = 0; bj < 2; ++bj) {
                    f32x4 v0 = acc[ai][bj][m][0] + bb, v1 = acc[ai][bj][m][1] + bb;
                    if (isv) {
                        f32x2 a = gelu_pk((f32x2){v0[0], v0[1]}), b = gelu_pk((f32x2){v0[2], v0[3]}), c = gelu_pk((f32x2){v1[0], v1[1]}), d = gelu_pk((f32x2){v1[2], v1[3]});
                        v0 = (f32x4){a.x, a.y, b.x, b.y}; v1 = (f32x4){c.x, c.y, d.x, d.y};
                    }
                    u32x4 w; w.x = cvt_pk_bf16(v0[0], v0[1]); w.y = cvt_pk_bf16(v0[2], v0[3]); w.z = cvt_pk_bf16(v1[0], v1[1]); w.w = cvt_pk_bf16(v1[2], v1[3]);
                    *(u32x4*)(rowp + bj * HALF) = w;
                    if (isv) {
                        const float e0 = bf_lo(w.x), e1 = bf_hi(w.x), e2 = bf_lo(w.y), e3 = bf_hi(w.y), e4 = bf_lo(w.z), e5 = bf_hi(w.z), e6 = bf_lo(w.w), e7 = bf_hi(w.w);
                        s[bj][0] += e0; s[bj][1] += e1; s[bj][2] += e2; s[bj][3] += e3; s[bj][4] += e4; s[bj][5] += e5; s[bj][6] += e6; s[bj][7] += e7;
                        q[bj][0] += e0 * e0; q[bj][1] += e1 * e1; q[bj][2] += e2 * e2; q[bj][3] += e3 * e3; q[bj][4] += e4 * e4; q[bj][5] += e5 * e5; q[bj][6] += e6 * e6; q[bj][7] += e7 * e7;
                    }
                }
            }
            if (isv) {
                const int slot = u.pm * 4 + ai * 2 + wr;
#pragma unroll
                for (int bj = 0; bj < 2; ++bj)
#pragma unroll
                    for (int e = 0; e < 8; ++e) {
                        float a = s[bj][e], b = q[bj][e];
                        a += __shfl_xor(a, 1); b += __shfl_xor(b, 1); a += __shfl_xor(a, 2); b += __shfl_xor(b, 2);
                        a += __shfl_xor(a, 4); b += __shfl_xor(b, 4); a += __shfl_xor(a, 8); b += __shfl_xor(b, 8);
                        if (fr == 0) *(f32x2*)(statsV + ((size_t)(col0 + bj * HALF + e) * 16 + slot) * 2) = (f32x2){a, b};
                    }
            }
        }
    }
};

struct EpiG2 {
    static constexpr bool PERM = true, AFTER_DRAIN = false, MID = true;
    const bf16_t* G; bf16_t* O; static constexpr int SLOT_FLOATS = 0;
    __device__ __forceinline__ void preload(PG8_LAS float*, const Unit&, int) const {}
    __device__ __forceinline__ void mid(f32x4 (&acc)[2][2][4][2], const Unit& u, int wr, int wc, int fr, int fq) const {
        int row0 = u.pm * BM + wr * 64 + fr, col0 = u.pn * BM + wc * 32 + 8 * fq;
        asm volatile("" : "+v"(row0), "+v"(col0));
#pragma unroll
        for (int ai = 0; ai < 2; ++ai)
#pragma unroll
            for (int m = 0; m < 4; ++m) {
                const bf16_t* gp = G + (size_t)(row0 + ai * HALF + m * 16) * (2 * DM) + col0;
#pragma unroll
                for (int bj = 0; bj < 2; ++bj) {
                    const u32x4 ga = *(const u32x4*)(gp + bj * HALF), gb = *(const u32x4*)(gp + DM + bj * HALF);
                    f32x4 r0, r1;
                    r0[0] = bf_lo(ga.x) * __builtin_amdgcn_rcpf(bf_lo(gb.x)); r0[1] = bf_hi(ga.x) * __builtin_amdgcn_rcpf(bf_hi(gb.x));
                    r0[2] = bf_lo(ga.y) * __builtin_amdgcn_rcpf(bf_lo(gb.y)); r0[3] = bf_hi(ga.y) * __builtin_amdgcn_rcpf(bf_hi(gb.y));
                    r1[0] = bf_lo(ga.z) * __builtin_amdgcn_rcpf(bf_lo(gb.z)); r1[1] = bf_hi(ga.z) * __builtin_amdgcn_rcpf(bf_hi(gb.z));
                    r1[2] = bf_lo(ga.w) * __builtin_amdgcn_rcpf(bf_lo(gb.w)); r1[3] = bf_hi(ga.w) * __builtin_amdgcn_rcpf(bf_hi(gb.w));
                    acc[ai][bj][m][0] *= r0; acc[ai][bj][m][1] *= r1;
                }
            }
    }
    __device__ __forceinline__ void operator()(const f32x4 (&acc)[2][2][4][2], const Unit& u, int wr, int wc, int fr, int fq, const PG8_LAS float*) const {
        const int row0 = u.pm * BM + wr * 64 + fr, col0 = u.pn * BM + wc * 32 + 8 * fq;
#pragma unroll
        for (int ai = 0; ai < 2; ++ai)
#pragma unroll
            for (int m = 0; m < 4; ++m) {
                const int row = row0 + ai * HALF + m * 16;
                const bf16_t* gp = G + (size_t)row * (2 * DM) + DM + col0;
                bf16_t* op = O + (size_t)row * DM + col0;
#pragma unroll
                for (int bj = 0; bj < 2; ++bj) {
                    const u32x4 gb = *(const u32x4*)(gp + bj * HALF);
                    const f32x4 a0 = acc[ai][bj][m][0], a1 = acc[ai][bj][m][1];
                    u32x4 w; w.x = cvt_pk_bf16(a0[0] * bf_lo(gb.x), a0[1] * bf_hi(gb.x)); w.y = cvt_pk_bf16(a0[2] * bf_lo(gb.y), a0[3] * bf_hi(gb.y));
                    w.z = cvt_pk_bf16(a1[0] * bf_lo(gb.z), a1[1] * bf_hi(gb.z)); w.w = cvt_pk_bf16(a1[2] * bf_lo(gb.w), a1[3] * bf_hi(gb.w));
                    *(u32x4*)(op + bj * HALF) = w;
                }
            }
    }
};

template <bool FIRST> struct EpiRes {
    static constexpr bool PERM = false, AFTER_DRAIN = false, MID = false; static constexpr int SLOT_FLOATS = FIRST ? 512 : 1024;
    const float* X;
    float* R;
    const float* gate;
    const float* bias;
    const float* lng; const float* lnb; const float* MU;
    float* stats;
    __device__ __forceinline__ void mid(f32x4 (&)[2][2][4][2], const Unit&, int, int, int, int) const {}
    __device__ __forceinline__ void preload(PG8_LAS float* slot, const Unit& u, int tid) const {
        const int c = tid & 255, col = u.pn * BM + c;
        if (tid < 256) slot[c] = gate[(size_t)(u.pm >> 3) * MODW + col]; else slot[256 + c] = bias[col];
        if (!FIRST) { if (tid < 256) slot[512 + c] = DN_ALPHA * lng[col]; else slot[768 + c] = DN_ALPHA * lnb[col]; }
    }
    __device__ __forceinline__ void operator()(const f32x4 (&acc)[2][2][4][2], const Unit& u, int wr, int wc, int fr, int fq, const PG8_LAS float* slot) const {
        int row0 = u.pm * BM + wr * 64 + fr; const int cl = wc * 32 + 4 * fq; int col0 = u.pn * BM + cl;
        asm volatile("" : "+v"(row0), "+v"(col0));
        constexpr int RB = FIRST ? 2 : 1;
#pragma unroll
        for (int ab = 0; ab < 8 / RB; ++ab) {
            const int ai = (ab * RB) >> 2, mb = (ab * RB) & 3;
            f32x4 base[RB][2][2]; f32x2 mr[RB];
            int rowb = row0 + ai * HALF + mb * 16; asm volatile("" : "+v"(rowb));
#pragma unroll
            for (int mm = 0; mm < RB; ++mm) {
                const size_t off = (size_t)(rowb + mm * 16) * DM + col0;
                if (!FIRST) mr[mm] = *(const f32x2*)(MU + (size_t)(rowb + mm * 16) * 2);
#pragma unroll
                for (int bj = 0; bj < 2; ++bj)
#pragma unroll
                    for (int n = 0; n < 2; ++n) base[mm][bj][n] = FIRST ? *(const f32x4*)(X + off + bj * HALF + n * 16) : *(const f32x4*)(R + off + bj * HALF + n * 16);
            }
#pragma unroll
            for (int mm = 0; mm < RB; ++mm) {
                const int m = mb + mm;
                const int row = rowb + mm * 16; float* rp = R + (size_t)row * DM + col0;
                float s = 0.f, q = 0.f;
#pragma unroll
                for (int bj = 0; bj < 2; ++bj)
#pragma unroll
                    for (int n = 0; n < 2; ++n) {
                        const int co = bj * HALF + n * 16;
                        const f32x4 gv = *(const PG8_LAS f32x4*)(slot + cl + co), bv = *(const PG8_LAS f32x4*)(slot + 256 + cl + co);
                        f32x4 bs;
                        if (FIRST) bs = base[mm][bj][n] * DN_ALPHA;
                        else bs = (base[mm][bj][n] - mr[mm].x) * mr[mm].y * *(const PG8_LAS f32x4*)(slot + 512 + cl + co) + *(const PG8_LAS f32x4*)(slot + 768 + cl + co);
                        const f32x4 o = bs + gv * (acc[ai][bj][m][n] + bv);
                        *(f32x4*)(rp + co) = o;
                        s += (o[0] + o[1]) + (o[2] + o[3]); q += (o[0] * o[0] + o[1] * o[1]) + (o[2] * o[2] + o[3] * o[3]);
                    }
                s += __shfl_xor(s, 16); s += __shfl_xor(s, 32); q += __shfl_xor(q, 16); q += __shfl_xor(q, 32);
                if (fq == 0) *(f32x2*)(stats + ((size_t)row * 32 + u.pn * 4 + wc) * 2) = (f32x2){s, q};
            }
            asm volatile("" ::: "memory");
        }
    }
};

struct EpiG4 {
    static constexpr bool PERM = true, AFTER_DRAIN = false, MID = false; static constexpr int SLOT_FLOATS = 256;
    bf16_t* O; const float* bias;
    __device__ __forceinline__ void mid(f32x4 (&)[2][2][4][2], const Unit&, int, int, int, int) const {}
    __device__ __forceinline__ void preload(PG8_LAS float* slot, const Unit& u, int tid) const { if (tid < 256) slot[tid] = bias[u.pn * BM + tid]; }
    __device__ __forceinline__ void operator()(const f32x4 (&acc)[2][2][4][2], const Unit& u, int wr, int wc, int fr, int fq, const PG8_LAS float* slot) const {
        const int row0 = u.pm * BM + wr * 64 + fr, cl = wc * 32 + 8 * fq, col0 = u.pn * BM + cl;
        f32x4 bv[2][2];
#pragma unroll
        for (int bj = 0; bj < 2; ++bj)
#pragma unroll
            for (int n = 0; n < 2; ++n) bv[bj][n] = *(const PG8_LAS f32x4*)(slot + cl + bj * HALF + 4 * n);
#pragma unroll
        for (int ai = 0; ai < 2; ++ai)
#pragma unroll
            for (int m = 0; m < 4; ++m) {
                bf16_t* rowp = O + (size_t)(row0 + ai * HALF + m * 16) * DFF + col0;
#pragma unroll
                for (int bj = 0; bj < 2; ++bj) {
                    f32x4 v0 = acc[ai][bj][m][0] + bv[bj][0], v1 = acc[ai][bj][m][1] + bv[bj][1];
                    v0 = __builtin_elementwise_max(v0, (f32x4){0.f, 0.f, 0.f, 0.f}); v1 = __builtin_elementwise_max(v1, (f32x4){0.f, 0.f, 0.f, 0.f});
                    v0 = v0 * v0; v1 = v1 * v1;
                    u32x4 w; w.x = cvt_pk_bf16(v0[0], v0[1]); w.y = cvt_pk_bf16(v0[2], v0[3]); w.z = cvt_pk_bf16(v1[0], v1[1]); w.w = cvt_pk_bf16(v1[2], v1[3]);
                    *(u32x4*)(rowp + bj * HALF) = w;
                }
            }
    }
};
}
namespace pg8 {
template <class Epi, class Sched, bool ALIGN_EPI = false, bool SP2 = false>
__device__ __forceinline__ void gemm_phase(PG8_LAS unsigned char* lds, const Gemm g, const Sched& S, const Epi& E) {
    const int tid = threadIdx.x, wid = __builtin_amdgcn_readfirstlane(tid >> 6), lane = tid & 63, wr = wid >> 2, wc = wid & 3, fr = lane & 15, fq = lane >> 4;
    const int K = g.K, nt = K / BK;
    unsigned voffA[2], voffB[2];
#pragma unroll
    for (int i = 0; i < 2; ++i) { int R, C; stage_rc(tid * 16 + i * 8192, R, C); const int Rb = Epi::PERM ? ((R & ~31) + perm32(R & 31)) : R;
        voffA[i] = (unsigned)(R * K + C) * 2u; voffB[i] = (unsigned)(Rb * K + C) * 2u; }
    const size_t kstep = (size_t)(BK * 2);
    const size_t hstep = (size_t)HALF * K * 2;
    const size_t tstep = 2 * hstep;
    const unsigned ldsw = (unsigned)wid * 1024u;
    const int aoff = lds_byte(wr * 64 + fr, fq * 8), boff = lds_byte(wc * 32 + fr, fq * 8);
#define PG8_SA(b, h) (((b) * 2 + (h)) * HTB)
#define PG8_SB(b, h) ((4 + (b) * 2 + (h)) * HTB)
#define PG8_STAGE(bufoff, gbase, voff) do { _Pragma("unroll") for (int _i = 0; _i < 2; ++_i) \
        __builtin_amdgcn_global_load_lds((const unsigned*)((const char*)(gbase) + (voff)[_i]), (PG8_LAS unsigned*)(lds + (bufoff) + ldsw + _i * 8192), 16, 0, 0); } while (0)
#define PG8_LDA(dst, b, h) do { _Pragma("unroll") for (int m = 0; m < 4; ++m) _Pragma("unroll") for (int k = 0; k < 2; ++k) dst[m][k] = *(const PG8_LAS bf16x8*)(lds + PG8_SA(b, h) + aoff + m * 2048 + k * 1024); } while (0)
#define PG8_LDB(dst, b, h) do { _Pragma("unroll") for (int n = 0; n < 2; ++n) _Pragma("unroll") for (int k = 0; k < 2; ++k) dst[n][k] = *(const PG8_LAS bf16x8*)(lds + PG8_SB(b, h) + boff + n * 2048 + k * 1024); } while (0)
#define PG8_MMA(ai, bj, At, Bt) do { __builtin_amdgcn_s_setprio(1); _Pragma("unroll") for (int m = 0; m < 4; ++m) _Pragma("unroll") for (int n = 0; n < 2; ++n) _Pragma("unroll") for (int k = 0; k < 2; ++k) \
        acc[ai][bj][m][n] = __builtin_amdgcn_mfma_f32_16x16x32_bf16(Bt[n][k], At[m][k], acc[ai][bj][m][n], 0, 0, 0); __builtin_amdgcn_s_setprio(0); } while (0)
#define PG8_WAIT_V(n) asm volatile("s_waitcnt vmcnt(" #n ")" ::: "memory")
#define PG8_WAIT_L(n) asm volatile("s_waitcnt lgkmcnt(" #n ")" ::: "memory")
#define PG8_BAR __builtin_amdgcn_s_barrier()
#define PG8_SCHED __builtin_amdgcn_sched_barrier(0)
    Unit cur, nxt; int ui = 0;
    if (!S.next(0, cur)) return;
    {
        Unit pu; for (int i = 0; S.next(i, pu); ++i) E.preload((PG8_LAS float*)(lds + EPI_LDS_OFF) + i * Epi::SLOT_FLOATS, pu, tid);
        asm volatile("s_waitcnt vmcnt(0) lgkmcnt(0)" ::: "memory"); __builtin_amdgcn_s_barrier(); asm volatile("" ::: "memory");
    }
    f32x4 acc[2][2][4][2];
#pragma unroll
    for (int a = 0; a < 2; ++a)
#pragma unroll
        for (int b = 0; b < 2; ++b)
#pragma unroll
            for (int m = 0; m < 4; ++m)
#pragma unroll
                for (int n = 0; n < 2; ++n) acc[a][b][m][n] = (f32x4){0.f, 0.f, 0.f, 0.f};
    bf16x8 At[4][2], B0[2][2], B1[2][2];
    const char* cA = (const char*)g.A + (size_t)cur.pm * tstep; const char* cB = (const char*)g.Bt + (size_t)cur.pn * tstep;
    S.a_ready(cur);
    if constexpr (SP2) {
        PG8_STAGE(PG8_SB(0, 0), cB, voffB); PG8_STAGE(PG8_SB(0, 1), cB + hstep, voffB); PG8_STAGE(PG8_SA(0, 0), cA, voffA); PG8_STAGE(PG8_SA(0, 1), cA + hstep, voffA);
        if (wr == 1) PG8_BAR;
        PG8_WAIT_V(2); PG8_BAR;
        PG8_STAGE(PG8_SB(1, 0), cB + kstep, voffB); PG8_STAGE(PG8_SA(1, 0), cA + kstep, voffA); PG8_STAGE(PG8_SB(1, 1), cB + hstep + kstep, voffB);
        PG8_WAIT_V(6); PG8_BAR;
    } else {
        PG8_STAGE(PG8_SB(0, 0), cB, voffB); PG8_STAGE(PG8_SA(0, 0), cA, voffA); PG8_STAGE(PG8_SB(0, 1), cB + hstep, voffB); PG8_STAGE(PG8_SA(0, 1), cA + hstep, voffA);
        if (wr == 1) PG8_BAR;
        PG8_WAIT_V(4); PG8_BAR;
        PG8_STAGE(PG8_SB(1, 0), cB + kstep, voffB); PG8_STAGE(PG8_SA(1, 0), cA + kstep, voffA); PG8_STAGE(PG8_SB(1, 1), cB + hstep + kstep, voffB);
        PG8_WAIT_V(6); PG8_BAR;
    }
    for (;;) {
        const bool has_next = S.next(ui + 1, nxt);
        const char* nA = has_next ? (const char*)g.A + (size_t)nxt.pm * tstep : cA; const char* nB = has_next ? (const char*)g.Bt + (size_t)nxt.pn * tstep : cB;
        for (int t = 0; t < nt; t += 2) {
            const bool last = (t == nt - 2);
            const char* a1 = cA + (size_t)(t + 1) * kstep;
            const char* a2 = last ? nA : cA + (size_t)(t + 2) * kstep; const char* b2 = last ? nB : cB + (size_t)(t + 2) * kstep;
            const char* a3 = a2 + kstep; const char* b3 = b2 + kstep;
            if (last && has_next) S.a_ready(nxt);
            if constexpr (Epi::MID) { if (t == (nt >> 1)) E.mid(acc, cur, wr, wc, fr, fq); }
            if constexpr (SP2) {
            PG8_LDB(B0, 0, 0); PG8_LDB(B1, 0, 1); PG8_SCHED; PG8_LDA(At, 0, 0); PG8_STAGE(PG8_SA(1, 1), a1 + hstep, voffA);
            PG8_WAIT_V(8); PG8_WAIT_L(0); PG8_BAR; PG8_MMA(0, 0, At, B0); PG8_MMA(0, 1, At, B1); PG8_BAR; PG8_SCHED;
            PG8_LDA(At, 0, 1); PG8_STAGE(PG8_SB(0, 0), b2, voffB); PG8_STAGE(PG8_SB(0, 1), b2 + hstep, voffB); PG8_STAGE(PG8_SA(0, 0), a2, voffA);
            PG8_WAIT_V(8); PG8_WAIT_L(0); PG8_BAR; PG8_MMA(1, 0, At, B0); PG8_MMA(1, 1, At, B1); PG8_BAR; PG8_SCHED;
            PG8_LDB(B0, 1, 0); PG8_LDB(B1, 1, 1); PG8_SCHED; PG8_LDA(At, 1, 0); PG8_STAGE(PG8_SA(0, 1), a2 + hstep, voffA);
            PG8_WAIT_V(8); PG8_WAIT_L(0); PG8_BAR; PG8_MMA(0, 0, At, B0); PG8_MMA(0, 1, At, B1); PG8_BAR; PG8_SCHED;
            PG8_LDA(At, 1, 1); PG8_STAGE(PG8_SB(1, 0), b3, voffB); PG8_STAGE(PG8_SB(1, 1), b3 + hstep, voffB); PG8_STAGE(PG8_SA(1, 0), a3, voffA);
            PG8_WAIT_V(8); PG8_WAIT_L(0); PG8_BAR; PG8_MMA(1, 0, At, B0); PG8_MMA(1, 1, At, B1); PG8_BAR; PG8_SCHED;
            } else {
            PG8_LDB(B0, 0, 0); PG8_SCHED; PG8_LDA(At, 0, 0); PG8_STAGE(PG8_SA(1, 1), a1 + hstep, voffA);
            PG8_WAIT_L(8); PG8_BAR; PG8_WAIT_L(0); PG8_MMA(0, 0, At, B0); PG8_BAR; PG8_SCHED;
            PG8_LDB(B1, 0, 1); PG8_STAGE(PG8_SB(0, 0), b2, voffB);
            PG8_BAR; PG8_WAIT_L(0); PG8_MMA(0, 1, At, B1); PG8_BAR;
            PG8_LDA(At, 0, 1); PG8_STAGE(PG8_SA(0, 0), a2, voffA);
            PG8_BAR; PG8_WAIT_L(0); PG8_MMA(1, 0, At, B0); PG8_BAR; PG8_SCHED;
            PG8_STAGE(PG8_SB(0, 1), b2 + hstep, voffB);
            PG8_WAIT_V(6); PG8_BAR; PG8_MMA(1, 1, At, B1); PG8_BAR;
            PG8_LDB(B0, 1, 0); PG8_SCHED; PG8_LDA(At, 1, 0); PG8_STAGE(PG8_SA(0, 1), a2 + hstep, voffA);
            PG8_WAIT_L(8); PG8_BAR; PG8_WAIT_L(0); PG8_MMA(0, 0, At, B0); PG8_BAR; PG8_SCHED;
            PG8_LDB(B1, 1, 1); PG8_STAGE(PG8_SB(1, 0), b3, voffB);
            PG8_BAR; PG8_WAIT_L(0); PG8_MMA(0, 1, At, B1); PG8_BAR;
            PG8_LDA(At, 1, 1); PG8_STAGE(PG8_SA(1, 0), a3, voffA);
            PG8_BAR; PG8_WAIT_L(0); PG8_MMA(1, 0, At, B0); PG8_BAR; PG8_SCHED;
            PG8_STAGE(PG8_SB(1, 1), b3 + hstep, voffB);
            PG8_WAIT_V(6); PG8_BAR; PG8_MMA(1, 1, At, B1); PG8_BAR;
            }
        }
        if constexpr (ALIGN_EPI) { if (wr == 0) PG8_BAR; }
        if constexpr (!Epi::AFTER_DRAIN) { E(acc, cur, wr, wc, fr, fq, (const PG8_LAS float*)(lds + EPI_LDS_OFF) + ui * Epi::SLOT_FLOATS); S.done(cur); }
        if (!has_next) break;
#pragma unroll
        for (int a = 0; a < 2; ++a)
#pragma unroll
            for (int b = 0; b < 2; ++b)
#pragma unroll
                for (int m = 0; m < 4; ++m)
#pragma unroll
                    for (int n = 0; n < 2; ++n) acc[a][b][m][n] = (f32x4){0.f, 0.f, 0.f, 0.f};
        cur = nxt; cA = nA; cB = nB; ++ui;
        if constexpr (ALIGN_EPI) { if (wr == 1) PG8_BAR; }
    }
    PG8_WAIT_V(0);
    if constexpr (!ALIGN_EPI) { if (wr == 0) PG8_BAR; }
    PG8_BAR;
    if constexpr (Epi::AFTER_DRAIN) { E.fused(acc, cur, wr, wc, fr, fq, lds, wid, lane); S.done(cur); }
#undef PG8_SA
#undef PG8_SB
#undef PG8_STAGE
#undef PG8_LDA
#undef PG8_LDB
#undef PG8_MMA
#undef PG8_WAIT_V
#undef PG8_WAIT_L
#undef PG8_BAR
#undef PG8_SCHED
}
}

constexpr size_t MiB = 1u << 20;
constexpr size_t WS_CTL = 0;
constexpr size_t WS_MOD = 1 * MiB;
constexpr size_t WS_STV = 2 * MiB;
constexpr size_t WS_ST1 = 4 * MiB;
constexpr size_t WS_ST2 = 8 * MiB;
constexpr size_t WS_MU1 = 12 * MiB;
constexpr size_t WS_SGW = 13 * MiB;
constexpr size_t WS_WIN = 16 * MiB;
constexpr size_t WS_WAB = 52 * MiB;
constexpr size_t WS_WO = 60 * MiB;
constexpr size_t WS_FILT = 68 * MiB;
constexpr size_t WS_WM2 = 68 * MiB;
constexpr size_t WS_H = 100 * MiB;
constexpr size_t WS_U = 164 * MiB;
constexpr size_t WS_V = 196 * MiB;
constexpr size_t WS_MERGED = 164 * MiB;
constexpr size_t WS_ZHT = 228 * MiB;
constexpr size_t WS_G = 324 * MiB;
constexpr size_t WS_AFF = 164 * MiB;
constexpr size_t WS_WM1 = 420 * MiB;
constexpr size_t WS_YT = 452 * MiB;
constexpr size_t WS_END = 484 * MiB;

constexpr int NWAVES = 8;
constexpr int LDS_BYTES = 147456;

#define GAS __attribute__((address_space(1)))
#define LAS __attribute__((address_space(3)))
typedef unsigned short bf16;
typedef unsigned v4u __attribute__((ext_vector_type(4)));
typedef unsigned v2u __attribute__((ext_vector_type(2)));
typedef float f32x4 __attribute__((ext_vector_type(4)));
typedef float f32x2 __attribute__((ext_vector_type(2)));
#define LDS_WAIT() asm volatile("s_waitcnt lgkmcnt(0)" ::: "memory")

__device__ __forceinline__ unsigned f2bf(float f) { unsigned u = __builtin_bit_cast(unsigned, f); return (u + 0x7fffu + ((u >> 16) & 1u)) >> 16; }
__device__ __forceinline__ unsigned pk2(float lo, float hi) { return f2bf(lo) | (f2bf(hi) << 16); }
__device__ __forceinline__ float bflo(unsigned w) { return __uint_as_float(w << 16); }
__device__ __forceinline__ float bfhi(unsigned w) { return __uint_as_float(w & 0xffff0000u); }
__device__ __forceinline__ float bf1(bf16 h) { return __uint_as_float((unsigned)h << 16); }
__device__ __forceinline__ float wave_sum(float v) {
#pragma unroll
    for (int o = 1; o < 64; o <<= 1) v += __shfl_xor(v, o);
    return v;
}

struct Args { const float* in[31]; float* out; unsigned char* ws; int ph_lo, ph_hi; };

struct Frame {
    LAS unsigned char* lds;
    int tid, lane, wave, G;
    const float* const* in; float* out; unsigned char* ws;
};
enum { I_X = 0, I_C, I_WADA, I_BADA, I_WIN, I_BIN, I_SLNG, I_SLNB, I_SW, I_SB, I_HCW, I_HCB, I_HW1, I_HB1, I_HW2, I_HB2, I_HFREQ, I_HW3, I_HSKIP,
       I_WA, I_WB, I_WO, I_BO, I_LN1G, I_LN1B, I_WM1, I_BM1, I_WM2, I_BM2, I_LN2G, I_LN2B };

__device__ __forceinline__ void transpose_matrix(Frame& F, const float* W, int K, int N, bf16* WT, int ldk, int koff, int remap_win, int first, int nblocks) {
    LAS float* tile = (LAS float*)F.lds;
    const int tid = F.tid, nblk = N / 256, nitems = (K / 64) * nblk;
    const int lr = tid >> 6, lc = tid & 63;
    const int wc = tid & 7, wn = tid >> 3;
    for (int it = first; it < nitems; it += nblocks) {
        const int kb = it / nblk, nb = it % nblk, n0 = nb * 256, k0 = kb * 64; int row0 = n0;
        if (remap_win) row0 = (n0 < 1024) ? n0 : (n0 < 2048 ? n0 - 1024 + 5120 : (n0 < 5120 ? n0 - 2048 + 6144 : n0 - 5120 + 1024));
        f32x4 v[8];
#pragma unroll
        for (int i = 0; i < 8; ++i) v[i] = *(const f32x4*)(W + (size_t)(k0 + 8 * i + lr) * N + n0 + 4 * lc);
#pragma unroll
        for (int i = 0; i < 8; ++i) *(LAS f32x4*)(tile + (8 * i + lr) * 256 + ((lc ^ i) << 2)) = v[i];
        __syncthreads();
#pragma unroll
        for (int j = 0; j < 4; ++j) { const int n = wn + 64 * j; const LAS float* sp = tile + (8 * wc) * 256 + ((((n >> 2) ^ wc) << 2) | (n & 3));
            v4u o; o.x = pk2(sp[0 * 256], sp[1 * 256]); o.y = pk2(sp[2 * 256], sp[3 * 256]); o.z = pk2(sp[4 * 256], sp[5 * 256]); o.w = pk2(sp[6 * 256], sp[7 * 256]);
            *(GAS v4u*)(WT + (size_t)(row0 + n) * ldk + koff + k0 + 8 * wc) = o; }
        __syncthreads();
    }
}

__device__ __forceinline__ void p0_mod(Frame& F) {
    LAS float* condS = (LAS float*)F.lds;
    LAS float* red = (LAS float*)(F.lds + 65536);
    const float* c = F.in[I_C]; const float* w_ada = F.in[I_WADA]; const float* b_ada = F.in[I_BADA];
    float* mod = (float*)(F.ws + WS_MOD);
    const int tid = F.tid;
    for (int item = blockIdx.x; item < MODW / 48; item += F.G) {
        for (int i = tid; i < NBATCH * DM; i += NWAVES * 64) { const float v = c[i]; condS[i] = v / (1.0f + __expf(-v)); }
        __syncthreads();
        const int cq = tid % 12, kq = tid / 12, col0 = item * 48;
        if (kq < 32) {
            f32x4 acc[8];
#pragma unroll
            for (int b = 0; b < 8; ++b) acc[b] = (f32x4){0.f, 0.f, 0.f, 0.f};
            const float* wp = w_ada + (size_t)kq * MODW + col0 + cq * 4;
            for (int k = kq; k < DM; k += 256, wp += (size_t)256 * MODW) {
                f32x4 w[8];
#pragma unroll
                for (int u = 0; u < 8; ++u) w[u] = *(const f32x4*)(wp + (size_t)(32 * u) * MODW);
#pragma unroll
                for (int u = 0; u < 8; ++u)
#pragma unroll
                    for (int b = 0; b < 8; ++b) acc[b] += w[u] * condS[b * DM + k + 32 * u];
            }
#pragma unroll
            for (int b = 0; b < 8; ++b) *(LAS f32x4*)(red + (kq * 8 + b) * 48 + cq * 4) = acc[b];
        }
        __syncthreads();
        if (tid < 384) { const int b = tid / 48, col = tid % 48; float s = 0.f;
#pragma unroll 8
          for (int k2 = 0; k2 < 32; ++k2) s += red[(k2 * 8 + b) * 48 + col];
          mod[(size_t)b * MODW + col0 + col] = s + b_ada[col0 + col]; }
        __syncthreads();
    }
}

__device__ __forceinline__ void p0_filter(Frame& F) {
    LAS float* h2T = (LAS float*)F.lds;
    LAS float* scr = (LAS float*)(F.lds + 16384) + F.wave * 128;
    const float* w1 = F.in[I_HW1]; const float* b1 = F.in[I_HB1]; const float* w2 = F.in[I_HW2]; const float* b2 = F.in[I_HB2];
    const float* freq = F.in[I_HFREQ]; const float* w3 = F.in[I_HW3];
    float* FILT = (float*)(F.ws + WS_FILT);
    const int tid = F.tid, lane = F.lane, wave = F.wave;
    const float min_decay = -3.0701134573253943f, max_decay = -15.350567286626972f;
    for (int item = blockIdx.x; item < 256; item += F.G) {
        const int pb = item >> 3, cb = item & 7;
        const float fr = freq[lane], bb1 = b1[lane], bb2 = b2[lane];
        for (int pp = 0; pp < 8; ++pp) {
            const int pl = wave * 8 + pp, l = pb * 64 + pl;
            const float tl = (float)l / (float)(SEQ - 1), omega = 6.283185307179586f * (float)l / (float)SEQ;
            float f = 0.f;
            if (lane == 0) f = tl;
            else if (lane <= 16) { const float band = 1e-4f + (float)(lane - 1) * ((15.0f - 1e-4f) / 15.0f); f = cosf(band * omega); }
            else if (lane <= 32) { const float band = 1e-4f + (float)(lane - 17) * ((15.0f - 1e-4f) / 15.0f); f = -sinf(band * omega); }
            scr[lane] = f; LDS_WAIT(); asm volatile("" ::: "memory");
            float a = bb1;
            for (int i = 0; i < 33; ++i) a += scr[i] * w1[i * 64 + lane];
            scr[64 + lane] = sinf(fr * a); LDS_WAIT(); asm volatile("" ::: "memory");
            a = bb2;
            for (int i = 0; i < 64; ++i) a += scr[64 + i] * w2[i * 64 + lane];
            h2T[lane * 64 + pl] = sinf(fr * a); LDS_WAIT(); asm volatile("" ::: "memory");
        }
        __syncthreads();
        {
            const int cg = tid & 127, pg = tid >> 7, j0 = cb * 512 + cg * 4;
            f32x4 acc[16];
#pragma unroll
            for (int p = 0; p < 16; ++p) acc[p] = (f32x4){0.f, 0.f, 0.f, 0.f};
#pragma unroll 4
            for (int i = 0; i < 64; ++i) { const f32x4 w = *(const f32x4*)(w3 + (size_t)i * 4096 + j0);
#pragma unroll
                for (int p4 = 0; p4 < 4; ++p4) { const f32x4 hv = *(const LAS f32x4*)(h2T + i * 64 + pg * 16 + 4 * p4);
                    acc[4 * p4 + 0] += w * hv[0]; acc[4 * p4 + 1] += w * hv[1]; acc[4 * p4 + 2] += w * hv[2]; acc[4 * p4 + 3] += w * hv[3]; } }
            const int p0 = pb * 64 + pg * 16;
#pragma unroll
            for (int e = 0; e < 4; ++e) { const int j = j0 + e, ch = j & 1023; const float delta = fabsf(min_decay + (float)ch * ((max_decay - min_decay) / 1023.0f));
                float o[16];
#pragma unroll
                for (int p = 0; p < 16; ++p) { const float tp = (float)(p0 + p) / (float)(SEQ - 1); o[p] = acc[p][e] * expf(-tp * delta); }
                float* op = FILT + (size_t)j * SEQ + p0;
#pragma unroll
                for (int p4 = 0; p4 < 4; ++p4) *(f32x4*)(op + 4 * p4) = (f32x4){o[4 * p4], o[4 * p4 + 1], o[4 * p4 + 2], o[4 * p4 + 3]}; }
        }
        __syncthreads();
    }
}

__device__ __forceinline__ void p1_modulate(Frame& F) {
    const float* x = F.in[I_X]; const float* mod = (const float*)(F.ws + WS_MOD); bf16* H = (bf16*)(F.ws + WS_H);
    const size_t nvec = (size_t)MTOK * DM / 8, stride = (size_t)F.G * NWAVES * 64;
    for (size_t i = (size_t)blockIdx.x * (NWAVES * 64) + F.tid; i < nvec; i += stride) {
        const int row = (int)(i >> 8), col = (int)(i & 255) * 8, b = row >> 11;
        const f32x4 x0 = *(const f32x4*)(x + (size_t)row * DM + col), x1 = *(const f32x4*)(x + (size_t)row * DM + col + 4);
        const float* mp = mod + (size_t)b * MODW + col;
        const f32x4 sh0 = *(const f32x4*)mp, sh1 = *(const f32x4*)(mp + 4), sc0 = *(const f32x4*)(mp + DM), sc1 = *(const f32x4*)(mp + DM + 4);
        const f32x4 h0 = x0 * (sc0 + 1.0f) + sh0, h1 = x1 * (sc1 + 1.0f) + sh1;
        v4u o; o.x = pk2(h0[0], h0[1]); o.y = pk2(h0[2], h0[3]); o.z = pk2(h1[0], h1[1]); o.w = pk2(h1[2], h1[3]);
        *(v4u*)(H + (size_t)row * DM + col) = o;
    }
}

typedef short sg_bf16x8 __attribute__((ext_vector_type(8)));
typedef float sg_f32x16 __attribute__((ext_vector_type(16)));
constexpr int SG_VT = 0, SG_LD = 136, SG_ST = 36864;
__device__ __forceinline__ void p3_sgu(Frame& F) {
    LAS bf16* vnT = (LAS bf16*)(F.lds + SG_VT); LAS float* stS = (LAS float*)(F.lds + SG_ST);
    const bf16* U = (const bf16*)(F.ws + WS_U); const bf16* VT = (const bf16*)(F.ws + WS_V); bf16* AB = (bf16*)(F.ws + WS_H);
    const bf16* Wb = (const bf16*)(F.ws + WS_SGW); const float* stv = (const float*)(F.ws + WS_STV);
    const float* lng = F.in[I_SLNG]; const float* lnb = F.in[I_SLNB]; const float* sb = F.in[I_SB];
    const int tid = F.tid, lane = F.lane, w = F.wave, r = lane & 31, h = lane >> 5;
    for (int item = blockIdx.x; item < 1024; item += F.G) {
        const int b = item >> 7, n = (item >> 3) & 15, g = item & 7, tok0 = b * SEQ + n * 128;
        if (tid < 128) { float s = 0.f, q = 0.f; const float* sp = stv + (size_t)(tok0 + tid) * 32;
#pragma unroll
            for (int i = 0; i < 16; ++i) { const f32x2 pr = *(const f32x2*)(sp + 2 * i); s += pr.x; q += pr.y; }
            const float mean = s * (1.0f / 1024.0f); float var = q * (1.0f / 1024.0f) - mean * mean; var = var > 0.f ? var : 0.f;
            *(LAS f32x2*)(stS + 2 * tid) = (f32x2){mean, 1.0f / sqrtf(var + LN_EPS)}; }
        __syncthreads();
        { const int c = tid >> 2, pseg = (tid & 3) * 32, ch = g * 128 + c; const float gg = lng[ch], bb = lnb[ch];
          const bf16* vp = VT + (size_t)ch * MTOK + tok0 + pseg;
          v4u wv[4];
#pragma unroll
          for (int k = 0; k < 4; ++k) wv[k] = *(const v4u*)(vp + 8 * k);
#pragma unroll
          for (int k = 0; k < 4; ++k) {
              const float e[8] = {bflo(wv[k].x), bfhi(wv[k].x), bflo(wv[k].y), bfhi(wv[k].y), bflo(wv[k].z), bfhi(wv[k].z), bflo(wv[k].w), bfhi(wv[k].w)};
              float o[8];
#pragma unroll
              for (int i = 0; i < 8; i += 2) { const f32x4 st = *(const LAS f32x4*)(stS + 2 * (pseg + 8 * k + i));
                  o[i] = (e[i] - st[0]) * st[1] * gg + bb; o[i + 1] = (e[i + 1] - st[2]) * st[3] * gg + bb; }
              v4u pk; pk.x = pk2(o[0], o[1]); pk.y = pk2(o[2], o[3]); pk.z = pk2(o[4], o[5]); pk.w = pk2(o[6], o[7]);
              *(LAS v4u*)(vnT + c * SG_LD + pseg + 8 * k) = pk; } }
        const int q0 = 32 * (w >> 1), ct0 = 2 * (w & 1);
        sg_bf16x8 af[8];
#pragma unroll
        for (int kk = 0; kk < 8; ++kk) af[kk] = *(const sg_bf16x8*)(Wb + (size_t)(g * 128 + q0 + r) * 128 + 16 * kk + 8 * h);
        __syncthreads();
        sg_f32x16 acc[2];
#pragma unroll
        for (int ct = 0; ct < 2; ++ct)
#pragma unroll
            for (int i = 0; i < 16; ++i) acc[ct][i] = 0.f;
#pragma unroll
        for (int kk = 0; kk < 8; ++kk)
#pragma unroll
            for (int ct = 0; ct < 2; ++ct) {
                const sg_bf16x8 bf = *(const LAS sg_bf16x8*)(vnT + ((ct0 + ct) * 32 + r) * SG_LD + 16 * kk + 8 * h);
                acc[ct] = __builtin_amdgcn_mfma_f32_32x32x16_bf16(af[kk], bf, acc[ct], 0, 0, 0);
            }
#pragma unroll
        for (int ct = 0; ct < 2; ++ct) {
            const int c = (ct0 + ct) * 32 + r;
#pragma unroll
            for (int rg = 0; rg < 16; ++rg) {
                const int q = q0 + (rg & 3) + 8 * (rg >> 2) + 4 * h;
                const float uv = bf1(U[(size_t)(tok0 + q) * SGUW + g * 128 + c]);
                AB[(size_t)(tok0 + q) * DM + g * 128 + c] = (bf16)f2bf(uv * (acc[ct][rg] + sb[g * 128 + q]));
            }
        }
        __syncthreads();
    }
}

__device__ __forceinline__ float sconv(const bf16* ZHT, const float* cw, const float* cb, int ch, int b, int t) {
    const bf16* zp = ZHT + (size_t)ch * MTOK + b * SEQ;
    const float z0 = t > 0 ? bf1(zp[t - 1]) : 0.f, z1 = bf1(zp[t]), z2 = t < SEQ - 1 ? bf1(zp[t + 1]) : 0.f;
    return cw[ch] * z0 + cw[3072 + ch] * z1 + cw[6144 + ch] * z2 + cb[ch];
}
__device__ __forceinline__ void p3_hyena(Frame& F) {
    LAS float* Us = (LAS float*)F.lds;
    LAS float* KF = (LAS float*)(F.lds + 65536);
    const bf16* ZHT = (const bf16*)(F.ws + WS_ZHT); const float* FILT = (const float*)(F.ws + WS_FILT); bf16* AB = (bf16*)(F.ws + WS_H);
    const float* cw = F.in[I_HCW]; const float* cb = F.in[I_HCB]; const float* skip = F.in[I_HSKIP];
    const int tid = F.tid;
    for (int item = blockIdx.x; item < HYW; item += F.G) {
        const int c = item;
        for (int i = tid; i < NBATCH * SEQ; i += NWAVES * 64) { const int b = i >> 11, t = i & 2047; Us[t * 8 + b] = sconv(ZHT, cw, cb, c, b, t); }
        for (int n = 0; n < 2; ++n) {
            const float* hf = FILT + (size_t)((0 * 2 + n) * 1024 + c) * SEQ; const float* hb = FILT + (size_t)((1 * 2 + n) * 1024 + c) * SEQ;
            for (int i = tid; i < 4095; i += NWAVES * 64) { const int lag = i - 2047; KF[i] = lag > 0 ? hf[lag] : (lag == 0 ? hf[0] + hb[0] : hb[-lag]); }
            __syncthreads();
            f32x4 acc[4][2];
#pragma unroll
            for (int ti = 0; ti < 4; ++ti) { acc[ti][0] = (f32x4){0.f, 0.f, 0.f, 0.f}; acc[ti][1] = (f32x4){0.f, 0.f, 0.f, 0.f}; }
            const LAS float* kp = KF + tid + 2047;
            for (int s = 0; s < SEQ; ++s) {
                const f32x4 u0 = *(const LAS f32x4*)(Us + s * 8), u1 = *(const LAS f32x4*)(Us + s * 8 + 4);
#pragma unroll
                for (int ti = 0; ti < 4; ++ti) { const float kv = kp[512 * ti - s]; acc[ti][0] += u0 * kv; acc[ti][1] += u1 * kv; }
            }
            __syncthreads();
            const float sk = skip[n * 1024 + c];
#pragma unroll
            for (int ti = 0; ti < 4; ++ti) { const int t = tid + 512 * ti;
#pragma unroll
                for (int b = 0; b < 8; ++b) {
                    const float uv = Us[t * 8 + b], gate = sconv(ZHT, cw, cb, (n + 1) * 1024 + c, b, t);
                    const float y = gate * (acc[ti][b >> 2][b & 3] + sk * uv);
                    if (n == 0) Us[t * 8 + b] = y; else AB[(size_t)(b * SEQ + t) * DM + 1024 + c] = (bf16)f2bf(y);
                } }
            __syncthreads();
        }
    }
}

#ifndef HYFFT_HD
#define HYFFT_HD __device__ __forceinline__
#define HYFFT_LAS __attribute__((address_space(3)))
#endif
typedef float hy_c32 __attribute__((ext_vector_type(2)));
HYFFT_HD int hy_padi(int i) { return i + (i >> 3); }
HYFFT_HD int hy_rev(int x) { return ((x & 7) << 9) | (((x >> 3) & 7) << 6) | (((x >> 6) & 7) << 3) | ((x >> 9) & 7); }

template <bool INV> HYFFT_HD void hy_dft8(float (&re)[8], float (&im)[8]) {
    const float h = 0.70710678118654752f;
    float ar[4], ai[4], br[4], bi[4];
#pragma unroll
    for (int m = 0; m < 4; ++m) { ar[m] = re[m] + re[m + 4]; ai[m] = im[m] + im[m + 4]; br[m] = re[m] - re[m + 4]; bi[m] = im[m] - im[m + 4]; }
    { float x = br[1], y = bi[1]; if (!INV) { br[1] = h * (x + y); bi[1] = h * (y - x); } else { br[1] = h * (x - y); bi[1] = h * (y + x); } }
    { float x = br[2], y = bi[2]; if (!INV) { br[2] = y; bi[2] = -x; } else { br[2] = -y; bi[2] = x; } }
    { float x = br[3], y = bi[3]; if (!INV) { br[3] = h * (y - x); bi[3] = -h * (x + y); } else { br[3] = -h * (x + y); bi[3] = h * (x - y); } }
#pragma unroll
    for (int s = 0; s < 2; ++s) {
        float* cr = s ? br : ar; float* ci = s ? bi : ai;
        const float e0r = cr[0] + cr[2], e0i = ci[0] + ci[2], e1r = cr[0] - cr[2], e1i = ci[0] - ci[2];
        const float o0r = cr[1] + cr[3], o0i = ci[1] + ci[3]; const float dr = cr[1] - cr[3], di = ci[1] - ci[3];
        float o1r, o1i; if (!INV) { o1r = di; o1i = -dr; } else { o1r = -di; o1i = dr; }
        re[0 + s] = e0r + o0r; im[0 + s] = e0i + o0i;
        re[2 + s] = e1r + o1r; im[2 + s] = e1i + o1i;
        re[4 + s] = e0r - o0r; im[4 + s] = e0i - o0i;
        re[6 + s] = e1r - o1r; im[6 + s] = e1i - o1i;
    }
}
template <bool CONJ> HYFFT_HD void hy_twiddle(float (&re)[8], float (&im)[8], float wr, float wi) {
    if (CONJ) wi = -wi;
    const float w2r = wr * wr - wi * wi, w2i = 2.f * wr * wi;
    const float w3r = w2r * wr - w2i * wi, w3i = w2r * wi + w2i * wr;
    const float w4r = w2r * w2r - w2i * w2i, w4i = 2.f * w2r * w2i;
    const float w5r = w4r * wr - w4i * wi, w5i = w4r * wi + w4i * wr;
    const float w6r = w3r * w3r - w3i * w3i, w6i = 2.f * w3r * w3i;
    const float w7r = w4r * w3r - w4i * w3i, w7i = w4r * w3i + w4i * w3r;
    const float pr[8] = {1.f, wr, w2r, w3r, w4r, w5r, w6r, w7r}, pi[8] = {0.f, wi, w2i, w3i, w4i, w5i, w6i, w7i};
#pragma unroll
    for (int k = 1; k < 8; ++k) { const float x = re[k], y = im[k]; re[k] = x * pr[k] - y * pi[k]; im[k] = x * pi[k] + y * pr[k]; }
}
template <int L, class BP, class TP> HYFFT_HD void hy_fwd_store(BP buf, TP tw, int j, float (&re)[8], float (&im)[8]) {
    constexpr int S = L / 8; const int blk = j / S, q = j % S, base = blk * L + q;
    hy_dft8<false>(re, im);
    if (L > 8) { const hy_c32 w = tw[q * (4096 / L)]; hy_twiddle<false>(re, im, w.x, w.y); }
#pragma unroll
    for (int k = 0; k < 8; ++k) buf[hy_padi(base + k * S)] = (hy_c32){re[k], im[k]};
}
template <int L, class BP> HYFFT_HD void hy_load8(BP buf, int j, float (&re)[8], float (&im)[8]) {
    constexpr int S = L / 8; const int blk = j / S, q = j % S, base = blk * L + q;
#pragma unroll
    for (int k = 0; k < 8; ++k) { const hy_c32 v = buf[hy_padi(base + k * S)]; re[k] = v.x; im[k] = v.y; }
}
template <int L, class BP, class TP> HYFFT_HD void hy_fwd_stage(BP buf, TP tw, int j) { float re[8], im[8]; hy_load8<L>(buf, j, re, im); hy_fwd_store<L>(buf, tw, j, re, im); }
template <int L, class BP, class TP> HYFFT_HD void hy_inv_regs(BP buf, TP tw, int j, float (&re)[8], float (&im)[8]) {
    constexpr int S = L / 8; const int q = j % S;
    hy_load8<L>(buf, j, re, im);
    if (L > 8) { const hy_c32 w = tw[q * (4096 / L)]; hy_twiddle<true>(re, im, w.x, w.y); }
    hy_dft8<true>(re, im);
}
template <int L, class BP, class TP> HYFFT_HD void hy_inv_stage(BP buf, TP tw, int j) {
    constexpr int S = L / 8; const int blk = j / S, q = j % S, base = blk * L + q;
    float re[8], im[8]; hy_inv_regs<L>(buf, tw, j, re, im);
#pragma unroll
    for (int k = 0; k < 8; ++k) buf[hy_padi(base + k * S)] = (hy_c32){re[k], im[k]};
}
template <class BP, class KP> HYFFT_HD void hy_mid_stage(BP buf, KP K, int j) {
    float re[8], im[8]; hy_load8<8>(buf, j, re, im);
    hy_dft8<false>(re, im);
#pragma unroll
    for (int k = 0; k < 8; ++k) { const hy_c32 kv = K[hy_padi(8 * j + k)]; const float x = re[k], y = im[k]; re[k] = x * kv.x - y * kv.y; im[k] = x * kv.y + y * kv.x; }
    hy_dft8<true>(re, im);
#pragma unroll
    for (int k = 0; k < 8; ++k) buf[hy_padi(8 * j + k)] = (hy_c32){re[k], im[k]};
}
template <class BP> HYFFT_HD void hy_last_fwd(BP buf, int j) {
    float re[8], im[8]; hy_load8<8>(buf, j, re, im); hy_dft8<false>(re, im);
#pragma unroll
    for (int k = 0; k < 8; ++k) buf[hy_padi(8 * j + k)] = (hy_c32){re[k], im[k]};
}
template <class BP, class KP> HYFFT_HD void hy_separate(BP Z, KP K1, KP K2, int j) {
    const float sc = 0.5f / 4096.0f;
#pragma unroll
    for (int r = 0; r < 8; ++r) {
        const int p = j + 512 * r, f = hy_rev(p), g = (4096 - f) & 4095, p2 = hy_rev(g);
        const hy_c32 a = Z[hy_padi(p)], b = Z[hy_padi(p2)];
        K1[hy_padi(p)] = (hy_c32){(a.x + b.x) * sc, (a.y - b.y) * sc};
        K2[hy_padi(p)] = (hy_c32){(a.y + b.y) * sc, (b.x - a.x) * sc};
    }
}

constexpr int HY_BUF = 0, HY_K1 = 36864, HY_K2 = 73728, HY_TW = 110592;
struct Raw3 { bf16 a, b, c; };
__device__ __forceinline__ Raw3 raw3(const bf16* zp, int t) { Raw3 r; r.a = zp[t > 0 ? t - 1 : 0]; r.b = zp[t]; r.c = zp[t < SEQ - 1 ? t + 1 : SEQ - 1]; return r; }
__device__ __forceinline__ float sconv_raw(const Raw3& r, int t, float w0, float w1, float w2, float cb) {
    const float z0 = t > 0 ? bf1(r.a) : 0.f, z1 = bf1(r.b), z2 = t < SEQ - 1 ? bf1(r.c) : 0.f;
    return w0 * z0 + w1 * z1 + w2 * z2 + cb;
}
__device__ __forceinline__ void p3_hyena_fft(Frame& F) {
    LAS hy_c32* BUF = (LAS hy_c32*)(F.lds + HY_BUF); LAS hy_c32* K1 = (LAS hy_c32*)(F.lds + HY_K1); LAS hy_c32* K2 = (LAS hy_c32*)(F.lds + HY_K2);
    LAS hy_c32* TW = (LAS hy_c32*)(F.lds + HY_TW);
    const bf16* ZHT = (const bf16*)(F.ws + WS_ZHT); const float* FILT = (const float*)(F.ws + WS_FILT); bf16* YT = (bf16*)(F.ws + WS_YT);
    const float* cw = F.in[I_HCW]; const float* cb = F.in[I_HCB]; const float* skip = F.in[I_HSKIP];
    const int j = F.tid;
    { float sn, cs; sincosf(-6.283185307179586f * (float)j / 4096.0f, &sn, &cs); TW[j] = (hy_c32){cs, sn}; }
    __syncthreads();
    for (int item = blockIdx.x; item < HYW; item += F.G) {
        const int c = item;
        float re[8], im[8];
        const bf16* zv = ZHT + (size_t)c * MTOK; const bf16* za = ZHT + (size_t)(1024 + c) * MTOK; const bf16* zb = ZHT + (size_t)(2048 + c) * MTOK;
        Raw3 rv0[4], rv1[4];
#pragma unroll
        for (int m = 0; m < 4; ++m) { rv0[m] = raw3(zv, j + 512 * m); rv1[m] = raw3(zv + SEQ, j + 512 * m); }
        {
            const float* hf0 = FILT + (size_t)(0 * 1024 + c) * SEQ; const float* hf1 = FILT + (size_t)(1 * 1024 + c) * SEQ;
            const float* hb0 = FILT + (size_t)(2 * 1024 + c) * SEQ; const float* hb1 = FILT + (size_t)(3 * 1024 + c) * SEQ;
#pragma unroll
            for (int m = 0; m < 4; ++m) { const int i = j + 512 * m; re[m] = hf0[i]; im[m] = hf1[i]; }
            if (j == 0) { re[0] += hb0[0]; im[0] += hb1[0]; }
#pragma unroll
            for (int m = 4; m < 8; ++m) { const int i = j + 512 * m; const bool z = (i == 2048); const int r = z ? 0 : 4096 - i; const float a = hb0[r], b = hb1[r]; re[m] = z ? 0.f : a; im[m] = z ? 0.f : b; }
            hy_fwd_store<4096>(BUF, TW, j, re, im); __syncthreads();
            hy_fwd_stage<512>(BUF, TW, j); __syncthreads();
            hy_fwd_stage<64>(BUF, TW, j); __syncthreads();
            hy_last_fwd(BUF, j); __syncthreads();
            hy_separate(BUF, K1, K2, j); __syncthreads();
        }
        const float vw0 = cw[c], vw1 = cw[3072 + c], vw2 = cw[6144 + c], vcb = cb[c];
        const float aw0 = cw[1024 + c], aw1 = cw[3072 + 1024 + c], aw2 = cw[6144 + 1024 + c], acb = cb[1024 + c];
        const float bw0 = cw[2048 + c], bw1 = cw[3072 + 2048 + c], bw2 = cw[6144 + 2048 + c], bcb = cb[2048 + c];
        const float sk0 = skip[c], sk1 = skip[1024 + c];
#pragma unroll 1
        for (int p = 0; p < 4; ++p) {
            const int boff = (2 * p) * SEQ;
            Raw3 rg0[4], rg1[4];
#pragma unroll
            for (int m = 0; m < 4; ++m) { rg0[m] = raw3(za + boff, j + 512 * m); rg1[m] = raw3(za + boff + SEQ, j + 512 * m); }
            float v0[4], v1[4];
#pragma unroll
            for (int m = 0; m < 4; ++m) { const int t = j + 512 * m; v0[m] = sconv_raw(rv0[m], t, vw0, vw1, vw2, vcb); v1[m] = sconv_raw(rv1[m], t, vw0, vw1, vw2, vcb); }
#pragma unroll
            for (int m = 0; m < 4; ++m) { re[m] = v0[m]; im[m] = v1[m]; re[m + 4] = 0.f; im[m + 4] = 0.f; }
            hy_fwd_store<4096>(BUF, TW, j, re, im); __syncthreads();
            hy_fwd_stage<512>(BUF, TW, j); __syncthreads();
            hy_fwd_stage<64>(BUF, TW, j); __syncthreads();
            hy_mid_stage(BUF, K1, j); __syncthreads();
            hy_inv_stage<64>(BUF, TW, j); __syncthreads();
            hy_inv_stage<512>(BUF, TW, j); __syncthreads();
            hy_inv_regs<4096>(BUF, TW, j, re, im);
#pragma unroll
            for (int m = 0; m < 4; ++m) { const int t = j + 512 * m;
                v0[m] = sconv_raw(rg0[m], t, aw0, aw1, aw2, acb) * (re[m] + sk0 * v0[m]); v1[m] = sconv_raw(rg1[m], t, aw0, aw1, aw2, acb) * (im[m] + sk0 * v1[m]); }
#pragma unroll
            for (int m = 0; m < 4; ++m) { rg0[m] = raw3(zb + boff, j + 512 * m); rg1[m] = raw3(zb + boff + SEQ, j + 512 * m); }
            { const int nb = (p < 3 ? boff + 2 * SEQ : 0);
#pragma unroll
              for (int m = 0; m < 4; ++m) { rv0[m] = raw3(zv + nb, j + 512 * m); rv1[m] = raw3(zv + nb + SEQ, j + 512 * m); } }
#pragma unroll
            for (int m = 0; m < 4; ++m) { re[m] = v0[m]; im[m] = v1[m]; re[m + 4] = 0.f; im[m + 4] = 0.f; }
            hy_fwd_store<4096>(BUF, TW, j, re, im); __syncthreads();
            hy_fwd_stage<512>(BUF, TW, j); __syncthreads();
            hy_fwd_stage<64>(BUF, TW, j); __syncthreads();
            hy_mid_stage(BUF, K2, j); __syncthreads();
            hy_inv_stage<64>(BUF, TW, j); __syncthreads();
            hy_inv_stage<512>(BUF, TW, j); __syncthreads();
            hy_inv_regs<4096>(BUF, TW, j, re, im);
#pragma unroll
            for (int m = 0; m < 4; ++m) { const int t = j + 512 * m;
                const float y0 = sconv_raw(rg0[m], t, bw0, bw1, bw2, bcb) * (re[m] + sk1 * v0[m]), y1 = sconv_raw(rg1[m], t, bw0, bw1, bw2, bcb) * (im[m] + sk1 * v1[m]);
                YT[(size_t)c * MTOK + boff + t] = (bf16)f2bf(y0); YT[(size_t)c * MTOK + boff + SEQ + t] = (bf16)f2bf(y1); }
        }
        __syncthreads();
    }
}

__device__ __forceinline__ void p3c_transpose(Frame& F) {
    constexpr int LD = 264;
    LAS bf16* tile = (LAS bf16*)F.lds;
    const bf16* YT = (const bf16*)(F.ws + WS_YT); bf16* AB = (bf16*)(F.ws + WS_H);
    const int tid = F.tid;
    for (int it = blockIdx.x; it < 16 * 64; it += F.G) {
        const int c0 = (it >> 6) * 64, t0 = (it & 63) * 256;
        { const int c = tid >> 3, ts = (tid & 7) * 32; const bf16* src = YT + (size_t)(c0 + c) * MTOK + t0 + ts;
          v4u w[4];
#pragma unroll
          for (int k = 0; k < 4; ++k) w[k] = *(const v4u*)(src + 8 * k);
#pragma unroll
          for (int k = 0; k < 4; ++k) *(LAS v4u*)(tile + c * LD + ts + 8 * k) = w[k]; }
        __syncthreads();
        { const int t = tid >> 1, cs = (tid & 1) * 32; unsigned o[16];
#pragma unroll
          for (int i = 0; i < 16; ++i) o[i] = (unsigned)tile[(cs + 2 * i) * LD + t] | ((unsigned)tile[(cs + 2 * i + 1) * LD + t] << 16);
          bf16* dst = AB + (size_t)(t0 + t) * DM + 1024 + c0 + cs;
#pragma unroll
          for (int k = 0; k < 4; ++k) *(v4u*)(dst + 8 * k) = (v4u){o[4 * k], o[4 * k + 1], o[4 * k + 2], o[4 * k + 3]}; }
        __syncthreads();
    }
}

template <bool FINAL> __device__ __forceinline__ void ln_rows(Frame& F) {
    float* R = F.out; const float* st = (const float*)(F.ws + (FINAL ? WS_ST2 : WS_ST1)); float* MU = (float*)(F.ws + WS_MU1);
    const float* mod = (const float*)(F.ws + WS_MOD); bf16* H2 = (bf16*)(F.ws + WS_H);
    const float* lng = F.in[FINAL ? I_LN2G : I_LN1G]; const float* lnb = F.in[FINAL ? I_LN2B : I_LN1B];
    const int gw = blockIdx.x * NWAVES + F.wave, NGW = F.G * NWAVES, lane = F.lane;
    for (int row = gw; row < MTOK; row += NGW) {
        float s = 0.f, q = 0.f; if (lane < 32) { const f32x2 p = *(const f32x2*)(st + ((size_t)row * 32 + lane) * 2); s = p.x; q = p.y; }
        s = wave_sum(s); q = wave_sum(q);
        const float mean = s * (1.0f / DM); float var = q * (1.0f / DM) - mean * mean; var = var > 0.f ? var : 0.f; const float rstd = 1.0f / sqrtf(var + LN_EPS);
        if (!FINAL && lane == 0) *(f32x2*)(MU + (size_t)row * 2) = (f32x2){mean, rstd};
        const int b = row >> 11; float* rp = R + (size_t)row * DM;
#pragma unroll
        for (int j = 0; j < 8; ++j) { const int col = 4 * lane + 256 * j;
            const f32x4 v = *(const f32x4*)(rp + col); const f32x4 y = (v - mean) * rstd * *(const f32x4*)(lng + col) + *(const f32x4*)(lnb + col);
            if (FINAL) *(f32x4*)(rp + col) = y;
            else { const float* mp = mod + (size_t)b * MODW + col; const f32x4 h = y * (*(const f32x4*)(mp + 4 * DM) + 1.0f) + *(const f32x4*)(mp + 3 * DM);
                   v2u o; o.x = pk2(h[0], h[1]); o.y = pk2(h[2], h[3]); *(v2u*)(H2 + (size_t)row * DM + col) = o; } }
    }
}

typedef GAS unsigned gu32;
#define RLX_AGENT __ATOMIC_RELAXED, __HIP_MEMORY_SCOPE_AGENT
constexpr int LDSCTL_OFF = 131072, MISC_OFF = LDSCTL_OFF + 320;
constexpr int CW_BAR = 4096;
constexpr size_t CTL_ZERO_BYTES = 65536;
#define XB_TMO      128
#define XB_XCNT(j)  (256  + 64 * (j))
#define XB_XSUB(j)  (1280 + 64 * (j))
#define XB_XGEN(j)  (2304 + 64 * (j))
#define XB_TOP      3328
#define XB_TOPGEN   3392
#define XCD_BAR_WORDS 3456
#define XB_SPIN_CAP (1u << 18)

__device__ __forceinline__ unsigned xb_ld(unsigned* p)              { return __hip_atomic_load(p, __ATOMIC_RELAXED, __HIP_MEMORY_SCOPE_AGENT); }
__device__ __forceinline__ unsigned xb_add(unsigned* p, unsigned v) { return __hip_atomic_fetch_add(p, v, __ATOMIC_RELAXED, __HIP_MEMORY_SCOPE_AGENT); }
__device__ __forceinline__ unsigned xb_xcc_id() { return (unsigned)__builtin_amdgcn_s_getreg((3 << 11) | 20) & 0xFu; }
#define XB_SPIN(cond, bar) do { unsigned _sp = 0; while (cond) { __builtin_amdgcn_s_sleep(1); \
    if ((++_sp & 255u) == 0u) { if (xb_ld(&(bar)[XB_TMO])) break; if (_sp > XB_SPIN_CAP) { atomicAdd(&(bar)[XB_TMO], 1u); break; } } } } while (0)

struct XcdBarrier {
    unsigned* bar; unsigned x;
    volatile LAS unsigned* st;
};

__device__ __forceinline__ XcdBarrier xcd_barrier_post(unsigned* bar, volatile LAS unsigned* st) {
    XcdBarrier b; b.bar = bar; b.x = xb_xcc_id(); b.st = st;
    if (threadIdx.x == 0) (void)xb_add(&bar[XB_XCNT(b.x)], 1u);
    return b;
}
__device__ __forceinline__ void xcd_barrier_complete(unsigned* bar, unsigned x, unsigned& nloc, unsigned& nx) {
    const unsigned G = gridDim.x * gridDim.y * gridDim.z;
    unsigned sum, cnt, mine, sp = 0u;
    for (;;) {
        sum = 0u; cnt = 0u; mine = 0u;
#pragma unroll
        for (unsigned j = 0; j < 16; ++j) { const unsigned c = xb_ld(&bar[XB_XCNT(j)]); sum += c; cnt += (c > 0u) ? 1u : 0u; mine = (j == x) ? c : mine; }
        if (sum == G) break;
        __builtin_amdgcn_s_sleep(1);
        if ((++sp & 255u) == 0u) { if (xb_ld(&bar[XB_TMO])) break; if (sp > XB_SPIN_CAP) { atomicAdd(&bar[XB_TMO], 1u); break; } }
    }
    nloc = mine > 0u ? mine : 1u; nx = cnt > 0u ? cnt : 1u;
}

__device__ __forceinline__ void xcd_barrier(const XcdBarrier& b) {
    asm volatile("s_waitcnt vmcnt(0)" ::: "memory");
    __syncthreads();
    if (threadIdx.x == 0) {
        unsigned* bar = b.bar;
        __builtin_amdgcn_s_waitcnt(0);
        unsigned nloc = b.st[0], nx = b.st[1];
        if (nloc == 0u) { xcd_barrier_complete(bar, b.x, nloc, nx); b.st[0] = nloc; b.st[1] = nx; }
        const unsigned old = xb_add(&bar[XB_XSUB(b.x)], 1u);
        const unsigned gen = old / nloc;
        if (old + 1u == (gen + 1u) * nloc) {
            __builtin_amdgcn_fence(__ATOMIC_RELEASE, "agent");
            asm volatile("s_waitcnt vmcnt(0)" ::: "memory");
            const unsigned og = xb_add(&bar[XB_TOP], 1u);
            const unsigned tg = og / nx;
            if (og + 1u == (tg + 1u) * nx) xb_add(&bar[XB_TOPGEN], 1u);
            else XB_SPIN(xb_ld(&bar[XB_TOPGEN]) == tg, bar);
            __builtin_amdgcn_fence(__ATOMIC_ACQUIRE, "agent");
            xb_add(&bar[XB_XGEN(b.x)], 1u);
            asm volatile("s_waitcnt vmcnt(0)" ::: "memory");
        } else {
            XB_SPIN(xb_ld(&bar[XB_XGEN(b.x)]) == gen, bar);
            __builtin_amdgcn_fence(__ATOMIC_ACQUIRE, "agent");
            asm volatile("s_waitcnt vmcnt(0)" ::: "memory");
        }
    }
    __syncthreads();
}

#define GRID_SYNC() xcd_barrier(bar)

__global__ void __launch_bounds__(NWAVES * 64, 2) fwd_megakernel(Args args) {
    extern __shared__ __attribute__((aligned(16))) unsigned char lds[];
    Frame F;
    F.lds = (LAS unsigned char*)lds;
    F.tid = threadIdx.x; F.lane = F.tid & 63; F.wave = __builtin_amdgcn_readfirstlane(F.tid >> 6); F.G = gridDim.x;
    F.in = args.in; F.out = args.out; F.ws = args.ws;
    for (int u = F.tid; u < (LDS_BYTES - LDSCTL_OFF) / 4; u += NWAVES * 64) ((LAS unsigned*)(F.lds + LDSCTL_OFF))[u] = 0u;
    __syncthreads();
    XcdBarrier bar = xcd_barrier_post((unsigned*)(args.ws + WS_CTL) + CW_BAR, (volatile LAS unsigned*)(F.lds + MISC_OFF) + 8);
    unsigned char* ws = args.ws;
    const int lo = args.ph_lo, hi = args.ph_hi;
#define IN(k) (lo <= (k) && (k) < hi)
#define BOTH(k) (IN(k) && IN((k) + 1))
    const int gw = blockIdx.x * NWAVES + F.wave, NGW = F.G * NWAVES;

    if (IN(0)) {
        p0_mod(F);
        transpose_matrix(F, F.in[I_WIN], DM, INW, (bf16*)(ws + WS_WIN), DM, 0, 1, (int)blockIdx.x, F.G);
        transpose_matrix(F, F.in[I_WA], SGUW, DM, (bf16*)(ws + WS_WAB), DM, 0, 0, (int)((blockIdx.x + 128) % F.G), F.G);
        transpose_matrix(F, F.in[I_WB], HYW, DM, (bf16*)(ws + WS_WAB), DM, 1024, 0, (int)blockIdx.x, F.G);
        transpose_matrix(F, F.in[I_WO], DM, DM, (bf16*)(ws + WS_WO), DM, 0, 0, (int)blockIdx.x, F.G);
        { const float* sw = F.in[I_SW]; bf16* sgw = (bf16*)(ws + WS_SGW);
          for (int i = blockIdx.x * (NWAVES * 64) + F.tid; i < 8 * 128 * 128 / 2; i += F.G * NWAVES * 64) { const f32x2 v = *(const f32x2*)(sw + 2 * i); *(unsigned*)(sgw + 2 * i) = pk2(v.x, v.y); } }
        __syncthreads();
        p0_filter(F);
        if (BOTH(0)) GRID_SYNC();
    }
    if (IN(1)) { p1_modulate(F); if (BOTH(1)) GRID_SYNC(); }
    if (IN(2)) {
        { pg8::Gemm g{(const pg8::bf16_t*)(ws + WS_H), (const pg8::bf16_t*)(ws + WS_WIN), MTOK, 5120, DM}; pg8::StaticOrder S; S.init(MTOK, 5120, F.G, (int)blockIdx.x);
          pg8::EpiG1 E{(pg8::bf16_t*)(ws + WS_U), (pg8::bf16_t*)(ws + WS_G), F.in[I_BIN]};
          pg8::gemm_phase<pg8::EpiG1, pg8::StaticOrder, true, true>(F.lds, g, S, E); }
        __syncthreads();
        { pg8::Gemm g{(const pg8::bf16_t*)(ws + WS_WIN) + (size_t)5120 * DM, (const pg8::bf16_t*)(ws + WS_H), 4096, MTOK, DM}; pg8::StaticOrder S; S.init(4096, MTOK, F.G, (int)blockIdx.x);
          pg8::EpiG1T E{(pg8::bf16_t*)(ws + WS_V), (pg8::bf16_t*)(ws + WS_ZHT), F.in[I_BIN], (float*)(ws + WS_STV)};
          pg8::gemm_phase<pg8::EpiG1T, pg8::StaticOrder, true, true>(F.lds, g, S, E); }
        if (BOTH(2)) GRID_SYNC();
    }
    if (IN(3)) { __syncthreads(); p3_sgu(F); p3_hyena_fft(F); if (BOTH(3)) GRID_SYNC(); p3c_transpose(F); GRID_SYNC(); }
    if (IN(4)) {
        pg8::Gemm g{(const pg8::bf16_t*)(ws + WS_H), (const pg8::bf16_t*)(ws + WS_WAB), MTOK, DM, DM}; pg8::StaticOrder S; S.init(MTOK, DM, F.G, (int)blockIdx.x);
        pg8::EpiG2 E{(const pg8::bf16_t*)(ws + WS_G), (pg8::bf16_t*)(ws + WS_MERGED)};
        pg8::gemm_phase<pg8::EpiG2, pg8::StaticOrder, true, true>(F.lds, g, S, E);
        if (BOTH(4)) GRID_SYNC();
    }
    if (IN(5)) {
        pg8::Gemm g{(const pg8::bf16_t*)(ws + WS_MERGED), (const pg8::bf16_t*)(ws + WS_WO), MTOK, DM, DM}; pg8::StaticOrder S; S.init(MTOK, DM, F.G, (int)blockIdx.x);
        pg8::EpiRes<true> E{F.in[I_X], F.out, (const float*)(ws + WS_MOD) + 2 * DM, F.in[I_BO], nullptr, nullptr, nullptr, (float*)(ws + WS_ST1)};
        pg8::gemm_phase<pg8::EpiRes<true>, pg8::StaticOrder, true, true>(F.lds, g, S, E);
        if (BOTH(5)) GRID_SYNC();
    }
    if (IN(6)) {
        __syncthreads();
        ln_rows<false>(F);
        __syncthreads();
        transpose_matrix(F, F.in[I_WM1], DM, DFF, (bf16*)(ws + WS_WM1), DM, 0, 0, (int)blockIdx.x, F.G);
        transpose_matrix(F, F.in[I_WM2], DFF, DM, (bf16*)(ws + WS_WM2), DFF, 0, 0, (int)blockIdx.x, F.G);
        if (BOTH(6)) GRID_SYNC();
    }
    if (IN(7)) {
        __syncthreads();
        pg8::Gemm g{(const pg8::bf16_t*)(ws + WS_H), (const pg8::bf16_t*)(ws + WS_WM1), MTOK, DFF, DM}; pg8::StaticOrder S; S.init(MTOK, DFF, F.G, (int)blockIdx.x);
        pg8::EpiG4 E{(pg8::bf16_t*)(ws + WS_AFF), F.in[I_BM1]};
        pg8::gemm_phase<pg8::EpiG4, pg8::StaticOrder, true, true>(F.lds, g, S, E);
        if (BOTH(7)) GRID_SYNC();
    }
    if (IN(8)) {
        pg8::Gemm g{(const pg8::bf16_t*)(ws + WS_AFF), (const pg8::bf16_t*)(ws + WS_WM2), MTOK, DM, DFF}; pg8::StaticOrder S; S.init(MTOK, DM, F.G, (int)blockIdx.x);
        pg8::EpiRes<false> E{nullptr, F.out, (const float*)(ws + WS_MOD) + 5 * DM, F.in[I_BM2], F.in[I_LN1G], F.in[I_LN1B], (const float*)(ws + WS_MU1), (float*)(ws + WS_ST2)};
        pg8::gemm_phase<pg8::EpiRes<false>, pg8::StaticOrder, true, true>(F.lds, g, S, E);
        if (BOTH(8)) GRID_SYNC();
    }
    if (IN(9)) { ln_rows<true>(F); }
#undef IN
#undef BOTH
}

constexpr int N_PHASES = 10;
#ifndef MK_N_LAUNCHES
#define MK_N_LAUNCHES 1
#endif
extern "C" void kernel_launch(void* const* d_in, const int* in_sizes, int n_in, void* d_out, int out_size, void* d_ws, size_t ws_size, hipStream_t stream) {
    static int grid = 0;
    if (grid == 0) {
        if (n_in != 31 || in_sizes[0] != MTOK * DM || out_size != MTOK * DM || ws_size < WS_END) {
            fprintf(stderr, "kernel_launch: unexpected problem: n_in %d in0 %d out %d ws %zu (need %zu)\n", n_in, n_in > 0 ? in_sizes[0] : -1, out_size, ws_size, (size_t)WS_END); grid = -1; return; }
        int dev = 0, cus = 0, per_cu = 0;
        if (hipGetDevice(&dev) != hipSuccess || hipDeviceGetAttribute(&cus, hipDeviceAttributeMultiprocessorCount, dev) != hipSuccess) { grid = -1; return; }
        if (hipFuncSetAttribute((const void*)fwd_megakernel, hipFuncAttributeMaxDynamicSharedMemorySize, LDS_BYTES) != hipSuccess) { fprintf(stderr, "kernel_launch: hipFuncSetAttribute failed\n"); grid = -1; return; }
        if (hipOccupancyMaxActiveBlocksPerMultiprocessor(&per_cu, (const void*)fwd_megakernel, NWAVES * 64, LDS_BYTES) != hipSuccess || per_cu < 1) { fprintf(stderr, "kernel_launch: occupancy query says %d\n", per_cu); per_cu = 1; }
        (void)hipGetLastError();
        grid = cus;
    }
    if (grid < 0) return;
    if (hipMemsetAsync((char*)d_ws + WS_CTL, 0, CTL_ZERO_BYTES, stream) != hipSuccess) { fprintf(stderr, "kernel_launch: memset failed\n"); return; }
    Args a{};
    for (int i = 0; i < 31; ++i) a.in[i] = (const float*)d_in[i];
    a.out = (float*)d_out; a.ws = (unsigned char*)d_ws;
    if (MK_N_LAUNCHES == 1) {
        a.ph_lo = 0; a.ph_hi = N_PHASES;
        void* kargs[] = {&a};
        hipError_t e = hipLaunchCooperativeKernel((const void*)fwd_megakernel, dim3(grid), dim3(NWAVES * 64), kargs, LDS_BYTES, stream);
        if (e != hipSuccess) fprintf(stderr, "kernel_launch: cooperative launch failed: %s (grid %d)\n", hipGetErrorString(e), grid);
    } else {
        for (int p = 0; p < N_PHASES; ++p) { a.ph_lo = p; a.ph_hi = p + 1; hipLaunchKernelGGL(fwd_megakernel, dim3(grid), dim3(NWAVES * 64), LDS_BYTES, stream, a); }
    }
}
```

```cpp
#include <hip/hip_runtime.h>
#include <cstdio>
#include <cstdint>

#ifndef PROBE_ID
#define PROBE_ID 0
#endif
#define PB_LDS_OFF (163840 - 512 + 128)
#define PB_START(id, ldsp) do { if (PROBE_ID == (id) && blockIdx.x == 0 && threadIdx.x == 0) { *(volatile __attribute__((address_space(3))) unsigned long long*)((ldsp) + PB_LDS_OFF + 8) = __builtin_amdgcn_s_memrealtime(); } } while (0)
#define PB_END(id, ldsp) do { if (PROBE_ID == (id) && blockIdx.x == 0 && threadIdx.x == 0) { volatile __attribute__((address_space(3))) unsigned long long* pb_ = (volatile __attribute__((address_space(3))) unsigned long long*)((ldsp) + PB_LDS_OFF); pb_[0] += __builtin_amdgcn_s_memrealtime() - pb_[1]; } } while (0)
namespace pg8 {
#define PG8_LAS __attribute__((address_space(3)))
typedef unsigned short bf16_t;
typedef short bf16x8 __attribute__((ext_vector_type(8)));
typedef float f32x4 __attribute__((ext_vector_type(4)));
typedef unsigned u32x4 __attribute__((ext_vector_type(4)));
typedef float f32x2 __attribute__((ext_vector_type(2)));
constexpr int EPI_LDS_OFF = 131072;
constexpr int BM = 256, BK = 64, HALF = 128, HTB = HALF * BK * 2  , STAGE_BYTES = 8 * HTB, NXCD = 8, WGM = 8;

__host__ __device__ __forceinline__ int lds_byte(int r, int c) { const int st = (r >> 4) * 2 + (c >> 5), rr = r & 15, cc = c & 31, ob = rr * 64 + cc * 2; return st * 1024 + (ob ^ (((ob >> 9) & 1) << 5)); }
__host__ __device__ __forceinline__ void stage_rc(int b, int& R, int& C) { const int st = b / 1024, sb = b % 1024, swz = sb ^ (((sb >> 9) & 1) << 5); R = (st >> 1) * 16 + swz / 64; C = (st & 1) * 32 + (swz % 64) / 2; }
__host__ __device__ __forceinline__ int perm32(int rho) { const int n = rho >> 4, i = rho & 15; return 8 * (i >> 2) + 4 * n + (i & 3); }

struct Unit { int pm, pn; };
struct Gemm { const bf16_t* A; const bf16_t* Bt; int M, N, K; };

struct StaticOrder {
    int nM, nN, nwg, G, c;
    __host__ __device__ void init(int M, int N, int G_, int c_) { nM = M / BM; nN = N / BM; nwg = nM * nN; G = G_; c = c_; }
    __host__ __device__ bool next(int i, Unit& u) const {
        const long L = (long)i * G + c; if (L >= nwg) return false;
        int wgid = (int)L; { const int q = nwg / NXCD, r = nwg % NXCD, xcd = wgid % NXCD, off = wgid / NXCD; wgid = (xcd < r ? xcd * (q + 1) : r * (q + 1) + (xcd - r) * q) + off; }
        const int nig = WGM * nN, gid = wgid / nig, fm = gid * WGM, gsz = (nM - fm) < WGM ? (nM - fm) : WGM;
        u.pm = fm + ((wgid % nig) % gsz); u.pn = (wgid % nig) / gsz; return true;
    }
    __device__ __forceinline__ void a_ready(const Unit&) const {}
    __device__ __forceinline__ void done(const Unit&) const {}
};

__device__ __forceinline__ unsigned cvt_pk_bf16(float lo, float hi) { unsigned r; asm volatile("v_cvt_pk_bf16_f32 %0, %1, %2" : "=v"(r) : "v"(lo), "v"(hi)); return r; }
__device__ __forceinline__ f32x2 gelu_pk(f32x2 v) {
    const f32x2 av = __builtin_elementwise_abs(v), d = av * 0.2316418882f + 1.0f;
    f32x2 t; t.x = __builtin_amdgcn_rcpf(d.x); t.y = __builtin_amdgcn_rcpf(d.y);
    f32x2 q = t * 0.5307027145f + (-0.7265760135f); q = q * t + 0.7107068705f; q = q * t + (-0.142248368f); q = q * t + 0.127414796f; q = q * t;
    const f32x2 s = (v * v) * (-0.72134752044f);
    f32x2 e; e.x = __builtin_amdgcn_exp2f(s.x); e.y = __builtin_amdgcn_exp2f(s.y);
    const f32x2 m = v * (q * e), r = v - m;
    f32x2 o; o.x = v.x < 0.f ? m.x : r.x; o.y = v.y < 0.f ? m.y : r.y; return o;
}
__device__ __forceinline__ float bf_lo(unsigned w) { return __uint_as_float(w << 16); }
__device__ __forceinline__ float bf_hi(unsigned w) { return __uint_as_float(w & 0xffff0000u); }
__device__ __forceinline__ float sigmoid_f(float x) { return __builtin_amdgcn_rcpf(1.0f + __expf(-x)); }
}

constexpr int DM = 2048, NBATCH = 8, SEQ = 2048, MTOK = NBATCH * SEQ;
constexpr int SGUW = 1024, HYW = 1024, DFF = 8192, INW = 9216, MODW = 6 * DM;
constexpr float LN_EPS = 1e-5f;
constexpr float DN_ALPHA = 1.189207115002721f;

namespace pg8 {

struct EpiG1 {
    static constexpr bool PERM = true, AFTER_DRAIN = false, MID = false; static constexpr int SLOT_FLOATS = 256;
    bf16_t* U; bf16_t* G; const float* b_in;
    __device__ __forceinline__ void mid(f32x4 (&)[2][2][4][2], const Unit&, int, int, int, int) const {}
    __device__ __forceinline__ void preload(PG8_LAS float* slot, const Unit& u, int tid) const { if (tid < 256) slot[tid] = b_in[(u.pn < 4 ? u.pn * 256 : 5120 + (u.pn - 4) * 256) + tid]; }
    __device__ __forceinline__ void operator()(const f32x4 (&acc)[2][2][4][2], const Unit& u, int wr, int wc, int fr, int fq, const PG8_LAS float* slot) const {
        const int row0 = u.pm * BM + wr * 64 + fr; const int pn = u.pn;
        int ldc, colt; bf16_t* base; const bool isu = pn < 4;
        if (isu) { base = U; ldc = SGUW; colt = pn * 256; }
        else { base = G; ldc = 2 * DM; colt = (pn - 4) * 256; }
        const int cl = wc * 32 + 8 * fq;
        f32x4 bv[2][2];
#pragma unroll
        for (int bj = 0; bj < 2; ++bj)
#pragma unroll
            for (int n = 0; n < 2; ++n) bv[bj][n] = *(const PG8_LAS f32x4*)(slot + cl + bj * HALF + 4 * n);
#pragma unroll
        for (int ai = 0; ai < 2; ++ai)
#pragma unroll
            for (int m = 0; m < 4; ++m) {
                const int row = row0 + ai * HALF + m * 16;
                bf16_t* rowp = base + (size_t)row * ldc + colt + cl;
#pragma unroll
                for (int bj = 0; bj < 2; ++bj) {
                    f32x4 v0 = acc[ai][bj][m][0] + bv[bj][0], v1 = acc[ai][bj][m][1] + bv[bj][1];
                    if (isu) {
                        f32x2 a = gelu_pk((f32x2){v0[0], v0[1]}), b = gelu_pk((f32x2){v0[2], v0[3]}), c = gelu_pk((f32x2){v1[0], v1[1]}), d = gelu_pk((f32x2){v1[2], v1[3]});
                        v0 = (f32x4){a.x, a.y, b.x, b.y}; v1 = (f32x4){c.x, c.y, d.x, d.y};
                    } else {
                        v0 = (f32x4){sigmoid_f(v0[0]), sigmoid_f(v0[1]), sigmoid_f(v0[2]), sigmoid_f(v0[3])};
                        v1 = (f32x4){sigmoid_f(v1[0]), sigmoid_f(v1[1]), sigmoid_f(v1[2]), sigmoid_f(v1[3])};
                    }
                    u32x4 w; w.x = cvt_pk_bf16(v0[0], v0[1]); w.y = cvt_pk_bf16(v0[2], v0[3]); w.z = cvt_pk_bf16(v1[0], v1[1]); w.w = cvt_pk_bf16(v1[2], v1[3]);
                    *(u32x4*)(rowp + bj * HALF) = w;
                }
            }
    }
};

struct EpiG1T {
    static constexpr bool PERM = true, AFTER_DRAIN = false, MID = false;
    bf16_t* VT; bf16_t* ZHT; const float* b_in; float* statsV; static constexpr int SLOT_FLOATS = 256;
    __device__ __forceinline__ void mid(f32x4 (&)[2][2][4][2], const Unit&, int, int, int, int) const {}
    __device__ __forceinline__ void preload(PG8_LAS float* slot, const Unit& u, int tid) const { if (tid < 256) slot[tid] = b_in[1024 + u.pm * 256 + tid]; }
    __device__ __forceinline__ void operator()(const f32x4 (&acc)[2][2][4][2], const Unit& u, int wr, int wc, int fr, int fq, const PG8_LAS float* slot) const {
        const int col0 = u.pn * BM + wc * 32 + 8 * fq; const bool isv = u.pm < 4;
        const int rowt = (isv ? u.pm : u.pm - 4) * BM + wr * 64 + fr;
        bf16_t* base = isv ? VT : ZHT;
#pragma unroll
        for (int ai = 0; ai < 2; ++ai) {
            float s[2][8], q[2][8];
#pragma unroll
            for (int bj = 0; bj < 2; ++bj)
#pragma unroll
                for (int e = 0; e < 8; ++e) { s[bj][e] = 0.f; q[bj][e] = 0.f; }
#pragma unroll
            for (int m = 0; m < 4; ++m) {
                const int row = rowt + ai * HALF + m * 16; const float bb = slot[wr * 64 + fr + ai * HALF + m * 16];
                bf16_t* rowp = base + (size_t)row * MTOK + col0;
#pragma unroll
                for (int bj = 0; bj < 2; ++bj) {
                    f32x4 v0 = acc[ai][bj][m][0] + bb, v1 = acc[ai][bj][m][1] + bb;
                    if (isv) {
                        f32x2 a = gelu_pk((f32x2){v0[0], v0[1]}), b = gelu_pk((f32x2){v0[2], v0[3]}), c = gelu_pk((f32x2){v1[0], v1[1]}), d = gelu_pk((f32x2){v1[2], v1[3]});
                        v0 = (f32x4){a.x, a.y, b.x, b.y}; v1 = (f32x4){c.x, c.y, d.x, d.y};
                    }
                    u32x4 w; w.x = cvt_pk_bf16(v0[0], v0[1]); w.y = cvt_pk_bf16(v0[2], v0[3]); w.z = cvt_pk_bf16(v1[0], v1[1]); w.w = cvt_pk_bf16(v1[2], v1[3]);
                    *(u32x4*)(rowp + bj * HALF) = w;
                    if (isv) {
                        const float e0 = bf_lo(w.x), e1 = bf_hi(w.x), e2 = bf_lo(w.y), e3 = bf_hi(w.y), e4 = bf_lo(w.z), e5 = bf_hi(w.z), e6 = bf_lo(w.w), e7 = bf_hi(w.w);
                        s[bj][0] += e0; s[bj][1] += e1; s[bj][2] += e2; s[bj][3] += e3; s[bj][4] += e4; s[bj][5] += e5; s[bj][6] += e6; s[bj][7] += e7;
                        q[bj][0] += e0 * e0; q[bj][1] += e1 * e1; q[bj][2] += e2 * e2; q[bj][3] += e3 * e3; q[bj][4] += e4 * e4; q[bj][5] += e5 * e5; q[bj][6] += e6 * e6; q[bj][7] += e7 * e7;
                    }
                }
            }
            if (isv) {
                const int slot = u.pm * 4 + ai * 2 + wr;
#pragma unroll
                for (int bj = 0; bj < 2; ++bj)
#pragma unroll
                    for (int e = 0; e < 8; ++e) {
                        float a = s[bj][e], b = q[bj][e];
                        a += __shfl_xor(a, 1); b += __shfl_xor(b, 1); a += __shfl_xor(a, 2); b += __shfl_xor(b, 2);
                        a += __shfl_xor(a, 4); b += __shfl_xor(b, 4); a += __shfl_xor(a, 8); b += __shfl_xor(b, 8);
                        if (fr == 0) *(f32x2*)(statsV + ((size_t)(col0 + bj * HALF + e) * 16 + slot) * 2) = (f32x2){a, b};
                    }
            }
        }
    }
};

struct EpiG2 {
    static constexpr bool PERM = true, AFTER_DRAIN = false, MID = true;
    const bf16_t* G; bf16_t* O; static constexpr int SLOT_FLOATS = 0;
    __device__ __forceinline__ void preload(PG8_LAS float*, const Unit&, int) const {}
    __device__ __forceinline__ void mid(f32x4 (&acc)[2][2][4][2], const Unit& u, int wr, int wc, int fr, int fq) const {
        int row0 = u.pm * BM + wr * 64 + fr, col0 = u.pn * BM + wc * 32 + 8 * fq;
        asm volatile("" : "+v"(row0), "+v"(col0));
#pragma unroll
        for (int ai = 0; ai < 2; ++ai)
#pragma unroll
            for (int m = 0; m < 4; ++m) {
                const bf16_t* gp = G + (size_t)(row0 + ai * HALF + m * 16) * (2 * DM) + col0;
#pragma unroll
                for (int bj = 0; bj < 2; ++bj) {
                    const u32x4 ga = *(const u32x4*)(gp + bj * HALF), gb = *(const u32x4*)(gp + DM + bj * HALF);
                    f32x4 r0, r1;
                    r0[0] = bf_lo(ga.x) * __builtin_amdgcn_rcpf(bf_lo(gb.x)); r0[1] = bf_hi(ga.x) * __builtin_amdgcn_rcpf(bf_hi(gb.x));
                    r0[2] = bf_lo(ga.y) * __builtin_amdgcn_rcpf(bf_lo(gb.y)); r0[3] = bf_hi(ga.y) * __builtin_amdgcn_rcpf(bf_hi(gb.y));
                    r1[0] = bf_lo(ga.z) * __builtin_amdgcn_rcpf(bf_lo(gb.z)); r1[1] = bf_hi(ga.z) * __builtin_amdgcn_rcpf(bf_hi(gb.z));
                    r1[2] = bf_lo(ga.w) * __builtin_amdgcn_rcpf(bf_lo(gb.w)); r1[3] = bf_hi(ga.w) * __builtin_amdgcn_rcpf(bf_hi(gb.w));
                    acc[ai][bj][m][0] *= r0; acc[ai][bj][m][1] *= r1;
                }
            }
    }
    __device__ __forceinline__ void operator()(const f32x4 (&acc)[2][2][4][2], const Unit& u, int wr, int wc, int fr, int fq, const PG8_LAS float*) const {
        const int row0 = u.pm * BM + wr * 64 + fr, col0 = u.pn * BM + wc * 32 + 8 * fq;
#pragma unroll
        for (int ai = 0; ai < 2; ++ai)
#pragma unroll
            for (int m = 0; m < 4; ++m) {
                const int row = row0 + ai * HALF + m * 16;
                const bf16_t* gp = G + (size_t)row * (2 * DM) + DM + col0;
                bf16_t* op = O + (size_t)row * DM + col0;
#pragma unroll
                for (int bj = 0; bj < 2; ++bj) {
                    const u32x4 gb = *(const u32x4*)(gp + bj * HALF);
                    const f32x4 a0 = acc[ai][bj][m][0], a1 = acc[ai][bj][m][1];
                    u32x4 w; w.x = cvt_pk_bf16(a0[0] * bf_lo(gb.x), a0[1] * bf_hi(gb.x)); w.y = cvt_pk_bf16(a0[2] * bf_lo(gb.y), a0[3] * bf_hi(gb.y));
                    w.z = cvt_pk_bf16(a1[0] * bf_lo(gb.z), a1[1] * bf_hi(gb.z)); w.w = cvt_pk_bf16(a1[2] * bf_lo(gb.w), a1[3] * bf_hi(gb.w));
                    *(u32x4*)(op + bj * HALF) = w;
                }
            }
    }
};

template <bool FIRST> struct EpiRes {
    static constexpr bool PERM = false, AFTER_DRAIN = false, MID = false; static constexpr int SLOT_FLOATS = FIRST ? 512 : 1024;
    const float* X;
    float* R;
    const float* gate;
    const float* bias;
    const float* lng; const float* lnb; const float* MU;
    float* stats;
    __device__ __forceinline__ void mid(f32x4 (&)[2][2][4][2], const Unit&, int, int, int, int) const {}
    __device__ __forceinline__ void preload(PG8_LAS float* slot, const Unit& u, int tid) const {
        const int c = tid & 255, col = u.pn * BM + c;
        if (tid < 256) slot[c] = gate[(size_t)(u.pm >> 3) * MODW + col]; else slot[256 + c] = bias[col];
        if (!FIRST) { if (tid < 256) slot[512 + c] = DN_ALPHA * lng[col]; else slot[768 + c] = DN_ALPHA * lnb[col]; }
    }
    __device__ __forceinline__ void operator()(const f32x4 (&acc)[2][2][4][2], const Unit& u, int wr, int wc, int fr, int fq, const PG8_LAS float* slot) const {
        int row0 = u.pm * BM + wr * 64 + fr; const int cl = wc * 32 + 4 * fq; int col0 = u.pn * BM + cl;
        asm volatile("" : "+v"(row0), "+v"(col0));
        constexpr int RB = FIRST ? 2 : 1;
#pragma unroll
        for (int ab = 0; ab < 8 / RB; ++ab) {
            const int ai = (ab * RB) >> 2, mb = (ab * RB) & 3;
            f32x4 base[RB][2][2]; f32x2 mr[RB];
            int rowb = row0 + ai * HALF + mb * 16; asm volatile("" : "+v"(rowb));
#pragma unroll
            for (int mm = 0; mm < RB; ++mm) {
                const size_t off = (size_t)(rowb + mm * 16) * DM + col0;
                if (!FIRST) mr[mm] = *(const f32x2*)(MU + (size_t)(rowb + mm * 16) * 2);
#pragma unroll
                for (int bj = 0; bj < 2; ++bj)
#pragma unroll
                    for (int n = 0; n < 2; ++n) base[mm][bj][n] = FIRST ? *(const f32x4*)(X + off + bj * HALF + n * 16) : *(const f32x4*)(R + off + bj * HALF + n * 16);
            }
#pragma unroll
            for (int mm = 0; mm < RB; ++mm) {
                const int m = mb + mm;
                const int row = rowb + mm * 16; float* rp = R + (size_t)row * DM + col0;
                float s = 0.f, q = 0.f;
#pragma unroll
                for (int bj = 0; bj < 2; ++bj)
#pragma unroll
                    for (int n = 0; n < 2; ++n) {
                        const int co = bj * HALF + n * 16;
                        const f32x4 gv = *(const PG8_LAS f32x4*)(slot + cl + co), bv = *(const PG8_LAS f32x4*)(slot + 256 + cl + co);
                        f32x4 bs;
                        if (FIRST) bs = base[mm][bj][n] * DN_ALPHA;
                        else bs = (base[mm][bj][n] - mr[mm].x) * mr[mm].y * *(const PG8_LAS f32x4*)(slot + 512 + cl + co) + *(const PG8_LAS f32x4*)(slot + 768 + cl + co);
                        const f32x4 o = bs + gv * (acc[ai][bj][m][n] + bv);
                        *(f32x4*)(rp + co) = o;
                        s += (o[0] + o[1]) + (o[2] + o[3]); q += (o[0] * o[0] + o[1] * o[1]) + (o[2] * o[2] + o[3] * o[3]);
                    }
                s += __shfl_xor(s, 16); s += __shfl_xor(s, 32); q += __shfl_xor(q, 16); q += __shfl_xor(q, 32);
                if (fq == 0) *(f32x2*)(stats + ((size_t)row * 32 + u.pn * 4 + wc) * 2) = (f32x2){s, q};
            }
            asm volatile("" ::: "memory");
        }
    }
};

struct EpiG4 {
    static constexpr bool PERM = true, AFTER_DRAIN = false, MID = false; static constexpr int SLOT_FLOATS = 256;
    bf16_t* O; const float* bias;
    __device__ __forceinline__ void mid(f32x4 (&)[2][2][4][2], const Unit&, int, int, int, int) const {}
    __device__ __forceinline__ void preload(PG8_LAS float* slot, const Unit& u, int tid) const { if (tid < 256) slot[tid] = bias[u.pn * BM + tid]; }
    __device__ __forceinline__ void operator()(const f32x4 (&acc)[2][2][4][2], const Unit& u, int wr, int wc, int fr, int fq, const PG8_LAS float* slot) const {
        const int row0 = u.pm * BM + wr * 64 + fr, cl = wc * 32 + 8 * fq, col0 = u.pn * BM + cl;
        f32x4 bv[2][2];
#pragma unroll
        for (int bj = 0; bj < 2; ++bj)
#pragma unroll
            for (int n = 0; n < 2; ++n) bv[bj][n] = *(const PG8_LAS f32x4*)(slot + cl + bj * HALF + 4 * n);
#pragma unroll
        for (int ai = 0; ai < 2; ++ai)
#pragma unroll
            for (int m = 0; m < 4; ++m) {
                bf16_t* rowp = O + (size_t)(row0 + ai * HALF + m * 16) * DFF + col0;
#pragma unroll
                for (int bj = 0; bj < 2; ++bj) {
                    f32x4 v0 = acc[ai][bj][m][0] + bv[bj][0], v1 = acc[ai][bj][m][1] + bv[bj][1];
                    v0 = __builtin_elementwise_max(v0, (f32x4){0.f, 0.f, 0.f, 0.f}); v1 = __builtin_elementwise_max(v1, (f32x4){0.f, 0.f, 0.f, 0.f});
                    v0 = v0 * v0; v1 = v1 * v1;
                    u32x4 w; w.x = cvt_pk_bf16(v0[0], v0[1]); w.y = cvt_pk_bf16(v0[2], v0[3]); w.z = cvt_pk_bf16(v1[0], v1[1]); w.w = cvt_pk_bf16(v1[2], v1[3]);
                    *(u32x4*)(rowp + bj * HALF) = w;
                }
            }
    }
};
}
namespace pg8 {
template <class Epi, class Sched, bool ALIGN_EPI = false, bool SP2 = false>
__device__ __forceinline__ void gemm_phase(PG8_LAS unsigned char* lds, const Gemm g, const Sched& S, const Epi& E) {
    const int tid = threadIdx.x, wid = __builtin_amdgcn_readfirstlane(tid >> 6), lane = tid & 63, wr = wid >> 2, wc = wid & 3, fr = lane & 15, fq = lane >> 4;
    const int K = g.K, nt = K / BK;
    unsigned voffA[2], voffB[2];
#pragma unroll
    for (int i = 0; i < 2; ++i) { int R, C; stage_rc(tid * 16 + i * 8192, R, C); const int Rb = Epi::PERM ? ((R & ~31) + perm32(R & 31)) : R;
        voffA[i] = (unsigned)(R * K + C) * 2u; voffB[i] = (unsigned)(Rb * K + C) * 2u; }
    const size_t kstep = (size_t)(BK * 2);
    const size_t hstep = (size_t)HALF * K * 2;
    const size_t tstep = 2 * hstep;
    const unsigned ldsw = (unsigned)wid * 1024u;
    const int aoff = lds_byte(wr * 64 + fr, fq * 8), boff = lds_byte(wc * 32 + fr, fq * 8);
#define PG8_SA(b, h) (((b) * 2 + (h)) * HTB)
#define PG8_SB(b, h) ((4 + (b) * 2 + (h)) * HTB)
#define PG8_STAGE(bufoff, gbase, voff) do { _Pragma("unroll") for (int _i = 0; _i < 2; ++_i) \
        __builtin_amdgcn_global_load_lds((const unsigned*)((const char*)(gbase) + (voff)[_i]), (PG8_LAS unsigned*)(lds + (bufoff) + ldsw + _i * 8192), 16, 0, 0); } while (0)
#define PG8_LDA(dst, b, h) do { _Pragma("unroll") for (int m = 0; m < 4; ++m) _Pragma("unroll") for (int k = 0; k < 2; ++k) dst[m][k] = *(const PG8_LAS bf16x8*)(lds + PG8_SA(b, h) + aoff + m * 2048 + k * 1024); } while (0)
#define PG8_LDB(dst, b, h) do { _Pragma("unroll") for (int n = 0; n < 2; ++n) _Pragma("unroll") for (int k = 0; k < 2; ++k) dst[n][k] = *(const PG8_LAS bf16x8*)(lds + PG8_SB(b, h) + boff + n * 2048 + k * 1024); } while (0)
#define PG8_MMA(ai, bj, At, Bt) do { __builtin_amdgcn_s_setprio(1); _Pragma("unroll") for (int m = 0; m < 4; ++m) _Pragma("unroll") for (int n = 0; n < 2; ++n) _Pragma("unroll") for (int k = 0; k < 2; ++k) \
        acc[ai][bj][m][n] = __builtin_amdgcn_mfma_f32_16x16x32_bf16(Bt[n][k], At[m][k], acc[ai][bj][m][n], 0, 0, 0); __builtin_amdgcn_s_setprio(0); } while (0)
#define PG8_WAIT_V(n) asm volatile("s_waitcnt vmcnt(" #n ")" ::: "memory")
#define PG8_WAIT_L(n) asm volatile("s_waitcnt lgkmcnt(" #n ")" ::: "memory")
#define PG8_BAR __builtin_amdgcn_s_barrier()
#define PG8_SCHED __builtin_amdgcn_sched_barrier(0)
    Unit cur, nxt; int ui = 0;
    if (!S.next(0, cur)) return;
    {
        Unit pu; for (int i = 0; S.next(i, pu); ++i) E.preload((PG8_LAS float*)(lds + EPI_LDS_OFF) + i * Epi::SLOT_FLOATS, pu, tid);
        asm volatile("s_waitcnt vmcnt(0) lgkmcnt(0)" ::: "memory"); __builtin_amdgcn_s_barrier(); asm volatile("" ::: "memory");
    }
    f32x4 acc[2][2][4][2];
#pragma unroll
    for (int a = 0; a < 2; ++a)
#pragma unroll
        for (int b = 0; b < 2; ++b)
#pragma unroll
            for (int m = 0; m < 4; ++m)
#pragma unroll
                for (int n = 0; n < 2; ++n) acc[a][b][m][n] = (f32x4){0.f, 0.f, 0.f, 0.f};
    bf16x8 At[4][2], B0[2][2], B1[2][2];
    const char* cA = (const char*)g.A + (size_t)cur.pm * tstep; const char* cB = (const char*)g.Bt + (size_t)cur.pn * tstep;
    S.a_ready(cur);
    if constexpr (SP2) {
        PG8_STAGE(PG8_SB(0, 0), cB, voffB); PG8_STAGE(PG8_SB(0, 1), cB + hstep, voffB); PG8_STAGE(PG8_SA(0, 0), cA, voffA); PG8_STAGE(PG8_SA(0, 1), cA + hstep, voffA);
        if (wr == 1) PG8_BAR;
        PG8_WAIT_V(2); PG8_BAR;
        PG8_STAGE(PG8_SB(1, 0), cB + kstep, voffB); PG8_STAGE(PG8_SA(1, 0), cA + kstep, voffA); PG8_STAGE(PG8_SB(1, 1), cB + hstep + kstep, voffB);
        PG8_WAIT_V(6); PG8_BAR;
    } else {
        PG8_STAGE(PG8_SB(0, 0), cB, voffB); PG8_STAGE(PG8_SA(0, 0), cA, voffA); PG8_STAGE(PG8_SB(0, 1), cB + hstep, voffB); PG8_STAGE(PG8_SA(0, 1), cA + hstep, voffA);
        if (wr == 1) PG8_BAR;
        PG8_WAIT_V(4); PG8_BAR;
        PG8_STAGE(PG8_SB(1, 0), cB + kstep, voffB); PG8_STAGE(PG8_SA(1, 0), cA + kstep, voffA); PG8_STAGE(PG8_SB(1, 1), cB + hstep + kstep, voffB);
        PG8_WAIT_V(6); PG8_BAR;
    }
    for (;;) {
        const bool has_next = S.next(ui + 1, nxt);
        const char* nA = has_next ? (const char*)g.A + (size_t)nxt.pm * tstep : cA; const char* nB = has_next ? (const char*)g.Bt + (size_t)nxt.pn * tstep : cB;
        for (int t = 0; t < nt; t += 2) {
            const bool last = (t == nt - 2);
            const char* a1 = cA + (size_t)(t + 1) * kstep;
            const char* a2 = last ? nA : cA + (size_t)(t + 2) * kstep; const char* b2 = last ? nB : cB + (size_t)(t + 2) * kstep;
            const char* a3 = a2 + kstep; const char* b3 = b2 + kstep;
            if (last && has_next) S.a_ready(nxt);
            if constexpr (Epi::MID) { if (t == (nt >> 1)) E.mid(acc, cur, wr, wc, fr, fq); }
            if constexpr (SP2) {
            PG8_LDB(B0, 0, 0); PG8_LDB(B1, 0, 1); PG8_SCHED; PG8_LDA(At, 0, 0); PG8_STAGE(PG8_SA(1, 1), a1 + hstep, voffA);
            PG8_WAIT_V(8); PG8_WAIT_L(0); PG8_BAR; PG8_MMA(0, 0, At, B0); PG8_MMA(0, 1, At, B1); PG8_BAR; PG8_SCHED;
            PG8_LDA(At, 0, 1); PG8_STAGE(PG8_SB(0, 0), b2, voffB); PG8_STAGE(PG8_SB(0, 1), b2 + hstep, voffB); PG8_STAGE(PG8_SA(0, 0), a2, voffA);
            PG8_WAIT_V(8); PG8_WAIT_L(0); PG8_BAR; PG8_MMA(1, 0, At, B0); PG8_MMA(1, 1, At, B1); PG8_BAR; PG8_SCHED;
            PG8_LDB(B0, 1, 0); PG8_LDB(B1, 1, 1); PG8_SCHED; PG8_LDA(At, 1, 0); PG8_STAGE(PG8_SA(0, 1), a2 + hstep, voffA);
            PG8_WAIT_V(8); PG8_WAIT_L(0); PG8_BAR; PG8_MMA(0, 0, At, B0); PG8_MMA(0, 1, At, B1); PG8_BAR; PG8_SCHED;
            PG8_LDA(At, 1, 1); PG8_STAGE(PG8_SB(1, 0), b3, voffB); PG8_STAGE(PG8_SB(1, 1), b3 + hstep, voffB); PG8_STAGE(PG8_SA(1, 0), a3, voffA);
            PG8_WAIT_V(8); PG8_WAIT_L(0); PG8_BAR; PG8_MMA(1, 0, At, B0); PG8_MMA(1, 1, At, B1); PG8_BAR; PG8_SCHED;
            } else {
            PG8_LDB(B0, 0, 0); PG8_SCHED; PG8_LDA(At, 0, 0); PG8_STAGE(PG8_SA(1, 1), a1 + hstep, voffA);
            PG8_WAIT_L(8); PG8_BAR; PG8_WAIT_L(0); PG8_MMA(0, 0, At, B0); PG8_BAR; PG8_SCHED;
            PG8_LDB(B1, 0, 1); PG8_STAGE(PG8_SB(0, 0), b2, voffB);
            PG8_BAR; PG8_WAIT_L(0); PG8_MMA(0, 1, At, B1); PG8_BAR;
            PG8_LDA(At, 0, 1); PG8_STAGE(PG8_SA(0, 0), a2, voffA);
            PG8_BAR; PG8_WAIT_L(0); PG8_MMA(1, 0, At, B0); PG8_BAR; PG8_SCHED;
            PG8_STAGE(PG8_SB(0, 1), b2 + hstep, voffB);
            PG8_WAIT_V(6); PG8_BAR; PG8_MMA(1, 1, At, B1); PG8_BAR;
            PG8_LDB(B0, 1, 0); PG8_SCHED; PG8_LDA(At, 1, 0); PG8_STAGE(PG8_SA(0, 1), a2 + hstep, voffA);
            PG8_WAIT_L(8); PG8_BAR; PG8_WAIT_L(0); PG8_MMA(0, 0, At, B0); PG8_BAR; PG8_SCHED;
            PG8_LDB(B1, 1, 1); PG8_STAGE(PG8_SB(1, 0), b3, voffB);
            PG8_BAR; PG8_WAIT_L(0); PG8_MMA(0, 1, At, B1); PG8_BAR;
            PG8_LDA(At, 1, 1); PG8_STAGE(PG8_SA(1, 0), a3, voffA);
            PG8_BAR; PG8_WAIT_L(0); PG8_MMA(1, 0, At, B0); PG8_BAR; PG8_SCHED;
            PG8_STAGE(PG8_SB(1, 1), b3 + hstep, voffB);
            PG8_WAIT_V(6); PG8_BAR; PG8_MMA(1, 1, At, B1); PG8_BAR;
            }
        }
        if constexpr (ALIGN_EPI) { if (wr == 0) PG8_BAR; }
        if constexpr (!Epi::AFTER_DRAIN) { E(acc, cur, wr, wc, fr, fq, (const PG8_LAS float*)(lds + EPI_LDS_OFF) + ui * Epi::SLOT_FLOATS); S.done(cur); }
        if (!has_next) break;
#pragma unroll
        for (int a = 0; a < 2; ++a)
#pragma unroll
            for (int b = 0; b < 2; ++b)
#pragma unroll
                for (int m = 0; m < 4; ++m)
#pragma unroll
                    for (int n = 0; n < 2; ++n) acc[a][b][m][n] = (f32x4){0.f, 0.f, 0.f, 0.f};
        cur = nxt; cA = nA; cB = nB; ++ui;
        if constexpr (ALIGN_EPI) { if (wr == 1) PG8_BAR; }
    }
    PG8_WAIT_V(0);
    if constexpr (!ALIGN_EPI) { if (wr == 0) PG8_BAR; }
    PG8_BAR;
    if constexpr (Epi::AFTER_DRAIN) { E.fused(acc, cur, wr, wc, fr, fq, lds, wid, lane); S.done(cur); }
#undef PG8_SA
#undef PG8_SB
#undef PG8_STAGE
#undef PG8_LDA
#undef PG8_LDB
#undef PG8_MMA
#undef PG8_WAIT_V
#undef PG8_WAIT_L
#undef PG8_BAR
#undef PG8_SCHED
}
}

constexpr size_t MiB = 1u << 20;
constexpr size_t WS_CTL = 0;
constexpr size_t WS_MOD = 1 * MiB;
constexpr size_t WS_STV = 2 * MiB;
constexpr size_t WS_ST1 = 4 * MiB;
constexpr size_t WS_ST2 = 8 * MiB;
constexpr size_t WS_MU1 = 12 * MiB;
constexpr size_t WS_SGW = 13 * MiB;
constexpr size_t WS_WIN = 16 * MiB;
constexpr size_t WS_WAB = 52 * MiB;
constexpr size_t WS_WO = 60 * MiB;
constexpr size_t WS_FILT = 68 * MiB;
constexpr size_t WS_WM2 = 68 * MiB;
constexpr size_t WS_H = 100 * MiB;
constexpr size_t WS_U = 164 * MiB;
constexpr size_t WS_V = 196 * MiB;
constexpr size_t WS_MERGED = 164 * MiB;
constexpr size_t WS_ZHT = 228 * MiB;
constexpr size_t WS_G = 324 * MiB;
constexpr size_t WS_AFF = 164 * MiB;
constexpr size_t WS_WM1 = 420 * MiB;
constexpr size_t WS_YT = 452 * MiB;
constexpr size_t WS_END = 484 * MiB;

constexpr int NWAVES = 8;
constexpr int LDS_BYTES = 163840;

#define GAS __attribute__((address_space(1)))
#define LAS __attribute__((address_space(3)))
typedef unsigned short bf16;
typedef unsigned v4u __attribute__((ext_vector_type(4)));
typedef unsigned v2u __attribute__((ext_vector_type(2)));
typedef float f32x4 __attribute__((ext_vector_type(4)));
typedef float f32x2 __attribute__((ext_vector_type(2)));
#define LDS_WAIT() asm volatile("s_waitcnt lgkmcnt(0)" ::: "memory")

__device__ __forceinline__ unsigned f2bf(float f) { unsigned u = __builtin_bit_cast(unsigned, f); return (u + 0x7fffu + ((u >> 16) & 1u)) >> 16; }
__device__ __forceinline__ unsigned pk2(float lo, float hi) { return f2bf(lo) | (f2bf(hi) << 16); }
__device__ __forceinline__ float bflo(unsigned w) { return __uint_as_float(w << 16); }
__device__ __forceinline__ float bfhi(unsigned w) { return __uint_as_float(w & 0xffff0000u); }
__device__ __forceinline__ float bf1(bf16 h) { return __uint_as_float((unsigned)h << 16); }
__device__ __forceinline__ float wave_sum(float v) {
#pragma unroll
    for (int o = 1; o < 64; o <<= 1) v += __shfl_xor(v, o);
    return v;
}

struct Args { const float* in[31]; float* out; unsigned char* ws; int ph_lo, ph_hi; };

struct Frame {
    LAS unsigned char* lds;
    int tid, lane, wave, G;
    const float* const* in; float* out; unsigned char* ws;
};
enum { I_X = 0, I_C, I_WADA, I_BADA, I_WIN, I_BIN, I_SLNG, I_SLNB, I_SW, I_SB, I_HCW, I_HCB, I_HW1, I_HB1, I_HW2, I_HB2, I_HFREQ, I_HW3, I_HSKIP,
       I_WA, I_WB, I_WO, I_BO, I_LN1G, I_LN1B, I_WM1, I_BM1, I_WM2, I_BM2, I_LN2G, I_LN2B };

__device__ __forceinline__ void transpose_matrix(Frame& F, const float* W, int K, int N, bf16* WT, int ldk, int koff, int remap_win, int first, int nblocks) {
    LAS float* tile = (LAS float*)F.lds;
    const int tid = F.tid, nblk = N / 256, nitems = (K / 64) * nblk;
    const int lr = tid >> 6, lc = tid & 63;
    const int wc = tid & 7, wn = tid >> 3;
    for (int it = first; it < nitems; it += nblocks) {
        const int kb = it / nblk, nb = it % nblk, n0 = nb * 256, k0 = kb * 64; int row0 = n0;
        if (remap_win) row0 = (n0 < 1024) ? n0 : (n0 < 2048 ? n0 - 1024 + 5120 : (n0 < 5120 ? n0 - 2048 + 6144 : n0 - 5120 + 1024));
        f32x4 v[8];
#pragma unroll
        for (int i = 0; i < 8; ++i) v[i] = *(const f32x4*)(W + (size_t)(k0 + 8 * i + lr) * N + n0 + 4 * lc);
#pragma unroll
        for (int i = 0; i < 8; ++i) *(LAS f32x4*)(tile + (8 * i + lr) * 256 + ((lc ^ i) << 2)) = v[i];
        __syncthreads();
#pragma unroll
        for (int j = 0; j < 4; ++j) { const int n = wn + 64 * j; const LAS float* sp = tile + (8 * wc) * 256 + ((((n >> 2) ^ wc) << 2) | (n & 3));
            v4u o; o.x = pk2(sp[0 * 256], sp[1 * 256]); o.y = pk2(sp[2 * 256], sp[3 * 256]); o.z = pk2(sp[4 * 256], sp[5 * 256]); o.w = pk2(sp[6 * 256], sp[7 * 256]);
            *(GAS v4u*)(WT + (size_t)(row0 + n) * ldk + koff + k0 + 8 * wc) = o; }
        __syncthreads();
    }
}

__device__ __forceinline__ void p0_mod(Frame& F) {
    LAS float* condS = (LAS float*)F.lds;
    LAS float* red = (LAS float*)(F.lds + 65536);
    const float* c = F.in[I_C]; const float* w_ada = F.in[I_WADA]; const float* b_ada = F.in[I_BADA];
    float* mod = (float*)(F.ws + WS_MOD);
    const int tid = F.tid;
    for (int item = blockIdx.x; item < MODW / 48; item += F.G) {
        for (int i = tid; i < NBATCH * DM; i += NWAVES * 64) { const float v = c[i]; condS[i] = v / (1.0f + __expf(-v)); }
        __syncthreads();
        const int cq = tid % 12, kq = tid / 12, col0 = item * 48;
        if (kq < 32) {
            f32x4 acc[8];
#pragma unroll
            for (int b = 0; b < 8; ++b) acc[b] = (f32x4){0.f, 0.f, 0.f, 0.f};
            const float* wp = w_ada + (size_t)kq * MODW + col0 + cq * 4;
            for (int k = kq; k < DM; k += 256, wp += (size_t)256 * MODW) {
                f32x4 w[8];
#pragma unroll
                for (int u = 0; u < 8; ++u) w[u] = *(const f32x4*)(wp + (size_t)(32 * u) * MODW);
#pragma unroll
                for (int u = 0; u < 8; ++u)
#pragma unroll
                    for (int b = 0; b < 8; ++b) acc[b] += w[u] * condS[b * DM + k + 32 * u];
            }
#pragma unroll
            for (int b = 0; b < 8; ++b) *(LAS f32x4*)(red + (kq * 8 + b) * 48 + cq * 4) = acc[b];
        }
        __syncthreads();
        if (tid < 384) { const int b = tid / 48, col = tid % 48; float s = 0.f;
#pragma unroll 8
          for (int k2 = 0; k2 < 32; ++k2) s += red[(k2 * 8 + b) * 48 + col];
          mod[(size_t)b * MODW + col0 + col] = s + b_ada[col0 + col]; }
        __syncthreads();
    }
}

__device__ __forceinline__ void p0_filter(Frame& F) {
    LAS float* h2T = (LAS float*)F.lds;
    LAS float* scr = (LAS float*)(F.lds + 16384) + F.wave * 128;
    const float* w1 = F.in[I_HW1]; const float* b1 = F.in[I_HB1]; const float* w2 = F.in[I_HW2]; const float* b2 = F.in[I_HB2];
    const float* freq = F.in[I_HFREQ]; const float* w3 = F.in[I_HW3];
    float* FILT = (float*)(F.ws + WS_FILT);
    const int tid = F.tid, lane = F.lane, wave = F.wave;
    const float min_decay = -3.0701134573253943f, max_decay = -15.350567286626972f;
    for (int item = blockIdx.x; item < 256; item += F.G) {
        const int pb = item >> 3, cb = item & 7;
        const float fr = freq[lane], bb1 = b1[lane], bb2 = b2[lane];
        for (int pp = 0; pp < 8; ++pp) {
            const int pl = wave * 8 + pp, l = pb * 64 + pl;
            const float tl = (float)l / (float)(SEQ - 1), omega = 6.283185307179586f * (float)l / (float)SEQ;
            float f = 0.f;
            if (lane == 0) f = tl;
            else if (lane <= 16) { const float band = 1e-4f + (float)(lane - 1) * ((15.0f - 1e-4f) / 15.0f); f = cosf(band * omega); }
            else if (lane <= 32) { const float band = 1e-4f + (float)(lane - 17) * ((15.0f - 1e-4f) / 15.0f); f = -sinf(band * omega); }
            scr[lane] = f; LDS_WAIT(); asm volatile("" ::: "memory");
            float a = bb1;
            for (int i = 0; i < 33; ++i) a += scr[i] * w1[i * 64 + lane];
            scr[64 + lane] = sinf(fr * a); LDS_WAIT(); asm volatile("" ::: "memory");
            a = bb2;
            for (int i = 0; i < 64; ++i) a += scr[64 + i] * w2[i * 64 + lane];
            h2T[lane * 64 + pl] = sinf(fr * a); LDS_WAIT(); asm volatile("" ::: "memory");
        }
        __syncthreads();
        {
            const int cg = tid & 127, pg = tid >> 7, j0 = cb * 512 + cg * 4;
            f32x4 acc[16];
#pragma unroll
            for (int p = 0; p < 16; ++p) acc[p] = (f32x4){0.f, 0.f, 0.f, 0.f};
#pragma unroll 4
            for (int i = 0; i < 64; ++i) { const f32x4 w = *(const f32x4*)(w3 + (size_t)i * 4096 + j0);
#pragma unroll
                for (int p4 = 0; p4 < 4; ++p4) { const f32x4 hv = *(const LAS f32x4*)(h2T + i * 64 + pg * 16 + 4 * p4);
                    acc[4 * p4 + 0] += w * hv[0]; acc[4 * p4 + 1] += w * hv[1]; acc[4 * p4 + 2] += w * hv[2]; acc[4 * p4 + 3] += w * hv[3]; } }
            const int p0 = pb * 64 + pg * 16;
#pragma unroll
            for (int e = 0; e < 4; ++e) { const int j = j0 + e, ch = j & 1023; const float delta = fabsf(min_decay + (float)ch * ((max_decay - min_decay) / 1023.0f));
                float o[16];
#pragma unroll
                for (int p = 0; p < 16; ++p) { const float tp = (float)(p0 + p) / (float)(SEQ - 1); o[p] = acc[p][e] * expf(-tp * delta); }
                float* op = FILT + (size_t)j * SEQ + p0;
#pragma unroll
                for (int p4 = 0; p4 < 4; ++p4) *(f32x4*)(op + 4 * p4) = (f32x4){o[4 * p4], o[4 * p4 + 1], o[4 * p4 + 2], o[4 * p4 + 3]}; }
        }
        __syncthreads();
    }
}

__device__ __forceinline__ void p1_modulate(Frame& F) {
    const float* x = F.in[I_X]; const float* mod = (const float*)(F.ws + WS_MOD); bf16* H = (bf16*)(F.ws + WS_H);
    const size_t nvec = (size_t)MTOK * DM / 8, stride = (size_t)F.G * NWAVES * 64;
    for (size_t i = (size_t)blockIdx.x * (NWAVES * 64) + F.tid; i < nvec; i += stride) {
        const int row = (int)(i >> 8), col = (int)(i & 255) * 8, b = row >> 11;
        const f32x4 x0 = *(const f32x4*)(x + (size_t)row * DM + col), x1 = *(const f32x4*)(x + (size_t)row * DM + col + 4);
        const float* mp = mod + (size_t)b * MODW + col;
        const f32x4 sh0 = *(const f32x4*)mp, sh1 = *(const f32x4*)(mp + 4), sc0 = *(const f32x4*)(mp + DM), sc1 = *(const f32x4*)(mp + DM + 4);
        const f32x4 h0 = x0 * (sc0 + 1.0f) + sh0, h1 = x1 * (sc1 + 1.0f) + sh1;
        v4u o; o.x = pk2(h0[0], h0[1]); o.y = pk2(h0[2], h0[3]); o.z = pk2(h1[0], h1[1]); o.w = pk2(h1[2], h1[3]);
        *(v4u*)(H + (size_t)row * DM + col) = o;
    }
}

typedef short sg_bf16x8 __attribute__((ext_vector_type(8)));
typedef float sg_f32x16 __attribute__((ext_vector_type(16)));
constexpr int SG_VT = 0, SG_LD = 136, SG_ST = 36864;
__device__ __forceinline__ void p3_sgu(Frame& F) {
    LAS bf16* vnT = (LAS bf16*)(F.lds + SG_VT); LAS float* stS = (LAS float*)(F.lds + SG_ST);
    const bf16* U = (const bf16*)(F.ws + WS_U); const bf16* VT = (const bf16*)(F.ws + WS_V); bf16* AB = (bf16*)(F.ws + WS_H);
    const bf16* Wb = (const bf16*)(F.ws + WS_SGW); const float* stv = (const float*)(F.ws + WS_STV);
    const float* lng = F.in[I_SLNG]; const float* lnb = F.in[I_SLNB]; const float* sb = F.in[I_SB];
    const int tid = F.tid, lane = F.lane, w = F.wave, r = lane & 31, h = lane >> 5;
    for (int item = blockIdx.x; item < 1024; item += F.G) {
        const int b = item >> 7, n = (item >> 3) & 15, g = item & 7, tok0 = b * SEQ + n * 128;
        if (tid < 128) { float s = 0.f, q = 0.f; const float* sp = stv + (size_t)(tok0 + tid) * 32;
#pragma unroll
            for (int i = 0; i < 16; ++i) { const f32x2 pr = *(const f32x2*)(sp + 2 * i); s += pr.x; q += pr.y; }
            const float mean = s * (1.0f / 1024.0f); float var = q * (1.0f / 1024.0f) - mean * mean; var = var > 0.f ? var : 0.f;
            *(LAS f32x2*)(stS + 2 * tid) = (f32x2){mean, 1.0f / sqrtf(var + LN_EPS)}; }
        __syncthreads();
        { const int c = tid >> 2, pseg = (tid & 3) * 32, ch = g * 128 + c; const float gg = lng[ch], bb = lnb[ch];
          const bf16* vp = VT + (size_t)ch * MTOK + tok0 + pseg;
          v4u wv[4];
#pragma unroll
          for (int k = 0; k < 4; ++k) wv[k] = *(const v4u*)(vp + 8 * k);
#pragma unroll
          for (int k = 0; k < 4; ++k) {
              const float e[8] = {bflo(wv[k].x), bfhi(wv[k].x), bflo(wv[k].y), bfhi(wv[k].y), bflo(wv[k].z), bfhi(wv[k].z), bflo(wv[k].w), bfhi(wv[k].w)};
              float o[8];
#pragma unroll
              for (int i = 0; i < 8; i += 2) { const f32x4 st = *(const LAS f32x4*)(stS + 2 * (pseg + 8 * k + i));
                  o[i] = (e[i] - st[0]) * st[1] * gg + bb; o[i + 1] = (e[i + 1] - st[2]) * st[3] * gg + bb; }
              v4u pk; pk.x = pk2(o[0], o[1]); pk.y = pk2(o[2], o[3]); pk.z = pk2(o[4], o[5]); pk.w = pk2(o[6], o[7]);
              *(LAS v4u*)(vnT + c * SG_LD + pseg + 8 * k) = pk; } }
        const int q0 = 32 * (w >> 1), ct0 = 2 * (w & 1);
        sg_bf16x8 af[8];
#pragma unroll
        for (int kk = 0; kk < 8; ++kk) af[kk] = *(const sg_bf16x8*)(Wb + (size_t)(g * 128 + q0 + r) * 128 + 16 * kk + 8 * h);
        __syncthreads();
        sg_f32x16 acc[2];
#pragma unroll
        for (int ct = 0; ct < 2; ++ct)
#pragma unroll
            for (int i = 0; i < 16; ++i) acc[ct][i] = 0.f;
#pragma unroll
        for (int kk = 0; kk < 8; ++kk)
#pragma unroll
            for (int ct = 0; ct < 2; ++ct) {
                const sg_bf16x8 bf = *(const LAS sg_bf16x8*)(vnT + ((ct0 + ct) * 32 + r) * SG_LD + 16 * kk + 8 * h);
                acc[ct] = __builtin_amdgcn_mfma_f32_32x32x16_bf16(af[kk], bf, acc[ct], 0, 0, 0);
            }
#pragma unroll
        for (int ct = 0; ct < 2; ++ct) {
            const int c = (ct0 + ct) * 32 + r;
#pragma unroll
            for (int rg = 0; rg < 16; ++rg) {
                const int q = q0 + (rg & 3) + 8 * (rg >> 2) + 4 * h;
                const float uv = bf1(U[(size_t)(tok0 + q) * SGUW + g * 128 + c]);
                AB[(size_t)(tok0 + q) * DM + g * 128 + c] = (bf16)f2bf(uv * (acc[ct][rg] + sb[g * 128 + q]));
            }
        }
        __syncthreads();
    }
}

__device__ __forceinline__ float sconv(const bf16* ZHT, const float* cw, const float* cb, int ch, int b, int t) {
    const bf16* zp = ZHT + (size_t)ch * MTOK + b * SEQ;
    const float z0 = t > 0 ? bf1(zp[t - 1]) : 0.f, z1 = bf1(zp[t]), z2 = t < SEQ - 1 ? bf1(zp[t + 1]) : 0.f;
    return cw[ch] * z0 + cw[3072 + ch] * z1 + cw[6144 + ch] * z2 + cb[ch];
}
__device__ __forceinline__ void p3_hyena(Frame& F) {
    LAS float* Us = (LAS float*)F.lds;
    LAS float* KF = (LAS float*)(F.lds + 65536);
    const bf16* ZHT = (const bf16*)(F.ws + WS_ZHT); const float* FILT = (const float*)(F.ws + WS_FILT); bf16* AB = (bf16*)(F.ws + WS_H);
    const float* cw = F.in[I_HCW]; const float* cb = F.in[I_HCB]; const float* skip = F.in[I_HSKIP];
    const int tid = F.tid;
    for (int item = blockIdx.x; item < HYW; item += F.G) {
        const int c = item;
        for (int i = tid; i < NBATCH * SEQ; i += NWAVES * 64) { const int b = i >> 11, t = i & 2047; Us[t * 8 + b] = sconv(ZHT, cw, cb, c, b, t); }
        for (int n = 0; n < 2; ++n) {
            const float* hf = FILT + (size_t)((0 * 2 + n) * 1024 + c) * SEQ; const float* hb = FILT + (size_t)((1 * 2 + n) * 1024 + c) * SEQ;
            for (int i = tid; i < 4095; i += NWAVES * 64) { const int lag = i - 2047; KF[i] = lag > 0 ? hf[lag] : (lag == 0 ? hf[0] + hb[0] : hb[-lag]); }
            __syncthreads();
            f32x4 acc[4][2];
#pragma unroll
            for (int ti = 0; ti < 4; ++ti) { acc[ti][0] = (f32x4){0.f, 0.f, 0.f, 0.f}; acc[ti][1] = (f32x4){0.f, 0.f, 0.f, 0.f}; }
            const LAS float* kp = KF + tid + 2047;
            for (int s = 0; s < SEQ; ++s) {
                const f32x4 u0 = *(const LAS f32x4*)(Us + s * 8), u1 = *(const LAS f32x4*)(Us + s * 8 + 4);
#pragma unroll
                for (int ti = 0; ti < 4; ++ti) { const float kv = kp[512 * ti - s]; acc[ti][0] += u0 * kv; acc[ti][1] += u1 * kv; }
            }
            __syncthreads();
            const float sk = skip[n * 1024 + c];
#pragma unroll
            for (int ti = 0; ti < 4; ++ti) { const int t = tid + 512 * ti;
#pragma unroll
                for (int b = 0; b < 8; ++b) {
                    const float uv = Us[t * 8 + b], gate = sconv(ZHT, cw, cb, (n + 1) * 1024 + c, b, t);
                    const float y = gate * (acc[ti][b >> 2][b & 3] + sk * uv);
                    if (n == 0) Us[t * 8 + b] = y; else AB[(size_t)(b * SEQ + t) * DM + 1024 + c] = (bf16)f2bf(y);
                } }
            __syncthreads();
        }
    }
}

#ifndef HYFFT_HD
#define HYFFT_HD __device__ __forceinline__
#define HYFFT_LAS __attribute__((address_space(3)))
#endif
typedef float hy_c32 __attribute__((ext_vector_type(2)));
HYFFT_HD int hy_padi(int i) { return i + (i >> 3); }
HYFFT_HD int hy_rev(int x) { return ((x & 7) << 9) | (((x >> 3) & 7) << 6) | (((x >> 6) & 7) << 3) | ((x >> 9) & 7); }

template <bool INV> HYFFT_HD void hy_dft8(float (&re)[8], float (&im)[8]) {
    const float h = 0.70710678118654752f;
    float ar[4], ai[4], br[4], bi[4];
#pragma unroll
    for (int m = 0; m < 4; ++m) { ar[m] = re[m] + re[m + 4]; ai[m] = im[m] + im[m + 4]; br[m] = re[m] - re[m + 4]; bi[m] = im[m] - im[m + 4]; }
    { float x = br[1], y = bi[1]; if (!INV) { br[1] = h * (x + y); bi[1] = h * (y - x); } else { br[1] = h * (x - y); bi[1] = h * (y + x); } }
    { float x = br[2], y = bi[2]; if (!INV) { br[2] = y; bi[2] = -x; } else { br[2] = -y; bi[2] = x; } }
    { float x = br[3], y = bi[3]; if (!INV) { br[3] = h * (y - x); bi[3] = -h * (x + y); } else { br[3] = -h * (x + y); bi[3] = h * (x - y); } }
#pragma unroll
    for (int s = 0; s < 2; ++s) {
        float* cr = s ? br : ar; float* ci = s ? bi : ai;
        const float e0r = cr[0] + cr[2], e0i = ci[0] + ci[2], e1r = cr[0] - cr[2], e1i = ci[0] - ci[2];
        const float o0r = cr[1] + cr[3], o0i = ci[1] + ci[3]; const float dr = cr[1] - cr[3], di = ci[1] - ci[3];
        float o1r, o1i; if (!INV) { o1r = di; o1i = -dr; } else { o1r = -di; o1i = dr; }
        re[0 + s] = e0r + o0r; im[0 + s] = e0i + o0i;
        re[2 + s] = e1r + o1r; im[2 + s] = e1i + o1i;
        re[4 + s] = e0r - o0r; im[4 + s] = e0i - o0i;
        re[6 + s] = e1r - o1r; im[6 + s] = e1i - o1i;
    }
}
template <bool CONJ> HYFFT_HD void hy_twiddle(float (&re)[8], float (&im)[8], float wr, float wi) {
    if (CONJ) wi = -wi;
    const float w2r = wr * wr - wi * wi, w2i = 2.f * wr * wi;
    const float w3r = w2r * wr - w2i * wi, w3i = w2r * wi + w2i * wr;
    const float w4r = w2r * w2r - w2i * w2i, w4i = 2.f * w2r * w2i;
    const float w5r = w4r * wr - w4i * wi, w5i = w4r * wi + w4i * wr;
    const float w6r = w3r * w3r - w3i * w3i, w6i = 2.f * w3r * w3i;
    const float w7r = w4r * w3r - w4i * w3i, w7i = w4r * w3i + w4i * w3r;
    const float pr[8] = {1.f, wr, w2r, w3r, w4r, w5r, w6r, w7r}, pi[8] = {0.f, wi, w2i, w3i, w4i, w5i, w6i, w7i};
#pragma unroll
    for (int k = 1; k < 8; ++k) { const float x = re[k], y = im[k]; re[k] = x * pr[k] - y * pi[k]; im[k] = x * pi[k] + y * pr[k]; }
}
template <int L, class BP, class TP> HYFFT_HD void hy_fwd_store(BP buf, TP tw, int j, float (&re)[8], float (&im)[8]) {
    constexpr int S = L / 8; const int blk = j / S, q = j % S, base = blk * L + q;
    hy_dft8<false>(re, im);
    if (L > 8) { const hy_c32 w = tw[q * (4096 / L)]; hy_twiddle<false>(re, im, w.x, w.y); }
#pragma unroll
    for (int k = 0; k < 8; ++k) buf[hy_padi(base + k * S)] = (hy_c32){re[k], im[k]};
}
template <int L, class BP> HYFFT_HD void hy_load8(BP buf, int j, float (&re)[8], float (&im)[8]) {
    constexpr int S = L / 8; const int blk = j / S, q = j % S, base = blk * L + q;
#pragma unroll
    for (int k = 0; k < 8; ++k) { const hy_c32 v = buf[hy_padi(base + k * S)]; re[k] = v.x; im[k] = v.y; }
}
template <int L, class BP, class TP> HYFFT_HD void hy_fwd_stage(BP buf, TP tw, int j) { float re[8], im[8]; hy_load8<L>(buf, j, re, im); hy_fwd_store<L>(buf, tw, j, re, im); }
template <int L, class BP, class TP> HYFFT_HD void hy_inv_regs(BP buf, TP tw, int j, float (&re)[8], float (&im)[8]) {
    constexpr int S = L / 8; const int q = j % S;
    hy_load8<L>(buf, j, re, im);
    if (L > 8) { const hy_c32 w = tw[q * (4096 / L)]; hy_twiddle<true>(re, im, w.x, w.y); }
    hy_dft8<true>(re, im);
}
template <int L, class BP, class TP> HYFFT_HD void hy_inv_stage(BP buf, TP tw, int j) {
    constexpr int S = L / 8; const int blk = j / S, q = j % S, base = blk * L + q;
    float re[8], im[8]; hy_inv_regs<L>(buf, tw, j, re, im);
#pragma unroll
    for (int k = 0; k < 8; ++k) buf[hy_padi(base + k * S)] = (hy_c32){re[k], im[k]};
}
template <class BP, class KP> HYFFT_HD void hy_mid_stage(BP buf, KP K, int j) {
    float re[8], im[8]; hy_load8<8>(buf, j, re, im);
    hy_dft8<false>(re, im);
#pragma unroll
    for (int k = 0; k < 8; ++k) { const hy_c32 kv = K[hy_padi(8 * j + k)]; const float x = re[k], y = im[k]; re[k] = x * kv.x - y * kv.y; im[k] = x * kv.y + y * kv.x; }
    hy_dft8<true>(re, im);
#pragma unroll
    for (int k = 0; k < 8; ++k) buf[hy_padi(8 * j + k)] = (hy_c32){re[k], im[k]};
}
template <class BP> HYFFT_HD void hy_last_fwd(BP buf, int j) {
    float re[8], im[8]; hy_load8<8>(buf, j, re, im); hy_dft8<false>(re, im);
#pragma unroll
    for (int k = 0; k < 8; ++k) buf[hy_padi(8 * j + k)] = (hy_c32){re[k], im[k]};
}
template <class BP, class KP> HYFFT_HD void hy_separate(BP Z, KP K1, KP K2, int j) {
    const float sc = 0.5f / 4096.0f;
#pragma unroll
    for (int r = 0; r < 8; ++r) {
        const int p = j + 512 * r, f = hy_rev(p), g = (4096 - f) & 4095, p2 = hy_rev(g);
        const hy_c32 a = Z[hy_padi(p)], b = Z[hy_padi(p2)];
        K1[hy_padi(p)] = (hy_c32){(a.x + b.x) * sc, (a.y - b.y) * sc};
        K2[hy_padi(p)] = (hy_c32){(a.y + b.y) * sc, (b.x - a.x) * sc};
    }
}

struct Raw3 { bf16 a, b, c; };
__device__ __forceinline__ Raw3 raw3(const bf16* zp, int t) { Raw3 r; r.a = zp[t > 0 ? t - 1 : 0]; r.b = zp[t]; r.c = zp[t < SEQ - 1 ? t + 1 : SEQ - 1]; return r; }
__device__ __forceinline__ float sconv_raw(const Raw3& r, int t, float w0, float w1, float w2, float cb) {
    const float z0 = t > 0 ? bf1(r.a) : 0.f, z1 = bf1(r.b), z2 = t < SEQ - 1 ? bf1(r.c) : 0.f;
    return w0 * z0 + w1 * z1 + w2 * z2 + cb;
}
__device__ __forceinline__ void p3_hyena_fft(Frame& F) {
    LAS hy_c32* BA = (LAS hy_c32*)(F.lds + 0); LAS hy_c32* BB = (LAS hy_c32*)(F.lds + 36864);
    LAS hy_c32* K1 = (LAS hy_c32*)(F.lds + 73728); LAS hy_c32* K2 = (LAS hy_c32*)(F.lds + 110592); LAS hy_c32* TW = (LAS hy_c32*)(F.lds + 147456);
    const bf16* ZHT = (const bf16*)(F.ws + WS_ZHT); const float* FILT = (const float*)(F.ws + WS_FILT); bf16* YT = (bf16*)(F.ws + WS_YT);
    const float* cw = F.in[I_HCW]; const float* cb = F.in[I_HCB]; const float* skip = F.in[I_HSKIP];
    const int jt = F.tid;
    { float sn, cs; sincosf(-6.283185307179586f * (float)jt / 4096.0f, &sn, &cs); TW[jt] = (hy_c32){cs, sn}; }
    __syncthreads();
    for (int item = blockIdx.x; item < HYW; item += F.G) {
        const int c = item;
        float ra[8], ia[8], rb[8], ib[8];
        int j = jt; asm volatile("" : "+v"(j));
        const bf16* zv = ZHT + (size_t)c * MTOK; const bf16* za = ZHT + (size_t)(1024 + c) * MTOK; const bf16* zb = ZHT + (size_t)(2048 + c) * MTOK;
        {
            const float* hf0 = FILT + (size_t)(0 * 1024 + c) * SEQ; const float* hf1 = FILT + (size_t)(1 * 1024 + c) * SEQ;
            const float* hb0 = FILT + (size_t)(2 * 1024 + c) * SEQ; const float* hb1 = FILT + (size_t)(3 * 1024 + c) * SEQ;
#pragma unroll
            for (int m = 0; m < 4; ++m) { const int i = j + 512 * m; ra[m] = hf0[i]; ia[m] = hf1[i]; }
            if (j == 0) { ra[0] += hb0[0]; ia[0] += hb1[0]; }
#pragma unroll
            for (int m = 4; m < 8; ++m) { const int i = j + 512 * m; const bool z = (i == 2048); const int r = z ? 0 : 4096 - i; const float a = hb0[r], b = hb1[r]; ra[m] = z ? 0.f : a; ia[m] = z ? 0.f : b; }
            hy_fwd_store<4096>(BA, TW, j, ra, ia); __syncthreads();
            hy_fwd_stage<512>(BA, TW, j); __syncthreads();
            hy_fwd_stage<64>(BA, TW, j); __syncthreads();
            hy_last_fwd(BA, j); __syncthreads();
            hy_separate(BA, K1, K2, j); __syncthreads();
        }
        const float vw0 = cw[c], vw1 = cw[3072 + c], vw2 = cw[6144 + c], vcb = cb[c];
        const float aw0 = cw[1024 + c], aw1 = cw[3072 + 1024 + c], aw2 = cw[6144 + 1024 + c], acb = cb[1024 + c];
        const float bw0 = cw[2048 + c], bw1 = cw[3072 + 2048 + c], bw2 = cw[6144 + 2048 + c], bcb = cb[2048 + c];
        const float sk0 = skip[c], sk1 = skip[1024 + c];
#pragma unroll 1
        for (int pp = 0; pp < 2; ++pp) {
            const int boff = (4 * pp) * SEQ;
            asm volatile("" : "+v"(j));
            Raw3 rg[4][4];
            float v[4][4];
#pragma unroll
            for (int b = 0; b < 4; ++b)
#pragma unroll
                for (int m = 0; m < 4; ++m) { const Raw3 r = raw3(zv + boff + b * SEQ, j + 512 * m); v[b][m] = sconv_raw(r, j + 512 * m, vw0, vw1, vw2, vcb); }
#pragma unroll
            for (int m = 0; m < 4; ++m) { ra[m] = v[0][m]; ia[m] = v[1][m]; rb[m] = v[2][m]; ib[m] = v[3][m]; ra[m + 4] = 0.f; ia[m + 4] = 0.f; rb[m + 4] = 0.f; ib[m + 4] = 0.f; }
            hy_fwd_store<4096>(BA, TW, j, ra, ia); hy_fwd_store<4096>(BB, TW, j, rb, ib); __syncthreads();
            hy_fwd_stage<512>(BA, TW, j); hy_fwd_stage<512>(BB, TW, j); __syncthreads();
            hy_fwd_stage<64>(BA, TW, j); hy_fwd_stage<64>(BB, TW, j); __syncthreads();
            hy_mid_stage(BA, K1, j); hy_mid_stage(BB, K1, j); __syncthreads();
#pragma unroll
            for (int b = 0; b < 4; ++b)
#pragma unroll
                for (int m = 0; m < 4; ++m) rg[b][m] = raw3(za + boff + b * SEQ, j + 512 * m);
            hy_inv_stage<64>(BA, TW, j); hy_inv_stage<64>(BB, TW, j); __syncthreads();
            hy_inv_stage<512>(BA, TW, j); hy_inv_stage<512>(BB, TW, j); __syncthreads();
            hy_inv_regs<4096>(BA, TW, j, ra, ia); hy_inv_regs<4096>(BB, TW, j, rb, ib);
#pragma unroll
            for (int m = 0; m < 4; ++m) { const int t = j + 512 * m;
                v[0][m] = sconv_raw(rg[0][m], t, aw0, aw1, aw2, acb) * (ra[m] + sk0 * v[0][m]); v[1][m] = sconv_raw(rg[1][m], t, aw0, aw1, aw2, acb) * (ia[m] + sk0 * v[1][m]);
                v[2][m] = sconv_raw(rg[2][m], t, aw0, aw1, aw2, acb) * (rb[m] + sk0 * v[2][m]); v[3][m] = sconv_raw(rg[3][m], t, aw0, aw1, aw2, acb) * (ib[m] + sk0 * v[3][m]); }
#pragma unroll
            for (int m = 0; m < 4; ++m) { ra[m] = v[0][m]; ia[m] = v[1][m]; rb[m] = v[2][m]; ib[m] = v[3][m]; ra[m + 4] = 0.f; ia[m + 4] = 0.f; rb[m + 4] = 0.f; ib[m + 4] = 0.f; }
            hy_fwd_store<4096>(BA, TW, j, ra, ia); hy_fwd_store<4096>(BB, TW, j, rb, ib); __syncthreads();
            hy_fwd_stage<512>(BA, TW, j); hy_fwd_stage<512>(BB, TW, j); __syncthreads();
            hy_fwd_stage<64>(BA, TW, j); hy_fwd_stage<64>(BB, TW, j); __syncthreads();
            hy_mid_stage(BA, K2, j); hy_mid_stage(BB, K2, j); __syncthreads();
#pragma unroll
            for (int b = 0; b < 4; ++b)
#pragma unroll
                for (int m = 0; m < 4; ++m) rg[b][m] = raw3(zb + boff + b * SEQ, j + 512 * m);
            hy_inv_stage<64>(BA, TW, j); hy_inv_stage<64>(BB, TW, j); __syncthreads();
            hy_inv_stage<512>(BA, TW, j); hy_inv_stage<512>(BB, TW, j); __syncthreads();
            hy_inv_regs<4096>(BA, TW, j, ra, ia); hy_inv_regs<4096>(BB, TW, j, rb, ib);
#pragma unroll
            for (int m = 0; m < 4; ++m) { const int t = j + 512 * m; bf16* yp = YT + (size_t)c * MTOK + boff + t;
                yp[0] = (bf16)f2bf(sconv_raw(rg[0][m], t, bw0, bw1, bw2, bcb) * (ra[m] + sk1 * v[0][m]));
                yp[SEQ] = (bf16)f2bf(sconv_raw(rg[1][m], t, bw0, bw1, bw2, bcb) * (ia[m] + sk1 * v[1][m]));
                yp[2 * SEQ] = (bf16)f2bf(sconv_raw(rg[2][m], t, bw0, bw1, bw2, bcb) * (rb[m] + sk1 * v[2][m]));
                yp[3 * SEQ] = (bf16)f2bf(sconv_raw(rg[3][m], t, bw0, bw1, bw2, bcb) * (ib[m] + sk1 * v[3][m])); }
        }
        __syncthreads();
    }
}

__device__ __forceinline__ void p3c_transpose(Frame& F) {
    constexpr int LD = 264;
    LAS bf16* tile = (LAS bf16*)F.lds;
    const bf16* YT = (const bf16*)(F.ws + WS_YT); bf16* AB = (bf16*)(F.ws + WS_H);
    const int tid = F.tid;
    for (int it = blockIdx.x; it < 16 * 64; it += F.G) {
        const int c0 = (it >> 6) * 64, t0 = (it & 63) * 256;
        { const int c = tid >> 3, ts = (tid & 7) * 32; const bf16* src = YT + (size_t)(c0 + c) * MTOK + t0 + ts;
          v4u w[4];
#pragma unroll
          for (int k = 0; k < 4; ++k) w[k] = *(const v4u*)(src + 8 * k);
#pragma unroll
          for (int k = 0; k < 4; ++k) *(LAS v4u*)(tile + c * LD + ts + 8 * k) = w[k]; }
        __syncthreads();
        { const int t = tid >> 1, cs = (tid & 1) * 32; unsigned o[16];
#pragma unroll
          for (int i = 0; i < 16; ++i) o[i] = (unsigned)tile[(cs + 2 * i) * LD + t] | ((unsigned)tile[(cs + 2 * i + 1) * LD + t] << 16);
          bf16* dst = AB + (size_t)(t0 + t) * DM + 1024 + c0 + cs;
#pragma unroll
          for (int k = 0; k < 4; ++k) *(v4u*)(dst + 8 * k) = (v4u){o[4 * k], o[4 * k + 1], o[4 * k + 2], o[4 * k + 3]}; }
        __syncthreads();
    }
}

template <bool FINAL> __device__ __forceinline__ void ln_rows(Frame& F) {
    float* R = F.out; const float* st = (const float*)(F.ws + (FINAL ? WS_ST2 : WS_ST1)); float* MU = (float*)(F.ws + WS_MU1);
    const float* mod = (const float*)(F.ws + WS_MOD); bf16* H2 = (bf16*)(F.ws + WS_H);
    const float* lng = F.in[FINAL ? I_LN2G : I_LN1G]; const float* lnb = F.in[FINAL ? I_LN2B : I_LN1B];
    const int gw = blockIdx.x * NWAVES + F.wave, NGW = F.G * NWAVES, lane = F.lane;
    for (int row = gw; row < MTOK; row += NGW) {
        float s = 0.f, q = 0.f; if (lane < 32) { const f32x2 p = *(const f32x2*)(st + ((size_t)row * 32 + lane) * 2); s = p.x; q = p.y; }
        s = wave_sum(s); q = wave_sum(q);
        const float mean = s * (1.0f / DM); float var = q * (1.0f / DM) - mean * mean; var = var > 0.f ? var : 0.f; const float rstd = 1.0f / sqrtf(var + LN_EPS);
        if (!FINAL && lane == 0) *(f32x2*)(MU + (size_t)row * 2) = (f32x2){mean, rstd};
        const int b = row >> 11; float* rp = R + (size_t)row * DM;
#pragma unroll
        for (int j = 0; j < 8; ++j) { const int col = 4 * lane + 256 * j;
            const f32x4 v = *(const f32x4*)(rp + col); const f32x4 y = (v - mean) * rstd * *(const f32x4*)(lng + col) + *(const f32x4*)(lnb + col);
            if (FINAL) *(f32x4*)(rp + col) = y;
            else { const float* mp = mod + (size_t)b * MODW + col; const f32x4 h = y * (*(const f32x4*)(mp + 4 * DM) + 1.0f) + *(const f32x4*)(mp + 3 * DM);
                   v2u o; o.x = pk2(h[0], h[1]); o.y = pk2(h[2], h[3]); *(v2u*)(H2 + (size_t)row * DM + col) = o; } }
    }
}

typedef GAS unsigned gu32;
#define RLX_AGENT __ATOMIC_RELAXED, __HIP_MEMORY_SCOPE_AGENT
constexpr int LDSCTL_OFF = 163840 - 512, MISC_OFF = LDSCTL_OFF;
constexpr int CW_BAR = 4096;
constexpr size_t CTL_ZERO_BYTES = 65536;
#define XB_TMO      128
#define XB_XCNT(j)  (256  + 64 * (j))
#define XB_XSUB(j)  (1280 + 64 * (j))
#define XB_XGEN(j)  (2304 + 64 * (j))
#define XB_TOP      3328
#define XB_TOPGEN   3392
#define XCD_BAR_WORDS 3456
#define XB_SPIN_CAP (1u << 18)

__device__ __forceinline__ unsigned xb_ld(unsigned* p)              { return __hip_atomic_load(p, __ATOMIC_RELAXED, __HIP_MEMORY_SCOPE_AGENT); }
__device__ __forceinline__ unsigned xb_add(unsigned* p, unsigned v) { return __hip_atomic_fetch_add(p, v, __ATOMIC_RELAXED, __HIP_MEMORY_SCOPE_AGENT); }
__device__ __forceinline__ unsigned xb_xcc_id() { return (unsigned)__builtin_amdgcn_s_getreg((3 << 11) | 20) & 0xFu; }
#define XB_SPIN(cond, bar) do { unsigned _sp = 0; while (cond) { __builtin_amdgcn_s_sleep(1); \
    if ((++_sp & 255u) == 0u) { if (xb_ld(&(bar)[XB_TMO])) break; if (_sp > XB_SPIN_CAP) { atomicAdd(&(bar)[XB_TMO], 1u); break; } } } } while (0)

struct XcdBarrier {
    unsigned* bar; unsigned x;
    volatile LAS unsigned* st;
};

__device__ __forceinline__ XcdBarrier xcd_barrier_post(unsigned* bar, volatile LAS unsigned* st) {
    XcdBarrier b; b.bar = bar; b.x = xb_xcc_id(); b.st = st;
    if (threadIdx.x == 0) (void)xb_add(&bar[XB_XCNT(b.x)], 1u);
    return b;
}
__device__ __forceinline__ void xcd_barrier_complete(unsigned* bar, unsigned x, unsigned& nloc, unsigned& nx) {
    const unsigned G = gridDim.x * gridDim.y * gridDim.z;
    unsigned sum, cnt, mine, sp = 0u;
    for (;;) {
        sum = 0u; cnt = 0u; mine = 0u;
#pragma unroll
        for (unsigned j = 0; j < 16; ++j) { const unsigned c = xb_ld(&bar[XB_XCNT(j)]); sum += c; cnt += (c > 0u) ? 1u : 0u; mine = (j == x) ? c : mine; }
        if (sum == G) break;
        __builtin_amdgcn_s_sleep(1);
        if ((++sp & 255u) == 0u) { if (xb_ld(&bar[XB_TMO])) break; if (sp > XB_SPIN_CAP) { atomicAdd(&bar[XB_TMO], 1u); break; } }
    }
    nloc = mine > 0u ? mine : 1u; nx = cnt > 0u ? cnt : 1u;
}

__device__ __forceinline__ void xcd_barrier(const XcdBarrier& b) {
    asm volatile("s_waitcnt vmcnt(0)" ::: "memory");
    __syncthreads();
    if (threadIdx.x == 0) {
        unsigned* bar = b.bar;
        __builtin_amdgcn_s_waitcnt(0);
        unsigned nloc = b.st[0], nx = b.st[1];
        if (nloc == 0u) { xcd_barrier_complete(bar, b.x, nloc, nx); b.st[0] = nloc; b.st[1] = nx; }
        const unsigned old = xb_add(&bar[XB_XSUB(b.x)], 1u);
        const unsigned gen = old / nloc;
        if (old + 1u == (gen + 1u) * nloc) {
            __builtin_amdgcn_fence(__ATOMIC_RELEASE, "agent");
            asm volatile("s_waitcnt vmcnt(0)" ::: "memory");
            const unsigned og = xb_add(&bar[XB_TOP], 1u);
            const unsigned tg = og / nx;
            if (og + 1u == (tg + 1u) * nx) xb_add(&bar[XB_TOPGEN], 1u);
            else XB_SPIN(xb_ld(&bar[XB_TOPGEN]) == tg, bar);
            __builtin_amdgcn_fence(__ATOMIC_ACQUIRE, "agent");
            xb_add(&bar[XB_XGEN(b.x)], 1u);
            asm volatile("s_waitcnt vmcnt(0)" ::: "memory");
        } else {
            XB_SPIN(xb_ld(&bar[XB_XGEN(b.x)]) == gen, bar);
            __builtin_amdgcn_fence(__ATOMIC_ACQUIRE, "agent");
            asm volatile("s_waitcnt vmcnt(0)" ::: "memory");
        }
    }
    __syncthreads();
}

#define GRID_SYNC() xcd_barrier(bar)

__global__ void __launch_bounds__(NWAVES * 64, 2) fwd_megakernel(Args args) {
    extern __shared__ __attribute__((aligned(16))) unsigned char lds[];
    Frame F;
    F.lds = (LAS unsigned char*)lds;
    F.tid = threadIdx.x; F.lane = F.tid & 63; F.wave = __builtin_amdgcn_readfirstlane(F.tid >> 6); F.G = gridDim.x;
    F.in = args.in; F.out = args.out; F.ws = args.ws;
    for (int u = F.tid; u < (LDS_BYTES - LDSCTL_OFF) / 4; u += NWAVES * 64) ((LAS unsigned*)(F.lds + LDSCTL_OFF))[u] = 0u;
    __syncthreads();
    XcdBarrier bar = xcd_barrier_post((unsigned*)(args.ws + WS_CTL) + CW_BAR, (volatile LAS unsigned*)(F.lds + MISC_OFF) + 8);
    unsigned char* ws = args.ws;
    const int lo = args.ph_lo, hi = args.ph_hi;
#define IN(k) (lo <= (k) && (k) < hi)
#define BOTH(k) (IN(k) && IN((k) + 1))
    const int gw = blockIdx.x * NWAVES + F.wave, NGW = F.G * NWAVES;

    PB_START(1, F.lds);
    if (IN(0)) {
        PB_START(21, F.lds); p0_mod(F); PB_END(21, F.lds);
        PB_START(22, F.lds);
        transpose_matrix(F, F.in[I_WIN], DM, INW, (bf16*)(ws + WS_WIN), DM, 0, 1, (int)blockIdx.x, F.G);
        transpose_matrix(F, F.in[I_WA], SGUW, DM, (bf16*)(ws + WS_WAB), DM, 0, 0, (int)((blockIdx.x + 128) % F.G), F.G);
        transpose_matrix(F, F.in[I_WB], HYW, DM, (bf16*)(ws + WS_WAB), DM, 1024, 0, (int)blockIdx.x, F.G);
        transpose_matrix(F, F.in[I_WO], DM, DM, (bf16*)(ws + WS_WO), DM, 0, 0, (int)blockIdx.x, F.G);
        { const float* sw = F.in[I_SW]; bf16* sgw = (bf16*)(ws + WS_SGW);
          for (int i = blockIdx.x * (NWAVES * 64) + F.tid; i < 8 * 128 * 128 / 2; i += F.G * NWAVES * 64) { const f32x2 v = *(const f32x2*)(sw + 2 * i); *(unsigned*)(sgw + 2 * i) = pk2(v.x, v.y); } }
        __syncthreads();
        PB_END(22, F.lds); PB_START(23, F.lds);
        p0_filter(F);
        PB_END(23, F.lds);
        if (BOTH(0)) GRID_SYNC();
    }
    PB_END(1, F.lds);
    PB_START(2, F.lds);
    if (IN(1)) { p1_modulate(F); if (BOTH(1)) GRID_SYNC(); }
    PB_END(2, F.lds);
    PB_START(3, F.lds);
    if (IN(2)) {
        { pg8::Gemm g{(const pg8::bf16_t*)(ws + WS_H), (const pg8::bf16_t*)(ws + WS_WIN), MTOK, 5120, DM}; pg8::StaticOrder S; S.init(MTOK, 5120, F.G, (int)blockIdx.x);
          pg8::EpiG1 E{(pg8::bf16_t*)(ws + WS_U), (pg8::bf16_t*)(ws + WS_G), F.in[I_BIN]};
          pg8::gemm_phase<pg8::EpiG1, pg8::StaticOrder, true, true>(F.lds, g, S, E); }
        __syncthreads();
        { pg8::Gemm g{(const pg8::bf16_t*)(ws + WS_WIN) + (size_t)5120 * DM, (const pg8::bf16_t*)(ws + WS_H), 4096, MTOK, DM}; pg8::StaticOrder S; S.init(4096, MTOK, F.G, (int)blockIdx.x);
          pg8::EpiG1T E{(pg8::bf16_t*)(ws + WS_V), (pg8::bf16_t*)(ws + WS_ZHT), F.in[I_BIN], (float*)(ws + WS_STV)};
          pg8::gemm_phase<pg8::EpiG1T, pg8::StaticOrder, true, true>(F.lds, g, S, E); }
        if (BOTH(2)) GRID_SYNC();
    }
    PB_END(3, F.lds);
    PB_START(4, F.lds);
    if (IN(3)) { __syncthreads(); PB_START(41, F.lds); p3_sgu(F); PB_END(41, F.lds); PB_START(42, F.lds); p3_hyena_fft(F); PB_END(42, F.lds); if (BOTH(3)) GRID_SYNC(); PB_START(43, F.lds); p3c_transpose(F); GRID_SYNC(); PB_END(43, F.lds); }
    PB_END(4, F.lds);
    PB_START(5, F.lds);
    if (IN(4)) {
        pg8::Gemm g{(const pg8::bf16_t*)(ws + WS_H), (const pg8::bf16_t*)(ws + WS_WAB), MTOK, DM, DM}; pg8::StaticOrder S; S.init(MTOK, DM, F.G, (int)blockIdx.x);
        pg8::EpiG2 E{(const pg8::bf16_t*)(ws + WS_G), (pg8::bf16_t*)(ws + WS_MERGED)};
        pg8::gemm_phase<pg8::EpiG2, pg8::StaticOrder, true, true>(F.lds, g, S, E);
        if (BOTH(4)) GRID_SYNC();
    }
    PB_END(5, F.lds);
    PB_START(6, F.lds);
    if (IN(5)) {
        pg8::Gemm g{(const pg8::bf16_t*)(ws + WS_MERGED), (const pg8::bf16_t*)(ws + WS_WO), MTOK, DM, DM}; pg8::StaticOrder S; S.init(MTOK, DM, F.G, (int)blockIdx.x);
        pg8::EpiRes<true> E{F.in[I_X], F.out, (const float*)(ws + WS_MOD) + 2 * DM, F.in[I_BO], nullptr, nullptr, nullptr, (float*)(ws + WS_ST1)};
        pg8::gemm_phase<pg8::EpiRes<true>, pg8::StaticOrder, true, true>(F.lds, g, S, E);
        if (BOTH(5)) GRID_SYNC();
    }
    PB_END(6, F.lds);
    PB_START(7, F.lds);
    if (IN(6)) {
        __syncthreads();
        ln_rows<false>(F);
        __syncthreads();
        transpose_matrix(F, F.in[I_WM1], DM, DFF, (bf16*)(ws + WS_WM1), DM, 0, 0, (int)blockIdx.x, F.G);
        transpose_matrix(F, F.in[I_WM2], DFF, DM, (bf16*)(ws + WS_WM2), DFF, 0, 0, (int)blockIdx.x, F.G);
        if (BOTH(6)) GRID_SYNC();
    }
    PB_END(7, F.lds);
    PB_START(8, F.lds);
    if (IN(7)) {
        __syncthreads();
        pg8::Gemm g{(const pg8::bf16_t*)(ws + WS_H), (const pg8::bf16_t*)(ws + WS_WM1), MTOK, DFF, DM}; pg8::StaticOrder S; S.init(MTOK, DFF, F.G, (int)blockIdx.x);
        pg8::EpiG4 E{(pg8::bf16_t*)(ws + WS_AFF), F.in[I_BM1]};
        pg8::gemm_phase<pg8::EpiG4, pg8::StaticOrder, true, true>(F.lds, g, S, E);
        if (BOTH(7)) GRID_SYNC();
    }
    PB_END(8, F.lds);
    PB_START(9, F.lds);
    if (IN(8)) {
        pg8::Gemm g{(const pg8::bf16_t*)(ws + WS_AFF), (const pg8::bf16_t*)(ws + WS_WM2), MTOK, DM, DFF}; pg8::StaticOrder S; S.init(MTOK, DM, F.G, (int)blockIdx.x);
        pg8::EpiRes<false> E{nullptr, F.out, (const float*)(ws + WS_MOD) + 5 * DM, F.in[I_BM2], F.in[I_LN1G], F.in[I_LN1B], (const float*)(ws + WS_MU1), (float*)(ws + WS_ST2)};
        pg8::gemm_phase<pg8::EpiRes<false>, pg8::StaticOrder, true, true>(F.lds, g, S, E);
        if (BOTH(8)) GRID_SYNC();
    }
    PB_END(9, F.lds);
    PB_START(10, F.lds);
    if (IN(9)) { ln_rows<true>(F); }
    PB_END(10, F.lds);
    if (PROBE_ID != 0 && blockIdx.x == 0 && threadIdx.x == 0) { const unsigned long long wait_ = *(volatile LAS unsigned long long*)(F.lds + PB_LDS_OFF), t0_ = __builtin_amdgcn_s_memrealtime();
        while (__builtin_amdgcn_s_memrealtime() - t0_ < wait_) __builtin_amdgcn_s_sleep(8); }
#undef IN
#undef BOTH
}

constexpr int N_PHASES = 10;
#ifndef MK_N_LAUNCHES
#define MK_N_LAUNCHES 1
#endif
extern "C" void kernel_launch(void* const* d_in, const int* in_sizes, int n_in, void* d_out, int out_size, void* d_ws, size_t ws_size, hipStream_t stream) {
    static int grid = 0;
    if (grid == 0) {
        if (n_in != 31 || in_sizes[0] != MTOK * DM || out_size != MTOK * DM || ws_size < WS_END) {
            fprintf(stderr, "kernel_launch: unexpected problem: n_in %d in0 %d out %d ws %zu (need %zu)\n", n_in, n_in > 0 ? in_sizes[0] : -1, out_size, ws_size, (size_t)WS_END); grid = -1; return; }
        int dev = 0, cus = 0, per_cu = 0;
        if (hipGetDevice(&dev) != hipSuccess || hipDeviceGetAttribute(&cus, hipDeviceAttributeMultiprocessorCount, dev) != hipSuccess) { grid = -1; return; }
        if (hipFuncSetAttribute((const void*)fwd_megakernel, hipFuncAttributeMaxDynamicSharedMemorySize, LDS_BYTES) != hipSuccess) { fprintf(stderr, "kernel_launch: hipFuncSetAttribute failed\n"); grid = -1; return; }
        if (hipOccupancyMaxActiveBlocksPerMultiprocessor(&per_cu, (const void*)fwd_megakernel, NWAVES * 64, LDS_BYTES) != hipSuccess || per_cu < 1) { fprintf(stderr, "kernel_launch: occupancy query says %d\n", per_cu); per_cu = 1; }
        (void)hipGetLastError();
        grid = cus;
    }
    if (grid < 0) return;
    if (hipMemsetAsync((char*)d_ws + WS_CTL, 0, CTL_ZERO_BYTES, stream) != hipSuccess) { fprintf(stderr, "kernel_launch: memset failed\n"); return; }
    Args a{};
    for (int i = 0; i < 31; ++i) a.in[i] = (const float*)d_in[i];
    a.out = (float*)d_out; a.ws = (unsigned char*)d_ws;
    if (MK_N_LAUNCHES == 1) {
        a.ph_lo = 0; a.ph_hi = N_PHASES;
        void* kargs[] = {&a};
        hipError_t e = hipLaunchCooperativeKernel((const void*)fwd_megakernel, dim3(grid), dim3(NWAVES * 64), kargs, LDS_BYTES, stream);
        if (e != hipSuccess) fprintf(stderr, "kernel_launch: cooperative launch failed: %s (grid %d)\n", hipGetErrorString(e), grid);
    } else {
        for (int p = 0; p < N_PHASES; ++p) { a.ph_lo = p; a.ph_hi = p + 1; hipLaunchKernelGGL(fwd_megakernel, dim3(grid), dim3(NWAVES * 64), LDS_BYTES, stream, a); }
    }
}
```

```cpp
#include <hip/hip_runtime.h>
#include <cstdio>
#include <cstdint>

#ifndef PROBE_ID
#define PROBE_ID 0
#endif
#define PB_LDS_OFF (163840 - 512 + 128)
#define PB_START(id, ldsp) do { if (PROBE_ID == (id) && blockIdx.x == 0 && threadIdx.x == 0) { *(volatile __attribute__((address_space(3))) unsigned long long*)((ldsp) + PB_LDS_OFF + 8) = __builtin_amdgcn_s_memrealtime(); } } while (0)
#define PB_END(id, ldsp) do { if (PROBE_ID == (id) && blockIdx.x == 0 && threadIdx.x == 0) { volatile __attribute__((address_space(3))) unsigned long long* pb_ = (volatile __attribute__((address_space(3))) unsigned long long*)((ldsp) + PB_LDS_OFF); pb_[0] += __builtin_amdgcn_s_memrealtime() - pb_[1]; } } while (0)
namespace pg8 {
#define PG8_LAS __attribute__((address_space(3)))
typedef unsigned short bf16_t;
typedef short bf16x8 __attribute__((ext_vector_type(8)));
typedef float f32x4 __attribute__((ext_vector_type(4)));
typedef unsigned u32x4 __attribute__((ext_vector_type(4)));
typedef float f32x2 __attribute__((ext_vector_type(2)));
constexpr int EPI_LDS_OFF = 131072;
constexpr int BM = 256, BK = 64, HALF = 128, HTB = HALF * BK * 2  , STAGE_BYTES = 8 * HTB, NXCD = 8, WGM = 8;

__host__ __device__ __forceinline__ int lds_byte(int r, int c) { const int st = (r >> 4) * 2 + (c >> 5), rr = r & 15, cc = c & 31, ob = rr * 64 + cc * 2; return st * 1024 + (ob ^ (((ob >> 9) & 1) << 5)); }
__host__ __device__ __forceinline__ void stage_rc(int b, int& R, int& C) { const int st = b / 1024, sb = b % 1024, swz = sb ^ (((sb >> 9) & 1) << 5); R = (st >> 1) * 16 + swz / 64; C = (st & 1) * 32 + (swz % 64) / 2; }
__host__ __device__ __forceinline__ int perm32(int rho) { const int n = rho >> 4, i = rho & 15; return 8 * (i >> 2) + 4 * n + (i & 3); }

struct Unit { int pm, pn; };
struct Gemm { const bf16_t* A; const bf16_t* Bt; int M, N, K; };

struct StaticOrder {
    int nM, nN, nwg, G, c;
    __host__ __device__ void init(int M, int N, int G_, int c_) { nM = M / BM; nN = N / BM; nwg = nM * nN; G = G_; c = c_; }
    __host__ __device__ bool next(int i, Unit& u) const {
        const long L = (long)i * G + c; if (L >= nwg) return false;
        int wgid = (int)L; { const int q = nwg / NXCD, r = nwg % NXCD, xcd = wgid % NXCD, off = wgid / NXCD; wgid = (xcd < r ? xcd * (q + 1) : r * (q + 1) + (xcd - r) * q) + off; }
        const int nig = WGM * nN, gid = wgid / nig, fm = gid * WGM, gsz = (nM - fm) < WGM ? (nM - fm) : WGM;
        u.pm = fm + ((wgid % nig) % gsz); u.pn = (wgid % nig) / gsz; return true;
    }
    __device__ __forceinline__ void a_ready(const Unit&) const {}
    __device__ __forceinline__ void done(const Unit&) const {}
};

__device__ __forceinline__ unsigned cvt_pk_bf16(float lo, float hi) { unsigned r; asm volatile("v_cvt_pk_bf16_f32 %0, %1, %2" : "=v"(r) : "v"(lo), "v"(hi)); return r; }
__device__ __forceinline__ f32x2 gelu_pk(f32x2 v) {
    const f32x2 av = __builtin_elementwise_abs(v), d = av * 0.2316418882f + 1.0f;
    f32x2 t; t.x = __builtin_amdgcn_rcpf(d.x); t.y = __builtin_amdgcn_rcpf(d.y);
    f32x2 q = t * 0.5307027145f + (-0.7265760135f); q = q * t + 0.7107068705f; q = q * t + (-0.142248368f); q = q * t + 0.127414796f; q = q * t;
    const f32x2 s = (v * v) * (-0.72134752044f);
    f32x2 e; e.x = __builtin_amdgcn_exp2f(s.x); e.y = __builtin_amdgcn_exp2f(s.y);
    const f32x2 m = v * (q * e), r = v - m;
    f32x2 o; o.x = v.x < 0.f ? m.x : r.x; o.y = v.y < 0.f ? m.y : r.y; return o;
}
__device__ __forceinline__ float bf_lo(unsigned w) { return __uint_as_float(w << 16); }
__device__ __forceinline__ float bf_hi(unsigned w) { return __uint_as_float(w & 0xffff0000u); }
__device__ __forceinline__ float sigmoid_f(float x) { return __builtin_amdgcn_rcpf(1.0f + __expf(-x)); }
}

constexpr int DM = 2048, NBATCH = 8, SEQ = 2048, MTOK = NBATCH * SEQ;
constexpr int SGUW = 1024, HYW = 1024, DFF = 8192, INW = 9216, MODW = 6 * DM;
constexpr float LN_EPS = 1e-5f;
constexpr float DN_ALPHA = 1.189207115002721f;

namespace pg8 {

struct EpiG1 {
    static constexpr bool PERM = true, AFTER_DRAIN = false, MID = false; static constexpr int SLOT_FLOATS = 256;
    bf16_t* U; bf16_t* G; const float* b_in;
    __device__ __forceinline__ void mid(f32x4 (&)[2][2][4][2], const Unit&, int, int, int, int) const {}
    __device__ __forceinline__ void preload(PG8_LAS float* slot, const Unit& u, int tid) const { if (tid < 256) slot[tid] = b_in[(u.pn < 4 ? u.pn * 256 : 5120 + (u.pn - 4) * 256) + tid]; }
    __device__ __forceinline__ void operator()(const f32x4 (&acc)[2][2][4][2], const Unit& u, int wr, int wc, int fr, int fq, const PG8_LAS float* slot) const {
        const int row0 = u.pm * BM + wr * 64 + fr; const int pn = u.pn;
        int ldc, colt; bf16_t* base; const bool isu = pn < 4;
        if (isu) { base = U; ldc = SGUW; colt = pn * 256; }
        else { base = G; ldc = 2 * DM; colt = (pn - 4) * 256; }
        const int cl = wc * 64 + 8 * fq;
        f32x4 bv[2][2];
#pragma unroll
        for (int bj = 0; bj < 2; ++bj)
#pragma unroll
            for (int n = 0; n < 2; ++n) bv[bj][n] = *(const PG8_LAS f32x4*)(slot + cl + bj * 32 + 4 * n);
#pragma unroll
        for (int ai = 0; ai < 2; ++ai)
#pragma unroll
            for (int m = 0; m < 4; ++m) {
                const int row = row0 + ai * HALF + m * 16;
                bf16_t* rowp = base + (size_t)row * ldc + colt + cl;
#pragma unroll
                for (int bj = 0; bj < 2; ++bj) {
                    f32x4 v0 = acc[ai][bj][m][0] + bv[bj][0], v1 = acc[ai][bj][m][1] + bv[bj][1];
                    if (isu) {
                        f32x2 a = gelu_pk((f32x2){v0[0], v0[1]}), b = gelu_pk((f32x2){v0[2], v0[3]}), c = gelu_pk((f32x2){v1[0], v1[1]}), d = gelu_pk((f32x2){v1[2], v1[3]});
                        v0 = (f32x4){a.x, a.y, b.x, b.y}; v1 = (f32x4){c.x, c.y, d.x, d.y};
                    } else {
                        v0 = (f32x4){sigmoid_f(v0[0]), sigmoid_f(v0[1]), sigmoid_f(v0[2]), sigmoid_f(v0[3])};
                        v1 = (f32x4){sigmoid_f(v1[0]), sigmoid_f(v1[1]), sigmoid_f(v1[2]), sigmoid_f(v1[3])};
                    }
                    u32x4 w; w.x = cvt_pk_bf16(v0[0], v0[1]); w.y = cvt_pk_bf16(v0[2], v0[3]); w.z = cvt_pk_bf16(v1[0], v1[1]); w.w = cvt_pk_bf16(v1[2], v1[3]);
                    *(u32x4*)(rowp + bj * 32) = w;
                }
            }
    }
};

struct EpiG1T {
    static constexpr bool PERM = true, AFTER_DRAIN = false, MID = false;
    bf16_t* VT; bf16_t* ZHT; const float* b_in; float* statsV; static constexpr int SLOT_FLOATS = 256;
    __device__ __forceinline__ void mid(f32x4 (&)[2][2][4][2], const Unit&, int, int, int, int) const {}
    __device__ __forceinline__ void preload(PG8_LAS float* slot, const Unit& u, int tid) const { if (tid < 256) slot[tid] = b_in[1024 + u.pm * 256 + tid]; }
    __device__ __forceinline__ void operator()(const f32x4 (&acc)[2][2][4][2], const Unit& u, int wr, int wc, int fr, int fq, const PG8_LAS float* slot) const {
        const int col0 = u.pn * BM + wc * 64 + 8 * fq; const bool isv = u.pm < 4;
        const int rowt = (isv ? u.pm : u.pm - 4) * BM + wr * 64 + fr;
        bf16_t* base = isv ? VT : ZHT;
#pragma unroll
        for (int ai = 0; ai < 2; ++ai) {
            float s[2][8], q[2][8];
#pragma unroll
            for (int bj = 0; bj < 2; ++bj)
#pragma unroll
                for (int e = 0; e < 8; ++e) { s[bj][e] = 0.f; q[bj][e] = 0.f; }
#pragma unroll
            for (int m = 0; m < 4; ++m) {
                const int row = rowt + ai * HALF + m * 16; const float bb = slot[wr * 64 + fr + ai * HALF + m * 16];
                bf16_t* rowp = base + (size_t)row * MTOK + col0;
#pragma unroll
                for (int bj = 0; bj < 2; ++bj) {
                    f32x4 v0 = acc[ai][bj][m][0] + bb, v1 = acc[ai][bj][m][1] + bb;
                    if (isv) {
                        f32x2 a = gelu_pk((f32x2){v0[0], v0[1]}), b = gelu_pk((f32x2){v0[2], v0[3]}), c = gelu_pk((f32x2){v1[0], v1[1]}), d = gelu_pk((f32x2){v1[2], v1[3]});
                        v0 = (f32x4){a.x, a.y, b.x, b.y}; v1 = (f32x4){c.x, c.y, d.x, d.y};
                    }
                    u32x4 w; w.x = cvt_pk_bf16(v0[0], v0[1]); w.y = cvt_pk_bf16(v0[2], v0[3]); w.z = cvt_pk_bf16(v1[0], v1[1]); w.w = cvt_pk_bf16(v1[2], v1[3]);
                    *(u32x4*)(rowp + bj * 32) = w;
                    if (isv) {
                        const float e0 = bf_lo(w.x), e1 = bf_hi(w.x), e2 = bf_lo(w.y), e3 = bf_hi(w.y), e4 = bf_lo(w.z), e5 = bf_hi(w.z), e6 = bf_lo(w.w), e7 = bf_hi(w.w);
                        s[bj][0] += e0; s[bj][1] += e1; s[bj][2] += e2; s[bj][3] += e3; s[bj][4] += e4; s[bj][5] += e5; s[bj][6] += e6; s[bj][7] += e7;
                        q[bj][0] += e0 * e0; q[bj][1] += e1 * e1; q[bj][2] += e2 * e2; q[bj][3] += e3 * e3; q[bj][4] += e4 * e4; q[bj][5] += e5 * e5; q[bj][6] += e6 * e6; q[bj][7] += e7 * e7;
                    }
                }
            }
            if (isv) {
                const int slot = u.pm * 4 + ai * 2 + wr;
#pragma unroll
                for (int bj = 0; bj < 2; ++bj)
#pragma unroll
                    for (int e = 0; e < 8; ++e) {
                        float a = s[bj][e], b = q[bj][e];
                        a += __shfl_xor(a, 1); b += __shfl_xor(b, 1); a += __shfl_xor(a, 2); b += __shfl_xor(b, 2);
                        a += __shfl_xor(a, 4); b += __shfl_xor(b, 4); a += __shfl_xor(a, 8); b += __shfl_xor(b, 8);
                        if (fr == 0) *(f32x2*)(statsV + ((size_t)(col0 + bj * 32 + e) * 16 + slot) * 2) = (f32x2){a, b};
                    }
            }
        }
    }
};

struct EpiG2 {
    static constexpr bool PERM = true, AFTER_DRAIN = false, MID = true;
    const bf16_t* G; bf16_t* O; static constexpr int SLOT_FLOATS = 0;
    __device__ __forceinline__ void preload(PG8_LAS float*, const Unit&, int) const {}
    __device__ __forceinline__ void mid(f32x4 (&acc)[2][2][4][2], const Unit& u, int wr, int wc, int fr, int fq) const {
        int row0 = u.pm * BM + wr * 64 + fr, col0 = u.pn * BM + wc * 64 + 8 * fq;
        asm volatile("" : "+v"(row0), "+v"(col0));
#pragma unroll
        for (int ai = 0; ai < 2; ++ai)
#pragma unroll
            for (int m = 0; m < 4; ++m) {
                const bf16_t* gp = G + (size_t)(row0 + ai * HALF + m * 16) * (2 * DM) + col0;
#pragma unroll
                for (int bj = 0; bj < 2; ++bj) {
                    const u32x4 ga = *(const u32x4*)(gp + bj * 32), gb = *(const u32x4*)(gp + DM + bj * 32);
                    f32x4 r0, r1;
                    r0[0] = bf_lo(ga.x) * __builtin_amdgcn_rcpf(bf_lo(gb.x)); r0[1] = bf_hi(ga.x) * __builtin_amdgcn_rcpf(bf_hi(gb.x));
                    r0[2] = bf_lo(ga.y) * __builtin_amdgcn_rcpf(bf_lo(gb.y)); r0[3] = bf_hi(ga.y) * __builtin_amdgcn_rcpf(bf_hi(gb.y));
                    r1[0] = bf_lo(ga.z) * __builtin_amdgcn_rcpf(bf_lo(gb.z)); r1[1] = bf_hi(ga.z) * __builtin_amdgcn_rcpf(bf_hi(gb.z));
                    r1[2] = bf_lo(ga.w) * __builtin_amdgcn_rcpf(bf_lo(gb.w)); r1[3] = bf_hi(ga.w) * __builtin_amdgcn_rcpf(bf_hi(gb.w));
                    acc[ai][bj][m][0] *= r0; acc[ai][bj][m][1] *= r1;
                }
            }
    }
    __device__ __forceinline__ void operator()(const f32x4 (&acc)[2][2][4][2], const Unit& u, int wr, int wc, int fr, int fq, const PG8_LAS float*) const {
        const int row0 = u.pm * BM + wr * 64 + fr, col0 = u.pn * BM + wc * 64 + 8 * fq;
#pragma unroll
        for (int ai = 0; ai < 2; ++ai)
#pragma unroll
            for (int m = 0; m < 4; ++m) {
                const int row = row0 + ai * HALF + m * 16;
                const bf16_t* gp = G + (size_t)row * (2 * DM) + DM + col0;
                bf16_t* op = O + (size_t)row * DM + col0;
#pragma unroll
                for (int bj = 0; bj < 2; ++bj) {
                    const u32x4 gb = *(const u32x4*)(gp + bj * 32);
                    const f32x4 a0 = acc[ai][bj][m][0], a1 = acc[ai][bj][m][1];
                    u32x4 w; w.x = cvt_pk_bf16(a0[0] * bf_lo(gb.x), a0[1] * bf_hi(gb.x)); w.y = cvt_pk_bf16(a0[2] * bf_lo(gb.y), a0[3] * bf_hi(gb.y));
                    w.z = cvt_pk_bf16(a1[0] * bf_lo(gb.z), a1[1] * bf_hi(gb.z)); w.w = cvt_pk_bf16(a1[2] * bf_lo(gb.w), a1[3] * bf_hi(gb.w));
                    *(u32x4*)(op + bj * 32) = w;
                }
            }
    }
};

template <bool FIRST> struct EpiRes {
    static constexpr bool PERM = false, AFTER_DRAIN = false, MID = false; static constexpr int SLOT_FLOATS = FIRST ? 512 : 1024;
    const float* X;
    float* R;
    const float* gate;
    const float* bias;
    const float* lng; const float* lnb; const float* MU;
    float* stats;
    __device__ __forceinline__ void mid(f32x4 (&)[2][2][4][2], const Unit&, int, int, int, int) const {}
    __device__ __forceinline__ void preload(PG8_LAS float* slot, const Unit& u, int tid) const {
        const int c = tid & 255, col = u.pn * BM + c;
        if (tid < 256) slot[c] = gate[(size_t)(u.pm >> 3) * MODW + col]; else slot[256 + c] = bias[col];
        if (!FIRST) { if (tid < 256) slot[512 + c] = DN_ALPHA * lng[col]; else slot[768 + c] = DN_ALPHA * lnb[col]; }
    }
    __device__ __forceinline__ void operator()(const f32x4 (&acc)[2][2][4][2], const Unit& u, int wr, int wc, int fr, int fq, const PG8_LAS float* slot) const {
        int row0 = u.pm * BM + wr * 64 + fr; const int cl = wc * 32 + 4 * fq; int col0 = u.pn * BM + cl;
        asm volatile("" : "+v"(row0), "+v"(col0));
        constexpr int RB = FIRST ? 2 : 1;
#pragma unroll
        for (int ab = 0; ab < 8 / RB; ++ab) {
            const int ai = (ab * RB) >> 2, mb = (ab * RB) & 3;
            f32x4 base[RB][2][2]; f32x2 mr[RB];
            int rowb = row0 + ai * HALF + mb * 16; asm volatile("" : "+v"(rowb));
#pragma unroll
            for (int mm = 0; mm < RB; ++mm) {
                const size_t off = (size_t)(rowb + mm * 16) * DM + col0;
                if (!FIRST) mr[mm] = *(const f32x2*)(MU + (size_t)(rowb + mm * 16) * 2);
#pragma unroll
                for (int bj = 0; bj < 2; ++bj)
#pragma unroll
                    for (int n = 0; n < 2; ++n) base[mm][bj][n] = FIRST ? *(const f32x4*)(X + off + bj * HALF + n * 16) : *(const f32x4*)(R + off + bj * HALF + n * 16);
            }
#pragma unroll
            for (int mm = 0; mm < RB; ++mm) {
                const int m = mb + mm;
                const int row = rowb + mm * 16; float* rp = R + (size_t)row * DM + col0;
                float s = 0.f, q = 0.f;
#pragma unroll
                for (int bj = 0; bj < 2; ++bj)
#pragma unroll
                    for (int n = 0; n < 2; ++n) {
                        const int co = bj * HALF + n * 16;
                        const f32x4 gv = *(const PG8_LAS f32x4*)(slot + cl + co), bv = *(const PG8_LAS f32x4*)(slot + 256 + cl + co);
                        f32x4 bs;
                        if (FIRST) bs = base[mm][bj][n] * DN_ALPHA;
                        else bs = (base[mm][bj][n] - mr[mm].x) * mr[mm].y * *(const PG8_LAS f32x4*)(slot + 512 + cl + co) + *(const PG8_LAS f32x4*)(slot + 768 + cl + co);
                        const f32x4 o = bs + gv * (acc[ai][bj][m][n] + bv);
                        *(f32x4*)(rp + co) = o;
                        s += (o[0] + o[1]) + (o[2] + o[3]); q += (o[0] * o[0] + o[1] * o[1]) + (o[2] * o[2] + o[3] * o[3]);
                    }
                s += __shfl_xor(s, 16); s += __shfl_xor(s, 32); q += __shfl_xor(q, 16); q += __shfl_xor(q, 32);
                if (fq == 0) *(f32x2*)(stats + ((size_t)row * 32 + u.pn * 4 + wc) * 2) = (f32x2){s, q};
            }
            asm volatile("" ::: "memory");
        }
    }
};

struct EpiG4 {
    static constexpr bool PERM = true, AFTER_DRAIN = false, MID = false; static constexpr int SLOT_FLOATS = 256;
    bf16_t* O; const float* bias;
    __device__ __forceinline__ void mid(f32x4 (&)[2][2][4][2], const Unit&, int, int, int, int) const {}
    __device__ __forceinline__ void preload(PG8_LAS float* slot, const Unit& u, int tid) const { if (tid < 256) slot[tid] = bias[u.pn * BM + tid]; }
    __device__ __forceinline__ void operator()(const f32x4 (&acc)[2][2][4][2], const Unit& u, int wr, int wc, int fr, int fq, const PG8_LAS float* slot) const {
        const int row0 = u.pm * BM + wr * 64 + fr, cl = wc * 64 + 8 * fq, col0 = u.pn * BM + cl;
        f32x4 bv[2][2];
#pragma unroll
        for (int bj = 0; bj < 2; ++bj)
#pragma unroll
            for (int n = 0; n < 2; ++n) bv[bj][n] = *(const PG8_LAS f32x4*)(slot + cl + bj * 32 + 4 * n);
#pragma unroll
        for (int ai = 0; ai < 2; ++ai)
#pragma unroll
            for (int m = 0; m < 4; ++m) {
                bf16_t* rowp = O + (size_t)(row0 + ai * HALF + m * 16) * DFF + col0;
#pragma unroll
                for (int bj = 0; bj < 2; ++bj) {
                    f32x4 v0 = acc[ai][bj][m][0] + bv[bj][0], v1 = acc[ai][bj][m][1] + bv[bj][1];
                    v0 = __builtin_elementwise_max(v0, (f32x4){0.f, 0.f, 0.f, 0.f}); v1 = __builtin_elementwise_max(v1, (f32x4){0.f, 0.f, 0.f, 0.f});
                    v0 = v0 * v0; v1 = v1 * v1;
                    u32x4 w; w.x = cvt_pk_bf16(v0[0], v0[1]); w.y = cvt_pk_bf16(v0[2], v0[3]); w.z = cvt_pk_bf16(v1[0], v1[1]); w.w = cvt_pk_bf16(v1[2], v1[3]);
                    *(u32x4*)(rowp + bj * 32) = w;
                }
            }
    }
};
}
namespace pg8 {
template <class Epi, class Sched, bool ALIGN_EPI = false, bool SP2 = false>
__device__ __forceinline__ void gemm_phase(PG8_LAS unsigned char* lds, const Gemm g, const Sched& S, const Epi& E) {
    const int tid = threadIdx.x, wid = __builtin_amdgcn_readfirstlane(tid >> 6), lane = tid & 63, wr = wid >> 2, wc = wid & 3, fr = lane & 15, fq = lane >> 4;
    const int K = g.K, nt = K / BK;
    unsigned voffA[2], voffB[2];
#pragma unroll
    for (int i = 0; i < 2; ++i) { int R, C; stage_rc(tid * 16 + i * 8192, R, C); const int Rb = Epi::PERM ? ((R & ~31) + perm32(R & 31)) : R;
        const int Rw = Epi::PERM ? ((R >> 5) * 64 + perm32(R & 31)) : R;
        voffA[i] = (unsigned)(R * K + C) * 2u; voffB[i] = (unsigned)(Rw * K + C) * 2u; (void)Rb; }
    const size_t kstep = (size_t)(BK * 2);
    const size_t hstep = (size_t)HALF * K * 2;
    const size_t tstep = 2 * hstep;
    const size_t hstepB = Epi::PERM ? (size_t)32 * K * 2 : hstep;
    const unsigned ldsw = (unsigned)wid * 1024u;
    const int aoff = lds_byte(wr * 64 + fr, fq * 8), boff = lds_byte(wc * 32 + fr, fq * 8);
#define PG8_SA(b, h) (((b) * 2 + (h)) * HTB)
#define PG8_SB(b, h) ((4 + (b) * 2 + (h)) * HTB)
#define PG8_STAGE(bufoff, gbase, voff) do { _Pragma("unroll") for (int _i = 0; _i < 2; ++_i) \
        __builtin_amdgcn_global_load_lds((const unsigned*)((const char*)(gbase) + (voff)[_i]), (PG8_LAS unsigned*)(lds + (bufoff) + ldsw + _i * 8192), 16, 0, 0); } while (0)
#define PG8_LDA(dst, b, h) do { _Pragma("unroll") for (int m = 0; m < 4; ++m) _Pragma("unroll") for (int k = 0; k < 2; ++k) dst[m][k] = *(const PG8_LAS bf16x8*)(lds + PG8_SA(b, h) + aoff + m * 2048 + k * 1024); } while (0)
#define PG8_LDB(dst, b, h) do { _Pragma("unroll") for (int n = 0; n < 2; ++n) _Pragma("unroll") for (int k = 0; k < 2; ++k) dst[n][k] = *(const PG8_LAS bf16x8*)(lds + PG8_SB(b, h) + boff + n * 2048 + k * 1024); } while (0)
#define PG8_MMA(ai, bj, At, Bt) do { __builtin_amdgcn_s_setprio(1); _Pragma("unroll") for (int m = 0; m < 4; ++m) _Pragma("unroll") for (int n = 0; n < 2; ++n) _Pragma("unroll") for (int k = 0; k < 2; ++k) \
        acc[ai][bj][m][n] = __builtin_amdgcn_mfma_f32_16x16x32_bf16(Bt[n][k], At[m][k], acc[ai][bj][m][n], 0, 0, 0); __builtin_amdgcn_s_setprio(0); } while (0)
#define PG8_WAIT_V(n) asm volatile("s_waitcnt vmcnt(" #n ")" ::: "memory")
#define PG8_WAIT_L(n) asm volatile("s_waitcnt lgkmcnt(" #n ")" ::: "memory")
#define PG8_BAR __builtin_amdgcn_s_barrier()
#define PG8_SCHED __builtin_amdgcn_sched_barrier(0)
    Unit cur, nxt; int ui = 0;
    if (!S.next(0, cur)) return;
    {
        Unit pu; for (int i = 0; S.next(i, pu); ++i) E.preload((PG8_LAS float*)(lds + EPI_LDS_OFF) + i * Epi::SLOT_FLOATS, pu, tid);
        asm volatile("s_waitcnt vmcnt(0) lgkmcnt(0)" ::: "memory"); __builtin_amdgcn_s_barrier(); asm volatile("" ::: "memory");
    }
    f32x4 acc[2][2][4][2];
#pragma unroll
    for (int a = 0; a < 2; ++a)
#pragma unroll
        for (int b = 0; b < 2; ++b)
#pragma unroll
            for (int m = 0; m < 4; ++m)
#pragma unroll
                for (int n = 0; n < 2; ++n) acc[a][b][m][n] = (f32x4){0.f, 0.f, 0.f, 0.f};
    bf16x8 At[4][2], B0[2][2], B1[2][2];
    const char* cA = (const char*)g.A + (size_t)cur.pm * tstep; const char* cB = (const char*)g.Bt + (size_t)cur.pn * tstep;
    S.a_ready(cur);
    if constexpr (SP2) {
        PG8_STAGE(PG8_SB(0, 0), cB, voffB); PG8_STAGE(PG8_SB(0, 1), cB + hstepB, voffB); PG8_STAGE(PG8_SA(0, 0), cA, voffA); PG8_STAGE(PG8_SA(0, 1), cA + hstep, voffA);
        if (wr == 1) PG8_BAR;
        PG8_WAIT_V(2); PG8_BAR;
        PG8_STAGE(PG8_SB(1, 0), cB + kstep, voffB); PG8_STAGE(PG8_SA(1, 0), cA + kstep, voffA); PG8_STAGE(PG8_SB(1, 1), cB + hstepB + kstep, voffB);
        PG8_WAIT_V(6); PG8_BAR;
    } else {
        PG8_STAGE(PG8_SB(0, 0), cB, voffB); PG8_STAGE(PG8_SA(0, 0), cA, voffA); PG8_STAGE(PG8_SB(0, 1), cB + hstepB, voffB); PG8_STAGE(PG8_SA(0, 1), cA + hstep, voffA);
        if (wr == 1) PG8_BAR;
        PG8_WAIT_V(4); PG8_BAR;
        PG8_STAGE(PG8_SB(1, 0), cB + kstep, voffB); PG8_STAGE(PG8_SA(1, 0), cA + kstep, voffA); PG8_STAGE(PG8_SB(1, 1), cB + hstepB + kstep, voffB);
        PG8_WAIT_V(6); PG8_BAR;
    }
    for (;;) {
        const bool has_next = S.next(ui + 1, nxt);
        const char* nA = has_next ? (const char*)g.A + (size_t)nxt.pm * tstep : cA; const char* nB = has_next ? (const char*)g.Bt + (size_t)nxt.pn * tstep : cB;
        for (int t = 0; t < nt; t += 2) {
            const bool last = (t == nt - 2);
            const char* a1 = cA + (size_t)(t + 1) * kstep;
            const char* a2 = last ? nA : cA + (size_t)(t + 2) * kstep; const char* b2 = last ? nB : cB + (size_t)(t + 2) * kstep;
            const char* a3 = a2 + kstep; const char* b3 = b2 + kstep;
            if (last && has_next) S.a_ready(nxt);
            if constexpr (Epi::MID) { if (t == (nt >> 1)) E.mid(acc, cur, wr, wc, fr, fq); }
            if constexpr (SP2) {
            PG8_LDB(B0, 0, 0); PG8_LDB(B1, 0, 1); PG8_SCHED; PG8_LDA(At, 0, 0); PG8_STAGE(PG8_SA(1, 1), a1 + hstep, voffA);
            PG8_WAIT_V(8); PG8_WAIT_L(0); PG8_BAR; PG8_MMA(0, 0, At, B0); PG8_MMA(0, 1, At, B1); PG8_BAR; PG8_SCHED;
            PG8_LDA(At, 0, 1); PG8_STAGE(PG8_SB(0, 0), b2, voffB); PG8_STAGE(PG8_SB(0, 1), b2 + hstepB, voffB); PG8_STAGE(PG8_SA(0, 0), a2, voffA);
            PG8_WAIT_V(8); PG8_WAIT_L(0); PG8_BAR; PG8_MMA(1, 0, At, B0); PG8_MMA(1, 1, At, B1); PG8_BAR; PG8_SCHED;
            PG8_LDB(B0, 1, 0); PG8_LDB(B1, 1, 1); PG8_SCHED; PG8_LDA(At, 1, 0); PG8_STAGE(PG8_SA(0, 1), a2 + hstep, voffA);
            PG8_WAIT_V(8); PG8_WAIT_L(0); PG8_BAR; PG8_MMA(0, 0, At, B0); PG8_MMA(0, 1, At, B1); PG8_BAR; PG8_SCHED;
            PG8_LDA(At, 1, 1); PG8_STAGE(PG8_SB(1, 0), b3, voffB); PG8_STAGE(PG8_SB(1, 1), b3 + hstepB, voffB); PG8_STAGE(PG8_SA(1, 0), a3, voffA);
            PG8_WAIT_V(8); PG8_WAIT_L(0); PG8_BAR; PG8_MMA(1, 0, At, B0); PG8_MMA(1, 1, At, B1); PG8_BAR; PG8_SCHED;
            } else {
            PG8_LDB(B0, 0, 0); PG8_SCHED; PG8_LDA(At, 0, 0); PG8_STAGE(PG8_SA(1, 1), a1 + hstep, voffA);
            PG8_WAIT_L(8); PG8_BAR; PG8_WAIT_L(0); PG8_MMA(0, 0, At, B0); PG8_BAR; PG8_SCHED;
            PG8_LDB(B1, 0, 1); PG8_STAGE(PG8_SB(0, 0), b2, voffB);
            PG8_BAR; PG8_WAIT_L(0); PG8_MMA(0, 1, At, B1); PG8_BAR;
            PG8_LDA(At, 0, 1); PG8_STAGE(PG8_SA(0, 0), a2, voffA);
            PG8_BAR; PG8_WAIT_L(0); PG8_MMA(1, 0, At, B0); PG8_BAR; PG8_SCHED;
            PG8_STAGE(PG8_SB(0, 1), b2 + hstepB, voffB);
            PG8_WAIT_V(6); PG8_BAR; PG8_MMA(1, 1, At, B1); PG8_BAR;
            PG8_LDB(B0, 1, 0); PG8_SCHED; PG8_LDA(At, 1, 0); PG8_STAGE(PG8_SA(0, 1), a2 + hstep, voffA);
            PG8_WAIT_L(8); PG8_BAR; PG8_WAIT_L(0); PG8_MMA(0, 0, At, B0); PG8_BAR; PG8_SCHED;
            PG8_LDB(B1, 1, 1); PG8_STAGE(PG8_SB(1, 0), b3, voffB);
            PG8_BAR; PG8_WAIT_L(0); PG8_MMA(0, 1, At, B1); PG8_BAR;
            PG8_LDA(At, 1, 1); PG8_STAGE(PG8_SA(1, 0), a3, voffA);
            PG8_BAR; PG8_WAIT_L(0); PG8_MMA(1, 0, At, B0); PG8_BAR; PG8_SCHED;
            PG8_STAGE(PG8_SB(1, 1), b3 + hstepB, voffB);
            PG8_WAIT_V(6); PG8_BAR; PG8_MMA(1, 1, At, B1); PG8_BAR;
            }
        }
        if constexpr (ALIGN_EPI) { if (wr == 0) PG8_BAR; }
        if constexpr (!Epi::AFTER_DRAIN) { E(acc, cur, wr, wc, fr, fq, (const PG8_LAS float*)(lds + EPI_LDS_OFF) + ui * Epi::SLOT_FLOATS); S.done(cur); }
        if (!has_next) break;
#pragma unroll
        for (int a = 0; a < 2; ++a)
#pragma unroll
            for (int b = 0; b < 2; ++b)
#pragma unroll
                for (int m = 0; m < 4; ++m)
#pragma unroll
                    for (int n = 0; n < 2; ++n) acc[a][b][m][n] = (f32x4){0.f, 0.f, 0.f, 0.f};
        cur = nxt; cA = nA; cB = nB; ++ui;
        if constexpr (ALIGN_EPI) { if (wr == 1) PG8_BAR; }
    }
    PG8_WAIT_V(0);
    if constexpr (!ALIGN_EPI) { if (wr == 0) PG8_BAR; }
    PG8_BAR;
    if constexpr (Epi::AFTER_DRAIN) { E.fused(acc, cur, wr, wc, fr, fq, lds, wid, lane); S.done(cur); }
#undef PG8_SA
#undef PG8_SB
#undef PG8_STAGE
#undef PG8_LDA
#undef PG8_LDB
#undef PG8_MMA
#undef PG8_WAIT_V
#undef PG8_WAIT_L
#undef PG8_BAR
#undef PG8_SCHED
}
}

constexpr size_t MiB = 1u << 20;
constexpr size_t WS_CTL = 0;
constexpr size_t WS_MOD = 1 * MiB;
constexpr size_t WS_STV = 2 * MiB;
constexpr size_t WS_ST1 = 4 * MiB;
constexpr size_t WS_ST2 = 8 * MiB;
constexpr size_t WS_MU1 = 12 * MiB;
constexpr size_t WS_HID2 = 14 * MiB;
constexpr size_t WS_SGW = 13 * MiB;
constexpr size_t WS_WIN = 16 * MiB;
constexpr size_t WS_WAB = 52 * MiB;
constexpr size_t WS_WO = 60 * MiB;
constexpr size_t WS_FILT = 68 * MiB;
constexpr size_t WS_WM2 = 68 * MiB;
constexpr size_t WS_H = 100 * MiB;
constexpr size_t WS_U = 164 * MiB;
constexpr size_t WS_V = 196 * MiB;
constexpr size_t WS_MERGED = 164 * MiB;
constexpr size_t WS_ZHT = 228 * MiB;
constexpr size_t WS_G = 324 * MiB;
constexpr size_t WS_AFF = 164 * MiB;
constexpr size_t WS_WM1 = 420 * MiB;
constexpr size_t WS_YT = 452 * MiB;
constexpr size_t WS_END = 484 * MiB;

constexpr int NWAVES = 8;
constexpr int LDS_BYTES = 163840;

#define GAS __attribute__((address_space(1)))
#define LAS __attribute__((address_space(3)))
typedef unsigned short bf16;
typedef unsigned v4u __attribute__((ext_vector_type(4)));
typedef unsigned v2u __attribute__((ext_vector_type(2)));
typedef float f32x4 __attribute__((ext_vector_type(4)));
typedef float f32x2 __attribute__((ext_vector_type(2)));
#define LDS_WAIT() asm volatile("s_waitcnt lgkmcnt(0)" ::: "memory")

__device__ __forceinline__ unsigned f2bf(float f) { unsigned u = __builtin_bit_cast(unsigned, f); return (u + 0x7fffu + ((u >> 16) & 1u)) >> 16; }
__device__ __forceinline__ unsigned pk2(float lo, float hi) { return f2bf(lo) | (f2bf(hi) << 16); }
__device__ __forceinline__ float bflo(unsigned w) { return __uint_as_float(w << 16); }
__device__ __forceinline__ float bfhi(unsigned w) { return __uint_as_float(w & 0xffff0000u); }
__device__ __forceinline__ float bf1(bf16 h) { return __uint_as_float((unsigned)h << 16); }
__device__ __forceinline__ float wave_sum(float v) {
#pragma unroll
    for (int o = 1; o < 64; o <<= 1) v += __shfl_xor(v, o);
    return v;
}

struct Args { const float* in[31]; float* out; unsigned char* ws; int ph_lo, ph_hi; };

struct Frame {
    LAS unsigned char* lds;
    int tid, lane, wave, G;
    const float* const* in; float* out; unsigned char* ws;
};
enum { I_X = 0, I_C, I_WADA, I_BADA, I_WIN, I_BIN, I_SLNG, I_SLNB, I_SW, I_SB, I_HCW, I_HCB, I_HW1, I_HB1, I_HW2, I_HB2, I_HFREQ, I_HW3, I_HSKIP,
       I_WA, I_WB, I_WO, I_BO, I_LN1G, I_LN1B, I_WM1, I_BM1, I_WM2, I_BM2, I_LN2G, I_LN2B };

__device__ __forceinline__ void transpose_matrix(Frame& F, const float* W, int K, int N, bf16* WT, int ldk, int koff, int remap_win, int first, int nblocks) {
    LAS float* tile = (LAS float*)F.lds;
    const int tid = F.tid, nblk = N / 256, nitems = (K / 64) * nblk;
    const int lr = tid >> 6, lc = tid & 63;
    const int wc = tid & 7, wn = tid >> 3;
    for (int it = first; it < nitems; it += nblocks) {
        const int kb = it / nblk, nb = it % nblk, n0 = nb * 256, k0 = kb * 64; int row0 = n0;
        if (remap_win) row0 = (n0 < 1024) ? n0 : (n0 < 2048 ? n0 - 1024 + 5120 : (n0 < 5120 ? n0 - 2048 + 6144 : n0 - 5120 + 1024));
        f32x4 v[8];
#pragma unroll
        for (int i = 0; i < 8; ++i) v[i] = *(const f32x4*)(W + (size_t)(k0 + 8 * i + lr) * N + n0 + 4 * lc);
#pragma unroll
        for (int i = 0; i < 8; ++i) *(LAS f32x4*)(tile + (8 * i + lr) * 256 + ((lc ^ i) << 2)) = v[i];
        __syncthreads();
#pragma unroll
        for (int j = 0; j < 4; ++j) { const int n = wn + 64 * j; const LAS float* sp = tile + (8 * wc) * 256 + ((((n >> 2) ^ wc) << 2) | (n & 3));
            v4u o; o.x = pk2(sp[0 * 256], sp[1 * 256]); o.y = pk2(sp[2 * 256], sp[3 * 256]); o.z = pk2(sp[4 * 256], sp[5 * 256]); o.w = pk2(sp[6 * 256], sp[7 * 256]);
            *(GAS v4u*)(WT + (size_t)(row0 + n) * ldk + koff + k0 + 8 * wc) = o; }
        __syncthreads();
    }
}

__device__ __forceinline__ void p0_mod(Frame& F) {
    LAS float* condS = (LAS float*)F.lds;
    LAS float* red = (LAS float*)(F.lds + 65536);
    const float* c = F.in[I_C]; const float* w_ada = F.in[I_WADA]; const float* b_ada = F.in[I_BADA];
    float* mod = (float*)(F.ws + WS_MOD);
    const int tid = F.tid;
    for (int item = blockIdx.x; item < MODW / 48; item += F.G) {
        for (int i = tid; i < NBATCH * DM; i += NWAVES * 64) { const float v = c[i]; condS[i] = v / (1.0f + __expf(-v)); }
        __syncthreads();
        const int cq = tid % 12, kq = tid / 12, col0 = item * 48;
        if (kq < 32) {
            f32x4 acc[8];
#pragma unroll
            for (int b = 0; b < 8; ++b) acc[b] = (f32x4){0.f, 0.f, 0.f, 0.f};
            const float* wp = w_ada + (size_t)kq * MODW + col0 + cq * 4;
            for (int k = kq; k < DM; k += 256, wp += (size_t)256 * MODW) {
                f32x4 w[8];
#pragma unroll
                for (int u = 0; u < 8; ++u) w[u] = *(const f32x4*)(wp + (size_t)(32 * u) * MODW);
#pragma unroll
                for (int u = 0; u < 8; ++u)
#pragma unroll
                    for (int b = 0; b < 8; ++b) acc[b] += w[u] * condS[b * DM + k + 32 * u];
            }
#pragma unroll
            for (int b = 0; b < 8; ++b) *(LAS f32x4*)(red + (kq * 8 + b) * 48 + cq * 4) = acc[b];
        }
        __syncthreads();
        if (tid < 384) { const int b = tid / 48, col = tid % 48; float s = 0.f;
#pragma unroll 8
          for (int k2 = 0; k2 < 32; ++k2) s += red[(k2 * 8 + b) * 48 + col];
          mod[(size_t)b * MODW + col0 + col] = s + b_ada[col0 + col]; }
        __syncthreads();
    }
}

__device__ __forceinline__ void p0_hid2(Frame& F) {
    LAS float* scr = (LAS float*)F.lds + F.wave * 128;
    const float* w1 = F.in[I_HW1]; const float* b1 = F.in[I_HB1]; const float* w2 = F.in[I_HW2]; const float* b2 = F.in[I_HB2]; const float* freq = F.in[I_HFREQ];
    float* HID2 = (float*)(F.ws + WS_HID2);
    const int lane = F.lane;
    for (int l = blockIdx.x * NWAVES + F.wave; l < SEQ; l += F.G * NWAVES) {
        const float fr = freq[lane];
        const float tl = (float)l / (float)(SEQ - 1), omega = 6.283185307179586f * (float)l / (float)SEQ;
        float f = 0.f;
        if (lane == 0) f = tl;
        else if (lane <= 16) { const float band = 1e-4f + (float)(lane - 1) * ((15.0f - 1e-4f) / 15.0f); f = cosf(band * omega); }
        else if (lane <= 32) { const float band = 1e-4f + (float)(lane - 17) * ((15.0f - 1e-4f) / 15.0f); f = -sinf(band * omega); }
        scr[lane] = f; LDS_WAIT(); asm volatile("" ::: "memory");
        float a = b1[lane];
#pragma unroll 11
        for (int i = 0; i < 33; ++i) a += scr[i] * w1[i * 64 + lane];
        scr[64 + lane] = sinf(fr * a); LDS_WAIT(); asm volatile("" ::: "memory");
        a = b2[lane];
#pragma unroll 16
        for (int i = 0; i < 64; ++i) a += scr[64 + i] * w2[i * 64 + lane];
        HID2[(size_t)l * 64 + lane] = sinf(fr * a);
        LDS_WAIT(); asm volatile("" ::: "memory");
    }
}
__device__ __forceinline__ void p1_filter_waves(Frame& F) {
    const int fwl = F.wave - 4;
    LAS float* h2T = (LAS float*)F.lds + fwl * 512;
    const float* w3 = F.in[I_HW3]; const float* HID2 = (const float*)(F.ws + WS_HID2);
    float* FILT = (float*)(F.ws + WS_FILT);
    const int lane = F.lane;
    const float min_decay = -3.0701134573253943f, max_decay = -15.350567286626972f;
    for (int item = blockIdx.x * 4 + fwl; item < 2048; item += F.G * 4) {
        const int g8 = item >> 3, cb = item & 7;
        { const int pp = lane >> 3, i8 = (lane & 7) * 8; const float* hp = HID2 + (size_t)(g8 * 8 + pp) * 64 + i8;
          const f32x4 a = *(const f32x4*)hp, b = *(const f32x4*)(hp + 4);
          h2T[(i8 + 0) * 8 + pp] = a[0]; h2T[(i8 + 1) * 8 + pp] = a[1]; h2T[(i8 + 2) * 8 + pp] = a[2]; h2T[(i8 + 3) * 8 + pp] = a[3];
          h2T[(i8 + 4) * 8 + pp] = b[0]; h2T[(i8 + 5) * 8 + pp] = b[1]; h2T[(i8 + 6) * 8 + pp] = b[2]; h2T[(i8 + 7) * 8 + pp] = b[3];
          LDS_WAIT(); asm volatile("" ::: "memory"); }
        {
            const int j0 = cb * 512 + lane * 8;
            f32x4 acc[8][2];
#pragma unroll
            for (int p = 0; p < 8; ++p) { acc[p][0] = (f32x4){0.f, 0.f, 0.f, 0.f}; acc[p][1] = (f32x4){0.f, 0.f, 0.f, 0.f}; }
#pragma unroll 8
            for (int i = 0; i < 64; ++i) { const f32x4 wa = *(const f32x4*)(w3 + (size_t)i * 4096 + j0), wb = *(const f32x4*)(w3 + (size_t)i * 4096 + j0 + 4);
                const f32x4 h0 = *(const LAS f32x4*)(h2T + i * 8), h1 = *(const LAS f32x4*)(h2T + i * 8 + 4);
#pragma unroll
                for (int p = 0; p < 4; ++p) { acc[p][0] += wa * h0[p]; acc[p][1] += wb * h0[p]; acc[p + 4][0] += wa * h1[p]; acc[p + 4][1] += wb * h1[p]; } }
            float tp[8];
#pragma unroll
            for (int p = 0; p < 8; ++p) tp[p] = (float)(g8 * 8 + p) / (float)(SEQ - 1);
#pragma unroll
            for (int e = 0; e < 8; ++e) { const int j = j0 + e, ch = j & 1023; const float delta = fabsf(min_decay + (float)ch * ((max_decay - min_decay) / 1023.0f));
                float o[8];
#pragma unroll
                for (int p = 0; p < 8; ++p) o[p] = acc[p][e >> 2][e & 3] * __expf(-tp[p] * delta);
                float* op = FILT + (size_t)j * SEQ + g8 * 8;
                *(f32x4*)op = (f32x4){o[0], o[1], o[2], o[3]}; *(f32x4*)(op + 4) = (f32x4){o[4], o[5], o[6], o[7]}; }
        }
        LDS_WAIT(); asm volatile("" ::: "memory");
    }
}

__device__ __forceinline__ void p1_modulate(Frame& F) {
    const float* x = F.in[I_X]; const float* mod = (const float*)(F.ws + WS_MOD); bf16* H = (bf16*)(F.ws + WS_H);
    const size_t nvec = (size_t)MTOK * DM / 8, stride = (size_t)F.G * 256;
    for (size_t i0 = (size_t)blockIdx.x * 256 + F.tid; i0 < nvec; i0 += 4 * stride) {
        f32x4 xa[4], xb[4];
#pragma unroll
        for (int u = 0; u < 4; ++u) { const size_t i = i0 + u * stride; if (i < nvec) { const float* xp = x + i * 8; xa[u] = *(const f32x4*)xp; xb[u] = *(const f32x4*)(xp + 4); } }
#pragma unroll
        for (int u = 0; u < 4; ++u) { const size_t i = i0 + u * stride; if (i < nvec) {
            const int row = (int)(i >> 8), col = (int)(i & 255) * 8, b = row >> 11;
            const float* mp = mod + (size_t)b * MODW + col;
            const f32x4 sh0 = *(const f32x4*)mp, sh1 = *(const f32x4*)(mp + 4), sc0 = *(const f32x4*)(mp + DM), sc1 = *(const f32x4*)(mp + DM + 4);
            const f32x4 h0 = xa[u] * (sc0 + 1.0f) + sh0, h1 = xb[u] * (sc1 + 1.0f) + sh1;
            v4u o; o.x = pk2(h0[0], h0[1]); o.y = pk2(h0[2], h0[3]); o.z = pk2(h1[0], h1[1]); o.w = pk2(h1[2], h1[3]);
            *(v4u*)(H + i * 8) = o; } }
    }
}

typedef short sg_bf16x8 __attribute__((ext_vector_type(8)));
typedef float sg_f32x16 __attribute__((ext_vector_type(16)));
constexpr int SG_VT = 0, SG_LD = 136, SG_ST = 36864;
__device__ __forceinline__ void p3_sgu(Frame& F) {
    LAS bf16* vnT = (LAS bf16*)(F.lds + SG_VT); LAS float* stS = (LAS float*)(F.lds + SG_ST);
    const bf16* U = (const bf16*)(F.ws + WS_U); const bf16* VT = (const bf16*)(F.ws + WS_V); bf16* AB = (bf16*)(F.ws + WS_H);
    const bf16* Wb = (const bf16*)(F.ws + WS_SGW); const float* stv = (const float*)(F.ws + WS_STV);
    const float* lng = F.in[I_SLNG]; const float* lnb = F.in[I_SLNB]; const float* sb = F.in[I_SB];
    const int tid = F.tid, lane = F.lane, w = F.wave, r = lane & 31, h = lane >> 5;
    for (int item = blockIdx.x; item < 1024; item += F.G) {
        const int b = item >> 7, n = (item >> 3) & 15, g = item & 7, tok0 = b * SEQ + n * 128;
        if (tid < 128) { float s = 0.f, q = 0.f; const float* sp = stv + (size_t)(tok0 + tid) * 32;
#pragma unroll
            for (int i = 0; i < 16; ++i) { const f32x2 pr = *(const f32x2*)(sp + 2 * i); s += pr.x; q += pr.y; }
            const float mean = s * (1.0f / 1024.0f); float var = q * (1.0f / 1024.0f) - mean * mean; var = var > 0.f ? var : 0.f;
            *(LAS f32x2*)(stS + 2 * tid) = (f32x2){mean, 1.0f / sqrtf(var + LN_EPS)}; }
        __syncthreads();
        { const int c = tid >> 2, pseg = (tid & 3) * 32, ch = g * 128 + c; const float gg = lng[ch], bb = lnb[ch];
          const bf16* vp = VT + (size_t)ch * MTOK + tok0 + pseg;
          v4u wv[4];
#pragma unroll
          for (int k = 0; k < 4; ++k) wv[k] = *(const v4u*)(vp + 8 * k);
#pragma unroll
          for (int k = 0; k < 4; ++k) {
              const float e[8] = {bflo(wv[k].x), bfhi(wv[k].x), bflo(wv[k].y), bfhi(wv[k].y), bflo(wv[k].z), bfhi(wv[k].z), bflo(wv[k].w), bfhi(wv[k].w)};
              float o[8];
#pragma unroll
              for (int i = 0; i < 8; i += 2) { const f32x4 st = *(const LAS f32x4*)(stS + 2 * (pseg + 8 * k + i));
                  o[i] = (e[i] - st[0]) * st[1] * gg + bb; o[i + 1] = (e[i + 1] - st[2]) * st[3] * gg + bb; }
              v4u pk; pk.x = pk2(o[0], o[1]); pk.y = pk2(o[2], o[3]); pk.z = pk2(o[4], o[5]); pk.w = pk2(o[6], o[7]);
              *(LAS v4u*)(vnT + c * SG_LD + pseg + 8 * k) = pk; } }
        const int q0 = 32 * (w >> 1), ct0 = 2 * (w & 1);
        sg_bf16x8 af[8];
#pragma unroll
        for (int kk = 0; kk < 8; ++kk) af[kk] = *(const sg_bf16x8*)(Wb + (size_t)(g * 128 + q0 + r) * 128 + 16 * kk + 8 * h);
        __syncthreads();
        sg_f32x16 acc[2];
#pragma unroll
        for (int ct = 0; ct < 2; ++ct)
#pragma unroll
            for (int i = 0; i < 16; ++i) acc[ct][i] = 0.f;
#pragma unroll
        for (int kk = 0; kk < 8; ++kk)
#pragma unroll
            for (int ct = 0; ct < 2; ++ct) {
                const sg_bf16x8 bf = *(const LAS sg_bf16x8*)(vnT + ((ct0 + ct) * 32 + r) * SG_LD + 16 * kk + 8 * h);
                acc[ct] = __builtin_amdgcn_mfma_f32_32x32x16_bf16(af[kk], bf, acc[ct], 0, 0, 0);
            }
#pragma unroll
        for (int ct = 0; ct < 2; ++ct) {
            const int c = (ct0 + ct) * 32 + r;
#pragma unroll
            for (int rg = 0; rg < 16; ++rg) {
                const int q = q0 + (rg & 3) + 8 * (rg >> 2) + 4 * h;
                const float uv = bf1(U[(size_t)(tok0 + q) * SGUW + g * 128 + c]);
                AB[(size_t)(tok0 + q) * DM + g * 128 + c] = (bf16)f2bf(uv * (acc[ct][rg] + sb[g * 128 + q]));
            }
        }
        __syncthreads();
    }
}

__device__ __forceinline__ float sconv(const bf16* ZHT, const float* cw, const float* cb, int ch, int b, int t) {
    const bf16* zp = ZHT + (size_t)ch * MTOK + b * SEQ;
    const float z0 = t > 0 ? bf1(zp[t - 1]) : 0.f, z1 = bf1(zp[t]), z2 = t < SEQ - 1 ? bf1(zp[t + 1]) : 0.f;
    return cw[ch] * z0 + cw[3072 + ch] * z1 + cw[6144 + ch] * z2 + cb[ch];
}
__device__ __forceinline__ void p3_hyena(Frame& F) {
    LAS float* Us = (LAS float*)F.lds;
    LAS float* KF = (LAS float*)(F.lds + 65536);
    const bf16* ZHT = (const bf16*)(F.ws + WS_ZHT); const float* FILT = (const float*)(F.ws + WS_FILT); bf16* AB = (bf16*)(F.ws + WS_H);
    const float* cw = F.in[I_HCW]; const float* cb = F.in[I_HCB]; const float* skip = F.in[I_HSKIP];
    const int tid = F.tid;
    for (int item = blockIdx.x; item < HYW; item += F.G) {
        const int c = item;
        for (int i = tid; i < NBATCH * SEQ; i += NWAVES * 64) { const int b = i >> 11, t = i & 2047; Us[t * 8 + b] = sconv(ZHT, cw, cb, c, b, t); }
        for (int n = 0; n < 2; ++n) {
            const float* hf = FILT + (size_t)((0 * 2 + n) * 1024 + c) * SEQ; const float* hb = FILT + (size_t)((1 * 2 + n) * 1024 + c) * SEQ;
            for (int i = tid; i < 4095; i += NWAVES * 64) { const int lag = i - 2047; KF[i] = lag > 0 ? hf[lag] : (lag == 0 ? hf[0] + hb[0] : hb[-lag]); }
            __syncthreads();
            f32x4 acc[4][2];
#pragma unroll
            for (int ti = 0; ti < 4; ++ti) { acc[ti][0] = (f32x4){0.f, 0.f, 0.f, 0.f}; acc[ti][1] = (f32x4){0.f, 0.f, 0.f, 0.f}; }
            const LAS float* kp = KF + tid + 2047;
            for (int s = 0; s < SEQ; ++s) {
                const f32x4 u0 = *(const LAS f32x4*)(Us + s * 8), u1 = *(const LAS f32x4*)(Us + s * 8 + 4);
#pragma unroll
                for (int ti = 0; ti < 4; ++ti) { const float kv = kp[512 * ti - s]; acc[ti][0] += u0 * kv; acc[ti][1] += u1 * kv; }
            }
            __syncthreads();
            const float sk = skip[n * 1024 + c];
#pragma unroll
            for (int ti = 0; ti < 4; ++ti) { const int t = tid + 512 * ti;
#pragma unroll
                for (int b = 0; b < 8; ++b) {
                    const float uv = Us[t * 8 + b], gate = sconv(ZHT, cw, cb, (n + 1) * 1024 + c, b, t);
                    const float y = gate * (acc[ti][b >> 2][b & 3] + sk * uv);
                    if (n == 0) Us[t * 8 + b] = y; else AB[(size_t)(b * SEQ + t) * DM + 1024 + c] = (bf16)f2bf(y);
                } }
            __syncthreads();
        }
    }
}

#ifndef HYFFT_HD
#define HYFFT_HD __device__ __forceinline__
#define HYFFT_LAS __attribute__((address_space(3)))
#endif
typedef float hy_c32 __attribute__((ext_vector_type(2)));
HYFFT_HD int hy_padi(int i) { return i + (i >> 3); }
HYFFT_HD int hy_rev(int x) { return ((x & 7) << 9) | (((x >> 3) & 7) << 6) | (((x >> 6) & 7) << 3) | ((x >> 9) & 7); }

template <bool INV> HYFFT_HD void hy_dft8(float (&re)[8], float (&im)[8]) {
    const float h = 0.70710678118654752f;
    float ar[4], ai[4], br[4], bi[4];
#pragma unroll
    for (int m = 0; m < 4; ++m) { ar[m] = re[m] + re[m + 4]; ai[m] = im[m] + im[m + 4]; br[m] = re[m] - re[m + 4]; bi[m] = im[m] - im[m + 4]; }
    { float x = br[1], y = bi[1]; if (!INV) { br[1] = h * (x + y); bi[1] = h * (y - x); } else { br[1] = h * (x - y); bi[1] = h * (y + x); } }
    { float x = br[2], y = bi[2]; if (!INV) { br[2] = y; bi[2] = -x; } else { br[2] = -y; bi[2] = x; } }
    { float x = br[3], y = bi[3]; if (!INV) { br[3] = h * (y - x); bi[3] = -h * (x + y); } else { br[3] = -h * (x + y); bi[3] = h * (x - y); } }
#pragma unroll
    for (int s = 0; s < 2; ++s) {
        float* cr = s ? br : ar; float* ci = s ? bi : ai;
        const float e0r = cr[0] + cr[2], e0i = ci[0] + ci[2], e1r = cr[0] - cr[2], e1i = ci[0] - ci[2];
        const float o0r = cr[1] + cr[3], o0i = ci[1] + ci[3]; const float dr = cr[1] - cr[3], di = ci[1] - ci[3];
        float o1r, o1i; if (!INV) { o1r = di; o1i = -dr; } else { o1r = -di; o1i = dr; }
        re[0 + s] = e0r + o0r; im[0 + s] = e0i + o0i;
        re[2 + s] = e1r + o1r; im[2 + s] = e1i + o1i;
        re[4 + s] = e0r - o0r; im[4 + s] = e0i - o0i;
        re[6 + s] = e1r - o1r; im[6 + s] = e1i - o1i;
    }
}
template <bool CONJ> HYFFT_HD void hy_twiddle(float (&re)[8], float (&im)[8], float wr, float wi) {
    if (CONJ) wi = -wi;
    const float w2r = wr * wr - wi * wi, w2i = 2.f * wr * wi;
    const float w3r = w2r * wr - w2i * wi, w3i = w2r * wi + w2i * wr;
    const float w4r = w2r * w2r - w2i * w2i, w4i = 2.f * w2r * w2i;
    const float w5r = w4r * wr - w4i * wi, w5i = w4r * wi + w4i * wr;
    const float w6r = w3r * w3r - w3i * w3i, w6i = 2.f * w3r * w3i;
    const float w7r = w4r * w3r - w4i * w3i, w7i = w4r * w3i + w4i * w3r;
    const float pr[8] = {1.f, wr, w2r, w3r, w4r, w5r, w6r, w7r}, pi[8] = {0.f, wi, w2i, w3i, w4i, w5i, w6i, w7i};
#pragma unroll
    for (int k = 1; k < 8; ++k) { const float x = re[k], y = im[k]; re[k] = x * pr[k] - y * pi[k]; im[k] = x * pi[k] + y * pr[k]; }
}
template <int L, class BP, class TP> HYFFT_HD void hy_fwd_store(BP buf, TP tw, int j, float (&re)[8], float (&im)[8]) {
    constexpr int S = L / 8; const int blk = j / S, q = j % S, base = blk * L + q;
    hy_dft8<false>(re, im);
    if (L > 8) { const hy_c32 w = tw[q * (4096 / L)]; hy_twiddle<false>(re, im, w.x, w.y); }
#pragma unroll
    for (int k = 0; k < 8; ++k) buf[hy_padi(base + k * S)] = (hy_c32){re[k], im[k]};
}
template <int L, class BP> HYFFT_HD void hy_load8(BP buf, int j, float (&re)[8], float (&im)[8]) {
    constexpr int S = L / 8; const int blk = j / S, q = j % S, base = blk * L + q;
#pragma unroll
    for (int k = 0; k < 8; ++k) { const hy_c32 v = buf[hy_padi(base + k * S)]; re[k] = v.x; im[k] = v.y; }
}
template <int L, class BP, class TP> HYFFT_HD void hy_fwd_stage(BP buf, TP tw, int j) { float re[8], im[8]; hy_load8<L>(buf, j, re, im); hy_fwd_store<L>(buf, tw, j, re, im); }
template <int L, class BP, class TP> HYFFT_HD void hy_inv_regs(BP buf, TP tw, int j, float (&re)[8], float (&im)[8]) {
    constexpr int S = L / 8; const int q = j % S;
    hy_load8<L>(buf, j, re, im);
    if (L > 8) { const hy_c32 w = tw[q * (4096 / L)]; hy_twiddle<true>(re, im, w.x, w.y); }
    hy_dft8<true>(re, im);
}
template <int L, class BP, class TP> HYFFT_HD void hy_inv_stage(BP buf, TP tw, int j) {
    constexpr int S = L / 8; const int blk = j / S, q = j % S, base = blk * L + q;
    float re[8], im[8]; hy_inv_regs<L>(buf, tw, j, re, im);
#pragma unroll
    for (int k = 0; k < 8; ++k) buf[hy_padi(base + k * S)] = (hy_c32){re[k], im[k]};
}
template <class BP, class KP> HYFFT_HD void hy_mid_stage(BP buf, KP K, int j) {
    float re[8], im[8]; hy_load8<8>(buf, j, re, im);
    hy_dft8<false>(re, im);
#pragma unroll
    for (int k = 0; k < 8; ++k) { const hy_c32 kv = K[hy_padi(8 * j + k)]; const float x = re[k], y = im[k]; re[k] = x * kv.x - y * kv.y; im[k] = x * kv.y + y * kv.x; }
    hy_dft8<true>(re, im);
#pragma unroll
    for (int k = 0; k < 8; ++k) buf[hy_padi(8 * j + k)] = (hy_c32){re[k], im[k]};
}
template <class BP> HYFFT_HD void hy_last_fwd(BP buf, int j) {
    float re[8], im[8]; hy_load8<8>(buf, j, re, im); hy_dft8<false>(re, im);
#pragma unroll
    for (int k = 0; k < 8; ++k) buf[hy_padi(8 * j + k)] = (hy_c32){re[k], im[k]};
}
template <class BP, class KP> HYFFT_HD void hy_separate(BP Z, KP K1, KP K2, int j) {
    const float sc = 0.5f / 4096.0f;
#pragma unroll
    for (int r = 0; r < 8; ++r) {
        const int p = j + 512 * r, f = hy_rev(p), g = (4096 - f) & 4095, p2 = hy_rev(g);
        const hy_c32 a = Z[hy_padi(p)], b = Z[hy_padi(p2)];
        K1[hy_padi(p)] = (hy_c32){(a.x + b.x) * sc, (a.y - b.y) * sc};
        K2[hy_padi(p)] = (hy_c32){(a.y + b.y) * sc, (b.x - a.x) * sc};
    }
}

struct Raw3 { bf16 a, b, c; };
__device__ __forceinline__ Raw3 raw3(const bf16* zp, int t) { Raw3 r; r.a = zp[t > 0 ? t - 1 : 0]; r.b = zp[t]; r.c = zp[t < SEQ - 1 ? t + 1 : SEQ - 1]; return r; }
__device__ __forceinline__ float sconv_raw(const Raw3& r, int t, float w0, float w1, float w2, float cb) {
    const float z0 = t > 0 ? bf1(r.a) : 0.f, z1 = bf1(r.b), z2 = t < SEQ - 1 ? bf1(r.c) : 0.f;
    return w0 * z0 + w1 * z1 + w2 * z2 + cb;
}
__device__ __forceinline__ void p3_hyena_fft(Frame& F) {
    LAS hy_c32* BA = (LAS hy_c32*)(F.lds + 0); LAS hy_c32* BB = (LAS hy_c32*)(F.lds + 36864);
    LAS hy_c32* K1 = (LAS hy_c32*)(F.lds + 73728); LAS hy_c32* K2 = (LAS hy_c32*)(F.lds + 110592); LAS hy_c32* TW = (LAS hy_c32*)(F.lds + 147456);
    const bf16* ZHT = (const bf16*)(F.ws + WS_ZHT); const float* FILT = (const float*)(F.ws + WS_FILT); bf16* YT = (bf16*)(F.ws + WS_YT);
    const float* cw = F.in[I_HCW]; const float* cb = F.in[I_HCB]; const float* skip = F.in[I_HSKIP];
    const int jt = F.tid;
    { float sn, cs; sincosf(-6.283185307179586f * (float)jt / 4096.0f, &sn, &cs); TW[jt] = (hy_c32){cs, sn}; }
    __syncthreads();
    for (int item = blockIdx.x; item < HYW; item += F.G) {
        const int c = item;
        float ra[8], ia[8], rb[8], ib[8];
        int j = jt; asm volatile("" : "+v"(j));
        const bf16* zv = ZHT + (size_t)c * MTOK; const bf16* za = ZHT + (size_t)(1024 + c) * MTOK; const bf16* zb = ZHT + (size_t)(2048 + c) * MTOK;
        {
            const float* hf0 = FILT + (size_t)(0 * 1024 + c) * SEQ; const float* hf1 = FILT + (size_t)(1 * 1024 + c) * SEQ;
            const float* hb0 = FILT + (size_t)(2 * 1024 + c) * SEQ; const float* hb1 = FILT + (size_t)(3 * 1024 + c) * SEQ;
#pragma unroll
            for (int m = 0; m < 4; ++m) { const int i = j + 512 * m; ra[m] = hf0[i]; ia[m] = hf1[i]; }
            if (j == 0) { ra[0] += hb0[0]; ia[0] += hb1[0]; }
#pragma unroll
            for (int m = 4; m < 8; ++m) { const int i = j + 512 * m; const bool z = (i == 2048); const int r = z ? 0 : 4096 - i; const float a = hb0[r], b = hb1[r]; ra[m] = z ? 0.f : a; ia[m] = z ? 0.f : b; }
            hy_fwd_store<4096>(BA, TW, j, ra, ia); __syncthreads();
            hy_fwd_stage<512>(BA, TW, j); __syncthreads();
            hy_fwd_stage<64>(BA, TW, j); __syncthreads();
            hy_last_fwd(BA, j); __syncthreads();
            hy_separate(BA, K1, K2, j); __syncthreads();
        }
        const float vw0 = cw[c], vw1 = cw[3072 + c], vw2 = cw[6144 + c], vcb = cb[c];
        const float aw0 = cw[1024 + c], aw1 = cw[3072 + 1024 + c], aw2 = cw[6144 + 1024 + c], acb = cb[1024 + c];
        const float bw0 = cw[2048 + c], bw1 = cw[3072 + 2048 + c], bw2 = cw[6144 + 2048 + c], bcb = cb[2048 + c];
        const float sk0 = skip[c], sk1 = skip[1024 + c];
#pragma unroll 1
        for (int pp = 0; pp < 2; ++pp) {
            const int boff = (4 * pp) * SEQ;
            asm volatile("" : "+v"(j));
            Raw3 rg[4][4];
            float v[4][4];
#pragma unroll
            for (int b = 0; b < 4; ++b)
#pragma unroll
                for (int m = 0; m < 4; ++m) { const Raw3 r = raw3(zv + boff + b * SEQ, j + 512 * m); v[b][m] = sconv_raw(r, j + 512 * m, vw0, vw1, vw2, vcb); }
#pragma unroll
            for (int m = 0; m < 4; ++m) { ra[m] = v[0][m]; ia[m] = v[1][m]; rb[m] = v[2][m]; ib[m] = v[3][m]; ra[m + 4] = 0.f; ia[m + 4] = 0.f; rb[m + 4] = 0.f; ib[m + 4] = 0.f; }
            hy_fwd_store<4096>(BA, TW, j, ra, ia); hy_fwd_store<4096>(BB, TW, j, rb, ib); __syncthreads();
            hy_fwd_stage<512>(BA, TW, j); hy_fwd_stage<512>(BB, TW, j); __syncthreads();
            hy_fwd_stage<64>(BA, TW, j); hy_fwd_stage<64>(BB, TW, j); __syncthreads();
            hy_mid_stage(BA, K1, j); hy_mid_stage(BB, K1, j); __syncthreads();
#pragma unroll
            for (int b = 0; b < 4; ++b)
#pragma unroll
                for (int m = 0; m < 4; ++m) rg[b][m] = raw3(za + boff + b * SEQ, j + 512 * m);
            hy_inv_stage<64>(BA, TW, j); hy_inv_stage<64>(BB, TW, j); __syncthreads();
            float gt[4][4];
#pragma unroll
            for (int b = 0; b < 4; ++b)
#pragma unroll
                for (int m = 0; m < 4; ++m) gt[b][m] = sconv_raw(rg[b][m], j + 512 * m, aw0, aw1, aw2, acb);
            hy_inv_stage<512>(BA, TW, j); hy_inv_stage<512>(BB, TW, j); __syncthreads();
            hy_inv_regs<4096>(BA, TW, j, ra, ia); hy_inv_regs<4096>(BB, TW, j, rb, ib);
#pragma unroll
            for (int m = 0; m < 4; ++m) {
                v[0][m] = gt[0][m] * (ra[m] + sk0 * v[0][m]); v[1][m] = gt[1][m] * (ia[m] + sk0 * v[1][m]);
                v[2][m] = gt[2][m] * (rb[m] + sk0 * v[2][m]); v[3][m] = gt[3][m] * (ib[m] + sk0 * v[3][m]); }
#pragma unroll
            for (int m = 0; m < 4; ++m) { ra[m] = v[0][m]; ia[m] = v[1][m]; rb[m] = v[2][m]; ib[m] = v[3][m]; ra[m + 4] = 0.f; ia[m + 4] = 0.f; rb[m + 4] = 0.f; ib[m + 4] = 0.f; }
            hy_fwd_store<4096>(BA, TW, j, ra, ia); hy_fwd_store<4096>(BB, TW, j, rb, ib); __syncthreads();
            hy_fwd_stage<512>(BA, TW, j); hy_fwd_stage<512>(BB, TW, j); __syncthreads();
            hy_fwd_stage<64>(BA, TW, j); hy_fwd_stage<64>(BB, TW, j); __syncthreads();
            hy_mid_stage(BA, K2, j); hy_mid_stage(BB, K2, j); __syncthreads();
#pragma unroll
            for (int b = 0; b < 4; ++b)
#pragma unroll
                for (int m = 0; m < 4; ++m) rg[b][m] = raw3(zb + boff + b * SEQ, j + 512 * m);
            hy_inv_stage<64>(BA, TW, j); hy_inv_stage<64>(BB, TW, j); __syncthreads();
#pragma unroll
            for (int b = 0; b < 4; ++b)
#pragma unroll
                for (int m = 0; m < 4; ++m) gt[b][m] = sconv_raw(rg[b][m], j + 512 * m, bw0, bw1, bw2, bcb);
            hy_inv_stage<512>(BA, TW, j); hy_inv_stage<512>(BB, TW, j); __syncthreads();
            hy_inv_regs<4096>(BA, TW, j, ra, ia); hy_inv_regs<4096>(BB, TW, j, rb, ib);
#pragma unroll
            for (int m = 0; m < 4; ++m) { const int t = j + 512 * m; bf16* yp = YT + (size_t)c * MTOK + boff + t;
                yp[0] = (bf16)f2bf(gt[0][m] * (ra[m] + sk1 * v[0][m]));
                yp[SEQ] = (bf16)f2bf(gt[1][m] * (ia[m] + sk1 * v[1][m]));
                yp[2 * SEQ] = (bf16)f2bf(gt[2][m] * (rb[m] + sk1 * v[2][m]));
                yp[3 * SEQ] = (bf16)f2bf(gt[3][m] * (ib[m] + sk1 * v[3][m])); }
        }
        __syncthreads();
    }
}

__device__ __forceinline__ void p3c_transpose(Frame& F) {
    constexpr int LD = 264;
    LAS bf16* tile = (LAS bf16*)F.lds;
    const bf16* YT = (const bf16*)(F.ws + WS_YT); bf16* AB = (bf16*)(F.ws + WS_H);
    const int tid = F.tid;
    for (int it = blockIdx.x; it < 16 * 64; it += F.G) {
        const int c0 = (it >> 6) * 64, t0 = (it & 63) * 256;
        { const int c = tid >> 3, ts = (tid & 7) * 32; const bf16* src = YT + (size_t)(c0 + c) * MTOK + t0 + ts;
          v4u w[4];
#pragma unroll
          for (int k = 0; k < 4; ++k) w[k] = *(const v4u*)(src + 8 * k);
#pragma unroll
          for (int k = 0; k < 4; ++k) *(LAS v4u*)(tile + c * LD + ts + 8 * k) = w[k]; }
        __syncthreads();
        { const int t = tid >> 1, cs = (tid & 1) * 32; unsigned o[16];
#pragma unroll
          for (int i = 0; i < 16; ++i) o[i] = (unsigned)tile[(cs + 2 * i) * LD + t] | ((unsigned)tile[(cs + 2 * i + 1) * LD + t] << 16);
          bf16* dst = AB + (size_t)(t0 + t) * DM + 1024 + c0 + cs;
#pragma unroll
          for (int k = 0; k < 4; ++k) *(v4u*)(dst + 8 * k) = (v4u){o[4 * k], o[4 * k + 1], o[4 * k + 2], o[4 * k + 3]}; }
        __syncthreads();
    }
}

template <bool FINAL> __device__ __forceinline__ void ln_rows(Frame& F) {
    float* R = F.out; const float* st = (const float*)(F.ws + (FINAL ? WS_ST2 : WS_ST1)); float* MU = (float*)(F.ws + WS_MU1);
    const float* mod = (const float*)(F.ws + WS_MOD); bf16* H2 = (bf16*)(F.ws + WS_H);
    const float* lng = F.in[FINAL ? I_LN2G : I_LN1G]; const float* lnb = F.in[FINAL ? I_LN2B : I_LN1B];
    const int gw = blockIdx.x * NWAVES + F.wave, NGW = F.G * NWAVES, lane = F.lane;
    for (int row = gw; row < MTOK; row += NGW) {
        float s = 0.f, q = 0.f; if (lane < 32) { const f32x2 p = *(const f32x2*)(st + ((size_t)row * 32 + lane) * 2); s = p.x; q = p.y; }
        s = wave_sum(s); q = wave_sum(q);
        const float mean = s * (1.0f / DM); float var = q * (1.0f / DM) - mean * mean; var = var > 0.f ? var : 0.f; const float rstd = 1.0f / sqrtf(var + LN_EPS);
        if (!FINAL && lane == 0) *(f32x2*)(MU + (size_t)row * 2) = (f32x2){mean, rstd};
        const int b = row >> 11; float* rp = R + (size_t)row * DM;
#pragma unroll
        for (int j = 0; j < 8; ++j) { const int col = 4 * lane + 256 * j;
            const f32x4 v = *(const f32x4*)(rp + col); const f32x4 y = (v - mean) * rstd * *(const f32x4*)(lng + col) + *(const f32x4*)(lnb + col);
            if (FINAL) *(f32x4*)(rp + col) = y;
            else { const float* mp = mod + (size_t)b * MODW + col; const f32x4 h = y * (*(const f32x4*)(mp + 4 * DM) + 1.0f) + *(const f32x4*)(mp + 3 * DM);
                   v2u o; o.x = pk2(h[0], h[1]); o.y = pk2(h[2], h[3]); *(v2u*)(H2 + (size_t)row * DM + col) = o; } }
    }
}

typedef GAS unsigned gu32;
#define RLX_AGENT __ATOMIC_RELAXED, __HIP_MEMORY_SCOPE_AGENT
constexpr int LDSCTL_OFF = 163840 - 512, MISC_OFF = LDSCTL_OFF;
constexpr int CW_BAR = 4096;
constexpr size_t CTL_ZERO_BYTES = 65536;
#define XB_TMO      128
#define XB_XCNT(j)  (256  + 64 * (j))
#define XB_XSUB(j)  (1280 + 64 * (j))
#define XB_XGEN(j)  (2304 + 64 * (j))
#define XB_TOP      3328
#define XB_TOPGEN   3392
#define XCD_BAR_WORDS 3456
#define XB_SPIN_CAP (1u << 18)

__device__ __forceinline__ unsigned xb_ld(unsigned* p)              { return __hip_atomic_load(p, __ATOMIC_RELAXED, __HIP_MEMORY_SCOPE_AGENT); }
__device__ __forceinline__ unsigned xb_add(unsigned* p, unsigned v) { return __hip_atomic_fetch_add(p, v, __ATOMIC_RELAXED, __HIP_MEMORY_SCOPE_AGENT); }
__device__ __forceinline__ unsigned xb_xcc_id() { return (unsigned)__builtin_amdgcn_s_getreg((3 << 11) | 20) & 0xFu; }
#define XB_SPIN(cond, bar) do { unsigned _sp = 0; while (cond) { __builtin_amdgcn_s_sleep(1); \
    if ((++_sp & 255u) == 0u) { if (xb_ld(&(bar)[XB_TMO])) break; if (_sp > XB_SPIN_CAP) { atomicAdd(&(bar)[XB_TMO], 1u); break; } } } } while (0)

struct XcdBarrier {
    unsigned* bar; unsigned x;
    volatile LAS unsigned* st;
};

__device__ __forceinline__ XcdBarrier xcd_barrier_post(unsigned* bar, volatile LAS unsigned* st) {
    XcdBarrier b; b.bar = bar; b.x = xb_xcc_id(); b.st = st;
    if (threadIdx.x == 0) (void)xb_add(&bar[XB_XCNT(b.x)], 1u);
    return b;
}
__device__ __forceinline__ void xcd_barrier_complete(unsigned* bar, unsigned x, unsigned& nloc, unsigned& nx) {
    const unsigned G = gridDim.x * gridDim.y * gridDim.z;
    unsigned sum, cnt, mine, sp = 0u;
    for (;;) {
        sum = 0u; cnt = 0u; mine = 0u;
#pragma unroll
        for (unsigned j = 0; j < 16; ++j) { const unsigned c = xb_ld(&bar[XB_XCNT(j)]); sum += c; cnt += (c > 0u) ? 1u : 0u; mine = (j == x) ? c : mine; }
        if (sum == G) break;
        __builtin_amdgcn_s_sleep(1);
        if ((++sp & 255u) == 0u) { if (xb_ld(&bar[XB_TMO])) break; if (sp > XB_SPIN_CAP) { atomicAdd(&bar[XB_TMO], 1u); break; } }
    }
    nloc = mine > 0u ? mine : 1u; nx = cnt > 0u ? cnt : 1u;
}

__device__ __forceinline__ void xcd_barrier(const XcdBarrier& b) {
    asm volatile("s_waitcnt vmcnt(0)" ::: "memory");
    __syncthreads();
    if (threadIdx.x == 0) {
        unsigned* bar = b.bar;
        __builtin_amdgcn_s_waitcnt(0);
        unsigned nloc = b.st[0], nx = b.st[1];
        if (nloc == 0u) { xcd_barrier_complete(bar, b.x, nloc, nx); b.st[0] = nloc; b.st[1] = nx; }
        const unsigned old = xb_add(&bar[XB_XSUB(b.x)], 1u);
        const unsigned gen = old / nloc;
        if (old + 1u == (gen + 1u) * nloc) {
            __builtin_amdgcn_fence(__ATOMIC_RELEASE, "agent");
            asm volatile("s_waitcnt vmcnt(0)" ::: "memory");
            const unsigned og = xb_add(&bar[XB_TOP], 1u);
            const unsigned tg = og / nx;
            if (og + 1u == (tg + 1u) * nx) xb_add(&bar[XB_TOPGEN], 1u);
            else XB_SPIN(xb_ld(&bar[XB_TOPGEN]) == tg, bar);
            __builtin_amdgcn_fence(__ATOMIC_ACQUIRE, "agent");
            xb_add(&bar[XB_XGEN(b.x)], 1u);
            asm volatile("s_waitcnt vmcnt(0)" ::: "memory");
        } else {
            XB_SPIN(xb_ld(&bar[XB_XGEN(b.x)]) == gen, bar);
            __builtin_amdgcn_fence(__ATOMIC_ACQUIRE, "agent");
            asm volatile("s_waitcnt vmcnt(0)" ::: "memory");
        }
    }
    __syncthreads();
}

#define GRID_SYNC() xcd_barrier(bar)

__global__ void __launch_bounds__(NWAVES * 64, 2) fwd_megakernel(Args args) {
    extern __shared__ __attribute__((aligned(16))) unsigned char lds[];
    Frame F;
    F.lds = (LAS unsigned char*)lds;
    F.tid = threadIdx.x; F.lane = F.tid & 63; F.wave = __builtin_amdgcn_readfirstlane(F.tid >> 6); F.G = gridDim.x;
    F.in = args.in; F.out = args.out; F.ws = args.ws;
    for (int u = F.tid; u < (LDS_BYTES - LDSCTL_OFF) / 4; u += NWAVES * 64) ((LAS unsigned*)(F.lds + LDSCTL_OFF))[u] = 0u;
    __syncthreads();
    XcdBarrier bar = xcd_barrier_post((unsigned*)(args.ws + WS_CTL) + CW_BAR, (volatile LAS unsigned*)(F.lds + MISC_OFF) + 8);
    unsigned char* ws = args.ws;
    const int lo = args.ph_lo, hi = args.ph_hi;
#define IN(k) (lo <= (k) && (k) < hi)
#define BOTH(k) (IN(k) && IN((k) + 1))
    const int gw = blockIdx.x * NWAVES + F.wave, NGW = F.G * NWAVES;

    PB_START(1, F.lds);
    if (IN(0)) { { int t_ = threadIdx.x; asm volatile("" : "+v"(t_)); F.tid = t_; F.lane = t_ & 63; }
        PB_START(21, F.lds); p0_mod(F); PB_END(21, F.lds);
        PB_START(22, F.lds);
        transpose_matrix(F, F.in[I_WIN], DM, INW, (bf16*)(ws + WS_WIN), DM, 0, 1, (int)blockIdx.x, F.G);
        transpose_matrix(F, F.in[I_WA], SGUW, DM, (bf16*)(ws + WS_WAB), DM, 0, 0, (int)((blockIdx.x + 128) % F.G), F.G);
        transpose_matrix(F, F.in[I_WB], HYW, DM, (bf16*)(ws + WS_WAB), DM, 1024, 0, (int)blockIdx.x, F.G);
        transpose_matrix(F, F.in[I_WO], DM, DM, (bf16*)(ws + WS_WO), DM, 0, 0, (int)blockIdx.x, F.G);
        { const float* sw = F.in[I_SW]; bf16* sgw = (bf16*)(ws + WS_SGW);
          for (int i = blockIdx.x * (NWAVES * 64) + F.tid; i < 8 * 128 * 128 / 2; i += F.G * NWAVES * 64) { const f32x2 v = *(const f32x2*)(sw + 2 * i); *(unsigned*)(sgw + 2 * i) = pk2(v.x, v.y); } }
        __syncthreads();
        __syncthreads(); p0_hid2(F);
        PB_END(22, F.lds);
        if (BOTH(0)) GRID_SYNC();
    }
    PB_END(1, F.lds);
    PB_START(2, F.lds);
    if (IN(1)) { { int t_ = threadIdx.x; asm volatile("" : "+v"(t_)); F.tid = t_; F.lane = t_ & 63; } if (F.wave < 4) p1_modulate(F); else p1_filter_waves(F); if (BOTH(1)) GRID_SYNC(); }
    PB_END(2, F.lds);
    PB_START(3, F.lds);
    if (IN(2)) { { int t_ = threadIdx.x; asm volatile("" : "+v"(t_)); F.tid = t_; F.lane = t_ & 63; }
        { pg8::Gemm g{(const pg8::bf16_t*)(ws + WS_H), (const pg8::bf16_t*)(ws + WS_WIN), MTOK, 5120, DM}; pg8::StaticOrder S; S.init(MTOK, 5120, F.G, (int)blockIdx.x);
          pg8::EpiG1 E{(pg8::bf16_t*)(ws + WS_U), (pg8::bf16_t*)(ws + WS_G), F.in[I_BIN]};
          pg8::gemm_phase<pg8::EpiG1, pg8::StaticOrder, true, true>(F.lds, g, S, E); }
        __syncthreads();
        { pg8::Gemm g{(const pg8::bf16_t*)(ws + WS_WIN) + (size_t)5120 * DM, (const pg8::bf16_t*)(ws + WS_H), 4096, MTOK, DM}; pg8::StaticOrder S; S.init(4096, MTOK, F.G, (int)blockIdx.x);
          pg8::EpiG1T E{(pg8::bf16_t*)(ws + WS_V), (pg8::bf16_t*)(ws + WS_ZHT), F.in[I_BIN], (float*)(ws + WS_STV)};
          pg8::gemm_phase<pg8::EpiG1T, pg8::StaticOrder, true, true>(F.lds, g, S, E); }
        if (BOTH(2)) GRID_SYNC();
    }
    PB_END(3, F.lds);
    PB_START(4, F.lds);
    if (IN(3)) { { int t_ = threadIdx.x; asm volatile("" : "+v"(t_)); F.tid = t_; F.lane = t_ & 63; } __syncthreads(); PB_START(41, F.lds); p3_sgu(F); PB_END(41, F.lds); PB_START(42, F.lds); p3_hyena_fft(F); PB_END(42, F.lds); if (BOTH(3)) GRID_SYNC(); PB_START(43, F.lds); p3c_transpose(F); GRID_SYNC(); PB_END(43, F.lds); }
    PB_END(4, F.lds);
    PB_START(5, F.lds);
    if (IN(4)) { { int t_ = threadIdx.x; asm volatile("" : "+v"(t_)); F.tid = t_; F.lane = t_ & 63; }
        pg8::Gemm g{(const pg8::bf16_t*)(ws + WS_H), (const pg8::bf16_t*)(ws + WS_WAB), MTOK, DM, DM}; pg8::StaticOrder S; S.init(MTOK, DM, F.G, (int)blockIdx.x);
        pg8::EpiG2 E{(const pg8::bf16_t*)(ws + WS_G), (pg8::bf16_t*)(ws + WS_MERGED)};
        pg8::gemm_phase<pg8::EpiG2, pg8::StaticOrder, true, true>(F.lds, g, S, E);
        if (BOTH(4)) GRID_SYNC();
    }
    PB_END(5, F.lds);
    PB_START(6, F.lds);
    if (IN(5)) { { int t_ = threadIdx.x; asm volatile("" : "+v"(t_)); F.tid = t_; F.lane = t_ & 63; }
        pg8::Gemm g{(const pg8::bf16_t*)(ws + WS_MERGED), (const pg8::bf16_t*)(ws + WS_WO), MTOK, DM, DM}; pg8::StaticOrder S; S.init(MTOK, DM, F.G, (int)blockIdx.x);
        pg8::EpiRes<true> E{F.in[I_X], F.out, (const float*)(ws + WS_MOD) + 2 * DM, F.in[I_BO], nullptr, nullptr, nullptr, (float*)(ws + WS_ST1)};
        pg8::gemm_phase<pg8::EpiRes<true>, pg8::StaticOrder, true, true>(F.lds, g, S, E);
        if (BOTH(5)) GRID_SYNC();
    }
    PB_END(6, F.lds);
    PB_START(7, F.lds);
    if (IN(6)) { { int t_ = threadIdx.x; asm volatile("" : "+v"(t_)); F.tid = t_; F.lane = t_ & 63; }
        __syncthreads();
        ln_rows<false>(F);
        __syncthreads();
        transpose_matrix(F, F.in[I_WM1], DM, DFF, (bf16*)(ws + WS_WM1), DM, 0, 0, (int)blockIdx.x, F.G);
        transpose_matrix(F, F.in[I_WM2], DFF, DM, (bf16*)(ws + WS_WM2), DFF, 0, 0, (int)blockIdx.x, F.G);
        if (BOTH(6)) GRID_SYNC();
    }
    PB_END(7, F.lds);
    PB_START(8, F.lds);
    if (IN(7)) { { int t_ = threadIdx.x; asm volatile("" : "+v"(t_)); F.tid = t_; F.lane = t_ & 63; }
        __syncthreads();
        pg8::Gemm g{(const pg8::bf16_t*)(ws + WS_H), (const pg8::bf16_t*)(ws + WS_WM1), MTOK, DFF, DM}; pg8::StaticOrder S; S.init(MTOK, DFF, F.G, (int)blockIdx.x);
        pg8::EpiG4 E{(pg8::bf16_t*)(ws + WS_AFF), F.in[I_BM1]};
        pg8::gemm_phase<pg8::EpiG4, pg8::StaticOrder, true, true>(F.lds, g, S, E);
        if (BOTH(7)) GRID_SYNC();
    }
    PB_END(8, F.lds);
    PB_START(9, F.lds);
    if (IN(8)) { { int t_ = threadIdx.x; asm volatile("" : "+v"(t_)); F.tid = t_; F.lane = t_ & 63; }
        pg8::Gemm g{(const pg8::bf16_t*)(ws + WS_AFF), (const pg8::bf16_t*)(ws + WS_WM2), MTOK, DM, DFF}; pg8::StaticOrder S; S.init(MTOK, DM, F.G, (int)blockIdx.x);
        pg8::EpiRes<false> E{nullptr, F.out, (const float*)(ws + WS_MOD) + 5 * DM, F.in[I_BM2], F.in[I_LN1G], F.in[I_LN1B], (const float*)(ws + WS_MU1), (float*)(ws + WS_ST2)};
        pg8::gemm_phase<pg8::EpiRes<false>, pg8::StaticOrder, true, true>(F.lds, g, S, E);
        if (BOTH(8)) GRID_SYNC();
    }
    PB_END(9, F.lds);
    PB_START(10, F.lds);
    if (IN(9)) { { int t_ = threadIdx.x; asm volatile("" : "+v"(t_)); F.tid = t_; F.lane = t_ & 63; } ln_rows<true>(F); }
    PB_END(10, F.lds);
    if (PROBE_ID != 0 && blockIdx.x == 0 && threadIdx.x == 0) { const unsigned long long wait_ = *(volatile LAS unsigned long long*)(F.lds + PB_LDS_OFF), t0_ = __builtin_amdgcn_s_memrealtime();
        while (__builtin_amdgcn_s_memrealtime() - t0_ < wait_) __builtin_amdgcn_s_sleep(8); }
#undef IN
#undef BOTH
}

constexpr int N_PHASES = 10;
#ifndef MK_N_LAUNCHES
#define MK_N_LAUNCHES 1
#endif
extern "C" void kernel_launch(void* const* d_in, const int* in_sizes, int n_in, void* d_out, int out_size, void* d_ws, size_t ws_size, hipStream_t stream) {
    static int grid = 0;
    if (grid == 0) {
        if (n_in != 31 || in_sizes[0] != MTOK * DM || out_size != MTOK * DM || ws_size < WS_END) {
            fprintf(stderr, "kernel_launch: unexpected problem: n_in %d in0 %d out %d ws %zu (need %zu)\n", n_in, n_in > 0 ? in_sizes[0] : -1, out_size, ws_size, (size_t)WS_END); grid = -1; return; }
        int dev = 0, cus = 0, per_cu = 0;
        if (hipGetDevice(&dev) != hipSuccess || hipDeviceGetAttribute(&cus, hipDeviceAttributeMultiprocessorCount, dev) != hipSuccess) { grid = -1; return; }
        if (hipFuncSetAttribute((const void*)fwd_megakernel, hipFuncAttributeMaxDynamicSharedMemorySize, LDS_BYTES) != hipSuccess) { fprintf(stderr, "kernel_launch: hipFuncSetAttribute failed\n"); grid = -1; return; }
        if (hipOccupancyMaxActiveBlocksPerMultiprocessor(&per_cu, (const void*)fwd_megakernel, NWAVES * 64, LDS_BYTES) != hipSuccess || per_cu < 1) { fprintf(stderr, "kernel_launch: occupancy query says %d\n", per_cu); per_cu = 1; }
        (void)hipGetLastError();
        grid = cus;
    }
    if (grid < 0) return;
    if (hipMemsetAsync((char*)d_ws + WS_CTL, 0, CTL_ZERO_BYTES, stream) != hipSuccess) { fprintf(stderr, "kernel_launch: memset failed\n"); return; }
    Args a{};
    for (int i = 0; i < 31; ++i) a.in[i] = (const float*)d_in[i];
    a.out = (float*)d_out; a.ws = (unsigned char*)d_ws;
    if (MK_N_LAUNCHES == 1) {
        a.ph_lo = 0; a.ph_hi = N_PHASES;
        void* kargs[] = {&a};
        hipError_t e = hipLaunchCooperativeKernel((const void*)fwd_megakernel, dim3(grid), dim3(NWAVES * 64), kargs, LDS_BYTES, stream);
        if (e != hipSuccess) fprintf(stderr, "kernel_launch: cooperative launch failed: %s (grid %d)\n", hipGetErrorString(e), grid);
    } else {
        for (int p = 0; p < N_PHASES; ++p) { a.ph_lo = p; a.ph_hi = p + 1; hipLaunchKernelGGL(fwd_megakernel, dim3(grid), dim3(NWAVES * 64), LDS_BYTES, stream, a); }
    }
}
```

```cpp
#include <hip/hip_runtime.h>
#include <cstdio>
#include <cstdint>

#ifndef PROBE_ID
#define PROBE_ID 0
#endif
#define PB_LDS_OFF (163840 - 512 + 128)
#define PB_START(id, ldsp) do { if (PROBE_ID == (id) && blockIdx.x == 0 && threadIdx.x == 0) { *(volatile __attribute__((address_space(3))) unsigned long long*)((ldsp) + PB_LDS_OFF + 8) = __builtin_amdgcn_s_memrealtime(); } } while (0)
#define PB_END(id, ldsp) do { if (PROBE_ID == (id) && blockIdx.x == 0 && threadIdx.x == 0) { volatile __attribute__((address_space(3))) unsigned long long* pb_ = (volatile __attribute__((address_space(3))) unsigned long long*)((ldsp) + PB_LDS_OFF); pb_[0] += __builtin_amdgcn_s_memrealtime() - pb_[1]; } } while (0)
namespace pg8 {
#define PG8_LAS __attribute__((address_space(3)))
typedef unsigned short bf16_t;
typedef short bf16x8 __attribute__((ext_vector_type(8)));
typedef float f32x4 __attribute__((ext_vector_type(4)));
typedef unsigned u32x4 __attribute__((ext_vector_type(4)));
typedef float f32x2 __attribute__((ext_vector_type(2)));
constexpr int EPI_LDS_OFF = 131072;
constexpr int BM = 256, BK = 64, HALF = 128, HTB = HALF * BK * 2  , STAGE_BYTES = 8 * HTB, NXCD = 8, WGM = 8;

__host__ __device__ __forceinline__ int lds_byte(int r, int c) { const int st = (r >> 4) * 2 + (c >> 5), rr = r & 15, cc = c & 31, ob = rr * 64 + cc * 2; return st * 1024 + (ob ^ (((ob >> 9) & 1) << 5)); }
__host__ __device__ __forceinline__ void stage_rc(int b, int& R, int& C) { const int st = b / 1024, sb = b % 1024, swz = sb ^ (((sb >> 9) & 1) << 5); R = (st >> 1) * 16 + swz / 64; C = (st & 1) * 32 + (swz % 64) / 2; }
__host__ __device__ __forceinline__ int perm32(int rho) { const int n = rho >> 4, i = rho & 15; return 8 * (i >> 2) + 4 * n + (i & 3); }

struct Unit { int pm, pn; };
struct Gemm { const bf16_t* A; const bf16_t* Bt; int M, N, K; };

struct StaticOrder {
    int nM, nN, nwg, G, c;
    __host__ __device__ void init(int M, int N, int G_, int c_) { nM = M / BM; nN = N / BM; nwg = nM * nN; G = G_; c = c_; }
    __host__ __device__ bool next(int i, Unit& u) const {
        const long L = (long)i * G + c; if (L >= nwg) return false;
        int wgid = (int)L; { const int q = nwg / NXCD, r = nwg % NXCD, xcd = wgid % NXCD, off = wgid / NXCD; wgid = (xcd < r ? xcd * (q + 1) : r * (q + 1) + (xcd - r) * q) + off; }
        const int nig = WGM * nN, gid = wgid / nig, fm = gid * WGM, gsz = (nM - fm) < WGM ? (nM - fm) : WGM;
        u.pm = fm + ((wgid % nig) % gsz); u.pn = (wgid % nig) / gsz; return true;
    }
    __device__ __forceinline__ void a_ready(const Unit&) const {}
    __device__ __forceinline__ void done(const Unit&) const {}
};

__device__ __forceinline__ unsigned cvt_pk_bf16(float lo, float hi) { unsigned r; asm volatile("v_cvt_pk_bf16_f32 %0, %1, %2" : "=v"(r) : "v"(lo), "v"(hi)); return r; }
__device__ __forceinline__ f32x2 gelu_pk(f32x2 v) {
    const f32x2 av = __builtin_elementwise_abs(v), d = av * 0.2316418882f + 1.0f;
    f32x2 t; t.x = __builtin_amdgcn_rcpf(d.x); t.y = __builtin_amdgcn_rcpf(d.y);
    f32x2 q = t * 0.5307027145f + (-0.7265760135f); q = q * t + 0.7107068705f; q = q * t + (-0.142248368f); q = q * t + 0.127414796f; q = q * t;
    const f32x2 s = (v * v) * (-0.72134752044f);
    f32x2 e; e.x = __builtin_amdgcn_exp2f(s.x); e.y = __builtin_amdgcn_exp2f(s.y);
    const f32x2 m = v * (q * e), r = v - m;
    f32x2 o; o.x = v.x < 0.f ? m.x : r.x; o.y = v.y < 0.f ? m.y : r.y; return o;
}
__device__ __forceinline__ float bf_lo(unsigned w) { return __uint_as_float(w << 16); }
__device__ __forceinline__ float bf_hi(unsigned w) { return __uint_as_float(w & 0xffff0000u); }
__device__ __forceinline__ float sigmoid_f(float x) { return __builtin_amdgcn_rcpf(1.0f + __expf(-x)); }
}

constexpr int DM = 2048, NBATCH = 8, SEQ = 2048, MTOK = NBATCH * SEQ;
constexpr int SGUW = 1024, HYW = 1024, DFF = 8192, INW = 9216, MODW = 6 * DM;
constexpr float LN_EPS = 1e-5f;
constexpr float DN_ALPHA = 1.189207115002721f;

namespace pg8 {

struct EpiG1 {
    static constexpr bool PERM = true, AFTER_DRAIN = false, MID = false; static constexpr int SLOT_FLOATS = 256;
    bf16_t* U; bf16_t* G; const float* b_in;
    __device__ __forceinline__ void mid(f32x4 (&)[2][2][4][2], const Unit&, int, int, int, int) const {}
    __device__ __forceinline__ void preload(PG8_LAS float* slot, const Unit& u, int tid) const { if (tid < 256) slot[tid] = b_in[(u.pn < 4 ? u.pn * 256 : 5120 + (u.pn - 4) * 256) + tid]; }
    __device__ __forceinline__ void operator()(const f32x4 (&acc)[2][2][4][2], const Unit& u, int wr, int wc, int fr, int fq, const PG8_LAS float* slot) const {
        const int row0 = u.pm * BM + wr * 64 + fr; const int pn = u.pn;
        int ldc, colt; bf16_t* base; const bool isu = pn < 4;
        if (isu) { base = U; ldc = SGUW; colt = pn * 256; }
        else { base = G; ldc = 2 * DM; colt = (pn - 4) * 256; }
        const int cl = wc * 64 + 8 * fq;
        f32x4 bv[2][2];
#pragma unroll
        for (int bj = 0; bj < 2; ++bj)
#pragma unroll
            for (int n = 0; n < 2; ++n) bv[bj][n] = *(const PG8_LAS f32x4*)(slot + cl + bj * 32 + 4 * n);
#pragma unroll
        for (int ai = 0; ai < 2; ++ai)
#pragma unroll
            for (int m = 0; m < 4; ++m) {
                const int row = row0 + ai * HALF + m * 16;
                bf16_t* rowp = base + (size_t)row * ldc + colt + cl;
#pragma unroll
                for (int bj = 0; bj < 2; ++bj) {
                    f32x4 v0 = acc[ai][bj][m][0] + bv[bj][0], v1 = acc[ai][bj][m][1] + bv[bj][1];
                    if (isu) {
                        f32x2 a = gelu_pk((f32x2){v0[0], v0[1]}), b = gelu_pk((f32x2){v0[2], v0[3]}), c = gelu_pk((f32x2){v1[0], v1[1]}), d = gelu_pk((f32x2){v1[2], v1[3]});
                        v0 = (f32x4){a.x, a.y, b.x, b.y}; v1 = (f32x4){c.x, c.y, d.x, d.y};
                    } else {
                        v0 = (f32x4){sigmoid_f(v0[0]), sigmoid_f(v0[1]), sigmoid_f(v0[2]), sigmoid_f(v0[3])};
                        v1 = (f32x4){sigmoid_f(v1[0]), sigmoid_f(v1[1]), sigmoid_f(v1[2]), sigmoid_f(v1[3])};
                    }
                    u32x4 w; w.x = cvt_pk_bf16(v0[0], v0[1]); w.y = cvt_pk_bf16(v0[2], v0[3]); w.z = cvt_pk_bf16(v1[0], v1[1]); w.w = cvt_pk_bf16(v1[2], v1[3]);
                    *(u32x4*)(rowp + bj * 32) = w;
                }
            }
    }
};

struct EpiG1T {
    static constexpr bool PERM = true, AFTER_DRAIN = false, MID = false;
    bf16_t* VT; bf16_t* ZHT; const float* b_in; float* statsV; static constexpr int SLOT_FLOATS = 256;
    __device__ __forceinline__ void mid(f32x4 (&)[2][2][4][2], const Unit&, int, int, int, int) const {}
    __device__ __forceinline__ void preload(PG8_LAS float* slot, const Unit& u, int tid) const { if (tid < 256) slot[tid] = b_in[1024 + u.pm * 256 + tid]; }
    __device__ __forceinline__ void operator()(const f32x4 (&acc)[2][2][4][2], const Unit& u, int wr, int wc, int fr, int fq, const PG8_LAS float* slot) const {
        const int col0 = u.pn * BM + wc * 64 + 8 * fq; const bool isv = u.pm < 4;
        const int rowt = (isv ? u.pm : u.pm - 4) * BM + wr * 64 + fr;
        bf16_t* base = isv ? VT : ZHT;
#pragma unroll
        for (int ai = 0; ai < 2; ++ai) {
            float s[2][8], q[2][8];
#pragma unroll
            for (int bj = 0; bj < 2; ++bj)
#pragma unroll
                for (int e = 0; e < 8; ++e) { s[bj][e] = 0.f; q[bj][e] = 0.f; }
#pragma unroll
            for (int m = 0; m < 4; ++m) {
                const int row = rowt + ai * HALF + m * 16; const float bb = slot[wr * 64 + fr + ai * HALF + m * 16];
                bf16_t* rowp = base + (size_t)row * MTOK + col0;
#pragma unroll
                for (int bj = 0; bj < 2; ++bj) {
                    f32x4 v0 = acc[ai][bj][m][0] + bb, v1 = acc[ai][bj][m][1] + bb;
                    if (isv) {
                        f32x2 a = gelu_pk((f32x2){v0[0], v0[1]}), b = gelu_pk((f32x2){v0[2], v0[3]}), c = gelu_pk((f32x2){v1[0], v1[1]}), d = gelu_pk((f32x2){v1[2], v1[3]});
                        v0 = (f32x4){a.x, a.y, b.x, b.y}; v1 = (f32x4){c.x, c.y, d.x, d.y};
                    }
                    u32x4 w; w.x = cvt_pk_bf16(v0[0], v0[1]); w.y = cvt_pk_bf16(v0[2], v0[3]); w.z = cvt_pk_bf16(v1[0], v1[1]); w.w = cvt_pk_bf16(v1[2], v1[3]);
                    *(u32x4*)(rowp + bj * 32) = w;
                    if (isv) {
                        const float e0 = bf_lo(w.x), e1 = bf_hi(w.x), e2 = bf_lo(w.y), e3 = bf_hi(w.y), e4 = bf_lo(w.z), e5 = bf_hi(w.z), e6 = bf_lo(w.w), e7 = bf_hi(w.w);
                        s[bj][0] += e0; s[bj][1] += e1; s[bj][2] += e2; s[bj][3] += e3; s[bj][4] += e4; s[bj][5] += e5; s[bj][6] += e6; s[bj][7] += e7;
                        q[bj][0] += e0 * e0; q[bj][1] += e1 * e1; q[bj][2] += e2 * e2; q[bj][3] += e3 * e3; q[bj][4] += e4 * e4; q[bj][5] += e5 * e5; q[bj][6] += e6 * e6; q[bj][7] += e7 * e7;
                    }
                }
            }
            if (isv) {
                const int slot = u.pm * 4 + ai * 2 + wr;
#pragma unroll
                for (int bj = 0; bj < 2; ++bj)
#pragma unroll
                    for (int e = 0; e < 8; ++e) {
                        float a = s[bj][e], b = q[bj][e];
                        a += __shfl_xor(a, 1); b += __shfl_xor(b, 1); a += __shfl_xor(a, 2); b += __shfl_xor(b, 2);
                        a += __shfl_xor(a, 4); b += __shfl_xor(b, 4); a += __shfl_xor(a, 8); b += __shfl_xor(b, 8);
                        if (fr == 0) *(f32x2*)(statsV + ((size_t)(col0 + bj * 32 + e) * 16 + slot) * 2) = (f32x2){a, b};
                    }
            }
        }
    }
};

struct EpiG2 {
    static constexpr bool PERM = true, AFTER_DRAIN = false, MID = true;
    const bf16_t* G; bf16_t* O; static constexpr int SLOT_FLOATS = 0;
    __device__ __forceinline__ void preload(PG8_LAS float*, const Unit&, int) const {}
    __device__ __forceinline__ void mid(f32x4 (&acc)[2][2][4][2], const Unit& u, int wr, int wc, int fr, int fq) const {
        int row0 = u.pm * BM + wr * 64 + fr, col0 = u.pn * BM + wc * 64 + 8 * fq;
        asm volatile("" : "+v"(row0), "+v"(col0));
#pragma unroll
        for (int ai = 0; ai < 2; ++ai)
#pragma unroll
            for (int m = 0; m < 4; ++m) {
                const bf16_t* gp = G + (size_t)(row0 + ai * HALF + m * 16) * (2 * DM) + col0;
#pragma unroll
                for (int bj = 0; bj < 2; ++bj) {
                    const u32x4 ga = *(const u32x4*)(gp + bj * 32), gb = *(const u32x4*)(gp + DM + bj * 32);
                    f32x4 r0, r1;
                    r0[0] = bf_lo(ga.x) * __builtin_amdgcn_rcpf(bf_lo(gb.x)); r0[1] = bf_hi(ga.x) * __builtin_amdgcn_rcpf(bf_hi(gb.x));
                    r0[2] = bf_lo(ga.y) * __builtin_amdgcn_rcpf(bf_lo(gb.y)); r0[3] = bf_hi(ga.y) * __builtin_amdgcn_rcpf(bf_hi(gb.y));
                    r1[0] = bf_lo(ga.z) * __builtin_amdgcn_rcpf(bf_lo(gb.z)); r1[1] = bf_hi(ga.z) * __builtin_amdgcn_rcpf(bf_hi(gb.z));
                    r1[2] = bf_lo(ga.w) * __builtin_amdgcn_rcpf(bf_lo(gb.w)); r1[3] = bf_hi(ga.w) * __builtin_amdgcn_rcpf(bf_hi(gb.w));
                    acc[ai][bj][m][0] *= r0; acc[ai][bj][m][1] *= r1;
                }
            }
    }
    __device__ __forceinline__ void operator()(const f32x4 (&acc)[2][2][4][2], const Unit& u, int wr, int wc, int fr, int fq, const PG8_LAS float*) const {
        const int row0 = u.pm * BM + wr * 64 + fr, col0 = u.pn * BM + wc * 64 + 8 * fq;
#pragma unroll
        for (int ai = 0; ai < 2; ++ai)
#pragma unroll
            for (int m = 0; m < 4; ++m) {
                const int row = row0 + ai * HALF + m * 16;
                const bf16_t* gp = G + (size_t)row * (2 * DM) + DM + col0;
                bf16_t* op = O + (size_t)row * DM + col0;
#pragma unroll
                for (int bj = 0; bj < 2; ++bj) {
                    const u32x4 gb = *(const u32x4*)(gp + bj * 32);
                    const f32x4 a0 = acc[ai][bj][m][0], a1 = acc[ai][bj][m][1];
                    u32x4 w; w.x = cvt_pk_bf16(a0[0] * bf_lo(gb.x), a0[1] * bf_hi(gb.x)); w.y = cvt_pk_bf16(a0[2] * bf_lo(gb.y), a0[3] * bf_hi(gb.y));
                    w.z = cvt_pk_bf16(a1[0] * bf_lo(gb.z), a1[1] * bf_hi(gb.z)); w.w = cvt_pk_bf16(a1[2] * bf_lo(gb.w), a1[3] * bf_hi(gb.w));
                    *(u32x4*)(op + bj * 32) = w;
                }
            }
    }
};

template <bool FIRST> struct EpiRes {
    static constexpr bool PERM = false, AFTER_DRAIN = false, MID = false; static constexpr int SLOT_FLOATS = FIRST ? 512 : 1024;
    const float* X;
    float* R;
    const float* gate;
    const float* bias;
    const float* lng; const float* lnb; const float* MU;
    float* stats;
    __device__ __forceinline__ void mid(f32x4 (&)[2][2][4][2], const Unit&, int, int, int, int) const {}
    __device__ __forceinline__ void preload(PG8_LAS float* slot, const Unit& u, int tid) const {
        const int c = tid & 255, col = u.pn * BM + c;
        if (tid < 256) slot[c] = gate[(size_t)(u.pm >> 3) * MODW + col]; else slot[256 + c] = bias[col];
        if (!FIRST) { if (tid < 256) slot[512 + c] = DN_ALPHA * lng[col]; else slot[768 + c] = DN_ALPHA * lnb[col]; }
    }
    __device__ __forceinline__ void operator()(const f32x4 (&acc)[2][2][4][2], const Unit& u, int wr, int wc, int fr, int fq, const PG8_LAS float* slot) const {
        int row0 = u.pm * BM + wr * 64 + fr; const int cl = wc * 32 + 4 * fq; int col0 = u.pn * BM + cl;
        asm volatile("" : "+v"(row0), "+v"(col0));
        constexpr int RB = FIRST ? 2 : 1;
#pragma unroll
        for (int ab = 0; ab < 8 / RB; ++ab) {
            const int ai = (ab * RB) >> 2, mb = (ab * RB) & 3;
            f32x4 base[RB][2][2]; f32x2 mr[RB];
            int rowb = row0 + ai * HALF + mb * 16; asm volatile("" : "+v"(rowb));
#pragma unroll
            for (int mm = 0; mm < RB; ++mm) {
                const size_t off = (size_t)(rowb + mm * 16) * DM + col0;
                if (!FIRST) mr[mm] = *(const f32x2*)(MU + (size_t)(rowb + mm * 16) * 2);
#pragma unroll
                for (int bj = 0; bj < 2; ++bj)
#pragma unroll
                    for (int n = 0; n < 2; ++n) base[mm][bj][n] = FIRST ? *(const f32x4*)(X + off + bj * HALF + n * 16) : *(const f32x4*)(R + off + bj * HALF + n * 16);
            }
#pragma unroll
            for (int mm = 0; mm < RB; ++mm) {
                const int m = mb + mm;
                const int row = rowb + mm * 16; float* rp = R + (size_t)row * DM + col0;
                float s = 0.f, q = 0.f;
#pragma unroll
                for (int bj = 0; bj < 2; ++bj)
#pragma unroll
                    for (int n = 0; n < 2; ++n) {
                        const int co = bj * HALF + n * 16;
                        const f32x4 gv = *(const PG8_LAS f32x4*)(slot + cl + co), bv = *(const PG8_LAS f32x4*)(slot + 256 + cl + co);
                        f32x4 bs;
                        if (FIRST) bs = base[mm][bj][n] * DN_ALPHA;
                        else bs = (base[mm][bj][n] - mr[mm].x) * mr[mm].y * *(const PG8_LAS f32x4*)(slot + 512 + cl + co) + *(const PG8_LAS f32x4*)(slot + 768 + cl + co);
                        const f32x4 o = bs + gv * (acc[ai][bj][m][n] + bv);
                        *(f32x4*)(rp + co) = o;
                        s += (o[0] + o[1]) + (o[2] + o[3]); q += (o[0] * o[0] + o[1] * o[1]) + (o[2] * o[2] + o[3] * o[3]);
                    }
                s += __shfl_xor(s, 16); s += __shfl_xor(s, 32); q += __shfl_xor(q, 16); q += __shfl_xor(q, 32);
                if (fq == 0) *(f32x2*)(stats + ((size_t)row * 32 + u.pn * 4 + wc) * 2) = (f32x2){s, q};
            }
            asm volatile("" ::: "memory");
        }
    }
};

struct EpiG4 {
    static constexpr bool PERM = true, AFTER_DRAIN = false, MID = false; static constexpr int SLOT_FLOATS = 256;
    bf16_t* O; const float* bias;
    __device__ __forceinline__ void mid(f32x4 (&)[2][2][4][2], const Unit&, int, int, int, int) const {}
    __device__ __forceinline__ void preload(PG8_LAS float* slot, const Unit& u, int tid) const { if (tid < 256) slot[tid] = bias[u.pn * BM + tid]; }
    __device__ __forceinline__ void operator()(const f32x4 (&acc)[2][2][4][2], const Unit& u, int wr, int wc, int fr, int fq, const PG8_LAS float* slot) const {
        const int row0 = u.pm * BM + wr * 64 + fr, cl = wc * 64 + 8 * fq, col0 = u.pn * BM + cl;
        f32x4 bv[2][2];
#pragma unroll
        for (int bj = 0; bj < 2; ++bj)
#pragma unroll
            for (int n = 0; n < 2; ++n) bv[bj][n] = *(const PG8_LAS f32x4*)(slot + cl + bj * 32 + 4 * n);
#pragma unroll
        for (int ai = 0; ai < 2; ++ai)
#pragma unroll
            for (int m = 0; m < 4; ++m) {
                bf16_t* rowp = O + (size_t)(row0 + ai * HALF + m * 16) * DFF + col0;
#pragma unroll
                for (int bj = 0; bj < 2; ++bj) {
                    f32x4 v0 = acc[ai][bj][m][0] + bv[bj][0], v1 = acc[ai][bj][m][1] + bv[bj][1];
                    v0 = __builtin_elementwise_max(v0, (f32x4){0.f, 0.f, 0.f, 0.f}); v1 = __builtin_elementwise_max(v1, (f32x4){0.f, 0.f, 0.f, 0.f});
                    v0 = v0 * v0; v1 = v1 * v1;
                    u32x4 w; w.x = cvt_pk_bf16(v0[0], v0[1]); w.y = cvt_pk_bf16(v0[2], v0[3]); w.z = cvt_pk_bf16(v1[0], v1[1]); w.w = cvt_pk_bf16(v1[2], v1[3]);
                    *(u32x4*)(rowp + bj * 32) = w;
                }
            }
    }
};
}
namespace pg8 {
template <class Epi, class Sched, bool ALIGN_EPI = false, bool SP2 = false>
__device__ __forceinline__ void gemm_phase(PG8_LAS unsigned char* lds, const Gemm g, const Sched& S, const Epi& E) {
    const int tid = threadIdx.x, wid = __builtin_amdgcn_readfirstlane(tid >> 6), lane = tid & 63, wr = wid >> 2, wc = wid & 3, fr = lane & 15, fq = lane >> 4;
    const int K = g.K, nt = K / BK;
    unsigned voffA[2], voffB[2];
#pragma unroll
    for (int i = 0; i < 2; ++i) { int R, C; stage_rc(tid * 16 + i * 8192, R, C); const int Rb = Epi::PERM ? ((R & ~31) + perm32(R & 31)) : R;
        const int Rw = Epi::PERM ? ((R >> 5) * 64 + perm32(R & 31)) : R;
        voffA[i] = (unsigned)(R * K + C) * 2u; voffB[i] = (unsigned)(Rw * K + C) * 2u; (void)Rb; }
    const size_t kstep = (size_t)(BK * 2);
    const size_t hstep = (size_t)HALF * K * 2;
    const size_t tstep = 2 * hstep;
    const size_t hstepB = Epi::PERM ? (size_t)32 * K * 2 : hstep;
    const unsigned ldsw = (unsigned)wid * 1024u;
    const int aoff = lds_byte(wr * 64 + fr, fq * 8), boff = lds_byte(wc * 32 + fr, fq * 8);
#define PG8_SA(b, h) (((b) * 2 + (h)) * HTB)
#define PG8_SB(b, h) ((4 + (b) * 2 + (h)) * HTB)
#define PG8_STAGE(bufoff, gbase, voff) do { _Pragma("unroll") for (int _i = 0; _i < 2; ++_i) \
        __builtin_amdgcn_global_load_lds((const unsigned*)((const char*)(gbase) + (voff)[_i]), (PG8_LAS unsigned*)(lds + (bufoff) + ldsw + _i * 8192), 16, 0, 0); } while (0)
#define PG8_LDA(dst, b, h) do { _Pragma("unroll") for (int m = 0; m < 4; ++m) _Pragma("unroll") for (int k = 0; k < 2; ++k) dst[m][k] = *(const PG8_LAS bf16x8*)(lds + PG8_SA(b, h) + aoff + m * 2048 + k * 1024); } while (0)
#define PG8_LDB(dst, b, h) do { _Pragma("unroll") for (int n = 0; n < 2; ++n) _Pragma("unroll") for (int k = 0; k < 2; ++k) dst[n][k] = *(const PG8_LAS bf16x8*)(lds + PG8_SB(b, h) + boff + n * 2048 + k * 1024); } while (0)
#define PG8_MMA(ai, bj, At, Bt) do { __builtin_amdgcn_s_setprio(1); _Pragma("unroll") for (int m = 0; m < 4; ++m) _Pragma("unroll") for (int n = 0; n < 2; ++n) _Pragma("unroll") for (int k = 0; k < 2; ++k) \
        acc[ai][bj][m][n] = __builtin_amdgcn_mfma_f32_16x16x32_bf16(Bt[n][k], At[m][k], acc[ai][bj][m][n], 0, 0, 0); __builtin_amdgcn_s_setprio(0); } while (0)
#define PG8_WAIT_V(n) asm volatile("s_waitcnt vmcnt(" #n ")" ::: "memory")
#define PG8_WAIT_L(n) asm volatile("s_waitcnt lgkmcnt(" #n ")" ::: "memory")
#define PG8_BAR __builtin_amdgcn_s_barrier()
#define PG8_SCHED __builtin_amdgcn_sched_barrier(0)
    Unit cur, nxt; int ui = 0;
    if (!S.next(0, cur)) return;
    {
        Unit pu; for (int i = 0; S.next(i, pu); ++i) E.preload((PG8_LAS float*)(lds + EPI_LDS_OFF) + i * Epi::SLOT_FLOATS, pu, tid);
        asm volatile("s_waitcnt vmcnt(0) lgkmcnt(0)" ::: "memory"); __builtin_amdgcn_s_barrier(); asm volatile("" ::: "memory");
    }
    f32x4 acc[2][2][4][2];
#pragma unroll
    for (int a = 0; a < 2; ++a)
#pragma unroll
        for (int b = 0; b < 2; ++b)
#pragma unroll
            for (int m = 0; m < 4; ++m)
#pragma unroll
                for (int n = 0; n < 2; ++n) acc[a][b][m][n] = (f32x4){0.f, 0.f, 0.f, 0.f};
    bf16x8 At[4][2], B0[2][2], B1[2][2];
    const char* cA = (const char*)g.A + (size_t)cur.pm * tstep; const char* cB = (const char*)g.Bt + (size_t)cur.pn * tstep;
    S.a_ready(cur);
    if constexpr (SP2) {
        PG8_STAGE(PG8_SB(0, 0), cB, voffB); PG8_STAGE(PG8_SB(0, 1), cB + hstepB, voffB); PG8_STAGE(PG8_SA(0, 0), cA, voffA); PG8_STAGE(PG8_SA(0, 1), cA + hstep, voffA);
        if (wr == 1) PG8_BAR;
        PG8_WAIT_V(2); PG8_BAR;
        PG8_STAGE(PG8_SB(1, 0), cB + kstep, voffB); PG8_STAGE(PG8_SA(1, 0), cA + kstep, voffA); PG8_STAGE(PG8_SB(1, 1), cB + hstepB + kstep, voffB);
        PG8_WAIT_V(6); PG8_BAR;
    } else {
        PG8_STAGE(PG8_SB(0, 0), cB, voffB); PG8_STAGE(PG8_SA(0, 0), cA, voffA); PG8_STAGE(PG8_SB(0, 1), cB + hstepB, voffB); PG8_STAGE(PG8_SA(0, 1), cA + hstep, voffA);
        if (wr == 1) PG8_BAR;
        PG8_WAIT_V(4); PG8_BAR;
        PG8_STAGE(PG8_SB(1, 0), cB + kstep, voffB); PG8_STAGE(PG8_SA(1, 0), cA + kstep, voffA); PG8_STAGE(PG8_SB(1, 1), cB + hstepB + kstep, voffB);
        PG8_WAIT_V(6); PG8_BAR;
    }
    for (;;) {
        const bool has_next = S.next(ui + 1, nxt);
        const char* nA = has_next ? (const char*)g.A + (size_t)nxt.pm * tstep : cA; const char* nB = has_next ? (const char*)g.Bt + (size_t)nxt.pn * tstep : cB;
        for (int t = 0; t < nt; t += 2) {
            const bool last = (t == nt - 2);
            const char* a1 = cA + (size_t)(t + 1) * kstep;
            const char* a2 = last ? nA : cA + (size_t)(t + 2) * kstep; const char* b2 = last ? nB : cB + (size_t)(t + 2) * kstep;
            const char* a3 = a2 + kstep; const char* b3 = b2 + kstep;
            if (last && has_next) S.a_ready(nxt);
            if constexpr (Epi::MID) { if (t == (nt >> 1)) E.mid(acc, cur, wr, wc, fr, fq); }
            if constexpr (SP2) {
            PG8_LDB(B0, 0, 0); PG8_LDB(B1, 0, 1); PG8_SCHED; PG8_LDA(At, 0, 0); PG8_STAGE(PG8_SA(1, 1), a1 + hstep, voffA);
            PG8_WAIT_V(8); PG8_WAIT_L(0); PG8_BAR; PG8_MMA(0, 0, At, B0); PG8_MMA(0, 1, At, B1); PG8_BAR; PG8_SCHED;
            PG8_LDA(At, 0, 1); PG8_STAGE(PG8_SB(0, 0), b2, voffB); PG8_STAGE(PG8_SB(0, 1), b2 + hstepB, voffB); PG8_STAGE(PG8_SA(0, 0), a2, voffA);
            PG8_WAIT_V(8); PG8_WAIT_L(0); PG8_BAR; PG8_MMA(1, 0, At, B0); PG8_MMA(1, 1, At, B1); PG8_BAR; PG8_SCHED;
            PG8_LDB(B0, 1, 0); PG8_LDB(B1, 1, 1); PG8_SCHED; PG8_LDA(At, 1, 0); PG8_STAGE(PG8_SA(0, 1), a2 + hstep, voffA);
            PG8_WAIT_V(8); PG8_WAIT_L(0); PG8_BAR; PG8_MMA(0, 0, At, B0); PG8_MMA(0, 1, At, B1); PG8_BAR; PG8_SCHED;
            PG8_LDA(At, 1, 1); PG8_STAGE(PG8_SB(1, 0), b3, voffB); PG8_STAGE(PG8_SB(1, 1), b3 + hstepB, voffB); PG8_STAGE(PG8_SA(1, 0), a3, voffA);
            PG8_WAIT_V(8); PG8_WAIT_L(0); PG8_BAR; PG8_MMA(1, 0, At, B0); PG8_MMA(1, 1, At, B1); PG8_BAR; PG8_SCHED;
            } else {
            PG8_LDB(B0, 0, 0); PG8_SCHED; PG8_LDA(At, 0, 0); PG8_STAGE(PG8_SA(1, 1), a1 + hstep, voffA);
            PG8_WAIT_L(8); PG8_BAR; PG8_WAIT_L(0); PG8_MMA(0, 0, At, B0); PG8_BAR; PG8_SCHED;
            PG8_LDB(B1, 0, 1); PG8_STAGE(PG8_SB(0, 0), b2, voffB);
            PG8_BAR; PG8_WAIT_L(0); PG8_MMA(0, 1, At, B1); PG8_BAR;
            PG8_LDA(At, 0, 1); PG8_STAGE(PG8_SA(0, 0), a2, voffA);
            PG8_BAR; PG8_WAIT_L(0); PG8_MMA(1, 0, At, B0); PG8_BAR; PG8_SCHED;
            PG8_STAGE(PG8_SB(0, 1), b2 + hstepB, voffB);
            PG8_WAIT_V(6); PG8_BAR; PG8_MMA(1, 1, At, B1); PG8_BAR;
            PG8_LDB(B0, 1, 0); PG8_SCHED; PG8_LDA(At, 1, 0); PG8_STAGE(PG8_SA(0, 1), a2 + hstep, voffA);
            PG8_WAIT_L(8); PG8_BAR; PG8_WAIT_L(0); PG8_MMA(0, 0, At, B0); PG8_BAR; PG8_SCHED;
            PG8_LDB(B1, 1, 1); PG8_STAGE(PG8_SB(1, 0), b3, voffB);
            PG8_BAR; PG8_WAIT_L(0); PG8_MMA(0, 1, At, B1); PG8_BAR;
            PG8_LDA(At, 1, 1); PG8_STAGE(PG8_SA(1, 0), a3, voffA);
            PG8_BAR; PG8_WAIT_L(0); PG8_MMA(1, 0, At, B0); PG8_BAR; PG8_SCHED;
            PG8_STAGE(PG8_SB(1, 1), b3 + hstepB, voffB);
            PG8_WAIT_V(6); PG8_BAR; PG8_MMA(1, 1, At, B1); PG8_BAR;
            }
        }
        if constexpr (ALIGN_EPI) { if (wr == 0) PG8_BAR; }
        if constexpr (!Epi::AFTER_DRAIN) { E(acc, cur, wr, wc, fr, fq, (const PG8_LAS float*)(lds + EPI_LDS_OFF) + ui * Epi::SLOT_FLOATS); S.done(cur); }
        if (!has_next) break;
#pragma unroll
        for (int a = 0; a < 2; ++a)
#pragma unroll
            for (int b = 0; b < 2; ++b)
#pragma unroll
                for (int m = 0; m < 4; ++m)
#pragma unroll
                    for (int n = 0; n < 2; ++n) acc[a][b][m][n] = (f32x4){0.f, 0.f, 0.f, 0.f};
        cur = nxt; cA = nA; cB = nB; ++ui;
        if constexpr (ALIGN_EPI) { if (wr == 1) PG8_BAR; }
    }
    PG8_WAIT_V(0);
    if constexpr (!ALIGN_EPI) { if (wr == 0) PG8_BAR; }
    PG8_BAR;
    if constexpr (Epi::AFTER_DRAIN) { E.fused(acc, cur, wr, wc, fr, fq, lds, wid, lane); S.done(cur); }
#undef PG8_SA
#undef PG8_SB
#undef PG8_STAGE
#undef PG8_LDA
#undef PG8_LDB
#undef PG8_MMA
#undef PG8_WAIT_V
#undef PG8_WAIT_L
#undef PG8_BAR
#undef PG8_SCHED
}
}

constexpr size_t MiB = 1u << 20;
constexpr size_t WS_CTL = 0;
constexpr size_t WS_MOD = 1 * MiB;
constexpr size_t WS_STV = 2 * MiB;
constexpr size_t WS_ST1 = 4 * MiB;
constexpr size_t WS_ST2 = 8 * MiB;
constexpr size_t WS_MU1 = 12 * MiB;
constexpr size_t WS_HID2 = 14 * MiB;
constexpr size_t WS_SGW = 13 * MiB;
constexpr size_t WS_WIN = 16 * MiB;
constexpr size_t WS_WAB = 52 * MiB;
constexpr size_t WS_WO = 60 * MiB;
constexpr size_t WS_FILT = 68 * MiB;
constexpr size_t WS_WM2 = 68 * MiB;
constexpr size_t WS_H = 100 * MiB;
constexpr size_t WS_U = 164 * MiB;
constexpr size_t WS_V = 196 * MiB;
constexpr size_t WS_MERGED = 164 * MiB;
constexpr size_t WS_ZHT = 228 * MiB;
constexpr size_t WS_G = 324 * MiB;
constexpr size_t WS_AFF = 164 * MiB;
constexpr size_t WS_WM1 = 420 * MiB;
constexpr size_t WS_YT = 452 * MiB;
constexpr size_t WS_END = 484 * MiB;

constexpr int NWAVES = 8;
constexpr int LDS_BYTES = 163840;

#define GAS __attribute__((address_space(1)))
#define LAS __attribute__((address_space(3)))
typedef unsigned short bf16;
typedef unsigned v4u __attribute__((ext_vector_type(4)));
typedef unsigned v2u __attribute__((ext_vector_type(2)));
typedef float f32x4 __attribute__((ext_vector_type(4)));
typedef float f32x2 __attribute__((ext_vector_type(2)));
#define LDS_WAIT() asm volatile("s_waitcnt lgkmcnt(0)" ::: "memory")

__device__ __forceinline__ unsigned f2bf(float f) { unsigned u = __builtin_bit_cast(unsigned, f); return (u + 0x7fffu + ((u >> 16) & 1u)) >> 16; }
__device__ __forceinline__ unsigned pk2(float lo, float hi) { return f2bf(lo) | (f2bf(hi) << 16); }
__device__ __forceinline__ float bflo(unsigned w) { return __uint_as_float(w << 16); }
__device__ __forceinline__ float bfhi(unsigned w) { return __uint_as_float(w & 0xffff0000u); }
__device__ __forceinline__ float bf1(bf16 h) { return __uint_as_float((unsigned)h << 16); }
__device__ __forceinline__ float wave_sum(float v) {
#pragma unroll
    for (int o = 1; o < 64; o <<= 1) v += __shfl_xor(v, o);
    return v;
}

struct Args { const float* in[31]; float* out; unsigned char* ws; int ph_lo, ph_hi; };

struct Frame {
    LAS unsigned char* lds;
    int tid, lane, wave, G;
    const float* const* in; float* out; unsigned char* ws;
};
enum { I_X = 0, I_C, I_WADA, I_BADA, I_WIN, I_BIN, I_SLNG, I_SLNB, I_SW, I_SB, I_HCW, I_HCB, I_HW1, I_HB1, I_HW2, I_HB2, I_HFREQ, I_HW3, I_HSKIP,
       I_WA, I_WB, I_WO, I_BO, I_LN1G, I_LN1B, I_WM1, I_BM1, I_WM2, I_BM2, I_LN2G, I_LN2B };

__device__ __forceinline__ void transpose_matrix(Frame& F, const float* W, int K, int N, bf16* WT, int ldk, int koff, int remap_win, int first, int nblocks) {
    LAS float* tile = (LAS float*)F.lds;
    const int tid = F.tid, nblk = N / 256, nitems = (K / 64) * nblk;
    const int lr = tid >> 6, lc = tid & 63;
    const int wc = tid & 7, wn = tid >> 3;
    for (int it = first; it < nitems; it += nblocks) {
        const int kb = it / nblk, nb = it % nblk, n0 = nb * 256, k0 = kb * 64; int row0 = n0;
        if (remap_win) row0 = (n0 < 1024) ? n0 : (n0 < 2048 ? n0 - 1024 + 5120 : (n0 < 5120 ? n0 - 2048 + 6144 : n0 - 5120 + 1024));
        f32x4 v[8];
#pragma unroll
        for (int i = 0; i < 8; ++i) v[i] = *(const f32x4*)(W + (size_t)(k0 + 8 * i + lr) * N + n0 + 4 * lc);
#pragma unroll
        for (int i = 0; i < 8; ++i) *(LAS f32x4*)(tile + (8 * i + lr) * 256 + ((lc ^ i) << 2)) = v[i];
        __syncthreads();
#pragma unroll
        for (int j = 0; j < 4; ++j) { const int n = wn + 64 * j; const LAS float* sp = tile + (8 * wc) * 256 + ((((n >> 2) ^ wc) << 2) | (n & 3));
            v4u o; o.x = pk2(sp[0 * 256], sp[1 * 256]); o.y = pk2(sp[2 * 256], sp[3 * 256]); o.z = pk2(sp[4 * 256], sp[5 * 256]); o.w = pk2(sp[6 * 256], sp[7 * 256]);
            *(GAS v4u*)(WT + (size_t)(row0 + n) * ldk + koff + k0 + 8 * wc) = o; }
        __syncthreads();
    }
}

__device__ __forceinline__ void p0_mod(Frame& F) {
    LAS float* condS = (LAS float*)F.lds;
    LAS float* red = (LAS float*)(F.lds + 65536);
    const float* c = F.in[I_C]; const float* w_ada = F.in[I_WADA]; const float* b_ada = F.in[I_BADA];
    float* mod = (float*)(F.ws + WS_MOD);
    const int tid = F.tid;
    for (int item = blockIdx.x; item < MODW / 48; item += F.G) {
        for (int i = tid; i < NBATCH * DM; i += NWAVES * 64) { const float v = c[i]; condS[i] = v / (1.0f + __expf(-v)); }
        __syncthreads();
        const int cq = tid % 12, kq = tid / 12, col0 = item * 48;
        if (kq < 32) {
            f32x4 acc[8];
#pragma unroll
            for (int b = 0; b < 8; ++b) acc[b] = (f32x4){0.f, 0.f, 0.f, 0.f};
            const float* wp = w_ada + (size_t)kq * MODW + col0 + cq * 4;
            for (int k = kq; k < DM; k += 256, wp += (size_t)256 * MODW) {
                f32x4 w[8];
#pragma unroll
                for (int u = 0; u < 8; ++u) w[u] = *(const f32x4*)(wp + (size_t)(32 * u) * MODW);
#pragma unroll
                for (int u = 0; u < 8; ++u)
#pragma unroll
                    for (int b = 0; b < 8; ++b) acc[b] += w[u] * condS[b * DM + k + 32 * u];
            }
#pragma unroll
            for (int b = 0; b < 8; ++b) *(LAS f32x4*)(red + (kq * 8 + b) * 48 + cq * 4) = acc[b];
        }
        __syncthreads();
        if (tid < 384) { const int b = tid / 48, col = tid % 48; float s = 0.f;
#pragma unroll 8
          for (int k2 = 0; k2 < 32; ++k2) s += red[(k2 * 8 + b) * 48 + col];
          mod[(size_t)b * MODW + col0 + col] = s + b_ada[col0 + col]; }
        __syncthreads();
    }
}

__device__ __forceinline__ void p0_hid2(Frame& F) {
    LAS float* scr = (LAS float*)F.lds + F.wave * 128;
    const float* w1 = F.in[I_HW1]; const float* b1 = F.in[I_HB1]; const float* w2 = F.in[I_HW2]; const float* b2 = F.in[I_HB2]; const float* freq = F.in[I_HFREQ];
    float* HID2 = (float*)(F.ws + WS_HID2);
    const int lane = F.lane;
    for (int l = blockIdx.x * NWAVES + F.wave; l < SEQ; l += F.G * NWAVES) {
        const float fr = freq[lane];
        const float tl = (float)l / (float)(SEQ - 1), omega = 6.283185307179586f * (float)l / (float)SEQ;
        float f = 0.f;
        if (lane == 0) f = tl;
        else if (lane <= 16) { const float band = 1e-4f + (float)(lane - 1) * ((15.0f - 1e-4f) / 15.0f); f = cosf(band * omega); }
        else if (lane <= 32) { const float band = 1e-4f + (float)(lane - 17) * ((15.0f - 1e-4f) / 15.0f); f = -sinf(band * omega); }
        scr[lane] = f; LDS_WAIT(); asm volatile("" ::: "memory");
        float a = b1[lane];
#pragma unroll 11
        for (int i = 0; i < 33; ++i) a += scr[i] * w1[i * 64 + lane];
        scr[64 + lane] = sinf(fr * a); LDS_WAIT(); asm volatile("" ::: "memory");
        a = b2[lane];
#pragma unroll 16
        for (int i = 0; i < 64; ++i) a += scr[64 + i] * w2[i * 64 + lane];
        HID2[(size_t)l * 64 + lane] = sinf(fr * a);
        LDS_WAIT(); asm volatile("" ::: "memory");
    }
}
__device__ __forceinline__ void p1_filter_waves(Frame& F) {
    const int fwl = F.wave - 4;
    LAS float* h2T = (LAS float*)F.lds + fwl * 512;
    const float* w3 = F.in[I_HW3]; const float* HID2 = (const float*)(F.ws + WS_HID2);
    float* FILT = (float*)(F.ws + WS_FILT);
    const int lane = F.lane;
    const float min_decay = -3.0701134573253943f, max_decay = -15.350567286626972f;
    for (int item = blockIdx.x * 4 + fwl; item < 2048; item += F.G * 4) {
        const int g8 = item >> 3, cb = item & 7;
        { const int pp = lane >> 3, i8 = (lane & 7) * 8; const float* hp = HID2 + (size_t)(g8 * 8 + pp) * 64 + i8;
          const f32x4 a = *(const f32x4*)hp, b = *(const f32x4*)(hp + 4);
          h2T[(i8 + 0) * 8 + pp] = a[0]; h2T[(i8 + 1) * 8 + pp] = a[1]; h2T[(i8 + 2) * 8 + pp] = a[2]; h2T[(i8 + 3) * 8 + pp] = a[3];
          h2T[(i8 + 4) * 8 + pp] = b[0]; h2T[(i8 + 5) * 8 + pp] = b[1]; h2T[(i8 + 6) * 8 + pp] = b[2]; h2T[(i8 + 7) * 8 + pp] = b[3];
          LDS_WAIT(); asm volatile("" ::: "memory"); }
        {
            const int j0 = cb * 512 + lane * 8;
            f32x4 acc[8][2];
#pragma unroll
            for (int p = 0; p < 8; ++p) { acc[p][0] = (f32x4){0.f, 0.f, 0.f, 0.f}; acc[p][1] = (f32x4){0.f, 0.f, 0.f, 0.f}; }
#pragma unroll 8
            for (int i = 0; i < 64; ++i) { const f32x4 wa = *(const f32x4*)(w3 + (size_t)i * 4096 + j0), wb = *(const f32x4*)(w3 + (size_t)i * 4096 + j0 + 4);
                const f32x4 h0 = *(const LAS f32x4*)(h2T + i * 8), h1 = *(const LAS f32x4*)(h2T + i * 8 + 4);
#pragma unroll
                for (int p = 0; p < 4; ++p) { acc[p][0] += wa * h0[p]; acc[p][1] += wb * h0[p]; acc[p + 4][0] += wa * h1[p]; acc[p + 4][1] += wb * h1[p]; } }
            float tp[8];
#pragma unroll
            for (int p = 0; p < 8; ++p) tp[p] = (float)(g8 * 8 + p) / (float)(SEQ - 1);
#pragma unroll
            for (int e = 0; e < 8; ++e) { const int j = j0 + e, ch = j & 1023; const float delta = fabsf(min_decay + (float)ch * ((max_decay - min_decay) / 1023.0f));
                float o[8];
#pragma unroll
                for (int p = 0; p < 8; ++p) o[p] = acc[p][e >> 2][e & 3] * __expf(-tp[p] * delta);
                float* op = FILT + (size_t)j * SEQ + g8 * 8;
                *(f32x4*)op = (f32x4){o[0], o[1], o[2], o[3]}; *(f32x4*)(op + 4) = (f32x4){o[4], o[5], o[6], o[7]}; }
        }
        LDS_WAIT(); asm volatile("" ::: "memory");
    }
}

__device__ __forceinline__ void p1_modulate(Frame& F) {
    const float* x = F.in[I_X]; const float* mod = (const float*)(F.ws + WS_MOD); bf16* H = (bf16*)(F.ws + WS_H);
    const size_t nvec = (size_t)MTOK * DM / 8, stride = (size_t)F.G * 256;
    for (size_t i0 = (size_t)blockIdx.x * 256 + F.tid; i0 < nvec; i0 += 4 * stride) {
        f32x4 xa[4], xb[4];
#pragma unroll
        for (int u = 0; u < 4; ++u) { const size_t i = i0 + u * stride; if (i < nvec) { const float* xp = x + i * 8; xa[u] = *(const f32x4*)xp; xb[u] = *(const f32x4*)(xp + 4); } }
#pragma unroll
        for (int u = 0; u < 4; ++u) { const size_t i = i0 + u * stride; if (i < nvec) {
            const int row = (int)(i >> 8), col = (int)(i & 255) * 8, b = row >> 11;
            const float* mp = mod + (size_t)b * MODW + col;
            const f32x4 sh0 = *(const f32x4*)mp, sh1 = *(const f32x4*)(mp + 4), sc0 = *(const f32x4*)(mp + DM), sc1 = *(const f32x4*)(mp + DM + 4);
            const f32x4 h0 = xa[u] * (sc0 + 1.0f) + sh0, h1 = xb[u] * (sc1 + 1.0f) + sh1;
            v4u o; o.x = pk2(h0[0], h0[1]); o.y = pk2(h0[2], h0[3]); o.z = pk2(h1[0], h1[1]); o.w = pk2(h1[2], h1[3]);
            *(v4u*)(H + i * 8) = o; } }
    }
}

typedef short sg_bf16x8 __attribute__((ext_vector_type(8)));
typedef float sg_f32x16 __attribute__((ext_vector_type(16)));
constexpr int SG_VT = 0, SG_LD = 136, SG_ST = 36864;
__device__ __forceinline__ void p3_sgu(Frame& F) {
    LAS bf16* vnT = (LAS bf16*)(F.lds + SG_VT); LAS float* stS = (LAS float*)(F.lds + SG_ST);
    const bf16* U = (const bf16*)(F.ws + WS_U); const bf16* VT = (const bf16*)(F.ws + WS_V); bf16* AB = (bf16*)(F.ws + WS_H);
    const bf16* Wb = (const bf16*)(F.ws + WS_SGW); const float* stv = (const float*)(F.ws + WS_STV);
    const float* lng = F.in[I_SLNG]; const float* lnb = F.in[I_SLNB]; const float* sb = F.in[I_SB];
    const int tid = F.tid, lane = F.lane, w = F.wave, r = lane & 31, h = lane >> 5;
    for (int item = blockIdx.x; item < 1024; item += F.G) {
        const int b = item >> 7, n = (item >> 3) & 15, g = item & 7, tok0 = b * SEQ + n * 128;
        if (tid < 128) { float s = 0.f, q = 0.f; const float* sp = stv + (size_t)(tok0 + tid) * 32;
#pragma unroll
            for (int i = 0; i < 16; ++i) { const f32x2 pr = *(const f32x2*)(sp + 2 * i); s += pr.x; q += pr.y; }
            const float mean = s * (1.0f / 1024.0f); float var = q * (1.0f / 1024.0f) - mean * mean; var = var > 0.f ? var : 0.f;
            *(LAS f32x2*)(stS + 2 * tid) = (f32x2){mean, 1.0f / sqrtf(var + LN_EPS)}; }
        __syncthreads();
        { const int c = tid >> 2, pseg = (tid & 3) * 32, ch = g * 128 + c; const float gg = lng[ch], bb = lnb[ch];
          const bf16* vp = VT + (size_t)ch * MTOK + tok0 + pseg;
          v4u wv[4];
#pragma unroll
          for (int k = 0; k < 4; ++k) wv[k] = *(const v4u*)(vp + 8 * k);
#pragma unroll
          for (int k = 0; k < 4; ++k) {
              const float e[8] = {bflo(wv[k].x), bfhi(wv[k].x), bflo(wv[k].y), bfhi(wv[k].y), bflo(wv[k].z), bfhi(wv[k].z), bflo(wv[k].w), bfhi(wv[k].w)};
              float o[8];
#pragma unroll
              for (int i = 0; i < 8; i += 2) { const f32x4 st = *(const LAS f32x4*)(stS + 2 * (pseg + 8 * k + i));
                  o[i] = (e[i] - st[0]) * st[1] * gg + bb; o[i + 1] = (e[i + 1] - st[2]) * st[3] * gg + bb; }
              v4u pk; pk.x = pk2(o[0], o[1]); pk.y = pk2(o[2], o[3]); pk.z = pk2(o[4], o[5]); pk.w = pk2(o[6], o[7]);
              *(LAS v4u*)(vnT + c * SG_LD + pseg + 8 * k) = pk; } }
        const int q0 = 32 * (w >> 1), ct0 = 2 * (w & 1);
        sg_bf16x8 af[8];
#pragma unroll
        for (int kk = 0; kk < 8; ++kk) af[kk] = *(const sg_bf16x8*)(Wb + (size_t)(g * 128 + q0 + r) * 128 + 16 * kk + 8 * h);
        __syncthreads();
        sg_f32x16 acc[2];
#pragma unroll
        for (int ct = 0; ct < 2; ++ct)
#pragma unroll
            for (int i = 0; i < 16; ++i) acc[ct][i] = 0.f;
#pragma unroll
        for (int kk = 0; kk < 8; ++kk)
#pragma unroll
            for (int ct = 0; ct < 2; ++ct) {
                const sg_bf16x8 bf = *(const LAS sg_bf16x8*)(vnT + ((ct0 + ct) * 32 + r) * SG_LD + 16 * kk + 8 * h);
                acc[ct] = __builtin_amdgcn_mfma_f32_32x32x16_bf16(af[kk], bf, acc[ct], 0, 0, 0);
            }
#pragma unroll
        for (int ct = 0; ct < 2; ++ct) {
            const int c = (ct0 + ct) * 32 + r;
#pragma unroll
            for (int rg = 0; rg < 16; ++rg) {
                const int q = q0 + (rg & 3) + 8 * (rg >> 2) + 4 * h;
                const float uv = bf1(U[(size_t)(tok0 + q) * SGUW + g * 128 + c]);
                AB[(size_t)(tok0 + q) * DM + g * 128 + c] = (bf16)f2bf(uv * (acc[ct][rg] + sb[g * 128 + q]));
            }
        }
        __syncthreads();
    }
}

__device__ __forceinline__ float sconv(const bf16* ZHT, const float* cw, const float* cb, int ch, int b, int t) {
    const bf16* zp = ZHT + (size_t)ch * MTOK + b * SEQ;
    const float z0 = t > 0 ? bf1(zp[t - 1]) : 0.f, z1 = bf1(zp[t]), z2 = t < SEQ - 1 ? bf1(zp[t + 1]) : 0.f;
    return cw[ch] * z0 + cw[3072 + ch] * z1 + cw[6144 + ch] * z2 + cb[ch];
}
__device__ __forceinline__ void p3_hyena(Frame& F) {
    LAS float* Us = (LAS float*)F.lds;
    LAS float* KF = (LAS float*)(F.lds + 65536);
    const bf16* ZHT = (const bf16*)(F.ws + WS_ZHT); const float* FILT = (const float*)(F.ws + WS_FILT); bf16* AB = (bf16*)(F.ws + WS_H);
    const float* cw = F.in[I_HCW]; const float* cb = F.in[I_HCB]; const float* skip = F.in[I_HSKIP];
    const int tid = F.tid;
    for (int item = blockIdx.x; item < HYW; item += F.G) {
        const int c = item;
        for (int i = tid; i < NBATCH * SEQ; i += NWAVES * 64) { const int b = i >> 11, t = i & 2047; Us[t * 8 + b] = sconv(ZHT, cw, cb, c, b, t); }
        for (int n = 0; n < 2; ++n) {
            const float* hf = FILT + (size_t)((0 * 2 + n) * 1024 + c) * SEQ; const float* hb = FILT + (size_t)((1 * 2 + n) * 1024 + c) * SEQ;
            for (int i = tid; i < 4095; i += NWAVES * 64) { const int lag = i - 2047; KF[i] = lag > 0 ? hf[lag] : (lag == 0 ? hf[0] + hb[0] : hb[-lag]); }
            __syncthreads();
            f32x4 acc[4][2];
#pragma unroll
            for (int ti = 0; ti < 4; ++ti) { acc[ti][0] = (f32x4){0.f, 0.f, 0.f, 0.f}; acc[ti][1] = (f32x4){0.f, 0.f, 0.f, 0.f}; }
            const LAS float* kp = KF + tid + 2047;
            for (int s = 0; s < SEQ; ++s) {
                const f32x4 u0 = *(const LAS f32x4*)(Us + s * 8), u1 = *(const LAS f32x4*)(Us + s * 8 + 4);
#pragma unroll
                for (int ti = 0; ti < 4; ++ti) { const float kv = kp[512 * ti - s]; acc[ti][0] += u0 * kv; acc[ti][1] += u1 * kv; }
            }
            __syncthreads();
            const float sk = skip[n * 1024 + c];
#pragma unroll
            for (int ti = 0; ti < 4; ++ti) { const int t = tid + 512 * ti;
#pragma unroll
                for (int b = 0; b < 8; ++b) {
                    const float uv = Us[t * 8 + b], gate = sconv(ZHT, cw, cb, (n + 1) * 1024 + c, b, t);
                    const float y = gate * (acc[ti][b >> 2][b & 3] + sk * uv);
                    if (n == 0) Us[t * 8 + b] = y; else AB[(size_t)(b * SEQ + t) * DM + 1024 + c] = (bf16)f2bf(y);
                } }
            __syncthreads();
        }
    }
}

#ifndef HYFFT_HD
#define HYFFT_HD __device__ __forceinline__
#define HYFFT_LAS __attribute__((address_space(3)))
#endif
typedef float hy_c32 __attribute__((ext_vector_type(2)));
HYFFT_HD int hy_padi(int i) { return i + (i >> 3); }
HYFFT_HD int hy_rev(int x) { return ((x & 7) << 9) | (((x >> 3) & 7) << 6) | (((x >> 6) & 7) << 3) | ((x >> 9) & 7); }

template <bool INV> HYFFT_HD void hy_dft8(float (&re)[8], float (&im)[8]) {
    const float h = 0.70710678118654752f;
    float ar[4], ai[4], br[4], bi[4];
#pragma unroll
    for (int m = 0; m < 4; ++m) { ar[m] = re[m] + re[m + 4]; ai[m] = im[m] + im[m + 4]; br[m] = re[m] - re[m + 4]; bi[m] = im[m] - im[m + 4]; }
    { float x = br[1], y = bi[1]; if (!INV) { br[1] = h * (x + y); bi[1] = h * (y - x); } else { br[1] = h * (x - y); bi[1] = h * (y + x); } }
    { float x = br[2], y = bi[2]; if (!INV) { br[2] = y; bi[2] = -x; } else { br[2] = -y; bi[2] = x; } }
    { float x = br[3], y = bi[3]; if (!INV) { br[3] = h * (y - x); bi[3] = -h * (x + y); } else { br[3] = -h * (x + y); bi[3] = h * (x - y); } }
#pragma unroll
    for (int s = 0; s < 2; ++s) {
        float* cr = s ? br : ar; float* ci = s ? bi : ai;
        const float e0r = cr[0] + cr[2], e0i = ci[0] + ci[2], e1r = cr[0] - cr[2], e1i = ci[0] - ci[2];
        const float o0r = cr[1] + cr[3], o0i = ci[1] + ci[3]; const float dr = cr[1] - cr[3], di = ci[1] - ci[3];
        float o1r, o1i; if (!INV) { o1r = di; o1i = -dr; } else { o1r = -di; o1i = dr; }
        re[0 + s] = e0r + o0r; im[0 + s] = e0i + o0i;
        re[2 + s] = e1r + o1r; im[2 + s] = e1i + o1i;
        re[4 + s] = e0r - o0r; im[4 + s] = e0i - o0i;
        re[6 + s] = e1r - o1r; im[6 + s] = e1i - o1i;
    }
}
template <bool CONJ> HYFFT_HD void hy_twiddle(float (&re)[8], float (&im)[8], float wr, float wi) {
    if (CONJ) wi = -wi;
    const float w2r = wr * wr - wi * wi, w2i = 2.f * wr * wi;
    const float w3r = w2r * wr - w2i * wi, w3i = w2r * wi + w2i * wr;
    const float w4r = w2r * w2r - w2i * w2i, w4i = 2.f * w2r * w2i;
    const float w5r = w4r * wr - w4i * wi, w5i = w4r * wi + w4i * wr;
    const float w6r = w3r * w3r - w3i * w3i, w6i = 2.f * w3r * w3i;
    const float w7r = w4r * w3r - w4i * w3i, w7i = w4r * w3i + w4i * w3r;
    const float pr[8] = {1.f, wr, w2r, w3r, w4r, w5r, w6r, w7r}, pi[8] = {0.f, wi, w2i, w3i, w4i, w5i, w6i, w7i};
#pragma unroll
    for (int k = 1; k < 8; ++k) { const float x = re[k], y = im[k]; re[k] = x * pr[k] - y * pi[k]; im[k] = x * pi[k] + y * pr[k]; }
}
template <int L, class BP, class TP> HYFFT_HD void hy_fwd_store(BP buf, TP tw, int j, float (&re)[8], float (&im)[8]) {
    constexpr int S = L / 8; const int blk = j / S, q = j % S, base = blk * L + q;
    hy_dft8<false>(re, im);
    if (L > 8) { const hy_c32 w = tw[q * (4096 / L)]; hy_twiddle<false>(re, im, w.x, w.y); }
#pragma unroll
    for (int k = 0; k < 8; ++k) buf[hy_padi(base + k * S)] = (hy_c32){re[k], im[k]};
}
template <int L, class BP> HYFFT_HD void hy_load8(BP buf, int j, float (&re)[8], float (&im)[8]) {
    constexpr int S = L / 8; const int blk = j / S, q = j % S, base = blk * L + q;
#pragma unroll
    for (int k = 0; k < 8; ++k) { const hy_c32 v = buf[hy_padi(base + k * S)]; re[k] = v.x; im[k] = v.y; }
}
template <int L, class BP, class TP> HYFFT_HD void hy_fwd_stage(BP buf, TP tw, int j) { float re[8], im[8]; hy_load8<L>(buf, j, re, im); hy_fwd_store<L>(buf, tw, j, re, im); }
template <int L, class BP, class TP> HYFFT_HD void hy_inv_regs(BP buf, TP tw, int j, float (&re)[8], float (&im)[8]) {
    constexpr int S = L / 8; const int q = j % S;
    hy_load8<L>(buf, j, re, im);
    if (L > 8) { const hy_c32 w = tw[q * (4096 / L)]; hy_twiddle<true>(re, im, w.x, w.y); }
    hy_dft8<true>(re, im);
}
template <int L, class BP, class TP> HYFFT_HD void hy_inv_stage(BP buf, TP tw, int j) {
    constexpr int S = L / 8; const int blk = j / S, q = j % S, base = blk * L + q;
    float re[8], im[8]; hy_inv_regs<L>(buf, tw, j, re, im);
#pragma unroll
    for (int k = 0; k < 8; ++k) buf[hy_padi(base + k * S)] = (hy_c32){re[k], im[k]};
}
template <class BP, class KP> HYFFT_HD void hy_mid_stage(BP buf, KP K, int j) {
    float re[8], im[8]; hy_load8<8>(buf, j, re, im);
    hy_dft8<false>(re, im);
#pragma unroll
    for (int k = 0; k < 8; ++k) { const hy_c32 kv = K[hy_padi(8 * j + k)]; const float x = re[k], y = im[k]; re[k] = x * kv.x - y * kv.y; im[k] = x * kv.y + y * kv.x; }
    hy_dft8<true>(re, im);
#pragma unroll
    for (int k = 0; k < 8; ++k) buf[hy_padi(8 * j + k)] = (hy_c32){re[k], im[k]};
}
template <class BP> HYFFT_HD void hy_last_fwd(BP buf, int j) {
    float re[8], im[8]; hy_load8<8>(buf, j, re, im); hy_dft8<false>(re, im);
#pragma unroll
    for (int k = 0; k < 8; ++k) buf[hy_padi(8 * j + k)] = (hy_c32){re[k], im[k]};
}
template <class BP, class KP> HYFFT_HD void hy_separate(BP Z, KP K1, KP K2, int j) {
    const float sc = 0.5f / 4096.0f;
#pragma unroll
    for (int r = 0; r < 8; ++r) {
        const int p = j + 512 * r, f = hy_rev(p), g = (4096 - f) & 4095, p2 = hy_rev(g);
        const hy_c32 a = Z[hy_padi(p)], b = Z[hy_padi(p2)];
        K1[hy_padi(p)] = (hy_c32){(a.x + b.x) * sc, (a.y - b.y) * sc};
        K2[hy_padi(p)] = (hy_c32){(a.y + b.y) * sc, (b.x - a.x) * sc};
    }
}

struct Raw3 { bf16 a, b, c; };
__device__ __forceinline__ Raw3 raw3(const bf16* zp, int t) { Raw3 r; r.a = zp[t > 0 ? t - 1 : 0]; r.b = zp[t]; r.c = zp[t < SEQ - 1 ? t + 1 : SEQ - 1]; return r; }
__device__ __forceinline__ float sconv_raw(const Raw3& r, int t, float w0, float w1, float w2, float cb) {
    const float z0 = t > 0 ? bf1(r.a) : 0.f, z1 = bf1(r.b), z2 = t < SEQ - 1 ? bf1(r.c) : 0.f;
    return w0 * z0 + w1 * z1 + w2 * z2 + cb;
}
HYFFT_HD int hy16_padi(int i) { return i + (i >> 4); }
HYFFT_HD int hy16_rev(int x) { return ((x & 15) << 8) | (x & 0xF0) | ((x >> 8) & 15); }
template <bool INV> HYFFT_HD void hy16_dft4(float& r0, float& i0, float& r1, float& i1, float& r2, float& i2, float& r3, float& i3) {
    const float e0r = r0 + r2, e0i = i0 + i2, e1r = r0 - r2, e1i = i0 - i2, o0r = r1 + r3, o0i = i1 + i3, dr = r1 - r3, di = i1 - i3;
    float o1r, o1i; if (!INV) { o1r = di; o1i = -dr; } else { o1r = -di; o1i = dr; }
    r0 = e0r + o0r; i0 = e0i + o0i; r1 = e1r + o1r; i1 = e1i + o1i; r2 = e0r - o0r; i2 = e0i - o0i; r3 = e1r - o1r; i3 = e1i - o1i;
}
template <bool INV> HYFFT_HD void hy16_cmulc(float& r, float& i, float cr, float ci) { if (INV) ci = -ci; const float x = r, y = i; r = x * cr - y * ci; i = x * ci + y * cr; }
template <bool INV> HYFFT_HD void hy16_dft16(float (&re)[16], float (&im)[16]) {
    const float c1 = 0.92387953251128674f, s1 = 0.38268343236508977f, h = 0.70710678118654752f;
#pragma unroll
    for (int m2 = 0; m2 < 4; ++m2) hy16_dft4<INV>(re[m2], im[m2], re[4 + m2], im[4 + m2], re[8 + m2], im[8 + m2], re[12 + m2], im[12 + m2]);
    hy16_cmulc<INV>(re[4 * 1 + 1], im[4 * 1 + 1], c1, -s1);
    hy16_cmulc<INV>(re[4 * 2 + 1], im[4 * 2 + 1], h, -h);
    hy16_cmulc<INV>(re[4 * 3 + 1], im[4 * 3 + 1], s1, -c1);
    hy16_cmulc<INV>(re[4 * 1 + 2], im[4 * 1 + 2], h, -h);
    hy16_cmulc<INV>(re[4 * 2 + 2], im[4 * 2 + 2], 0.f, -1.f);
    hy16_cmulc<INV>(re[4 * 3 + 2], im[4 * 3 + 2], -h, -h);
    hy16_cmulc<INV>(re[4 * 1 + 3], im[4 * 1 + 3], s1, -c1);
    hy16_cmulc<INV>(re[4 * 2 + 3], im[4 * 2 + 3], -h, -h);
    hy16_cmulc<INV>(re[4 * 3 + 3], im[4 * 3 + 3], -c1, s1);
#pragma unroll
    for (int k1 = 0; k1 < 4; ++k1) hy16_dft4<INV>(re[4 * k1], im[4 * k1], re[4 * k1 + 1], im[4 * k1 + 1], re[4 * k1 + 2], im[4 * k1 + 2], re[4 * k1 + 3], im[4 * k1 + 3]);
#pragma unroll
    for (int a = 0; a < 4; ++a)
#pragma unroll
        for (int b = a + 1; b < 4; ++b) { float t = re[4 * a + b]; re[4 * a + b] = re[4 * b + a]; re[4 * b + a] = t; t = im[4 * a + b]; im[4 * a + b] = im[4 * b + a]; im[4 * b + a] = t; }
}
template <bool CONJ> HYFFT_HD void hy16_twiddle(float (&re)[16], float (&im)[16], float wr, float wi) {
    if (CONJ) wi = -wi;
    float pr[16], pi[16]; pr[1] = wr; pi[1] = wi;
#define HY16_SQ(d, a) pr[d] = pr[a] * pr[a] - pi[a] * pi[a]; pi[d] = 2.f * pr[a] * pi[a];
#define HY16_MUL(d, a, b) pr[d] = pr[a] * pr[b] - pi[a] * pi[b]; pi[d] = pr[a] * pi[b] + pi[a] * pr[b];
    HY16_SQ(2, 1) HY16_MUL(3, 2, 1) HY16_SQ(4, 2) HY16_MUL(5, 4, 1) HY16_SQ(6, 3) HY16_MUL(7, 4, 3) HY16_SQ(8, 4)
    HY16_MUL(9, 8, 1) HY16_SQ(10, 5) HY16_MUL(11, 8, 3) HY16_SQ(12, 6) HY16_MUL(13, 8, 5) HY16_SQ(14, 7) HY16_MUL(15, 8, 7)
#undef HY16_SQ
#undef HY16_MUL
#pragma unroll
    for (int k = 1; k < 16; ++k) { const float x = re[k], y = im[k]; re[k] = x * pr[k] - y * pi[k]; im[k] = x * pi[k] + y * pr[k]; }
}
template <int L, class BP> HYFFT_HD void hy16_load(BP buf, int jj, float (&re)[16], float (&im)[16]) {
    constexpr int S = L / 16; const int blk = jj / S, q = jj % S, pb = hy16_padi(blk * L + q);
#pragma unroll
    for (int k = 0; k < 16; ++k) { const hy_c32 v = buf[pb + k * (S + S / 16)]; re[k] = v.x; im[k] = v.y; }
}
template <class BP> HYFFT_HD void hy16_load1(BP buf, int jj, float (&re)[16], float (&im)[16]) {
#pragma unroll
    for (int k = 0; k < 16; ++k) { const hy_c32 v = buf[17 * jj + k]; re[k] = v.x; im[k] = v.y; }
}
template <int L, class BP> HYFFT_HD void hy16_store(BP buf, int jj, const float (&re)[16], const float (&im)[16]) {
    constexpr int S = L / 16; const int blk = jj / S, q = jj % S, pb = hy16_padi(blk * L + q);
#pragma unroll
    for (int k = 0; k < 16; ++k) buf[pb + k * (S + S / 16)] = (hy_c32){re[k], im[k]};
}
template <class BP> HYFFT_HD void hy16_store1(BP buf, int jj, const float (&re)[16], const float (&im)[16]) {
#pragma unroll
    for (int k = 0; k < 16; ++k) buf[17 * jj + k] = (hy_c32){re[k], im[k]};
}
template <int L, class BP, class TP> HYFFT_HD void hy16_fwd_store(BP buf, TP tw, int jj, float (&re)[16], float (&im)[16]) {
    constexpr int S = L / 16; const int q = jj % S;
    hy16_dft16<false>(re, im);
    { const hy_c32 w = tw[q * (4096 / L)]; hy16_twiddle<false>(re, im, w.x, w.y); }
    hy16_store<L>(buf, jj, re, im);
}
template <int L, class BP, class TP> HYFFT_HD void hy16_fwd_stage(BP buf, TP tw, int jj) { float re[16], im[16]; hy16_load<L>(buf, jj, re, im); hy16_fwd_store<L>(buf, tw, jj, re, im); }
template <int L, class BP, class TP> HYFFT_HD void hy16_inv_regs(BP buf, TP tw, int jj, float (&re)[16], float (&im)[16]) {
    constexpr int S = L / 16; const int q = jj % S;
    hy16_load<L>(buf, jj, re, im);
    { const hy_c32 w = tw[q * (4096 / L)]; hy16_twiddle<true>(re, im, w.x, w.y); }
    hy16_dft16<true>(re, im);
}
template <int L, class BP, class TP> HYFFT_HD void hy16_inv_stage(BP buf, TP tw, int jj) { float re[16], im[16]; hy16_inv_regs<L>(buf, tw, jj, re, im); hy16_store<L>(buf, jj, re, im); }
template <class BP, class KP> HYFFT_HD void hy16_mid_stage(BP buf, KP K, int jj) {
    float re[16], im[16]; hy16_load1(buf, jj, re, im);
    hy16_dft16<false>(re, im);
#pragma unroll
    for (int k = 0; k < 16; ++k) { const hy_c32 kv = K[17 * jj + k]; const float x = re[k], y = im[k]; re[k] = x * kv.x - y * kv.y; im[k] = x * kv.y + y * kv.x; }
    hy16_dft16<true>(re, im);
    hy16_store1(buf, jj, re, im);
}
template <class BP> HYFFT_HD void hy16_last_fwd(BP buf, int jj) { float re[16], im[16]; hy16_load1(buf, jj, re, im); hy16_dft16<false>(re, im); hy16_store1(buf, jj, re, im); }
template <class BP, class KP> HYFFT_HD void hy16_separate(BP Z, KP K1, KP K2, int t) {
    const float sc = 0.5f / 4096.0f;
#pragma unroll
    for (int r = 0; r < 8; ++r) {
        const int p = t + 512 * r, f = hy16_rev(p), g = (4096 - f) & 4095, p2 = hy16_rev(g);
        const hy_c32 a = Z[hy16_padi(p)], b = Z[hy16_padi(p2)];
        K1[hy16_padi(p)] = (hy_c32){(a.x + b.x) * sc, (a.y - b.y) * sc};
        K2[hy16_padi(p)] = (hy_c32){(a.y + b.y) * sc, (b.x - a.x) * sc};
    }
}
__device__ __forceinline__ void p3_hyena_fft(Frame& F) {
    const int tid0 = F.tid;
    const int half = __builtin_amdgcn_readfirstlane(tid0 >> 8);
    LAS hy_c32* BUF = (LAS hy_c32*)(F.lds + half * 34816);
    LAS hy_c32* B0 = (LAS hy_c32*)(F.lds + 0);
    LAS hy_c32* K1 = (LAS hy_c32*)(F.lds + 69632); LAS hy_c32* K2 = (LAS hy_c32*)(F.lds + 104448); LAS hy_c32* TW = (LAS hy_c32*)(F.lds + 139264);
    const bf16* ZHT = (const bf16*)(F.ws + WS_ZHT); const float* FILT = (const float*)(F.ws + WS_FILT); bf16* YT = (bf16*)(F.ws + WS_YT);
    const float* cw = F.in[I_HCW]; const float* cb = F.in[I_HCB]; const float* skip = F.in[I_HSKIP];
    if (tid0 < 256) { float sn, cs; sincosf(-6.283185307179586f * (float)tid0 / 4096.0f, &sn, &cs); TW[tid0] = (hy_c32){cs, sn}; }
    __syncthreads();
    for (int item = blockIdx.x; item < HYW; item += F.G) {
        const int c = item;
        int tid = tid0; asm volatile("" : "+v"(tid));
        int jj = tid & 255;
        float re[16], im[16];
        const bf16* zv = ZHT + (size_t)c * MTOK; const bf16* za = ZHT + (size_t)(1024 + c) * MTOK; const bf16* zb = ZHT + (size_t)(2048 + c) * MTOK;
        {
            if (half == 0) {
                const float* hf0 = FILT + (size_t)(0 * 1024 + c) * SEQ; const float* hf1 = FILT + (size_t)(1 * 1024 + c) * SEQ;
                const float* hb0 = FILT + (size_t)(2 * 1024 + c) * SEQ; const float* hb1 = FILT + (size_t)(3 * 1024 + c) * SEQ;
#pragma unroll
                for (int m = 0; m < 8; ++m) { const int i = jj + 256 * m; re[m] = hf0[i]; im[m] = hf1[i]; }
                if (jj == 0) { re[0] += hb0[0]; im[0] += hb1[0]; }
#pragma unroll
                for (int m = 8; m < 16; ++m) { const int i = jj + 256 * m; const bool z = (i == 2048); const int r = z ? 0 : 4096 - i; const float a = hb0[r], b = hb1[r]; re[m] = z ? 0.f : a; im[m] = z ? 0.f : b; }
                hy16_fwd_store<4096>(B0, TW, jj, re, im);
            }
            __syncthreads();
            if (half == 0) hy16_fwd_stage<256>(B0, TW, jj);
            __syncthreads();
            if (half == 0) hy16_last_fwd(B0, jj);
            __syncthreads();
            hy16_separate(B0, K1, K2, tid); __syncthreads();
        }
        const float vw0 = cw[c], vw1 = cw[3072 + c], vw2 = cw[6144 + c], vcb = cb[c];
        const float aw0 = cw[1024 + c], aw1 = cw[3072 + 1024 + c], aw2 = cw[6144 + 1024 + c], acb = cb[1024 + c];
        const float bw0 = cw[2048 + c], bw1 = cw[3072 + 2048 + c], bw2 = cw[6144 + 2048 + c], bcb = cb[2048 + c];
        const float sk0 = skip[c], sk1 = skip[1024 + c];
#pragma unroll 1
        for (int rd = 0; rd < 2; ++rd) {
            const int boff = (4 * rd + 2 * half) * SEQ;
            asm volatile("" : "+v"(jj));
            Raw3 rg[2][8];
            float v[2][8];
#pragma unroll
            for (int m = 0; m < 8; ++m) { const int t = jj + 256 * m;
                const Raw3 r0 = raw3(zv + boff, t), r1 = raw3(zv + boff + SEQ, t); v[0][m] = sconv_raw(r0, t, vw0, vw1, vw2, vcb); v[1][m] = sconv_raw(r1, t, vw0, vw1, vw2, vcb); }
#pragma unroll
            for (int m = 0; m < 8; ++m) { re[m] = v[0][m]; im[m] = v[1][m]; re[m + 8] = 0.f; im[m + 8] = 0.f; }
            hy16_fwd_store<4096>(BUF, TW, jj, re, im); __syncthreads();
            hy16_fwd_stage<256>(BUF, TW, jj); __syncthreads();
            hy16_mid_stage(BUF, K1, jj); __syncthreads();
#pragma unroll
            for (int m = 0; m < 8; ++m) { const int t = jj + 256 * m; rg[0][m] = raw3(za + boff, t); rg[1][m] = raw3(za + boff + SEQ, t); }
            hy16_inv_stage<256>(BUF, TW, jj); __syncthreads();
            hy16_inv_regs<4096>(BUF, TW, jj, re, im);
#pragma unroll
            for (int m = 0; m < 8; ++m) { const int t = jj + 256 * m;
                v[0][m] = sconv_raw(rg[0][m], t, aw0, aw1, aw2, acb) * (re[m] + sk0 * v[0][m]); v[1][m] = sconv_raw(rg[1][m], t, aw0, aw1, aw2, acb) * (im[m] + sk0 * v[1][m]); }
#pragma unroll
            for (int m = 0; m < 8; ++m) { re[m] = v[0][m]; im[m] = v[1][m]; re[m + 8] = 0.f; im[m + 8] = 0.f; }
            hy16_fwd_store<4096>(BUF, TW, jj, re, im); __syncthreads();
            hy16_fwd_stage<256>(BUF, TW, jj); __syncthreads();
            hy16_mid_stage(BUF, K2, jj); __syncthreads();
#pragma unroll
            for (int m = 0; m < 8; ++m) { const int t = jj + 256 * m; rg[0][m] = raw3(zb + boff, t); rg[1][m] = raw3(zb + boff + SEQ, t); }
            hy16_inv_stage<256>(BUF, TW, jj); __syncthreads();
            hy16_inv_regs<4096>(BUF, TW, jj, re, im);
#pragma unroll
            for (int m = 0; m < 8; ++m) { const int t = jj + 256 * m; bf16* yp = YT + (size_t)c * MTOK + boff + t;
                yp[0] = (bf16)f2bf(sconv_raw(rg[0][m], t, bw0, bw1, bw2, bcb) * (re[m] + sk1 * v[0][m]));
                yp[SEQ] = (bf16)f2bf(sconv_raw(rg[1][m], t, bw0, bw1, bw2, bcb) * (im[m] + sk1 * v[1][m])); }
        }
        __syncthreads();
    }
}

__device__ __forceinline__ void p3c_transpose(Frame& F) {
    constexpr int LD = 264;
    LAS bf16* tile = (LAS bf16*)F.lds;
    const bf16* YT = (const bf16*)(F.ws + WS_YT); bf16* AB = (bf16*)(F.ws + WS_H);
    const int tid = F.tid;
    for (int it = blockIdx.x; it < 16 * 64; it += F.G) {
        const int c0 = (it >> 6) * 64, t0 = (it & 63) * 256;
        { const int c = tid >> 3, ts = (tid & 7) * 32; const bf16* src = YT + (size_t)(c0 + c) * MTOK + t0 + ts;
          v4u w[4];
#pragma unroll
          for (int k = 0; k < 4; ++k) w[k] = *(const v4u*)(src + 8 * k);
#pragma unroll
          for (int k = 0; k < 4; ++k) *(LAS v4u*)(tile + c * LD + ts + 8 * k) = w[k]; }
        __syncthreads();
        { const int t = tid >> 1, cs = (tid & 1) * 32; unsigned o[16];
#pragma unroll
          for (int i = 0; i < 16; ++i) o[i] = (unsigned)tile[(cs + 2 * i) * LD + t] | ((unsigned)tile[(cs + 2 * i + 1) * LD + t] << 16);
          bf16* dst = AB + (size_t)(t0 + t) * DM + 1024 + c0 + cs;
#pragma unroll
          for (int k = 0; k < 4; ++k) *(v4u*)(dst + 8 * k) = (v4u){o[4 * k], o[4 * k + 1], o[4 * k + 2], o[4 * k + 3]}; }
        __syncthreads();
    }
}

template <bool FINAL> __device__ __forceinline__ void ln_rows(Frame& F) {
    float* R = F.out; const float* st = (const float*)(F.ws + (FINAL ? WS_ST2 : WS_ST1)); float* MU = (float*)(F.ws + WS_MU1);
    const float* mod = (const float*)(F.ws + WS_MOD); bf16* H2 = (bf16*)(F.ws + WS_H);
    const float* lng = F.in[FINAL ? I_LN2G : I_LN1G]; const float* lnb = F.in[FINAL ? I_LN2B : I_LN1B];
    const int gw = blockIdx.x * NWAVES + F.wave, NGW = F.G * NWAVES, lane = F.lane;
    f32x4 cur[8], nxt[8]; f32x2 ps = (f32x2){0.f, 0.f}, pn = (f32x2){0.f, 0.f};
    int row = gw;
    if (row < MTOK) {
#pragma unroll
        for (int j = 0; j < 8; ++j) cur[j] = *(const f32x4*)(R + (size_t)row * DM + 4 * lane + 256 * j);
        if (lane < 32) ps = *(const f32x2*)(st + ((size_t)row * 32 + lane) * 2);
    }
    for (; row < MTOK; row += NGW) {
        const int rn = row + NGW;
        if (rn < MTOK) {
#pragma unroll
            for (int j = 0; j < 8; ++j) nxt[j] = *(const f32x4*)(R + (size_t)rn * DM + 4 * lane + 256 * j);
            pn = (f32x2){0.f, 0.f}; if (lane < 32) pn = *(const f32x2*)(st + ((size_t)rn * 32 + lane) * 2);
        }
        const float s = wave_sum(ps.x), q = wave_sum(ps.y);
        const float mean = s * (1.0f / DM); float var = q * (1.0f / DM) - mean * mean; var = var > 0.f ? var : 0.f; const float rstd = 1.0f / sqrtf(var + LN_EPS);
        if (!FINAL && lane == 0) *(f32x2*)(MU + (size_t)row * 2) = (f32x2){mean, rstd};
        const int b = row >> 11; float* rp = R + (size_t)row * DM;
#pragma unroll
        for (int j = 0; j < 8; ++j) { const int col = 4 * lane + 256 * j;
            const f32x4 y = (cur[j] - mean) * rstd * *(const f32x4*)(lng + col) + *(const f32x4*)(lnb + col);
            if (FINAL) *(f32x4*)(rp + col) = y;
            else { const float* mp = mod + (size_t)b * MODW + col; const f32x4 h = y * (*(const f32x4*)(mp + 4 * DM) + 1.0f) + *(const f32x4*)(mp + 3 * DM);
                   v2u o; o.x = pk2(h[0], h[1]); o.y = pk2(h[2], h[3]); *(v2u*)(H2 + (size_t)row * DM + col) = o; } }
#pragma unroll
        for (int j = 0; j < 8; ++j) cur[j] = nxt[j];
        ps = pn;
    }
}

typedef GAS unsigned gu32;
#define RLX_AGENT __ATOMIC_RELAXED, __HIP_MEMORY_SCOPE_AGENT
constexpr int LDSCTL_OFF = 163840 - 512, MISC_OFF = LDSCTL_OFF;
constexpr int CW_BAR = 4096;
constexpr size_t CTL_ZERO_BYTES = 65536;
#define XB_TMO      128
#define XB_XCNT(j)  (256  + 64 * (j))
#define XB_XSUB(j)  (1280 + 64 * (j))
#define XB_XGEN(j)  (2304 + 64 * (j))
#define XB_TOP      3328
#define XB_TOPGEN   3392
#define XCD_BAR_WORDS 3456
#define XB_SPIN_CAP (1u << 18)

__device__ __forceinline__ unsigned xb_ld(unsigned* p)              { return __hip_atomic_load(p, __ATOMIC_RELAXED, __HIP_MEMORY_SCOPE_AGENT); }
__device__ __forceinline__ unsigned xb_add(unsigned* p, unsigned v) { return __hip_atomic_fetch_add(p, v, __ATOMIC_RELAXED, __HIP_MEMORY_SCOPE_AGENT); }
__device__ __forceinline__ unsigned xb_xcc_id() { return (unsigned)__builtin_amdgcn_s_getreg((3 << 11) | 20) & 0xFu; }
#define XB_SPIN(cond, bar) do { unsigned _sp = 0; while (cond) { __builtin_amdgcn_s_sleep(1); \
    if ((++_sp & 255u) == 0u) { if (xb_ld(&(bar)[XB_TMO])) break; if (_sp > XB_SPIN_CAP) { atomicAdd(&(bar)[XB_TMO], 1u); break; } } } } while (0)

struct XcdBarrier {
    unsigned* bar; unsigned x;
    volatile LAS unsigned* st;
};

__device__ __forceinline__ XcdBarrier xcd_barrier_post(unsigned* bar, volatile LAS unsigned* st) {
    XcdBarrier b; b.bar = bar; b.x = xb_xcc_id(); b.st = st;
    if (threadIdx.x == 0) (void)xb_add(&bar[XB_XCNT(b.x)], 1u);
    return b;
}
__device__ __forceinline__ void xcd_barrier_complete(unsigned* bar, unsigned x, unsigned& nloc, unsigned& nx) {
    const unsigned G = gridDim.x * gridDim.y * gridDim.z;
    unsigned sum, cnt, mine, sp = 0u;
    for (;;) {
        sum = 0u; cnt = 0u; mine = 0u;
#pragma unroll
        for (unsigned j = 0; j < 16; ++j) { const unsigned c = xb_ld(&bar[XB_XCNT(j)]); sum += c; cnt += (c > 0u) ? 1u : 0u; mine = (j == x) ? c : mine; }
        if (sum == G) break;
        __builtin_amdgcn_s_sleep(1);
        if ((++sp & 255u) == 0u) { if (xb_ld(&bar[XB_TMO])) break; if (sp > XB_SPIN_CAP) { atomicAdd(&bar[XB_TMO], 1u); break; } }
    }
    nloc = mine > 0u ? mine : 1u; nx = cnt > 0u ? cnt : 1u;
}

__device__ __forceinline__ void xcd_barrier(const XcdBarrier& b) {
    asm volatile("s_waitcnt vmcnt(0)" ::: "memory");
    __syncthreads();
    if (threadIdx.x == 0) {
        unsigned* bar = b.bar;
        __builtin_amdgcn_s_waitcnt(0);
        unsigned nloc = b.st[0], nx = b.st[1];
        if (nloc == 0u) { xcd_barrier_complete(bar, b.x, nloc, nx); b.st[0] = nloc; b.st[1] = nx; }
        const unsigned old = xb_add(&bar[XB_XSUB(b.x)], 1u);
        const unsigned gen = old / nloc;
        if (old + 1u == (gen + 1u) * nloc) {
            __builtin_amdgcn_fence(__ATOMIC_RELEASE, "agent");
            asm volatile("s_waitcnt vmcnt(0)" ::: "memory");
            const unsigned og = xb_add(&bar[XB_TOP], 1u);
            const unsigned tg = og / nx;
            if (og + 1u == (tg + 1u) * nx) xb_add(&bar[XB_TOPGEN], 1u);
            else XB_SPIN(xb_ld(&bar[XB_TOPGEN]) == tg, bar);
            __builtin_amdgcn_fence(__ATOMIC_ACQUIRE, "agent");
            xb_add(&bar[XB_XGEN(b.x)], 1u);
            asm volatile("s_waitcnt vmcnt(0)" ::: "memory");
        } else {
            XB_SPIN(xb_ld(&bar[XB_XGEN(b.x)]) == gen, bar);
            __builtin_amdgcn_fence(__ATOMIC_ACQUIRE, "agent");
            asm volatile("s_waitcnt vmcnt(0)" ::: "memory");
        }
    }
    __syncthreads();
}

#define GRID_SYNC() xcd_barrier(bar)

__global__ void __launch_bounds__(NWAVES * 64, 2) fwd_megakernel(Args args) {
    extern __shared__ __attribute__((aligned(16))) unsigned char lds[];
    Frame F;
    F.lds = (LAS unsigned char*)lds;
    F.tid = threadIdx.x; F.lane = F.tid & 63; F.wave = __builtin_amdgcn_readfirstlane(F.tid >> 6); F.G = gridDim.x;
    F.in = args.in; F.out = args.out; F.ws = args.ws;
    for (int u = F.tid; u < (LDS_BYTES - LDSCTL_OFF) / 4; u += NWAVES * 64) ((LAS unsigned*)(F.lds + LDSCTL_OFF))[u] = 0u;
    __syncthreads();
    XcdBarrier bar = xcd_barrier_post((unsigned*)(args.ws + WS_CTL) + CW_BAR, (volatile LAS unsigned*)(F.lds + MISC_OFF) + 8);
    unsigned char* ws = args.ws;
    const int lo = args.ph_lo, hi = args.ph_hi;
#define IN(k) (lo <= (k) && (k) < hi)
#define BOTH(k) (IN(k) && IN((k) + 1))
    const int gw = blockIdx.x * NWAVES + F.wave, NGW = F.G * NWAVES;

    PB_START(1, F.lds);
    if (IN(0)) { { int t_ = threadIdx.x; asm volatile("" : "+v"(t_)); F.tid = t_; F.lane = t_ & 63; }
        PB_START(21, F.lds); p0_mod(F); PB_END(21, F.lds);
        PB_START(22, F.lds);
        transpose_matrix(F, F.in[I_WIN], DM, INW, (bf16*)(ws + WS_WIN), DM, 0, 1, (int)blockIdx.x, F.G);
        transpose_matrix(F, F.in[I_WA], SGUW, DM, (bf16*)(ws + WS_WAB), DM, 0, 0, (int)((blockIdx.x + 128) % F.G), F.G);
        transpose_matrix(F, F.in[I_WB], HYW, DM, (bf16*)(ws + WS_WAB), DM, 1024, 0, (int)blockIdx.x, F.G);
        transpose_matrix(F, F.in[I_WO], DM, DM, (bf16*)(ws + WS_WO), DM, 0, 0, (int)blockIdx.x, F.G);
        { const float* sw = F.in[I_SW]; bf16* sgw = (bf16*)(ws + WS_SGW);
          for (int i = blockIdx.x * (NWAVES * 64) + F.tid; i < 8 * 128 * 128 / 2; i += F.G * NWAVES * 64) { const f32x2 v = *(const f32x2*)(sw + 2 * i); *(unsigned*)(sgw + 2 * i) = pk2(v.x, v.y); } }
        __syncthreads();
        __syncthreads(); p0_hid2(F);
        PB_END(22, F.lds);
        if (BOTH(0)) GRID_SYNC();
    }
    PB_END(1, F.lds);
    PB_START(2, F.lds);
    if (IN(1)) { { int t_ = threadIdx.x; asm volatile("" : "+v"(t_)); F.tid = t_; F.lane = t_ & 63; } if (F.wave < 4) p1_modulate(F); else p1_filter_waves(F); if (BOTH(1)) GRID_SYNC(); }
    PB_END(2, F.lds);
    PB_START(3, F.lds);
    if (IN(2)) { { int t_ = threadIdx.x; asm volatile("" : "+v"(t_)); F.tid = t_; F.lane = t_ & 63; }
        { pg8::Gemm g{(const pg8::bf16_t*)(ws + WS_H), (const pg8::bf16_t*)(ws + WS_WIN), MTOK, 5120, DM}; pg8::StaticOrder S; S.init(MTOK, 5120, F.G, (int)blockIdx.x);
          pg8::EpiG1 E{(pg8::bf16_t*)(ws + WS_U), (pg8::bf16_t*)(ws + WS_G), F.in[I_BIN]};
          pg8::gemm_phase<pg8::EpiG1, pg8::StaticOrder, true, true>(F.lds, g, S, E); }
        __syncthreads();
        { pg8::Gemm g{(const pg8::bf16_t*)(ws + WS_WIN) + (size_t)5120 * DM, (const pg8::bf16_t*)(ws + WS_H), 4096, MTOK, DM}; pg8::StaticOrder S; S.init(4096, MTOK, F.G, (int)blockIdx.x);
          pg8::EpiG1T E{(pg8::bf16_t*)(ws + WS_V), (pg8::bf16_t*)(ws + WS_ZHT), F.in[I_BIN], (float*)(ws + WS_STV)};
          pg8::gemm_phase<pg8::EpiG1T, pg8::StaticOrder, true, true>(F.lds, g, S, E); }
        if (BOTH(2)) GRID_SYNC();
    }
    PB_END(3, F.lds);
    PB_START(4, F.lds);
    if (IN(3)) { { int t_ = threadIdx.x; asm volatile("" : "+v"(t_)); F.tid = t_; F.lane = t_ & 63; } __syncthreads(); PB_START(41, F.lds); p3_sgu(F); PB_END(41, F.lds); PB_START(42, F.lds); p3_hyena_fft(F); PB_END(42, F.lds); if (BOTH(3)) GRID_SYNC(); PB_START(43, F.lds); p3c_transpose(F); GRID_SYNC(); PB_END(43, F.lds); }
    PB_END(4, F.lds);
    PB_START(5, F.lds);
    if (IN(4)) { { int t_ = threadIdx.x; asm volatile("" : "+v"(t_)); F.tid = t_; F.lane = t_ & 63; }
        pg8::Gemm g{(const pg8::bf16_t*)(ws + WS_H), (const pg8::bf16_t*)(ws + WS_WAB), MTOK, DM, DM}; pg8::StaticOrder S; S.init(MTOK, DM, F.G, (int)blockIdx.x);
        pg8::EpiG2 E{(const pg8::bf16_t*)(ws + WS_G), (pg8::bf16_t*)(ws + WS_MERGED)};
        pg8::gemm_phase<pg8::EpiG2, pg8::StaticOrder, true, true>(F.lds, g, S, E);
        if (BOTH(4)) GRID_SYNC();
    }
    PB_END(5, F.lds);
    PB_START(6, F.lds);
    if (IN(5)) { { int t_ = threadIdx.x; asm volatile("" : "+v"(t_)); F.tid = t_; F.lane = t_ & 63; }
        pg8::Gemm g{(const pg8::bf16_t*)(ws + WS_MERGED), (const pg8::bf16_t*)(ws + WS_WO), MTOK, DM, DM}; pg8::StaticOrder S; S.init(MTOK, DM, F.G, (int)blockIdx.x);
        pg8::EpiRes<true> E{F.in[I_X], F.out, (const float*)(ws + WS_MOD) + 2 * DM, F.in[I_BO], nullptr, nullptr, nullptr, (float*)(ws + WS_ST1)};
        pg8::gemm_phase<pg8::EpiRes<true>, pg8::StaticOrder, true, true>(F.lds, g, S, E);
        if (BOTH(5)) GRID_SYNC();
    }
    PB_END(6, F.lds);
    PB_START(7, F.lds);
    if (IN(6)) { { int t_ = threadIdx.x; asm volatile("" : "+v"(t_)); F.tid = t_; F.lane = t_ & 63; }
        __syncthreads();
        ln_rows<false>(F);
        __syncthreads();
        transpose_matrix(F, F.in[I_WM1], DM, DFF, (bf16*)(ws + WS_WM1), DM, 0, 0, (int)blockIdx.x, F.G);
        transpose_matrix(F, F.in[I_WM2], DFF, DM, (bf16*)(ws + WS_WM2), DFF, 0, 0, (int)blockIdx.x, F.G);
        if (BOTH(6)) GRID_SYNC();
    }
    PB_END(7, F.lds);
    PB_START(8, F.lds);
    if (IN(7)) { { int t_ = threadIdx.x; asm volatile("" : "+v"(t_)); F.tid = t_; F.lane = t_ & 63; }
        __syncthreads();
        pg8::Gemm g{(const pg8::bf16_t*)(ws + WS_H), (const pg8::bf16_t*)(ws + WS_WM1), MTOK, DFF, DM}; pg8::StaticOrder S; S.init(MTOK, DFF, F.G, (int)blockIdx.x);
        pg8::EpiG4 E{(pg8::bf16_t*)(ws + WS_AFF), F.in[I_BM1]};
        pg8::gemm_phase<pg8::EpiG4, pg8::StaticOrder, true, true>(F.lds, g, S, E);
        if (BOTH(7)) GRID_SYNC();
    }
    PB_END(8, F.lds);
    PB_START(9, F.lds);
    if (IN(8)) { { int t_ = threadIdx.x; asm volatile("" : "+v"(t_)); F.tid = t_; F.lane = t_ & 63; }
        pg8::Gemm g{(const pg8::bf16_t*)(ws + WS_AFF), (const pg8::bf16_t*)(ws + WS_WM2), MTOK, DM, DFF}; pg8::StaticOrder S; S.init(MTOK, DM, F.G, (int)blockIdx.x);
        pg8::EpiRes<false> E{nullptr, F.out, (const float*)(ws + WS_MOD) + 5 * DM, F.in[I_BM2], F.in[I_LN1G], F.in[I_LN1B], (const float*)(ws + WS_MU1), (float*)(ws + WS_ST2)};
        pg8::gemm_phase<pg8::EpiRes<false>, pg8::StaticOrder, true, true>(F.lds, g, S, E);
        if (BOTH(8)) GRID_SYNC();
    }
    PB_END(9, F.lds);
    PB_START(10, F.lds);
    if (IN(9)) { { int t_ = threadIdx.x; asm volatile("" : "+v"(t_)); F.tid = t_; F.lane = t_ & 63; } ln_rows<true>(F); }
    PB_END(10, F.lds);
    if (PROBE_ID != 0 && blockIdx.x == 0 && threadIdx.x == 0) { const unsigned long long wait_ = *(volatile LAS unsigned long long*)(F.lds + PB_LDS_OFF), t0_ = __builtin_amdgcn_s_memrealtime();
        while (__builtin_amdgcn_s_memrealtime() - t0_ < wait_) __builtin_amdgcn_s_sleep(8); }
#undef IN
#undef BOTH
}

constexpr int N_PHASES = 10;
#ifndef MK_N_LAUNCHES
#define MK_N_LAUNCHES 1
#endif
extern "C" void kernel_launch(void* const* d_in, const int* in_sizes, int n_in, void* d_out, int out_size, void* d_ws, size_t ws_size, hipStream_t stream) {
    static int grid = 0;
    if (grid == 0) {
        if (n_in != 31 || in_sizes[0] != MTOK * DM || out_size != MTOK * DM || ws_size < WS_END) {
            fprintf(stderr, "kernel_launch: unexpected problem: n_in %d in0 %d out %d ws %zu (need %zu)\n", n_in, n_in > 0 ? in_sizes[0] : -1, out_size, ws_size, (size_t)WS_END); grid = -1; return; }
        int dev = 0, cus = 0, per_cu = 0;
        if (hipGetDevice(&dev) != hipSuccess || hipDeviceGetAttribute(&cus, hipDeviceAttributeMultiprocessorCount, dev) != hipSuccess) { grid = -1; return; }
        if (hipFuncSetAttribute((const void*)fwd_megakernel, hipFuncAttributeMaxDynamicSharedMemorySize, LDS_BYTES) != hipSuccess) { fprintf(stderr, "kernel_launch: hipFuncSetAttribute failed\n"); grid = -1; return; }
        if (hipOccupancyMaxActiveBlocksPerMultiprocessor(&per_cu, (const void*)fwd_megakernel, NWAVES * 64, LDS_BYTES) != hipSuccess || per_cu < 1) { fprintf(stderr, "kernel_launch: occupancy query says %d\n", per_cu); per_cu = 1; }
        (void)hipGetLastError();
        grid = cus;
    }
    if (grid < 0) return;
    if (hipMemsetAsync((char*)d_ws + WS_CTL, 0, CTL_ZERO_BYTES, stream) != hipSuccess) { fprintf(stderr, "kernel_launch: memset failed\n"); return; }
    Args a{};
    for (int i = 0; i < 31; ++i) a.in[i] = (const float*)d_in[i];
    a.out = (float*)d_out; a.ws = (unsigned char*)d_ws;
    if (MK_N_LAUNCHES == 1) {
        a.ph_lo = 0; a.ph_hi = N_PHASES;
        void* kargs[] = {&a};
        hipError_t e = hipLaunchCooperativeKernel((const void*)fwd_megakernel, dim3(grid), dim3(NWAVES * 64), kargs, LDS_BYTES, stream);
        if (e != hipSuccess) fprintf(stderr, "kernel_launch: cooperative launch failed: %s (grid %d)\n", hipGetErrorString(e), grid);
    } else {
        for (int p = 0; p < N_PHASES; ++p) { a.ph_lo = p; a.ph_hi = p + 1; hipLaunchKernelGGL(fwd_megakernel, dim3(grid), dim3(NWAVES * 64), LDS_BYTES, stream, a); }
    }
}
```

```cpp
#include <hip/hip_runtime.h>
#include <cstdio>
#include <cstdint>

#ifndef PROBE_ID
#define PROBE_ID 0
#endif
#define PB_LDS_OFF (163840 - 512 + 128)
#define PB_START(id, ldsp) do { if (PROBE_ID == (id) && blockIdx.x == 0 && threadIdx.x == 0) { *(volatile __attribute__((address_space(3))) unsigned long long*)((ldsp) + PB_LDS_OFF + 8) = __builtin_amdgcn_s_memrealtime(); } } while (0)
#define PB_END(id, ldsp) do { if (PROBE_ID == (id) && blockIdx.x == 0 && threadIdx.x == 0) { volatile __attribute__((address_space(3))) unsigned long long* pb_ = (volatile __attribute__((address_space(3))) unsigned long long*)((ldsp) + PB_LDS_OFF); pb_[0] += __builtin_amdgcn_s_memrealtime() - pb_[1]; } } while (0)
namespace pg8 {
#define PG8_LAS __attribute__((address_space(3)))
typedef unsigned short bf16_t;
typedef short bf16x8 __attribute__((ext_vector_type(8)));
typedef float f32x4 __attribute__((ext_vector_type(4)));
typedef unsigned u32x4 __attribute__((ext_vector_type(4)));
typedef float f32x2 __attribute__((ext_vector_type(2)));
constexpr int EPI_LDS_OFF = 131072;
constexpr int BM = 256, BK = 64, HALF = 128, HTB = HALF * BK * 2  , STAGE_BYTES = 8 * HTB, NXCD = 8, WGM = 8;

__host__ __device__ __forceinline__ int lds_byte(int r, int c) { const int st = (r >> 4) * 2 + (c >> 5), rr = r & 15, cc = c & 31, ob = rr * 64 + cc * 2; return st * 1024 + (ob ^ (((ob >> 9) & 1) << 5)); }
__host__ __device__ __forceinline__ void stage_rc(int b, int& R, int& C) { const int st = b / 1024, sb = b % 1024, swz = sb ^ (((sb >> 9) & 1) << 5); R = (st >> 1) * 16 + swz / 64; C = (st & 1) * 32 + (swz % 64) / 2; }
__host__ __device__ __forceinline__ int perm32(int rho) { const int n = rho >> 4, i = rho & 15; return 8 * (i >> 2) + 4 * n + (i & 3); }

struct Unit { int pm, pn; };
struct Gemm { const bf16_t* A; const bf16_t* Bt; int M, N, K; };

struct StaticOrder {
    int nM, nN, nwg, G, c;
    __host__ __device__ void init(int M, int N, int G_, int c_) { nM = M / BM; nN = N / BM; nwg = nM * nN; G = G_; c = c_; }
    __host__ __device__ bool next(int i, Unit& u) const {
        const long L = (long)i * G + c; if (L >= nwg) return false;
        int wgid = (int)L; { const int q = nwg / NXCD, r = nwg % NXCD, xcd = wgid % NXCD, off = wgid / NXCD; wgid = (xcd < r ? xcd * (q + 1) : r * (q + 1) + (xcd - r) * q) + off; }
        const int nig = WGM * nN, gid = wgid / nig, fm = gid * WGM, gsz = (nM - fm) < WGM ? (nM - fm) : WGM;
        u.pm = fm + ((wgid % nig) % gsz); u.pn = (wgid % nig) / gsz; return true;
    }
    __device__ __forceinline__ void a_ready(const Unit&) const {}
    __device__ __forceinline__ void done(const Unit&) const {}
};

__device__ __forceinline__ unsigned cvt_pk_bf16(float lo, float hi) { unsigned r; asm volatile("v_cvt_pk_bf16_f32 %0, %1, %2" : "=v"(r) : "v"(lo), "v"(hi)); return r; }
__device__ __forceinline__ f32x2 gelu_pk(f32x2 v) {
    const f32x2 av = __builtin_elementwise_abs(v), d = av * 0.2316418882f + 1.0f;
    f32x2 t; t.x = __builtin_amdgcn_rcpf(d.x); t.y = __builtin_amdgcn_rcpf(d.y);
    f32x2 q = t * 0.5307027145f + (-0.7265760135f); q = q * t + 0.7107068705f; q = q * t + (-0.142248368f); q = q * t + 0.127414796f; q = q * t;
    const f32x2 s = (v * v) * (-0.72134752044f);
    f32x2 e; e.x = __builtin_amdgcn_exp2f(s.x); e.y = __builtin_amdgcn_exp2f(s.y);
    const f32x2 m = v * (q * e), r = v - m;
    f32x2 o; o.x = v.x < 0.f ? m.x : r.x; o.y = v.y < 0.f ? m.y : r.y; return o;
}
__device__ __forceinline__ float bf_lo(unsigned w) { return __uint_as_float(w << 16); }
__device__ __forceinline__ float bf_hi(unsigned w) { return __uint_as_float(w & 0xffff0000u); }
__device__ __forceinline__ float sigmoid_f(float x) { return __builtin_amdgcn_rcpf(1.0f + __expf(-x)); }
}

constexpr int DM = 2048, NBATCH = 8, SEQ = 2048, MTOK = NBATCH * SEQ;
constexpr int SGUW = 1024, HYW = 1024, DFF = 8192, INW = 9216, MODW = 6 * DM;
constexpr float LN_EPS = 1e-5f;
constexpr float DN_ALPHA = 1.189207115002721f;

namespace pg8 {

struct EpiG1 {
    static constexpr bool PERM = true, AFTER_DRAIN = false, MID = false; static constexpr int SLOT_FLOATS = 256;
    bf16_t* U; bf16_t* G; const float* b_in;
    __device__ __forceinline__ void mid(f32x4 (&)[2][2][4][2], const Unit&, int, int, int, int) const {}
    __device__ __forceinline__ void preload(PG8_LAS float* slot, const Unit& u, int tid) const { if (tid < 256) slot[tid] = b_in[(u.pn < 4 ? u.pn * 256 : 5120 + (u.pn - 4) * 256) + tid]; }
    __device__ __forceinline__ void operator()(const f32x4 (&acc)[2][2][4][2], const Unit& u, int wr, int wc, int fr, int fq, const PG8_LAS float* slot) const {
        const int row0 = u.pm * BM + wr * 64 + fr; const int pn = u.pn;
        int ldc, colt; bf16_t* base; const bool isu = pn < 4;
        if (isu) { base = U; ldc = SGUW; colt = pn * 256; }
        else { base = G; ldc = 2 * DM; colt = (pn - 4) * 256; }
        const int cl = wc * 64 + 8 * fq;
        f32x4 bv[2][2];
#pragma unroll
        for (int bj = 0; bj < 2; ++bj)
#pragma unroll
            for (int n = 0; n < 2; ++n) bv[bj][n] = *(const PG8_LAS f32x4*)(slot + cl + bj * 32 + 4 * n);
#pragma unroll
        for (int ai = 0; ai < 2; ++ai)
#pragma unroll
            for (int m = 0; m < 4; ++m) {
                const int row = row0 + ai * HALF + m * 16;
                bf16_t* rowp = base + (size_t)row * ldc + colt + cl;
#pragma unroll
                for (int bj = 0; bj < 2; ++bj) {
                    f32x4 v0 = acc[ai][bj][m][0] + bv[bj][0], v1 = acc[ai][bj][m][1] + bv[bj][1];
                    if (isu) {
                        f32x2 a = gelu_pk((f32x2){v0[0], v0[1]}), b = gelu_pk((f32x2){v0[2], v0[3]}), c = gelu_pk((f32x2){v1[0], v1[1]}), d = gelu_pk((f32x2){v1[2], v1[3]});
                        v0 = (f32x4){a.x, a.y, b.x, b.y}; v1 = (f32x4){c.x, c.y, d.x, d.y};
                    } else {
                        v0 = (f32x4){sigmoid_f(v0[0]), sigmoid_f(v0[1]), sigmoid_f(v0[2]), sigmoid_f(v0[3])};
                        v1 = (f32x4){sigmoid_f(v1[0]), sigmoid_f(v1[1]), sigmoid_f(v1[2]), sigmoid_f(v1[3])};
                    }
                    u32x4 w; w.x = cvt_pk_bf16(v0[0], v0[1]); w.y = cvt_pk_bf16(v0[2], v0[3]); w.z = cvt_pk_bf16(v1[0], v1[1]); w.w = cvt_pk_bf16(v1[2], v1[3]);
                    *(u32x4*)(rowp + bj * 32) = w;
                }
            }
    }
};

struct EpiG1T {
    static constexpr bool PERM = true, AFTER_DRAIN = false, MID = false;
    bf16_t* VT; bf16_t* ZHT; const float* b_in; float* statsV; static constexpr int SLOT_FLOATS = 256;
    __device__ __forceinline__ void mid(f32x4 (&)[2][2][4][2], const Unit&, int, int, int, int) const {}
    __device__ __forceinline__ void preload(PG8_LAS float* slot, const Unit& u, int tid) const { if (tid < 256) slot[tid] = b_in[1024 + u.pm * 256 + tid]; }
    __device__ __forceinline__ void operator()(const f32x4 (&acc)[2][2][4][2], const Unit& u, int wr, int wc, int fr, int fq, const PG8_LAS float* slot) const {
        const int col0 = u.pn * BM + wc * 64 + 8 * fq; const bool isv = u.pm < 4;
        const int rowt = (isv ? u.pm : u.pm - 4) * BM + wr * 64 + fr;
        bf16_t* base = isv ? VT : ZHT;
#pragma unroll
        for (int ai = 0; ai < 2; ++ai) {
            float s[2][8], q[2][8];
#pragma unroll
            for (int bj = 0; bj < 2; ++bj)
#pragma unroll
                for (int e = 0; e < 8; ++e) { s[bj][e] = 0.f; q[bj][e] = 0.f; }
#pragma unroll
            for (int m = 0; m < 4; ++m) {
                const int row = rowt + ai * HALF + m * 16; const float bb = slot[wr * 64 + fr + ai * HALF + m * 16];
                bf16_t* rowp = base + (size_t)row * MTOK + col0;
#pragma unroll
                for (int bj = 0; bj < 2; ++bj) {
                    f32x4 v0 = acc[ai][bj][m][0] + bb, v1 = acc[ai][bj][m][1] + bb;
                    if (isv) {
                        f32x2 a = gelu_pk((f32x2){v0[0], v0[1]}), b = gelu_pk((f32x2){v0[2], v0[3]}), c = gelu_pk((f32x2){v1[0], v1[1]}), d = gelu_pk((f32x2){v1[2], v1[3]});
                        v0 = (f32x4){a.x, a.y, b.x, b.y}; v1 = (f32x4){c.x, c.y, d.x, d.y};
                    }
                    u32x4 w; w.x = cvt_pk_bf16(v0[0], v0[1]); w.y = cvt_pk_bf16(v0[2], v0[3]); w.z = cvt_pk_bf16(v1[0], v1[1]); w.w = cvt_pk_bf16(v1[2], v1[3]);
                    *(u32x4*)(rowp + bj * 32) = w;
                    if (isv) {
                        const float e0 = bf_lo(w.x), e1 = bf_hi(w.x), e2 = bf_lo(w.y), e3 = bf_hi(w.y), e4 = bf_lo(w.z), e5 = bf_hi(w.z), e6 = bf_lo(w.w), e7 = bf_hi(w.w);
                        s[bj][0] += e0; s[bj][1] += e1; s[bj][2] += e2; s[bj][3] += e3; s[bj][4] += e4; s[bj][5] += e5; s[bj][6] += e6; s[bj][7] += e7;
                        q[bj][0] += e0 * e0; q[bj][1] += e1 * e1; q[bj][2] += e2 * e2; q[bj][3] += e3 * e3; q[bj][4] += e4 * e4; q[bj][5] += e5 * e5; q[bj][6] += e6 * e6; q[bj][7] += e7 * e7;
                    }
                }
            }
            if (isv) {
                const int slot = u.pm * 4 + ai * 2 + wr;
#pragma unroll
                for (int bj = 0; bj < 2; ++bj)
#pragma unroll
                    for (int e = 0; e < 8; ++e) {
                        float a = s[bj][e], b = q[bj][e];
                        a += __shfl_xor(a, 1); b += __shfl_xor(b, 1); a += __shfl_xor(a, 2); b += __shfl_xor(b, 2);
                        a += __shfl_xor(a, 4); b += __shfl_xor(b, 4); a += __shfl_xor(a, 8); b += __shfl_xor(b, 8);
                        if (fr == 0) *(f32x2*)(statsV + ((size_t)(col0 + bj * 32 + e) * 16 + slot) * 2) = (f32x2){a, b};
                    }
            }
        }
    }
};

struct EpiG2 {
    static constexpr bool PERM = true, AFTER_DRAIN = false, MID = true;
    const bf16_t* G; bf16_t* O; static constexpr int SLOT_FLOATS = 0;
    __device__ __forceinline__ void preload(PG8_LAS float*, const Unit&, int) const {}
    __device__ __forceinline__ void mid(f32x4 (&acc)[2][2][4][2], const Unit& u, int wr, int wc, int fr, int fq) const {
        int row0 = u.pm * BM + wr * 64 + fr, col0 = u.pn * BM + wc * 64 + 8 * fq;
        asm volatile("" : "+v"(row0), "+v"(col0));
#pragma unroll
        for (int ai = 0; ai < 2; ++ai)
#pragma unroll
            for (int m = 0; m < 4; ++m) {
                const bf16_t* gp = G + (size_t)(row0 + ai * HALF + m * 16) * (2 * DM) + col0;
#pragma unroll
                for (int bj = 0; bj < 2; ++bj) {
                    const u32x4 ga = *(const u32x4*)(gp + bj * 32), gb = *(const u32x4*)(gp + DM + bj * 32);
                    f32x4 r0, r1;
                    r0[0] = bf_lo(ga.x) * __builtin_amdgcn_rcpf(bf_lo(gb.x)); r0[1] = bf_hi(ga.x) * __builtin_amdgcn_rcpf(bf_hi(gb.x));
                    r0[2] = bf_lo(ga.y) * __builtin_amdgcn_rcpf(bf_lo(gb.y)); r0[3] = bf_hi(ga.y) * __builtin_amdgcn_rcpf(bf_hi(gb.y));
                    r1[0] = bf_lo(ga.z) * __builtin_amdgcn_rcpf(bf_lo(gb.z)); r1[1] = bf_hi(ga.z) * __builtin_amdgcn_rcpf(bf_hi(gb.z));
                    r1[2] = bf_lo(ga.w) * __builtin_amdgcn_rcpf(bf_lo(gb.w)); r1[3] = bf_hi(ga.w) * __builtin_amdgcn_rcpf(bf_hi(gb.w));
                    acc[ai][bj][m][0] *= r0; acc[ai][bj][m][1] *= r1;
                }
            }
    }
    __device__ __forceinline__ void operator()(const f32x4 (&acc)[2][2][4][2], const Unit& u, int wr, int wc, int fr, int fq, const PG8_LAS float*) const {
        const int row0 = u.pm * BM + wr * 64 + fr, col0 = u.pn * BM + wc * 64 + 8 * fq;
#pragma unroll
        for (int ai = 0; ai < 2; ++ai)
#pragma unroll
            for (int m = 0; m < 4; ++m) {
                const int row = row0 + ai * HALF + m * 16;
                const bf16_t* gp = G + (size_t)row * (2 * DM) + DM + col0;
                bf16_t* op = O + (size_t)row * DM + col0;
#pragma unroll
                for (int bj = 0; bj < 2; ++bj) {
                    const u32x4 gb = *(const u32x4*)(gp + bj * 32);
                    const f32x4 a0 = acc[ai][bj][m][0], a1 = acc[ai][bj][m][1];
                    u32x4 w; w.x = cvt_pk_bf16(a0[0] * bf_lo(gb.x), a0[1] * bf_hi(gb.x)); w.y = cvt_pk_bf16(a0[2] * bf_lo(gb.y), a0[3] * bf_hi(gb.y));
                    w.z = cvt_pk_bf16(a1[0] * bf_lo(gb.z), a1[1] * bf_hi(gb.z)); w.w = cvt_pk_bf16(a1[2] * bf_lo(gb.w), a1[3] * bf_hi(gb.w));
                    *(u32x4*)(op + bj * 32) = w;
                }
            }
    }
};

template <bool FIRST> struct EpiRes {
    static constexpr bool PERM = false, AFTER_DRAIN = false, MID = false; static constexpr int SLOT_FLOATS = FIRST ? 512 : 1024;
    const float* X;
    float* R;
    const float* gate;
    const float* bias;
    const float* lng; const float* lnb; const float* MU;
    float* stats;
    __device__ __forceinline__ void mid(f32x4 (&)[2][2][4][2], const Unit&, int, int, int, int) const {}
    __device__ __forceinline__ void preload(PG8_LAS float* slot, const Unit& u, int tid) const {
        const int c = tid & 255, col = u.pn * BM + c;
        if (tid < 256) slot[c] = gate[(size_t)(u.pm >> 3) * MODW + col]; else slot[256 + c] = bias[col];
        if (!FIRST) { if (tid < 256) slot[512 + c] = DN_ALPHA * lng[col]; else slot[768 + c] = DN_ALPHA * lnb[col]; }
    }
    __device__ __forceinline__ void operator()(const f32x4 (&acc)[2][2][4][2], const Unit& u, int wr, int wc, int fr, int fq, const PG8_LAS float* slot) const {
        int row0 = u.pm * BM + wr * 64 + fr; const int cl = wc * 32 + 4 * fq; int col0 = u.pn * BM + cl;
        asm volatile("" : "+v"(row0), "+v"(col0));
        constexpr int RB = FIRST ? 2 : 1;
#pragma unroll
        for (int ab = 0; ab < 8 / RB; ++ab) {
            const int ai = (ab * RB) >> 2, mb = (ab * RB) & 3;
            f32x4 base[RB][2][2]; f32x2 mr[RB];
            int rowb = row0 + ai * HALF + mb * 16; asm volatile("" : "+v"(rowb));
#pragma unroll
            for (int mm = 0; mm < RB; ++mm) {
                const size_t off = (size_t)(rowb + mm * 16) * DM + col0;
                if (!FIRST) mr[mm] = *(const f32x2*)(MU + (size_t)(rowb + mm * 16) * 2);
#pragma unroll
                for (int bj = 0; bj < 2; ++bj)
#pragma unroll
                    for (int n = 0; n < 2; ++n) base[mm][bj][n] = FIRST ? *(const f32x4*)(X + off + bj * HALF + n * 16) : *(const f32x4*)(R + off + bj * HALF + n * 16);
            }
#pragma unroll
            for (int mm = 0; mm < RB; ++mm) {
                const int m = mb + mm;
                const int row = rowb + mm * 16; float* rp = R + (size_t)row * DM + col0;
                float s = 0.f, q = 0.f;
#pragma unroll
                for (int bj = 0; bj < 2; ++bj)
#pragma unroll
                    for (int n = 0; n < 2; ++n) {
                        const int co = bj * HALF + n * 16;
                        const f32x4 gv = *(const PG8_LAS f32x4*)(slot + cl + co), bv = *(const PG8_LAS f32x4*)(slot + 256 + cl + co);
                        f32x4 bs;
                        if (FIRST) bs = base[mm][bj][n] * DN_ALPHA;
                        else bs = (base[mm][bj][n] - mr[mm].x) * mr[mm].y * *(const PG8_LAS f32x4*)(slot + 512 + cl + co) + *(const PG8_LAS f32x4*)(slot + 768 + cl + co);
                        const f32x4 o = bs + gv * (acc[ai][bj][m][n] + bv);
                        *(f32x4*)(rp + co) = o;
                        s += (o[0] + o[1]) + (o[2] + o[3]); q += (o[0] * o[0] + o[1] * o[1]) + (o[2] * o[2] + o[3] * o[3]);
                    }
                s += __shfl_xor(s, 16); s += __shfl_xor(s, 32); q += __shfl_xor(q, 16); q += __shfl_xor(q, 32);
                if (fq == 0) *(f32x2*)(stats + ((size_t)row * 32 + u.pn * 4 + wc) * 2) = (f32x2){s, q};
            }
            asm volatile("" ::: "memory");
        }
    }
};

struct EpiG4 {
    static constexpr bool PERM = true, AFTER_DRAIN = false, MID = false; static constexpr int SLOT_FLOATS = 256;
    bf16_t* O; const float* bias;
    __device__ __forceinline__ void mid(f32x4 (&)[2][2][4][2], const Unit&, int, int, int, int) const {}
    __device__ __forceinline__ void preload(PG8_LAS float* slot, const Unit& u, int tid) const { if (tid < 256) slot[tid] = bias[u.pn * BM + tid]; }
    __device__ __forceinline__ void operator()(const f32x4 (&acc)[2][2][4][2], const Unit& u, int wr, int wc, int fr, int fq, const PG8_LAS float* slot) const {
        const int row0 = u.pm * BM + wr * 64 + fr, cl = wc * 64 + 8 * fq, col0 = u.pn * BM + cl;
        f32x4 bv[2][2];
#pragma unroll
        for (int bj = 0; bj < 2; ++bj)
#pragma unroll
            for (int n = 0; n < 2; ++n) bv[bj][n] = *(const PG8_LAS f32x4*)(slot + cl + bj * 32 + 4 * n);
#pragma unroll
        for (int ai = 0; ai < 2; ++ai)
#pragma unroll
            for (int m = 0; m < 4; ++m) {
                bf16_t* rowp = O + (size_t)(row0 + ai * HALF + m * 16) * DFF + col0;
#pragma unroll
                for (int bj = 0; bj < 2; ++bj) {
                    f32x4 v0 = acc[ai][bj][m][0] + bv[bj][0], v1 = acc[ai][bj][m][1] + bv[bj][1];
                    v0 = __builtin_elementwise_max(v0, (f32x4){0.f, 0.f, 0.f, 0.f}); v1 = __builtin_elementwise_max(v1, (f32x4){0.f, 0.f, 0.f, 0.f});
                    v0 = v0 * v0; v1 = v1 * v1;
                    u32x4 w; w.x = cvt_pk_bf16(v0[0], v0[1]); w.y = cvt_pk_bf16(v0[2], v0[3]); w.z = cvt_pk_bf16(v1[0], v1[1]); w.w = cvt_pk_bf16(v1[2], v1[3]);
                    *(u32x4*)(rowp + bj * 32) = w;
                }
            }
    }
};
}
namespace pg8 {
template <class Epi, class Sched, bool ALIGN_EPI = false, bool SP2 = false>
__device__ __forceinline__ void gemm_phase(PG8_LAS unsigned char* lds, const Gemm g, const Sched& S, const Epi& E) {
    const int tid = threadIdx.x, wid = __builtin_amdgcn_readfirstlane(tid >> 6), lane = tid & 63, wr = wid >> 2, wc = wid & 3, fr = lane & 15, fq = lane >> 4;
    const int K = g.K, nt = K / BK;
    unsigned voffA[2], voffB[2];
#pragma unroll
    for (int i = 0; i < 2; ++i) { int R, C; stage_rc(tid * 16 + i * 8192, R, C); const int Rb = Epi::PERM ? ((R & ~31) + perm32(R & 31)) : R;
        const int Rw = Epi::PERM ? ((R >> 5) * 64 + perm32(R & 31)) : R;
        voffA[i] = (unsigned)(R * K + C) * 2u; voffB[i] = (unsigned)(Rw * K + C) * 2u; (void)Rb; }
    const size_t kstep = (size_t)(BK * 2);
    const size_t hstep = (size_t)HALF * K * 2;
    const size_t tstep = 2 * hstep;
    const size_t hstepB = Epi::PERM ? (size_t)32 * K * 2 : hstep;
    const unsigned ldsw = (unsigned)wid * 1024u;
    const int aoff = lds_byte(wr * 64 + fr, fq * 8), boff = lds_byte(wc * 32 + fr, fq * 8);
#define PG8_SA(b, h) (((b) * 2 + (h)) * HTB)
#define PG8_SB(b, h) ((4 + (b) * 2 + (h)) * HTB)
#define PG8_STAGE(bufoff, gbase, voff) do { _Pragma("unroll") for (int _i = 0; _i < 2; ++_i) \
        __builtin_amdgcn_global_load_lds((const unsigned*)((const char*)(gbase) + (voff)[_i]), (PG8_LAS unsigned*)(lds + (bufoff) + ldsw + _i * 8192), 16, 0, 0); } while (0)
#define PG8_LDA(dst, b, h) do { _Pragma("unroll") for (int m = 0; m < 4; ++m) _Pragma("unroll") for (int k = 0; k < 2; ++k) dst[m][k] = *(const PG8_LAS bf16x8*)(lds + PG8_SA(b, h) + aoff + m * 2048 + k * 1024); } while (0)
#define PG8_LDB(dst, b, h) do { _Pragma("unroll") for (int n = 0; n < 2; ++n) _Pragma("unroll") for (int k = 0; k < 2; ++k) dst[n][k] = *(const PG8_LAS bf16x8*)(lds + PG8_SB(b, h) + boff + n * 2048 + k * 1024); } while (0)
#define PG8_MMA(ai, bj, At, Bt) do { __builtin_amdgcn_s_setprio(1); _Pragma("unroll") for (int m = 0; m < 4; ++m) _Pragma("unroll") for (int n = 0; n < 2; ++n) _Pragma("unroll") for (int k = 0; k < 2; ++k) \
        acc[ai][bj][m][n] = __builtin_amdgcn_mfma_f32_16x16x32_bf16(Bt[n][k], At[m][k], acc[ai][bj][m][n], 0, 0, 0); __builtin_amdgcn_s_setprio(0); } while (0)
#define PG8_WAIT_V(n) asm volatile("s_waitcnt vmcnt(" #n ")" ::: "memory")
#define PG8_WAIT_L(n) asm volatile("s_waitcnt lgkmcnt(" #n ")" ::: "memory")
#define PG8_BAR __builtin_amdgcn_s_barrier()
#define PG8_SCHED __builtin_amdgcn_sched_barrier(0)
    Unit cur, nxt; int ui = 0;
    if (!S.next(0, cur)) return;
    {
        Unit pu; for (int i = 0; S.next(i, pu); ++i) E.preload((PG8_LAS float*)(lds + EPI_LDS_OFF) + i * Epi::SLOT_FLOATS, pu, tid);
        asm volatile("s_waitcnt vmcnt(0) lgkmcnt(0)" ::: "memory"); __builtin_amdgcn_s_barrier(); asm volatile("" ::: "memory");
    }
    f32x4 acc[2][2][4][2];
#pragma unroll
    for (int a = 0; a < 2; ++a)
#pragma unroll
        for (int b = 0; b < 2; ++b)
#pragma unroll
            for (int m = 0; m < 4; ++m)
#pragma unroll
                for (int n = 0; n < 2; ++n) acc[a][b][m][n] = (f32x4){0.f, 0.f, 0.f, 0.f};
    bf16x8 At[4][2], B0[2][2], B1[2][2];
    const char* cA = (const char*)g.A + (size_t)cur.pm * tstep; const char* cB = (const char*)g.Bt + (size_t)cur.pn * tstep;
    S.a_ready(cur);
    if constexpr (SP2) {
        PG8_STAGE(PG8_SB(0, 0), cB, voffB); PG8_STAGE(PG8_SB(0, 1), cB + hstepB, voffB); PG8_STAGE(PG8_SA(0, 0), cA, voffA); PG8_STAGE(PG8_SA(0, 1), cA + hstep, voffA);
        if (wr == 1) PG8_BAR;
        PG8_WAIT_V(2); PG8_BAR;
        PG8_STAGE(PG8_SB(1, 0), cB + kstep, voffB); PG8_STAGE(PG8_SA(1, 0), cA + kstep, voffA); PG8_STAGE(PG8_SB(1, 1), cB + hstepB + kstep, voffB);
        PG8_WAIT_V(6); PG8_BAR;
    } else {
        PG8_STAGE(PG8_SB(0, 0), cB, voffB); PG8_STAGE(PG8_SA(0, 0), cA, voffA); PG8_STAGE(PG8_SB(0, 1), cB + hstepB, voffB); PG8_STAGE(PG8_SA(0, 1), cA + hstep, voffA);
        if (wr == 1) PG8_BAR;
        PG8_WAIT_V(4); PG8_BAR;
        PG8_STAGE(PG8_SB(1, 0), cB + kstep, voffB); PG8_STAGE(PG8_SA(1, 0), cA + kstep, voffA); PG8_STAGE(PG8_SB(1, 1), cB + hstepB + kstep, voffB);
        PG8_WAIT_V(6); PG8_BAR;
    }
    for (;;) {
        const bool has_next = S.next(ui + 1, nxt);
        const char* nA = has_next ? (const char*)g.A + (size_t)nxt.pm * tstep : cA; const char* nB = has_next ? (const char*)g.Bt + (size_t)nxt.pn * tstep : cB;
        for (int t = 0; t < nt; t += 2) {
            const bool last = (t == nt - 2);
            const char* a1 = cA + (size_t)(t + 1) * kstep;
            const char* a2 = last ? nA : cA + (size_t)(t + 2) * kstep; const char* b2 = last ? nB : cB + (size_t)(t + 2) * kstep;
            const char* a3 = a2 + kstep; const char* b3 = b2 + kstep;
            if (last && has_next) S.a_ready(nxt);
            if constexpr (Epi::MID) { if (t == (nt >> 1)) E.mid(acc, cur, wr, wc, fr, fq); }
            if constexpr (SP2) {
            PG8_LDB(B0, 0, 0); PG8_LDB(B1, 0, 1); PG8_SCHED; PG8_LDA(At, 0, 0); PG8_STAGE(PG8_SA(1, 1), a1 + hstep, voffA);
            PG8_WAIT_V(8); PG8_WAIT_L(0); PG8_BAR; PG8_MMA(0, 0, At, B0); PG8_MMA(0, 1, At, B1); PG8_BAR; PG8_SCHED;
            PG8_LDA(At, 0, 1); PG8_STAGE(PG8_SB(0, 0), b2, voffB); PG8_STAGE(PG8_SB(0, 1), b2 + hstepB, voffB); PG8_STAGE(PG8_SA(0, 0), a2, voffA);
            PG8_WAIT_V(8); PG8_WAIT_L(0); PG8_BAR; PG8_MMA(1, 0, At, B0); PG8_MMA(1, 1, At, B1); PG8_BAR; PG8_SCHED;
            PG8_LDB(B0, 1, 0); PG8_LDB(B1, 1, 1); PG8_SCHED; PG8_LDA(At, 1, 0); PG8_STAGE(PG8_SA(0, 1), a2 + hstep, voffA);
            PG8_WAIT_V(8); PG8_WAIT_L(0); PG8_BAR; PG8_MMA(0, 0, At, B0); PG8_MMA(0, 1, At, B1); PG8_BAR; PG8_SCHED;
            PG8_LDA(At, 1, 1); PG8_STAGE(PG8_SB(1, 0), b3, voffB); PG8_STAGE(PG8_SB(1, 1), b3 + hstepB, voffB); PG8_STAGE(PG8_SA(1, 0), a3, voffA);
            PG8_WAIT_V(8); PG8_WAIT_L(0); PG8_BAR; PG8_MMA(1, 0, At, B0); PG8_MMA(1, 1, At, B1); PG8_BAR; PG8_SCHED;
            } else {
            PG8_LDB(B0, 0, 0); PG8_SCHED; PG8_LDA(At, 0, 0); PG8_STAGE(PG8_SA(1, 1), a1 + hstep, voffA);
            PG8_WAIT_L(8); PG8_BAR; PG8_WAIT_L(0); PG8_MMA(0, 0, At, B0); PG8_BAR; PG8_SCHED;
            PG8_LDB(B1, 0, 1); PG8_STAGE(PG8_SB(0, 0), b2, voffB);
            PG8_BAR; PG8_WAIT_L(0); PG8_MMA(0, 1, At, B1); PG8_BAR;
            PG8_LDA(At, 0, 1); PG8_STAGE(PG8_SA(0, 0), a2, voffA);
            PG8_BAR; PG8_WAIT_L(0); PG8_MMA(1, 0, At, B0); PG8_BAR; PG8_SCHED;
            PG8_STAGE(PG8_SB(0, 1), b2 + hstepB, voffB);
            PG8_WAIT_V(6); PG8_BAR; PG8_MMA(1, 1, At, B1); PG8_BAR;
            PG8_LDB(B0, 1, 0); PG8_SCHED; PG8_LDA(At, 1, 0); PG8_STAGE(PG8_SA(0, 1), a2 + hstep, voffA);
            PG8_WAIT_L(8); PG8_BAR; PG8_WAIT_L(0); PG8_MMA(0, 0, At, B0); PG8_BAR; PG8_SCHED;
            PG8_LDB(B1, 1, 1); PG8_STAGE(PG8_SB(1, 0), b3, voffB);
            PG8_BAR; PG8_WAIT_L(0); PG8_MMA(0, 1, At, B1); PG8_BAR;
            PG8_LDA(At, 1, 1); PG8_STAGE(PG8_SA(1, 0), a3, voffA);
            PG8_BAR; PG8_WAIT_L(0); PG8_MMA(1, 0, At, B0); PG8_BAR; PG8_SCHED;
            PG8_STAGE(PG8_SB(1, 1), b3 + hstepB, voffB);
            PG8_WAIT_V(6); PG8_BAR; PG8_MMA(1, 1, At, B1); PG8_BAR;
            }
        }
        if constexpr (ALIGN_EPI) { if (wr == 0) PG8_BAR; }
        if constexpr (!Epi::AFTER_DRAIN) { E(acc, cur, wr, wc, fr, fq, (const PG8_LAS float*)(lds + EPI_LDS_OFF) + ui * Epi::SLOT_FLOATS); S.done(cur); }
        if (!has_next) break;
#pragma unroll
        for (int a = 0; a < 2; ++a)
#pragma unroll
            for (int b = 0; b < 2; ++b)
#pragma unroll
                for (int m = 0; m < 4; ++m)
#pragma unroll
                    for (int n = 0; n < 2; ++n) acc[a][b][m][n] = (f32x4){0.f, 0.f, 0.f, 0.f};
        cur = nxt; cA = nA; cB = nB; ++ui;
        if constexpr (ALIGN_EPI) { if (wr == 1) PG8_BAR; }
    }
    PG8_WAIT_V(0);
    if constexpr (!ALIGN_EPI) { if (wr == 0) PG8_BAR; }
    PG8_BAR;
    if constexpr (Epi::AFTER_DRAIN) { E.fused(acc, cur, wr, wc, fr, fq, lds, wid, lane); S.done(cur); }
#undef PG8_SA
#undef PG8_SB
#undef PG8_STAGE
#undef PG8_LDA
#undef PG8_LDB
#undef PG8_MMA
#undef PG8_WAIT_V
#undef PG8_WAIT_L
#undef PG8_BAR
#undef PG8_SCHED
}
}

constexpr size_t MiB = 1u << 20;
constexpr size_t WS_CTL = 0;
constexpr size_t WS_MOD = 1 * MiB;
constexpr size_t WS_STV = 2 * MiB;
constexpr size_t WS_ST1 = 4 * MiB;
constexpr size_t WS_ST2 = 8 * MiB;
constexpr size_t WS_MU1 = 12 * MiB;
constexpr size_t WS_HID2 = 14 * MiB;
constexpr size_t WS_SGW = 13 * MiB;
constexpr size_t WS_WIN = 16 * MiB;
constexpr size_t WS_WAB = 52 * MiB;
constexpr size_t WS_WO = 60 * MiB;
constexpr size_t WS_FILT = 68 * MiB;
constexpr size_t WS_WM2 = 68 * MiB;
constexpr size_t WS_H = 100 * MiB;
constexpr size_t WS_U = 164 * MiB;
constexpr size_t WS_V = 196 * MiB;
constexpr size_t WS_MERGED = 164 * MiB;
constexpr size_t WS_ZHT = 228 * MiB;
constexpr size_t WS_G = 324 * MiB;
constexpr size_t WS_AFF = 164 * MiB;
constexpr size_t WS_WM1 = 420 * MiB;
constexpr size_t WS_YT = 452 * MiB;
constexpr size_t WS_END = 484 * MiB;

constexpr int NWAVES = 8;
constexpr int LDS_BYTES = 163840;

#define GAS __attribute__((address_space(1)))
#define LAS __attribute__((address_space(3)))
typedef unsigned short bf16;
typedef unsigned v4u __attribute__((ext_vector_type(4)));
typedef unsigned v2u __attribute__((ext_vector_type(2)));
typedef float f32x4 __attribute__((ext_vector_type(4)));
typedef float f32x2 __attribute__((ext_vector_type(2)));
#define LDS_WAIT() asm volatile("s_waitcnt lgkmcnt(0)" ::: "memory")

__device__ __forceinline__ unsigned f2bf(float f) { unsigned u = __builtin_bit_cast(unsigned, f); return (u + 0x7fffu + ((u >> 16) & 1u)) >> 16; }
__device__ __forceinline__ unsigned pk2(float lo, float hi) { return f2bf(lo) | (f2bf(hi) << 16); }
__device__ __forceinline__ float bflo(unsigned w) { return __uint_as_float(w << 16); }
__device__ __forceinline__ float bfhi(unsigned w) { return __uint_as_float(w & 0xffff0000u); }
__device__ __forceinline__ float bf1(bf16 h) { return __uint_as_float((unsigned)h << 16); }
__device__ __forceinline__ float wave_sum(float v) {
#pragma unroll
    for (int o = 1; o < 64; o <<= 1) v += __shfl_xor(v, o);
    return v;
}

struct Args { const float* in[31]; float* out; unsigned char* ws; int ph_lo, ph_hi; };

struct Frame {
    LAS unsigned char* lds;
    int tid, lane, wave, G;
    const float* const* in; float* out; unsigned char* ws;
};
enum { I_X = 0, I_C, I_WADA, I_BADA, I_WIN, I_BIN, I_SLNG, I_SLNB, I_SW, I_SB, I_HCW, I_HCB, I_HW1, I_HB1, I_HW2, I_HB2, I_HFREQ, I_HW3, I_HSKIP,
       I_WA, I_WB, I_WO, I_BO, I_LN1G, I_LN1B, I_WM1, I_BM1, I_WM2, I_BM2, I_LN2G, I_LN2B };

__device__ __forceinline__ void transpose_matrix(Frame& F, const float* W, int K, int N, bf16* WT, int ldk, int koff, int remap_win, int first, int nblocks) {
    LAS float* tile = (LAS float*)F.lds;
    const int tid = F.tid, nblk = N / 256, nitems = (K / 64) * nblk;
    const int lr = tid >> 6, lc = tid & 63;
    const int wc = tid & 7, wn = tid >> 3;
    for (int it = first; it < nitems; it += nblocks) {
        const int kb = it / nblk, nb = it % nblk, n0 = nb * 256, k0 = kb * 64; int row0 = n0;
        if (remap_win) row0 = (n0 < 1024) ? n0 : (n0 < 2048 ? n0 - 1024 + 5120 : (n0 < 5120 ? n0 - 2048 + 6144 : n0 - 5120 + 1024));
        f32x4 v[8];
#pragma unroll
        for (int i = 0; i < 8; ++i) v[i] = *(const f32x4*)(W + (size_t)(k0 + 8 * i + lr) * N + n0 + 4 * lc);
#pragma unroll
        for (int i = 0; i < 8; ++i) *(LAS f32x4*)(tile + (8 * i + lr) * 256 + ((lc ^ i) << 2)) = v[i];
        __syncthreads();
#pragma unroll
        for (int j = 0; j < 4; ++j) { const int n = wn + 64 * j; const LAS float* sp = tile + (8 * wc) * 256 + ((((n >> 2) ^ wc) << 2) | (n & 3));
            v4u o; o.x = pk2(sp[0 * 256], sp[1 * 256]); o.y = pk2(sp[2 * 256], sp[3 * 256]); o.z = pk2(sp[4 * 256], sp[5 * 256]); o.w = pk2(sp[6 * 256], sp[7 * 256]);
            *(GAS v4u*)(WT + (size_t)(row0 + n) * ldk + koff + k0 + 8 * wc) = o; }
        __syncthreads();
    }
}

__device__ __forceinline__ void p0_mod(Frame& F) {
    LAS float* condS = (LAS float*)F.lds;
    LAS float* red = (LAS float*)(F.lds + 65536);
    const float* c = F.in[I_C]; const float* w_ada = F.in[I_WADA]; const float* b_ada = F.in[I_BADA];
    float* mod = (float*)(F.ws + WS_MOD);
    const int tid = F.tid;
    for (int item = blockIdx.x; item < MODW / 48; item += F.G) {
        for (int i = tid; i < NBATCH * DM; i += NWAVES * 64) { const float v = c[i]; condS[i] = v / (1.0f + __expf(-v)); }
        __syncthreads();
        const int cq = tid % 12, kq = tid / 12, col0 = item * 48;
        if (kq < 32) {
            f32x4 acc[8];
#pragma unroll
            for (int b = 0; b < 8; ++b) acc[b] = (f32x4){0.f, 0.f, 0.f, 0.f};
            const float* wp = w_ada + (size_t)kq * MODW + col0 + cq * 4;
            for (int k = kq; k < DM; k += 256, wp += (size_t)256 * MODW) {
                f32x4 w[8];
#pragma unroll
                for (int u = 0; u < 8; ++u) w[u] = *(const f32x4*)(wp + (size_t)(32 * u) * MODW);
#pragma unroll
                for (int u = 0; u < 8; ++u)
#pragma unroll
                    for (int b = 0; b < 8; ++b) acc[b] += w[u] * condS[b * DM + k + 32 * u];
            }
#pragma unroll
            for (int b = 0; b < 8; ++b) *(LAS f32x4*)(red + (kq * 8 + b) * 48 + cq * 4) = acc[b];
        }
        __syncthreads();
        if (tid < 384) { const int b = tid / 48, col = tid % 48; float s = 0.f;
#pragma unroll 8
          for (int k2 = 0; k2 < 32; ++k2) s += red[(k2 * 8 + b) * 48 + col];
          mod[(size_t)b * MODW + col0 + col] = s + b_ada[col0 + col]; }
        __syncthreads();
    }
}

__device__ __forceinline__ void p0_hid2(Frame& F) {
    LAS float* scr = (LAS float*)F.lds + F.wave * 128;
    const float* w1 = F.in[I_HW1]; const float* b1 = F.in[I_HB1]; const float* w2 = F.in[I_HW2]; const float* b2 = F.in[I_HB2]; const float* freq = F.in[I_HFREQ];
    float* HID2 = (float*)(F.ws + WS_HID2);
    const int lane = F.lane;
    for (int l = blockIdx.x * NWAVES + F.wave; l < SEQ; l += F.G * NWAVES) {
        const float fr = freq[lane];
        const float tl = (float)l / (float)(SEQ - 1), omega = 6.283185307179586f * (float)l / (float)SEQ;
        float f = 0.f;
        if (lane == 0) f = tl;
        else if (lane <= 16) { const float band = 1e-4f + (float)(lane - 1) * ((15.0f - 1e-4f) / 15.0f); f = cosf(band * omega); }
        else if (lane <= 32) { const float band = 1e-4f + (float)(lane - 17) * ((15.0f - 1e-4f) / 15.0f); f = -sinf(band * omega); }
        scr[lane] = f; LDS_WAIT(); asm volatile("" ::: "memory");
        float a = b1[lane];
#pragma unroll 11
        for (int i = 0; i < 33; ++i) a += scr[i] * w1[i * 64 + lane];
        scr[64 + lane] = sinf(fr * a); LDS_WAIT(); asm volatile("" ::: "memory");
        a = b2[lane];
#pragma unroll 16
        for (int i = 0; i < 64; ++i) a += scr[64 + i] * w2[i * 64 + lane];
        HID2[(size_t)l * 64 + lane] = sinf(fr * a);
        LDS_WAIT(); asm volatile("" ::: "memory");
    }
}
typedef float fl_f32x16 __attribute__((ext_vector_type(16)));
__device__ __forceinline__ void p1_filter_waves(Frame& F) {
    const int fwl = F.wave - 4;
    LAS float* hS = (LAS float*)F.lds + fwl * (32 * 65);
    const float* w3 = F.in[I_HW3]; const float* HID2 = (const float*)(F.ws + WS_HID2);
    float* FILT = (float*)(F.ws + WS_FILT);
    const int lane = F.lane, r = lane & 31, h = lane >> 5;
    const float min_decay = -3.0701134573253943f, max_decay = -15.350567286626972f;
    for (int item = blockIdx.x * 4 + fwl; item < 1024; item += F.G * 4) {
        const int pb = item >> 4, cb = item & 15, pos0 = pb * 32, col0 = cb * 256;
        {
#pragma unroll
            for (int u = 0; u < 8; ++u) { const int e = (u * 64 + lane) * 4, p = e >> 6, k = e & 63; const f32x4 v = *(const f32x4*)(HID2 + (size_t)(pos0 + p) * 64 + k);
                hS[p * 65 + k] = v[0]; hS[p * 65 + k + 1] = v[1]; hS[p * 65 + k + 2] = v[2]; hS[p * 65 + k + 3] = v[3]; }
            LDS_WAIT(); asm volatile("" ::: "memory");
        }
        fl_f32x16 acc[8];
#pragma unroll
        for (int t = 0; t < 8; ++t)
#pragma unroll
            for (int e = 0; e < 16; ++e) acc[t][e] = 0.f;
        const float* wp = w3 + (size_t)h * 4096 + col0 + r;
#pragma unroll 2
        for (int s2 = 0; s2 < 32; ++s2) {
            const float a = hS[r * 65 + 2 * s2 + h];
            float b[8];
#pragma unroll
            for (int t = 0; t < 8; ++t) b[t] = wp[(size_t)(2 * s2) * 4096 + t * 32];
#pragma unroll
            for (int t = 0; t < 8; ++t) acc[t] = __builtin_amdgcn_mfma_f32_32x32x2f32(a, b[t], acc[t], 0, 0, 0);
        }
#pragma unroll
        for (int t = 0; t < 8; ++t) {
            const int j = col0 + t * 32 + r, ch = j & 1023; const float delta = fabsf(min_decay + (float)ch * ((max_decay - min_decay) / 1023.0f));
            float* op = FILT + (size_t)j * SEQ + pos0 + 4 * h;
#pragma unroll
            for (int g = 0; g < 4; ++g) {
                f32x4 o;
#pragma unroll
                for (int e = 0; e < 4; ++e) { const float tp = (float)(pos0 + 8 * g + 4 * h + e) / (float)(SEQ - 1); o[e] = acc[t][4 * g + e] * __expf(-tp * delta); }
                *(f32x4*)(op + 8 * g) = o;
            }
        }
        LDS_WAIT(); asm volatile("" ::: "memory");
    }
}

__device__ __forceinline__ void p1_modulate(Frame& F) {
    const float* x = F.in[I_X]; const float* mod = (const float*)(F.ws + WS_MOD); bf16* H = (bf16*)(F.ws + WS_H);
    const size_t nvec = (size_t)MTOK * DM / 8, stride = (size_t)F.G * 256;
    for (size_t i0 = (size_t)blockIdx.x * 256 + F.tid; i0 < nvec; i0 += 4 * stride) {
        f32x4 xa[4], xb[4];
#pragma unroll
        for (int u = 0; u < 4; ++u) { const size_t i = i0 + u * stride; if (i < nvec) { const float* xp = x + i * 8; xa[u] = *(const f32x4*)xp; xb[u] = *(const f32x4*)(xp + 4); } }
#pragma unroll
        for (int u = 0; u < 4; ++u) { const size_t i = i0 + u * stride; if (i < nvec) {
            const int row = (int)(i >> 8), col = (int)(i & 255) * 8, b = row >> 11;
            const float* mp = mod + (size_t)b * MODW + col;
            const f32x4 sh0 = *(const f32x4*)mp, sh1 = *(const f32x4*)(mp + 4), sc0 = *(const f32x4*)(mp + DM), sc1 = *(const f32x4*)(mp + DM + 4);
            const f32x4 h0 = xa[u] * (sc0 + 1.0f) + sh0, h1 = xb[u] * (sc1 + 1.0f) + sh1;
            v4u o; o.x = pk2(h0[0], h0[1]); o.y = pk2(h0[2], h0[3]); o.z = pk2(h1[0], h1[1]); o.w = pk2(h1[2], h1[3]);
            *(v4u*)(H + i * 8) = o; } }
    }
}

typedef short sg_bf16x8 __attribute__((ext_vector_type(8)));
typedef float sg_f32x16 __attribute__((ext_vector_type(16)));
constexpr int SG_VT = 0, SG_LD = 136, SG_ST = 36864;
__device__ __forceinline__ void p3_sgu(Frame& F) {
    LAS bf16* vnT = (LAS bf16*)(F.lds + SG_VT); LAS float* stS = (LAS float*)(F.lds + SG_ST);
    const bf16* U = (const bf16*)(F.ws + WS_U); const bf16* VT = (const bf16*)(F.ws + WS_V); bf16* AB = (bf16*)(F.ws + WS_H);
    const bf16* Wb = (const bf16*)(F.ws + WS_SGW); const float* stv = (const float*)(F.ws + WS_STV);
    const float* lng = F.in[I_SLNG]; const float* lnb = F.in[I_SLNB]; const float* sb = F.in[I_SB];
    const int tid = F.tid, lane = F.lane, w = F.wave, r = lane & 31, h = lane >> 5;
    for (int item = blockIdx.x; item < 1024; item += F.G) {
        const int b = item >> 7, n = (item >> 3) & 15, g = item & 7, tok0 = b * SEQ + n * 128;
        if (tid < 128) { float s = 0.f, q = 0.f; const float* sp = stv + (size_t)(tok0 + tid) * 32;
#pragma unroll
            for (int i = 0; i < 16; ++i) { const f32x2 pr = *(const f32x2*)(sp + 2 * i); s += pr.x; q += pr.y; }
            const float mean = s * (1.0f / 1024.0f); float var = q * (1.0f / 1024.0f) - mean * mean; var = var > 0.f ? var : 0.f;
            *(LAS f32x2*)(stS + 2 * tid) = (f32x2){mean, 1.0f / sqrtf(var + LN_EPS)}; }
        __syncthreads();
        { const int c = tid >> 2, pseg = (tid & 3) * 32, ch = g * 128 + c; const float gg = lng[ch], bb = lnb[ch];
          const bf16* vp = VT + (size_t)ch * MTOK + tok0 + pseg;
          v4u wv[4];
#pragma unroll
          for (int k = 0; k < 4; ++k) wv[k] = *(const v4u*)(vp + 8 * k);
#pragma unroll
          for (int k = 0; k < 4; ++k) {
              const float e[8] = {bflo(wv[k].x), bfhi(wv[k].x), bflo(wv[k].y), bfhi(wv[k].y), bflo(wv[k].z), bfhi(wv[k].z), bflo(wv[k].w), bfhi(wv[k].w)};
              float o[8];
#pragma unroll
              for (int i = 0; i < 8; i += 2) { const f32x4 st = *(const LAS f32x4*)(stS + 2 * (pseg + 8 * k + i));
                  o[i] = (e[i] - st[0]) * st[1] * gg + bb; o[i + 1] = (e[i + 1] - st[2]) * st[3] * gg + bb; }
              v4u pk; pk.x = pk2(o[0], o[1]); pk.y = pk2(o[2], o[3]); pk.z = pk2(o[4], o[5]); pk.w = pk2(o[6], o[7]);
              *(LAS v4u*)(vnT + c * SG_LD + pseg + 8 * k) = pk; } }
        const int q0 = 32 * (w >> 1), ct0 = 2 * (w & 1);
        sg_bf16x8 af[8];
#pragma unroll
        for (int kk = 0; kk < 8; ++kk) af[kk] = *(const sg_bf16x8*)(Wb + (size_t)(g * 128 + q0 + r) * 128 + 16 * kk + 8 * h);
        __syncthreads();
        sg_f32x16 acc[2];
#pragma unroll
        for (int ct = 0; ct < 2; ++ct)
#pragma unroll
            for (int i = 0; i < 16; ++i) acc[ct][i] = 0.f;
#pragma unroll
        for (int kk = 0; kk < 8; ++kk)
#pragma unroll
            for (int ct = 0; ct < 2; ++ct) {
                const sg_bf16x8 bf = *(const LAS sg_bf16x8*)(vnT + ((ct0 + ct) * 32 + r) * SG_LD + 16 * kk + 8 * h);
                acc[ct] = __builtin_amdgcn_mfma_f32_32x32x16_bf16(af[kk], bf, acc[ct], 0, 0, 0);
            }
#pragma unroll
        for (int ct = 0; ct < 2; ++ct) {
            const int c = (ct0 + ct) * 32 + r;
#pragma unroll
            for (int rg = 0; rg < 16; ++rg) {
                const int q = q0 + (rg & 3) + 8 * (rg >> 2) + 4 * h;
                const float uv = bf1(U[(size_t)(tok0 + q) * SGUW + g * 128 + c]);
                AB[(size_t)(tok0 + q) * DM + g * 128 + c] = (bf16)f2bf(uv * (acc[ct][rg] + sb[g * 128 + q]));
            }
        }
        __syncthreads();
    }
}

__device__ __forceinline__ float sconv(const bf16* ZHT, const float* cw, const float* cb, int ch, int b, int t) {
    const bf16* zp = ZHT + (size_t)ch * MTOK + b * SEQ;
    const float z0 = t > 0 ? bf1(zp[t - 1]) : 0.f, z1 = bf1(zp[t]), z2 = t < SEQ - 1 ? bf1(zp[t + 1]) : 0.f;
    return cw[ch] * z0 + cw[3072 + ch] * z1 + cw[6144 + ch] * z2 + cb[ch];
}
__device__ __forceinline__ void p3_hyena(Frame& F) {
    LAS float* Us = (LAS float*)F.lds;
    LAS float* KF = (LAS float*)(F.lds + 65536);
    const bf16* ZHT = (const bf16*)(F.ws + WS_ZHT); const float* FILT = (const float*)(F.ws + WS_FILT); bf16* AB = (bf16*)(F.ws + WS_H);
    const float* cw = F.in[I_HCW]; const float* cb = F.in[I_HCB]; const float* skip = F.in[I_HSKIP];
    const int tid = F.tid;
    for (int item = blockIdx.x; item < HYW; item += F.G) {
        const int c = item;
        for (int i = tid; i < NBATCH * SEQ; i += NWAVES * 64) { const int b = i >> 11, t = i & 2047; Us[t * 8 + b] = sconv(ZHT, cw, cb, c, b, t); }
        for (int n = 0; n < 2; ++n) {
            const float* hf = FILT + (size_t)((0 * 2 + n) * 1024 + c) * SEQ; const float* hb = FILT + (size_t)((1 * 2 + n) * 1024 + c) * SEQ;
            for (int i = tid; i < 4095; i += NWAVES * 64) { const int lag = i - 2047; KF[i] = lag > 0 ? hf[lag] : (lag == 0 ? hf[0] + hb[0] : hb[-lag]); }
            __syncthreads();
            f32x4 acc[4][2];
#pragma unroll
            for (int ti = 0; ti < 4; ++ti) { acc[ti][0] = (f32x4){0.f, 0.f, 0.f, 0.f}; acc[ti][1] = (f32x4){0.f, 0.f, 0.f, 0.f}; }
            const LAS float* kp = KF + tid + 2047;
            for (int s = 0; s < SEQ; ++s) {
                const f32x4 u0 = *(const LAS f32x4*)(Us + s * 8), u1 = *(const LAS f32x4*)(Us + s * 8 + 4);
#pragma unroll
                for (int ti = 0; ti < 4; ++ti) { const float kv = kp[512 * ti - s]; acc[ti][0] += u0 * kv; acc[ti][1] += u1 * kv; }
            }
            __syncthreads();
            const float sk = skip[n * 1024 + c];
#pragma unroll
            for (int ti = 0; ti < 4; ++ti) { const int t = tid + 512 * ti;
#pragma unroll
                for (int b = 0; b < 8; ++b) {
                    const float uv = Us[t * 8 + b], gate = sconv(ZHT, cw, cb, (n + 1) * 1024 + c, b, t);
                    const float y = gate * (acc[ti][b >> 2][b & 3] + sk * uv);
                    if (n == 0) Us[t * 8 + b] = y; else AB[(size_t)(b * SEQ + t) * DM + 1024 + c] = (bf16)f2bf(y);
                } }
            __syncthreads();
        }
    }
}

#ifndef HYFFT_HD
#define HYFFT_HD __device__ __forceinline__
#define HYFFT_LAS __attribute__((address_space(3)))
#endif
typedef float hy_c32 __attribute__((ext_vector_type(2)));
HYFFT_HD int hy_padi(int i) { return i + (i >> 3); }
HYFFT_HD int hy_rev(int x) { return ((x & 7) << 9) | (((x >> 3) & 7) << 6) | (((x >> 6) & 7) << 3) | ((x >> 9) & 7); }

template <bool INV> HYFFT_HD void hy_dft8(float (&re)[8], float (&im)[8]) {
    const float h = 0.70710678118654752f;
    float ar[4], ai[4], br[4], bi[4];
#pragma unroll
    for (int m = 0; m < 4; ++m) { ar[m] = re[m] + re[m + 4]; ai[m] = im[m] + im[m + 4]; br[m] = re[m] - re[m + 4]; bi[m] = im[m] - im[m + 4]; }
    { float x = br[1], y = bi[1]; if (!INV) { br[1] = h * (x + y); bi[1] = h * (y - x); } else { br[1] = h * (x - y); bi[1] = h * (y + x); } }
    { float x = br[2], y = bi[2]; if (!INV) { br[2] = y; bi[2] = -x; } else { br[2] = -y; bi[2] = x; } }
    { float x = br[3], y = bi[3]; if (!INV) { br[3] = h * (y - x); bi[3] = -h * (x + y); } else { br[3] = -h * (x + y); bi[3] = h * (x - y); } }
#pragma unroll
    for (int s = 0; s < 2; ++s) {
        float* cr = s ? br : ar; float* ci = s ? bi : ai;
        const float e0r = cr[0] + cr[2], e0i = ci[0] + ci[2], e1r = cr[0] - cr[2], e1i = ci[0] - ci[2];
        const float o0r = cr[1] + cr[3], o0i = ci[1] + ci[3]; const float dr = cr[1] - cr[3], di = ci[1] - ci[3];
        float o1r, o1i; if (!INV) { o1r = di; o1i = -dr; } else { o1r = -di; o1i = dr; }
        re[0 + s] = e0r + o0r; im[0 + s] = e0i + o0i;
        re[2 + s] = e1r + o1r; im[2 + s] = e1i + o1i;
        re[4 + s] = e0r - o0r; im[4 + s] = e0i - o0i;
        re[6 + s] = e1r - o1r; im[6 + s] = e1i - o1i;
    }
}
template <bool CONJ> HYFFT_HD void hy_twiddle(float (&re)[8], float (&im)[8], float wr, float wi) {
    if (CONJ) wi = -wi;
    const float w2r = wr * wr - wi * wi, w2i = 2.f * wr * wi;
    const float w3r = w2r * wr - w2i * wi, w3i = w2r * wi + w2i * wr;
    const float w4r = w2r * w2r - w2i * w2i, w4i = 2.f * w2r * w2i;
    const float w5r = w4r * wr - w4i * wi, w5i = w4r * wi + w4i * wr;
    const float w6r = w3r * w3r - w3i * w3i, w6i = 2.f * w3r * w3i;
    const float w7r = w4r * w3r - w4i * w3i, w7i = w4r * w3i + w4i * w3r;
    const float pr[8] = {1.f, wr, w2r, w3r, w4r, w5r, w6r, w7r}, pi[8] = {0.f, wi, w2i, w3i, w4i, w5i, w6i, w7i};
#pragma unroll
    for (int k = 1; k < 8; ++k) { const float x = re[k], y = im[k]; re[k] = x * pr[k] - y * pi[k]; im[k] = x * pi[k] + y * pr[k]; }
}
template <int L, class BP, class TP> HYFFT_HD void hy_fwd_store(BP buf, TP tw, int j, float (&re)[8], float (&im)[8]) {
    constexpr int S = L / 8; const int blk = j / S, q = j % S, base = blk * L + q;
    hy_dft8<false>(re, im);
    if (L > 8) { const hy_c32 w = tw[q * (4096 / L)]; hy_twiddle<false>(re, im, w.x, w.y); }
#pragma unroll
    for (int k = 0; k < 8; ++k) buf[hy_padi(base + k * S)] = (hy_c32){re[k], im[k]};
}
template <int L, class BP> HYFFT_HD void hy_load8(BP buf, int j, float (&re)[8], float (&im)[8]) {
    constexpr int S = L / 8; const int blk = j / S, q = j % S, base = blk * L + q;
#pragma unroll
    for (int k = 0; k < 8; ++k) { const hy_c32 v = buf[hy_padi(base + k * S)]; re[k] = v.x; im[k] = v.y; }
}
template <int L, class BP, class TP> HYFFT_HD void hy_fwd_stage(BP buf, TP tw, int j) { float re[8], im[8]; hy_load8<L>(buf, j, re, im); hy_fwd_store<L>(buf, tw, j, re, im); }
template <int L, class BP, class TP> HYFFT_HD void hy_inv_regs(BP buf, TP tw, int j, float (&re)[8], float (&im)[8]) {
    constexpr int S = L / 8; const int q = j % S;
    hy_load8<L>(buf, j, re, im);
    if (L > 8) { const hy_c32 w = tw[q * (4096 / L)]; hy_twiddle<true>(re, im, w.x, w.y); }
    hy_dft8<true>(re, im);
}
template <int L, class BP, class TP> HYFFT_HD void hy_inv_stage(BP buf, TP tw, int j) {
    constexpr int S = L / 8; const int blk = j / S, q = j % S, base = blk * L + q;
    float re[8], im[8]; hy_inv_regs<L>(buf, tw, j, re, im);
#pragma unroll
    for (int k = 0; k < 8; ++k) buf[hy_padi(base + k * S)] = (hy_c32){re[k], im[k]};
}
template <class BP, class KP> HYFFT_HD void hy_mid_stage(BP buf, KP K, int j) {
    float re[8], im[8]; hy_load8<8>(buf, j, re, im);
    hy_dft8<false>(re, im);
#pragma unroll
    for (int k = 0; k < 8; ++k) { const hy_c32 kv = K[hy_padi(8 * j + k)]; const float x = re[k], y = im[k]; re[k] = x * kv.x - y * kv.y; im[k] = x * kv.y + y * kv.x; }
    hy_dft8<true>(re, im);
#pragma unroll
    for (int k = 0; k < 8; ++k) buf[hy_padi(8 * j + k)] = (hy_c32){re[k], im[k]};
}
template <class BP> HYFFT_HD void hy_last_fwd(BP buf, int j) {
    float re[8], im[8]; hy_load8<8>(buf, j, re, im); hy_dft8<false>(re, im);
#pragma unroll
    for (int k = 0; k < 8; ++k) buf[hy_padi(8 * j + k)] = (hy_c32){re[k], im[k]};
}
template <class BP, class KP> HYFFT_HD void hy_separate(BP Z, KP K1, KP K2, int j) {
    const float sc = 0.5f / 4096.0f;
#pragma unroll
    for (int r = 0; r < 8; ++r) {
        const int p = j + 512 * r, f = hy_rev(p), g = (4096 - f) & 4095, p2 = hy_rev(g);
        const hy_c32 a = Z[hy_padi(p)], b = Z[hy_padi(p2)];
        K1[hy_padi(p)] = (hy_c32){(a.x + b.x) * sc, (a.y - b.y) * sc};
        K2[hy_padi(p)] = (hy_c32){(a.y + b.y) * sc, (b.x - a.x) * sc};
    }
}

struct Raw3 { bf16 a, b, c; };
__device__ __forceinline__ Raw3 raw3(const bf16* zp, int t) { Raw3 r; r.a = zp[t > 0 ? t - 1 : 0]; r.b = zp[t]; r.c = zp[t < SEQ - 1 ? t + 1 : SEQ - 1]; return r; }
__device__ __forceinline__ float sconv_raw(const Raw3& r, int t, float w0, float w1, float w2, float cb) {
    const float z0 = t > 0 ? bf1(r.a) : 0.f, z1 = bf1(r.b), z2 = t < SEQ - 1 ? bf1(r.c) : 0.f;
    return w0 * z0 + w1 * z1 + w2 * z2 + cb;
}
HYFFT_HD int hy16_padi(int i) { return i + (i >> 4); }
HYFFT_HD int hy16_rev(int x) { return ((x & 15) << 8) | (x & 0xF0) | ((x >> 8) & 15); }
template <bool INV> HYFFT_HD void hy16_dft4(float& r0, float& i0, float& r1, float& i1, float& r2, float& i2, float& r3, float& i3) {
    const float e0r = r0 + r2, e0i = i0 + i2, e1r = r0 - r2, e1i = i0 - i2, o0r = r1 + r3, o0i = i1 + i3, dr = r1 - r3, di = i1 - i3;
    float o1r, o1i; if (!INV) { o1r = di; o1i = -dr; } else { o1r = -di; o1i = dr; }
    r0 = e0r + o0r; i0 = e0i + o0i; r1 = e1r + o1r; i1 = e1i + o1i; r2 = e0r - o0r; i2 = e0i - o0i; r3 = e1r - o1r; i3 = e1i - o1i;
}
template <bool INV> HYFFT_HD void hy16_cmulc(float& r, float& i, float cr, float ci) { if (INV) ci = -ci; const float x = r, y = i; r = x * cr - y * ci; i = x * ci + y * cr; }
template <bool INV> HYFFT_HD void hy16_dft16(float (&re)[16], float (&im)[16]) {
    const float c1 = 0.92387953251128674f, s1 = 0.38268343236508977f, h = 0.70710678118654752f;
#pragma unroll
    for (int m2 = 0; m2 < 4; ++m2) hy16_dft4<INV>(re[m2], im[m2], re[4 + m2], im[4 + m2], re[8 + m2], im[8 + m2], re[12 + m2], im[12 + m2]);
    hy16_cmulc<INV>(re[4 * 1 + 1], im[4 * 1 + 1], c1, -s1);
    hy16_cmulc<INV>(re[4 * 2 + 1], im[4 * 2 + 1], h, -h);
    hy16_cmulc<INV>(re[4 * 3 + 1], im[4 * 3 + 1], s1, -c1);
    hy16_cmulc<INV>(re[4 * 1 + 2], im[4 * 1 + 2], h, -h);
    hy16_cmulc<INV>(re[4 * 2 + 2], im[4 * 2 + 2], 0.f, -1.f);
    hy16_cmulc<INV>(re[4 * 3 + 2], im[4 * 3 + 2], -h, -h);
    hy16_cmulc<INV>(re[4 * 1 + 3], im[4 * 1 + 3], s1, -c1);
    hy16_cmulc<INV>(re[4 * 2 + 3], im[4 * 2 + 3], -h, -h);
    hy16_cmulc<INV>(re[4 * 3 + 3], im[4 * 3 + 3], -c1, s1);
#pragma unroll
    for (int k1 = 0; k1 < 4; ++k1) hy16_dft4<INV>(re[4 * k1], im[4 * k1], re[4 * k1 + 1], im[4 * k1 + 1], re[4 * k1 + 2], im[4 * k1 + 2], re[4 * k1 + 3], im[4 * k1 + 3]);
#pragma unroll
    for (int a = 0; a < 4; ++a)
#pragma unroll
        for (int b = a + 1; b < 4; ++b) { float t = re[4 * a + b]; re[4 * a + b] = re[4 * b + a]; re[4 * b + a] = t; t = im[4 * a + b]; im[4 * a + b] = im[4 * b + a]; im[4 * b + a] = t; }
}
template <bool CONJ> HYFFT_HD void hy16_twiddle(float (&re)[16], float (&im)[16], float wr, float wi) {
    if (CONJ) wi = -wi;
    float pr[16], pi[16]; pr[1] = wr; pi[1] = wi;
#define HY16_SQ(d, a) pr[d] = pr[a] * pr[a] - pi[a] * pi[a]; pi[d] = 2.f * pr[a] * pi[a];
#define HY16_MUL(d, a, b) pr[d] = pr[a] * pr[b] - pi[a] * pi[b]; pi[d] = pr[a] * pi[b] + pi[a] * pr[b];
    HY16_SQ(2, 1) HY16_MUL(3, 2, 1) HY16_SQ(4, 2) HY16_MUL(5, 4, 1) HY16_SQ(6, 3) HY16_MUL(7, 4, 3) HY16_SQ(8, 4)
    HY16_MUL(9, 8, 1) HY16_SQ(10, 5) HY16_MUL(11, 8, 3) HY16_SQ(12, 6) HY16_MUL(13, 8, 5) HY16_SQ(14, 7) HY16_MUL(15, 8, 7)
#undef HY16_SQ
#undef HY16_MUL
#pragma unroll
    for (int k = 1; k < 16; ++k) { const float x = re[k], y = im[k]; re[k] = x * pr[k] - y * pi[k]; im[k] = x * pi[k] + y * pr[k]; }
}
template <int L, class BP> HYFFT_HD void hy16_load(BP buf, int jj, float (&re)[16], float (&im)[16]) {
    constexpr int S = L / 16; const int blk = jj / S, q = jj % S, pb = hy16_padi(blk * L + q);
#pragma unroll
    for (int k = 0; k < 16; ++k) { const hy_c32 v = buf[pb + k * (S + S / 16)]; re[k] = v.x; im[k] = v.y; }
}
template <class BP> HYFFT_HD void hy16_load1(BP buf, int jj, float (&re)[16], float (&im)[16]) {
#pragma unroll
    for (int k = 0; k < 16; ++k) { const hy_c32 v = buf[17 * jj + k]; re[k] = v.x; im[k] = v.y; }
}
template <int L, class BP> HYFFT_HD void hy16_store(BP buf, int jj, const float (&re)[16], const float (&im)[16]) {
    constexpr int S = L / 16; const int blk = jj / S, q = jj % S, pb = hy16_padi(blk * L + q);
#pragma unroll
    for (int k = 0; k < 16; ++k) buf[pb + k * (S + S / 16)] = (hy_c32){re[k], im[k]};
}
template <class BP> HYFFT_HD void hy16_store1(BP buf, int jj, const float (&re)[16], const float (&im)[16]) {
#pragma unroll
    for (int k = 0; k < 16; ++k) buf[17 * jj + k] = (hy_c32){re[k], im[k]};
}
template <int L, class BP, class TP> HYFFT_HD void hy16_fwd_store(BP buf, TP tw, int jj, float (&re)[16], float (&im)[16]) {
    constexpr int S = L / 16; const int q = jj % S;
    hy16_dft16<false>(re, im);
    { const hy_c32 w = tw[q * (4096 / L)]; hy16_twiddle<false>(re, im, w.x, w.y); }
    hy16_store<L>(buf, jj, re, im);
}
template <int L, class BP, class TP> HYFFT_HD void hy16_fwd_stage(BP buf, TP tw, int jj) { float re[16], im[16]; hy16_load<L>(buf, jj, re, im); hy16_fwd_store<L>(buf, tw, jj, re, im); }
template <int L, class BP, class TP> HYFFT_HD void hy16_inv_regs(BP buf, TP tw, int jj, float (&re)[16], float (&im)[16]) {
    constexpr int S = L / 16; const int q = jj % S;
    hy16_load<L>(buf, jj, re, im);
    { const hy_c32 w = tw[q * (4096 / L)]; hy16_twiddle<true>(re, im, w.x, w.y); }
    hy16_dft16<true>(re, im);
}
template <int L, class BP, class TP> HYFFT_HD void hy16_inv_stage(BP buf, TP tw, int jj) { float re[16], im[16]; hy16_inv_regs<L>(buf, tw, jj, re, im); hy16_store<L>(buf, jj, re, im); }
template <class BP, class KP> HYFFT_HD void hy16_mid_stage(BP buf, KP K, int jj) {
    float re[16], im[16]; hy16_load1(buf, jj, re, im);
    hy16_dft16<false>(re, im);
#pragma unroll
    for (int k = 0; k < 16; ++k) { const hy_c32 kv = K[17 * jj + k]; const float x = re[k], y = im[k]; re[k] = x * kv.x - y * kv.y; im[k] = x * kv.y + y * kv.x; }
    hy16_dft16<true>(re, im);
    hy16_store1(buf, jj, re, im);
}
template <class BP> HYFFT_HD void hy16_last_fwd(BP buf, int jj) { float re[16], im[16]; hy16_load1(buf, jj, re, im); hy16_dft16<false>(re, im); hy16_store1(buf, jj, re, im); }
template <class BP, class KP> HYFFT_HD void hy16_separate(BP Z, KP K1, KP K2, int t) {
    const float sc = 0.5f / 4096.0f;
#pragma unroll
    for (int r = 0; r < 8; ++r) {
        const int p = t + 512 * r, f = hy16_rev(p), g = (4096 - f) & 4095, p2 = hy16_rev(g);
        const hy_c32 a = Z[hy16_padi(p)], b = Z[hy16_padi(p2)];
        K1[hy16_padi(p)] = (hy_c32){(a.x + b.x) * sc, (a.y - b.y) * sc};
        K2[hy16_padi(p)] = (hy_c32){(a.y + b.y) * sc, (b.x - a.x) * sc};
    }
}
__device__ __forceinline__ void p3_hyena_fft(Frame& F) {
    const int tid0 = F.tid;
    const int half = __builtin_amdgcn_readfirstlane(tid0 >> 8);
    LAS hy_c32* BUF = (LAS hy_c32*)(F.lds + half * 34816);
    LAS hy_c32* B0 = (LAS hy_c32*)(F.lds + 0);
    LAS hy_c32* K1 = (LAS hy_c32*)(F.lds + 69632); LAS hy_c32* K2 = (LAS hy_c32*)(F.lds + 104448); LAS hy_c32* TW = (LAS hy_c32*)(F.lds + 139264);
    const bf16* ZHT = (const bf16*)(F.ws + WS_ZHT); const float* FILT = (const float*)(F.ws + WS_FILT); bf16* YT = (bf16*)(F.ws + WS_YT);
    const float* cw = F.in[I_HCW]; const float* cb = F.in[I_HCB]; const float* skip = F.in[I_HSKIP];
    if (tid0 < 256) { float sn, cs; sincosf(-6.283185307179586f * (float)tid0 / 4096.0f, &sn, &cs); TW[tid0] = (hy_c32){cs, sn}; }
    __syncthreads();
    for (int item = blockIdx.x; item < HYW; item += F.G) {
        const int c = item;
        int tid = tid0; asm volatile("" : "+v"(tid));
        int jj = tid & 255;
        float re[16], im[16];
        const bf16* zv = ZHT + (size_t)c * MTOK; const bf16* za = ZHT + (size_t)(1024 + c) * MTOK; const bf16* zb = ZHT + (size_t)(2048 + c) * MTOK;
        {
            if (half == 0) {
                const float* hf0 = FILT + (size_t)(0 * 1024 + c) * SEQ; const float* hf1 = FILT + (size_t)(1 * 1024 + c) * SEQ;
                const float* hb0 = FILT + (size_t)(2 * 1024 + c) * SEQ; const float* hb1 = FILT + (size_t)(3 * 1024 + c) * SEQ;
#pragma unroll
                for (int m = 0; m < 8; ++m) { const int i = jj + 256 * m; re[m] = hf0[i]; im[m] = hf1[i]; }
                if (jj == 0) { re[0] += hb0[0]; im[0] += hb1[0]; }
#pragma unroll
                for (int m = 8; m < 16; ++m) { const int i = jj + 256 * m; const bool z = (i == 2048); const int r = z ? 0 : 4096 - i; const float a = hb0[r], b = hb1[r]; re[m] = z ? 0.f : a; im[m] = z ? 0.f : b; }
                hy16_fwd_store<4096>(B0, TW, jj, re, im);
            }
            __syncthreads();
            if (half == 0) hy16_fwd_stage<256>(B0, TW, jj);
            __syncthreads();
            if (half == 0) hy16_last_fwd(B0, jj);
            __syncthreads();
            hy16_separate(B0, K1, K2, tid); __syncthreads();
        }
        const float vw0 = cw[c], vw1 = cw[3072 + c], vw2 = cw[6144 + c], vcb = cb[c];
        const float aw0 = cw[1024 + c], aw1 = cw[3072 + 1024 + c], aw2 = cw[6144 + 1024 + c], acb = cb[1024 + c];
        const float bw0 = cw[2048 + c], bw1 = cw[3072 + 2048 + c], bw2 = cw[6144 + 2048 + c], bcb = cb[2048 + c];
        const float sk0 = skip[c], sk1 = skip[1024 + c];
#pragma unroll 1
        for (int rd = 0; rd < 2; ++rd) {
            const int boff = (4 * rd + 2 * half) * SEQ;
            asm volatile("" : "+v"(jj));
            Raw3 rg[2][8];
            float v[2][8];
#pragma unroll
            for (int m = 0; m < 8; ++m) { const int t = jj + 256 * m;
                const Raw3 r0 = raw3(zv + boff, t), r1 = raw3(zv + boff + SEQ, t); v[0][m] = sconv_raw(r0, t, vw0, vw1, vw2, vcb); v[1][m] = sconv_raw(r1, t, vw0, vw1, vw2, vcb); }
#pragma unroll
            for (int m = 0; m < 8; ++m) { re[m] = v[0][m]; im[m] = v[1][m]; re[m + 8] = 0.f; im[m + 8] = 0.f; }
            hy16_fwd_store<4096>(BUF, TW, jj, re, im); __syncthreads();
            hy16_fwd_stage<256>(BUF, TW, jj); __syncthreads();
            hy16_mid_stage(BUF, K1, jj); __syncthreads();
#pragma unroll
            for (int m = 0; m < 8; ++m) { const int t = jj + 256 * m; rg[0][m] = raw3(za + boff, t); rg[1][m] = raw3(za + boff + SEQ, t); }
            hy16_inv_stage<256>(BUF, TW, jj); __syncthreads();
            hy16_inv_regs<4096>(BUF, TW, jj, re, im);
#pragma unroll
            for (int m = 0; m < 8; ++m) { const int t = jj + 256 * m;
                v[0][m] = sconv_raw(rg[0][m], t, aw0, aw1, aw2, acb) * (re[m] + sk0 * v[0][m]); v[1][m] = sconv_raw(rg[1][m], t, aw0, aw1, aw2, acb) * (im[m] + sk0 * v[1][m]); }
#pragma unroll
            for (int m = 0; m < 8; ++m) { re[m] = v[0][m]; im[m] = v[1][m]; re[m + 8] = 0.f; im[m + 8] = 0.f; }
            hy16_fwd_store<4096>(BUF, TW, jj, re, im); __syncthreads();
            hy16_fwd_stage<256>(BUF, TW, jj); __syncthreads();
            hy16_mid_stage(BUF, K2, jj); __syncthreads();
#pragma unroll
            for (int m = 0; m < 8; ++m) { const int t = jj + 256 * m; rg[0][m] = raw3(zb + boff, t); rg[1][m] = raw3(zb + boff + SEQ, t); }
            hy16_inv_stage<256>(BUF, TW, jj); __syncthreads();
            hy16_inv_regs<4096>(BUF, TW, jj, re, im);
#pragma unroll
            for (int m = 0; m < 8; ++m) { const int t = jj + 256 * m; bf16* yp = YT + (size_t)c * MTOK + boff + t;
                yp[0] = (bf16)f2bf(sconv_raw(rg[0][m], t, bw0, bw1, bw2, bcb) * (re[m] + sk1 * v[0][m]));
                yp[SEQ] = (bf16)f2bf(sconv_raw(rg[1][m], t, bw0, bw1, bw2, bcb) * (im[m] + sk1 * v[1][m])); }
        }
        __syncthreads();
    }
}

__device__ __forceinline__ void p3c_transpose(Frame& F) {
    constexpr int LD = 264;
    LAS bf16* tile = (LAS bf16*)F.lds;
    const bf16* YT = (const bf16*)(F.ws + WS_YT); bf16* AB = (bf16*)(F.ws + WS_H);
    const int tid = F.tid;
    for (int it = blockIdx.x; it < 16 * 64; it += F.G) {
        const int c0 = (it >> 6) * 64, t0 = (it & 63) * 256;
        { const int c = tid >> 3, ts = (tid & 7) * 32; const bf16* src = YT + (size_t)(c0 + c) * MTOK + t0 + ts;
          v4u w[4];
#pragma unroll
          for (int k = 0; k < 4; ++k) w[k] = *(const v4u*)(src + 8 * k);
#pragma unroll
          for (int k = 0; k < 4; ++k) *(LAS v4u*)(tile + c * LD + ts + 8 * k) = w[k]; }
        __syncthreads();
        { const int t = tid >> 1, cs = (tid & 1) * 32; unsigned o[16];
#pragma unroll
          for (int i = 0; i < 16; ++i) o[i] = (unsigned)tile[(cs + 2 * i) * LD + t] | ((unsigned)tile[(cs + 2 * i + 1) * LD + t] << 16);
          bf16* dst = AB + (size_t)(t0 + t) * DM + 1024 + c0 + cs;
#pragma unroll
          for (int k = 0; k < 4; ++k) *(v4u*)(dst + 8 * k) = (v4u){o[4 * k], o[4 * k + 1], o[4 * k + 2], o[4 * k + 3]}; }
        __syncthreads();
    }
}

template <bool FINAL> __device__ __forceinline__ void ln_rows(Frame& F) {
    float* R = F.out; const float* st = (const float*)(F.ws + (FINAL ? WS_ST2 : WS_ST1)); float* MU = (float*)(F.ws + WS_MU1);
    const float* mod = (const float*)(F.ws + WS_MOD); bf16* H2 = (bf16*)(F.ws + WS_H);
    const float* lng = F.in[FINAL ? I_LN2G : I_LN1G]; const float* lnb = F.in[FINAL ? I_LN2B : I_LN1B];
    const int gw = blockIdx.x * NWAVES + F.wave, NGW = F.G * NWAVES, lane = F.lane;
    f32x4 cur[8], nxt[8]; f32x2 ps = (f32x2){0.f, 0.f}, pn = (f32x2){0.f, 0.f};
    int row = gw;
    if (row < MTOK) {
#pragma unroll
        for (int j = 0; j < 8; ++j) cur[j] = *(const f32x4*)(R + (size_t)row * DM + 4 * lane + 256 * j);
        if (lane < 32) ps = *(const f32x2*)(st + ((size_t)row * 32 + lane) * 2);
    }
    for (; row < MTOK; row += NGW) {
        const int rn = row + NGW;
        if (rn < MTOK) {
#pragma unroll
            for (int j = 0; j < 8; ++j) nxt[j] = *(const f32x4*)(R + (size_t)rn * DM + 4 * lane + 256 * j);
            pn = (f32x2){0.f, 0.f}; if (lane < 32) pn = *(const f32x2*)(st + ((size_t)rn * 32 + lane) * 2);
        }
        const float s = wave_sum(ps.x), q = wave_sum(ps.y);
        const float mean = s * (1.0f / DM); float var = q * (1.0f / DM) - mean * mean; var = var > 0.f ? var : 0.f; const float rstd = 1.0f / sqrtf(var + LN_EPS);
        if (!FINAL && lane == 0) *(f32x2*)(MU + (size_t)row * 2) = (f32x2){mean, rstd};
        const int b = row >> 11; float* rp = R + (size_t)row * DM;
#pragma unroll
        for (int j = 0; j < 8; ++j) { const int col = 4 * lane + 256 * j;
            const f32x4 y = (cur[j] - mean) * rstd * *(const f32x4*)(lng + col) + *(const f32x4*)(lnb + col);
            if (FINAL) *(f32x4*)(rp + col) = y;
            else { const float* mp = mod + (size_t)b * MODW + col; const f32x4 h = y * (*(const f32x4*)(mp + 4 * DM) + 1.0f) + *(const f32x4*)(mp + 3 * DM);
                   v2u o; o.x = pk2(h[0], h[1]); o.y = pk2(h[2], h[3]); *(v2u*)(H2 + (size_t)row * DM + col) = o; } }
#pragma unroll
        for (int j = 0; j < 8; ++j) cur[j] = nxt[j];
        ps = pn;
    }
}

typedef GAS unsigned gu32;
#define RLX_AGENT __ATOMIC_RELAXED, __HIP_MEMORY_SCOPE_AGENT
constexpr int LDSCTL_OFF = 163840 - 512, MISC_OFF = LDSCTL_OFF;
constexpr int CW_BAR = 4096;
constexpr size_t CTL_ZERO_BYTES = 65536;
#define XB_TMO      128
#define XB_XCNT(j)  (256  + 64 * (j))
#define XB_XSUB(j)  (1280 + 64 * (j))
#define XB_XGEN(j)  (2304 + 64 * (j))
#define XB_TOP      3328
#define XB_TOPGEN   3392
#define XCD_BAR_WORDS 3456
#define XB_SPIN_CAP (1u << 18)

__device__ __forceinline__ unsigned xb_ld(unsigned* p)              { return __hip_atomic_load(p, __ATOMIC_RELAXED, __HIP_MEMORY_SCOPE_AGENT); }
__device__ __forceinline__ unsigned xb_add(unsigned* p, unsigned v) { return __hip_atomic_fetch_add(p, v, __ATOMIC_RELAXED, __HIP_MEMORY_SCOPE_AGENT); }
__device__ __forceinline__ unsigned xb_xcc_id() { return (unsigned)__builtin_amdgcn_s_getreg((3 << 11) | 20) & 0xFu; }
#define XB_SPIN(cond, bar) do { unsigned _sp = 0; while (cond) { __builtin_amdgcn_s_sleep(1); \
    if ((++_sp & 255u) == 0u) { if (xb_ld(&(bar)[XB_TMO])) break; if (_sp > XB_SPIN_CAP) { atomicAdd(&(bar)[XB_TMO], 1u); break; } } } } while (0)

struct XcdBarrier {
    unsigned* bar; unsigned x;
    volatile LAS unsigned* st;
};

__device__ __forceinline__ XcdBarrier xcd_barrier_post(unsigned* bar, volatile LAS unsigned* st) {
    XcdBarrier b; b.bar = bar; b.x = xb_xcc_id(); b.st = st;
    if (threadIdx.x == 0) (void)xb_add(&bar[XB_XCNT(b.x)], 1u);
    return b;
}
__device__ __forceinline__ void xcd_barrier_complete(unsigned* bar, unsigned x, unsigned& nloc, unsigned& nx) {
    const unsigned G = gridDim.x * gridDim.y * gridDim.z;
    unsigned sum, cnt, mine, sp = 0u;
    for (;;) {
        sum = 0u; cnt = 0u; mine = 0u;
#pragma unroll
        for (unsigned j = 0; j < 16; ++j) { const unsigned c = xb_ld(&bar[XB_XCNT(j)]); sum += c; cnt += (c > 0u) ? 1u : 0u; mine = (j == x) ? c : mine; }
        if (sum == G) break;
        __builtin_amdgcn_s_sleep(1);
        if ((++sp & 255u) == 0u) { if (xb_ld(&bar[XB_TMO])) break; if (sp > XB_SPIN_CAP) { atomicAdd(&bar[XB_TMO], 1u); break; } }
    }
    nloc = mine > 0u ? mine : 1u; nx = cnt > 0u ? cnt : 1u;
}

__device__ __forceinline__ void xcd_barrier(const XcdBarrier& b) {
    asm volatile("s_waitcnt vmcnt(0)" ::: "memory");
    __syncthreads();
    if (threadIdx.x == 0) {
        unsigned* bar = b.bar;
        __builtin_amdgcn_s_waitcnt(0);
        unsigned nloc = b.st[0], nx = b.st[1];
        if (nloc == 0u) { xcd_barrier_complete(bar, b.x, nloc, nx); b.st[0] = nloc; b.st[1] = nx; }
        const unsigned old = xb_add(&bar[XB_XSUB(b.x)], 1u);
        const unsigned gen = old / nloc;
        if (old + 1u == (gen + 1u) * nloc) {
            __builtin_amdgcn_fence(__ATOMIC_RELEASE, "agent");
            asm volatile("s_waitcnt vmcnt(0)" ::: "memory");
            const unsigned og = xb_add(&bar[XB_TOP], 1u);
            const unsigned tg = og / nx;
            if (og + 1u == (tg + 1u) * nx) xb_add(&bar[XB_TOPGEN], 1u);
            else XB_SPIN(xb_ld(&bar[XB_TOPGEN]) == tg, bar);
            __builtin_amdgcn_fence(__ATOMIC_ACQUIRE, "agent");
            xb_add(&bar[XB_XGEN(b.x)], 1u);
            asm volatile("s_waitcnt vmcnt(0)" ::: "memory");
        } else {
            XB_SPIN(xb_ld(&bar[XB_XGEN(b.x)]) == gen, bar);
            __builtin_amdgcn_fence(__ATOMIC_ACQUIRE, "agent");
            asm volatile("s_waitcnt vmcnt(0)" ::: "memory");
        }
    }
    __syncthreads();
}

#define GRID_SYNC() xcd_barrier(bar)

__global__ void __launch_bounds__(NWAVES * 64, 2) fwd_megakernel(Args args) {
    extern __shared__ __attribute__((aligned(16))) unsigned char lds[];
    Frame F;
    F.lds = (LAS unsigned char*)lds;
    F.tid = threadIdx.x; F.lane = F.tid & 63; F.wave = __builtin_amdgcn_readfirstlane(F.tid >> 6); F.G = gridDim.x;
    F.in = args.in; F.out = args.out; F.ws = args.ws;
    for (int u = F.tid; u < (LDS_BYTES - LDSCTL_OFF) / 4; u += NWAVES * 64) ((LAS unsigned*)(F.lds + LDSCTL_OFF))[u] = 0u;
    __syncthreads();
    XcdBarrier bar = xcd_barrier_post((unsigned*)(args.ws + WS_CTL) + CW_BAR, (volatile LAS unsigned*)(F.lds + MISC_OFF) + 8);
    unsigned char* ws = args.ws;
    const int lo = args.ph_lo, hi = args.ph_hi;
#define IN(k) (lo <= (k) && (k) < hi)
#define BOTH(k) (IN(k) && IN((k) + 1))
    const int gw = blockIdx.x * NWAVES + F.wave, NGW = F.G * NWAVES;

    PB_START(1, F.lds);
    if (IN(0)) { { int t_ = threadIdx.x; asm volatile("" : "+v"(t_)); F.tid = t_; F.lane = t_ & 63; }
        PB_START(21, F.lds); p0_mod(F); PB_END(21, F.lds);
        PB_START(22, F.lds);
        transpose_matrix(F, F.in[I_WIN], DM, INW, (bf16*)(ws + WS_WIN), DM, 0, 1, (int)blockIdx.x, F.G);
        transpose_matrix(F, F.in[I_WA], SGUW, DM, (bf16*)(ws + WS_WAB), DM, 0, 0, (int)((blockIdx.x + 128) % F.G), F.G);
        transpose_matrix(F, F.in[I_WB], HYW, DM, (bf16*)(ws + WS_WAB), DM, 1024, 0, (int)blockIdx.x, F.G);
        transpose_matrix(F, F.in[I_WO], DM, DM, (bf16*)(ws + WS_WO), DM, 0, 0, (int)blockIdx.x, F.G);
        { const float* sw = F.in[I_SW]; bf16* sgw = (bf16*)(ws + WS_SGW);
          for (int i = blockIdx.x * (NWAVES * 64) + F.tid; i < 8 * 128 * 128 / 2; i += F.G * NWAVES * 64) { const f32x2 v = *(const f32x2*)(sw + 2 * i); *(unsigned*)(sgw + 2 * i) = pk2(v.x, v.y); } }
        __syncthreads();
        __syncthreads(); p0_hid2(F);
        PB_END(22, F.lds);
        if (BOTH(0)) GRID_SYNC();
    }
    PB_END(1, F.lds);
    PB_START(2, F.lds);
    if (IN(1)) { { int t_ = threadIdx.x; asm volatile("" : "+v"(t_)); F.tid = t_; F.lane = t_ & 63; } if (F.wave < 4) p1_modulate(F); else p1_filter_waves(F); if (BOTH(1)) GRID_SYNC(); }
    PB_END(2, F.lds);
    PB_START(3, F.lds);
    if (IN(2)) { { int t_ = threadIdx.x; asm volatile("" : "+v"(t_)); F.tid = t_; F.lane = t_ & 63; }
        { pg8::Gemm g{(const pg8::bf16_t*)(ws + WS_H), (const pg8::bf16_t*)(ws + WS_WIN), MTOK, 5120, DM}; pg8::StaticOrder S; S.init(MTOK, 5120, F.G, (int)blockIdx.x);
          pg8::EpiG1 E{(pg8::bf16_t*)(ws + WS_U), (pg8::bf16_t*)(ws + WS_G), F.in[I_BIN]};
          pg8::gemm_phase<pg8::EpiG1, pg8::StaticOrder, true, true>(F.lds, g, S, E); }
        __syncthreads();
        { pg8::Gemm g{(const pg8::bf16_t*)(ws + WS_WIN) + (size_t)5120 * DM, (const pg8::bf16_t*)(ws + WS_H), 4096, MTOK, DM}; pg8::StaticOrder S; S.init(4096, MTOK, F.G, (int)blockIdx.x);
          pg8::EpiG1T E{(pg8::bf16_t*)(ws + WS_V), (pg8::bf16_t*)(ws + WS_ZHT), F.in[I_BIN], (float*)(ws + WS_STV)};
          pg8::gemm_phase<pg8::EpiG1T, pg8::StaticOrder, true, true>(F.lds, g, S, E); }
        if (BOTH(2)) GRID_SYNC();
    }
    PB_END(3, F.lds);
    PB_START(4, F.lds);
    if (IN(3)) { { int t_ = threadIdx.x; asm volatile("" : "+v"(t_)); F.tid = t_; F.lane = t_ & 63; } __syncthreads(); PB_START(41, F.lds); p3_sgu(F); PB_END(41, F.lds); PB_START(42, F.lds); p3_hyena_fft(F); PB_END(42, F.lds); if (BOTH(3)) GRID_SYNC(); PB_START(43, F.lds); p3c_transpose(F); GRID_SYNC(); PB_END(43, F.lds); }
    PB_END(4, F.lds);
    PB_START(5, F.lds);
    if (IN(4)) { { int t_ = threadIdx.x; asm volatile("" : "+v"(t_)); F.tid = t_; F.lane = t_ & 63; }
        pg8::Gemm g{(const pg8::bf16_t*)(ws + WS_H), (const pg8::bf16_t*)(ws + WS_WAB), MTOK, DM, DM}; pg8::StaticOrder S; S.init(MTOK, DM, F.G, (int)blockIdx.x);
        pg8::EpiG2 E{(const pg8::bf16_t*)(ws + WS_G), (pg8::bf16_t*)(ws + WS_MERGED)};
        pg8::gemm_phase<pg8::EpiG2, pg8::StaticOrder, true, true>(F.lds, g, S, E);
        if (BOTH(4)) GRID_SYNC();
    }
    PB_END(5, F.lds);
    PB_START(6, F.lds);
    if (IN(5)) { { int t_ = threadIdx.x; asm volatile("" : "+v"(t_)); F.tid = t_; F.lane = t_ & 63; }
        pg8::Gemm g{(const pg8::bf16_t*)(ws + WS_MERGED), (const pg8::bf16_t*)(ws + WS_WO), MTOK, DM, DM}; pg8::StaticOrder S; S.init(MTOK, DM, F.G, (int)blockIdx.x);
        pg8::EpiRes<true> E{F.in[I_X], F.out, (const float*)(ws + WS_MOD) + 2 * DM, F.in[I_BO], nullptr, nullptr, nullptr, (float*)(ws + WS_ST1)};
        pg8::gemm_phase<pg8::EpiRes<true>, pg8::StaticOrder, true, true>(F.lds, g, S, E);
        if (BOTH(5)) GRID_SYNC();
    }
    PB_END(6, F.lds);
    PB_START(7, F.lds);
    if (IN(6)) { { int t_ = threadIdx.x; asm volatile("" : "+v"(t_)); F.tid = t_; F.lane = t_ & 63; }
        __syncthreads();
        ln_rows<false>(F);
        __syncthreads();
        transpose_matrix(F, F.in[I_WM1], DM, DFF, (bf16*)(ws + WS_WM1), DM, 0, 0, (int)blockIdx.x, F.G);
        transpose_matrix(F, F.in[I_WM2], DFF, DM, (bf16*)(ws + WS_WM2), DFF, 0, 0, (int)blockIdx.x, F.G);
        if (BOTH(6)) GRID_SYNC();
    }
    PB_END(7, F.lds);
    PB_START(8, F.lds);
    if (IN(7)) { { int t_ = threadIdx.x; asm volatile("" : "+v"(t_)); F.tid = t_; F.lane = t_ & 63; }
        __syncthreads();
        pg8::Gemm g{(const pg8::bf16_t*)(ws + WS_H), (const pg8::bf16_t*)(ws + WS_WM1), MTOK, DFF, DM}; pg8::StaticOrder S; S.init(MTOK, DFF, F.G, (int)blockIdx.x);
        pg8::EpiG4 E{(pg8::bf16_t*)(ws + WS_AFF), F.in[I_BM1]};
        pg8::gemm_phase<pg8::EpiG4, pg8::StaticOrder, true, true>(F.lds, g, S, E);
        if (BOTH(7)) GRID_SYNC();
    }
    PB_END(8, F.lds);
    PB_START(9, F.lds);
    if (IN(8)) { { int t_ = threadIdx.x; asm volatile("" : "+v"(t_)); F.tid = t_; F.lane = t_ & 63; }
        pg8::Gemm g{(const pg8::bf16_t*)(ws + WS_AFF), (const pg8::bf16_t*)(ws + WS_WM2), MTOK, DM, DFF}; pg8::StaticOrder S; S.init(MTOK, DM, F.G, (int)blockIdx.x);
        pg8::EpiRes<false> E{nullptr, F.out, (const float*)(ws + WS_MOD) + 5 * DM, F.in[I_BM2], F.in[I_LN1G], F.in[I_LN1B], (const float*)(ws + WS_MU1), (float*)(ws + WS_ST2)};
        pg8::gemm_phase<pg8::EpiRes<false>, pg8::StaticOrder, true, true>(F.lds, g, S, E);
        if (BOTH(8)) GRID_SYNC();
    }
    PB_END(9, F.lds);
    PB_START(10, F.lds);
    if (IN(9)) { { int t_ = threadIdx.x; asm volatile("" : "+v"(t_)); F.tid = t_; F.lane = t_ & 63; } ln_rows<true>(F); }
    PB_END(10, F.lds);
    if (PROBE_ID != 0 && blockIdx.x == 0 && threadIdx.x == 0) { const unsigned long long wait_ = *(volatile LAS unsigned long long*)(F.lds + PB_LDS_OFF), t0_ = __builtin_amdgcn_s_memrealtime();
        while (__builtin_amdgcn_s_memrealtime() - t0_ < wait_) __builtin_amdgcn_s_sleep(8); }
#undef IN
#undef BOTH
}

constexpr int N_PHASES = 10;
#ifndef MK_N_LAUNCHES
#define MK_N_LAUNCHES 1
#endif
extern "C" void kernel_launch(void* const* d_in, const int* in_sizes, int n_in, void* d_out, int out_size, void* d_ws, size_t ws_size, hipStream_t stream) {
    static int grid = 0;
    if (grid == 0) {
        if (n_in != 31 || in_sizes[0] != MTOK * DM || out_size != MTOK * DM || ws_size < WS_END) {
            fprintf(stderr, "kernel_launch: unexpected problem: n_in %d in0 %d out %d ws %zu (need %zu)\n", n_in, n_in > 0 ? in_sizes[0] : -1, out_size, ws_size, (size_t)WS_END); grid = -1; return; }
        int dev = 0, cus = 0, per_cu = 0;
        if (hipGetDevice(&dev) != hipSuccess || hipDeviceGetAttribute(&cus, hipDeviceAttributeMultiprocessorCount, dev) != hipSuccess) { grid = -1; return; }
        if (hipFuncSetAttribute((const void*)fwd_megakernel, hipFuncAttributeMaxDynamicSharedMemorySize, LDS_BYTES) != hipSuccess) { fprintf(stderr, "kernel_launch: hipFuncSetAttribute failed\n"); grid = -1; return; }
        if (hipOccupancyMaxActiveBlocksPerMultiprocessor(&per_cu, (const void*)fwd_megakernel, NWAVES * 64, LDS_BYTES) != hipSuccess || per_cu < 1) { fprintf(stderr, "kernel_launch: occupancy query says %d\n", per_cu); per_cu = 1; }
        (void)hipGetLastError();
        grid = cus;
    }
    if (grid < 0) return;
    if (hipMemsetAsync((char*)d_ws + WS_CTL, 0, CTL_ZERO_BYTES, stream) != hipSuccess) { fprintf(stderr, "kernel_launch: memset failed\n"); return; }
    Args a{};
    for (int i = 0; i < 31; ++i) a.in[i] = (const float*)d_in[i];
    a.out = (float*)d_out; a.ws = (unsigned char*)d_ws;
    if (MK_N_LAUNCHES == 1) {
        a.ph_lo = 0; a.ph_hi = N_PHASES;
        void* kargs[] = {&a};
        hipError_t e = hipLaunchCooperativeKernel((const void*)fwd_megakernel, dim3(grid), dim3(NWAVES * 64), kargs, LDS_BYTES, stream);
        if (e != hipSuccess) fprintf(stderr, "kernel_launch: cooperative launch failed: %s (grid %d)\n", hipGetErrorString(e), grid);
    } else {
        for (int p = 0; p < N_PHASES; ++p) { a.ph_lo = p; a.ph_hi = p + 1; hipLaunchKernelGGL(fwd_megakernel, dim3(grid), dim3(NWAVES * 64), LDS_BYTES, stream, a); }
    }
}
```

```cpp
#include <hip/hip_runtime.h>
#include <cstdio>
#include <cstdint>

#ifndef PROBE_ID
#define PROBE_ID 0
#endif
#define PB_LDS_OFF (163840 - 512 + 128)
#define PB_START(id, ldsp) do { if (PROBE_ID == (id) && blockIdx.x == 0 && threadIdx.x == 0) { *(volatile __attribute__((address_space(3))) unsigned long long*)((ldsp) + PB_LDS_OFF + 8) = __builtin_amdgcn_s_memrealtime(); } } while (0)
#define PB_END(id, ldsp) do { if (PROBE_ID == (id) && blockIdx.x == 0 && threadIdx.x == 0) { volatile __attribute__((address_space(3))) unsigned long long* pb_ = (volatile __attribute__((address_space(3))) unsigned long long*)((ldsp) + PB_LDS_OFF); pb_[0] += __builtin_amdgcn_s_memrealtime() - pb_[1]; } } while (0)
namespace pg8 {
#define PG8_LAS __attribute__((address_space(3)))
typedef unsigned short bf16_t;
typedef short bf16x8 __attribute__((ext_vector_type(8)));
typedef float f32x4 __attribute__((ext_vector_type(4)));
typedef unsigned u32x4 __attribute__((ext_vector_type(4)));
typedef float f32x2 __attribute__((ext_vector_type(2)));
constexpr int EPI_LDS_OFF = 131072;
constexpr int BM = 256, BK = 64, HALF = 128, HTB = HALF * BK * 2  , STAGE_BYTES = 8 * HTB, NXCD = 8, WGM = 8;

__host__ __device__ __forceinline__ int lds_byte(int r, int c) { const int st = (r >> 4) * 2 + (c >> 5), rr = r & 15, cc = c & 31, ob = rr * 64 + cc * 2; return st * 1024 + (ob ^ (((ob >> 9) & 1) << 5)); }
__host__ __device__ __forceinline__ void stage_rc(int b, int& R, int& C) { const int st = b / 1024, sb = b % 1024, swz = sb ^ (((sb >> 9) & 1) << 5); R = (st >> 1) * 16 + swz / 64; C = (st & 1) * 32 + (swz % 64) / 2; }
__host__ __device__ __forceinline__ int perm32(int rho) { const int n = rho >> 4, i = rho & 15; return 8 * (i >> 2) + 4 * n + (i & 3); }

struct Unit { int pm, pn; };
struct Gemm { const bf16_t* A; const bf16_t* Bt; int M, N, K; };

struct StaticOrder {
    int nM, nN, nwg, G, c;
    __host__ __device__ void init(int M, int N, int G_, int c_) { nM = M / BM; nN = N / BM; nwg = nM * nN; G = G_; c = c_; }
    __host__ __device__ bool next(int i, Unit& u) const {
        const long L = (long)i * G + c; if (L >= nwg) return false;
        int wgid = (int)L; { const int q = nwg / NXCD, r = nwg % NXCD, xcd = wgid % NXCD, off = wgid / NXCD; wgid = (xcd < r ? xcd * (q + 1) : r * (q + 1) + (xcd - r) * q) + off; }
        const int nig = WGM * nN, gid = wgid / nig, fm = gid * WGM, gsz = (nM - fm) < WGM ? (nM - fm) : WGM;
        u.pm = fm + ((wgid % nig) % gsz); u.pn = (wgid % nig) / gsz; return true;
    }
    __device__ __forceinline__ void a_ready(const Unit&) const {}
    __device__ __forceinline__ void done(const Unit&) const {}
};

__device__ __forceinline__ unsigned cvt_pk_bf16(float lo, float hi) { unsigned r; asm volatile("v_cvt_pk_bf16_f32 %0, %1, %2" : "=v"(r) : "v"(lo), "v"(hi)); return r; }
__device__ __forceinline__ f32x2 gelu_pk(f32x2 v) {
    const f32x2 av = __builtin_elementwise_abs(v), d = av * 0.2316418882f + 1.0f;
    f32x2 t; t.x = __builtin_amdgcn_rcpf(d.x); t.y = __builtin_amdgcn_rcpf(d.y);
    f32x2 q = t * 0.5307027145f + (-0.7265760135f); q = q * t + 0.7107068705f; q = q * t + (-0.142248368f); q = q * t + 0.127414796f; q = q * t;
    const f32x2 s = (v * v) * (-0.72134752044f);
    f32x2 e; e.x = __builtin_amdgcn_exp2f(s.x); e.y = __builtin_amdgcn_exp2f(s.y);
    const f32x2 m = v * (q * e), r = v - m;
    f32x2 o; o.x = v.x < 0.f ? m.x : r.x; o.y = v.y < 0.f ? m.y : r.y; return o;
}
__device__ __forceinline__ float bf_lo(unsigned w) { return __uint_as_float(w << 16); }
__device__ __forceinline__ float bf_hi(unsigned w) { return __uint_as_float(w & 0xffff0000u); }
__device__ __forceinline__ float sigmoid_f(float x) { return __builtin_amdgcn_rcpf(1.0f + __expf(-x)); }
}

constexpr int DM = 2048, NBATCH = 8, SEQ = 2048, MTOK = NBATCH * SEQ;
constexpr int SGUW = 1024, HYW = 1024, DFF = 8192, INW = 9216, MODW = 6 * DM;
constexpr float LN_EPS = 1e-5f;
constexpr float DN_ALPHA = 1.189207115002721f;

namespace pg8 {

struct EpiG1 {
    static constexpr bool PERM = true, AFTER_DRAIN = false, MID = false; static constexpr int SLOT_FLOATS = 256;
    bf16_t* U; bf16_t* G; const float* b_in;
    __device__ __forceinline__ void mid(f32x4 (&)[2][2][4][2], const Unit&, int, int, int, int) const {}
    __device__ __forceinline__ void preload(PG8_LAS float* slot, const Unit& u, int tid) const { if (tid < 256) slot[tid] = b_in[(u.pn < 4 ? u.pn * 256 : 5120 + (u.pn - 4) * 256) + tid]; }
    __device__ __forceinline__ void operator()(const f32x4 (&acc)[2][2][4][2], const Unit& u, int wr, int wc, int fr, int fq, const PG8_LAS float* slot) const {
        const int row0 = u.pm * BM + wr * 64 + fr; const int pn = u.pn;
        int ldc, colt; bf16_t* base; const bool isu = pn < 4;
        if (isu) { base = U; ldc = SGUW; colt = pn * 256; }
        else { base = G; ldc = 2 * DM; colt = (pn - 4) * 256; }
        const int cl = wc * 64 + 8 * fq;
        f32x4 bv[2][2];
#pragma unroll
        for (int bj = 0; bj < 2; ++bj)
#pragma unroll
            for (int n = 0; n < 2; ++n) bv[bj][n] = *(const PG8_LAS f32x4*)(slot + cl + bj * 32 + 4 * n);
#pragma unroll
        for (int ai = 0; ai < 2; ++ai)
#pragma unroll
            for (int m = 0; m < 4; ++m) {
                const int row = row0 + ai * HALF + m * 16;
                bf16_t* rowp = base + (size_t)row * ldc + colt + cl;
#pragma unroll
                for (int bj = 0; bj < 2; ++bj) {
                    f32x4 v0 = acc[ai][bj][m][0] + bv[bj][0], v1 = acc[ai][bj][m][1] + bv[bj][1];
                    if (isu) {
                        f32x2 a = gelu_pk((f32x2){v0[0], v0[1]}), b = gelu_pk((f32x2){v0[2], v0[3]}), c = gelu_pk((f32x2){v1[0], v1[1]}), d = gelu_pk((f32x2){v1[2], v1[3]});
                        v0 = (f32x4){a.x, a.y, b.x, b.y}; v1 = (f32x4){c.x, c.y, d.x, d.y};
                    } else {
                        v0 = (f32x4){sigmoid_f(v0[0]), sigmoid_f(v0[1]), sigmoid_f(v0[2]), sigmoid_f(v0[3])};
                        v1 = (f32x4){sigmoid_f(v1[0]), sigmoid_f(v1[1]), sigmoid_f(v1[2]), sigmoid_f(v1[3])};
                    }
                    u32x4 w; w.x = cvt_pk_bf16(v0[0], v0[1]); w.y = cvt_pk_bf16(v0[2], v0[3]); w.z = cvt_pk_bf16(v1[0], v1[1]); w.w = cvt_pk_bf16(v1[2], v1[3]);
                    *(u32x4*)(rowp + bj * 32) = w;
                }
            }
    }
};

struct EpiG1T {
    static constexpr bool PERM = true, AFTER_DRAIN = false, MID = false;
    bf16_t* VT; bf16_t* ZHT; const float* b_in; float* statsV; static constexpr int SLOT_FLOATS = 256;
    __device__ __forceinline__ void mid(f32x4 (&)[2][2][4][2], const Unit&, int, int, int, int) const {}
    __device__ __forceinline__ void preload(PG8_LAS float* slot, const Unit& u, int tid) const { if (tid < 256) slot[tid] = b_in[1024 + u.pm * 256 + tid]; }
    __device__ __forceinline__ void operator()(const f32x4 (&acc)[2][2][4][2], const Unit& u, int wr, int wc, int fr, int fq, const PG8_LAS float* slot) const {
        const int col0 = u.pn * BM + wc * 64 + 8 * fq; const bool isv = u.pm < 4;
        const int rowt = (isv ? u.pm : u.pm - 4) * BM + wr * 64 + fr;
        bf16_t* base = isv ? VT : ZHT;
#pragma unroll
        for (int ai = 0; ai < 2; ++ai) {
            float s[2][8], q[2][8];
#pragma unroll
            for (int bj = 0; bj < 2; ++bj)
#pragma unroll
                for (int e = 0; e < 8; ++e) { s[bj][e] = 0.f; q[bj][e] = 0.f; }
#pragma unroll
            for (int m = 0; m < 4; ++m) {
                const int row = rowt + ai * HALF + m * 16; const float bb = slot[wr * 64 + fr + ai * HALF + m * 16];
                bf16_t* rowp = base + (size_t)row * MTOK + col0;
#pragma unroll
                for (int bj = 0; bj < 2; ++bj) {
                    f32x4 v0 = acc[ai][bj][m][0] + bb, v1 = acc[ai][bj][m][1] + bb;
                    if (isv) {
                        f32x2 a = gelu_pk((f32x2){v0[0], v0[1]}), b = gelu_pk((f32x2){v0[2], v0[3]}), c = gelu_pk((f32x2){v1[0], v1[1]}), d = gelu_pk((f32x2){v1[2], v1[3]});
                        v0 = (f32x4){a.x, a.y, b.x, b.y}; v1 = (f32x4){c.x, c.y, d.x, d.y};
                    }
                    u32x4 w; w.x = cvt_pk_bf16(v0[0], v0[1]); w.y = cvt_pk_bf16(v0[2], v0[3]); w.z = cvt_pk_bf16(v1[0], v1[1]); w.w = cvt_pk_bf16(v1[2], v1[3]);
                    *(u32x4*)(rowp + bj * 32) = w;
                    if (isv) {
                        const float e0 = bf_lo(w.x), e1 = bf_hi(w.x), e2 = bf_lo(w.y), e3 = bf_hi(w.y), e4 = bf_lo(w.z), e5 = bf_hi(w.z), e6 = bf_lo(w.w), e7 = bf_hi(w.w);
                        s[bj][0] += e0; s[bj][1] += e1; s[bj][2] += e2; s[bj][3] += e3; s[bj][4] += e4; s[bj][5] += e5; s[bj][6] += e6; s[bj][7] += e7;
                        q[bj][0] += e0 * e0; q[bj][1] += e1 * e1; q[bj][2] += e2 * e2; q[bj][3] += e3 * e3; q[bj][4] += e4 * e4; q[bj][5] += e5 * e5; q[bj][6] += e6 * e6; q[bj][7] += e7 * e7;
                    }
                }
            }
            if (isv) {
                const int slot = u.pm * 4 + ai * 2 + wr;
#pragma unroll
                for (int bj = 0; bj < 2; ++bj)
#pragma unroll
                    for (int e = 0; e < 8; ++e) {
                        float a = s[bj][e], b = q[bj][e];
                        a += __shfl_xor(a, 1); b += __shfl_xor(b, 1); a += __shfl_xor(a, 2); b += __shfl_xor(b, 2);
                        a += __shfl_xor(a, 4); b += __shfl_xor(b, 4); a += __shfl_xor(a, 8); b += __shfl_xor(b, 8);
                        if (fr == 0) *(f32x2*)(statsV + ((size_t)(col0 + bj * 32 + e) * 16 + slot) * 2) = (f32x2){a, b};
                    }
            }
        }
    }
};

struct EpiG2 {
    static constexpr bool PERM = true, AFTER_DRAIN = false, MID = true;
    const bf16_t* G; bf16_t* O; static constexpr int SLOT_FLOATS = 0;
    __device__ __forceinline__ void preload(PG8_LAS float*, const Unit&, int) const {}
    __device__ __forceinline__ void mid(f32x4 (&acc)[2][2][4][2], const Unit& u, int wr, int wc, int fr, int fq) const {
        int row0 = u.pm * BM + wr * 64 + fr, col0 = u.pn * BM + wc * 64 + 8 * fq;
        asm volatile("" : "+v"(row0), "+v"(col0));
#pragma unroll
        for (int ai = 0; ai < 2; ++ai)
#pragma unroll
            for (int m = 0; m < 4; ++m) {
                const bf16_t* gp = G + (size_t)(row0 + ai * HALF + m * 16) * (2 * DM) + col0;
#pragma unroll
                for (int bj = 0; bj < 2; ++bj) {
                    const u32x4 ga = *(const u32x4*)(gp + bj * 32), gb = *(const u32x4*)(gp + DM + bj * 32);
                    f32x4 r0, r1;
                    r0[0] = bf_lo(ga.x) * __builtin_amdgcn_rcpf(bf_lo(gb.x)); r0[1] = bf_hi(ga.x) * __builtin_amdgcn_rcpf(bf_hi(gb.x));
                    r0[2] = bf_lo(ga.y) * __builtin_amdgcn_rcpf(bf_lo(gb.y)); r0[3] = bf_hi(ga.y) * __builtin_amdgcn_rcpf(bf_hi(gb.y));
                    r1[0] = bf_lo(ga.z) * __builtin_amdgcn_rcpf(bf_lo(gb.z)); r1[1] = bf_hi(ga.z) * __builtin_amdgcn_rcpf(bf_hi(gb.z));
                    r1[2] = bf_lo(ga.w) * __builtin_amdgcn_rcpf(bf_lo(gb.w)); r1[3] = bf_hi(ga.w) * __builtin_amdgcn_rcpf(bf_hi(gb.w));
                    acc[ai][bj][m][0] *= r0; acc[ai][bj][m][1] *= r1;
                }
            }
    }
    __device__ __forceinline__ void operator()(const f32x4 (&acc)[2][2][4][2], const Unit& u, int wr, int wc, int fr, int fq, const PG8_LAS float*) const {
        const int row0 = u.pm * BM + wr * 64 + fr, col0 = u.pn * BM + wc * 64 + 8 * fq;
#pragma unroll
        for (int ai = 0; ai < 2; ++ai)
#pragma unroll
            for (int m = 0; m < 4; ++m) {
                const int row = row0 + ai * HALF + m * 16;
                const bf16_t* gp = G + (size_t)row * (2 * DM) + DM + col0;
                bf16_t* op = O + (size_t)row * DM + col0;
#pragma unroll
                for (int bj = 0; bj < 2; ++bj) {
                    const u32x4 gb = *(const u32x4*)(gp + bj * 32);
                    const f32x4 a0 = acc[ai][bj][m][0], a1 = acc[ai][bj][m][1];
                    u32x4 w; w.x = cvt_pk_bf16(a0[0] * bf_lo(gb.x), a0[1] * bf_hi(gb.x)); w.y = cvt_pk_bf16(a0[2] * bf_lo(gb.y), a0[3] * bf_hi(gb.y));
                    w.z = cvt_pk_bf16(a1[0] * bf_lo(gb.z), a1[1] * bf_hi(gb.z)); w.w = cvt_pk_bf16(a1[2] * bf_lo(gb.w), a1[3] * bf_hi(gb.w));
                    *(u32x4*)(op + bj * 32) = w;
                }
            }
    }
};

typedef _Float16 f16x4 __attribute__((ext_vector_type(4)));
__device__ __forceinline__ f16x4 to_f16x4(f32x4 v) { return (f16x4){(_Float16)v[0], (_Float16)v[1], (_Float16)v[2], (_Float16)v[3]}; }
__device__ __forceinline__ f32x4 from_f16x4(f16x4 v) { return (f32x4){(float)v[0], (float)v[1], (float)v[2], (float)v[3]}; }
template <bool FIRST> struct EpiRes {
    static constexpr bool PERM = false, AFTER_DRAIN = false, MID = false; static constexpr int SLOT_FLOATS = FIRST ? 512 : 1024;
    const float* X;
    const _Float16* R16;
    _Float16* O16;
    const float* gate;
    const float* bias;
    const float* lng; const float* lnb; const float* MU;
    float* stats;
    __device__ __forceinline__ void mid(f32x4 (&)[2][2][4][2], const Unit&, int, int, int, int) const {}
    __device__ __forceinline__ void preload(PG8_LAS float* slot, const Unit& u, int tid) const {
        const int c = tid & 255, col = u.pn * BM + c;
        if (tid < 256) slot[c] = gate[(size_t)(u.pm >> 3) * MODW + col]; else slot[256 + c] = bias[col];
        if (!FIRST) { if (tid < 256) slot[512 + c] = DN_ALPHA * lng[col]; else slot[768 + c] = DN_ALPHA * lnb[col]; }
    }
    __device__ __forceinline__ void operator()(const f32x4 (&acc)[2][2][4][2], const Unit& u, int wr, int wc, int fr, int fq, const PG8_LAS float* slot) const {
        int row0 = u.pm * BM + wr * 64 + fr; const int cl = wc * 32 + 4 * fq; int col0 = u.pn * BM + cl;
        asm volatile("" : "+v"(row0), "+v"(col0));
        constexpr int RB = FIRST ? 2 : 1;
#pragma unroll
        for (int ab = 0; ab < 8 / RB; ++ab) {
            const int ai = (ab * RB) >> 2, mb = (ab * RB) & 3;
            f32x4 base[RB][2][2]; f16x4 b16[RB][2][2]; f32x2 mr[RB];
            int rowb = row0 + ai * HALF + mb * 16; asm volatile("" : "+v"(rowb));
#pragma unroll
            for (int mm = 0; mm < RB; ++mm) {
                const size_t off = (size_t)(rowb + mm * 16) * DM + col0;
                if (!FIRST) mr[mm] = *(const f32x2*)(MU + (size_t)(rowb + mm * 16) * 2);
#pragma unroll
                for (int bj = 0; bj < 2; ++bj)
#pragma unroll
                    for (int n = 0; n < 2; ++n) { if (FIRST) base[mm][bj][n] = *(const f32x4*)(X + off + bj * HALF + n * 16); else b16[mm][bj][n] = *(const f16x4*)(R16 + off + bj * HALF + n * 16); }
            }
#pragma unroll
            for (int mm = 0; mm < RB; ++mm) {
                const int m = mb + mm;
                const int row = rowb + mm * 16; _Float16* rp = O16 + (size_t)row * DM + col0;
                float s = 0.f, q = 0.f;
#pragma unroll
                for (int bj = 0; bj < 2; ++bj)
#pragma unroll
                    for (int n = 0; n < 2; ++n) {
                        const int co = bj * HALF + n * 16;
                        const f32x4 gv = *(const PG8_LAS f32x4*)(slot + cl + co), bv = *(const PG8_LAS f32x4*)(slot + 256 + cl + co);
                        f32x4 bs;
                        if (FIRST) bs = base[mm][bj][n] * DN_ALPHA;
                        else bs = (from_f16x4(b16[mm][bj][n]) - mr[mm].x) * mr[mm].y * *(const PG8_LAS f32x4*)(slot + 512 + cl + co) + *(const PG8_LAS f32x4*)(slot + 768 + cl + co);
                        const f16x4 oh = to_f16x4(bs + gv * (acc[ai][bj][m][n] + bv));
                        *(f16x4*)(rp + co) = oh;
                        const f32x4 o = from_f16x4(oh);
                        s += (o[0] + o[1]) + (o[2] + o[3]); q += (o[0] * o[0] + o[1] * o[1]) + (o[2] * o[2] + o[3] * o[3]);
                    }
                s += __shfl_xor(s, 16); s += __shfl_xor(s, 32); q += __shfl_xor(q, 16); q += __shfl_xor(q, 32);
                if (fq == 0) *(f32x2*)(stats + ((size_t)row * 32 + u.pn * 4 + wc) * 2) = (f32x2){s, q};
            }
            asm volatile("" ::: "memory");
        }
    }
};

struct EpiG4 {
    static constexpr bool PERM = true, AFTER_DRAIN = false, MID = false; static constexpr int SLOT_FLOATS = 256;
    bf16_t* O; const float* bias;
    __device__ __forceinline__ void mid(f32x4 (&)[2][2][4][2], const Unit&, int, int, int, int) const {}
    __device__ __forceinline__ void preload(PG8_LAS float* slot, const Unit& u, int tid) const { if (tid < 256) slot[tid] = bias[u.pn * BM + tid]; }
    __device__ __forceinline__ void operator()(const f32x4 (&acc)[2][2][4][2], const Unit& u, int wr, int wc, int fr, int fq, const PG8_LAS float* slot) const {
        const int row0 = u.pm * BM + wr * 64 + fr, cl = wc * 64 + 8 * fq, col0 = u.pn * BM + cl;
        f32x4 bv[2][2];
#pragma unroll
        for (int bj = 0; bj < 2; ++bj)
#pragma unroll
            for (int n = 0; n < 2; ++n) bv[bj][n] = *(const PG8_LAS f32x4*)(slot + cl + bj * 32 + 4 * n);
#pragma unroll
        for (int ai = 0; ai < 2; ++ai)
#pragma unroll
            for (int m = 0; m < 4; ++m) {
                bf16_t* rowp = O + (size_t)(row0 + ai * HALF + m * 16) * DFF + col0;
#pragma unroll
                for (int bj = 0; bj < 2; ++bj) {
                    f32x4 v0 = acc[ai][bj][m][0] + bv[bj][0], v1 = acc[ai][bj][m][1] + bv[bj][1];
                    v0 = __builtin_elementwise_max(v0, (f32x4){0.f, 0.f, 0.f, 0.f}); v1 = __builtin_elementwise_max(v1, (f32x4){0.f, 0.f, 0.f, 0.f});
                    v0 = v0 * v0; v1 = v1 * v1;
                    u32x4 w; w.x = cvt_pk_bf16(v0[0], v0[1]); w.y = cvt_pk_bf16(v0[2], v0[3]); w.z = cvt_pk_bf16(v1[0], v1[1]); w.w = cvt_pk_bf16(v1[2], v1[3]);
                    *(u32x4*)(rowp + bj * 32) = w;
                }
            }
    }
};
}
namespace pg8 {
template <class Epi, class Sched, bool ALIGN_EPI = false, bool SP2 = false>
__device__ __forceinline__ void gemm_phase(PG8_LAS unsigned char* lds, const Gemm g, const Sched& S, const Epi& E) {
    const int tid = threadIdx.x, wid = __builtin_amdgcn_readfirstlane(tid >> 6), lane = tid & 63, wr = wid >> 2, wc = wid & 3, fr = lane & 15, fq = lane >> 4;
    const int K = g.K, nt = K / BK;
    unsigned voffA[2], voffB[2];
#pragma unroll
    for (int i = 0; i < 2; ++i) { int R, C; stage_rc(tid * 16 + i * 8192, R, C); const int Rb = Epi::PERM ? ((R & ~31) + perm32(R & 31)) : R;
        const int Rw = Epi::PERM ? ((R >> 5) * 64 + perm32(R & 31)) : R;
        voffA[i] = (unsigned)(R * K + C) * 2u; voffB[i] = (unsigned)(Rw * K + C) * 2u; (void)Rb; }
    const size_t kstep = (size_t)(BK * 2);
    const size_t hstep = (size_t)HALF * K * 2;
    const size_t tstep = 2 * hstep;
    const size_t hstepB = Epi::PERM ? (size_t)32 * K * 2 : hstep;
    const unsigned ldsw = (unsigned)wid * 1024u;
    const int aoff = lds_byte(wr * 64 + fr, fq * 8), boff = lds_byte(wc * 32 + fr, fq * 8);
#define PG8_SA(b, h) (((b) * 2 + (h)) * HTB)
#define PG8_SB(b, h) ((4 + (b) * 2 + (h)) * HTB)
#define PG8_STAGE(bufoff, gbase, voff) do { _Pragma("unroll") for (int _i = 0; _i < 2; ++_i) \
        __builtin_amdgcn_global_load_lds((const unsigned*)((const char*)(gbase) + (voff)[_i]), (PG8_LAS unsigned*)(lds + (bufoff) + ldsw + _i * 8192), 16, 0, 0); } while (0)
#define PG8_LDA(dst, b, h) do { _Pragma("unroll") for (int m = 0; m < 4; ++m) _Pragma("unroll") for (int k = 0; k < 2; ++k) dst[m][k] = *(const PG8_LAS bf16x8*)(lds + PG8_SA(b, h) + aoff + m * 2048 + k * 1024); } while (0)
#define PG8_LDB(dst, b, h) do { _Pragma("unroll") for (int n = 0; n < 2; ++n) _Pragma("unroll") for (int k = 0; k < 2; ++k) dst[n][k] = *(const PG8_LAS bf16x8*)(lds + PG8_SB(b, h) + boff + n * 2048 + k * 1024); } while (0)
#define PG8_MMA(ai, bj, At, Bt) do { __builtin_amdgcn_s_setprio(1); _Pragma("unroll") for (int m = 0; m < 4; ++m) _Pragma("unroll") for (int n = 0; n < 2; ++n) _Pragma("unroll") for (int k = 0; k < 2; ++k) \
        acc[ai][bj][m][n] = __builtin_amdgcn_mfma_f32_16x16x32_bf16(Bt[n][k], At[m][k], acc[ai][bj][m][n], 0, 0, 0); __builtin_amdgcn_s_setprio(0); } while (0)
#define PG8_WAIT_V(n) asm volatile("s_waitcnt vmcnt(" #n ")" ::: "memory")
#define PG8_WAIT_L(n) asm volatile("s_waitcnt lgkmcnt(" #n ")" ::: "memory")
#define PG8_BAR __builtin_amdgcn_s_barrier()
#define PG8_SCHED __builtin_amdgcn_sched_barrier(0)
    Unit cur, nxt; int ui = 0;
    if (!S.next(0, cur)) return;
    {
        Unit pu; for (int i = 0; S.next(i, pu); ++i) E.preload((PG8_LAS float*)(lds + EPI_LDS_OFF) + i * Epi::SLOT_FLOATS, pu, tid);
        asm volatile("s_waitcnt vmcnt(0) lgkmcnt(0)" ::: "memory"); __builtin_amdgcn_s_barrier(); asm volatile("" ::: "memory");
    }
    f32x4 acc[2][2][4][2];
#pragma unroll
    for (int a = 0; a < 2; ++a)
#pragma unroll
        for (int b = 0; b < 2; ++b)
#pragma unroll
            for (int m = 0; m < 4; ++m)
#pragma unroll
                for (int n = 0; n < 2; ++n) acc[a][b][m][n] = (f32x4){0.f, 0.f, 0.f, 0.f};
    bf16x8 At[4][2], B0[2][2], B1[2][2];
    const char* cA = (const char*)g.A + (size_t)cur.pm * tstep; const char* cB = (const char*)g.Bt + (size_t)cur.pn * tstep;
    S.a_ready(cur);
    if constexpr (SP2) {
        PG8_STAGE(PG8_SB(0, 0), cB, voffB); PG8_STAGE(PG8_SB(0, 1), cB + hstepB, voffB); PG8_STAGE(PG8_SA(0, 0), cA, voffA); PG8_STAGE(PG8_SA(0, 1), cA + hstep, voffA);
        if (wr == 1) PG8_BAR;
        PG8_WAIT_V(2); PG8_BAR;
        PG8_STAGE(PG8_SB(1, 0), cB + kstep, voffB); PG8_STAGE(PG8_SA(1, 0), cA + kstep, voffA); PG8_STAGE(PG8_SB(1, 1), cB + hstepB + kstep, voffB);
        PG8_WAIT_V(6); PG8_BAR;
    } else {
        PG8_STAGE(PG8_SB(0, 0), cB, voffB); PG8_STAGE(PG8_SA(0, 0), cA, voffA); PG8_STAGE(PG8_SB(0, 1), cB + hstepB, voffB); PG8_STAGE(PG8_SA(0, 1), cA + hstep, voffA);
        if (wr == 1) PG8_BAR;
        PG8_WAIT_V(4); PG8_BAR;
        PG8_STAGE(PG8_SB(1, 0), cB + kstep, voffB); PG8_STAGE(PG8_SA(1, 0), cA + kstep, voffA); PG8_STAGE(PG8_SB(1, 1), cB + hstepB + kstep, voffB);
        PG8_WAIT_V(6); PG8_BAR;
    }
    for (;;) {
        const bool has_next = S.next(ui + 1, nxt);
        const char* nA = has_next ? (const char*)g.A + (size_t)nxt.pm * tstep : cA; const char* nB = has_next ? (const char*)g.Bt + (size_t)nxt.pn * tstep : cB;
        for (int t = 0; t < nt; t += 2) {
            const bool last = (t == nt - 2);
            const char* a1 = cA + (size_t)(t + 1) * kstep;
            const char* a2 = last ? nA : cA + (size_t)(t + 2) * kstep; const char* b2 = last ? nB : cB + (size_t)(t + 2) * kstep;
            const char* a3 = a2 + kstep; const char* b3 = b2 + kstep;
            if (last && has_next) S.a_ready(nxt);
            if constexpr (Epi::MID) { if (t == (nt >> 1)) E.mid(acc, cur, wr, wc, fr, fq); }
            if constexpr (SP2) {
            PG8_LDB(B0, 0, 0); PG8_LDB(B1, 0, 1); PG8_SCHED; PG8_LDA(At, 0, 0); PG8_STAGE(PG8_SA(1, 1), a1 + hstep, voffA);
            PG8_WAIT_V(8); PG8_WAIT_L(0); PG8_BAR; PG8_MMA(0, 0, At, B0); PG8_MMA(0, 1, At, B1); PG8_BAR; PG8_SCHED;
            PG8_LDA(At, 0, 1); PG8_STAGE(PG8_SB(0, 0), b2, voffB); PG8_STAGE(PG8_SB(0, 1), b2 + hstepB, voffB); PG8_STAGE(PG8_SA(0, 0), a2, voffA);
            PG8_WAIT_V(8); PG8_WAIT_L(0); PG8_BAR; PG8_MMA(1, 0, At, B0); PG8_MMA(1, 1, At, B1); PG8_BAR; PG8_SCHED;
            PG8_LDB(B0, 1, 0); PG8_LDB(B1, 1, 1); PG8_SCHED; PG8_LDA(At, 1, 0); PG8_STAGE(PG8_SA(0, 1), a2 + hstep, voffA);
            PG8_WAIT_V(8); PG8_WAIT_L(0); PG8_BAR; PG8_MMA(0, 0, At, B0); PG8_MMA(0, 1, At, B1); PG8_BAR; PG8_SCHED;
            PG8_LDA(At, 1, 1); PG8_STAGE(PG8_SB(1, 0), b3, voffB); PG8_STAGE(PG8_SB(1, 1), b3 + hstepB, voffB); PG8_STAGE(PG8_SA(1, 0), a3, voffA);
            PG8_WAIT_V(8); PG8_WAIT_L(0); PG8_BAR; PG8_MMA(1, 0, At, B0); PG8_MMA(1, 1, At, B1); PG8_BAR; PG8_SCHED;
            } else {
            PG8_LDB(B0, 0, 0); PG8_SCHED; PG8_LDA(At, 0, 0); PG8_STAGE(PG8_SA(1, 1), a1 + hstep, voffA);
            PG8_WAIT_L(8); PG8_BAR; PG8_WAIT_L(0); PG8_MMA(0, 0, At, B0); PG8_BAR; PG8_SCHED;
            PG8_LDB(B1, 0, 1); PG8_STAGE(PG8_SB(0, 0), b2, voffB);
            PG8_BAR; PG8_WAIT_L(0); PG8_MMA(0, 1, At, B1); PG8_BAR;
            PG8_LDA(At, 0, 1); PG8_STAGE(PG8_SA(0, 0), a2, voffA);
            PG8_BAR; PG8_WAIT_L(0); PG8_MMA(1, 0, At, B0); PG8_BAR; PG8_SCHED;
            PG8_STAGE(PG8_SB(0, 1), b2 + hstepB, voffB);
            PG8_WAIT_V(6); PG8_BAR; PG8_MMA(1, 1, At, B1); PG8_BAR;
            PG8_LDB(B0, 1, 0); PG8_SCHED; PG8_LDA(At, 1, 0); PG8_STAGE(PG8_SA(0, 1), a2 + hstep, voffA);
            PG8_WAIT_L(8); PG8_BAR; PG8_WAIT_L(0); PG8_MMA(0, 0, At, B0); PG8_BAR; PG8_SCHED;
            PG8_LDB(B1, 1, 1); PG8_STAGE(PG8_SB(1, 0), b3, voffB);
            PG8_BAR; PG8_WAIT_L(0); PG8_MMA(0, 1, At, B1); PG8_BAR;
            PG8_LDA(At, 1, 1); PG8_STAGE(PG8_SA(1, 0), a3, voffA);
            PG8_BAR; PG8_WAIT_L(0); PG8_MMA(1, 0, At, B0); PG8_BAR; PG8_SCHED;
            PG8_STAGE(PG8_SB(1, 1), b3 + hstepB, voffB);
            PG8_WAIT_V(6); PG8_BAR; PG8_MMA(1, 1, At, B1); PG8_BAR;
            }
        }
        if constexpr (ALIGN_EPI) { if (wr == 0) PG8_BAR; }
        if constexpr (!Epi::AFTER_DRAIN) { E(acc, cur, wr, wc, fr, fq, (const PG8_LAS float*)(lds + EPI_LDS_OFF) + ui * Epi::SLOT_FLOATS); S.done(cur); }
        if (!has_next) break;
#pragma unroll
        for (int a = 0; a < 2; ++a)
#pragma unroll
            for (int b = 0; b < 2; ++b)
#pragma unroll
                for (int m = 0; m < 4; ++m)
#pragma unroll
                    for (int n = 0; n < 2; ++n) acc[a][b][m][n] = (f32x4){0.f, 0.f, 0.f, 0.f};
        cur = nxt; cA = nA; cB = nB; ++ui;
        if constexpr (ALIGN_EPI) { if (wr == 1) PG8_BAR; }
    }
    PG8_WAIT_V(0);
    if constexpr (!ALIGN_EPI) { if (wr == 0) PG8_BAR; }
    PG8_BAR;
    if constexpr (Epi::AFTER_DRAIN) { E.fused(acc, cur, wr, wc, fr, fq, lds, wid, lane); S.done(cur); }
#undef PG8_SA
#undef PG8_SB
#undef PG8_STAGE
#undef PG8_LDA
#undef PG8_LDB
#undef PG8_MMA
#undef PG8_WAIT_V
#undef PG8_WAIT_L
#undef PG8_BAR
#undef PG8_SCHED
}
}

constexpr size_t MiB = 1u << 20;
constexpr size_t WS_CTL = 0;
constexpr size_t WS_MOD = 1 * MiB;
constexpr size_t WS_STV = 2 * MiB;
constexpr size_t WS_ST1 = 4 * MiB;
constexpr size_t WS_ST2 = 8 * MiB;
constexpr size_t WS_MU1 = 12 * MiB;
constexpr size_t WS_HID2 = 14 * MiB;
constexpr size_t WS_SGW = 13 * MiB;
constexpr size_t WS_WIN = 16 * MiB;
constexpr size_t WS_WAB = 52 * MiB;
constexpr size_t WS_WO = 60 * MiB;
constexpr size_t WS_FILT = 68 * MiB;
constexpr size_t WS_WM2 = 68 * MiB;
constexpr size_t WS_H = 100 * MiB;
constexpr size_t WS_U = 164 * MiB;
constexpr size_t WS_V = 196 * MiB;
constexpr size_t WS_MERGED = 164 * MiB;
constexpr size_t WS_ZHT = 228 * MiB;
constexpr size_t WS_G = 324 * MiB;
constexpr size_t WS_AFF = 164 * MiB;
constexpr size_t WS_WM1 = 420 * MiB;
constexpr size_t WS_YT = 452 * MiB;
constexpr size_t WS_END = 484 * MiB;

constexpr int NWAVES = 8;
constexpr int LDS_BYTES = 163840;

#define GAS __attribute__((address_space(1)))
#define LAS __attribute__((address_space(3)))
typedef unsigned short bf16;
typedef unsigned v4u __attribute__((ext_vector_type(4)));
typedef unsigned v2u __attribute__((ext_vector_type(2)));
typedef float f32x4 __attribute__((ext_vector_type(4)));
typedef float f32x2 __attribute__((ext_vector_type(2)));
#define LDS_WAIT() asm volatile("s_waitcnt lgkmcnt(0)" ::: "memory")

__device__ __forceinline__ unsigned f2bf(float f) { unsigned u = __builtin_bit_cast(unsigned, f); return (u + 0x7fffu + ((u >> 16) & 1u)) >> 16; }
__device__ __forceinline__ unsigned pk2(float lo, float hi) { return f2bf(lo) | (f2bf(hi) << 16); }
__device__ __forceinline__ float bflo(unsigned w) { return __uint_as_float(w << 16); }
__device__ __forceinline__ float bfhi(unsigned w) { return __uint_as_float(w & 0xffff0000u); }
__device__ __forceinline__ float bf1(bf16 h) { return __uint_as_float((unsigned)h << 16); }
__device__ __forceinline__ float wave_sum(float v) {
#pragma unroll
    for (int o = 1; o < 64; o <<= 1) v += __shfl_xor(v, o);
    return v;
}

struct Args { const float* in[31]; float* out; unsigned char* ws; int ph_lo, ph_hi; };

struct Frame {
    LAS unsigned char* lds;
    int tid, lane, wave, G;
    const float* const* in; float* out; unsigned char* ws;
};
enum { I_X = 0, I_C, I_WADA, I_BADA, I_WIN, I_BIN, I_SLNG, I_SLNB, I_SW, I_SB, I_HCW, I_HCB, I_HW1, I_HB1, I_HW2, I_HB2, I_HFREQ, I_HW3, I_HSKIP,
       I_WA, I_WB, I_WO, I_BO, I_LN1G, I_LN1B, I_WM1, I_BM1, I_WM2, I_BM2, I_LN2G, I_LN2B };

__device__ __forceinline__ void transpose_matrix(Frame& F, const float* W, int K, int N, bf16* WT, int ldk, int koff, int remap_win, int first, int nblocks) {
    LAS float* tile = (LAS float*)F.lds;
    const int tid = F.tid, nblk = N / 256, nitems = (K / 64) * nblk;
    const int lr = tid >> 6, lc = tid & 63;
    const int wc = tid & 7, wn = tid >> 3;
    for (int it = first; it < nitems; it += nblocks) {
        const int kb = it / nblk, nb = it % nblk, n0 = nb * 256, k0 = kb * 64; int row0 = n0;
        if (remap_win) row0 = (n0 < 1024) ? n0 : (n0 < 2048 ? n0 - 1024 + 5120 : (n0 < 5120 ? n0 - 2048 + 6144 : n0 - 5120 + 1024));
        f32x4 v[8];
#pragma unroll
        for (int i = 0; i < 8; ++i) v[i] = *(const f32x4*)(W + (size_t)(k0 + 8 * i + lr) * N + n0 + 4 * lc);
#pragma unroll
        for (int i = 0; i < 8; ++i) *(LAS f32x4*)(tile + (8 * i + lr) * 256 + ((lc ^ i) << 2)) = v[i];
        __syncthreads();
#pragma unroll
        for (int j = 0; j < 4; ++j) { const int n = wn + 64 * j; const LAS float* sp = tile + (8 * wc) * 256 + ((((n >> 2) ^ wc) << 2) | (n & 3));
            v4u o; o.x = pk2(sp[0 * 256], sp[1 * 256]); o.y = pk2(sp[2 * 256], sp[3 * 256]); o.z = pk2(sp[4 * 256], sp[5 * 256]); o.w = pk2(sp[6 * 256], sp[7 * 256]);
            *(GAS v4u*)(WT + (size_t)(row0 + n) * ldk + koff + k0 + 8 * wc) = o; }
        __syncthreads();
    }
}

__device__ __forceinline__ void p0_mod(Frame& F) {
    LAS float* condS = (LAS float*)F.lds;
    LAS float* red = (LAS float*)(F.lds + 65536);
    const float* c = F.in[I_C]; const float* w_ada = F.in[I_WADA]; const float* b_ada = F.in[I_BADA];
    float* mod = (float*)(F.ws + WS_MOD);
    const int tid = F.tid;
    for (int item = blockIdx.x; item < MODW / 48; item += F.G) {
        for (int i = tid; i < NBATCH * DM; i += NWAVES * 64) { const float v = c[i]; condS[i] = v / (1.0f + __expf(-v)); }
        __syncthreads();
        const int cq = tid % 12, kq = tid / 12, col0 = item * 48;
        if (kq < 32) {
            f32x4 acc[8];
#pragma unroll
            for (int b = 0; b < 8; ++b) acc[b] = (f32x4){0.f, 0.f, 0.f, 0.f};
            const float* wp = w_ada + (size_t)kq * MODW + col0 + cq * 4;
            for (int k = kq; k < DM; k += 256, wp += (size_t)256 * MODW) {
                f32x4 w[8];
#pragma unroll
                for (int u = 0; u < 8; ++u) w[u] = *(const f32x4*)(wp + (size_t)(32 * u) * MODW);
#pragma unroll
                for (int u = 0; u < 8; ++u)
#pragma unroll
                    for (int b = 0; b < 8; ++b) acc[b] += w[u] * condS[b * DM + k + 32 * u];
            }
#pragma unroll
            for (int b = 0; b < 8; ++b) *(LAS f32x4*)(red + (kq * 8 + b) * 48 + cq * 4) = acc[b];
        }
        __syncthreads();
        if (tid < 384) { const int b = tid / 48, col = tid % 48; float s = 0.f;
#pragma unroll 8
          for (int k2 = 0; k2 < 32; ++k2) s += red[(k2 * 8 + b) * 48 + col];
          mod[(size_t)b * MODW + col0 + col] = s + b_ada[col0 + col]; }
        __syncthreads();
    }
}

__device__ __forceinline__ void p0_hid2(Frame& F) {
    LAS float* scr = (LAS float*)F.lds + F.wave * 128;
    const float* w1 = F.in[I_HW1]; const float* b1 = F.in[I_HB1]; const float* w2 = F.in[I_HW2]; const float* b2 = F.in[I_HB2]; const float* freq = F.in[I_HFREQ];
    float* HID2 = (float*)(F.ws + WS_HID2);
    const int lane = F.lane;
    for (int l = blockIdx.x * NWAVES + F.wave; l < SEQ; l += F.G * NWAVES) {
        const float fr = freq[lane];
        const float tl = (float)l / (float)(SEQ - 1), omega = 6.283185307179586f * (float)l / (float)SEQ;
        float f = 0.f;
        if (lane == 0) f = tl;
        else if (lane <= 16) { const float band = 1e-4f + (float)(lane - 1) * ((15.0f - 1e-4f) / 15.0f); f = cosf(band * omega); }
        else if (lane <= 32) { const float band = 1e-4f + (float)(lane - 17) * ((15.0f - 1e-4f) / 15.0f); f = -sinf(band * omega); }
        scr[lane] = f; LDS_WAIT(); asm volatile("" ::: "memory");
        float a = b1[lane];
#pragma unroll 11
        for (int i = 0; i < 33; ++i) a += scr[i] * w1[i * 64 + lane];
        scr[64 + lane] = sinf(fr * a); LDS_WAIT(); asm volatile("" ::: "memory");
        a = b2[lane];
#pragma unroll 16
        for (int i = 0; i < 64; ++i) a += scr[64 + i] * w2[i * 64 + lane];
        HID2[(size_t)l * 64 + lane] = sinf(fr * a);
        LDS_WAIT(); asm volatile("" ::: "memory");
    }
}
typedef float fl_f32x16 __attribute__((ext_vector_type(16)));
__device__ __forceinline__ void p1_filter_waves(Frame& F) {
    const int fwl = F.wave - 4;
    LAS float* hS = (LAS float*)F.lds + fwl * (32 * 65);
    const float* w3 = F.in[I_HW3]; const float* HID2 = (const float*)(F.ws + WS_HID2);
    float* FILT = (float*)(F.ws + WS_FILT);
    const int lane = F.lane, r = lane & 31, h = lane >> 5;
    const float min_decay = -3.0701134573253943f, max_decay = -15.350567286626972f;
    for (int item = blockIdx.x * 4 + fwl; item < 1024; item += F.G * 4) {
        const int pb = item >> 4, cb = item & 15, pos0 = pb * 32, col0 = cb * 256;
        {
#pragma unroll
            for (int u = 0; u < 8; ++u) { const int e = (u * 64 + lane) * 4, p = e >> 6, k = e & 63; const f32x4 v = *(const f32x4*)(HID2 + (size_t)(pos0 + p) * 64 + k);
                hS[p * 65 + k] = v[0]; hS[p * 65 + k + 1] = v[1]; hS[p * 65 + k + 2] = v[2]; hS[p * 65 + k + 3] = v[3]; }
            LDS_WAIT(); asm volatile("" ::: "memory");
        }
        fl_f32x16 acc[8];
#pragma unroll
        for (int t = 0; t < 8; ++t)
#pragma unroll
            for (int e = 0; e < 16; ++e) acc[t][e] = 0.f;
        const float* wp = w3 + (size_t)h * 4096 + col0 + r;
#pragma unroll 2
        for (int s2 = 0; s2 < 32; ++s2) {
            const float a = hS[r * 65 + 2 * s2 + h];
            float b[8];
#pragma unroll
            for (int t = 0; t < 8; ++t) b[t] = wp[(size_t)(2 * s2) * 4096 + t * 32];
#pragma unroll
            for (int t = 0; t < 8; ++t) acc[t] = __builtin_amdgcn_mfma_f32_32x32x2f32(a, b[t], acc[t], 0, 0, 0);
        }
#pragma unroll
        for (int t = 0; t < 8; ++t) {
            const int j = col0 + t * 32 + r, ch = j & 1023; const float delta = fabsf(min_decay + (float)ch * ((max_decay - min_decay) / 1023.0f));
            float* op = FILT + (size_t)j * SEQ + pos0 + 4 * h;
#pragma unroll
            for (int g = 0; g < 4; ++g) {
                f32x4 o;
#pragma unroll
                for (int e = 0; e < 4; ++e) { const float tp = (float)(pos0 + 8 * g + 4 * h + e) / (float)(SEQ - 1); o[e] = acc[t][4 * g + e] * __expf(-tp * delta); }
                *(f32x4*)(op + 8 * g) = o;
            }
        }
        LDS_WAIT(); asm volatile("" ::: "memory");
    }
}

__device__ __forceinline__ void p1_modulate(Frame& F) {
    const float* x = F.in[I_X]; const float* mod = (const float*)(F.ws + WS_MOD); bf16* H = (bf16*)(F.ws + WS_H);
    const size_t nvec = (size_t)MTOK * DM / 8, stride = (size_t)F.G * 256;
    for (size_t i0 = (size_t)blockIdx.x * 256 + F.tid; i0 < nvec; i0 += 4 * stride) {
        f32x4 xa[4], xb[4];
#pragma unroll
        for (int u = 0; u < 4; ++u) { const size_t i = i0 + u * stride; if (i < nvec) { const float* xp = x + i * 8; xa[u] = *(const f32x4*)xp; xb[u] = *(const f32x4*)(xp + 4); } }
#pragma unroll
        for (int u = 0; u < 4; ++u) { const size_t i = i0 + u * stride; if (i < nvec) {
            const int row = (int)(i >> 8), col = (int)(i & 255) * 8, b = row >> 11;
            const float* mp = mod + (size_t)b * MODW + col;
            const f32x4 sh0 = *(const f32x4*)mp, sh1 = *(const f32x4*)(mp + 4), sc0 = *(const f32x4*)(mp + DM), sc1 = *(const f32x4*)(mp + DM + 4);
            const f32x4 h0 = xa[u] * (sc0 + 1.0f) + sh0, h1 = xb[u] * (sc1 + 1.0f) + sh1;
            v4u o; o.x = pk2(h0[0], h0[1]); o.y = pk2(h0[2], h0[3]); o.z = pk2(h1[0], h1[1]); o.w = pk2(h1[2], h1[3]);
            *(v4u*)(H + i * 8) = o; } }
    }
}

typedef short sg_bf16x8 __attribute__((ext_vector_type(8)));
typedef float sg_f32x16 __attribute__((ext_vector_type(16)));
constexpr int SG_VT = 0, SG_LD = 136, SG_ST = 36864;
__device__ __forceinline__ void p3_sgu(Frame& F) {
    LAS bf16* vnT = (LAS bf16*)(F.lds + SG_VT); LAS float* stS = (LAS float*)(F.lds + SG_ST);
    const bf16* U = (const bf16*)(F.ws + WS_U); const bf16* VT = (const bf16*)(F.ws + WS_V); bf16* AB = (bf16*)(F.ws + WS_H);
    const bf16* Wb = (const bf16*)(F.ws + WS_SGW); const float* stv = (const float*)(F.ws + WS_STV);
    const float* lng = F.in[I_SLNG]; const float* lnb = F.in[I_SLNB]; const float* sb = F.in[I_SB];
    const int tid = F.tid, lane = F.lane, w = F.wave, r = lane & 31, h = lane >> 5;
    for (int item = blockIdx.x; item < 1024; item += F.G) {
        const int b = item >> 7, n = (item >> 3) & 15, g = item & 7, tok0 = b * SEQ + n * 128;
        if (tid < 128) { float s = 0.f, q = 0.f; const float* sp = stv + (size_t)(tok0 + tid) * 32;
#pragma unroll
            for (int i = 0; i < 16; ++i) { const f32x2 pr = *(const f32x2*)(sp + 2 * i); s += pr.x; q += pr.y; }
            const float mean = s * (1.0f / 1024.0f); float var = q * (1.0f / 1024.0f) - mean * mean; var = var > 0.f ? var : 0.f;
            *(LAS f32x2*)(stS + 2 * tid) = (f32x2){mean, 1.0f / sqrtf(var + LN_EPS)}; }
        __syncthreads();
        { const int c = tid >> 2, pseg = (tid & 3) * 32, ch = g * 128 + c; const float gg = lng[ch], bb = lnb[ch];
          const bf16* vp = VT + (size_t)ch * MTOK + tok0 + pseg;
          v4u wv[4];
#pragma unroll
          for (int k = 0; k < 4; ++k) wv[k] = *(const v4u*)(vp + 8 * k);
#pragma unroll
          for (int k = 0; k < 4; ++k) {
              const float e[8] = {bflo(wv[k].x), bfhi(wv[k].x), bflo(wv[k].y), bfhi(wv[k].y), bflo(wv[k].z), bfhi(wv[k].z), bflo(wv[k].w), bfhi(wv[k].w)};
              float o[8];
#pragma unroll
              for (int i = 0; i < 8; i += 2) { const f32x4 st = *(const LAS f32x4*)(stS + 2 * (pseg + 8 * k + i));
                  o[i] = (e[i] - st[0]) * st[1] * gg + bb; o[i + 1] = (e[i + 1] - st[2]) * st[3] * gg + bb; }
              v4u pk; pk.x = pk2(o[0], o[1]); pk.y = pk2(o[2], o[3]); pk.z = pk2(o[4], o[5]); pk.w = pk2(o[6], o[7]);
              *(LAS v4u*)(vnT + c * SG_LD + pseg + 8 * k) = pk; } }
        const int q0 = 32 * (w >> 1), ct0 = 2 * (w & 1);
        sg_bf16x8 af[8];
#pragma unroll
        for (int kk = 0; kk < 8; ++kk) af[kk] = *(const sg_bf16x8*)(Wb + (size_t)(g * 128 + q0 + r) * 128 + 16 * kk + 8 * h);
        __syncthreads();
        sg_f32x16 acc[2];
#pragma unroll
        for (int ct = 0; ct < 2; ++ct)
#pragma unroll
            for (int i = 0; i < 16; ++i) acc[ct][i] = 0.f;
#pragma unroll
        for (int kk = 0; kk < 8; ++kk)
#pragma unroll
            for (int ct = 0; ct < 2; ++ct) {
                const sg_bf16x8 bf = *(const LAS sg_bf16x8*)(vnT + ((ct0 + ct) * 32 + r) * SG_LD + 16 * kk + 8 * h);
                acc[ct] = __builtin_amdgcn_mfma_f32_32x32x16_bf16(af[kk], bf, acc[ct], 0, 0, 0);
            }
#pragma unroll
        for (int ct = 0; ct < 2; ++ct) {
            const int c = (ct0 + ct) * 32 + r;
#pragma unroll
            for (int rg = 0; rg < 16; ++rg) {
                const int q = q0 + (rg & 3) + 8 * (rg >> 2) + 4 * h;
                const float uv = bf1(U[(size_t)(tok0 + q) * SGUW + g * 128 + c]);
                AB[(size_t)(tok0 + q) * DM + g * 128 + c] = (bf16)f2bf(uv * (acc[ct][rg] + sb[g * 128 + q]));
            }
        }
        __syncthreads();
    }
}

__device__ __forceinline__ float sconv(const bf16* ZHT, const float* cw, const float* cb, int ch, int b, int t) {
    const bf16* zp = ZHT + (size_t)ch * MTOK + b * SEQ;
    const float z0 = t > 0 ? bf1(zp[t - 1]) : 0.f, z1 = bf1(zp[t]), z2 = t < SEQ - 1 ? bf1(zp[t + 1]) : 0.f;
    return cw[ch] * z0 + cw[3072 + ch] * z1 + cw[6144 + ch] * z2 + cb[ch];
}
__device__ __forceinline__ void p3_hyena(Frame& F) {
    LAS float* Us = (LAS float*)F.lds;
    LAS float* KF = (LAS float*)(F.lds + 65536);
    const bf16* ZHT = (const bf16*)(F.ws + WS_ZHT); const float* FILT = (const float*)(F.ws + WS_FILT); bf16* AB = (bf16*)(F.ws + WS_H);
    const float* cw = F.in[I_HCW]; const float* cb = F.in[I_HCB]; const float* skip = F.in[I_HSKIP];
    const int tid = F.tid;
    for (int item = blockIdx.x; item < HYW; item += F.G) {
        const int c = item;
        for (int i = tid; i < NBATCH * SEQ; i += NWAVES * 64) { const int b = i >> 11, t = i & 2047; Us[t * 8 + b] = sconv(ZHT, cw, cb, c, b, t); }
        for (int n = 0; n < 2; ++n) {
            const float* hf = FILT + (size_t)((0 * 2 + n) * 1024 + c) * SEQ; const float* hb = FILT + (size_t)((1 * 2 + n) * 1024 + c) * SEQ;
            for (int i = tid; i < 4095; i += NWAVES * 64) { const int lag = i - 2047; KF[i] = lag > 0 ? hf[lag] : (lag == 0 ? hf[0] + hb[0] : hb[-lag]); }
            __syncthreads();
            f32x4 acc[4][2];
#pragma unroll
            for (int ti = 0; ti < 4; ++ti) { acc[ti][0] = (f32x4){0.f, 0.f, 0.f, 0.f}; acc[ti][1] = (f32x4){0.f, 0.f, 0.f, 0.f}; }
            const LAS float* kp = KF + tid + 2047;
            for (int s = 0; s < SEQ; ++s) {
                const f32x4 u0 = *(const LAS f32x4*)(Us + s * 8), u1 = *(const LAS f32x4*)(Us + s * 8 + 4);
#pragma unroll
                for (int ti = 0; ti < 4; ++ti) { const float kv = kp[512 * ti - s]; acc[ti][0] += u0 * kv; acc[ti][1] += u1 * kv; }
            }
            __syncthreads();
            const float sk = skip[n * 1024 + c];
#pragma unroll
            for (int ti = 0; ti < 4; ++ti) { const int t = tid + 512 * ti;
#pragma unroll
                for (int b = 0; b < 8; ++b) {
                    const float uv = Us[t * 8 + b], gate = sconv(ZHT, cw, cb, (n + 1) * 1024 + c, b, t);
                    const float y = gate * (acc[ti][b >> 2][b & 3] + sk * uv);
                    if (n == 0) Us[t * 8 + b] = y; else AB[(size_t)(b * SEQ + t) * DM + 1024 + c] = (bf16)f2bf(y);
                } }
            __syncthreads();
        }
    }
}

#ifndef HYFFT_HD
#define HYFFT_HD __device__ __forceinline__
#define HYFFT_LAS __attribute__((address_space(3)))
#endif
typedef float hy_c32 __attribute__((ext_vector_type(2)));
HYFFT_HD int hy_padi(int i) { return i + (i >> 3); }
HYFFT_HD int hy_rev(int x) { return ((x & 7) << 9) | (((x >> 3) & 7) << 6) | (((x >> 6) & 7) << 3) | ((x >> 9) & 7); }

template <bool INV> HYFFT_HD void hy_dft8(float (&re)[8], float (&im)[8]) {
    const float h = 0.70710678118654752f;
    float ar[4], ai[4], br[4], bi[4];
#pragma unroll
    for (int m = 0; m < 4; ++m) { ar[m] = re[m] + re[m + 4]; ai[m] = im[m] + im[m + 4]; br[m] = re[m] - re[m + 4]; bi[m] = im[m] - im[m + 4]; }
    { float x = br[1], y = bi[1]; if (!INV) { br[1] = h * (x + y); bi[1] = h * (y - x); } else { br[1] = h * (x - y); bi[1] = h * (y + x); } }
    { float x = br[2], y = bi[2]; if (!INV) { br[2] = y; bi[2] = -x; } else { br[2] = -y; bi[2] = x; } }
    { float x = br[3], y = bi[3]; if (!INV) { br[3] = h * (y - x); bi[3] = -h * (x + y); } else { br[3] = -h * (x + y); bi[3] = h * (x - y); } }
#pragma unroll
    for (int s = 0; s < 2; ++s) {
        float* cr = s ? br : ar; float* ci = s ? bi : ai;
        const float e0r = cr[0] + cr[2], e0i = ci[0] + ci[2], e1r = cr[0] - cr[2], e1i = ci[0] - ci[2];
        const float o0r = cr[1] + cr[3], o0i = ci[1] + ci[3]; const float dr = cr[1] - cr[3], di = ci[1] - ci[3];
        float o1r, o1i; if (!INV) { o1r = di; o1i = -dr; } else { o1r = -di; o1i = dr; }
        re[0 + s] = e0r + o0r; im[0 + s] = e0i + o0i;
        re[2 + s] = e1r + o1r; im[2 + s] = e1i + o1i;
        re[4 + s] = e0r - o0r; im[4 + s] = e0i - o0i;
        re[6 + s] = e1r - o1r; im[6 + s] = e1i - o1i;
    }
}
template <bool CONJ> HYFFT_HD void hy_twiddle(float (&re)[8], float (&im)[8], float wr, float wi) {
    if (CONJ) wi = -wi;
    const float w2r = wr * wr - wi * wi, w2i = 2.f * wr * wi;
    const float w3r = w2r * wr - w2i * wi, w3i = w2r * wi + w2i * wr;
    const float w4r = w2r * w2r - w2i * w2i, w4i = 2.f * w2r * w2i;
    const float w5r = w4r * wr - w4i * wi, w5i = w4r * wi + w4i * wr;
    const float w6r = w3r * w3r - w3i * w3i, w6i = 2.f * w3r * w3i;
    const float w7r = w4r * w3r - w4i * w3i, w7i = w4r * w3i + w4i * w3r;
    const float pr[8] = {1.f, wr, w2r, w3r, w4r, w5r, w6r, w7r}, pi[8] = {0.f, wi, w2i, w3i, w4i, w5i, w6i, w7i};
#pragma unroll
    for (int k = 1; k < 8; ++k) { const float x = re[k], y = im[k]; re[k] = x * pr[k] - y * pi[k]; im[k] = x * pi[k] + y * pr[k]; }
}
template <int L, class BP, class TP> HYFFT_HD void hy_fwd_store(BP buf, TP tw, int j, float (&re)[8], float (&im)[8]) {
    constexpr int S = L / 8; const int blk = j / S, q = j % S, base = blk * L + q;
    hy_dft8<false>(re, im);
    if (L > 8) { const hy_c32 w = tw[q * (4096 / L)]; hy_twiddle<false>(re, im, w.x, w.y); }
#pragma unroll
    for (int k = 0; k < 8; ++k) buf[hy_padi(base + k * S)] = (hy_c32){re[k], im[k]};
}
template <int L, class BP> HYFFT_HD void hy_load8(BP buf, int j, float (&re)[8], float (&im)[8]) {
    constexpr int S = L / 8; const int blk = j / S, q = j % S, base = blk * L + q;
#pragma unroll
    for (int k = 0; k < 8; ++k) { const hy_c32 v = buf[hy_padi(base + k * S)]; re[k] = v.x; im[k] = v.y; }
}
template <int L, class BP, class TP> HYFFT_HD void hy_fwd_stage(BP buf, TP tw, int j) { float re[8], im[8]; hy_load8<L>(buf, j, re, im); hy_fwd_store<L>(buf, tw, j, re, im); }
template <int L, class BP, class TP> HYFFT_HD void hy_inv_regs(BP buf, TP tw, int j, float (&re)[8], float (&im)[8]) {
    constexpr int S = L / 8; const int q = j % S;
    hy_load8<L>(buf, j, re, im);
    if (L > 8) { const hy_c32 w = tw[q * (4096 / L)]; hy_twiddle<true>(re, im, w.x, w.y); }
    hy_dft8<true>(re, im);
}
template <int L, class BP, class TP> HYFFT_HD void hy_inv_stage(BP buf, TP tw, int j) {
    constexpr int S = L / 8; const int blk = j / S, q = j % S, base = blk * L + q;
    float re[8], im[8]; hy_inv_regs<L>(buf, tw, j, re, im);
#pragma unroll
    for (int k = 0; k < 8; ++k) buf[hy_padi(base + k * S)] = (hy_c32){re[k], im[k]};
}
template <class BP, class KP> HYFFT_HD void hy_mid_stage(BP buf, KP K, int j) {
    float re[8], im[8]; hy_load8<8>(buf, j, re, im);
    hy_dft8<false>(re, im);
#pragma unroll
    for (int k = 0; k < 8; ++k) { const hy_c32 kv = K[hy_padi(8 * j + k)]; const float x = re[k], y = im[k]; re[k] = x * kv.x - y * kv.y; im[k] = x * kv.y + y * kv.x; }
    hy_dft8<true>(re, im);
#pragma unroll
    for (int k = 0; k < 8; ++k) buf[hy_padi(8 * j + k)] = (hy_c32){re[k], im[k]};
}
template <class BP> HYFFT_HD void hy_last_fwd(BP buf, int j) {
    float re[8], im[8]; hy_load8<8>(buf, j, re, im); hy_dft8<false>(re, im);
#pragma unroll
    for (int k = 0; k < 8; ++k) buf[hy_padi(8 * j + k)] = (hy_c32){re[k], im[k]};
}
template <class BP, class KP> HYFFT_HD void hy_separate(BP Z, KP K1, KP K2, int j) {
    const float sc = 0.5f / 4096.0f;
#pragma unroll
    for (int r = 0; r < 8; ++r) {
        const int p = j + 512 * r, f = hy_rev(p), g = (4096 - f) & 4095, p2 = hy_rev(g);
        const hy_c32 a = Z[hy_padi(p)], b = Z[hy_padi(p2)];
        K1[hy_padi(p)] = (hy_c32){(a.x + b.x) * sc, (a.y - b.y) * sc};
        K2[hy_padi(p)] = (hy_c32){(a.y + b.y) * sc, (b.x - a.x) * sc};
    }
}

struct Raw3 { bf16 a, b, c; };
__device__ __forceinline__ Raw3 raw3(const bf16* zp, int t) { Raw3 r; r.a = zp[t > 0 ? t - 1 : 0]; r.b = zp[t]; r.c = zp[t < SEQ - 1 ? t + 1 : SEQ - 1]; return r; }
__device__ __forceinline__ float sconv_raw(const Raw3& r, int t, float w0, float w1, float w2, float cb) {
    const float z0 = t > 0 ? bf1(r.a) : 0.f, z1 = bf1(r.b), z2 = t < SEQ - 1 ? bf1(r.c) : 0.f;
    return w0 * z0 + w1 * z1 + w2 * z2 + cb;
}
HYFFT_HD int hy16_padi(int i) { return i + (i >> 4); }
HYFFT_HD int hy16_rev(int x) { return ((x & 15) << 8) | (x & 0xF0) | ((x >> 8) & 15); }
template <bool INV> HYFFT_HD void hy16_dft4(float& r0, float& i0, float& r1, float& i1, float& r2, float& i2, float& r3, float& i3) {
    const float e0r = r0 + r2, e0i = i0 + i2, e1r = r0 - r2, e1i = i0 - i2, o0r = r1 + r3, o0i = i1 + i3, dr = r1 - r3, di = i1 - i3;
    float o1r, o1i; if (!INV) { o1r = di; o1i = -dr; } else { o1r = -di; o1i = dr; }
    r0 = e0r + o0r; i0 = e0i + o0i; r1 = e1r + o1r; i1 = e1i + o1i; r2 = e0r - o0r; i2 = e0i - o0i; r3 = e1r - o1r; i3 = e1i - o1i;
}
template <bool INV> HYFFT_HD void hy16_cmulc(float& r, float& i, float cr, float ci) { if (INV) ci = -ci; const float x = r, y = i; r = x * cr - y * ci; i = x * ci + y * cr; }
template <bool INV> HYFFT_HD void hy16_dft16(float (&re)[16], float (&im)[16]) {
    const float c1 = 0.92387953251128674f, s1 = 0.38268343236508977f, h = 0.70710678118654752f;
#pragma unroll
    for (int m2 = 0; m2 < 4; ++m2) hy16_dft4<INV>(re[m2], im[m2], re[4 + m2], im[4 + m2], re[8 + m2], im[8 + m2], re[12 + m2], im[12 + m2]);
    hy16_cmulc<INV>(re[4 * 1 + 1], im[4 * 1 + 1], c1, -s1);
    hy16_cmulc<INV>(re[4 * 2 + 1], im[4 * 2 + 1], h, -h);
    hy16_cmulc<INV>(re[4 * 3 + 1], im[4 * 3 + 1], s1, -c1);
    hy16_cmulc<INV>(re[4 * 1 + 2], im[4 * 1 + 2], h, -h);
    hy16_cmulc<INV>(re[4 * 2 + 2], im[4 * 2 + 2], 0.f, -1.f);
    hy16_cmulc<INV>(re[4 * 3 + 2], im[4 * 3 + 2], -h, -h);
    hy16_cmulc<INV>(re[4 * 1 + 3], im[4 * 1 + 3], s1, -c1);
    hy16_cmulc<INV>(re[4 * 2 + 3], im[4 * 2 + 3], -h, -h);
    hy16_cmulc<INV>(re[4 * 3 + 3], im[4 * 3 + 3], -c1, s1);
#pragma unroll
    for (int k1 = 0; k1 < 4; ++k1) hy16_dft4<INV>(re[4 * k1], im[4 * k1], re[4 * k1 + 1], im[4 * k1 + 1], re[4 * k1 + 2], im[4 * k1 + 2], re[4 * k1 + 3], im[4 * k1 + 3]);
#pragma unroll
    for (int a = 0; a < 4; ++a)
#pragma unroll
        for (int b = a + 1; b < 4; ++b) { float t = re[4 * a + b]; re[4 * a + b] = re[4 * b + a]; re[4 * b + a] = t; t = im[4 * a + b]; im[4 * a + b] = im[4 * b + a]; im[4 * b + a] = t; }
}
template <bool CONJ> HYFFT_HD void hy16_twiddle(float (&re)[16], float (&im)[16], float wr, float wi) {
    if (CONJ) wi = -wi;
    float pr[16], pi[16]; pr[1] = wr; pi[1] = wi;
#define HY16_SQ(d, a) pr[d] = pr[a] * pr[a] - pi[a] * pi[a]; pi[d] = 2.f * pr[a] * pi[a];
#define HY16_MUL(d, a, b) pr[d] = pr[a] * pr[b] - pi[a] * pi[b]; pi[d] = pr[a] * pi[b] + pi[a] * pr[b];
    HY16_SQ(2, 1) HY16_MUL(3, 2, 1) HY16_SQ(4, 2) HY16_MUL(5, 4, 1) HY16_SQ(6, 3) HY16_MUL(7, 4, 3) HY16_SQ(8, 4)
    HY16_MUL(9, 8, 1) HY16_SQ(10, 5) HY16_MUL(11, 8, 3) HY16_SQ(12, 6) HY16_MUL(13, 8, 5) HY16_SQ(14, 7) HY16_MUL(15, 8, 7)
#undef HY16_SQ
#undef HY16_MUL
#pragma unroll
    for (int k = 1; k < 16; ++k) { const float x = re[k], y = im[k]; re[k] = x * pr[k] - y * pi[k]; im[k] = x * pi[k] + y * pr[k]; }
}
template <int L, class BP> HYFFT_HD void hy16_load(BP buf, int jj, float (&re)[16], float (&im)[16]) {
    constexpr int S = L / 16; const int blk = jj / S, q = jj % S, pb = hy16_padi(blk * L + q);
#pragma unroll
    for (int k = 0; k < 16; ++k) { const hy_c32 v = buf[pb + k * (S + S / 16)]; re[k] = v.x; im[k] = v.y; }
}
template <class BP> HYFFT_HD void hy16_load1(BP buf, int jj, float (&re)[16], float (&im)[16]) {
#pragma unroll
    for (int k = 0; k < 16; ++k) { const hy_c32 v = buf[17 * jj + k]; re[k] = v.x; im[k] = v.y; }
}
template <int L, class BP> HYFFT_HD void hy16_store(BP buf, int jj, const float (&re)[16], const float (&im)[16]) {
    constexpr int S = L / 16; const int blk = jj / S, q = jj % S, pb = hy16_padi(blk * L + q);
#pragma unroll
    for (int k = 0; k < 16; ++k) buf[pb + k * (S + S / 16)] = (hy_c32){re[k], im[k]};
}
template <class BP> HYFFT_HD void hy16_store1(BP buf, int jj, const float (&re)[16], const float (&im)[16]) {
#pragma unroll
    for (int k = 0; k < 16; ++k) buf[17 * jj + k] = (hy_c32){re[k], im[k]};
}
template <int L, class BP, class TP> HYFFT_HD void hy16_fwd_store(BP buf, TP tw, int jj, float (&re)[16], float (&im)[16]) {
    constexpr int S = L / 16; const int q = jj % S;
    hy16_dft16<false>(re, im);
    { const hy_c32 w = tw[q * (4096 / L)]; hy16_twiddle<false>(re, im, w.x, w.y); }
    hy16_store<L>(buf, jj, re, im);
}
template <int L, class BP, class TP> HYFFT_HD void hy16_fwd_stage(BP buf, TP tw, int jj) { float re[16], im[16]; hy16_load<L>(buf, jj, re, im); hy16_fwd_store<L>(buf, tw, jj, re, im); }
template <int L, class BP, class TP> HYFFT_HD void hy16_inv_regs(BP buf, TP tw, int jj, float (&re)[16], float (&im)[16]) {
    constexpr int S = L / 16; const int q = jj % S;
    hy16_load<L>(buf, jj, re, im);
    { const hy_c32 w = tw[q * (4096 / L)]; hy16_twiddle<true>(re, im, w.x, w.y); }
    hy16_dft16<true>(re, im);
}
template <int L, class BP, class TP> HYFFT_HD void hy16_inv_stage(BP buf, TP tw, int jj) { float re[16], im[16]; hy16_inv_regs<L>(buf, tw, jj, re, im); hy16_store<L>(buf, jj, re, im); }
template <class BP, class KP> HYFFT_HD void hy16_mid_stage(BP buf, KP K, int jj) {
    float re[16], im[16]; hy16_load1(buf, jj, re, im);
    hy16_dft16<false>(re, im);
#pragma unroll
    for (int k = 0; k < 16; ++k) { const hy_c32 kv = K[17 * jj + k]; const float x = re[k], y = im[k]; re[k] = x * kv.x - y * kv.y; im[k] = x * kv.y + y * kv.x; }
    hy16_dft16<true>(re, im);
    hy16_store1(buf, jj, re, im);
}
template <class BP> HYFFT_HD void hy16_last_fwd(BP buf, int jj) { float re[16], im[16]; hy16_load1(buf, jj, re, im); hy16_dft16<false>(re, im); hy16_store1(buf, jj, re, im); }
template <class BP, class KP> HYFFT_HD void hy16_separate(BP Z, KP K1, KP K2, int t) {
    const float sc = 0.5f / 4096.0f;
#pragma unroll
    for (int r = 0; r < 8; ++r) {
        const int p = t + 512 * r, f = hy16_rev(p), g = (4096 - f) & 4095, p2 = hy16_rev(g);
        const hy_c32 a = Z[hy16_padi(p)], b = Z[hy16_padi(p2)];
        K1[hy16_padi(p)] = (hy_c32){(a.x + b.x) * sc, (a.y - b.y) * sc};
        K2[hy16_padi(p)] = (hy_c32){(a.y + b.y) * sc, (b.x - a.x) * sc};
    }
}
__device__ __forceinline__ void p3_hyena_fft(Frame& F) {
    const int tid0 = F.tid;
    const int half = __builtin_amdgcn_readfirstlane(tid0 >> 8);
    LAS hy_c32* BUF = (LAS hy_c32*)(F.lds + half * 34816);
    LAS hy_c32* B0 = (LAS hy_c32*)(F.lds + 0);
    LAS hy_c32* K1 = (LAS hy_c32*)(F.lds + 69632); LAS hy_c32* K2 = (LAS hy_c32*)(F.lds + 104448); LAS hy_c32* TW = (LAS hy_c32*)(F.lds + 139264);
    const bf16* ZHT = (const bf16*)(F.ws + WS_ZHT); const float* FILT = (const float*)(F.ws + WS_FILT); bf16* YT = (bf16*)(F.ws + WS_YT);
    const float* cw = F.in[I_HCW]; const float* cb = F.in[I_HCB]; const float* skip = F.in[I_HSKIP];
    if (tid0 < 256) { float sn, cs; sincosf(-6.283185307179586f * (float)tid0 / 4096.0f, &sn, &cs); TW[tid0] = (hy_c32){cs, sn}; }
    __syncthreads();
    for (int item = blockIdx.x; item < HYW; item += F.G) {
        const int c = item;
        int tid = tid0; asm volatile("" : "+v"(tid));
        int jj = tid & 255;
        float re[16], im[16];
        const bf16* zv = ZHT + (size_t)c * MTOK; const bf16* za = ZHT + (size_t)(1024 + c) * MTOK; const bf16* zb = ZHT + (size_t)(2048 + c) * MTOK;
        {
            if (half == 0) {
                const float* hf0 = FILT + (size_t)(0 * 1024 + c) * SEQ; const float* hf1 = FILT + (size_t)(1 * 1024 + c) * SEQ;
                const float* hb0 = FILT + (size_t)(2 * 1024 + c) * SEQ; const float* hb1 = FILT + (size_t)(3 * 1024 + c) * SEQ;
#pragma unroll
                for (int m = 0; m < 8; ++m) { const int i = jj + 256 * m; re[m] = hf0[i]; im[m] = hf1[i]; }
                if (jj == 0) { re[0] += hb0[0]; im[0] += hb1[0]; }
#pragma unroll
                for (int m = 8; m < 16; ++m) { const int i = jj + 256 * m; const bool z = (i == 2048); const int r = z ? 0 : 4096 - i; const float a = hb0[r], b = hb1[r]; re[m] = z ? 0.f : a; im[m] = z ? 0.f : b; }
                hy16_fwd_store<4096>(B0, TW, jj, re, im);
            }
            __syncthreads();
            if (half == 0) hy16_fwd_stage<256>(B0, TW, jj);
            __syncthreads();
            if (half == 0) hy16_last_fwd(B0, jj);
            __syncthreads();
            hy16_separate(B0, K1, K2, tid); __syncthreads();
        }
        const float vw0 = cw[c], vw1 = cw[3072 + c], vw2 = cw[6144 + c], vcb = cb[c];
        const float aw0 = cw[1024 + c], aw1 = cw[3072 + 1024 + c], aw2 = cw[6144 + 1024 + c], acb = cb[1024 + c];
        const float bw0 = cw[2048 + c], bw1 = cw[3072 + 2048 + c], bw2 = cw[6144 + 2048 + c], bcb = cb[2048 + c];
        const float sk0 = skip[c], sk1 = skip[1024 + c];
#pragma unroll 1
        for (int rd = 0; rd < 2; ++rd) {
            const int boff = (4 * rd + 2 * half) * SEQ;
            asm volatile("" : "+v"(jj));
            Raw3 rg[2][8];
            float v[2][8];
#pragma unroll
            for (int m = 0; m < 8; ++m) { const int t = jj + 256 * m;
                const Raw3 r0 = raw3(zv + boff, t), r1 = raw3(zv + boff + SEQ, t); v[0][m] = sconv_raw(r0, t, vw0, vw1, vw2, vcb); v[1][m] = sconv_raw(r1, t, vw0, vw1, vw2, vcb); }
#pragma unroll
            for (int m = 0; m < 8; ++m) { re[m] = v[0][m]; im[m] = v[1][m]; re[m + 8] = 0.f; im[m + 8] = 0.f; }
            hy16_fwd_store<4096>(BUF, TW, jj, re, im); __syncthreads();
            hy16_fwd_stage<256>(BUF, TW, jj); __syncthreads();
            hy16_mid_stage(BUF, K1, jj); __syncthreads();
#pragma unroll
            for (int m = 0; m < 8; ++m) { const int t = jj + 256 * m; rg[0][m] = raw3(za + boff, t); rg[1][m] = raw3(za + boff + SEQ, t); }
            hy16_inv_stage<256>(BUF, TW, jj); __syncthreads();
            hy16_inv_regs<4096>(BUF, TW, jj, re, im);
#pragma unroll
            for (int m = 0; m < 8; ++m) { const int t = jj + 256 * m;
                v[0][m] = sconv_raw(rg[0][m], t, aw0, aw1, aw2, acb) * (re[m] + sk0 * v[0][m]); v[1][m] = sconv_raw(rg[1][m], t, aw0, aw1, aw2, acb) * (im[m] + sk0 * v[1][m]); }
#pragma unroll
            for (int m = 0; m < 8; ++m) { re[m] = v[0][m]; im[m] = v[1][m]; re[m + 8] = 0.f; im[m + 8] = 0.f; }
            hy16_fwd_store<4096>(BUF, TW, jj, re, im); __syncthreads();
            hy16_fwd_stage<256>(BUF, TW, jj); __syncthreads();
            hy16_mid_stage(BUF, K2, jj); __syncthreads();
#pragma unroll
            for (int m = 0; m < 8; ++m) { const int t = jj + 256 * m; rg[0][m] = raw3(zb + boff, t); rg[1][m] = raw3(zb + boff + SEQ, t); }
            hy16_inv_stage<256>(BUF, TW, jj); __syncthreads();
            hy16_inv_regs<4096>(BUF, TW, jj, re, im);
#pragma unroll
            for (int m = 0; m < 8; ++m) { const int t = jj + 256 * m; bf16* yp = YT + (size_t)c * MTOK + boff + t;
                yp[0] = (bf16)f2bf(sconv_raw(rg[0][m], t, bw0, bw1, bw2, bcb) * (re[m] + sk1 * v[0][m]));
                yp[SEQ] = (bf16)f2bf(sconv_raw(rg[1][m], t, bw0, bw1, bw2, bcb) * (im[m] + sk1 * v[1][m])); }
        }
        __syncthreads();
    }
}

__device__ __forceinline__ void p3c_transpose(Frame& F) {
    constexpr int LD = 264;
    LAS bf16* tile = (LAS bf16*)F.lds;
    const bf16* YT = (const bf16*)(F.ws + WS_YT); bf16* AB = (bf16*)(F.ws + WS_H);
    const int tid = F.tid;
    for (int it = blockIdx.x; it < 16 * 64; it += F.G) {
        const int c0 = (it >> 6) * 64, t0 = (it & 63) * 256;
        { const int c = tid >> 3, ts = (tid & 7) * 32; const bf16* src = YT + (size_t)(c0 + c) * MTOK + t0 + ts;
          v4u w[4];
#pragma unroll
          for (int k = 0; k < 4; ++k) w[k] = *(const v4u*)(src + 8 * k);
#pragma unroll
          for (int k = 0; k < 4; ++k) *(LAS v4u*)(tile + c * LD + ts + 8 * k) = w[k]; }
        __syncthreads();
        { const int t = tid >> 1, cs = (tid & 1) * 32; unsigned o[16];
#pragma unroll
          for (int i = 0; i < 16; ++i) o[i] = (unsigned)tile[(cs + 2 * i) * LD + t] | ((unsigned)tile[(cs + 2 * i + 1) * LD + t] << 16);
          bf16* dst = AB + (size_t)(t0 + t) * DM + 1024 + c0 + cs;
#pragma unroll
          for (int k = 0; k < 4; ++k) *(v4u*)(dst + 8 * k) = (v4u){o[4 * k], o[4 * k + 1], o[4 * k + 2], o[4 * k + 3]}; }
        __syncthreads();
    }
}

typedef _Float16 ln_f16x4 __attribute__((ext_vector_type(4)));
template <bool FINAL> __device__ __forceinline__ void ln_rows(Frame& F) {
    const _Float16* R = FINAL ? (const _Float16*)(F.ws + WS_H) : (const _Float16*)F.out;
    const float* st = (const float*)(F.ws + (FINAL ? WS_ST2 : WS_ST1)); float* MU = (float*)(F.ws + WS_MU1);
    const float* mod = (const float*)(F.ws + WS_MOD); bf16* H2 = (bf16*)(F.ws + WS_H);
    const float* lng = F.in[FINAL ? I_LN2G : I_LN1G]; const float* lnb = F.in[FINAL ? I_LN2B : I_LN1B];
    const int gw = blockIdx.x * NWAVES + F.wave, NGW = F.G * NWAVES, lane = F.lane;
    ln_f16x4 cur[8], nxt[8]; f32x2 ps = (f32x2){0.f, 0.f}, pn = (f32x2){0.f, 0.f};
    int row = gw;
    if (row < MTOK) {
#pragma unroll
        for (int j = 0; j < 8; ++j) cur[j] = *(const ln_f16x4*)(R + (size_t)row * DM + 4 * lane + 256 * j);
        if (lane < 32) ps = *(const f32x2*)(st + ((size_t)row * 32 + lane) * 2);
    }
    for (; row < MTOK; row += NGW) {
        const int rn = row + NGW;
        if (rn < MTOK) {
#pragma unroll
            for (int j = 0; j < 8; ++j) nxt[j] = *(const ln_f16x4*)(R + (size_t)rn * DM + 4 * lane + 256 * j);
            pn = (f32x2){0.f, 0.f}; if (lane < 32) pn = *(const f32x2*)(st + ((size_t)rn * 32 + lane) * 2);
        }
        const float s = wave_sum(ps.x), q = wave_sum(ps.y);
        const float mean = s * (1.0f / DM); float var = q * (1.0f / DM) - mean * mean; var = var > 0.f ? var : 0.f; const float rstd = 1.0f / sqrtf(var + LN_EPS);
        if (!FINAL && lane == 0) *(f32x2*)(MU + (size_t)row * 2) = (f32x2){mean, rstd};
        const int b = row >> 11;
#pragma unroll
        for (int j = 0; j < 8; ++j) { const int col = 4 * lane + 256 * j;
            const f32x4 v = (f32x4){(float)cur[j][0], (float)cur[j][1], (float)cur[j][2], (float)cur[j][3]};
            const f32x4 y = (v - mean) * rstd * *(const f32x4*)(lng + col) + *(const f32x4*)(lnb + col);
            if (FINAL) *(f32x4*)(F.out + (size_t)row * DM + col) = y;
            else { const float* mp = mod + (size_t)b * MODW + col; const f32x4 h = y * (*(const f32x4*)(mp + 4 * DM) + 1.0f) + *(const f32x4*)(mp + 3 * DM);
                   v2u o; o.x = pk2(h[0], h[1]); o.y = pk2(h[2], h[3]); *(v2u*)(H2 + (size_t)row * DM + col) = o; } }
#pragma unroll
        for (int j = 0; j < 8; ++j) cur[j] = nxt[j];
        ps = pn;
    }
}

typedef GAS unsigned gu32;
#define RLX_AGENT __ATOMIC_RELAXED, __HIP_MEMORY_SCOPE_AGENT
constexpr int LDSCTL_OFF = 163840 - 512, MISC_OFF = LDSCTL_OFF;
constexpr int CW_BAR = 4096;
constexpr size_t CTL_ZERO_BYTES = 65536;
#define XB_TMO      128
#define XB_XCNT(j)  (256  + 64 * (j))
#define XB_XSUB(j)  (1280 + 64 * (j))
#define XB_XGEN(j)  (2304 + 64 * (j))
#define XB_TOP      3328
#define XB_TOPGEN   3392
#define XCD_BAR_WORDS 3456
#define XB_SPIN_CAP (1u << 18)

__device__ __forceinline__ unsigned xb_ld(unsigned* p)              { return __hip_atomic_load(p, __ATOMIC_RELAXED, __HIP_MEMORY_SCOPE_AGENT); }
__device__ __forceinline__ unsigned xb_add(unsigned* p, unsigned v) { return __hip_atomic_fetch_add(p, v, __ATOMIC_RELAXED, __HIP_MEMORY_SCOPE_AGENT); }
__device__ __forceinline__ unsigned xb_xcc_id() { return (unsigned)__builtin_amdgcn_s_getreg((3 << 11) | 20) & 0xFu; }
#define XB_SPIN(cond, bar) do { unsigned _sp = 0; while (cond) { __builtin_amdgcn_s_sleep(1); \
    if ((++_sp & 255u) == 0u) { if (xb_ld(&(bar)[XB_TMO])) break; if (_sp > XB_SPIN_CAP) { atomicAdd(&(bar)[XB_TMO], 1u); break; } } } } while (0)

struct XcdBarrier {
    unsigned* bar; unsigned x;
    volatile LAS unsigned* st;
};

__device__ __forceinline__ XcdBarrier xcd_barrier_post(unsigned* bar, volatile LAS unsigned* st) {
    XcdBarrier b; b.bar = bar; b.x = xb_xcc_id(); b.st = st;
    if (threadIdx.x == 0) (void)xb_add(&bar[XB_XCNT(b.x)], 1u);
    return b;
}
__device__ __forceinline__ void xcd_barrier_complete(unsigned* bar, unsigned x, unsigned& nloc, unsigned& nx) {
    const unsigned G = gridDim.x * gridDim.y * gridDim.z;
    unsigned sum, cnt, mine, sp = 0u;
    for (;;) {
        sum = 0u; cnt = 0u; mine = 0u;
#pragma unroll
        for (unsigned j = 0; j < 16; ++j) { const unsigned c = xb_ld(&bar[XB_XCNT(j)]); sum += c; cnt += (c > 0u) ? 1u : 0u; mine = (j == x) ? c : mine; }
        if (sum == G) break;
        __builtin_amdgcn_s_sleep(1);
        if ((++sp & 255u) == 0u) { if (xb_ld(&bar[XB_TMO])) break; if (sp > XB_SPIN_CAP) { atomicAdd(&bar[XB_TMO], 1u); break; } }
    }
    nloc = mine > 0u ? mine : 1u; nx = cnt > 0u ? cnt : 1u;
}

__device__ __forceinline__ void xcd_barrier(const XcdBarrier& b) {
    asm volatile("s_waitcnt vmcnt(0)" ::: "memory");
    __syncthreads();
    if (threadIdx.x == 0) {
        unsigned* bar = b.bar;
        __builtin_amdgcn_s_waitcnt(0);
        unsigned nloc = b.st[0], nx = b.st[1];
        if (nloc == 0u) { xcd_barrier_complete(bar, b.x, nloc, nx); b.st[0] = nloc; b.st[1] = nx; }
        const unsigned old = xb_add(&bar[XB_XSUB(b.x)], 1u);
        const unsigned gen = old / nloc;
        if (old + 1u == (gen + 1u) * nloc) {
            __builtin_amdgcn_fence(__ATOMIC_RELEASE, "agent");
            asm volatile("s_waitcnt vmcnt(0)" ::: "memory");
            const unsigned og = xb_add(&bar[XB_TOP], 1u);
            const unsigned tg = og / nx;
            if (og + 1u == (tg + 1u) * nx) xb_add(&bar[XB_TOPGEN], 1u);
            else XB_SPIN(xb_ld(&bar[XB_TOPGEN]) == tg, bar);
            __builtin_amdgcn_fence(__ATOMIC_ACQUIRE, "agent");
            xb_add(&bar[XB_XGEN(b.x)], 1u);
            asm volatile("s_waitcnt vmcnt(0)" ::: "memory");
        } else {
            XB_SPIN(xb_ld(&bar[XB_XGEN(b.x)]) == gen, bar);
            __builtin_amdgcn_fence(__ATOMIC_ACQUIRE, "agent");
            asm volatile("s_waitcnt vmcnt(0)" ::: "memory");
        }
    }
    __syncthreads();
}

#define GRID_SYNC() xcd_barrier(bar)

__global__ void __launch_bounds__(NWAVES * 64, 2) fwd_megakernel(Args args) {
    extern __shared__ __attribute__((aligned(16))) unsigned char lds[];
    Frame F;
    F.lds = (LAS unsigned char*)lds;
    F.tid = threadIdx.x; F.lane = F.tid & 63; F.wave = __builtin_amdgcn_readfirstlane(F.tid >> 6); F.G = gridDim.x;
    F.in = args.in; F.out = args.out; F.ws = args.ws;
    for (int u = F.tid; u < (LDS_BYTES - LDSCTL_OFF) / 4; u += NWAVES * 64) ((LAS unsigned*)(F.lds + LDSCTL_OFF))[u] = 0u;
    __syncthreads();
    XcdBarrier bar = xcd_barrier_post((unsigned*)(args.ws + WS_CTL) + CW_BAR, (volatile LAS unsigned*)(F.lds + MISC_OFF) + 8);
    unsigned char* ws = args.ws;
    const int lo = args.ph_lo, hi = args.ph_hi;
#define IN(k) (lo <= (k) && (k) < hi)
#define BOTH(k) (IN(k) && IN((k) + 1))
    const int gw = blockIdx.x * NWAVES + F.wave, NGW = F.G * NWAVES;

    PB_START(1, F.lds);
    if (IN(0)) { { int t_ = threadIdx.x; asm volatile("" : "+v"(t_)); F.tid = t_; F.lane = t_ & 63; }
        PB_START(21, F.lds); p0_mod(F); PB_END(21, F.lds);
        PB_START(22, F.lds);
        transpose_matrix(F, F.in[I_WIN], DM, INW, (bf16*)(ws + WS_WIN), DM, 0, 1, (int)blockIdx.x, F.G);
        transpose_matrix(F, F.in[I_WA], SGUW, DM, (bf16*)(ws + WS_WAB), DM, 0, 0, (int)((blockIdx.x + 128) % F.G), F.G);
        transpose_matrix(F, F.in[I_WB], HYW, DM, (bf16*)(ws + WS_WAB), DM, 1024, 0, (int)blockIdx.x, F.G);
        transpose_matrix(F, F.in[I_WO], DM, DM, (bf16*)(ws + WS_WO), DM, 0, 0, (int)blockIdx.x, F.G);
        { const float* sw = F.in[I_SW]; bf16* sgw = (bf16*)(ws + WS_SGW);
          for (int i = blockIdx.x * (NWAVES * 64) + F.tid; i < 8 * 128 * 128 / 2; i += F.G * NWAVES * 64) { const f32x2 v = *(const f32x2*)(sw + 2 * i); *(unsigned*)(sgw + 2 * i) = pk2(v.x, v.y); } }
        __syncthreads();
        __syncthreads(); p0_hid2(F);
        PB_END(22, F.lds);
        if (BOTH(0)) GRID_SYNC();
    }
    PB_END(1, F.lds);
    PB_START(2, F.lds);
    if (IN(1)) { { int t_ = threadIdx.x; asm volatile("" : "+v"(t_)); F.tid = t_; F.lane = t_ & 63; } if (F.wave < 4) p1_modulate(F); else p1_filter_waves(F); if (BOTH(1)) GRID_SYNC(); }
    PB_END(2, F.lds);
    PB_START(3, F.lds);
    if (IN(2)) { { int t_ = threadIdx.x; asm volatile("" : "+v"(t_)); F.tid = t_; F.lane = t_ & 63; }
        { pg8::Gemm g{(const pg8::bf16_t*)(ws + WS_H), (const pg8::bf16_t*)(ws + WS_WIN), MTOK, 5120, DM}; pg8::StaticOrder S; S.init(MTOK, 5120, F.G, (int)blockIdx.x);
          pg8::EpiG1 E{(pg8::bf16_t*)(ws + WS_U), (pg8::bf16_t*)(ws + WS_G), F.in[I_BIN]};
          pg8::gemm_phase<pg8::EpiG1, pg8::StaticOrder, true, true>(F.lds, g, S, E); }
        __syncthreads();
        { pg8::Gemm g{(const pg8::bf16_t*)(ws + WS_WIN) + (size_t)5120 * DM, (const pg8::bf16_t*)(ws + WS_H), 4096, MTOK, DM}; pg8::StaticOrder S; S.init(4096, MTOK, F.G, (int)blockIdx.x);
          pg8::EpiG1T E{(pg8::bf16_t*)(ws + WS_V), (pg8::bf16_t*)(ws + WS_ZHT), F.in[I_BIN], (float*)(ws + WS_STV)};
          pg8::gemm_phase<pg8::EpiG1T, pg8::StaticOrder, true, true>(F.lds, g, S, E); }
        if (BOTH(2)) GRID_SYNC();
    }
    PB_END(3, F.lds);
    PB_START(4, F.lds);
    if (IN(3)) { { int t_ = threadIdx.x; asm volatile("" : "+v"(t_)); F.tid = t_; F.lane = t_ & 63; } __syncthreads(); PB_START(41, F.lds); p3_sgu(F); PB_END(41, F.lds); PB_START(42, F.lds); p3_hyena_fft(F); PB_END(42, F.lds); if (BOTH(3)) GRID_SYNC(); PB_START(43, F.lds); p3c_transpose(F); GRID_SYNC(); PB_END(43, F.lds); }
    PB_END(4, F.lds);
    PB_START(5, F.lds);
    if (IN(4)) { { int t_ = threadIdx.x; asm volatile("" : "+v"(t_)); F.tid = t_; F.lane = t_ & 63; }
        pg8::Gemm g{(const pg8::bf16_t*)(ws + WS_H), (const pg8::bf16_t*)(ws + WS_WAB), MTOK, DM, DM}; pg8::StaticOrder S; S.init(MTOK, DM, F.G, (int)blockIdx.x);
        pg8::EpiG2 E{(const pg8::bf16_t*)(ws + WS_G), (pg8::bf16_t*)(ws + WS_MERGED)};
        pg8::gemm_phase<pg8::EpiG2, pg8::StaticOrder, true, true>(F.lds, g, S, E);
        if (BOTH(4)) GRID_SYNC();
    }
    PB_END(5, F.lds);
    PB_START(6, F.lds);
    if (IN(5)) { { int t_ = threadIdx.x; asm volatile("" : "+v"(t_)); F.tid = t_; F.lane = t_ & 63; }
        pg8::Gemm g{(const pg8::bf16_t*)(ws + WS_MERGED), (const pg8::bf16_t*)(ws + WS_WO), MTOK, DM, DM}; pg8::StaticOrder S; S.init(MTOK, DM, F.G, (int)blockIdx.x);
        pg8::EpiRes<true> E{F.in[I_X], nullptr, (_Float16*)F.out, (const float*)(ws + WS_MOD) + 2 * DM, F.in[I_BO], nullptr, nullptr, nullptr, (float*)(ws + WS_ST1)};
        pg8::gemm_phase<pg8::EpiRes<true>, pg8::StaticOrder, true, true>(F.lds, g, S, E);
        if (BOTH(5)) GRID_SYNC();
    }
    PB_END(6, F.lds);
    PB_START(7, F.lds);
    if (IN(6)) { { int t_ = threadIdx.x; asm volatile("" : "+v"(t_)); F.tid = t_; F.lane = t_ & 63; }
        __syncthreads();
        ln_rows<false>(F);
        __syncthreads();
        transpose_matrix(F, F.in[I_WM1], DM, DFF, (bf16*)(ws + WS_WM1), DM, 0, 0, (int)blockIdx.x, F.G);
        transpose_matrix(F, F.in[I_WM2], DFF, DM, (bf16*)(ws + WS_WM2), DFF, 0, 0, (int)blockIdx.x, F.G);
        if (BOTH(6)) GRID_SYNC();
    }
    PB_END(7, F.lds);
    PB_START(8, F.lds);
    if (IN(7)) { { int t_ = threadIdx.x; asm volatile("" : "+v"(t_)); F.tid = t_; F.lane = t_ & 63; }
        __syncthreads();
        pg8::Gemm g{(const pg8::bf16_t*)(ws + WS_H), (const pg8::bf16_t*)(ws + WS_WM1), MTOK, DFF, DM}; pg8::StaticOrder S; S.init(MTOK, DFF, F.G, (int)blockIdx.x);
        pg8::EpiG4 E{(pg8::bf16_t*)(ws + WS_AFF), F.in[I_BM1]};
        pg8::gemm_phase<pg8::EpiG4, pg8::StaticOrder, true, true>(F.lds, g, S, E);
        if (BOTH(7)) GRID_SYNC();
    }
    PB_END(8, F.lds);
    PB_START(9, F.lds);
    if (IN(8)) { { int t_ = threadIdx.x; asm volatile("" : "+v"(t_)); F.tid = t_; F.lane = t_ & 63; }
        pg8::Gemm g{(const pg8::bf16_t*)(ws + WS_AFF), (const pg8::bf16_t*)(ws + WS_WM2), MTOK, DM, DFF}; pg8::StaticOrder S; S.init(MTOK, DM, F.G, (int)blockIdx.x);
        pg8::EpiRes<false> E{nullptr, (const _Float16*)F.out, (_Float16*)(ws + WS_H), (const float*)(ws + WS_MOD) + 5 * DM, F.in[I_BM2], F.in[I_LN1G], F.in[I_LN1B], (const float*)(ws + WS_MU1), (float*)(ws + WS_ST2)};
        pg8::gemm_phase<pg8::EpiRes<false>, pg8::StaticOrder, true, true>(F.lds, g, S, E);
        if (BOTH(8)) GRID_SYNC();
    }
    PB_END(9, F.lds);
    PB_START(10, F.lds);
    if (IN(9)) { { int t_ = threadIdx.x; asm volatile("" : "+v"(t_)); F.tid = t_; F.lane = t_ & 63; } ln_rows<true>(F); }
    PB_END(10, F.lds);
    if (PROBE_ID != 0 && blockIdx.x == 0 && threadIdx.x == 0) { const unsigned long long wait_ = *(volatile LAS unsigned long long*)(F.lds + PB_LDS_OFF), t0_ = __builtin_amdgcn_s_memrealtime();
        while (__builtin_amdgcn_s_memrealtime() - t0_ < wait_) __builtin_amdgcn_s_sleep(8); }
#undef IN
#undef BOTH
}

constexpr int N_PHASES = 10;
#ifndef MK_N_LAUNCHES
#define MK_N_LAUNCHES 1
#endif
extern "C" void kernel_launch(void* const* d_in, const int* in_sizes, int n_in, void* d_out, int out_size, void* d_ws, size_t ws_size, hipStream_t stream) {
    static int grid = 0;
    if (grid == 0) {
        if (n_in != 31 || in_sizes[0] != MTOK * DM || out_size != MTOK * DM || ws_size < WS_END) {
            fprintf(stderr, "kernel_launch: unexpected problem: n_in %d in0 %d out %d ws %zu (need %zu)\n", n_in, n_in > 0 ? in_sizes[0] : -1, out_size, ws_size, (size_t)WS_END); grid = -1; return; }
        int dev = 0, cus = 0, per_cu = 0;
        if (hipGetDevice(&dev) != hipSuccess || hipDeviceGetAttribute(&cus, hipDeviceAttributeMultiprocessorCount, dev) != hipSuccess) { grid = -1; return; }
        if (hipFuncSetAttribute((const void*)fwd_megakernel, hipFuncAttributeMaxDynamicSharedMemorySize, LDS_BYTES) != hipSuccess) { fprintf(stderr, "kernel_launch: hipFuncSetAttribute failed\n"); grid = -1; return; }
        if (hipOccupancyMaxActiveBlocksPerMultiprocessor(&per_cu, (const void*)fwd_megakernel, NWAVES * 64, LDS_BYTES) != hipSuccess || per_cu < 1) { fprintf(stderr, "kernel_launch: occupancy query says %d\n", per_cu); per_cu = 1; }
        (void)hipGetLastError();
        grid = cus;
    }
    if (grid < 0) return;
    if (hipMemsetAsync((char*)d_ws + WS_CTL, 0, CTL_ZERO_BYTES, stream) != hipSuccess) { fprintf(stderr, "kernel_launch: memset failed\n"); return; }
    Args a{};
    for (int i = 0; i < 31; ++i) a.in[i] = (const float*)d_in[i];
    a.out = (float*)d_out; a.ws = (unsigned char*)d_ws;
    if (MK_N_LAUNCHES == 1) {
        a.ph_lo = 0; a.ph_hi = N_PHASES;
        void* kargs[] = {&a};
        hipError_t e = hipLaunchCooperativeKernel((const void*)fwd_megakernel, dim3(grid), dim3(NWAVES * 64), kargs, LDS_BYTES, stream);
        if (e != hipSuccess) fprintf(stderr, "kernel_launch: cooperative launch failed: %s (grid %d)\n", hipGetErrorString(e), grid);
    } else {
        for (int p = 0; p < N_PHASES; ++p) { a.ph_lo = p; a.ph_hi = p + 1; hipLaunchKernelGGL(fwd_megakernel, dim3(grid), dim3(NWAVES * 64), LDS_BYTES, stream, a); }
    }
}
```

```cpp
#include <hip/hip_runtime.h>
#include <cstdio>
#include <cstdint>

#ifndef PROBE_ID
#define PROBE_ID 0
#endif
#define PB_LDS_OFF (163840 - 512 + 128)
#define PB_START(id, ldsp) do { if (PROBE_ID == (id) && blockIdx.x == 0 && threadIdx.x == 0) { *(volatile __attribute__((address_space(3))) unsigned long long*)((ldsp) + PB_LDS_OFF + 8) = __builtin_amdgcn_s_memrealtime(); } } while (0)
#define PB_END(id, ldsp) do { if (PROBE_ID == (id) && blockIdx.x == 0 && threadIdx.x == 0) { volatile __attribute__((address_space(3))) unsigned long long* pb_ = (volatile __attribute__((address_space(3))) unsigned long long*)((ldsp) + PB_LDS_OFF); pb_[0] += __builtin_amdgcn_s_memrealtime() - pb_[1]; } } while (0)
namespace pg8 {
#define PG8_LAS __attribute__((address_space(3)))
typedef unsigned short bf16_t;
typedef short bf16x8 __attribute__((ext_vector_type(8)));
typedef float f32x4 __attribute__((ext_vector_type(4)));
typedef unsigned u32x4 __attribute__((ext_vector_type(4)));
typedef float f32x2 __attribute__((ext_vector_type(2)));
constexpr int EPI_LDS_OFF = 131072;
constexpr int BM = 256, BK = 64, HALF = 128, HTB = HALF * BK * 2  , STAGE_BYTES = 8 * HTB, NXCD = 8, WGM = 8;

__host__ __device__ __forceinline__ int lds_byte(int r, int c) { const int st = (r >> 4) * 2 + (c >> 5), rr = r & 15, cc = c & 31, ob = rr * 64 + cc * 2; return st * 1024 + (ob ^ (((ob >> 9) & 1) << 5)); }
__host__ __device__ __forceinline__ void stage_rc(int b, int& R, int& C) { const int st = b / 1024, sb = b % 1024, swz = sb ^ (((sb >> 9) & 1) << 5); R = (st >> 1) * 16 + swz / 64; C = (st & 1) * 32 + (swz % 64) / 2; }
__host__ __device__ __forceinline__ int perm32(int rho) { const int n = rho >> 4, i = rho & 15; return 8 * (i >> 2) + 4 * n + (i & 3); }

struct Unit { int pm, pn; };
struct Gemm { const bf16_t* A; const bf16_t* Bt; int M, N, K; };

struct StaticOrder {
    int nM, nN, nwg, G, c;
    __host__ __device__ void init(int M, int N, int G_, int c_) { nM = M / BM; nN = N / BM; nwg = nM * nN; G = G_; c = c_; }
    __host__ __device__ bool next(int i, Unit& u) const {
        const long L = (long)i * G + c; if (L >= nwg) return false;
        int wgid = (int)L; { const int q = nwg / NXCD, r = nwg % NXCD, xcd = wgid % NXCD, off = wgid / NXCD; wgid = (xcd < r ? xcd * (q + 1) : r * (q + 1) + (xcd - r) * q) + off; }
        const int nig = WGM * nN, gid = wgid / nig, fm = gid * WGM, gsz = (nM - fm) < WGM ? (nM - fm) : WGM;
        u.pm = fm + ((wgid % nig) % gsz); u.pn = (wgid % nig) / gsz; return true;
    }
    __device__ __forceinline__ void a_ready(const Unit&) const {}
    __device__ __forceinline__ void done(const Unit&) const {}
};

__device__ __forceinline__ unsigned cvt_pk_bf16(float lo, float hi) { unsigned r; asm volatile("v_cvt_pk_bf16_f32 %0, %1, %2" : "=v"(r) : "v"(lo), "v"(hi)); return r; }
__device__ __forceinline__ f32x2 gelu_pk(f32x2 v) {
    const f32x2 av = __builtin_elementwise_abs(v), d = av * 0.2316418882f + 1.0f;
    f32x2 t; t.x = __builtin_amdgcn_rcpf(d.x); t.y = __builtin_amdgcn_rcpf(d.y);
    f32x2 q = t * 0.5307027145f + (-0.7265760135f); q = q * t + 0.7107068705f; q = q * t + (-0.142248368f); q = q * t + 0.127414796f; q = q * t;
    const f32x2 s = (v * v) * (-0.72134752044f);
    f32x2 e; e.x = __builtin_amdgcn_exp2f(s.x); e.y = __builtin_amdgcn_exp2f(s.y);
    const f32x2 m = v * (q * e), r = v - m;
    f32x2 o; o.x = v.x < 0.f ? m.x : r.x; o.y = v.y < 0.f ? m.y : r.y; return o;
}
__device__ __forceinline__ float bf_lo(unsigned w) { return __uint_as_float(w << 16); }
__device__ __forceinline__ float bf_hi(unsigned w) { return __uint_as_float(w & 0xffff0000u); }
__device__ __forceinline__ float sigmoid_f(float x) { return __builtin_amdgcn_rcpf(1.0f + __expf(-x)); }
}

constexpr int DM = 2048, NBATCH = 8, SEQ = 2048, MTOK = NBATCH * SEQ;
constexpr int SGUW = 1024, HYW = 1024, DFF = 8192, INW = 9216, MODW = 6 * DM;
constexpr float LN_EPS = 1e-5f;
constexpr float DN_ALPHA = 1.189207115002721f;

namespace pg8 {

struct EpiG1 {
    static constexpr bool PERM = true, AFTER_DRAIN = false, MID = false; static constexpr int SLOT_FLOATS = 256;
    bf16_t* U; bf16_t* G; const float* b_in;
    __device__ __forceinline__ void mid(f32x4 (&)[2][2][4][2], const Unit&, int, int, int, int) const {}
    __device__ __forceinline__ void preload(PG8_LAS float* slot, const Unit& u, int tid) const { if (tid < 256) slot[tid] = b_in[(u.pn < 4 ? u.pn * 256 : 5120 + (u.pn - 4) * 256) + tid]; }
    __device__ __forceinline__ void operator()(const f32x4 (&acc)[2][2][4][2], const Unit& u, int wr, int wc, int fr, int fq, const PG8_LAS float* slot) const {
        const int row0 = u.pm * BM + wr * 64 + fr; const int pn = u.pn;
        int ldc, colt; bf16_t* base; const bool isu = pn < 4;
        if (isu) { base = U; ldc = SGUW; colt = pn * 256; }
        else { base = G; ldc = 2 * DM; colt = (pn - 4) * 256; }
        const int cl = wc * 64 + 8 * fq;
        f32x4 bv[2][2];
#pragma unroll
        for (int bj = 0; bj < 2; ++bj)
#pragma unroll
            for (int n = 0; n < 2; ++n) bv[bj][n] = *(const PG8_LAS f32x4*)(slot + cl + bj * 32 + 4 * n);
#pragma unroll
        for (int ai = 0; ai < 2; ++ai)
#pragma unroll
            for (int m = 0; m < 4; ++m) {
                const int row = row0 + ai * HALF + m * 16;
                bf16_t* rowp = base + (size_t)row * ldc + colt + cl;
#pragma unroll
                for (int bj = 0; bj < 2; ++bj) {
                    f32x4 v0 = acc[ai][bj][m][0] + bv[bj][0], v1 = acc[ai][bj][m][1] + bv[bj][1];
                    if (isu) {
                        f32x2 a = gelu_pk((f32x2){v0[0], v0[1]}), b = gelu_pk((f32x2){v0[2], v0[3]}), c = gelu_pk((f32x2){v1[0], v1[1]}), d = gelu_pk((f32x2){v1[2], v1[3]});
                        v0 = (f32x4){a.x, a.y, b.x, b.y}; v1 = (f32x4){c.x, c.y, d.x, d.y};
                    } else {
                        v0 = (f32x4){sigmoid_f(v0[0]), sigmoid_f(v0[1]), sigmoid_f(v0[2]), sigmoid_f(v0[3])};
                        v1 = (f32x4){sigmoid_f(v1[0]), sigmoid_f(v1[1]), sigmoid_f(v1[2]), sigmoid_f(v1[3])};
                    }
                    u32x4 w; w.x = cvt_pk_bf16(v0[0], v0[1]); w.y = cvt_pk_bf16(v0[2], v0[3]); w.z = cvt_pk_bf16(v1[0], v1[1]); w.w = cvt_pk_bf16(v1[2], v1[3]);
                    *(u32x4*)(rowp + bj * 32) = w;
                }
            }
    }
};

struct EpiG1T {
    static constexpr bool PERM = true, AFTER_DRAIN = false, MID = false;
    bf16_t* VT; bf16_t* ZHT; const float* b_in; float* statsV; static constexpr int SLOT_FLOATS = 256;
    __device__ __forceinline__ void mid(f32x4 (&)[2][2][4][2], const Unit&, int, int, int, int) const {}
    __device__ __forceinline__ void preload(PG8_LAS float* slot, const Unit& u, int tid) const { if (tid < 256) slot[tid] = b_in[1024 + u.pm * 256 + tid]; }
    __device__ __forceinline__ void operator()(const f32x4 (&acc)[2][2][4][2], const Unit& u, int wr, int wc, int fr, int fq, const PG8_LAS float* slot) const {
        const int col0 = u.pn * BM + wc * 64 + 8 * fq; const bool isv = u.pm < 4;
        const int rowt = (isv ? u.pm : u.pm - 4) * BM + wr * 64 + fr;
        bf16_t* base = isv ? VT : ZHT;
#pragma unroll
        for (int ai = 0; ai < 2; ++ai) {
            float s[2][8], q[2][8];
#pragma unroll
            for (int bj = 0; bj < 2; ++bj)
#pragma unroll
                for (int e = 0; e < 8; ++e) { s[bj][e] = 0.f; q[bj][e] = 0.f; }
#pragma unroll
            for (int m = 0; m < 4; ++m) {
                const int row = rowt + ai * HALF + m * 16; const float bb = slot[wr * 64 + fr + ai * HALF + m * 16];
                bf16_t* rowp = base + (size_t)row * MTOK + col0;
#pragma unroll
                for (int bj = 0; bj < 2; ++bj) {
                    f32x4 v0 = acc[ai][bj][m][0] + bb, v1 = acc[ai][bj][m][1] + bb;
                    if (isv) {
                        f32x2 a = gelu_pk((f32x2){v0[0], v0[1]}), b = gelu_pk((f32x2){v0[2], v0[3]}), c = gelu_pk((f32x2){v1[0], v1[1]}), d = gelu_pk((f32x2){v1[2], v1[3]});
                        v0 = (f32x4){a.x, a.y, b.x, b.y}; v1 = (f32x4){c.x, c.y, d.x, d.y};
                    }
                    u32x4 w; w.x = cvt_pk_bf16(v0[0], v0[1]); w.y = cvt_pk_bf16(v0[2], v0[3]); w.z = cvt_pk_bf16(v1[0], v1[1]); w.w = cvt_pk_bf16(v1[2], v1[3]);
                    *(u32x4*)(rowp + bj * 32) = w;
                    if (isv) {
                        const float e0 = bf_lo(w.x), e1 = bf_hi(w.x), e2 = bf_lo(w.y), e3 = bf_hi(w.y), e4 = bf_lo(w.z), e5 = bf_hi(w.z), e6 = bf_lo(w.w), e7 = bf_hi(w.w);
                        s[bj][0] += e0; s[bj][1] += e1; s[bj][2] += e2; s[bj][3] += e3; s[bj][4] += e4; s[bj][5] += e5; s[bj][6] += e6; s[bj][7] += e7;
                        q[bj][0] += e0 * e0; q[bj][1] += e1 * e1; q[bj][2] += e2 * e2; q[bj][3] += e3 * e3; q[bj][4] += e4 * e4; q[bj][5] += e5 * e5; q[bj][6] += e6 * e6; q[bj][7] += e7 * e7;
                    }
                }
            }
            if (isv) {
                const int slot = u.pm * 4 + ai * 2 + wr;
#pragma unroll
                for (int bj = 0; bj < 2; ++bj)
#pragma unroll
                    for (int e = 0; e < 8; ++e) {
                        float a = s[bj][e], b = q[bj][e];
                        a += __shfl_xor(a, 1); b += __shfl_xor(b, 1); a += __shfl_xor(a, 2); b += __shfl_xor(b, 2);
                        a += __shfl_xor(a, 4); b += __shfl_xor(b, 4); a += __shfl_xor(a, 8); b += __shfl_xor(b, 8);
                        if (fr == 0) *(f32x2*)(statsV + ((size_t)(col0 + bj * 32 + e) * 16 + slot) * 2) = (f32x2){a, b};
                    }
            }
        }
    }
};

struct EpiG2 {
    static constexpr bool PERM = true, AFTER_DRAIN = false, MID = true;
    const bf16_t* G; bf16_t* O; static constexpr int SLOT_FLOATS = 0;
    __device__ __forceinline__ void preload(PG8_LAS float*, const Unit&, int) const {}
    __device__ __forceinline__ void mid(f32x4 (&acc)[2][2][4][2], const Unit& u, int wr, int wc, int fr, int fq) const {
        int row0 = u.pm * BM + wr * 64 + fr, col0 = u.pn * BM + wc * 64 + 8 * fq;
        asm volatile("" : "+v"(row0), "+v"(col0));
#pragma unroll
        for (int ai = 0; ai < 2; ++ai)
#pragma unroll
            for (int m = 0; m < 4; ++m) {
                const bf16_t* gp = G + (size_t)(row0 + ai * HALF + m * 16) * (2 * DM) + col0;
#pragma unroll
                for (int bj = 0; bj < 2; ++bj) {
                    const u32x4 ga = *(const u32x4*)(gp + bj * 32), gb = *(const u32x4*)(gp + DM + bj * 32);
                    f32x4 r0, r1;
                    r0[0] = bf_lo(ga.x) * __builtin_amdgcn_rcpf(bf_lo(gb.x)); r0[1] = bf_hi(ga.x) * __builtin_amdgcn_rcpf(bf_hi(gb.x));
                    r0[2] = bf_lo(ga.y) * __builtin_amdgcn_rcpf(bf_lo(gb.y)); r0[3] = bf_hi(ga.y) * __builtin_amdgcn_rcpf(bf_hi(gb.y));
                    r1[0] = bf_lo(ga.z) * __builtin_amdgcn_rcpf(bf_lo(gb.z)); r1[1] = bf_hi(ga.z) * __builtin_amdgcn_rcpf(bf_hi(gb.z));
                    r1[2] = bf_lo(ga.w) * __builtin_amdgcn_rcpf(bf_lo(gb.w)); r1[3] = bf_hi(ga.w) * __builtin_amdgcn_rcpf(bf_hi(gb.w));
                    acc[ai][bj][m][0] *= r0; acc[ai][bj][m][1] *= r1;
                }
            }
    }
    __device__ __forceinline__ void operator()(const f32x4 (&acc)[2][2][4][2], const Unit& u, int wr, int wc, int fr, int fq, const PG8_LAS float*) const {
        const int row0 = u.pm * BM + wr * 64 + fr, col0 = u.pn * BM + wc * 64 + 8 * fq;
#pragma unroll
        for (int ai = 0; ai < 2; ++ai)
#pragma unroll
            for (int m = 0; m < 4; ++m) {
                const int row = row0 + ai * HALF + m * 16;
                const bf16_t* gp = G + (size_t)row * (2 * DM) + DM + col0;
                bf16_t* op = O + (size_t)row * DM + col0;
#pragma unroll
                for (int bj = 0; bj < 2; ++bj) {
                    const u32x4 gb = *(const u32x4*)(gp + bj * 32);
                    const f32x4 a0 = acc[ai][bj][m][0], a1 = acc[ai][bj][m][1];
                    u32x4 w; w.x = cvt_pk_bf16(a0[0] * bf_lo(gb.x), a0[1] * bf_hi(gb.x)); w.y = cvt_pk_bf16(a0[2] * bf_lo(gb.y), a0[3] * bf_hi(gb.y));
                    w.z = cvt_pk_bf16(a1[0] * bf_lo(gb.z), a1[1] * bf_hi(gb.z)); w.w = cvt_pk_bf16(a1[2] * bf_lo(gb.w), a1[3] * bf_hi(gb.w));
                    *(u32x4*)(op + bj * 32) = w;
                }
            }
    }
};

typedef _Float16 f16x4 __attribute__((ext_vector_type(4)));
__device__ __forceinline__ f16x4 to_f16x4(f32x4 v) { return (f16x4){(_Float16)v[0], (_Float16)v[1], (_Float16)v[2], (_Float16)v[3]}; }
__device__ __forceinline__ f32x4 from_f16x4(f16x4 v) { return (f32x4){(float)v[0], (float)v[1], (float)v[2], (float)v[3]}; }
template <bool FIRST> struct EpiRes {
    static constexpr bool PERM = false, AFTER_DRAIN = false, MID = false; static constexpr int SLOT_FLOATS = FIRST ? 512 : 1024;
    const float* X;
    const _Float16* R16;
    _Float16* O16;
    const float* gate;
    const float* bias;
    const float* lng; const float* lnb; const float* MU;
    float* stats;
    __device__ __forceinline__ void mid(f32x4 (&)[2][2][4][2], const Unit&, int, int, int, int) const {}
    __device__ __forceinline__ void preload(PG8_LAS float* slot, const Unit& u, int tid) const {
        const int c = tid & 255, col = u.pn * BM + c;
        if (tid < 256) slot[c] = gate[(size_t)(u.pm >> 3) * MODW + col]; else slot[256 + c] = bias[col];
        if (!FIRST) { if (tid < 256) slot[512 + c] = DN_ALPHA * lng[col]; else slot[768 + c] = DN_ALPHA * lnb[col]; }
    }
    __device__ __forceinline__ void operator()(const f32x4 (&acc)[2][2][4][2], const Unit& u, int wr, int wc, int fr, int fq, const PG8_LAS float* slot) const {
        int row0 = u.pm * BM + wr * 64 + fr; const int cl = wc * 32 + 4 * fq; int col0 = u.pn * BM + cl;
        asm volatile("" : "+v"(row0), "+v"(col0));
        constexpr int RB = FIRST ? 2 : 1;
#pragma unroll
        for (int ab = 0; ab < 8 / RB; ++ab) {
            const int ai = (ab * RB) >> 2, mb = (ab * RB) & 3;
            f32x4 base[RB][2][2]; f16x4 b16[RB][2][2]; f32x2 mr[RB];
            int rowb = row0 + ai * HALF + mb * 16; asm volatile("" : "+v"(rowb));
#pragma unroll
            for (int mm = 0; mm < RB; ++mm) {
                const size_t off = (size_t)(rowb + mm * 16) * DM + col0;
                if (!FIRST) mr[mm] = *(const f32x2*)(MU + (size_t)(rowb + mm * 16) * 2);
#pragma unroll
                for (int bj = 0; bj < 2; ++bj)
#pragma unroll
                    for (int n = 0; n < 2; ++n) { if (FIRST) base[mm][bj][n] = *(const f32x4*)(X + off + bj * HALF + n * 16); else b16[mm][bj][n] = *(const f16x4*)(R16 + off + bj * HALF + n * 16); }
            }
#pragma unroll
            for (int mm = 0; mm < RB; ++mm) {
                const int m = mb + mm;
                const int row = rowb + mm * 16; _Float16* rp = O16 + (size_t)row * DM + col0;
                float s = 0.f, q = 0.f;
#pragma unroll
                for (int bj = 0; bj < 2; ++bj)
#pragma unroll
                    for (int n = 0; n < 2; ++n) {
                        const int co = bj * HALF + n * 16;
                        const f32x4 gv = *(const PG8_LAS f32x4*)(slot + cl + co), bv = *(const PG8_LAS f32x4*)(slot + 256 + cl + co);
                        f32x4 bs;
                        if (FIRST) bs = base[mm][bj][n] * DN_ALPHA;
                        else bs = (from_f16x4(b16[mm][bj][n]) - mr[mm].x) * mr[mm].y * *(const PG8_LAS f32x4*)(slot + 512 + cl + co) + *(const PG8_LAS f32x4*)(slot + 768 + cl + co);
                        const f16x4 oh = to_f16x4(bs + gv * (acc[ai][bj][m][n] + bv));
                        *(f16x4*)(rp + co) = oh;
                        const f32x4 o = from_f16x4(oh);
                        s += (o[0] + o[1]) + (o[2] + o[3]); q += (o[0] * o[0] + o[1] * o[1]) + (o[2] * o[2] + o[3] * o[3]);
                    }
                s += __shfl_xor(s, 16); s += __shfl_xor(s, 32); q += __shfl_xor(q, 16); q += __shfl_xor(q, 32);
                if (fq == 0) *(f32x2*)(stats + ((size_t)row * 32 + u.pn * 4 + wc) * 2) = (f32x2){s, q};
            }
            asm volatile("" ::: "memory");
        }
    }
};

struct EpiG4 {
    static constexpr bool PERM = true, AFTER_DRAIN = false, MID = false; static constexpr int SLOT_FLOATS = 256;
    bf16_t* O; const float* bias;
    __device__ __forceinline__ void mid(f32x4 (&)[2][2][4][2], const Unit&, int, int, int, int) const {}
    __device__ __forceinline__ void preload(PG8_LAS float* slot, const Unit& u, int tid) const { if (tid < 256) slot[tid] = bias[u.pn * BM + tid]; }
    __device__ __forceinline__ void operator()(const f32x4 (&acc)[2][2][4][2], const Unit& u, int wr, int wc, int fr, int fq, const PG8_LAS float* slot) const {
        const int row0 = u.pm * BM + wr * 64 + fr, cl = wc * 64 + 8 * fq, col0 = u.pn * BM + cl;
        f32x4 bv[2][2];
#pragma unroll
        for (int bj = 0; bj < 2; ++bj)
#pragma unroll
            for (int n = 0; n < 2; ++n) bv[bj][n] = *(const PG8_LAS f32x4*)(slot + cl + bj * 32 + 4 * n);
#pragma unroll
        for (int ai = 0; ai < 2; ++ai)
#pragma unroll
            for (int m = 0; m < 4; ++m) {
                bf16_t* rowp = O + (size_t)(row0 + ai * HALF + m * 16) * DFF + col0;
#pragma unroll
                for (int bj = 0; bj < 2; ++bj) {
                    f32x4 v0 = acc[ai][bj][m][0] + bv[bj][0], v1 = acc[ai][bj][m][1] + bv[bj][1];
                    v0 = __builtin_elementwise_max(v0, (f32x4){0.f, 0.f, 0.f, 0.f}); v1 = __builtin_elementwise_max(v1, (f32x4){0.f, 0.f, 0.f, 0.f});
                    v0 = v0 * v0; v1 = v1 * v1;
                    u32x4 w; w.x = cvt_pk_bf16(v0[0], v0[1]); w.y = cvt_pk_bf16(v0[2], v0[3]); w.z = cvt_pk_bf16(v1[0], v1[1]); w.w = cvt_pk_bf16(v1[2], v1[3]);
                    *(u32x4*)(rowp + bj * 32) = w;
                }
            }
    }
};
}
namespace pg8 {
template <class Epi, class Sched, bool ALIGN_EPI = false, bool SP2 = false>
__device__ __forceinline__ void gemm_phase(PG8_LAS unsigned char* lds, const Gemm g, const Sched& S, const Epi& E) {
    const int tid = threadIdx.x, wid = __builtin_amdgcn_readfirstlane(tid >> 6), lane = tid & 63, wr = wid >> 2, wc = wid & 3, fr = lane & 15, fq = lane >> 4;
    const int K = g.K, nt = K / BK;
    unsigned voffA[2], voffB[2];
#pragma unroll
    for (int i = 0; i < 2; ++i) { int R, C; stage_rc(tid * 16 + i * 8192, R, C); const int Rb = Epi::PERM ? ((R & ~31) + perm32(R & 31)) : R;
        const int Rw = Epi::PERM ? ((R >> 5) * 64 + perm32(R & 31)) : R;
        voffA[i] = (unsigned)(R * K + C) * 2u; voffB[i] = (unsigned)(Rw * K + C) * 2u; (void)Rb; }
    const size_t kstep = (size_t)(BK * 2);
    const size_t hstep = (size_t)HALF * K * 2;
    const size_t tstep = 2 * hstep;
    const size_t hstepB = Epi::PERM ? (size_t)32 * K * 2 : hstep;
    const unsigned ldsw = (unsigned)wid * 1024u;
    const int aoff = lds_byte(wr * 64 + fr, fq * 8), boff = lds_byte(wc * 32 + fr, fq * 8);
#define PG8_SA(b, h) (((b) * 2 + (h)) * HTB)
#define PG8_SB(b, h) ((4 + (b) * 2 + (h)) * HTB)
#define PG8_STAGE(bufoff, gbase, voff) do { _Pragma("unroll") for (int _i = 0; _i < 2; ++_i) \
        __builtin_amdgcn_global_load_lds((const unsigned*)((const char*)(gbase) + (voff)[_i]), (PG8_LAS unsigned*)(lds + (bufoff) + ldsw + _i * 8192), 16, 0, 0); } while (0)
#define PG8_LDA(dst, b, h) do { _Pragma("unroll") for (int m = 0; m < 4; ++m) _Pragma("unroll") for (int k = 0; k < 2; ++k) dst[m][k] = *(const PG8_LAS bf16x8*)(lds + PG8_SA(b, h) + aoff + m * 2048 + k * 1024); } while (0)
#define PG8_LDB(dst, b, h) do { _Pragma("unroll") for (int n = 0; n < 2; ++n) _Pragma("unroll") for (int k = 0; k < 2; ++k) dst[n][k] = *(const PG8_LAS bf16x8*)(lds + PG8_SB(b, h) + boff + n * 2048 + k * 1024); } while (0)
#define PG8_MMA(ai, bj, At, Bt) do { __builtin_amdgcn_s_setprio(1); _Pragma("unroll") for (int m = 0; m < 4; ++m) _Pragma("unroll") for (int n = 0; n < 2; ++n) _Pragma("unroll") for (int k = 0; k < 2; ++k) \
        acc[ai][bj][m][n] = __builtin_amdgcn_mfma_f32_16x16x32_bf16(Bt[n][k], At[m][k], acc[ai][bj][m][n], 0, 0, 0); __builtin_amdgcn_s_setprio(0); } while (0)
#define PG8_WAIT_V(n) asm volatile("s_waitcnt vmcnt(" #n ")" ::: "memory")
#define PG8_WAIT_L(n) asm volatile("s_waitcnt lgkmcnt(" #n ")" ::: "memory")
#define PG8_BAR __builtin_amdgcn_s_barrier()
#define PG8_SCHED __builtin_amdgcn_sched_barrier(0)
    Unit cur, nxt; int ui = 0;
    if (!S.next(0, cur)) return;
    {
        Unit pu; for (int i = 0; S.next(i, pu); ++i) E.preload((PG8_LAS float*)(lds + EPI_LDS_OFF) + i * Epi::SLOT_FLOATS, pu, tid);
        asm volatile("s_waitcnt vmcnt(0) lgkmcnt(0)" ::: "memory"); __builtin_amdgcn_s_barrier(); asm volatile("" ::: "memory");
    }
    f32x4 acc[2][2][4][2];
#pragma unroll
    for (int a = 0; a < 2; ++a)
#pragma unroll
        for (int b = 0; b < 2; ++b)
#pragma unroll
            for (int m = 0; m < 4; ++m)
#pragma unroll
                for (int n = 0; n < 2; ++n) acc[a][b][m][n] = (f32x4){0.f, 0.f, 0.f, 0.f};
    bf16x8 At[4][2], B0[2][2], B1[2][2];
    const char* cA = (const char*)g.A + (size_t)cur.pm * tstep; const char* cB = (const char*)g.Bt + (size_t)cur.pn * tstep;
    S.a_ready(cur);
    if constexpr (SP2) {
        PG8_STAGE(PG8_SB(0, 0), cB, voffB); PG8_STAGE(PG8_SB(0, 1), cB + hstepB, voffB); PG8_STAGE(PG8_SA(0, 0), cA, voffA); PG8_STAGE(PG8_SA(0, 1), cA + hstep, voffA);
        if (wr == 1) PG8_BAR;
        PG8_WAIT_V(2); PG8_BAR;
        PG8_STAGE(PG8_SB(1, 0), cB + kstep, voffB); PG8_STAGE(PG8_SA(1, 0), cA + kstep, voffA); PG8_STAGE(PG8_SB(1, 1), cB + hstepB + kstep, voffB);
        PG8_WAIT_V(6); PG8_BAR;
    } else {
        PG8_STAGE(PG8_SB(0, 0), cB, voffB); PG8_STAGE(PG8_SA(0, 0), cA, voffA); PG8_STAGE(PG8_SB(0, 1), cB + hstepB, voffB); PG8_STAGE(PG8_SA(0, 1), cA + hstep, voffA);
        if (wr == 1) PG8_BAR;
        PG8_WAIT_V(4); PG8_BAR;
        PG8_STAGE(PG8_SB(1, 0), cB + kstep, voffB); PG8_STAGE(PG8_SA(1, 0), cA + kstep, voffA); PG8_STAGE(PG8_SB(1, 1), cB + hstepB + kstep, voffB);
        PG8_WAIT_V(6); PG8_BAR;
    }
    for (;;) {
        const bool has_next = S.next(ui + 1, nxt);
        const char* nA = has_next ? (const char*)g.A + (size_t)nxt.pm * tstep : cA; const char* nB = has_next ? (const char*)g.Bt + (size_t)nxt.pn * tstep : cB;
        for (int t = 0; t < nt; t += 2) {
            const bool last = (t == nt - 2);
            const char* a1 = cA + (size_t)(t + 1) * kstep;
            const char* a2 = last ? nA : cA + (size_t)(t + 2) * kstep; const char* b2 = last ? nB : cB + (size_t)(t + 2) * kstep;
            const char* a3 = a2 + kstep; const char* b3 = b2 + kstep;
            if (last && has_next) S.a_ready(nxt);
            if constexpr (Epi::MID) { if (t == (nt >> 1)) E.mid(acc, cur, wr, wc, fr, fq); }
            if constexpr (SP2) {
            PG8_LDB(B0, 0, 0); PG8_LDB(B1, 0, 1); PG8_SCHED; PG8_LDA(At, 0, 0); PG8_STAGE(PG8_SA(1, 1), a1 + hstep, voffA);
            PG8_WAIT_V(8); PG8_WAIT_L(0); PG8_BAR; PG8_MMA(0, 0, At, B0); PG8_MMA(0, 1, At, B1); PG8_BAR; PG8_SCHED;
            PG8_LDA(At, 0, 1); PG8_STAGE(PG8_SB(0, 0), b2, voffB); PG8_STAGE(PG8_SB(0, 1), b2 + hstepB, voffB); PG8_STAGE(PG8_SA(0, 0), a2, voffA);
            PG8_WAIT_V(8); PG8_WAIT_L(0); PG8_BAR; PG8_MMA(1, 0, At, B0); PG8_MMA(1, 1, At, B1); PG8_BAR; PG8_SCHED;
            PG8_LDB(B0, 1, 0); PG8_LDB(B1, 1, 1); PG8_SCHED; PG8_LDA(At, 1, 0); PG8_STAGE(PG8_SA(0, 1), a2 + hstep, voffA);
            PG8_WAIT_V(8); PG8_WAIT_L(0); PG8_BAR; PG8_MMA(0, 0, At, B0); PG8_MMA(0, 1, At, B1); PG8_BAR; PG8_SCHED;
            PG8_LDA(At, 1, 1); PG8_STAGE(PG8_SB(1, 0), b3, voffB); PG8_STAGE(PG8_SB(1, 1), b3 + hstepB, voffB); PG8_STAGE(PG8_SA(1, 0), a3, voffA);
            PG8_WAIT_V(8); PG8_WAIT_L(0); PG8_BAR; PG8_MMA(1, 0, At, B0); PG8_MMA(1, 1, At, B1); PG8_BAR; PG8_SCHED;
            } else {
            PG8_LDB(B0, 0, 0); PG8_SCHED; PG8_LDA(At, 0, 0); PG8_STAGE(PG8_SA(1, 1), a1 + hstep, voffA);
            PG8_WAIT_L(8); PG8_BAR; PG8_WAIT_L(0); PG8_MMA(0, 0, At, B0); PG8_BAR; PG8_SCHED;
            PG8_LDB(B1, 0, 1); PG8_STAGE(PG8_SB(0, 0), b2, voffB);
            PG8_BAR; PG8_WAIT_L(0); PG8_MMA(0, 1, At, B1); PG8_BAR;
            PG8_LDA(At, 0, 1); PG8_STAGE(PG8_SA(0, 0), a2, voffA);
            PG8_BAR; PG8_WAIT_L(0); PG8_MMA(1, 0, At, B0); PG8_BAR; PG8_SCHED;
            PG8_STAGE(PG8_SB(0, 1), b2 + hstepB, voffB);
            PG8_WAIT_V(6); PG8_BAR; PG8_MMA(1, 1, At, B1); PG8_BAR;
            PG8_LDB(B0, 1, 0); PG8_SCHED; PG8_LDA(At, 1, 0); PG8_STAGE(PG8_SA(0, 1), a2 + hstep, voffA);
            PG8_WAIT_L(8); PG8_BAR; PG8_WAIT_L(0); PG8_MMA(0, 0, At, B0); PG8_BAR; PG8_SCHED;
            PG8_LDB(B1, 1, 1); PG8_STAGE(PG8_SB(1, 0), b3, voffB);
            PG8_BAR; PG8_WAIT_L(0); PG8_MMA(0, 1, At, B1); PG8_BAR;
            PG8_LDA(At, 1, 1); PG8_STAGE(PG8_SA(1, 0), a3, voffA);
            PG8_BAR; PG8_WAIT_L(0); PG8_MMA(1, 0, At, B0); PG8_BAR; PG8_SCHED;
            PG8_STAGE(PG8_SB(1, 1), b3 + hstepB, voffB);
            PG8_WAIT_V(6); PG8_BAR; PG8_MMA(1, 1, At, B1); PG8_BAR;
            }
        }
        if constexpr (ALIGN_EPI) { if (wr == 0) PG8_BAR; }
        if constexpr (!Epi::AFTER_DRAIN) { E(acc, cur, wr, wc, fr, fq, (const PG8_LAS float*)(lds + EPI_LDS_OFF) + ui * Epi::SLOT_FLOATS); S.done(cur); }
        if (!has_next) break;
#pragma unroll
        for (int a = 0; a < 2; ++a)
#pragma unroll
            for (int b = 0; b < 2; ++b)
#pragma unroll
                for (int m = 0; m < 4; ++m)
#pragma unroll
                    for (int n = 0; n < 2; ++n) acc[a][b][m][n] = (f32x4){0.f, 0.f, 0.f, 0.f};
        cur = nxt; cA = nA; cB = nB; ++ui;
        if constexpr (ALIGN_EPI) { if (wr == 1) PG8_BAR; }
    }
    PG8_WAIT_V(0);
    if constexpr (!ALIGN_EPI) { if (wr == 0) PG8_BAR; }
    PG8_BAR;
    if constexpr (Epi::AFTER_DRAIN) { E.fused(acc, cur, wr, wc, fr, fq, lds, wid, lane); S.done(cur); }
#undef PG8_SA
#undef PG8_SB
#undef PG8_STAGE
#undef PG8_LDA
#undef PG8_LDB
#undef PG8_MMA
#undef PG8_WAIT_V
#undef PG8_WAIT_L
#undef PG8_BAR
#undef PG8_SCHED
}
}

constexpr size_t MiB = 1u << 20;
constexpr size_t WS_CTL = 0;
constexpr size_t WS_MOD = 1 * MiB;
constexpr size_t WS_STV = 2 * MiB;
constexpr size_t WS_ST1 = 4 * MiB;
constexpr size_t WS_ST2 = 8 * MiB;
constexpr size_t WS_MU1 = 12 * MiB;
constexpr size_t WS_HID2 = 14 * MiB;
constexpr size_t WS_SGW = 13 * MiB;
constexpr size_t WS_WIN = 16 * MiB;
constexpr size_t WS_WAB = 52 * MiB;
constexpr size_t WS_WO = 60 * MiB;
constexpr size_t WS_FILT = 68 * MiB;
constexpr size_t WS_WM2 = 68 * MiB;
constexpr size_t WS_H = 100 * MiB;
constexpr size_t WS_U = 164 * MiB;
constexpr size_t WS_V = 196 * MiB;
constexpr size_t WS_MERGED = 164 * MiB;
constexpr size_t WS_ZHT = 228 * MiB;
constexpr size_t WS_G = 324 * MiB;
constexpr size_t WS_AFF = 164 * MiB;
constexpr size_t WS_WM1 = 420 * MiB;
constexpr size_t WS_YT = 452 * MiB;
constexpr size_t WS_END = 484 * MiB;

constexpr int NWAVES = 8;
constexpr int LDS_BYTES = 163840;

#define GAS __attribute__((address_space(1)))
#define LAS __attribute__((address_space(3)))
typedef unsigned short bf16;
typedef unsigned v4u __attribute__((ext_vector_type(4)));
typedef unsigned v2u __attribute__((ext_vector_type(2)));
typedef float f32x4 __attribute__((ext_vector_type(4)));
typedef float f32x2 __attribute__((ext_vector_type(2)));
#define LDS_WAIT() asm volatile("s_waitcnt lgkmcnt(0)" ::: "memory")

__device__ __forceinline__ unsigned f2bf(float f) { unsigned u = __builtin_bit_cast(unsigned, f); return (u + 0x7fffu + ((u >> 16) & 1u)) >> 16; }
__device__ __forceinline__ unsigned pk2(float lo, float hi) { return f2bf(lo) | (f2bf(hi) << 16); }
__device__ __forceinline__ float bflo(unsigned w) { return __uint_as_float(w << 16); }
__device__ __forceinline__ float bfhi(unsigned w) { return __uint_as_float(w & 0xffff0000u); }
__device__ __forceinline__ float bf1(bf16 h) { return __uint_as_float((unsigned)h << 16); }
__device__ __forceinline__ float wave_sum(float v) {
#pragma unroll
    for (int o = 1; o < 64; o <<= 1) v += __shfl_xor(v, o);
    return v;
}

struct Args { const float* in[31]; float* out; unsigned char* ws; int ph_lo, ph_hi; };

struct Frame {
    LAS unsigned char* lds;
    int tid, lane, wave, G;
    const float* const* in; float* out; unsigned char* ws;
};
enum { I_X = 0, I_C, I_WADA, I_BADA, I_WIN, I_BIN, I_SLNG, I_SLNB, I_SW, I_SB, I_HCW, I_HCB, I_HW1, I_HB1, I_HW2, I_HB2, I_HFREQ, I_HW3, I_HSKIP,
       I_WA, I_WB, I_WO, I_BO, I_LN1G, I_LN1B, I_WM1, I_BM1, I_WM2, I_BM2, I_LN2G, I_LN2B };

__device__ __forceinline__ void transpose_matrix(Frame& F, const float* W, int K, int N, bf16* WT, int ldk, int koff, int remap_win, int first, int nblocks) {
    LAS float* tile = (LAS float*)F.lds;
    const int tid = F.tid, nblk = N / 256, nitems = (K / 64) * nblk;
    const int lr = tid >> 6, lc = tid & 63;
    const int wc = tid & 7, wn = tid >> 3;
    for (int it = first; it < nitems; it += nblocks) {
        const int kb = it / nblk, nb = it % nblk, n0 = nb * 256, k0 = kb * 64; int row0 = n0;
        if (remap_win) row0 = (n0 < 1024) ? n0 : (n0 < 2048 ? n0 - 1024 + 5120 : (n0 < 5120 ? n0 - 2048 + 6144 : n0 - 5120 + 1024));
        f32x4 v[8];
#pragma unroll
        for (int i = 0; i < 8; ++i) v[i] = *(const f32x4*)(W + (size_t)(k0 + 8 * i + lr) * N + n0 + 4 * lc);
#pragma unroll
        for (int i = 0; i < 8; ++i) *(LAS f32x4*)(tile + (8 * i + lr) * 256 + ((lc ^ i) << 2)) = v[i];
        __syncthreads();
#pragma unroll
        for (int j = 0; j < 4; ++j) { const int n = wn + 64 * j; const LAS float* sp = tile + (8 * wc) * 256 + ((((n >> 2) ^ wc) << 2) | (n & 3));
            v4u o; o.x = pk2(sp[0 * 256], sp[1 * 256]); o.y = pk2(sp[2 * 256], sp[3 * 256]); o.z = pk2(sp[4 * 256], sp[5 * 256]); o.w = pk2(sp[6 * 256], sp[7 * 256]);
            *(GAS v4u*)(WT + (size_t)(row0 + n) * ldk + koff + k0 + 8 * wc) = o; }
        __syncthreads();
    }
}

__device__ __forceinline__ void p0_mod(Frame& F) {
    LAS float* condS = (LAS float*)F.lds;
    LAS float* red = (LAS float*)(F.lds + 65536);
    const float* c = F.in[I_C]; const float* w_ada = F.in[I_WADA]; const float* b_ada = F.in[I_BADA];
    float* mod = (float*)(F.ws + WS_MOD);
    const int tid = F.tid;
    for (int item = blockIdx.x; item < MODW / 48; item += F.G) {
        for (int i = tid; i < NBATCH * DM; i += NWAVES * 64) { const float v = c[i]; condS[i] = v / (1.0f + __expf(-v)); }
        __syncthreads();
        const int cq = tid % 12, kq = tid / 12, col0 = item * 48;
        if (kq < 32) {
            f32x4 acc[8];
#pragma unroll
            for (int b = 0; b < 8; ++b) acc[b] = (f32x4){0.f, 0.f, 0.f, 0.f};
            const float* wp = w_ada + (size_t)kq * MODW + col0 + cq * 4;
            for (int k = kq; k < DM; k += 256, wp += (size_t)256 * MODW) {
                f32x4 w[8];
#pragma unroll
                for (int u = 0; u < 8; ++u) w[u] = *(const f32x4*)(wp + (size_t)(32 * u) * MODW);
#pragma unroll
                for (int u = 0; u < 8; ++u)
#pragma unroll
                    for (int b = 0; b < 8; ++b) acc[b] += w[u] * condS[b * DM + k + 32 * u];
            }
#pragma unroll
            for (int b = 0; b < 8; ++b) *(LAS f32x4*)(red + (kq * 8 + b) * 48 + cq * 4) = acc[b];
        }
        __syncthreads();
        if (tid < 384) { const int b = tid / 48, col = tid % 48; float s = 0.f;
#pragma unroll 8
          for (int k2 = 0; k2 < 32; ++k2) s += red[(k2 * 8 + b) * 48 + col];
          mod[(size_t)b * MODW + col0 + col] = s + b_ada[col0 + col]; }
        __syncthreads();
    }
}

__device__ __forceinline__ void p0_hid2(Frame& F) {
    LAS float* scr = (LAS float*)F.lds + F.wave * 128;
    const float* w1 = F.in[I_HW1]; const float* b1 = F.in[I_HB1]; const float* w2 = F.in[I_HW2]; const float* b2 = F.in[I_HB2]; const float* freq = F.in[I_HFREQ];
    float* HID2 = (float*)(F.ws + WS_HID2);
    const int lane = F.lane;
    for (int l = blockIdx.x * NWAVES + F.wave; l < SEQ; l += F.G * NWAVES) {
        const float fr = freq[lane];
        const float tl = (float)l / (float)(SEQ - 1), omega = 6.283185307179586f * (float)l / (float)SEQ;
        float f = 0.f;
        if (lane == 0) f = tl;
        else if (lane <= 16) { const float band = 1e-4f + (float)(lane - 1) * ((15.0f - 1e-4f) / 15.0f); f = cosf(band * omega); }
        else if (lane <= 32) { const float band = 1e-4f + (float)(lane - 17) * ((15.0f - 1e-4f) / 15.0f); f = -sinf(band * omega); }
        scr[lane] = f; LDS_WAIT(); asm volatile("" ::: "memory");
        float a = b1[lane];
#pragma unroll 11
        for (int i = 0; i < 33; ++i) a += scr[i] * w1[i * 64 + lane];
        scr[64 + lane] = sinf(fr * a); LDS_WAIT(); asm volatile("" ::: "memory");
        a = b2[lane];
#pragma unroll 16
        for (int i = 0; i < 64; ++i) a += scr[64 + i] * w2[i * 64 + lane];
        HID2[(size_t)l * 64 + lane] = sinf(fr * a);
        LDS_WAIT(); asm volatile("" ::: "memory");
    }
}
typedef float fl_f32x16 __attribute__((ext_vector_type(16)));
__device__ __forceinline__ void p1_filter_waves(Frame& F) {
    const int fwl = F.wave - 4;
    LAS float* hS = (LAS float*)F.lds + fwl * (32 * 65);
    const float* w3 = F.in[I_HW3]; const float* HID2 = (const float*)(F.ws + WS_HID2);
    float* FILT = (float*)(F.ws + WS_FILT);
    const int lane = F.lane, r = lane & 31, h = lane >> 5;
    const float min_decay = -3.0701134573253943f, max_decay = -15.350567286626972f;
    for (int item = blockIdx.x * 4 + fwl; item < 1024; item += F.G * 4) {
        const int pb = item >> 4, cb = item & 15, pos0 = pb * 32, col0 = cb * 256;
        {
#pragma unroll
            for (int u = 0; u < 8; ++u) { const int e = (u * 64 + lane) * 4, p = e >> 6, k = e & 63; const f32x4 v = *(const f32x4*)(HID2 + (size_t)(pos0 + p) * 64 + k);
                hS[p * 65 + k] = v[0]; hS[p * 65 + k + 1] = v[1]; hS[p * 65 + k + 2] = v[2]; hS[p * 65 + k + 3] = v[3]; }
            LDS_WAIT(); asm volatile("" ::: "memory");
        }
        fl_f32x16 acc[8];
#pragma unroll
        for (int t = 0; t < 8; ++t)
#pragma unroll
            for (int e = 0; e < 16; ++e) acc[t][e] = 0.f;
        const float* wp = w3 + (size_t)h * 4096 + col0 + r;
#pragma unroll 2
        for (int s2 = 0; s2 < 32; ++s2) {
            const float a = hS[r * 65 + 2 * s2 + h];
            float b[8];
#pragma unroll
            for (int t = 0; t < 8; ++t) b[t] = wp[(size_t)(2 * s2) * 4096 + t * 32];
#pragma unroll
            for (int t = 0; t < 8; ++t) acc[t] = __builtin_amdgcn_mfma_f32_32x32x2f32(a, b[t], acc[t], 0, 0, 0);
        }
#pragma unroll
        for (int t = 0; t < 8; ++t) {
            const int j = col0 + t * 32 + r, ch = j & 1023; const float delta = fabsf(min_decay + (float)ch * ((max_decay - min_decay) / 1023.0f));
            float* op = FILT + (size_t)j * SEQ + pos0 + 4 * h;
#pragma unroll
            for (int g = 0; g < 4; ++g) {
                f32x4 o;
#pragma unroll
                for (int e = 0; e < 4; ++e) { const float tp = (float)(pos0 + 8 * g + 4 * h + e) / (float)(SEQ - 1); o[e] = acc[t][4 * g + e] * __expf(-tp * delta); }
                *(f32x4*)(op + 8 * g) = o;
            }
        }
        LDS_WAIT(); asm volatile("" ::: "memory");
    }
}

__device__ __forceinline__ void p1_modulate(Frame& F) {
    const float* x = F.in[I_X]; const float* mod = (const float*)(F.ws + WS_MOD); bf16* H = (bf16*)(F.ws + WS_H);
    const size_t nvec = (size_t)MTOK * DM / 8, stride = (size_t)F.G * 256;
    for (size_t i0 = (size_t)blockIdx.x * 256 + F.tid; i0 < nvec; i0 += 4 * stride) {
        f32x4 xa[4], xb[4];
#pragma unroll
        for (int u = 0; u < 4; ++u) { const size_t i = i0 + u * stride; if (i < nvec) { const float* xp = x + i * 8; xa[u] = *(const f32x4*)xp; xb[u] = *(const f32x4*)(xp + 4); } }
#pragma unroll
        for (int u = 0; u < 4; ++u) { const size_t i = i0 + u * stride; if (i < nvec) {
            const int row = (int)(i >> 8), col = (int)(i & 255) * 8, b = row >> 11;
            const float* mp = mod + (size_t)b * MODW + col;
            const f32x4 sh0 = *(const f32x4*)mp, sh1 = *(const f32x4*)(mp + 4), sc0 = *(const f32x4*)(mp + DM), sc1 = *(const f32x4*)(mp + DM + 4);
            const f32x4 h0 = xa[u] * (sc0 + 1.0f) + sh0, h1 = xb[u] * (sc1 + 1.0f) + sh1;
            v4u o; o.x = pk2(h0[0], h0[1]); o.y = pk2(h0[2], h0[3]); o.z = pk2(h1[0], h1[1]); o.w = pk2(h1[2], h1[3]);
            *(v4u*)(H + i * 8) = o; } }
    }
}

typedef short sg_bf16x8 __attribute__((ext_vector_type(8)));
typedef float sg_f32x16 __attribute__((ext_vector_type(16)));
constexpr int SG_VT = 0, SG_LD = 136, SG_ST = 36864;
__device__ __forceinline__ void p3_sgu(Frame& F) {
    LAS bf16* vnT = (LAS bf16*)(F.lds + SG_VT); LAS float* stS = (LAS float*)(F.lds + SG_ST);
    const bf16* U = (const bf16*)(F.ws + WS_U); const bf16* VT = (const bf16*)(F.ws + WS_V); bf16* AB = (bf16*)(F.ws + WS_H);
    const bf16* Wb = (const bf16*)(F.ws + WS_SGW); const float* stv = (const float*)(F.ws + WS_STV);
    const float* lng = F.in[I_SLNG]; const float* lnb = F.in[I_SLNB]; const float* sb = F.in[I_SB];
    const int tid = F.tid, lane = F.lane, w = F.wave, r = lane & 31, h = lane >> 5;
    const int q0 = 32 * (w >> 1), ct0 = 2 * (w & 1);
    for (int item = blockIdx.x; item < 1024; item += F.G) {
        const int b = item >> 7, n = (item >> 3) & 15, g = item & 7, tok0 = b * SEQ + n * 128;
        f32x2 pst[16];
        if (tid < 128) { const float* sp = stv + (size_t)(tok0 + tid) * 32;
#pragma unroll
            for (int i = 0; i < 16; ++i) pst[i] = *(const f32x2*)(sp + 2 * i); }
        const int c = tid >> 2, pseg = (tid & 3) * 32, ch = g * 128 + c;
        v4u wv[4];
        { const bf16* vp = VT + (size_t)ch * MTOK + tok0 + pseg;
#pragma unroll
          for (int k = 0; k < 4; ++k) wv[k] = *(const v4u*)(vp + 8 * k); }
        const float gg = lng[ch], bb = lnb[ch];
        sg_bf16x8 af[8];
#pragma unroll
        for (int kk = 0; kk < 8; ++kk) af[kk] = *(const sg_bf16x8*)(Wb + (size_t)(g * 128 + q0 + r) * 128 + 16 * kk + 8 * h);
        bf16 uu[2][16]; float sbv[16];
#pragma unroll
        for (int rg = 0; rg < 16; ++rg) { const int q = q0 + (rg & 3) + 8 * (rg >> 2) + 4 * h; sbv[rg] = sb[g * 128 + q];
#pragma unroll
            for (int ct = 0; ct < 2; ++ct) uu[ct][rg] = U[(size_t)(tok0 + q) * SGUW + g * 128 + (ct0 + ct) * 32 + r]; }
        if (tid < 128) { float s = 0.f, q = 0.f;
#pragma unroll
            for (int i = 0; i < 16; ++i) { s += pst[i].x; q += pst[i].y; }
            const float mean = s * (1.0f / 1024.0f); float var = q * (1.0f / 1024.0f) - mean * mean; var = var > 0.f ? var : 0.f;
            *(LAS f32x2*)(stS + 2 * tid) = (f32x2){mean, 1.0f / sqrtf(var + LN_EPS)}; }
        __syncthreads();
#pragma unroll
        for (int k = 0; k < 4; ++k) {
            const float e[8] = {bflo(wv[k].x), bfhi(wv[k].x), bflo(wv[k].y), bfhi(wv[k].y), bflo(wv[k].z), bfhi(wv[k].z), bflo(wv[k].w), bfhi(wv[k].w)};
            float o[8];
#pragma unroll
            for (int i = 0; i < 8; i += 2) { const f32x4 st = *(const LAS f32x4*)(stS + 2 * (pseg + 8 * k + i));
                o[i] = (e[i] - st[0]) * st[1] * gg + bb; o[i + 1] = (e[i + 1] - st[2]) * st[3] * gg + bb; }
            v4u pk; pk.x = pk2(o[0], o[1]); pk.y = pk2(o[2], o[3]); pk.z = pk2(o[4], o[5]); pk.w = pk2(o[6], o[7]);
            *(LAS v4u*)(vnT + c * SG_LD + pseg + 8 * k) = pk; }
        __syncthreads();
        sg_f32x16 acc[2];
#pragma unroll
        for (int ct = 0; ct < 2; ++ct)
#pragma unroll
            for (int i = 0; i < 16; ++i) acc[ct][i] = 0.f;
#pragma unroll
        for (int kk = 0; kk < 8; ++kk)
#pragma unroll
            for (int ct = 0; ct < 2; ++ct) {
                const sg_bf16x8 bf = *(const LAS sg_bf16x8*)(vnT + ((ct0 + ct) * 32 + r) * SG_LD + 16 * kk + 8 * h);
                acc[ct] = __builtin_amdgcn_mfma_f32_32x32x16_bf16(af[kk], bf, acc[ct], 0, 0, 0);
            }
#pragma unroll
        for (int ct = 0; ct < 2; ++ct) {
            const int cc = (ct0 + ct) * 32 + r;
#pragma unroll
            for (int rg = 0; rg < 16; ++rg) {
                const int q = q0 + (rg & 3) + 8 * (rg >> 2) + 4 * h;
                AB[(size_t)(tok0 + q) * DM + g * 128 + cc] = (bf16)f2bf(bf1(uu[ct][rg]) * (acc[ct][rg] + sbv[rg]));
            }
        }
        __syncthreads();
    }
}

__device__ __forceinline__ float sconv(const bf16* ZHT, const float* cw, const float* cb, int ch, int b, int t) {
    const bf16* zp = ZHT + (size_t)ch * MTOK + b * SEQ;
    const float z0 = t > 0 ? bf1(zp[t - 1]) : 0.f, z1 = bf1(zp[t]), z2 = t < SEQ - 1 ? bf1(zp[t + 1]) : 0.f;
    return cw[ch] * z0 + cw[3072 + ch] * z1 + cw[6144 + ch] * z2 + cb[ch];
}
__device__ __forceinline__ void p3_hyena(Frame& F) {
    LAS float* Us = (LAS float*)F.lds;
    LAS float* KF = (LAS float*)(F.lds + 65536);
    const bf16* ZHT = (const bf16*)(F.ws + WS_ZHT); const float* FILT = (const float*)(F.ws + WS_FILT); bf16* AB = (bf16*)(F.ws + WS_H);
    const float* cw = F.in[I_HCW]; const float* cb = F.in[I_HCB]; const float* skip = F.in[I_HSKIP];
    const int tid = F.tid;
    for (int item = blockIdx.x; item < HYW; item += F.G) {
        const int c = item;
        for (int i = tid; i < NBATCH * SEQ; i += NWAVES * 64) { const int b = i >> 11, t = i & 2047; Us[t * 8 + b] = sconv(ZHT, cw, cb, c, b, t); }
        for (int n = 0; n < 2; ++n) {
            const float* hf = FILT + (size_t)((0 * 2 + n) * 1024 + c) * SEQ; const float* hb = FILT + (size_t)((1 * 2 + n) * 1024 + c) * SEQ;
            for (int i = tid; i < 4095; i += NWAVES * 64) { const int lag = i - 2047; KF[i] = lag > 0 ? hf[lag] : (lag == 0 ? hf[0] + hb[0] : hb[-lag]); }
            __syncthreads();
            f32x4 acc[4][2];
#pragma unroll
            for (int ti = 0; ti < 4; ++ti) { acc[ti][0] = (f32x4){0.f, 0.f, 0.f, 0.f}; acc[ti][1] = (f32x4){0.f, 0.f, 0.f, 0.f}; }
            const LAS float* kp = KF + tid + 2047;
            for (int s = 0; s < SEQ; ++s) {
                const f32x4 u0 = *(const LAS f32x4*)(Us + s * 8), u1 = *(const LAS f32x4*)(Us + s * 8 + 4);
#pragma unroll
                for (int ti = 0; ti < 4; ++ti) { const float kv = kp[512 * ti - s]; acc[ti][0] += u0 * kv; acc[ti][1] += u1 * kv; }
            }
            __syncthreads();
            const float sk = skip[n * 1024 + c];
#pragma unroll
            for (int ti = 0; ti < 4; ++ti) { const int t = tid + 512 * ti;
#pragma unroll
                for (int b = 0; b < 8; ++b) {
                    const float uv = Us[t * 8 + b], gate = sconv(ZHT, cw, cb, (n + 1) * 1024 + c, b, t);
                    const float y = gate * (acc[ti][b >> 2][b & 3] + sk * uv);
                    if (n == 0) Us[t * 8 + b] = y; else AB[(size_t)(b * SEQ + t) * DM + 1024 + c] = (bf16)f2bf(y);
                } }
            __syncthreads();
        }
    }
}

#ifndef HYFFT_HD
#define HYFFT_HD __device__ __forceinline__
#define HYFFT_LAS __attribute__((address_space(3)))
#endif
typedef float hy_c32 __attribute__((ext_vector_type(2)));
HYFFT_HD int hy_padi(int i) { return i + (i >> 3); }
HYFFT_HD int hy_rev(int x) { return ((x & 7) << 9) | (((x >> 3) & 7) << 6) | (((x >> 6) & 7) << 3) | ((x >> 9) & 7); }

template <bool INV> HYFFT_HD void hy_dft8(float (&re)[8], float (&im)[8]) {
    const float h = 0.70710678118654752f;
    float ar[4], ai[4], br[4], bi[4];
#pragma unroll
    for (int m = 0; m < 4; ++m) { ar[m] = re[m] + re[m + 4]; ai[m] = im[m] + im[m + 4]; br[m] = re[m] - re[m + 4]; bi[m] = im[m] - im[m + 4]; }
    { float x = br[1], y = bi[1]; if (!INV) { br[1] = h * (x + y); bi[1] = h * (y - x); } else { br[1] = h * (x - y); bi[1] = h * (y + x); } }
    { float x = br[2], y = bi[2]; if (!INV) { br[2] = y; bi[2] = -x; } else { br[2] = -y; bi[2] = x; } }
    { float x = br[3], y = bi[3]; if (!INV) { br[3] = h * (y - x); bi[3] = -h * (x + y); } else { br[3] = -h * (x + y); bi[3] = h * (x - y); } }
#pragma unroll
    for (int s = 0; s < 2; ++s) {
        float* cr = s ? br : ar; float* ci = s ? bi : ai;
        const float e0r = cr[0] + cr[2], e0i = ci[0] + ci[2], e1r = cr[0] - cr[2], e1i = ci[0] - ci[2];
        const float o0r = cr[1] + cr[3], o0i = ci[1] + ci[3]; const float dr = cr[1] - cr[3], di = ci[1] - ci[3];
        float o1r, o1i; if (!INV) { o1r = di; o1i = -dr; } else { o1r = -di; o1i = dr; }
        re[0 + s] = e0r + o0r; im[0 + s] = e0i + o0i;
        re[2 + s] = e1r + o1r; im[2 + s] = e1i + o1i;
        re[4 + s] = e0r - o0r; im[4 + s] = e0i - o0i;
        re[6 + s] = e1r - o1r; im[6 + s] = e1i - o1i;
    }
}
template <bool CONJ> HYFFT_HD void hy_twiddle(float (&re)[8], float (&im)[8], float wr, float wi) {
    if (CONJ) wi = -wi;
    const float w2r = wr * wr - wi * wi, w2i = 2.f * wr * wi;
    const float w3r = w2r * wr - w2i * wi, w3i = w2r * wi + w2i * wr;
    const float w4r = w2r * w2r - w2i * w2i, w4i = 2.f * w2r * w2i;
    const float w5r = w4r * wr - w4i * wi, w5i = w4r * wi + w4i * wr;
    const float w6r = w3r * w3r - w3i * w3i, w6i = 2.f * w3r * w3i;
    const float w7r = w4r * w3r - w4i * w3i, w7i = w4r * w3i + w4i * w3r;
    const float pr[8] = {1.f, wr, w2r, w3r, w4r, w5r, w6r, w7r}, pi[8] = {0.f, wi, w2i, w3i, w4i, w5i, w6i, w7i};
#pragma unroll
    for (int k = 1; k < 8; ++k) { const float x = re[k], y = im[k]; re[k] = x * pr[k] - y * pi[k]; im[k] = x * pi[k] + y * pr[k]; }
}
template <int L, class BP, class TP> HYFFT_HD void hy_fwd_store(BP buf, TP tw, int j, float (&re)[8], float (&im)[8]) {
    constexpr int S = L / 8; const int blk = j / S, q = j % S, base = blk * L + q;
    hy_dft8<false>(re, im);
    if (L > 8) { const hy_c32 w = tw[q * (4096 / L)]; hy_twiddle<false>(re, im, w.x, w.y); }
#pragma unroll
    for (int k = 0; k < 8; ++k) buf[hy_padi(base + k * S)] = (hy_c32){re[k], im[k]};
}
template <int L, class BP> HYFFT_HD void hy_load8(BP buf, int j, float (&re)[8], float (&im)[8]) {
    constexpr int S = L / 8; const int blk = j / S, q = j % S, base = blk * L + q;
#pragma unroll
    for (int k = 0; k < 8; ++k) { const hy_c32 v = buf[hy_padi(base + k * S)]; re[k] = v.x; im[k] = v.y; }
}
template <int L, class BP, class TP> HYFFT_HD void hy_fwd_stage(BP buf, TP tw, int j) { float re[8], im[8]; hy_load8<L>(buf, j, re, im); hy_fwd_store<L>(buf, tw, j, re, im); }
template <int L, class BP, class TP> HYFFT_HD void hy_inv_regs(BP buf, TP tw, int j, float (&re)[8], float (&im)[8]) {
    constexpr int S = L / 8; const int q = j % S;
    hy_load8<L>(buf, j, re, im);
    if (L > 8) { const hy_c32 w = tw[q * (4096 / L)]; hy_twiddle<true>(re, im, w.x, w.y); }
    hy_dft8<true>(re, im);
}
template <int L, class BP, class TP> HYFFT_HD void hy_inv_stage(BP buf, TP tw, int j) {
    constexpr int S = L / 8; const int blk = j / S, q = j % S, base = blk * L + q;
    float re[8], im[8]; hy_inv_regs<L>(buf, tw, j, re, im);
#pragma unroll
    for (int k = 0; k < 8; ++k) buf[hy_padi(base + k * S)] = (hy_c32){re[k], im[k]};
}
template <class BP, class KP> HYFFT_HD void hy_mid_stage(BP buf, KP K, int j) {
    float re[8], im[8]; hy_load8<8>(buf, j, re, im);
    hy_dft8<false>(re, im);
#pragma unroll
    for (int k = 0; k < 8; ++k) { const hy_c32 kv = K[hy_padi(8 * j + k)]; const float x = re[k], y = im[k]; re[k] = x * kv.x - y * kv.y; im[k] = x * kv.y + y * kv.x; }
    hy_dft8<true>(re, im);
#pragma unroll
    for (int k = 0; k < 8; ++k) buf[hy_padi(8 * j + k)] = (hy_c32){re[k], im[k]};
}
template <class BP> HYFFT_HD void hy_last_fwd(BP buf, int j) {
    float re[8], im[8]; hy_load8<8>(buf, j, re, im); hy_dft8<false>(re, im);
#pragma unroll
    for (int k = 0; k < 8; ++k) buf[hy_padi(8 * j + k)] = (hy_c32){re[k], im[k]};
}
template <class BP, class KP> HYFFT_HD void hy_separate(BP Z, KP K1, KP K2, int j) {
    const float sc = 0.5f / 4096.0f;
#pragma unroll
    for (int r = 0; r < 8; ++r) {
        const int p = j + 512 * r, f = hy_rev(p), g = (4096 - f) & 4095, p2 = hy_rev(g);
        const hy_c32 a = Z[hy_padi(p)], b = Z[hy_padi(p2)];
        K1[hy_padi(p)] = (hy_c32){(a.x + b.x) * sc, (a.y - b.y) * sc};
        K2[hy_padi(p)] = (hy_c32){(a.y + b.y) * sc, (b.x - a.x) * sc};
    }
}

struct Raw3 { bf16 a, b, c; };
__device__ __forceinline__ Raw3 raw3(const bf16* zp, int t) { const bf16* p = zp + t; Raw3 r; r.a = p[-1]; r.b = p[0]; r.c = p[1]; return r; }
template <bool M0, bool M7> __device__ __forceinline__ float sconv_raw(const Raw3& r, int t, float w0, float w1, float w2, float cb) {
    float z0 = bf1(r.a), z2 = bf1(r.c); const float z1 = bf1(r.b);
    if (M0) z0 = t > 0 ? z0 : 0.f;
    if (M7) z2 = t < SEQ - 1 ? z2 : 0.f;
    return w0 * z0 + w1 * z1 + w2 * z2 + cb;
}
__device__ __forceinline__ float sconv_raw_m(int m, const Raw3& r, int t, float w0, float w1, float w2, float cb) {
    return m == 0 ? sconv_raw<true, false>(r, t, w0, w1, w2, cb) : (m == 7 ? sconv_raw<false, true>(r, t, w0, w1, w2, cb) : sconv_raw<false, false>(r, t, w0, w1, w2, cb));
}
HYFFT_HD int hy16_padi(int i) { return i + (i >> 4); }
HYFFT_HD int hy16_rev(int x) { return ((x & 15) << 8) | (x & 0xF0) | ((x >> 8) & 15); }
template <bool INV> HYFFT_HD void hy16_dft4(float& r0, float& i0, float& r1, float& i1, float& r2, float& i2, float& r3, float& i3) {
    const float e0r = r0 + r2, e0i = i0 + i2, e1r = r0 - r2, e1i = i0 - i2, o0r = r1 + r3, o0i = i1 + i3, dr = r1 - r3, di = i1 - i3;
    float o1r, o1i; if (!INV) { o1r = di; o1i = -dr; } else { o1r = -di; o1i = dr; }
    r0 = e0r + o0r; i0 = e0i + o0i; r1 = e1r + o1r; i1 = e1i + o1i; r2 = e0r - o0r; i2 = e0i - o0i; r3 = e1r - o1r; i3 = e1i - o1i;
}
template <bool INV> HYFFT_HD void hy16_cmulc(float& r, float& i, float cr, float ci) { if (INV) ci = -ci; const float x = r, y = i; r = x * cr - y * ci; i = x * ci + y * cr; }
template <bool INV> HYFFT_HD void hy16_dft16(float (&re)[16], float (&im)[16]) {
    const float c1 = 0.92387953251128674f, s1 = 0.38268343236508977f, h = 0.70710678118654752f;
#pragma unroll
    for (int m2 = 0; m2 < 4; ++m2) hy16_dft4<INV>(re[m2], im[m2], re[4 + m2], im[4 + m2], re[8 + m2], im[8 + m2], re[12 + m2], im[12 + m2]);
    hy16_cmulc<INV>(re[4 * 1 + 1], im[4 * 1 + 1], c1, -s1);
    hy16_cmulc<INV>(re[4 * 2 + 1], im[4 * 2 + 1], h, -h);
    hy16_cmulc<INV>(re[4 * 3 + 1], im[4 * 3 + 1], s1, -c1);
    hy16_cmulc<INV>(re[4 * 1 + 2], im[4 * 1 + 2], h, -h);
    hy16_cmulc<INV>(re[4 * 2 + 2], im[4 * 2 + 2], 0.f, -1.f);
    hy16_cmulc<INV>(re[4 * 3 + 2], im[4 * 3 + 2], -h, -h);
    hy16_cmulc<INV>(re[4 * 1 + 3], im[4 * 1 + 3], s1, -c1);
    hy16_cmulc<INV>(re[4 * 2 + 3], im[4 * 2 + 3], -h, -h);
    hy16_cmulc<INV>(re[4 * 3 + 3], im[4 * 3 + 3], -c1, s1);
#pragma unroll
    for (int k1 = 0; k1 < 4; ++k1) hy16_dft4<INV>(re[4 * k1], im[4 * k1], re[4 * k1 + 1], im[4 * k1 + 1], re[4 * k1 + 2], im[4 * k1 + 2], re[4 * k1 + 3], im[4 * k1 + 3]);
#pragma unroll
    for (int a = 0; a < 4; ++a)
#pragma unroll
        for (int b = a + 1; b < 4; ++b) { float t = re[4 * a + b]; re[4 * a + b] = re[4 * b + a]; re[4 * b + a] = t; t = im[4 * a + b]; im[4 * a + b] = im[4 * b + a]; im[4 * b + a] = t; }
}
template <bool CONJ> HYFFT_HD void hy16_twiddle(float (&re)[16], float (&im)[16], float wr, float wi) {
    if (CONJ) wi = -wi;
    float pr[16], pi[16]; pr[1] = wr; pi[1] = wi;
#define HY16_SQ(d, a) pr[d] = pr[a] * pr[a] - pi[a] * pi[a]; pi[d] = 2.f * pr[a] * pi[a];
#define HY16_MUL(d, a, b) pr[d] = pr[a] * pr[b] - pi[a] * pi[b]; pi[d] = pr[a] * pi[b] + pi[a] * pr[b];
    HY16_SQ(2, 1) HY16_MUL(3, 2, 1) HY16_SQ(4, 2) HY16_MUL(5, 4, 1) HY16_SQ(6, 3) HY16_MUL(7, 4, 3) HY16_SQ(8, 4)
    HY16_MUL(9, 8, 1) HY16_SQ(10, 5) HY16_MUL(11, 8, 3) HY16_SQ(12, 6) HY16_MUL(13, 8, 5) HY16_SQ(14, 7) HY16_MUL(15, 8, 7)
#undef HY16_SQ
#undef HY16_MUL
#pragma unroll
    for (int k = 1; k < 16; ++k) { const float x = re[k], y = im[k]; re[k] = x * pr[k] - y * pi[k]; im[k] = x * pi[k] + y * pr[k]; }
}
template <int L, class BP> HYFFT_HD void hy16_load(BP buf, int jj, float (&re)[16], float (&im)[16]) {
    constexpr int S = L / 16; const int blk = jj / S, q = jj % S, pb = hy16_padi(blk * L + q);
#pragma unroll
    for (int k = 0; k < 16; ++k) { const hy_c32 v = buf[pb + k * (S + S / 16)]; re[k] = v.x; im[k] = v.y; }
}
template <class BP> HYFFT_HD void hy16_load1(BP buf, int jj, float (&re)[16], float (&im)[16]) {
#pragma unroll
    for (int k = 0; k < 16; ++k) { const hy_c32 v = buf[17 * jj + k]; re[k] = v.x; im[k] = v.y; }
}
template <int L, class BP> HYFFT_HD void hy16_store(BP buf, int jj, const float (&re)[16], const float (&im)[16]) {
    constexpr int S = L / 16; const int blk = jj / S, q = jj % S, pb = hy16_padi(blk * L + q);
#pragma unroll
    for (int k = 0; k < 16; ++k) buf[pb + k * (S + S / 16)] = (hy_c32){re[k], im[k]};
}
template <class BP> HYFFT_HD void hy16_store1(BP buf, int jj, const float (&re)[16], const float (&im)[16]) {
#pragma unroll
    for (int k = 0; k < 16; ++k) buf[17 * jj + k] = (hy_c32){re[k], im[k]};
}
template <int L, class BP, class TP> HYFFT_HD void hy16_fwd_store(BP buf, TP tw, int jj, float (&re)[16], float (&im)[16]) {
    constexpr int S = L / 16; const int q = jj % S;
    hy16_dft16<false>(re, im);
    { const hy_c32 w = tw[q * (4096 / L)]; hy16_twiddle<false>(re, im, w.x, w.y); }
    hy16_store<L>(buf, jj, re, im);
}
template <int L, class BP, class TP> HYFFT_HD void hy16_fwd_stage(BP buf, TP tw, int jj) { float re[16], im[16]; hy16_load<L>(buf, jj, re, im); hy16_fwd_store<L>(buf, tw, jj, re, im); }
template <int L, class BP, class TP> HYFFT_HD void hy16_inv_regs(BP buf, TP tw, int jj, float (&re)[16], float (&im)[16]) {
    constexpr int S = L / 16; const int q = jj % S;
    hy16_load<L>(buf, jj, re, im);
    { const hy_c32 w = tw[q * (4096 / L)]; hy16_twiddle<true>(re, im, w.x, w.y); }
    hy16_dft16<true>(re, im);
}
template <int L, class BP, class TP> HYFFT_HD void hy16_inv_stage(BP buf, TP tw, int jj) { float re[16], im[16]; hy16_inv_regs<L>(buf, tw, jj, re, im); hy16_store<L>(buf, jj, re, im); }
template <class BP, class KP> HYFFT_HD void hy16_mid_stage(BP buf, KP K, int jj) {
    float re[16], im[16]; hy16_load1(buf, jj, re, im);
    hy16_dft16<false>(re, im);
#pragma unroll
    for (int k = 0; k < 16; ++k) { const hy_c32 kv = K[17 * jj + k]; const float x = re[k], y = im[k]; re[k] = x * kv.x - y * kv.y; im[k] = x * kv.y + y * kv.x; }
    hy16_dft16<true>(re, im);
    hy16_store1(buf, jj, re, im);
}
template <class BP> HYFFT_HD void hy16_last_fwd(BP buf, int jj) { float re[16], im[16]; hy16_load1(buf, jj, re, im); hy16_dft16<false>(re, im); hy16_store1(buf, jj, re, im); }
template <class BP, class KP> HYFFT_HD void hy16_separate(BP Z, KP K1, KP K2, int t) {
    const float sc = 0.5f / 4096.0f;
#pragma unroll
    for (int r = 0; r < 8; ++r) {
        const int p = t + 512 * r, f = hy16_rev(p), g = (4096 - f) & 4095, p2 = hy16_rev(g);
        const hy_c32 a = Z[hy16_padi(p)], b = Z[hy16_padi(p2)];
        K1[hy16_padi(p)] = (hy_c32){(a.x + b.x) * sc, (a.y - b.y) * sc};
        K2[hy16_padi(p)] = (hy_c32){(a.y + b.y) * sc, (b.x - a.x) * sc};
    }
}
__device__ __forceinline__ void p3_hyena_fft(Frame& F) {
    const int tid0 = F.tid;
    const int half = __builtin_amdgcn_readfirstlane(tid0 >> 8);
    LAS hy_c32* BUF = (LAS hy_c32*)(F.lds + half * 34816);
    LAS hy_c32* B0 = (LAS hy_c32*)(F.lds + 0);
    LAS hy_c32* K1 = (LAS hy_c32*)(F.lds + 69632); LAS hy_c32* K2 = (LAS hy_c32*)(F.lds + 104448); LAS hy_c32* TW = (LAS hy_c32*)(F.lds + 139264);
    const bf16* ZHT = (const bf16*)(F.ws + WS_ZHT); const float* FILT = (const float*)(F.ws + WS_FILT); bf16* YT = (bf16*)(F.ws + WS_YT);
    const float* cw = F.in[I_HCW]; const float* cb = F.in[I_HCB]; const float* skip = F.in[I_HSKIP];
    if (tid0 < 256) { float sn, cs; sincosf(-6.283185307179586f * (float)tid0 / 4096.0f, &sn, &cs); TW[tid0] = (hy_c32){cs, sn}; }
    __syncthreads();
    for (int item = blockIdx.x; item < HYW; item += F.G) {
        const int c = item;
        int tid = tid0; asm volatile("" : "+v"(tid));
        int jj = tid & 255;
        float re[16], im[16];
        const bf16* zv = ZHT + (size_t)c * MTOK; const bf16* za = ZHT + (size_t)(1024 + c) * MTOK; const bf16* zb = ZHT + (size_t)(2048 + c) * MTOK;
        {
            if (half == 0) {
                const float* hf0 = FILT + (size_t)(0 * 1024 + c) * SEQ; const float* hf1 = FILT + (size_t)(1 * 1024 + c) * SEQ;
                const float* hb0 = FILT + (size_t)(2 * 1024 + c) * SEQ; const float* hb1 = FILT + (size_t)(3 * 1024 + c) * SEQ;
#pragma unroll
                for (int m = 0; m < 8; ++m) { const int i = jj + 256 * m; re[m] = hf0[i]; im[m] = hf1[i]; }
                if (jj == 0) { re[0] += hb0[0]; im[0] += hb1[0]; }
#pragma unroll
                for (int m = 8; m < 16; ++m) { const int i = jj + 256 * m; const bool z = (i == 2048); const int r = z ? 0 : 4096 - i; const float a = hb0[r], b = hb1[r]; re[m] = z ? 0.f : a; im[m] = z ? 0.f : b; }
                hy16_fwd_store<4096>(B0, TW, jj, re, im);
            }
            __syncthreads();
            if (half == 0) hy16_fwd_stage<256>(B0, TW, jj);
            __syncthreads();
            if (half == 0) hy16_last_fwd(B0, jj);
            __syncthreads();
            hy16_separate(B0, K1, K2, tid); __syncthreads();
        }
        const float vw0 = cw[c], vw1 = cw[3072 + c], vw2 = cw[6144 + c], vcb = cb[c];
        const float aw0 = cw[1024 + c], aw1 = cw[3072 + 1024 + c], aw2 = cw[6144 + 1024 + c], acb = cb[1024 + c];
        const float bw0 = cw[2048 + c], bw1 = cw[3072 + 2048 + c], bw2 = cw[6144 + 2048 + c], bcb = cb[2048 + c];
        const float sk0 = skip[c], sk1 = skip[1024 + c];
#pragma unroll 1
        for (int rd = 0; rd < 2; ++rd) {
            const int boff = (4 * rd + 2 * half) * SEQ;
            asm volatile("" : "+v"(jj));
            Raw3 rg[2][8];
            float v[2][8];
#pragma unroll
            for (int m = 0; m < 8; ++m) { const int t = jj + 256 * m;
                const Raw3 r0 = raw3(zv + boff, t), r1 = raw3(zv + boff + SEQ, t); v[0][m] = sconv_raw_m(m, r0, t, vw0, vw1, vw2, vcb); v[1][m] = sconv_raw_m(m, r1, t, vw0, vw1, vw2, vcb); }
#pragma unroll
            for (int m = 0; m < 8; ++m) { re[m] = v[0][m]; im[m] = v[1][m]; re[m + 8] = 0.f; im[m + 8] = 0.f; }
            hy16_fwd_store<4096>(BUF, TW, jj, re, im); __syncthreads();
            hy16_fwd_stage<256>(BUF, TW, jj); __syncthreads();
            hy16_mid_stage(BUF, K1, jj); __syncthreads();
#pragma unroll
            for (int m = 0; m < 8; ++m) { const int t = jj + 256 * m; rg[0][m] = raw3(za + boff, t); rg[1][m] = raw3(za + boff + SEQ, t); }
            hy16_inv_stage<256>(BUF, TW, jj); __syncthreads();
            hy16_inv_regs<4096>(BUF, TW, jj, re, im);
#pragma unroll
            for (int m = 0; m < 8; ++m) { const int t = jj + 256 * m;
                v[0][m] = sconv_raw_m(m, rg[0][m], t, aw0, aw1, aw2, acb) * (re[m] + sk0 * v[0][m]); v[1][m] = sconv_raw_m(m, rg[1][m], t, aw0, aw1, aw2, acb) * (im[m] + sk0 * v[1][m]); }
#pragma unroll
            for (int m = 0; m < 8; ++m) { re[m] = v[0][m]; im[m] = v[1][m]; re[m + 8] = 0.f; im[m + 8] = 0.f; }
            hy16_fwd_store<4096>(BUF, TW, jj, re, im); __syncthreads();
            hy16_fwd_stage<256>(BUF, TW, jj); __syncthreads();
            hy16_mid_stage(BUF, K2, jj); __syncthreads();
#pragma unroll
            for (int m = 0; m < 8; ++m) { const int t = jj + 256 * m; rg[0][m] = raw3(zb + boff, t); rg[1][m] = raw3(zb + boff + SEQ, t); }
            hy16_inv_stage<256>(BUF, TW, jj); __syncthreads();
            hy16_inv_regs<4096>(BUF, TW, jj, re, im);
#pragma unroll
            for (int m = 0; m < 8; ++m) { const int t = jj + 256 * m; bf16* yp = YT + (size_t)c * MTOK + boff + t;
                yp[0] = (bf16)f2bf(sconv_raw_m(m, rg[0][m], t, bw0, bw1, bw2, bcb) * (re[m] + sk1 * v[0][m]));
                yp[SEQ] = (bf16)f2bf(sconv_raw_m(m, rg[1][m], t, bw0, bw1, bw2, bcb) * (im[m] + sk1 * v[1][m])); }
        }
        __syncthreads();
    }
}

__device__ __forceinline__ void p3c_transpose(Frame& F) {
    LAS unsigned* tile = (LAS unsigned*)F.lds;
    const bf16* YT = (const bf16*)(F.ws + WS_YT); bf16* AB = (bf16*)(F.ws + WS_H);
    const int tid = F.tid;
    for (int it = blockIdx.x; it < MTOK / 64; it += F.G) {
        const int t0 = it * 64;
        { const int rr = tid >> 3, seg = tid & 7;
          v4u w[16];
#pragma unroll
          for (int i = 0; i < 16; ++i) w[i] = *(const v4u*)(YT + (size_t)(i * 64 + rr) * MTOK + t0 + seg * 8);
#pragma unroll
          for (int i = 0; i < 16; ++i) { const int c = i * 64 + rr, rot = (c >> 3) + (c & 3); LAS unsigned* row = tile + c * 32;
              row[(seg * 4 + 0 + rot) & 31] = w[i].x; row[(seg * 4 + 1 + rot) & 31] = w[i].y; row[(seg * 4 + 2 + rot) & 31] = w[i].z; row[(seg * 4 + 3 + rot) & 31] = w[i].w; } }
        __syncthreads();
#pragma unroll 2
        for (int k = 0; k < 8; ++k) { const int j = tid + 512 * k, tp = j >> 7, cseg = j & 127;
            unsigned d[8];
#pragma unroll
            for (int e = 0; e < 8; ++e) d[e] = tile[(8 * cseg + e) * 32 + ((tp + cseg + (e & 3)) & 31)];
            v4u lo, hi;
            lo.x = (d[0] & 0xffffu) | (d[1] << 16); lo.y = (d[2] & 0xffffu) | (d[3] << 16); lo.z = (d[4] & 0xffffu) | (d[5] << 16); lo.w = (d[6] & 0xffffu) | (d[7] << 16);
            hi.x = (d[0] >> 16) | (d[1] & 0xffff0000u); hi.y = (d[2] >> 16) | (d[3] & 0xffff0000u); hi.z = (d[4] >> 16) | (d[5] & 0xffff0000u); hi.w = (d[6] >> 16) | (d[7] & 0xffff0000u);
            bf16* dst = AB + (size_t)(t0 + 2 * tp) * DM + 1024 + 8 * cseg;
            *(v4u*)dst = lo; *(v4u*)(dst + DM) = hi; }
        __syncthreads();
    }
}

typedef _Float16 ln_f16x4 __attribute__((ext_vector_type(4)));
template <bool FINAL> __device__ __forceinline__ void ln_rows(Frame& F) {
    const _Float16* R = FINAL ? (const _Float16*)(F.ws + WS_H) : (const _Float16*)F.out;
    const float* st = (const float*)(F.ws + (FINAL ? WS_ST2 : WS_ST1)); float* MU = (float*)(F.ws + WS_MU1);
    const float* mod = (const float*)(F.ws + WS_MOD); bf16* H2 = (bf16*)(F.ws + WS_H);
    const float* lng = F.in[FINAL ? I_LN2G : I_LN1G]; const float* lnb = F.in[FINAL ? I_LN2B : I_LN1B];
    const int gw = blockIdx.x * NWAVES + F.wave, NGW = F.G * NWAVES, lane = F.lane;
    ln_f16x4 cur[8], nxt[8]; f32x2 ps = (f32x2){0.f, 0.f}, pn = (f32x2){0.f, 0.f};
    int row = gw;
    if (row < MTOK) {
#pragma unroll
        for (int j = 0; j < 8; ++j) cur[j] = *(const ln_f16x4*)(R + (size_t)row * DM + 4 * lane + 256 * j);
        if (lane < 32) ps = *(const f32x2*)(st + ((size_t)row * 32 + lane) * 2);
    }
    for (; row < MTOK; row += NGW) {
        const int rn = row + NGW;
        if (rn < MTOK) {
#pragma unroll
            for (int j = 0; j < 8; ++j) nxt[j] = *(const ln_f16x4*)(R + (size_t)rn * DM + 4 * lane + 256 * j);
            pn = (f32x2){0.f, 0.f}; if (lane < 32) pn = *(const f32x2*)(st + ((size_t)rn * 32 + lane) * 2);
        }
        const float s = wave_sum(ps.x), q = wave_sum(ps.y);
        const float mean = s * (1.0f / DM); float var = q * (1.0f / DM) - mean * mean; var = var > 0.f ? var : 0.f; const float rstd = 1.0f / sqrtf(var + LN_EPS);
        if (!FINAL && lane == 0) *(f32x2*)(MU + (size_t)row * 2) = (f32x2){mean, rstd};
        const int b = row >> 11;
#pragma unroll
        for (int j = 0; j < 8; ++j) { const int col = 4 * lane + 256 * j;
            const f32x4 v = (f32x4){(float)cur[j][0], (float)cur[j][1], (float)cur[j][2], (float)cur[j][3]};
            const f32x4 y = (v - mean) * rstd * *(const f32x4*)(lng + col) + *(const f32x4*)(lnb + col);
            if (FINAL) *(f32x4*)(F.out + (size_t)row * DM + col) = y;
            else { const float* mp = mod + (size_t)b * MODW + col; const f32x4 h = y * (*(const f32x4*)(mp + 4 * DM) + 1.0f) + *(const f32x4*)(mp + 3 * DM);
                   v2u o; o.x = pk2(h[0], h[1]); o.y = pk2(h[2], h[3]); *(v2u*)(H2 + (size_t)row * DM + col) = o; } }
#pragma unroll
        for (int j = 0; j < 8; ++j) cur[j] = nxt[j];
        ps = pn;
    }
}

typedef GAS unsigned gu32;
#define RLX_AGENT __ATOMIC_RELAXED, __HIP_MEMORY_SCOPE_AGENT
constexpr int LDSCTL_OFF = 163840 - 512, MISC_OFF = LDSCTL_OFF;
constexpr int CW_BAR = 4096;
constexpr size_t CTL_ZERO_BYTES = 65536;
#define XB_TMO      128
#define XB_XCNT(j)  (256  + 64 * (j))
#define XB_XSUB(j)  (1280 + 64 * (j))
#define XB_XGEN(j)  (2304 + 64 * (j))
#define XB_TOP      3328
#define XB_TOPGEN   3392
#define XCD_BAR_WORDS 3456
#define XB_SPIN_CAP (1u << 18)

__device__ __forceinline__ unsigned xb_ld(unsigned* p)              { return __hip_atomic_load(p, __ATOMIC_RELAXED, __HIP_MEMORY_SCOPE_AGENT); }
__device__ __forceinline__ unsigned xb_add(unsigned* p, unsigned v) { return __hip_atomic_fetch_add(p, v, __ATOMIC_RELAXED, __HIP_MEMORY_SCOPE_AGENT); }
__device__ __forceinline__ unsigned xb_xcc_id() { return (unsigned)__builtin_amdgcn_s_getreg((3 << 11) | 20) & 0xFu; }
#define XB_SPIN(cond, bar) do { unsigned _sp = 0; while (cond) { __builtin_amdgcn_s_sleep(1); \
    if ((++_sp & 255u) == 0u) { if (xb_ld(&(bar)[XB_TMO])) break; if (_sp > XB_SPIN_CAP) { atomicAdd(&(bar)[XB_TMO], 1u); break; } } } } while (0)

struct XcdBarrier {
    unsigned* bar; unsigned x;
    volatile LAS unsigned* st;
};

__device__ __forceinline__ XcdBarrier xcd_barrier_post(unsigned* bar, volatile LAS unsigned* st) {
    XcdBarrier b; b.bar = bar; b.x = xb_xcc_id(); b.st = st;
    if (threadIdx.x == 0) (void)xb_add(&bar[XB_XCNT(b.x)], 1u);
    return b;
}
__device__ __forceinline__ void xcd_barrier_complete(unsigned* bar, unsigned x, unsigned& nloc, unsigned& nx) {
    const unsigned G = gridDim.x * gridDim.y * gridDim.z;
    unsigned sum, cnt, mine, sp = 0u;
    for (;;) {
        sum = 0u; cnt = 0u; mine = 0u;
#pragma unroll
        for (unsigned j = 0; j < 16; ++j) { const unsigned c = xb_ld(&bar[XB_XCNT(j)]); sum += c; cnt += (c > 0u) ? 1u : 0u; mine = (j == x) ? c : mine; }
        if (sum == G) break;
        __builtin_amdgcn_s_sleep(1);
        if ((++sp & 255u) == 0u) { if (xb_ld(&bar[XB_TMO])) break; if (sp > XB_SPIN_CAP) { atomicAdd(&bar[XB_TMO], 1u); break; } }
    }
    nloc = mine > 0u ? mine : 1u; nx = cnt > 0u ? cnt : 1u;
}

__device__ __forceinline__ void xcd_barrier(const XcdBarrier& b) {
    asm volatile("s_waitcnt vmcnt(0)" ::: "memory");
    __syncthreads();
    if (threadIdx.x == 0) {
        unsigned* bar = b.bar;
        __builtin_amdgcn_s_waitcnt(0);
        unsigned nloc = b.st[0], nx = b.st[1];
        if (nloc == 0u) { xcd_barrier_complete(bar, b.x, nloc, nx); b.st[0] = nloc; b.st[1] = nx; }
        const unsigned old = xb_add(&bar[XB_XSUB(b.x)], 1u);
        const unsigned gen = old / nloc;
        if (old + 1u == (gen + 1u) * nloc) {
            __builtin_amdgcn_fence(__ATOMIC_RELEASE, "agent");
            asm volatile("s_waitcnt vmcnt(0)" ::: "memory");
            const unsigned og = xb_add(&bar[XB_TOP], 1u);
            const unsigned tg = og / nx;
            if (og + 1u == (tg + 1u) * nx) xb_add(&bar[XB_TOPGEN], 1u);
            else XB_SPIN(xb_ld(&bar[XB_TOPGEN]) == tg, bar);
            __builtin_amdgcn_fence(__ATOMIC_ACQUIRE, "agent");
            xb_add(&bar[XB_XGEN(b.x)], 1u);
            asm volatile("s_waitcnt vmcnt(0)" ::: "memory");
        } else {
            XB_SPIN(xb_ld(&bar[XB_XGEN(b.x)]) == gen, bar);
            __builtin_amdgcn_fence(__ATOMIC_ACQUIRE, "agent");
            asm volatile("s_waitcnt vmcnt(0)" ::: "memory");
        }
    }
    __syncthreads();
}

#define GRID_SYNC() xcd_barrier(bar)

__global__ void __launch_bounds__(NWAVES * 64, 2) fwd_megakernel(Args args) {
    extern __shared__ __attribute__((aligned(16))) unsigned char lds[];
    Frame F;
    F.lds = (LAS unsigned char*)lds;
    F.tid = threadIdx.x; F.lane = F.tid & 63; F.wave = __builtin_amdgcn_readfirstlane(F.tid >> 6); F.G = gridDim.x;
    F.in = args.in; F.out = args.out; F.ws = args.ws;
    for (int u = F.tid; u < (LDS_BYTES - LDSCTL_OFF) / 4; u += NWAVES * 64) ((LAS unsigned*)(F.lds + LDSCTL_OFF))[u] = 0u;
    __syncthreads();
    XcdBarrier bar = xcd_barrier_post((unsigned*)(args.ws + WS_CTL) + CW_BAR, (volatile LAS unsigned*)(F.lds + MISC_OFF) + 8);
    unsigned char* ws = args.ws;
    const int lo = args.ph_lo, hi = args.ph_hi;
#define IN(k) (lo <= (k) && (k) < hi)
#define BOTH(k) (IN(k) && IN((k) + 1))
    const int gw = blockIdx.x * NWAVES + F.wave, NGW = F.G * NWAVES;

    PB_START(1, F.lds);
    if (IN(0)) { { int t_ = threadIdx.x; asm volatile("" : "+v"(t_)); F.tid = t_; F.lane = t_ & 63; }
        PB_START(21, F.lds); p0_mod(F); PB_END(21, F.lds);
        PB_START(22, F.lds);
        transpose_matrix(F, F.in[I_WIN], DM, INW, (bf16*)(ws + WS_WIN), DM, 0, 1, (int)blockIdx.x, F.G);
        transpose_matrix(F, F.in[I_WA], SGUW, DM, (bf16*)(ws + WS_WAB), DM, 0, 0, (int)((blockIdx.x + 128) % F.G), F.G);
        transpose_matrix(F, F.in[I_WB], HYW, DM, (bf16*)(ws + WS_WAB), DM, 1024, 0, (int)blockIdx.x, F.G);
        transpose_matrix(F, F.in[I_WO], DM, DM, (bf16*)(ws + WS_WO), DM, 0, 0, (int)blockIdx.x, F.G);
        { const float* sw = F.in[I_SW]; bf16* sgw = (bf16*)(ws + WS_SGW);
          for (int i = blockIdx.x * (NWAVES * 64) + F.tid; i < 8 * 128 * 128 / 2; i += F.G * NWAVES * 64) { const f32x2 v = *(const f32x2*)(sw + 2 * i); *(unsigned*)(sgw + 2 * i) = pk2(v.x, v.y); } }
        __syncthreads();
        __syncthreads(); p0_hid2(F);
        PB_END(22, F.lds);
        if (BOTH(0)) GRID_SYNC();
    }
    PB_END(1, F.lds);
    PB_START(2, F.lds);
    if (IN(1)) { { int t_ = threadIdx.x; asm volatile("" : "+v"(t_)); F.tid = t_; F.lane = t_ & 63; } if (F.wave < 4) p1_modulate(F); else p1_filter_waves(F); if (BOTH(1)) GRID_SYNC(); }
    PB_END(2, F.lds);
    PB_START(3, F.lds);
    if (IN(2)) { { int t_ = threadIdx.x; asm volatile("" : "+v"(t_)); F.tid = t_; F.lane = t_ & 63; }
        { pg8::Gemm g{(const pg8::bf16_t*)(ws + WS_H), (const pg8::bf16_t*)(ws + WS_WIN), MTOK, 5120, DM}; pg8::StaticOrder S; S.init(MTOK, 5120, F.G, (int)blockIdx.x);
          pg8::EpiG1 E{(pg8::bf16_t*)(ws + WS_U), (pg8::bf16_t*)(ws + WS_G), F.in[I_BIN]};
          pg8::gemm_phase<pg8::EpiG1, pg8::StaticOrder, true, true>(F.lds, g, S, E); }
        __syncthreads();
        { pg8::Gemm g{(const pg8::bf16_t*)(ws + WS_WIN) + (size_t)5120 * DM, (const pg8::bf16_t*)(ws + WS_H), 4096, MTOK, DM}; pg8::StaticOrder S; S.init(4096, MTOK, F.G, (int)blockIdx.x);
          pg8::EpiG1T E{(pg8::bf16_t*)(ws + WS_V), (pg8::bf16_t*)(ws + WS_ZHT), F.in[I_BIN], (float*)(ws + WS_STV)};
          pg8::gemm_phase<pg8::EpiG1T, pg8::StaticOrder, true, true>(F.lds, g, S, E); }
        if (BOTH(2)) GRID_SYNC();
    }
    PB_END(3, F.lds);
    PB_START(4, F.lds);
    if (IN(3)) { { int t_ = threadIdx.x; asm volatile("" : "+v"(t_)); F.tid = t_; F.lane = t_ & 63; } __syncthreads(); PB_START(41, F.lds); p3_sgu(F); PB_END(41, F.lds); PB_START(42, F.lds); p3_hyena_fft(F); PB_END(42, F.lds); if (BOTH(3)) GRID_SYNC(); PB_START(43, F.lds); p3c_transpose(F); GRID_SYNC(); PB_END(43, F.lds); }
    PB_END(4, F.lds);
    PB_START(5, F.lds);
    if (IN(4)) { { int t_ = threadIdx.x; asm volatile("" : "+v"(t_)); F.tid = t_; F.lane = t_ & 63; }
        pg8::Gemm g{(const pg8::bf16_t*)(ws + WS_H), (const pg8::bf16_t*)(ws + WS_WAB), MTOK, DM, DM}; pg8::StaticOrder S; S.init(MTOK, DM, F.G, (int)blockIdx.x);
        pg8::EpiG2 E{(const pg8::bf16_t*)(ws + WS_G), (pg8::bf16_t*)(ws + WS_MERGED)};
        pg8::gemm_phase<pg8::EpiG2, pg8::StaticOrder, true, true>(F.lds, g, S, E);
        if (BOTH(4)) GRID_SYNC();
    }
    PB_END(5, F.lds);
    PB_START(6, F.lds);
    if (IN(5)) { { int t_ = threadIdx.x; asm volatile("" : "+v"(t_)); F.tid = t_; F.lane = t_ & 63; }
        pg8::Gemm g{(const pg8::bf16_t*)(ws + WS_MERGED), (const pg8::bf16_t*)(ws + WS_WO), MTOK, DM, DM}; pg8::StaticOrder S; S.init(MTOK, DM, F.G, (int)blockIdx.x);
        pg8::EpiRes<true> E{F.in[I_X], nullptr, (_Float16*)F.out, (const float*)(ws + WS_MOD) + 2 * DM, F.in[I_BO], nullptr, nullptr, nullptr, (float*)(ws + WS_ST1)};
        pg8::gemm_phase<pg8::EpiRes<true>, pg8::StaticOrder, true, true>(F.lds, g, S, E);
        if (BOTH(5)) GRID_SYNC();
    }
    PB_END(6, F.lds);
    PB_START(7, F.lds);
    if (IN(6)) { { int t_ = threadIdx.x; asm volatile("" : "+v"(t_)); F.tid = t_; F.lane = t_ & 63; }
        __syncthreads();
        ln_rows<false>(F);
        __syncthreads();
        transpose_matrix(F, F.in[I_WM1], DM, DFF, (bf16*)(ws + WS_WM1), DM, 0, 0, (int)blockIdx.x, F.G);
        transpose_matrix(F, F.in[I_WM2], DFF, DM, (bf16*)(ws + WS_WM2), DFF, 0, 0, (int)blockIdx.x, F.G);
        if (BOTH(6)) GRID_SYNC();
    }
    PB_END(7, F.lds);
    PB_START(8, F.lds);
    if (IN(7)) { { int t_ = threadIdx.x; asm volatile("" : "+v"(t_)); F.tid = t_; F.lane = t_ & 63; }
        __syncthreads();
        pg8::Gemm g{(const pg8::bf16_t*)(ws + WS_H), (const pg8::bf16_t*)(ws + WS_WM1), MTOK, DFF, DM}; pg8::StaticOrder S; S.init(MTOK, DFF, F.G, (int)blockIdx.x);
        pg8::EpiG4 E{(pg8::bf16_t*)(ws + WS_AFF), F.in[I_BM1]};
        pg8::gemm_phase<pg8::EpiG4, pg8::StaticOrder, true, true>(F.lds, g, S, E);
        if (BOTH(7)) GRID_SYNC();
    }
    PB_END(8, F.lds);
    PB_START(9, F.lds);
    if (IN(8)) { { int t_ = threadIdx.x; asm volatile("" : "+v"(t_)); F.tid = t_; F.lane = t_ & 63; }
        pg8::Gemm g{(const pg8::bf16_t*)(ws + WS_AFF), (const pg8::bf16_t*)(ws + WS_WM2), MTOK, DM, DFF}; pg8::StaticOrder S; S.init(MTOK, DM, F.G, (int)blockIdx.x);
        pg8::EpiRes<false> E{nullptr, (const _Float16*)F.out, (_Float16*)(ws + WS_H), (const float*)(ws + WS_MOD) + 5 * DM, F.in[I_BM2], F.in[I_LN1G], F.in[I_LN1B], (const float*)(ws + WS_MU1), (float*)(ws + WS_ST2)};
        pg8::gemm_phase<pg8::EpiRes<false>, pg8::StaticOrder, true, true>(F.lds, g, S, E);
        if (BOTH(8)) GRID_SYNC();
    }
    PB_END(9, F.lds);
    PB_START(10, F.lds);
    if (IN(9)) { { int t_ = threadIdx.x; asm volatile("" : "+v"(t_)); F.tid = t_; F.lane = t_ & 63; } ln_rows<true>(F); }
    PB_END(10, F.lds);
    if (PROBE_ID != 0 && blockIdx.x == 0 && threadIdx.x == 0) { const unsigned long long wait_ = *(volatile LAS unsigned long long*)(F.lds + PB_LDS_OFF), t0_ = __builtin_amdgcn_s_memrealtime();
        while (__builtin_amdgcn_s_memrealtime() - t0_ < wait_) __builtin_amdgcn_s_sleep(8); }
#undef IN
#undef BOTH
}

constexpr int N_PHASES = 10;
#ifndef MK_N_LAUNCHES
#define MK_N_LAUNCHES 1
#endif
extern "C" void kernel_launch(void* const* d_in, const int* in_sizes, int n_in, void* d_out, int out_size, void* d_ws, size_t ws_size, hipStream_t stream) {
    static int grid = 0;
    if (grid == 0) {
        if (n_in != 31 || in_sizes[0] != MTOK * DM || out_size != MTOK * DM || ws_size < WS_END) {
            fprintf(stderr, "kernel_launch: unexpected problem: n_in %d in0 %d out %d ws %zu (need %zu)\n", n_in, n_in > 0 ? in_sizes[0] : -1, out_size, ws_size, (size_t)WS_END); grid = -1; return; }
        int dev = 0, cus = 0, per_cu = 0;
        if (hipGetDevice(&dev) != hipSuccess || hipDeviceGetAttribute(&cus, hipDeviceAttributeMultiprocessorCount, dev) != hipSuccess) { grid = -1; return; }
        if (hipFuncSetAttribute((const void*)fwd_megakernel, hipFuncAttributeMaxDynamicSharedMemorySize, LDS_BYTES) != hipSuccess) { fprintf(stderr, "kernel_launch: hipFuncSetAttribute failed\n"); grid = -1; return; }
        if (hipOccupancyMaxActiveBlocksPerMultiprocessor(&per_cu, (const void*)fwd_megakernel, NWAVES * 64, LDS_BYTES) != hipSuccess || per_cu < 1) { fprintf(stderr, "kernel_launch: occupancy query says %d\n", per_cu); per_cu = 1; }
        (void)hipGetLastError();
        grid = cus;
    }
    if (grid < 0) return;
    if (hipMemsetAsync((char*)d_ws + WS_CTL, 0, CTL_ZERO_BYTES, stream) != hipSuccess) { fprintf(stderr, "kernel_launch: memset failed\n"); return; }
    Args a{};
    for (int i = 0; i < 31; ++i) a.in[i] = (const float*)d_in[i];
    a.out = (float*)d_out; a.ws = (unsigned char*)d_ws;
    if (MK_N_LAUNCHES == 1) {
        a.ph_lo = 0; a.ph_hi = N_PHASES;
        void* kargs[] = {&a};
        hipError_t e = hipLaunchCooperativeKernel((const void*)fwd_megakernel, dim3(grid), dim3(NWAVES * 64), kargs, LDS_BYTES, stream);
        if (e != hipSuccess) fprintf(stderr, "kernel_launch: cooperative launch failed: %s (grid %d)\n", hipGetErrorString(e), grid);
    } else {
        for (int p = 0; p < N_PHASES; ++p) { a.ph_lo = p; a.ph_hi = p + 1; hipLaunchKernelGGL(fwd_megakernel, dim3(grid), dim3(NWAVES * 64), LDS_BYTES, stream, a); }
    }
}
```

```cpp
#include <hip/hip_runtime.h>
#include <cstdio>
#include <cstdint>

#ifndef WGM_P2A
#define WGM_P2A 4
#endif
#ifndef WGM_P2B
#define WGM_P2B 4
#endif
#ifndef WGM_P4
#define WGM_P4 4
#endif
#ifndef WGM_P5
#define WGM_P5 4
#endif
#ifndef WGM_P7
#define WGM_P7 4
#endif
#ifndef WGM_P8
#define WGM_P8 4
#endif
#ifndef PROBE_ID
#define PROBE_ID 0
#endif
#define PB_LDS_OFF (163840 - 512 + 128)
#define PB_START(id, ldsp) do { if (PROBE_ID == (id) && blockIdx.x == 0 && threadIdx.x == 0) { *(volatile __attribute__((address_space(3))) unsigned long long*)((ldsp) + PB_LDS_OFF + 8) = __builtin_amdgcn_s_memrealtime(); } } while (0)
#define PB_END(id, ldsp) do { if (PROBE_ID == (id) && blockIdx.x == 0 && threadIdx.x == 0) { volatile __attribute__((address_space(3))) unsigned long long* pb_ = (volatile __attribute__((address_space(3))) unsigned long long*)((ldsp) + PB_LDS_OFF); pb_[0] += __builtin_amdgcn_s_memrealtime() - pb_[1]; } } while (0)
namespace pg8 {
#define PG8_LAS __attribute__((address_space(3)))
typedef unsigned short bf16_t;
typedef short bf16x8 __attribute__((ext_vector_type(8)));
typedef float f32x4 __attribute__((ext_vector_type(4)));
typedef unsigned u32x4 __attribute__((ext_vector_type(4)));
typedef float f32x2 __attribute__((ext_vector_type(2)));
constexpr int EPI_LDS_OFF = 131072;
constexpr int BM = 256, BK = 64, HALF = 128, HTB = HALF * BK * 2  , STAGE_BYTES = 8 * HTB, NXCD = 8, WGM = 8;

__host__ __device__ __forceinline__ int lds_byte(int r, int c) { const int st = (r >> 4) * 2 + (c >> 5), rr = r & 15, cc = c & 31, ob = rr * 64 + cc * 2; return st * 1024 + (ob ^ (((ob >> 9) & 1) << 5)); }
__host__ __device__ __forceinline__ void stage_rc(int b, int& R, int& C) { const int st = b / 1024, sb = b % 1024, swz = sb ^ (((sb >> 9) & 1) << 5); R = (st >> 1) * 16 + swz / 64; C = (st & 1) * 32 + (swz % 64) / 2; }
__host__ __device__ __forceinline__ int perm32(int rho) { const int n = rho >> 4, i = rho & 15; return 8 * (i >> 2) + 4 * n + (i & 3); }

struct Unit { int pm, pn; };
struct Gemm { const bf16_t* A; const bf16_t* Bt; int M, N, K; };

struct StaticOrder {
    int nM, nN, nwg, G, c, wgm;
    __host__ __device__ void init(int M, int N, int G_, int c_, int wgm_ = 4) { nM = M / BM; nN = N / BM; nwg = nM * nN; G = G_; c = c_; wgm = wgm_; }
    __host__ __device__ bool next(int i, Unit& u) const {
        const long L = (long)i * G + c; if (L >= nwg) return false;
        int wgid = (int)L; { const int q = nwg / NXCD, r = nwg % NXCD, xcd = wgid % NXCD, off = wgid / NXCD; wgid = (xcd < r ? xcd * (q + 1) : r * (q + 1) + (xcd - r) * q) + off; }
        const int nig = wgm * nN, gid = wgid / nig, fm = gid * wgm, gsz = (nM - fm) < wgm ? (nM - fm) : wgm;
        u.pm = fm + ((wgid % nig) % gsz); u.pn = (wgid % nig) / gsz; return true;
    }
    __device__ __forceinline__ void a_ready(const Unit&) const {}
    __device__ __forceinline__ void done(const Unit&) const {}
};

__device__ __forceinline__ unsigned cvt_pk_bf16(float lo, float hi) { unsigned r; asm volatile("v_cvt_pk_bf16_f32 %0, %1, %2" : "=v"(r) : "v"(lo), "v"(hi)); return r; }
__device__ __forceinline__ f32x2 gelu_pk(f32x2 v) {
    const f32x2 av = __builtin_elementwise_abs(v), d = av * 0.2316418882f + 1.0f;
    f32x2 t; t.x = __builtin_amdgcn_rcpf(d.x); t.y = __builtin_amdgcn_rcpf(d.y);
    f32x2 q = t * 0.5307027145f + (-0.7265760135f); q = q * t + 0.7107068705f; q = q * t + (-0.142248368f); q = q * t + 0.127414796f; q = q * t;
    const f32x2 s = (v * v) * (-0.72134752044f);
    f32x2 e; e.x = __builtin_amdgcn_exp2f(s.x); e.y = __builtin_amdgcn_exp2f(s.y);
    const f32x2 m = v * (q * e), r = v - m;
    f32x2 o; o.x = v.x < 0.f ? m.x : r.x; o.y = v.y < 0.f ? m.y : r.y; return o;
}
__device__ __forceinline__ float bf_lo(unsigned w) { return __uint_as_float(w << 16); }
__device__ __forceinline__ float bf_hi(unsigned w) { return __uint_as_float(w & 0xffff0000u); }
__device__ __forceinline__ float sigmoid_f(float x) { return __builtin_amdgcn_rcpf(1.0f + __expf(-x)); }
}

constexpr int DM = 2048, NBATCH = 8, SEQ = 2048, MTOK = NBATCH * SEQ;
constexpr int SGUW = 1024, HYW = 1024, DFF = 8192, INW = 9216, MODW = 6 * DM;
constexpr float LN_EPS = 1e-5f;
constexpr float DN_ALPHA = 1.189207115002721f;

namespace pg8 {

struct EpiG1 {
    static constexpr bool PERM = true, AFTER_DRAIN = false, MID = false; static constexpr int SLOT_FLOATS = 256;
    bf16_t* U; bf16_t* G; const float* b_in;
    __device__ __forceinline__ void mid(f32x4 (&)[2][2][4][2], const Unit&, int, int, int, int) const {}
    __device__ __forceinline__ void preload(PG8_LAS float* slot, const Unit& u, int tid) const { if (tid < 256) slot[tid] = b_in[(u.pn < 4 ? u.pn * 256 : 5120 + (u.pn - 4) * 256) + tid]; }
    __device__ __forceinline__ void operator()(const f32x4 (&acc)[2][2][4][2], const Unit& u, int wr, int wc, int fr, int fq, const PG8_LAS float* slot) const {
        const int row0 = u.pm * BM + wr * 64 + fr; const int pn = u.pn;
        int ldc, colt; bf16_t* base; const bool isu = pn < 4;
        if (isu) { base = U; ldc = SGUW; colt = pn * 256; }
        else { base = G; ldc = 2 * DM; colt = (pn - 4) * 256; }
        const int cl = wc * 64 + 8 * fq;
        f32x4 bv[2][2];
#pragma unroll
        for (int bj = 0; bj < 2; ++bj)
#pragma unroll
            for (int n = 0; n < 2; ++n) bv[bj][n] = *(const PG8_LAS f32x4*)(slot + cl + bj * 32 + 4 * n);
#pragma unroll
        for (int ai = 0; ai < 2; ++ai)
#pragma unroll
            for (int m = 0; m < 4; ++m) {
                const int row = row0 + ai * HALF + m * 16;
                bf16_t* rowp = base + (size_t)row * ldc + colt + cl;
#pragma unroll
                for (int bj = 0; bj < 2; ++bj) {
                    f32x4 v0 = acc[ai][bj][m][0] + bv[bj][0], v1 = acc[ai][bj][m][1] + bv[bj][1];
                    if (isu) {
                        f32x2 a = gelu_pk((f32x2){v0[0], v0[1]}), b = gelu_pk((f32x2){v0[2], v0[3]}), c = gelu_pk((f32x2){v1[0], v1[1]}), d = gelu_pk((f32x2){v1[2], v1[3]});
                        v0 = (f32x4){a.x, a.y, b.x, b.y}; v1 = (f32x4){c.x, c.y, d.x, d.y};
                    } else {
                        v0 = (f32x4){sigmoid_f(v0[0]), sigmoid_f(v0[1]), sigmoid_f(v0[2]), sigmoid_f(v0[3])};
                        v1 = (f32x4){sigmoid_f(v1[0]), sigmoid_f(v1[1]), sigmoid_f(v1[2]), sigmoid_f(v1[3])};
                    }
                    u32x4 w; w.x = cvt_pk_bf16(v0[0], v0[1]); w.y = cvt_pk_bf16(v0[2], v0[3]); w.z = cvt_pk_bf16(v1[0], v1[1]); w.w = cvt_pk_bf16(v1[2], v1[3]);
                    *(u32x4*)(rowp + bj * 32) = w;
                }
            }
    }
};

struct EpiG1T {
    static constexpr bool PERM = true, AFTER_DRAIN = false, MID = false;
    bf16_t* VT; bf16_t* ZHT; const float* b_in; float* statsV; static constexpr int SLOT_FLOATS = 256;
    __device__ __forceinline__ void mid(f32x4 (&)[2][2][4][2], const Unit&, int, int, int, int) const {}
    __device__ __forceinline__ void preload(PG8_LAS float* slot, const Unit& u, int tid) const { if (tid < 256) slot[tid] = b_in[1024 + u.pm * 256 + tid]; }
    __device__ __forceinline__ void operator()(const f32x4 (&acc)[2][2][4][2], const Unit& u, int wr, int wc, int fr, int fq, const PG8_LAS float* slot) const {
        const int col0 = u.pn * BM + wc * 64 + 8 * fq; const bool isv = u.pm < 4;
        const int rowt = (isv ? u.pm : u.pm - 4) * BM + wr * 64 + fr;
        bf16_t* base = isv ? VT : ZHT;
#pragma unroll
        for (int ai = 0; ai < 2; ++ai) {
            float s[2][8], q[2][8];
#pragma unroll
            for (int bj = 0; bj < 2; ++bj)
#pragma unroll
                for (int e = 0; e < 8; ++e) { s[bj][e] = 0.f; q[bj][e] = 0.f; }
#pragma unroll
            for (int m = 0; m < 4; ++m) {
                const int row = rowt + ai * HALF + m * 16; const float bb = slot[wr * 64 + fr + ai * HALF + m * 16];
                bf16_t* rowp = base + (size_t)row * MTOK + col0;
#pragma unroll
                for (int bj = 0; bj < 2; ++bj) {
                    f32x4 v0 = acc[ai][bj][m][0] + bb, v1 = acc[ai][bj][m][1] + bb;
                    if (isv) {
                        f32x2 a = gelu_pk((f32x2){v0[0], v0[1]}), b = gelu_pk((f32x2){v0[2], v0[3]}), c = gelu_pk((f32x2){v1[0], v1[1]}), d = gelu_pk((f32x2){v1[2], v1[3]});
                        v0 = (f32x4){a.x, a.y, b.x, b.y}; v1 = (f32x4){c.x, c.y, d.x, d.y};
                    }
                    u32x4 w; w.x = cvt_pk_bf16(v0[0], v0[1]); w.y = cvt_pk_bf16(v0[2], v0[3]); w.z = cvt_pk_bf16(v1[0], v1[1]); w.w = cvt_pk_bf16(v1[2], v1[3]);
                    *(u32x4*)(rowp + bj * 32) = w;
                    if (isv) {
                        const float e0 = bf_lo(w.x), e1 = bf_hi(w.x), e2 = bf_lo(w.y), e3 = bf_hi(w.y), e4 = bf_lo(w.z), e5 = bf_hi(w.z), e6 = bf_lo(w.w), e7 = bf_hi(w.w);
                        s[bj][0] += e0; s[bj][1] += e1; s[bj][2] += e2; s[bj][3] += e3; s[bj][4] += e4; s[bj][5] += e5; s[bj][6] += e6; s[bj][7] += e7;
                        q[bj][0] += e0 * e0; q[bj][1] += e1 * e1; q[bj][2] += e2 * e2; q[bj][3] += e3 * e3; q[bj][4] += e4 * e4; q[bj][5] += e5 * e5; q[bj][6] += e6 * e6; q[bj][7] += e7 * e7;
                    }
                }
            }
            if (isv) {
                const int slot = u.pm * 4 + ai * 2 + wr;
#pragma unroll
                for (int bj = 0; bj < 2; ++bj)
#pragma unroll
                    for (int e = 0; e < 8; ++e) {
                        float a = s[bj][e], b = q[bj][e];
                        a += __shfl_xor(a, 1); b += __shfl_xor(b, 1); a += __shfl_xor(a, 2); b += __shfl_xor(b, 2);
                        a += __shfl_xor(a, 4); b += __shfl_xor(b, 4); a += __shfl_xor(a, 8); b += __shfl_xor(b, 8);
                        if (fr == 0) *(f32x2*)(statsV + ((size_t)(col0 + bj * 32 + e) * 16 + slot) * 2) = (f32x2){a, b};
                    }
            }
        }
    }
};

struct EpiG2 {
    static constexpr bool PERM = true, AFTER_DRAIN = false, MID = true;
    const bf16_t* G; bf16_t* O; static constexpr int SLOT_FLOATS = 0;
    __device__ __forceinline__ void preload(PG8_LAS float*, const Unit&, int) const {}
    __device__ __forceinline__ void mid(f32x4 (&acc)[2][2][4][2], const Unit& u, int wr, int wc, int fr, int fq) const {
        int row0 = u.pm * BM + wr * 64 + fr, col0 = u.pn * BM + wc * 64 + 8 * fq;
        asm volatile("" : "+v"(row0), "+v"(col0));
#pragma unroll
        for (int ai = 0; ai < 2; ++ai)
#pragma unroll
            for (int m = 0; m < 4; ++m) {
                const bf16_t* gp = G + (size_t)(row0 + ai * HALF + m * 16) * (2 * DM) + col0;
#pragma unroll
                for (int bj = 0; bj < 2; ++bj) {
                    const u32x4 ga = *(const u32x4*)(gp + bj * 32), gb = *(const u32x4*)(gp + DM + bj * 32);
                    f32x4 r0, r1;
                    r0[0] = bf_lo(ga.x) * __builtin_amdgcn_rcpf(bf_lo(gb.x)); r0[1] = bf_hi(ga.x) * __builtin_amdgcn_rcpf(bf_hi(gb.x));
                    r0[2] = bf_lo(ga.y) * __builtin_amdgcn_rcpf(bf_lo(gb.y)); r0[3] = bf_hi(ga.y) * __builtin_amdgcn_rcpf(bf_hi(gb.y));
                    r1[0] = bf_lo(ga.z) * __builtin_amdgcn_rcpf(bf_lo(gb.z)); r1[1] = bf_hi(ga.z) * __builtin_amdgcn_rcpf(bf_hi(gb.z));
                    r1[2] = bf_lo(ga.w) * __builtin_amdgcn_rcpf(bf_lo(gb.w)); r1[3] = bf_hi(ga.w) * __builtin_amdgcn_rcpf(bf_hi(gb.w));
                    acc[ai][bj][m][0] *= r0; acc[ai][bj][m][1] *= r1;
                }
            }
    }
    __device__ __forceinline__ void operator()(const f32x4 (&acc)[2][2][4][2], const Unit& u, int wr, int wc, int fr, int fq, const PG8_LAS float*) const {
        const int row0 = u.pm * BM + wr * 64 + fr, col0 = u.pn * BM + wc * 64 + 8 * fq;
#pragma unroll
        for (int ai = 0; ai < 2; ++ai)
#pragma unroll
            for (int m = 0; m < 4; ++m) {
                const int row = row0 + ai * HALF + m * 16;
                const bf16_t* gp = G + (size_t)row * (2 * DM) + DM + col0;
                bf16_t* op = O + (size_t)row * DM + col0;
#pragma unroll
                for (int bj = 0; bj < 2; ++bj) {
                    const u32x4 gb = *(const u32x4*)(gp + bj * 32);
                    const f32x4 a0 = acc[ai][bj][m][0], a1 = acc[ai][bj][m][1];
                    u32x4 w; w.x = cvt_pk_bf16(a0[0] * bf_lo(gb.x), a0[1] * bf_hi(gb.x)); w.y = cvt_pk_bf16(a0[2] * bf_lo(gb.y), a0[3] * bf_hi(gb.y));
                    w.z = cvt_pk_bf16(a1[0] * bf_lo(gb.z), a1[1] * bf_hi(gb.z)); w.w = cvt_pk_bf16(a1[2] * bf_lo(gb.w), a1[3] * bf_hi(gb.w));
                    *(u32x4*)(op + bj * 32) = w;
                }
            }
    }
};

typedef _Float16 f16x4 __attribute__((ext_vector_type(4)));
__device__ __forceinline__ f16x4 to_f16x4(f32x4 v) { return (f16x4){(_Float16)v[0], (_Float16)v[1], (_Float16)v[2], (_Float16)v[3]}; }
__device__ __forceinline__ f32x4 from_f16x4(f16x4 v) { return (f32x4){(float)v[0], (float)v[1], (float)v[2], (float)v[3]}; }
template <bool FIRST> struct EpiRes {
    static constexpr bool PERM = false, AFTER_DRAIN = false, MID = false; static constexpr int SLOT_FLOATS = FIRST ? 512 : 1024;
    const float* X;
    const _Float16* R16;
    _Float16* O16;
    const float* gate;
    const float* bias;
    const float* lng; const float* lnb; const float* MU;
    float* stats;
    __device__ __forceinline__ void mid(f32x4 (&)[2][2][4][2], const Unit&, int, int, int, int) const {}
    __device__ __forceinline__ void preload(PG8_LAS float* slot, const Unit& u, int tid) const {
        const int c = tid & 255, col = u.pn * BM + c;
        if (tid < 256) slot[c] = gate[(size_t)(u.pm >> 3) * MODW + col]; else slot[256 + c] = bias[col];
        if (!FIRST) { if (tid < 256) slot[512 + c] = DN_ALPHA * lng[col]; else slot[768 + c] = DN_ALPHA * lnb[col]; }
    }
    __device__ __forceinline__ void operator()(const f32x4 (&acc)[2][2][4][2], const Unit& u, int wr, int wc, int fr, int fq, const PG8_LAS float* slot) const {
        int row0 = u.pm * BM + wr * 64 + fr; const int cl = wc * 32 + 4 * fq; int col0 = u.pn * BM + cl;
        asm volatile("" : "+v"(row0), "+v"(col0));
        constexpr int RB = FIRST ? 2 : 1;
#pragma unroll
        for (int ab = 0; ab < 8 / RB; ++ab) {
            const int ai = (ab * RB) >> 2, mb = (ab * RB) & 3;
            f32x4 base[RB][2][2]; f16x4 b16[RB][2][2]; f32x2 mr[RB];
            int rowb = row0 + ai * HALF + mb * 16; asm volatile("" : "+v"(rowb));
#pragma unroll
            for (int mm = 0; mm < RB; ++mm) {
                const size_t off = (size_t)(rowb + mm * 16) * DM + col0;
                if (!FIRST) mr[mm] = *(const f32x2*)(MU + (size_t)(rowb + mm * 16) * 2);
#pragma unroll
                for (int bj = 0; bj < 2; ++bj)
#pragma unroll
                    for (int n = 0; n < 2; ++n) { if (FIRST) base[mm][bj][n] = *(const f32x4*)(X + off + bj * HALF + n * 16); else b16[mm][bj][n] = *(const f16x4*)(R16 + off + bj * HALF + n * 16); }
            }
#pragma unroll
            for (int mm = 0; mm < RB; ++mm) {
                const int m = mb + mm;
                const int row = rowb + mm * 16; _Float16* rp = O16 + (size_t)row * DM + col0;
                float s = 0.f, q = 0.f;
#pragma unroll
                for (int bj = 0; bj < 2; ++bj)
#pragma unroll
                    for (int n = 0; n < 2; ++n) {
                        const int co = bj * HALF + n * 16;
                        const f32x4 gv = *(const PG8_LAS f32x4*)(slot + cl + co), bv = *(const PG8_LAS f32x4*)(slot + 256 + cl + co);
                        f32x4 bs;
                        if (FIRST) bs = base[mm][bj][n] * DN_ALPHA;
                        else bs = (from_f16x4(b16[mm][bj][n]) - mr[mm].x) * mr[mm].y * *(const PG8_LAS f32x4*)(slot + 512 + cl + co) + *(const PG8_LAS f32x4*)(slot + 768 + cl + co);
                        const f16x4 oh = to_f16x4(bs + gv * (acc[ai][bj][m][n] + bv));
                        *(f16x4*)(rp + co) = oh;
                        const f32x4 o = from_f16x4(oh);
                        s += (o[0] + o[1]) + (o[2] + o[3]); q += (o[0] * o[0] + o[1] * o[1]) + (o[2] * o[2] + o[3] * o[3]);
                    }
                s += __shfl_xor(s, 16); s += __shfl_xor(s, 32); q += __shfl_xor(q, 16); q += __shfl_xor(q, 32);
                if (fq == 0) *(f32x2*)(stats + ((size_t)row * 32 + u.pn * 4 + wc) * 2) = (f32x2){s, q};
            }
            asm volatile("" ::: "memory");
        }
    }
};

struct EpiG4 {
    static constexpr bool PERM = true, AFTER_DRAIN = false, MID = false; static constexpr int SLOT_FLOATS = 256;
    bf16_t* O; const float* bias;
    __device__ __forceinline__ void mid(f32x4 (&)[2][2][4][2], const Unit&, int, int, int, int) const {}
    __device__ __forceinline__ void preload(PG8_LAS float* slot, const Unit& u, int tid) const { if (tid < 256) slot[tid] = bias[u.pn * BM + tid]; }
    __device__ __forceinline__ void operator()(const f32x4 (&acc)[2][2][4][2], const Unit& u, int wr, int wc, int fr, int fq, const PG8_LAS float* slot) const {
        const int row0 = u.pm * BM + wr * 64 + fr, cl = wc * 64 + 8 * fq, col0 = u.pn * BM + cl;
        f32x4 bv[2][2];
#pragma unroll
        for (int bj = 0; bj < 2; ++bj)
#pragma unroll
            for (int n = 0; n < 2; ++n) bv[bj][n] = *(const PG8_LAS f32x4*)(slot + cl + bj * 32 + 4 * n);
#pragma unroll
        for (int ai = 0; ai < 2; ++ai)
#pragma unroll
            for (int m = 0; m < 4; ++m) {
                bf16_t* rowp = O + (size_t)(row0 + ai * HALF + m * 16) * DFF + col0;
#pragma unroll
                for (int bj = 0; bj < 2; ++bj) {
                    f32x4 v0 = acc[ai][bj][m][0] + bv[bj][0], v1 = acc[ai][bj][m][1] + bv[bj][1];
                    v0 = __builtin_elementwise_max(v0, (f32x4){0.f, 0.f, 0.f, 0.f}); v1 = __builtin_elementwise_max(v1, (f32x4){0.f, 0.f, 0.f, 0.f});
                    v0 = v0 * v0; v1 = v1 * v1;
                    u32x4 w; w.x = cvt_pk_bf16(v0[0], v0[1]); w.y = cvt_pk_bf16(v0[2], v0[3]); w.z = cvt_pk_bf16(v1[0], v1[1]); w.w = cvt_pk_bf16(v1[2], v1[3]);
                    *(u32x4*)(rowp + bj * 32) = w;
                }
            }
    }
};
}
namespace pg8 {
template <class Epi, class Sched, bool ALIGN_EPI = false, bool SP2 = false>
__device__ __forceinline__ void gemm_phase(PG8_LAS unsigned char* lds, const Gemm g, const Sched& S, const Epi& E) {
    const int tid = threadIdx.x, wid = __builtin_amdgcn_readfirstlane(tid >> 6), lane = tid & 63, wr = wid >> 2, wc = wid & 3, fr = lane & 15, fq = lane >> 4;
    const int K = g.K, nt = K / BK;
    unsigned voffA[2], voffB[2];
#pragma unroll
    for (int i = 0; i < 2; ++i) { int R, C; stage_rc(tid * 16 + i * 8192, R, C); const int Rb = Epi::PERM ? ((R & ~31) + perm32(R & 31)) : R;
        const int Rw = Epi::PERM ? ((R >> 5) * 64 + perm32(R & 31)) : R;
        voffA[i] = (unsigned)(R * K + C) * 2u; voffB[i] = (unsigned)(Rw * K + C) * 2u; (void)Rb; }
    const size_t kstep = (size_t)(BK * 2);
    const size_t hstep = (size_t)HALF * K * 2;
    const size_t tstep = 2 * hstep;
    const size_t hstepB = Epi::PERM ? (size_t)32 * K * 2 : hstep;
    const unsigned ldsw = (unsigned)wid * 1024u;
    const int aoff = lds_byte(wr * 64 + fr, fq * 8), boff = lds_byte(wc * 32 + fr, fq * 8);
#define PG8_SA(b, h) (((b) * 2 + (h)) * HTB)
#define PG8_SB(b, h) ((4 + (b) * 2 + (h)) * HTB)
#define PG8_STAGE(bufoff, gbase, voff) do { _Pragma("unroll") for (int _i = 0; _i < 2; ++_i) \
        __builtin_amdgcn_global_load_lds((const unsigned*)((const char*)(gbase) + (voff)[_i]), (PG8_LAS unsigned*)(lds + (bufoff) + ldsw + _i * 8192), 16, 0, 0); } while (0)
#define PG8_LDA(dst, b, h) do { _Pragma("unroll") for (int m = 0; m < 4; ++m) _Pragma("unroll") for (int k = 0; k < 2; ++k) dst[m][k] = *(const PG8_LAS bf16x8*)(lds + PG8_SA(b, h) + aoff + m * 2048 + k * 1024); } while (0)
#define PG8_LDB(dst, b, h) do { _Pragma("unroll") for (int n = 0; n < 2; ++n) _Pragma("unroll") for (int k = 0; k < 2; ++k) dst[n][k] = *(const PG8_LAS bf16x8*)(lds + PG8_SB(b, h) + boff + n * 2048 + k * 1024); } while (0)
#define PG8_MMA(ai, bj, At, Bt) do { __builtin_amdgcn_s_setprio(1); _Pragma("unroll") for (int m = 0; m < 4; ++m) _Pragma("unroll") for (int n = 0; n < 2; ++n) _Pragma("unroll") for (int k = 0; k < 2; ++k) \
        acc[ai][bj][m][n] = __builtin_amdgcn_mfma_f32_16x16x32_bf16(Bt[n][k], At[m][k], acc[ai][bj][m][n], 0, 0, 0); __builtin_amdgcn_s_setprio(0); } while (0)
#define PG8_WAIT_V(n) asm volatile("s_waitcnt vmcnt(" #n ")" ::: "memory")
#define PG8_WAIT_L(n) asm volatile("s_waitcnt lgkmcnt(" #n ")" ::: "memory")
#define PG8_BAR __builtin_amdgcn_s_barrier()
#define PG8_SCHED __builtin_amdgcn_sched_barrier(0)
    Unit cur, nxt; int ui = 0;
    if (!S.next(0, cur)) return;
    {
        Unit pu; for (int i = 0; S.next(i, pu); ++i) E.preload((PG8_LAS float*)(lds + EPI_LDS_OFF) + i * Epi::SLOT_FLOATS, pu, tid);
        asm volatile("s_waitcnt vmcnt(0) lgkmcnt(0)" ::: "memory"); __builtin_amdgcn_s_barrier(); asm volatile("" ::: "memory");
    }
    f32x4 acc[2][2][4][2];
#pragma unroll
    for (int a = 0; a < 2; ++a)
#pragma unroll
        for (int b = 0; b < 2; ++b)
#pragma unroll
            for (int m = 0; m < 4; ++m)
#pragma unroll
                for (int n = 0; n < 2; ++n) acc[a][b][m][n] = (f32x4){0.f, 0.f, 0.f, 0.f};
    bf16x8 At[4][2], B0[2][2], B1[2][2];
    const char* cA = (const char*)g.A + (size_t)cur.pm * tstep; const char* cB = (const char*)g.Bt + (size_t)cur.pn * tstep;
    S.a_ready(cur);
    if constexpr (SP2) {
        PG8_STAGE(PG8_SB(0, 0), cB, voffB); PG8_STAGE(PG8_SB(0, 1), cB + hstepB, voffB); PG8_STAGE(PG8_SA(0, 0), cA, voffA); PG8_STAGE(PG8_SA(0, 1), cA + hstep, voffA);
        if (wr == 1) PG8_BAR;
        PG8_WAIT_V(2); PG8_BAR;
        PG8_STAGE(PG8_SB(1, 0), cB + kstep, voffB); PG8_STAGE(PG8_SA(1, 0), cA + kstep, voffA); PG8_STAGE(PG8_SB(1, 1), cB + hstepB + kstep, voffB);
        PG8_WAIT_V(6); PG8_BAR;
    } else {
        PG8_STAGE(PG8_SB(0, 0), cB, voffB); PG8_STAGE(PG8_SA(0, 0), cA, voffA); PG8_STAGE(PG8_SB(0, 1), cB + hstepB, voffB); PG8_STAGE(PG8_SA(0, 1), cA + hstep, voffA);
        if (wr == 1) PG8_BAR;
        PG8_WAIT_V(4); PG8_BAR;
        PG8_STAGE(PG8_SB(1, 0), cB + kstep, voffB); PG8_STAGE(PG8_SA(1, 0), cA + kstep, voffA); PG8_STAGE(PG8_SB(1, 1), cB + hstepB + kstep, voffB);
        PG8_WAIT_V(6); PG8_BAR;
    }
    for (;;) {
        const bool has_next = S.next(ui + 1, nxt);
        const char* nA = has_next ? (const char*)g.A + (size_t)nxt.pm * tstep : cA; const char* nB = has_next ? (const char*)g.Bt + (size_t)nxt.pn * tstep : cB;
        for (int t = 0; t < nt; t += 2) {
            const bool last = (t == nt - 2);
            const char* a1 = cA + (size_t)(t + 1) * kstep;
            const char* a2 = last ? nA : cA + (size_t)(t + 2) * kstep; const char* b2 = last ? nB : cB + (size_t)(t + 2) * kstep;
            const char* a3 = a2 + kstep; const char* b3 = b2 + kstep;
            if (last && has_next) S.a_ready(nxt);
            if constexpr (Epi::MID) { if (t == (nt >> 1)) E.mid(acc, cur, wr, wc, fr, fq); }
            if constexpr (SP2) {
            PG8_LDB(B0, 0, 0); PG8_LDB(B1, 0, 1); PG8_SCHED; PG8_LDA(At, 0, 0); PG8_STAGE(PG8_SA(1, 1), a1 + hstep, voffA);
            PG8_WAIT_V(8); PG8_WAIT_L(0); PG8_BAR; PG8_MMA(0, 0, At, B0); PG8_MMA(0, 1, At, B1); PG8_BAR; PG8_SCHED;
            PG8_LDA(At, 0, 1); PG8_STAGE(PG8_SB(0, 0), b2, voffB); PG8_STAGE(PG8_SB(0, 1), b2 + hstepB, voffB); PG8_STAGE(PG8_SA(0, 0), a2, voffA);
            PG8_WAIT_V(8); PG8_WAIT_L(0); PG8_BAR; PG8_MMA(1, 0, At, B0); PG8_MMA(1, 1, At, B1); PG8_BAR; PG8_SCHED;
            PG8_LDB(B0, 1, 0); PG8_LDB(B1, 1, 1); PG8_SCHED; PG8_LDA(At, 1, 0); PG8_STAGE(PG8_SA(0, 1), a2 + hstep, voffA);
            PG8_WAIT_V(8); PG8_WAIT_L(0); PG8_BAR; PG8_MMA(0, 0, At, B0); PG8_MMA(0, 1, At, B1); PG8_BAR; PG8_SCHED;
            PG8_LDA(At, 1, 1); PG8_STAGE(PG8_SB(1, 0), b3, voffB); PG8_STAGE(PG8_SB(1, 1), b3 + hstepB, voffB); PG8_STAGE(PG8_SA(1, 0), a3, voffA);
            PG8_WAIT_V(8); PG8_WAIT_L(0); PG8_BAR; PG8_MMA(1, 0, At, B0); PG8_MMA(1, 1, At, B1); PG8_BAR; PG8_SCHED;
            } else {
            PG8_LDB(B0, 0, 0); PG8_SCHED; PG8_LDA(At, 0, 0); PG8_STAGE(PG8_SA(1, 1), a1 + hstep, voffA);
            PG8_WAIT_L(8); PG8_BAR; PG8_WAIT_L(0); PG8_MMA(0, 0, At, B0); PG8_BAR; PG8_SCHED;
            PG8_LDB(B1, 0, 1); PG8_STAGE(PG8_SB(0, 0), b2, voffB);
            PG8_BAR; PG8_WAIT_L(0); PG8_MMA(0, 1, At, B1); PG8_BAR;
            PG8_LDA(At, 0, 1); PG8_STAGE(PG8_SA(0, 0), a2, voffA);
            PG8_BAR; PG8_WAIT_L(0); PG8_MMA(1, 0, At, B0); PG8_BAR; PG8_SCHED;
            PG8_STAGE(PG8_SB(0, 1), b2 + hstepB, voffB);
            PG8_WAIT_V(6); PG8_BAR; PG8_MMA(1, 1, At, B1); PG8_BAR;
            PG8_LDB(B0, 1, 0); PG8_SCHED; PG8_LDA(At, 1, 0); PG8_STAGE(PG8_SA(0, 1), a2 + hstep, voffA);
            PG8_WAIT_L(8); PG8_BAR; PG8_WAIT_L(0); PG8_MMA(0, 0, At, B0); PG8_BAR; PG8_SCHED;
            PG8_LDB(B1, 1, 1); PG8_STAGE(PG8_SB(1, 0), b3, voffB);
            PG8_BAR; PG8_WAIT_L(0); PG8_MMA(0, 1, At, B1); PG8_BAR;
            PG8_LDA(At, 1, 1); PG8_STAGE(PG8_SA(1, 0), a3, voffA);
            PG8_BAR; PG8_WAIT_L(0); PG8_MMA(1, 0, At, B0); PG8_BAR; PG8_SCHED;
            PG8_STAGE(PG8_SB(1, 1), b3 + hstepB, voffB);
            PG8_WAIT_V(6); PG8_BAR; PG8_MMA(1, 1, At, B1); PG8_BAR;
            }
        }
        if constexpr (ALIGN_EPI) { if (wr == 0) PG8_BAR; }
        if constexpr (!Epi::AFTER_DRAIN) { E(acc, cur, wr, wc, fr, fq, (const PG8_LAS float*)(lds + EPI_LDS_OFF) + ui * Epi::SLOT_FLOATS); S.done(cur); }
        if (!has_next) break;
#pragma unroll
        for (int a = 0; a < 2; ++a)
#pragma unroll
            for (int b = 0; b < 2; ++b)
#pragma unroll
                for (int m = 0; m < 4; ++m)
#pragma unroll
                    for (int n = 0; n < 2; ++n) acc[a][b][m][n] = (f32x4){0.f, 0.f, 0.f, 0.f};
        cur = nxt; cA = nA; cB = nB; ++ui;
        if constexpr (ALIGN_EPI) { if (wr == 1) PG8_BAR; }
    }
    PG8_WAIT_V(0);
    if constexpr (!ALIGN_EPI) { if (wr == 0) PG8_BAR; }
    PG8_BAR;
    if constexpr (Epi::AFTER_DRAIN) { E.fused(acc, cur, wr, wc, fr, fq, lds, wid, lane); S.done(cur); }
#undef PG8_SA
#undef PG8_SB
#undef PG8_STAGE
#undef PG8_LDA
#undef PG8_LDB
#undef PG8_MMA
#undef PG8_WAIT_V
#undef PG8_WAIT_L
#undef PG8_BAR
#undef PG8_SCHED
}
}

constexpr size_t MiB = 1u << 20;
constexpr size_t WS_CTL = 0;
constexpr size_t WS_MOD = 1 * MiB;
constexpr size_t WS_STV = 2 * MiB;
constexpr size_t WS_ST1 = 4 * MiB;
constexpr size_t WS_ST2 = 8 * MiB;
constexpr size_t WS_MU1 = 12 * MiB;
constexpr size_t WS_HID2 = 14 * MiB;
constexpr size_t WS_SGW = 13 * MiB;
constexpr size_t WS_WIN = 16 * MiB;
constexpr size_t WS_WAB = 52 * MiB;
constexpr size_t WS_WO = 60 * MiB;
constexpr size_t WS_FILT = 68 * MiB;
constexpr size_t WS_WM2 = 68 * MiB;
constexpr size_t WS_H = 100 * MiB;
constexpr size_t WS_U = 164 * MiB;
constexpr size_t WS_V = 196 * MiB;
constexpr size_t WS_MERGED = 164 * MiB;
constexpr size_t WS_ZHT = 228 * MiB;
constexpr size_t WS_G = 324 * MiB;
constexpr size_t WS_AFF = 164 * MiB;
constexpr size_t WS_WM1 = 420 * MiB;
constexpr size_t WS_YT = 452 * MiB;
constexpr size_t WS_END = 484 * MiB;

constexpr int NWAVES = 8;
constexpr int LDS_BYTES = 163840;

#define GAS __attribute__((address_space(1)))
#define LAS __attribute__((address_space(3)))
typedef unsigned short bf16;
typedef unsigned v4u __attribute__((ext_vector_type(4)));
typedef unsigned v2u __attribute__((ext_vector_type(2)));
typedef float f32x4 __attribute__((ext_vector_type(4)));
typedef float f32x2 __attribute__((ext_vector_type(2)));
#define LDS_WAIT() asm volatile("s_waitcnt lgkmcnt(0)" ::: "memory")

__device__ __forceinline__ unsigned f2bf(float f) { unsigned u = __builtin_bit_cast(unsigned, f); return (u + 0x7fffu + ((u >> 16) & 1u)) >> 16; }
__device__ __forceinline__ unsigned pk2(float lo, float hi) { return f2bf(lo) | (f2bf(hi) << 16); }
__device__ __forceinline__ float bflo(unsigned w) { return __uint_as_float(w << 16); }
__device__ __forceinline__ float bfhi(unsigned w) { return __uint_as_float(w & 0xffff0000u); }
__device__ __forceinline__ float bf1(bf16 h) { return __uint_as_float((unsigned)h << 16); }
__device__ __forceinline__ float wave_sum(float v) {
#pragma unroll
    for (int o = 1; o < 64; o <<= 1) v += __shfl_xor(v, o);
    return v;
}

struct Args { const float* in[31]; float* out; unsigned char* ws; int ph_lo, ph_hi; };

struct Frame {
    LAS unsigned char* lds;
    int tid, lane, wave, G;
    const float* const* in; float* out; unsigned char* ws;
};
enum { I_X = 0, I_C, I_WADA, I_BADA, I_WIN, I_BIN, I_SLNG, I_SLNB, I_SW, I_SB, I_HCW, I_HCB, I_HW1, I_HB1, I_HW2, I_HB2, I_HFREQ, I_HW3, I_HSKIP,
       I_WA, I_WB, I_WO, I_BO, I_LN1G, I_LN1B, I_WM1, I_BM1, I_WM2, I_BM2, I_LN2G, I_LN2B };

__device__ __forceinline__ void transpose_matrix(Frame& F, const float* W, int K, int N, bf16* WT, int ldk, int koff, int remap_win, int first, int nblocks) {
    LAS float* tile = (LAS float*)F.lds;
    const int tid = F.tid, nblk = N / 256, nitems = (K / 64) * nblk;
    const int lr = tid >> 6, lc = tid & 63;
    const int wc = tid & 7, wn = tid >> 3;
    for (int it = first; it < nitems; it += nblocks) {
        const int kb = it / nblk, nb = it % nblk, n0 = nb * 256, k0 = kb * 64; int row0 = n0;
        if (remap_win) row0 = (n0 < 1024) ? n0 : (n0 < 2048 ? n0 - 1024 + 5120 : (n0 < 5120 ? n0 - 2048 + 6144 : n0 - 5120 + 1024));
        f32x4 v[8];
#pragma unroll
        for (int i = 0; i < 8; ++i) v[i] = *(const f32x4*)(W + (size_t)(k0 + 8 * i + lr) * N + n0 + 4 * lc);
#pragma unroll
        for (int i = 0; i < 8; ++i) *(LAS f32x4*)(tile + (8 * i + lr) * 256 + ((lc ^ i) << 2)) = v[i];
        __syncthreads();
#pragma unroll
        for (int j = 0; j < 4; ++j) { const int n = wn + 64 * j; const LAS float* sp = tile + (8 * wc) * 256 + ((((n >> 2) ^ wc) << 2) | (n & 3));
            v4u o; o.x = pk2(sp[0 * 256], sp[1 * 256]); o.y = pk2(sp[2 * 256], sp[3 * 256]); o.z = pk2(sp[4 * 256], sp[5 * 256]); o.w = pk2(sp[6 * 256], sp[7 * 256]);
            *(GAS v4u*)(WT + (size_t)(row0 + n) * ldk + koff + k0 + 8 * wc) = o; }
        __syncthreads();
    }
}

__device__ __forceinline__ void p0_mod(Frame& F) {
    LAS float* condS = (LAS float*)F.lds;
    LAS float* red = (LAS float*)(F.lds + 65536);
    const float* c = F.in[I_C]; const float* w_ada = F.in[I_WADA]; const float* b_ada = F.in[I_BADA];
    float* mod = (float*)(F.ws + WS_MOD);
    const int tid = F.tid;
    for (int item = blockIdx.x; item < MODW / 48; item += F.G) {
        for (int i = tid; i < NBATCH * DM; i += NWAVES * 64) { const float v = c[i]; condS[i] = v / (1.0f + __expf(-v)); }
        __syncthreads();
        const int cq = tid % 12, kq = tid / 12, col0 = item * 48;
        if (kq < 32) {
            f32x4 acc[8];
#pragma unroll
            for (int b = 0; b < 8; ++b) acc[b] = (f32x4){0.f, 0.f, 0.f, 0.f};
            const float* wp = w_ada + (size_t)kq * MODW + col0 + cq * 4;
            for (int k = kq; k < DM; k += 256, wp += (size_t)256 * MODW) {
                f32x4 w[8];
#pragma unroll
                for (int u = 0; u < 8; ++u) w[u] = *(const f32x4*)(wp + (size_t)(32 * u) * MODW);
#pragma unroll
                for (int u = 0; u < 8; ++u)
#pragma unroll
                    for (int b = 0; b < 8; ++b) acc[b] += w[u] * condS[b * DM + k + 32 * u];
            }
#pragma unroll
            for (int b = 0; b < 8; ++b) *(LAS f32x4*)(red + (kq * 8 + b) * 48 + cq * 4) = acc[b];
        }
        __syncthreads();
        if (tid < 384) { const int b = tid / 48, col = tid % 48; float s = 0.f;
#pragma unroll 8
          for (int k2 = 0; k2 < 32; ++k2) s += red[(k2 * 8 + b) * 48 + col];
          mod[(size_t)b * MODW + col0 + col] = s + b_ada[col0 + col]; }
        __syncthreads();
    }
}

__device__ __forceinline__ void p0_hid2(Frame& F) {
    LAS float* scr = (LAS float*)F.lds + F.wave * 128;
    const float* w1 = F.in[I_HW1]; const float* b1 = F.in[I_HB1]; const float* w2 = F.in[I_HW2]; const float* b2 = F.in[I_HB2]; const float* freq = F.in[I_HFREQ];
    float* HID2 = (float*)(F.ws + WS_HID2);
    const int lane = F.lane;
    for (int l = blockIdx.x * NWAVES + F.wave; l < SEQ; l += F.G * NWAVES) {
        const float fr = freq[lane];
        const float tl = (float)l / (float)(SEQ - 1), omega = 6.283185307179586f * (float)l / (float)SEQ;
        float f = 0.f;
        if (lane == 0) f = tl;
        else if (lane <= 16) { const float band = 1e-4f + (float)(lane - 1) * ((15.0f - 1e-4f) / 15.0f); f = cosf(band * omega); }
        else if (lane <= 32) { const float band = 1e-4f + (float)(lane - 17) * ((15.0f - 1e-4f) / 15.0f); f = -sinf(band * omega); }
        scr[lane] = f; LDS_WAIT(); asm volatile("" ::: "memory");
        float a = b1[lane];
#pragma unroll 11
        for (int i = 0; i < 33; ++i) a += scr[i] * w1[i * 64 + lane];
        scr[64 + lane] = sinf(fr * a); LDS_WAIT(); asm volatile("" ::: "memory");
        a = b2[lane];
#pragma unroll 16
        for (int i = 0; i < 64; ++i) a += scr[64 + i] * w2[i * 64 + lane];
        HID2[(size_t)l * 64 + lane] = sinf(fr * a);
        LDS_WAIT(); asm volatile("" ::: "memory");
    }
}
typedef float fl_f32x16 __attribute__((ext_vector_type(16)));
__device__ __forceinline__ void p1_filter_waves(Frame& F) {
    const int fwl = F.wave - 4;
    LAS float* hS = (LAS float*)F.lds + fwl * (32 * 65);
    const float* w3 = F.in[I_HW3]; const float* HID2 = (const float*)(F.ws + WS_HID2);
    float* FILT = (float*)(F.ws + WS_FILT);
    const int lane = F.lane, r = lane & 31, h = lane >> 5;
    const float min_decay = -3.0701134573253943f, max_decay = -15.350567286626972f;
    for (int item = blockIdx.x * 4 + fwl; item < 1024; item += F.G * 4) {
        const int pb = item >> 4, cb = item & 15, pos0 = pb * 32, col0 = cb * 256;
        {
#pragma unroll
            for (int u = 0; u < 8; ++u) { const int e = (u * 64 + lane) * 4, p = e >> 6, k = e & 63; const f32x4 v = *(const f32x4*)(HID2 + (size_t)(pos0 + p) * 64 + k);
                hS[p * 65 + k] = v[0]; hS[p * 65 + k + 1] = v[1]; hS[p * 65 + k + 2] = v[2]; hS[p * 65 + k + 3] = v[3]; }
            LDS_WAIT(); asm volatile("" ::: "memory");
        }
        fl_f32x16 acc[8];
#pragma unroll
        for (int t = 0; t < 8; ++t)
#pragma unroll
            for (int e = 0; e < 16; ++e) acc[t][e] = 0.f;
        const float* wp = w3 + (size_t)h * 4096 + col0 + r;
#pragma unroll 2
        for (int s2 = 0; s2 < 32; ++s2) {
            const float a = hS[r * 65 + 2 * s2 + h];
            float b[8];
#pragma unroll
            for (int t = 0; t < 8; ++t) b[t] = wp[(size_t)(2 * s2) * 4096 + t * 32];
#pragma unroll
            for (int t = 0; t < 8; ++t) acc[t] = __builtin_amdgcn_mfma_f32_32x32x2f32(a, b[t], acc[t], 0, 0, 0);
        }
#pragma unroll
        for (int t = 0; t < 8; ++t) {
            const int j = col0 + t * 32 + r, ch = j & 1023; const float delta = fabsf(min_decay + (float)ch * ((max_decay - min_decay) / 1023.0f));
            float* op = FILT + (size_t)j * SEQ + pos0 + 4 * h;
#pragma unroll
            for (int g = 0; g < 4; ++g) {
                f32x4 o;
#pragma unroll
                for (int e = 0; e < 4; ++e) { const float tp = (float)(pos0 + 8 * g + 4 * h + e) / (float)(SEQ - 1); o[e] = acc[t][4 * g + e] * __expf(-tp * delta); }
                *(f32x4*)(op + 8 * g) = o;
            }
        }
        LDS_WAIT(); asm volatile("" ::: "memory");
    }
}

__device__ __forceinline__ void p1_modulate(Frame& F) {
    const float* x = F.in[I_X]; const float* mod = (const float*)(F.ws + WS_MOD); bf16* H = (bf16*)(F.ws + WS_H);
    const size_t nvec = (size_t)MTOK * DM / 8, stride = (size_t)F.G * 256;
    for (size_t i0 = (size_t)blockIdx.x * 256 + F.tid; i0 < nvec; i0 += 4 * stride) {
        f32x4 xa[4], xb[4];
#pragma unroll
        for (int u = 0; u < 4; ++u) { const size_t i = i0 + u * stride; if (i < nvec) { const float* xp = x + i * 8; xa[u] = *(const f32x4*)xp; xb[u] = *(const f32x4*)(xp + 4); } }
#pragma unroll
        for (int u = 0; u < 4; ++u) { const size_t i = i0 + u * stride; if (i < nvec) {
            const int row = (int)(i >> 8), col = (int)(i & 255) * 8, b = row >> 11;
            const float* mp = mod + (size_t)b * MODW + col;
            const f32x4 sh0 = *(const f32x4*)mp, sh1 = *(const f32x4*)(mp + 4), sc0 = *(const f32x4*)(mp + DM), sc1 = *(const f32x4*)(mp + DM + 4);
            const f32x4 h0 = xa[u] * (sc0 + 1.0f) + sh0, h1 = xb[u] * (sc1 + 1.0f) + sh1;
            v4u o; o.x = pk2(h0[0], h0[1]); o.y = pk2(h0[2], h0[3]); o.z = pk2(h1[0], h1[1]); o.w = pk2(h1[2], h1[3]);
            *(v4u*)(H + i * 8) = o; } }
    }
}

typedef short sg_bf16x8 __attribute__((ext_vector_type(8)));
typedef float sg_f32x16 __attribute__((ext_vector_type(16)));
constexpr int SG_VT = 0, SG_LD = 136, SG_ST = 36864;
__device__ __forceinline__ void p3_sgu(Frame& F) {
    LAS bf16* vnT = (LAS bf16*)(F.lds + SG_VT); LAS float* stS = (LAS float*)(F.lds + SG_ST);
    const bf16* U = (const bf16*)(F.ws + WS_U); const bf16* VT = (const bf16*)(F.ws + WS_V); bf16* AB = (bf16*)(F.ws + WS_H);
    const bf16* Wb = (const bf16*)(F.ws + WS_SGW); const float* stv = (const float*)(F.ws + WS_STV);
    const float* lng = F.in[I_SLNG]; const float* lnb = F.in[I_SLNB]; const float* sb = F.in[I_SB];
    const int tid = F.tid, lane = F.lane, w = F.wave, r = lane & 31, h = lane >> 5;
    const int q0 = 32 * (w >> 1), ct0 = 2 * (w & 1);
    for (int item = blockIdx.x; item < 1024; item += F.G) {
        const int b = item >> 7, n = (item >> 3) & 15, g = item & 7, tok0 = b * SEQ + n * 128;
        f32x2 pst[16];
        if (tid < 128) { const float* sp = stv + (size_t)(tok0 + tid) * 32;
#pragma unroll
            for (int i = 0; i < 16; ++i) pst[i] = *(const f32x2*)(sp + 2 * i); }
        const int c = tid >> 2, pseg = (tid & 3) * 32, ch = g * 128 + c;
        v4u wv[4];
        { const bf16* vp = VT + (size_t)ch * MTOK + tok0 + pseg;
#pragma unroll
          for (int k = 0; k < 4; ++k) wv[k] = *(const v4u*)(vp + 8 * k); }
        const float gg = lng[ch], bb = lnb[ch];
        sg_bf16x8 af[8];
#pragma unroll
        for (int kk = 0; kk < 8; ++kk) af[kk] = *(const sg_bf16x8*)(Wb + (size_t)(g * 128 + q0 + r) * 128 + 16 * kk + 8 * h);
        bf16 uu[2][16]; float sbv[16];
#pragma unroll
        for (int rg = 0; rg < 16; ++rg) { const int q = q0 + (rg & 3) + 8 * (rg >> 2) + 4 * h; sbv[rg] = sb[g * 128 + q];
#pragma unroll
            for (int ct = 0; ct < 2; ++ct) uu[ct][rg] = U[(size_t)(tok0 + q) * SGUW + g * 128 + (ct0 + ct) * 32 + r]; }
        if (tid < 128) { float s = 0.f, q = 0.f;
#pragma unroll
            for (int i = 0; i < 16; ++i) { s += pst[i].x; q += pst[i].y; }
            const float mean = s * (1.0f / 1024.0f); float var = q * (1.0f / 1024.0f) - mean * mean; var = var > 0.f ? var : 0.f;
            *(LAS f32x2*)(stS + 2 * tid) = (f32x2){mean, 1.0f / sqrtf(var + LN_EPS)}; }
        __syncthreads();
#pragma unroll
        for (int k = 0; k < 4; ++k) {
            const float e[8] = {bflo(wv[k].x), bfhi(wv[k].x), bflo(wv[k].y), bfhi(wv[k].y), bflo(wv[k].z), bfhi(wv[k].z), bflo(wv[k].w), bfhi(wv[k].w)};
            float o[8];
#pragma unroll
            for (int i = 0; i < 8; i += 2) { const f32x4 st = *(const LAS f32x4*)(stS + 2 * (pseg + 8 * k + i));
                o[i] = (e[i] - st[0]) * st[1] * gg + bb; o[i + 1] = (e[i + 1] - st[2]) * st[3] * gg + bb; }
            v4u pk; pk.x = pk2(o[0], o[1]); pk.y = pk2(o[2], o[3]); pk.z = pk2(o[4], o[5]); pk.w = pk2(o[6], o[7]);
            *(LAS v4u*)(vnT + c * SG_LD + pseg + 8 * k) = pk; }
        __syncthreads();
        sg_f32x16 acc[2];
#pragma unroll
        for (int ct = 0; ct < 2; ++ct)
#pragma unroll
            for (int i = 0; i < 16; ++i) acc[ct][i] = 0.f;
#pragma unroll
        for (int kk = 0; kk < 8; ++kk)
#pragma unroll
            for (int ct = 0; ct < 2; ++ct) {
                const sg_bf16x8 bf = *(const LAS sg_bf16x8*)(vnT + ((ct0 + ct) * 32 + r) * SG_LD + 16 * kk + 8 * h);
                acc[ct] = __builtin_amdgcn_mfma_f32_32x32x16_bf16(af[kk], bf, acc[ct], 0, 0, 0);
            }
#pragma unroll
        for (int ct = 0; ct < 2; ++ct) {
            const int cc = (ct0 + ct) * 32 + r;
#pragma unroll
            for (int rg = 0; rg < 16; ++rg) {
                const int q = q0 + (rg & 3) + 8 * (rg >> 2) + 4 * h;
                AB[(size_t)(tok0 + q) * DM + g * 128 + cc] = (bf16)f2bf(bf1(uu[ct][rg]) * (acc[ct][rg] + sbv[rg]));
            }
        }
        __syncthreads();
    }
}

__device__ __forceinline__ float sconv(const bf16* ZHT, const float* cw, const float* cb, int ch, int b, int t) {
    const bf16* zp = ZHT + (size_t)ch * MTOK + b * SEQ;
    const float z0 = t > 0 ? bf1(zp[t - 1]) : 0.f, z1 = bf1(zp[t]), z2 = t < SEQ - 1 ? bf1(zp[t + 1]) : 0.f;
    return cw[ch] * z0 + cw[3072 + ch] * z1 + cw[6144 + ch] * z2 + cb[ch];
}
__device__ __forceinline__ void p3_hyena(Frame& F) {
    LAS float* Us = (LAS float*)F.lds;
    LAS float* KF = (LAS float*)(F.lds + 65536);
    const bf16* ZHT = (const bf16*)(F.ws + WS_ZHT); const float* FILT = (const float*)(F.ws + WS_FILT); bf16* AB = (bf16*)(F.ws + WS_H);
    const float* cw = F.in[I_HCW]; const float* cb = F.in[I_HCB]; const float* skip = F.in[I_HSKIP];
    const int tid = F.tid;
    for (int item = blockIdx.x; item < HYW; item += F.G) {
        const int c = item;
        for (int i = tid; i < NBATCH * SEQ; i += NWAVES * 64) { const int b = i >> 11, t = i & 2047; Us[t * 8 + b] = sconv(ZHT, cw, cb, c, b, t); }
        for (int n = 0; n < 2; ++n) {
            const float* hf = FILT + (size_t)((0 * 2 + n) * 1024 + c) * SEQ; const float* hb = FILT + (size_t)((1 * 2 + n) * 1024 + c) * SEQ;
            for (int i = tid; i < 4095; i += NWAVES * 64) { const int lag = i - 2047; KF[i] = lag > 0 ? hf[lag] : (lag == 0 ? hf[0] + hb[0] : hb[-lag]); }
            __syncthreads();
            f32x4 acc[4][2];
#pragma unroll
            for (int ti = 0; ti < 4; ++ti) { acc[ti][0] = (f32x4){0.f, 0.f, 0.f, 0.f}; acc[ti][1] = (f32x4){0.f, 0.f, 0.f, 0.f}; }
            const LAS float* kp = KF + tid + 2047;
            for (int s = 0; s < SEQ; ++s) {
                const f32x4 u0 = *(const LAS f32x4*)(Us + s * 8), u1 = *(const LAS f32x4*)(Us + s * 8 + 4);
#pragma unroll
                for (int ti = 0; ti < 4; ++ti) { const float kv = kp[512 * ti - s]; acc[ti][0] += u0 * kv; acc[ti][1] += u1 * kv; }
            }
            __syncthreads();
            const float sk = skip[n * 1024 + c];
#pragma unroll
            for (int ti = 0; ti < 4; ++ti) { const int t = tid + 512 * ti;
#pragma unroll
                for (int b = 0; b < 8; ++b) {
                    const float uv = Us[t * 8 + b], gate = sconv(ZHT, cw, cb, (n + 1) * 1024 + c, b, t);
                    const float y = gate * (acc[ti][b >> 2][b & 3] + sk * uv);
                    if (n == 0) Us[t * 8 + b] = y; else AB[(size_t)(b * SEQ + t) * DM + 1024 + c] = (bf16)f2bf(y);
                } }
            __syncthreads();
        }
    }
}

#ifndef HYFFT_HD
#define HYFFT_HD __device__ __forceinline__
#define HYFFT_LAS __attribute__((address_space(3)))
#endif
typedef float hy_c32 __attribute__((ext_vector_type(2)));
HYFFT_HD int hy_padi(int i) { return i + (i >> 3); }
HYFFT_HD int hy_rev(int x) { return ((x & 7) << 9) | (((x >> 3) & 7) << 6) | (((x >> 6) & 7) << 3) | ((x >> 9) & 7); }

template <bool INV> HYFFT_HD void hy_dft8(float (&re)[8], float (&im)[8]) {
    const float h = 0.70710678118654752f;
    float ar[4], ai[4], br[4], bi[4];
#pragma unroll
    for (int m = 0; m < 4; ++m) { ar[m] = re[m] + re[m + 4]; ai[m] = im[m] + im[m + 4]; br[m] = re[m] - re[m + 4]; bi[m] = im[m] - im[m + 4]; }
    { float x = br[1], y = bi[1]; if (!INV) { br[1] = h * (x + y); bi[1] = h * (y - x); } else { br[1] = h * (x - y); bi[1] = h * (y + x); } }
    { float x = br[2], y = bi[2]; if (!INV) { br[2] = y; bi[2] = -x; } else { br[2] = -y; bi[2] = x; } }
    { float x = br[3], y = bi[3]; if (!INV) { br[3] = h * (y - x); bi[3] = -h * (x + y); } else { br[3] = -h * (x + y); bi[3] = h * (x - y); } }
#pragma unroll
    for (int s = 0; s < 2; ++s) {
        float* cr = s ? br : ar; float* ci = s ? bi : ai;
        const float e0r = cr[0] + cr[2], e0i = ci[0] + ci[2], e1r = cr[0] - cr[2], e1i = ci[0] - ci[2];
        const float o0r = cr[1] + cr[3], o0i = ci[1] + ci[3]; const float dr = cr[1] - cr[3], di = ci[1] - ci[3];
        float o1r, o1i; if (!INV) { o1r = di; o1i = -dr; } else { o1r = -di; o1i = dr; }
        re[0 + s] = e0r + o0r; im[0 + s] = e0i + o0i;
        re[2 + s] = e1r + o1r; im[2 + s] = e1i + o1i;
        re[4 + s] = e0r - o0r; im[4 + s] = e0i - o0i;
        re[6 + s] = e1r - o1r; im[6 + s] = e1i - o1i;
    }
}
template <bool CONJ> HYFFT_HD void hy_twiddle(float (&re)[8], float (&im)[8], float wr, float wi) {
    if (CONJ) wi = -wi;
    const float w2r = wr * wr - wi * wi, w2i = 2.f * wr * wi;
    const float w3r = w2r * wr - w2i * wi, w3i = w2r * wi + w2i * wr;
    const float w4r = w2r * w2r - w2i * w2i, w4i = 2.f * w2r * w2i;
    const float w5r = w4r * wr - w4i * wi, w5i = w4r * wi + w4i * wr;
    const float w6r = w3r * w3r - w3i * w3i, w6i = 2.f * w3r * w3i;
    const float w7r = w4r * w3r - w4i * w3i, w7i = w4r * w3i + w4i * w3r;
    const float pr[8] = {1.f, wr, w2r, w3r, w4r, w5r, w6r, w7r}, pi[8] = {0.f, wi, w2i, w3i, w4i, w5i, w6i, w7i};
#pragma unroll
    for (int k = 1; k < 8; ++k) { const float x = re[k], y = im[k]; re[k] = x * pr[k] - y * pi[k]; im[k] = x * pi[k] + y * pr[k]; }
}
template <int L, class BP, class TP> HYFFT_HD void hy_fwd_store(BP buf, TP tw, int j, float (&re)[8], float (&im)[8]) {
    constexpr int S = L / 8; const int blk = j / S, q = j % S, base = blk * L + q;
    hy_dft8<false>(re, im);
    if (L > 8) { const hy_c32 w = tw[q * (4096 / L)]; hy_twiddle<false>(re, im, w.x, w.y); }
#pragma unroll
    for (int k = 0; k < 8; ++k) buf[hy_padi(base + k * S)] = (hy_c32){re[k], im[k]};
}
template <int L, class BP> HYFFT_HD void hy_load8(BP buf, int j, float (&re)[8], float (&im)[8]) {
    constexpr int S = L / 8; const int blk = j / S, q = j % S, base = blk * L + q;
#pragma unroll
    for (int k = 0; k < 8; ++k) { const hy_c32 v = buf[hy_padi(base + k * S)]; re[k] = v.x; im[k] = v.y; }
}
template <int L, class BP, class TP> HYFFT_HD void hy_fwd_stage(BP buf, TP tw, int j) { float re[8], im[8]; hy_load8<L>(buf, j, re, im); hy_fwd_store<L>(buf, tw, j, re, im); }
template <int L, class BP, class TP> HYFFT_HD void hy_inv_regs(BP buf, TP tw, int j, float (&re)[8], float (&im)[8]) {
    constexpr int S = L / 8; const int q = j % S;
    hy_load8<L>(buf, j, re, im);
    if (L > 8) { const hy_c32 w = tw[q * (4096 / L)]; hy_twiddle<true>(re, im, w.x, w.y); }
    hy_dft8<true>(re, im);
}
template <int L, class BP, class TP> HYFFT_HD void hy_inv_stage(BP buf, TP tw, int j) {
    constexpr int S = L / 8; const int blk = j / S, q = j % S, base = blk * L + q;
    float re[8], im[8]; hy_inv_regs<L>(buf, tw, j, re, im);
#pragma unroll
    for (int k = 0; k < 8; ++k) buf[hy_padi(base + k * S)] = (hy_c32){re[k], im[k]};
}
template <class BP, class KP> HYFFT_HD void hy_mid_stage(BP buf, KP K, int j) {
    float re[8], im[8]; hy_load8<8>(buf, j, re, im);
    hy_dft8<false>(re, im);
#pragma unroll
    for (int k = 0; k < 8; ++k) { const hy_c32 kv = K[hy_padi(8 * j + k)]; const float x = re[k], y = im[k]; re[k] = x * kv.x - y * kv.y; im[k] = x * kv.y + y * kv.x; }
    hy_dft8<true>(re, im);
#pragma unroll
    for (int k = 0; k < 8; ++k) buf[hy_padi(8 * j + k)] = (hy_c32){re[k], im[k]};
}
template <class BP> HYFFT_HD void hy_last_fwd(BP buf, int j) {
    float re[8], im[8]; hy_load8<8>(buf, j, re, im); hy_dft8<false>(re, im);
#pragma unroll
    for (int k = 0; k < 8; ++k) buf[hy_padi(8 * j + k)] = (hy_c32){re[k], im[k]};
}
template <class BP, class KP> HYFFT_HD void hy_separate(BP Z, KP K1, KP K2, int j) {
    const float sc = 0.5f / 4096.0f;
#pragma unroll
    for (int r = 0; r < 8; ++r) {
        const int p = j + 512 * r, f = hy_rev(p), g = (4096 - f) & 4095, p2 = hy_rev(g);
        const hy_c32 a = Z[hy_padi(p)], b = Z[hy_padi(p2)];
        K1[hy_padi(p)] = (hy_c32){(a.x + b.x) * sc, (a.y - b.y) * sc};
        K2[hy_padi(p)] = (hy_c32){(a.y + b.y) * sc, (b.x - a.x) * sc};
    }
}

struct Raw3 { bf16 a, b, c; };
__device__ __forceinline__ Raw3 raw3(const bf16* zp, int t) { const bf16* p = zp + t; Raw3 r; r.a = p[-1]; r.b = p[0]; r.c = p[1]; return r; }
template <bool M0, bool M7> __device__ __forceinline__ float sconv_raw(const Raw3& r, int t, float w0, float w1, float w2, float cb) {
    float z0 = bf1(r.a), z2 = bf1(r.c); const float z1 = bf1(r.b);
    if (M0) z0 = t > 0 ? z0 : 0.f;
    if (M7) z2 = t < SEQ - 1 ? z2 : 0.f;
    return w0 * z0 + w1 * z1 + w2 * z2 + cb;
}
__device__ __forceinline__ float sconv_raw_m(int m, const Raw3& r, int t, float w0, float w1, float w2, float cb) {
    return m == 0 ? sconv_raw<true, false>(r, t, w0, w1, w2, cb) : (m == 7 ? sconv_raw<false, true>(r, t, w0, w1, w2, cb) : sconv_raw<false, false>(r, t, w0, w1, w2, cb));
}
HYFFT_HD int hy16_padi(int i) { return i + (i >> 4); }
HYFFT_HD int hy16_rev(int x) { return ((x & 15) << 8) | (x & 0xF0) | ((x >> 8) & 15); }
template <bool INV> HYFFT_HD void hy16_dft4(float& r0, float& i0, float& r1, float& i1, float& r2, float& i2, float& r3, float& i3) {
    const float e0r = r0 + r2, e0i = i0 + i2, e1r = r0 - r2, e1i = i0 - i2, o0r = r1 + r3, o0i = i1 + i3, dr = r1 - r3, di = i1 - i3;
    float o1r, o1i; if (!INV) { o1r = di; o1i = -dr; } else { o1r = -di; o1i = dr; }
    r0 = e0r + o0r; i0 = e0i + o0i; r1 = e1r + o1r; i1 = e1i + o1i; r2 = e0r - o0r; i2 = e0i - o0i; r3 = e1r - o1r; i3 = e1i - o1i;
}
template <bool INV> HYFFT_HD void hy16_cmulc(float& r, float& i, float cr, float ci) { if (INV) ci = -ci; const float x = r, y = i; r = x * cr - y * ci; i = x * ci + y * cr; }
template <bool INV> HYFFT_HD void hy16_dft16(float (&re)[16], float (&im)[16]) {
    const float c1 = 0.92387953251128674f, s1 = 0.38268343236508977f, h = 0.70710678118654752f;
#pragma unroll
    for (int m2 = 0; m2 < 4; ++m2) hy16_dft4<INV>(re[m2], im[m2], re[4 + m2], im[4 + m2], re[8 + m2], im[8 + m2], re[12 + m2], im[12 + m2]);
    hy16_cmulc<INV>(re[4 * 1 + 1], im[4 * 1 + 1], c1, -s1);
    hy16_cmulc<INV>(re[4 * 2 + 1], im[4 * 2 + 1], h, -h);
    hy16_cmulc<INV>(re[4 * 3 + 1], im[4 * 3 + 1], s1, -c1);
    hy16_cmulc<INV>(re[4 * 1 + 2], im[4 * 1 + 2], h, -h);
    hy16_cmulc<INV>(re[4 * 2 + 2], im[4 * 2 + 2], 0.f, -1.f);
    hy16_cmulc<INV>(re[4 * 3 + 2], im[4 * 3 + 2], -h, -h);
    hy16_cmulc<INV>(re[4 * 1 + 3], im[4 * 1 + 3], s1, -c1);
    hy16_cmulc<INV>(re[4 * 2 + 3], im[4 * 2 + 3], -h, -h);
    hy16_cmulc<INV>(re[4 * 3 + 3], im[4 * 3 + 3], -c1, s1);
#pragma unroll
    for (int k1 = 0; k1 < 4; ++k1) hy16_dft4<INV>(re[4 * k1], im[4 * k1], re[4 * k1 + 1], im[4 * k1 + 1], re[4 * k1 + 2], im[4 * k1 + 2], re[4 * k1 + 3], im[4 * k1 + 3]);
#pragma unroll
    for (int a = 0; a < 4; ++a)
#pragma unroll
        for (int b = a + 1; b < 4; ++b) { float t = re[4 * a + b]; re[4 * a + b] = re[4 * b + a]; re[4 * b + a] = t; t = im[4 * a + b]; im[4 * a + b] = im[4 * b + a]; im[4 * b + a] = t; }
}
template <bool CONJ> HYFFT_HD void hy16_twiddle(float (&re)[16], float (&im)[16], float wr, float wi) {
    if (CONJ) wi = -wi;
    float pr[16], pi[16]; pr[1] = wr; pi[1] = wi;
#define HY16_SQ(d, a) pr[d] = pr[a] * pr[a] - pi[a] * pi[a]; pi[d] = 2.f * pr[a] * pi[a];
#define HY16_MUL(d, a, b) pr[d] = pr[a] * pr[b] - pi[a] * pi[b]; pi[d] = pr[a] * pi[b] + pi[a] * pr[b];
    HY16_SQ(2, 1) HY16_MUL(3, 2, 1) HY16_SQ(4, 2) HY16_MUL(5, 4, 1) HY16_SQ(6, 3) HY16_MUL(7, 4, 3) HY16_SQ(8, 4)
    HY16_MUL(9, 8, 1) HY16_SQ(10, 5) HY16_MUL(11, 8, 3) HY16_SQ(12, 6) HY16_MUL(13, 8, 5) HY16_SQ(14, 7) HY16_MUL(15, 8, 7)
#undef HY16_SQ
#undef HY16_MUL
#pragma unroll
    for (int k = 1; k < 16; ++k) { const float x = re[k], y = im[k]; re[k] = x * pr[k] - y * pi[k]; im[k] = x * pi[k] + y * pr[k]; }
}
template <int L, class BP> HYFFT_HD void hy16_load(BP buf, int jj, float (&re)[16], float (&im)[16]) {
    constexpr int S = L / 16; const int blk = jj / S, q = jj % S, pb = hy16_padi(blk * L + q);
#pragma unroll
    for (int k = 0; k < 16; ++k) { const hy_c32 v = buf[pb + k * (S + S / 16)]; re[k] = v.x; im[k] = v.y; }
}
template <class BP> HYFFT_HD void hy16_load1(BP buf, int jj, float (&re)[16], float (&im)[16]) {
#pragma unroll
    for (int k = 0; k < 16; ++k) { const hy_c32 v = buf[17 * jj + k]; re[k] = v.x; im[k] = v.y; }
}
template <int L, class BP> HYFFT_HD void hy16_store(BP buf, int jj, const float (&re)[16], const float (&im)[16]) {
    constexpr int S = L / 16; const int blk = jj / S, q = jj % S, pb = hy16_padi(blk * L + q);
#pragma unroll
    for (int k = 0; k < 16; ++k) buf[pb + k * (S + S / 16)] = (hy_c32){re[k], im[k]};
}
template <class BP> HYFFT_HD void hy16_store1(BP buf, int jj, const float (&re)[16], const float (&im)[16]) {
#pragma unroll
    for (int k = 0; k < 16; ++k) buf[17 * jj + k] = (hy_c32){re[k], im[k]};
}
template <int L, class BP, class TP> HYFFT_HD void hy16_fwd_store(BP buf, TP tw, int jj, float (&re)[16], float (&im)[16]) {
    constexpr int S = L / 16; const int q = jj % S;
    hy16_dft16<false>(re, im);
    { const hy_c32 w = tw[q * (4096 / L)]; hy16_twiddle<false>(re, im, w.x, w.y); }
    hy16_store<L>(buf, jj, re, im);
}
template <int L, class BP, class TP> HYFFT_HD void hy16_fwd_stage(BP buf, TP tw, int jj) { float re[16], im[16]; hy16_load<L>(buf, jj, re, im); hy16_fwd_store<L>(buf, tw, jj, re, im); }
template <int L, class BP, class TP> HYFFT_HD void hy16_inv_regs(BP buf, TP tw, int jj, float (&re)[16], float (&im)[16]) {
    constexpr int S = L / 16; const int q = jj % S;
    hy16_load<L>(buf, jj, re, im);
    { const hy_c32 w = tw[q * (4096 / L)]; hy16_twiddle<true>(re, im, w.x, w.y); }
    hy16_dft16<true>(re, im);
}
template <int L, class BP, class TP> HYFFT_HD void hy16_inv_stage(BP buf, TP tw, int jj) { float re[16], im[16]; hy16_inv_regs<L>(buf, tw, jj, re, im); hy16_store<L>(buf, jj, re, im); }
template <class BP, class KP> HYFFT_HD void hy16_mid_stage(BP buf, KP K, int jj) {
    float re[16], im[16]; hy16_load1(buf, jj, re, im);
    hy16_dft16<false>(re, im);
#pragma unroll
    for (int k = 0; k < 16; ++k) { const hy_c32 kv = K[17 * jj + k]; const float x = re[k], y = im[k]; re[k] = x * kv.x - y * kv.y; im[k] = x * kv.y + y * kv.x; }
    hy16_dft16<true>(re, im);
    hy16_store1(buf, jj, re, im);
}
template <class BP> HYFFT_HD void hy16_last_fwd(BP buf, int jj) { float re[16], im[16]; hy16_load1(buf, jj, re, im); hy16_dft16<false>(re, im); hy16_store1(buf, jj, re, im); }
template <class BP, class KP> HYFFT_HD void hy16_separate(BP Z, KP K1, KP K2, int t) {
    const float sc = 0.5f / 4096.0f;
#pragma unroll
    for (int r = 0; r < 8; ++r) {
        const int p = t + 512 * r, f = hy16_rev(p), g = (4096 - f) & 4095, p2 = hy16_rev(g);
        const hy_c32 a = Z[hy16_padi(p)], b = Z[hy16_padi(p2)];
        K1[hy16_padi(p)] = (hy_c32){(a.x + b.x) * sc, (a.y - b.y) * sc};
        K2[hy16_padi(p)] = (hy_c32){(a.y + b.y) * sc, (b.x - a.x) * sc};
    }
}
__device__ __forceinline__ void p3_hyena_fft(Frame& F) {
    const int tid0 = F.tid;
    const int half = __builtin_amdgcn_readfirstlane(tid0 >> 8);
    LAS hy_c32* BUF = (LAS hy_c32*)(F.lds + half * 34816);
    LAS hy_c32* B0 = (LAS hy_c32*)(F.lds + 0);
    LAS hy_c32* K1 = (LAS hy_c32*)(F.lds + 69632); LAS hy_c32* K2 = (LAS hy_c32*)(F.lds + 104448); LAS hy_c32* TW = (LAS hy_c32*)(F.lds + 139264);
    const bf16* ZHT = (const bf16*)(F.ws + WS_ZHT); const float* FILT = (const float*)(F.ws + WS_FILT); bf16* YT = (bf16*)(F.ws + WS_YT);
    const float* cw = F.in[I_HCW]; const float* cb = F.in[I_HCB]; const float* skip = F.in[I_HSKIP];
    if (tid0 < 256) { float sn, cs; sincosf(-6.283185307179586f * (float)tid0 / 4096.0f, &sn, &cs); TW[tid0] = (hy_c32){cs, sn}; }
    __syncthreads();
    for (int item = blockIdx.x; item < HYW; item += F.G) {
        const int c = item;
        int tid = tid0; asm volatile("" : "+v"(tid));
        int jj = tid & 255;
        float re[16], im[16];
        const bf16* zv = ZHT + (size_t)c * MTOK; const bf16* za = ZHT + (size_t)(1024 + c) * MTOK; const bf16* zb = ZHT + (size_t)(2048 + c) * MTOK;
        {
            if (half == 0) {
                const float* hf0 = FILT + (size_t)(0 * 1024 + c) * SEQ; const float* hf1 = FILT + (size_t)(1 * 1024 + c) * SEQ;
                const float* hb0 = FILT + (size_t)(2 * 1024 + c) * SEQ; const float* hb1 = FILT + (size_t)(3 * 1024 + c) * SEQ;
#pragma unroll
                for (int m = 0; m < 8; ++m) { const int i = jj + 256 * m; re[m] = hf0[i]; im[m] = hf1[i]; }
                if (jj == 0) { re[0] += hb0[0]; im[0] += hb1[0]; }
#pragma unroll
                for (int m = 8; m < 16; ++m) { const int i = jj + 256 * m; const bool z = (i == 2048); const int r = z ? 0 : 4096 - i; const float a = hb0[r], b = hb1[r]; re[m] = z ? 0.f : a; im[m] = z ? 0.f : b; }
                hy16_fwd_store<4096>(B0, TW, jj, re, im);
            }
            __syncthreads();
            if (half == 0) hy16_fwd_stage<256>(B0, TW, jj);
            __syncthreads();
            if (half == 0) hy16_last_fwd(B0, jj);
            __syncthreads();
            hy16_separate(B0, K1, K2, tid); __syncthreads();
        }
        const float vw0 = cw[c], vw1 = cw[3072 + c], vw2 = cw[6144 + c], vcb = cb[c];
        const float aw0 = cw[1024 + c], aw1 = cw[3072 + 1024 + c], aw2 = cw[6144 + 1024 + c], acb = cb[1024 + c];
        const float bw0 = cw[2048 + c], bw1 = cw[3072 + 2048 + c], bw2 = cw[6144 + 2048 + c], bcb = cb[2048 + c];
        const float sk0 = skip[c], sk1 = skip[1024 + c];
#pragma unroll 1
        for (int rd = 0; rd < 2; ++rd) {
            const int boff = (4 * rd + 2 * half) * SEQ;
            asm volatile("" : "+v"(jj));
            Raw3 rg[2][8];
            float v[2][8];
#pragma unroll
            for (int m = 0; m < 8; ++m) { const int t = jj + 256 * m;
                const Raw3 r0 = raw3(zv + boff, t), r1 = raw3(zv + boff + SEQ, t); v[0][m] = sconv_raw_m(m, r0, t, vw0, vw1, vw2, vcb); v[1][m] = sconv_raw_m(m, r1, t, vw0, vw1, vw2, vcb); }
#pragma unroll
            for (int m = 0; m < 8; ++m) { re[m] = v[0][m]; im[m] = v[1][m]; re[m + 8] = 0.f; im[m + 8] = 0.f; }
            hy16_fwd_store<4096>(BUF, TW, jj, re, im); __syncthreads();
            hy16_fwd_stage<256>(BUF, TW, jj); __syncthreads();
            hy16_mid_stage(BUF, K1, jj); __syncthreads();
#pragma unroll
            for (int m = 0; m < 8; ++m) { const int t = jj + 256 * m; rg[0][m] = raw3(za + boff, t); rg[1][m] = raw3(za + boff + SEQ, t); }
            hy16_inv_stage<256>(BUF, TW, jj); __syncthreads();
            hy16_inv_regs<4096>(BUF, TW, jj, re, im);
#pragma unroll
            for (int m = 0; m < 8; ++m) { const int t = jj + 256 * m;
                v[0][m] = sconv_raw_m(m, rg[0][m], t, aw0, aw1, aw2, acb) * (re[m] + sk0 * v[0][m]); v[1][m] = sconv_raw_m(m, rg[1][m], t, aw0, aw1, aw2, acb) * (im[m] + sk0 * v[1][m]); }
#pragma unroll
            for (int m = 0; m < 8; ++m) { re[m] = v[0][m]; im[m] = v[1][m]; re[m + 8] = 0.f; im[m + 8] = 0.f; }
            hy16_fwd_store<4096>(BUF, TW, jj, re, im); __syncthreads();
            hy16_fwd_stage<256>(BUF, TW, jj); __syncthreads();
            hy16_mid_stage(BUF, K2, jj); __syncthreads();
#pragma unroll
            for (int m = 0; m < 8; ++m) { const int t = jj + 256 * m; rg[0][m] = raw3(zb + boff, t); rg[1][m] = raw3(zb + boff + SEQ, t); }
            hy16_inv_stage<256>(BUF, TW, jj); __syncthreads();
            hy16_inv_regs<4096>(BUF, TW, jj, re, im);
#pragma unroll
            for (int m = 0; m < 8; ++m) { const int t = jj + 256 * m; bf16* yp = YT + (size_t)c * MTOK + boff + t;
                yp[0] = (bf16)f2bf(sconv_raw_m(m, rg[0][m], t, bw0, bw1, bw2, bcb) * (re[m] + sk1 * v[0][m]));
                yp[SEQ] = (bf16)f2bf(sconv_raw_m(m, rg[1][m], t, bw0, bw1, bw2, bcb) * (im[m] + sk1 * v[1][m])); }
        }
        __syncthreads();
    }
}

__device__ __forceinline__ void p3c_transpose(Frame& F) {
    constexpr int LD = 264;
    LAS bf16* tile = (LAS bf16*)F.lds;
    const bf16* YT = (const bf16*)(F.ws + WS_YT); bf16* AB = (bf16*)(F.ws + WS_H);
    const int tid = F.tid;
    for (int it = blockIdx.x; it < 16 * 64; it += F.G) {
        const int c0 = (it >> 6) * 64, t0 = (it & 63) * 256;
        { const int c = tid >> 3, ts = (tid & 7) * 32; const bf16* src = YT + (size_t)(c0 + c) * MTOK + t0 + ts;
          v4u w[4];
#pragma unroll
          for (int k = 0; k < 4; ++k) w[k] = *(const v4u*)(src + 8 * k);
#pragma unroll
          for (int k = 0; k < 4; ++k) *(LAS v4u*)(tile + c * LD + ts + 8 * k) = w[k]; }
        __syncthreads();
        { const int t = tid >> 1, cs = (tid & 1) * 32; unsigned o[16];
#pragma unroll
          for (int i = 0; i < 16; ++i) o[i] = (unsigned)tile[(cs + 2 * i) * LD + t] | ((unsigned)tile[(cs + 2 * i + 1) * LD + t] << 16);
          bf16* dst = AB + (size_t)(t0 + t) * DM + 1024 + c0 + cs;
#pragma unroll
          for (int k = 0; k < 4; ++k) *(v4u*)(dst + 8 * k) = (v4u){o[4 * k], o[4 * k + 1], o[4 * k + 2], o[4 * k + 3]}; }
        __syncthreads();
    }
}

typedef _Float16 ln_f16x4 __attribute__((ext_vector_type(4)));
template <bool FINAL> __device__ __forceinline__ void ln_rows(Frame& F) {
    const _Float16* R = FINAL ? (const _Float16*)(F.ws + WS_H) : (const _Float16*)F.out;
    const float* st = (const float*)(F.ws + (FINAL ? WS_ST2 : WS_ST1)); float* MU = (float*)(F.ws + WS_MU1);
    const float* mod = (const float*)(F.ws + WS_MOD); bf16* H2 = (bf16*)(F.ws + WS_H);
    const float* lng = F.in[FINAL ? I_LN2G : I_LN1G]; const float* lnb = F.in[FINAL ? I_LN2B : I_LN1B];
    const int gw = blockIdx.x * NWAVES + F.wave, NGW = F.G * NWAVES, lane = F.lane;
    ln_f16x4 cur[8], nxt[8]; f32x2 ps = (f32x2){0.f, 0.f}, pn = (f32x2){0.f, 0.f};
    int row = gw;
    if (row < MTOK) {
#pragma unroll
        for (int j = 0; j < 8; ++j) cur[j] = *(const ln_f16x4*)(R + (size_t)row * DM + 4 * lane + 256 * j);
        if (lane < 32) ps = *(const f32x2*)(st + ((size_t)row * 32 + lane) * 2);
    }
    for (; row < MTOK; row += NGW) {
        const int rn = row + NGW;
        if (rn < MTOK) {
#pragma unroll
            for (int j = 0; j < 8; ++j) nxt[j] = *(const ln_f16x4*)(R + (size_t)rn * DM + 4 * lane + 256 * j);
            pn = (f32x2){0.f, 0.f}; if (lane < 32) pn = *(const f32x2*)(st + ((size_t)rn * 32 + lane) * 2);
        }
        const float s = wave_sum(ps.x), q = wave_sum(ps.y);
        const float mean = s * (1.0f / DM); float var = q * (1.0f / DM) - mean * mean; var = var > 0.f ? var : 0.f; const float rstd = 1.0f / sqrtf(var + LN_EPS);
        if (!FINAL && lane == 0) *(f32x2*)(MU + (size_t)row * 2) = (f32x2){mean, rstd};
        const int b = row >> 11;
#pragma unroll
        for (int j = 0; j < 8; ++j) { const int col = 4 * lane + 256 * j;
            const f32x4 v = (f32x4){(float)cur[j][0], (float)cur[j][1], (float)cur[j][2], (float)cur[j][3]};
            const f32x4 y = (v - mean) * rstd * *(const f32x4*)(lng + col) + *(const f32x4*)(lnb + col);
            if (FINAL) *(f32x4*)(F.out + (size_t)row * DM + col) = y;
            else { const float* mp = mod + (size_t)b * MODW + col; const f32x4 h = y * (*(const f32x4*)(mp + 4 * DM) + 1.0f) + *(const f32x4*)(mp + 3 * DM);
                   v2u o; o.x = pk2(h[0], h[1]); o.y = pk2(h[2], h[3]); *(v2u*)(H2 + (size_t)row * DM + col) = o; } }
#pragma unroll
        for (int j = 0; j < 8; ++j) cur[j] = nxt[j];
        ps = pn;
    }
}

typedef GAS unsigned gu32;
#define RLX_AGENT __ATOMIC_RELAXED, __HIP_MEMORY_SCOPE_AGENT
constexpr int LDSCTL_OFF = 163840 - 512, MISC_OFF = LDSCTL_OFF;
constexpr int CW_BAR = 4096;
constexpr size_t CTL_ZERO_BYTES = 65536;
#define XB_TMO      128
#define XB_XCNT(j)  (256  + 64 * (j))
#define XB_XSUB(j)  (1280 + 64 * (j))
#define XB_XGEN(j)  (2304 + 64 * (j))
#define XB_TOP      3328
#define XB_TOPGEN   3392
#define XCD_BAR_WORDS 3456
#define XB_SPIN_CAP (1u << 18)

__device__ __forceinline__ unsigned xb_ld(unsigned* p)              { return __hip_atomic_load(p, __ATOMIC_RELAXED, __HIP_MEMORY_SCOPE_AGENT); }
__device__ __forceinline__ unsigned xb_add(unsigned* p, unsigned v) { return __hip_atomic_fetch_add(p, v, __ATOMIC_RELAXED, __HIP_MEMORY_SCOPE_AGENT); }
__device__ __forceinline__ unsigned xb_xcc_id() { return (unsigned)__builtin_amdgcn_s_getreg((3 << 11) | 20) & 0xFu; }
#define XB_SPIN(cond, bar) do { unsigned _sp = 0; while (cond) { __builtin_amdgcn_s_sleep(1); \
    if ((++_sp & 255u) == 0u) { if (xb_ld(&(bar)[XB_TMO])) break; if (_sp > XB_SPIN_CAP) { atomicAdd(&(bar)[XB_TMO], 1u); break; } } } } while (0)

struct XcdBarrier {
    unsigned* bar; unsigned x;
    volatile LAS unsigned* st;
};

__device__ __forceinline__ XcdBarrier xcd_barrier_post(unsigned* bar, volatile LAS unsigned* st) {
    XcdBarrier b; b.bar = bar; b.x = xb_xcc_id(); b.st = st;
    if (threadIdx.x == 0) (void)xb_add(&bar[XB_XCNT(b.x)], 1u);
    return b;
}
__device__ __forceinline__ void xcd_barrier_complete(unsigned* bar, unsigned x, unsigned& nloc, unsigned& nx) {
    const unsigned G = gridDim.x * gridDim.y * gridDim.z;
    unsigned sum, cnt, mine, sp = 0u;
    for (;;) {
        sum = 0u; cnt = 0u; mine = 0u;
#pragma unroll
        for (unsigned j = 0; j < 16; ++j) { const unsigned c = xb_ld(&bar[XB_XCNT(j)]); sum += c; cnt += (c > 0u) ? 1u : 0u; mine = (j == x) ? c : mine; }
        if (sum == G) break;
        __builtin_amdgcn_s_sleep(1);
        if ((++sp & 255u) == 0u) { if (xb_ld(&bar[XB_TMO])) break; if (sp > XB_SPIN_CAP) { atomicAdd(&bar[XB_TMO], 1u); break; } }
    }
    nloc = mine > 0u ? mine : 1u; nx = cnt > 0u ? cnt : 1u;
}

__device__ __forceinline__ void xcd_barrier(const XcdBarrier& b) {
    asm volatile("s_waitcnt vmcnt(0)" ::: "memory");
    __syncthreads();
    if (threadIdx.x == 0) {
        unsigned* bar = b.bar;
        __builtin_amdgcn_s_waitcnt(0);
        unsigned nloc = b.st[0], nx = b.st[1];
        if (nloc == 0u) { xcd_barrier_complete(bar, b.x, nloc, nx); b.st[0] = nloc; b.st[1] = nx; }
        const unsigned old = xb_add(&bar[XB_XSUB(b.x)], 1u);
        const unsigned gen = old / nloc;
        if (old + 1u == (gen + 1u) * nloc) {
            __builtin_amdgcn_fence(__ATOMIC_RELEASE, "agent");
            asm volatile("s_waitcnt vmcnt(0)" ::: "memory");
            const unsigned og = xb_add(&bar[XB_TOP], 1u);
            const unsigned tg = og / nx;
            if (og + 1u == (tg + 1u) * nx) xb_add(&bar[XB_TOPGEN], 1u);
            else XB_SPIN(xb_ld(&bar[XB_TOPGEN]) == tg, bar);
            __builtin_amdgcn_fence(__ATOMIC_ACQUIRE, "agent");
            xb_add(&bar[XB_XGEN(b.x)], 1u);
            asm volatile("s_waitcnt vmcnt(0)" ::: "memory");
        } else {
            XB_SPIN(xb_ld(&bar[XB_XGEN(b.x)]) == gen, bar);
            __builtin_amdgcn_fence(__ATOMIC_ACQUIRE, "agent");
            asm volatile("s_waitcnt vmcnt(0)" ::: "memory");
        }
    }
    __syncthreads();
}

#define GRID_SYNC() xcd_barrier(bar)

__global__ void __launch_bounds__(NWAVES * 64, 2) fwd_megakernel(Args args) {
    extern __shared__ __attribute__((aligned(16))) unsigned char lds[];
    Frame F;
    F.lds = (LAS unsigned char*)lds;
    F.tid = threadIdx.x; F.lane = F.tid & 63; F.wave = __builtin_amdgcn_readfirstlane(F.tid >> 6); F.G = gridDim.x;
    F.in = args.in; F.out = args.out; F.ws = args.ws;
    for (int u = F.tid; u < (LDS_BYTES - LDSCTL_OFF) / 4; u += NWAVES * 64) ((LAS unsigned*)(F.lds + LDSCTL_OFF))[u] = 0u;
    __syncthreads();
    XcdBarrier bar = xcd_barrier_post((unsigned*)(args.ws + WS_CTL) + CW_BAR, (volatile LAS unsigned*)(F.lds + MISC_OFF) + 8);
    unsigned char* ws = args.ws;
    const int lo = args.ph_lo, hi = args.ph_hi;
#define IN(k) (lo <= (k) && (k) < hi)
#define BOTH(k) (IN(k) && IN((k) + 1))
    const int gw = blockIdx.x * NWAVES + F.wave, NGW = F.G * NWAVES;

    PB_START(1, F.lds);
    if (IN(0)) { { int t_ = threadIdx.x; asm volatile("" : "+v"(t_)); F.tid = t_; F.lane = t_ & 63; }
        PB_START(21, F.lds); p0_mod(F); PB_END(21, F.lds);
        PB_START(22, F.lds);
        transpose_matrix(F, F.in[I_WIN], DM, INW, (bf16*)(ws + WS_WIN), DM, 0, 1, (int)blockIdx.x, F.G);
        transpose_matrix(F, F.in[I_WA], SGUW, DM, (bf16*)(ws + WS_WAB), DM, 0, 0, (int)((blockIdx.x + 128) % F.G), F.G);
        transpose_matrix(F, F.in[I_WB], HYW, DM, (bf16*)(ws + WS_WAB), DM, 1024, 0, (int)blockIdx.x, F.G);
        transpose_matrix(F, F.in[I_WO], DM, DM, (bf16*)(ws + WS_WO), DM, 0, 0, (int)blockIdx.x, F.G);
        { const float* sw = F.in[I_SW]; bf16* sgw = (bf16*)(ws + WS_SGW);
          for (int i = blockIdx.x * (NWAVES * 64) + F.tid; i < 8 * 128 * 128 / 2; i += F.G * NWAVES * 64) { const f32x2 v = *(const f32x2*)(sw + 2 * i); *(unsigned*)(sgw + 2 * i) = pk2(v.x, v.y); } }
        __syncthreads();
        __syncthreads(); p0_hid2(F);
        PB_END(22, F.lds);
        if (BOTH(0)) GRID_SYNC();
    }
    PB_END(1, F.lds);
    PB_START(2, F.lds);
    if (IN(1)) { { int t_ = threadIdx.x; asm volatile("" : "+v"(t_)); F.tid = t_; F.lane = t_ & 63; } if (F.wave < 4) p1_modulate(F); else p1_filter_waves(F); if (BOTH(1)) GRID_SYNC(); }
    PB_END(2, F.lds);
    PB_START(3, F.lds);
    if (IN(2)) { { int t_ = threadIdx.x; asm volatile("" : "+v"(t_)); F.tid = t_; F.lane = t_ & 63; }
        { pg8::Gemm g{(const pg8::bf16_t*)(ws + WS_H), (const pg8::bf16_t*)(ws + WS_WIN), MTOK, 5120, DM}; pg8::StaticOrder S; S.init(MTOK, 5120, F.G, (int)blockIdx.x, WGM_P2A);
          pg8::EpiG1 E{(pg8::bf16_t*)(ws + WS_U), (pg8::bf16_t*)(ws + WS_G), F.in[I_BIN]};
          pg8::gemm_phase<pg8::EpiG1, pg8::StaticOrder, true, true>(F.lds, g, S, E); }
        __syncthreads();
        { pg8::Gemm g{(const pg8::bf16_t*)(ws + WS_WIN) + (size_t)5120 * DM, (const pg8::bf16_t*)(ws + WS_H), 4096, MTOK, DM}; pg8::StaticOrder S; S.init(4096, MTOK, F.G, (int)blockIdx.x, WGM_P2B);
          pg8::EpiG1T E{(pg8::bf16_t*)(ws + WS_V), (pg8::bf16_t*)(ws + WS_ZHT), F.in[I_BIN], (float*)(ws + WS_STV)};
          pg8::gemm_phase<pg8::EpiG1T, pg8::StaticOrder, true, true>(F.lds, g, S, E); }
        if (BOTH(2)) GRID_SYNC();
    }
    PB_END(3, F.lds);
    PB_START(4, F.lds);
    if (IN(3)) { { int t_ = threadIdx.x; asm volatile("" : "+v"(t_)); F.tid = t_; F.lane = t_ & 63; } __syncthreads(); PB_START(41, F.lds); p3_sgu(F); PB_END(41, F.lds); PB_START(42, F.lds); p3_hyena_fft(F); PB_END(42, F.lds); if (BOTH(3)) GRID_SYNC(); PB_START(43, F.lds); p3c_transpose(F); GRID_SYNC(); PB_END(43, F.lds); }
    PB_END(4, F.lds);
    PB_START(5, F.lds);
    if (IN(4)) { { int t_ = threadIdx.x; asm volatile("" : "+v"(t_)); F.tid = t_; F.lane = t_ & 63; }
        pg8::Gemm g{(const pg8::bf16_t*)(ws + WS_H), (const pg8::bf16_t*)(ws + WS_WAB), MTOK, DM, DM}; pg8::StaticOrder S; S.init(MTOK, DM, F.G, (int)blockIdx.x, WGM_P4);
        pg8::EpiG2 E{(const pg8::bf16_t*)(ws + WS_G), (pg8::bf16_t*)(ws + WS_MERGED)};
        pg8::gemm_phase<pg8::EpiG2, pg8::StaticOrder, true, true>(F.lds, g, S, E);
        if (BOTH(4)) GRID_SYNC();
    }
    PB_END(5, F.lds);
    PB_START(6, F.lds);
    if (IN(5)) { { int t_ = threadIdx.x; asm volatile("" : "+v"(t_)); F.tid = t_; F.lane = t_ & 63; }
        pg8::Gemm g{(const pg8::bf16_t*)(ws + WS_MERGED), (const pg8::bf16_t*)(ws + WS_WO), MTOK, DM, DM}; pg8::StaticOrder S; S.init(MTOK, DM, F.G, (int)blockIdx.x, WGM_P5);
        pg8::EpiRes<true> E{F.in[I_X], nullptr, (_Float16*)F.out, (const float*)(ws + WS_MOD) + 2 * DM, F.in[I_BO], nullptr, nullptr, nullptr, (float*)(ws + WS_ST1)};
        pg8::gemm_phase<pg8::EpiRes<true>, pg8::StaticOrder, true, true>(F.lds, g, S, E);
        if (BOTH(5)) GRID_SYNC();
    }
    PB_END(6, F.lds);
    PB_START(7, F.lds);
    if (IN(6)) { { int t_ = threadIdx.x; asm volatile("" : "+v"(t_)); F.tid = t_; F.lane = t_ & 63; }
        __syncthreads();
        ln_rows<false>(F);
        __syncthreads();
        transpose_matrix(F, F.in[I_WM1], DM, DFF, (bf16*)(ws + WS_WM1), DM, 0, 0, (int)blockIdx.x, F.G);
        transpose_matrix(F, F.in[I_WM2], DFF, DM, (bf16*)(ws + WS_WM2), DFF, 0, 0, (int)blockIdx.x, F.G);
        if (BOTH(6)) GRID_SYNC();
    }
    PB_END(7, F.lds);
    PB_START(8, F.lds);
    if (IN(7)) { { int t_ = threadIdx.x; asm volatile("" : "+v"(t_)); F.tid = t_; F.lane = t_ & 63; }
        __syncthreads();
        pg8::Gemm g{(const pg8::bf16_t*)(ws + WS_H), (const pg8::bf16_t*)(ws + WS_WM1), MTOK, DFF, DM}; pg8::StaticOrder S; S.init(MTOK, DFF, F.G, (int)blockIdx.x, WGM_P7);
        pg8::EpiG4 E{(pg8::bf16_t*)(ws + WS_AFF), F.in[I_BM1]};
        pg8::gemm_phase<pg8::EpiG4, pg8::StaticOrder, true, true>(F.lds, g, S, E);
        if (BOTH(7)) GRID_SYNC();
    }
    PB_END(8, F.lds);
    PB_START(9, F.lds);
    if (IN(8)) { { int t_ = threadIdx.x; asm volatile("" : "+v"(t_)); F.tid = t_; F.lane = t_ & 63; }
        pg8::Gemm g{(const pg8::bf16_t*)(ws + WS_AFF), (const pg8::bf16_t*)(ws + WS_WM2), MTOK, DM, DFF}; pg8::StaticOrder S; S.init(MTOK, DM, F.G, (int)blockIdx.x, WGM_P8);
        pg8::EpiRes<false> E{nullptr, (const _Float16*)F.out, (_Float16*)(ws + WS_H), (const float*)(ws + WS_MOD) + 5 * DM, F.in[I_BM2], F.in[I_LN1G], F.in[I_LN1B], (const float*)(ws + WS_MU1), (float*)(ws + WS_ST2)};
        pg8::gemm_phase<pg8::EpiRes<false>, pg8::StaticOrder, true, true>(F.lds, g, S, E);
        if (BOTH(8)) GRID_SYNC();
    }
    PB_END(9, F.lds);
    PB_START(10, F.lds);
    if (IN(9)) { { int t_ = threadIdx.x; asm volatile("" : "+v"(t_)); F.tid = t_; F.lane = t_ & 63; } ln_rows<true>(F); }
    PB_END(10, F.lds);
    if (PROBE_ID != 0 && blockIdx.x == 0 && threadIdx.x == 0) { const unsigned long long wait_ = *(volatile LAS unsigned long long*)(F.lds + PB_LDS_OFF), t0_ = __builtin_amdgcn_s_memrealtime();
        while (__builtin_amdgcn_s_memrealtime() - t0_ < wait_) __builtin_amdgcn_s_sleep(8); }
#undef IN
#undef BOTH
}

constexpr int N_PHASES = 10;
#ifndef MK_N_LAUNCHES
#define MK_N_LAUNCHES 1
#endif
extern "C" void kernel_launch(void* const* d_in, const int* in_sizes, int n_in, void* d_out, int out_size, void* d_ws, size_t ws_size, hipStream_t stream) {
    static int grid = 0;
    if (grid == 0) {
        if (n_in != 31 || in_sizes[0] != MTOK * DM || out_size != MTOK * DM || ws_size < WS_END) {
            fprintf(stderr, "kernel_launch: unexpected problem: n_in %d in0 %d out %d ws %zu (need %zu)\n", n_in, n_in > 0 ? in_sizes[0] : -1, out_size, ws_size, (size_t)WS_END); grid = -1; return; }
        int dev = 0, cus = 0, per_cu = 0;
        if (hipGetDevice(&dev) != hipSuccess || hipDeviceGetAttribute(&cus, hipDeviceAttributeMultiprocessorCount, dev) != hipSuccess) { grid = -1; return; }
        if (hipFuncSetAttribute((const void*)fwd_megakernel, hipFuncAttributeMaxDynamicSharedMemorySize, LDS_BYTES) != hipSuccess) { fprintf(stderr, "kernel_launch: hipFuncSetAttribute failed\n"); grid = -1; return; }
        if (hipOccupancyMaxActiveBlocksPerMultiprocessor(&per_cu, (const void*)fwd_megakernel, NWAVES * 64, LDS_BYTES) != hipSuccess || per_cu < 1) { fprintf(stderr, "kernel_launch: occupancy query says %d\n", per_cu); per_cu = 1; }
        (void)hipGetLastError();
        grid = cus;
    }
    if (grid < 0) return;
    if (hipMemsetAsync((char*)d_ws + WS_CTL, 0, CTL_ZERO_BYTES, stream) != hipSuccess) { fprintf(stderr, "kernel_launch: memset failed\n"); return; }
    Args a{};
    for (int i = 0; i < 31; ++i) a.in[i] = (const float*)d_in[i];
    a.out = (float*)d_out; a.ws = (unsigned char*)d_ws;
    if (MK_N_LAUNCHES == 1) {
        a.ph_lo = 0; a.ph_hi = N_PHASES;
        void* kargs[] = {&a};
        hipError_t e = hipLaunchCooperativeKernel((const void*)fwd_megakernel, dim3(grid), dim3(NWAVES * 64), kargs, LDS_BYTES, stream);
        if (e != hipSuccess) fprintf(stderr, "kernel_launch: cooperative launch failed: %s (grid %d)\n", hipGetErrorString(e), grid);
    } else {
        for (int p = 0; p < N_PHASES; ++p) { a.ph_lo = p; a.ph_hi = p + 1; hipLaunchKernelGGL(fwd_megakernel, dim3(grid), dim3(NWAVES * 64), LDS_BYTES, stream, a); }
    }
}
```

```cpp
#include <hip/hip_runtime.h>
#include <cstdio>
#include <cstdint>

#ifndef WGM_P2A
#define WGM_P2A 4
#endif
#ifndef WGM_P2B
#define WGM_P2B 4
#endif
#ifndef WGM_P4
#define WGM_P4 4
#endif
#ifndef WGM_P5
#define WGM_P5 4
#endif
#ifndef WGM_P7
#define WGM_P7 4
#endif
#ifndef WGM_P8
#define WGM_P8 4
#endif
#ifndef PROBE_ID
#define PROBE_ID 0
#endif
#define PB_LDS_OFF (163840 - 512 + 128)
#define PB_START(id, ldsp) do { if (PROBE_ID == (id) && blockIdx.x == 0 && threadIdx.x == 0) { *(volatile __attribute__((address_space(3))) unsigned long long*)((ldsp) + PB_LDS_OFF + 8) = __builtin_amdgcn_s_memrealtime(); } } while (0)
#define PB_END(id, ldsp) do { if (PROBE_ID == (id) && blockIdx.x == 0 && threadIdx.x == 0) { volatile __attribute__((address_space(3))) unsigned long long* pb_ = (volatile __attribute__((address_space(3))) unsigned long long*)((ldsp) + PB_LDS_OFF); pb_[0] += __builtin_amdgcn_s_memrealtime() - pb_[1]; } } while (0)
namespace pg8 {
#define PG8_LAS __attribute__((address_space(3)))
typedef unsigned short bf16_t;
typedef short bf16x8 __attribute__((ext_vector_type(8)));
typedef float f32x4 __attribute__((ext_vector_type(4)));
typedef unsigned u32x4 __attribute__((ext_vector_type(4)));
typedef float f32x2 __attribute__((ext_vector_type(2)));
constexpr int EPI_LDS_OFF = 131072;
constexpr int BM = 256, BK = 64, HALF = 128, HTB = HALF * BK * 2  , STAGE_BYTES = 8 * HTB, NXCD = 8, WGM = 8;

__host__ __device__ __forceinline__ int lds_byte(int r, int c) { const int st = (r >> 4) * 2 + (c >> 5), rr = r & 15, cc = c & 31, ob = rr * 64 + cc * 2; return st * 1024 + (ob ^ (((ob >> 9) & 1) << 5)); }
__host__ __device__ __forceinline__ void stage_rc(int b, int& R, int& C) { const int st = b / 1024, sb = b % 1024, swz = sb ^ (((sb >> 9) & 1) << 5); R = (st >> 1) * 16 + swz / 64; C = (st & 1) * 32 + (swz % 64) / 2; }
__host__ __device__ __forceinline__ int perm32(int rho) { const int n = rho >> 4, i = rho & 15; return 8 * (i >> 2) + 4 * n + (i & 3); }

struct Unit { int pm, pn; };
struct Gemm { const bf16_t* A; const bf16_t* Bt; int M, N, K; };

struct StaticOrder {
    int nM, nN, nwg, G, c, wgm;
    __host__ __device__ void init(int M, int N, int G_, int c_, int wgm_ = 4) { nM = M / BM; nN = N / BM; nwg = nM * nN; G = G_; c = c_; wgm = wgm_; }
    __host__ __device__ bool next(int i, Unit& u) const {
        const long L = (long)i * G + c; if (L >= nwg) return false;
        int wgid = (int)L; { const int q = nwg / NXCD, r = nwg % NXCD, xcd = wgid % NXCD, off = wgid / NXCD; wgid = (xcd < r ? xcd * (q + 1) : r * (q + 1) + (xcd - r) * q) + off; }
        const int nig = wgm * nN, gid = wgid / nig, fm = gid * wgm, gsz = (nM - fm) < wgm ? (nM - fm) : wgm;
        u.pm = fm + ((wgid % nig) % gsz); u.pn = (wgid % nig) / gsz; return true;
    }
    __device__ __forceinline__ void a_ready(const Unit&) const {}
    __device__ __forceinline__ void done(const Unit&) const {}
};

__device__ __forceinline__ unsigned cvt_pk_bf16(float lo, float hi) { unsigned r; asm volatile("v_cvt_pk_bf16_f32 %0, %1, %2" : "=v"(r) : "v"(lo), "v"(hi)); return r; }
__device__ __forceinline__ f32x2 gelu_pk(f32x2 v) {
    const f32x2 av = __builtin_elementwise_abs(v), d = av * 0.2316418882f + 1.0f;
    f32x2 t; t.x = __builtin_amdgcn_rcpf(d.x); t.y = __builtin_amdgcn_rcpf(d.y);
    f32x2 q = t * 0.5307027145f + (-0.7265760135f); q = q * t + 0.7107068705f; q = q * t + (-0.142248368f); q = q * t + 0.127414796f; q = q * t;
    const f32x2 s = (v * v) * (-0.72134752044f);
    f32x2 e; e.x = __builtin_amdgcn_exp2f(s.x); e.y = __builtin_amdgcn_exp2f(s.y);
    const f32x2 m = v * (q * e), r = v - m;
    f32x2 o; o.x = v.x < 0.f ? m.x : r.x; o.y = v.y < 0.f ? m.y : r.y; return o;
}
__device__ __forceinline__ float bf_lo(unsigned w) { return __uint_as_float(w << 16); }
__device__ __forceinline__ float bf_hi(unsigned w) { return __uint_as_float(w & 0xffff0000u); }
__device__ __forceinline__ float sigmoid_f(float x) { return __builtin_amdgcn_rcpf(1.0f + __expf(-x)); }
}

constexpr int DM = 2048, NBATCH = 8, SEQ = 2048, MTOK = NBATCH * SEQ;
constexpr int SGUW = 1024, HYW = 1024, DFF = 8192, INW = 9216, MODW = 6 * DM;
constexpr float LN_EPS = 1e-5f;
constexpr float DN_ALPHA = 1.189207115002721f;

namespace pg8 {

struct EpiG1 {
    static constexpr bool PERM = true, AFTER_DRAIN = false, MID = false; static constexpr int SLOT_FLOATS = 256;
    bf16_t* U; bf16_t* G; const float* b_in;
    __device__ __forceinline__ void mid(f32x4 (&)[2][2][4][2], const Unit&, int, int, int, int) const {}
    __device__ __forceinline__ void preload(PG8_LAS float* slot, const Unit& u, int tid) const { if (tid < 256) slot[tid] = b_in[(u.pn < 4 ? u.pn * 256 : 5120 + (u.pn - 4) * 256) + tid]; }
    __device__ __forceinline__ void operator()(const f32x4 (&acc)[2][2][4][2], const Unit& u, int wr, int wc, int fr, int fq, const PG8_LAS float* slot) const {
        const int row0 = u.pm * BM + wr * 64 + fr; const int pn = u.pn;
        int ldc, colt; bf16_t* base; const bool isu = pn < 4;
        if (isu) { base = U; ldc = SGUW; colt = pn * 256; }
        else { base = G; ldc = 2 * DM; colt = (pn - 4) * 256; }
        const int cl = wc * 64 + 8 * fq;
        f32x4 bv[2][2];
#pragma unroll
        for (int bj = 0; bj < 2; ++bj)
#pragma unroll
            for (int n = 0; n < 2; ++n) bv[bj][n] = *(const PG8_LAS f32x4*)(slot + cl + bj * 32 + 4 * n);
#pragma unroll
        for (int ai = 0; ai < 2; ++ai)
#pragma unroll
            for (int m = 0; m < 4; ++m) {
                const int row = row0 + ai * HALF + m * 16;
                bf16_t* rowp = base + (size_t)row * ldc + colt + cl;
#pragma unroll
                for (int bj = 0; bj < 2; ++bj) {
                    f32x4 v0 = acc[ai][bj][m][0] + bv[bj][0], v1 = acc[ai][bj][m][1] + bv[bj][1];
                    if (isu) {
                        f32x2 a = gelu_pk((f32x2){v0[0], v0[1]}), b = gelu_pk((f32x2){v0[2], v0[3]}), c = gelu_pk((f32x2){v1[0], v1[1]}), d = gelu_pk((f32x2){v1[2], v1[3]});
                        v0 = (f32x4){a.x, a.y, b.x, b.y}; v1 = (f32x4){c.x, c.y, d.x, d.y};
                    } else {
                        v0 = (f32x4){sigmoid_f(v0[0]), sigmoid_f(v0[1]), sigmoid_f(v0[2]), sigmoid_f(v0[3])};
                        v1 = (f32x4){sigmoid_f(v1[0]), sigmoid_f(v1[1]), sigmoid_f(v1[2]), sigmoid_f(v1[3])};
                    }
                    u32x4 w; w.x = cvt_pk_bf16(v0[0], v0[1]); w.y = cvt_pk_bf16(v0[2], v0[3]); w.z = cvt_pk_bf16(v1[0], v1[1]); w.w = cvt_pk_bf16(v1[2], v1[3]);
                    *(u32x4*)(rowp + bj * 32) = w;
                }
            }
    }
};

struct EpiG1T {
    static constexpr bool PERM = true, AFTER_DRAIN = false, MID = false;
    bf16_t* VT; bf16_t* ZHT; const float* b_in; float* statsV; static constexpr int SLOT_FLOATS = 256;
    __device__ __forceinline__ void mid(f32x4 (&)[2][2][4][2], const Unit&, int, int, int, int) const {}
    __device__ __forceinline__ void preload(PG8_LAS float* slot, const Unit& u, int tid) const { if (tid < 256) slot[tid] = b_in[1024 + u.pm * 256 + tid]; }
    __device__ __forceinline__ void operator()(const f32x4 (&acc)[2][2][4][2], const Unit& u, int wr, int wc, int fr, int fq, const PG8_LAS float* slot) const {
        const int col0 = u.pn * BM + wc * 64 + 8 * fq; const bool isv = u.pm < 4;
        const int rowt = (isv ? u.pm : u.pm - 4) * BM + wr * 64 + fr;
        bf16_t* base = isv ? VT : ZHT;
#pragma unroll
        for (int ai = 0; ai < 2; ++ai) {
            float s[2][8], q[2][8];
#pragma unroll
            for (int bj = 0; bj < 2; ++bj)
#pragma unroll
                for (int e = 0; e < 8; ++e) { s[bj][e] = 0.f; q[bj][e] = 0.f; }
#pragma unroll
            for (int m = 0; m < 4; ++m) {
                const int row = rowt + ai * HALF + m * 16; const float bb = slot[wr * 64 + fr + ai * HALF + m * 16];
                bf16_t* rowp = base + (size_t)row * MTOK + col0;
#pragma unroll
                for (int bj = 0; bj < 2; ++bj) {
                    f32x4 v0 = acc[ai][bj][m][0] + bb, v1 = acc[ai][bj][m][1] + bb;
                    if (isv) {
                        f32x2 a = gelu_pk((f32x2){v0[0], v0[1]}), b = gelu_pk((f32x2){v0[2], v0[3]}), c = gelu_pk((f32x2){v1[0], v1[1]}), d = gelu_pk((f32x2){v1[2], v1[3]});
                        v0 = (f32x4){a.x, a.y, b.x, b.y}; v1 = (f32x4){c.x, c.y, d.x, d.y};
                    }
                    u32x4 w; w.x = cvt_pk_bf16(v0[0], v0[1]); w.y = cvt_pk_bf16(v0[2], v0[3]); w.z = cvt_pk_bf16(v1[0], v1[1]); w.w = cvt_pk_bf16(v1[2], v1[3]);
                    *(u32x4*)(rowp + bj * 32) = w;
                    if (isv) {
                        const float e0 = bf_lo(w.x), e1 = bf_hi(w.x), e2 = bf_lo(w.y), e3 = bf_hi(w.y), e4 = bf_lo(w.z), e5 = bf_hi(w.z), e6 = bf_lo(w.w), e7 = bf_hi(w.w);
                        s[bj][0] += e0; s[bj][1] += e1; s[bj][2] += e2; s[bj][3] += e3; s[bj][4] += e4; s[bj][5] += e5; s[bj][6] += e6; s[bj][7] += e7;
                        q[bj][0] += e0 * e0; q[bj][1] += e1 * e1; q[bj][2] += e2 * e2; q[bj][3] += e3 * e3; q[bj][4] += e4 * e4; q[bj][5] += e5 * e5; q[bj][6] += e6 * e6; q[bj][7] += e7 * e7;
                    }
                }
            }
            if (isv) {
                const int slot = u.pm * 4 + ai * 2 + wr;
#pragma unroll
                for (int bj = 0; bj < 2; ++bj)
#pragma unroll
                    for (int e = 0; e < 8; ++e) {
                        float a = s[bj][e], b = q[bj][e];
                        a += __shfl_xor(a, 1); b += __shfl_xor(b, 1); a += __shfl_xor(a, 2); b += __shfl_xor(b, 2);
                        a += __shfl_xor(a, 4); b += __shfl_xor(b, 4); a += __shfl_xor(a, 8); b += __shfl_xor(b, 8);
                        if (fr == 0) *(f32x2*)(statsV + ((size_t)(col0 + bj * 32 + e) * 16 + slot) * 2) = (f32x2){a, b};
                    }
            }
        }
    }
};

struct EpiG2 {
    static constexpr bool PERM = true, AFTER_DRAIN = false, MID = true;
    const bf16_t* G; bf16_t* O; static constexpr int SLOT_FLOATS = 0;
    __device__ __forceinline__ void preload(PG8_LAS float*, const Unit&, int) const {}
    __device__ __forceinline__ void mid(f32x4 (&acc)[2][2][4][2], const Unit& u, int wr, int wc, int fr, int fq) const {
        int row0 = u.pm * BM + wr * 64 + fr, col0 = u.pn * BM + wc * 64 + 8 * fq;
        asm volatile("" : "+v"(row0), "+v"(col0));
#pragma unroll
        for (int ai = 0; ai < 2; ++ai)
#pragma unroll
            for (int m = 0; m < 4; ++m) {
                const bf16_t* gp = G + (size_t)(row0 + ai * HALF + m * 16) * (2 * DM) + col0;
#pragma unroll
                for (int bj = 0; bj < 2; ++bj) {
                    const u32x4 ga = *(const u32x4*)(gp + bj * 32), gb = *(const u32x4*)(gp + DM + bj * 32);
                    f32x4 r0, r1;
                    r0[0] = bf_lo(ga.x) * __builtin_amdgcn_rcpf(bf_lo(gb.x)); r0[1] = bf_hi(ga.x) * __builtin_amdgcn_rcpf(bf_hi(gb.x));
                    r0[2] = bf_lo(ga.y) * __builtin_amdgcn_rcpf(bf_lo(gb.y)); r0[3] = bf_hi(ga.y) * __builtin_amdgcn_rcpf(bf_hi(gb.y));
                    r1[0] = bf_lo(ga.z) * __builtin_amdgcn_rcpf(bf_lo(gb.z)); r1[1] = bf_hi(ga.z) * __builtin_amdgcn_rcpf(bf_hi(gb.z));
                    r1[2] = bf_lo(ga.w) * __builtin_amdgcn_rcpf(bf_lo(gb.w)); r1[3] = bf_hi(ga.w) * __builtin_amdgcn_rcpf(bf_hi(gb.w));
                    acc[ai][bj][m][0] *= r0; acc[ai][bj][m][1] *= r1;
                }
            }
    }
    __device__ __forceinline__ void operator()(const f32x4 (&acc)[2][2][4][2], const Unit& u, int wr, int wc, int fr, int fq, const PG8_LAS float*) const {
        const int row0 = u.pm * BM + wr * 64 + fr, col0 = u.pn * BM + wc * 64 + 8 * fq;
#pragma unroll
        for (int ai = 0; ai < 2; ++ai)
#pragma unroll
            for (int m = 0; m < 4; ++m) {
                const int row = row0 + ai * HALF + m * 16;
                const bf16_t* gp = G + (size_t)row * (2 * DM) + DM + col0;
                bf16_t* op = O + (size_t)row * DM + col0;
#pragma unroll
                for (int bj = 0; bj < 2; ++bj) {
                    const u32x4 gb = *(const u32x4*)(gp + bj * 32);
                    const f32x4 a0 = acc[ai][bj][m][0], a1 = acc[ai][bj][m][1];
                    u32x4 w; w.x = cvt_pk_bf16(a0[0] * bf_lo(gb.x), a0[1] * bf_hi(gb.x)); w.y = cvt_pk_bf16(a0[2] * bf_lo(gb.y), a0[3] * bf_hi(gb.y));
                    w.z = cvt_pk_bf16(a1[0] * bf_lo(gb.z), a1[1] * bf_hi(gb.z)); w.w = cvt_pk_bf16(a1[2] * bf_lo(gb.w), a1[3] * bf_hi(gb.w));
                    *(u32x4*)(op + bj * 32) = w;
                }
            }
    }
};

typedef _Float16 f16x4 __attribute__((ext_vector_type(4)));
__device__ __forceinline__ f16x4 to_f16x4(f32x4 v) { return (f16x4){(_Float16)v[0], (_Float16)v[1], (_Float16)v[2], (_Float16)v[3]}; }
__device__ __forceinline__ f32x4 from_f16x4(f16x4 v) { return (f32x4){(float)v[0], (float)v[1], (float)v[2], (float)v[3]}; }
template <bool FIRST> struct EpiRes {
    static constexpr bool PERM = false, AFTER_DRAIN = false, MID = false; static constexpr int SLOT_FLOATS = FIRST ? 512 : 1024;
    const float* X;
    const _Float16* R16;
    _Float16* O16;
    const float* gate;
    const float* bias;
    const float* lng; const float* lnb; const float* MU;
    float* stats;
    __device__ __forceinline__ void mid(f32x4 (&)[2][2][4][2], const Unit&, int, int, int, int) const {}
    __device__ __forceinline__ void preload(PG8_LAS float* slot, const Unit& u, int tid) const {
        const int c = tid & 255, col = u.pn * BM + c;
        if (tid < 256) slot[c] = gate[(size_t)(u.pm >> 3) * MODW + col]; else slot[256 + c] = bias[col];
        if (!FIRST) { if (tid < 256) slot[512 + c] = DN_ALPHA * lng[col]; else slot[768 + c] = DN_ALPHA * lnb[col]; }
    }
    __device__ __forceinline__ void operator()(const f32x4 (&acc)[2][2][4][2], const Unit& u, int wr, int wc, int fr, int fq, const PG8_LAS float* slot) const {
        int row0 = u.pm * BM + wr * 64 + fr; const int cl = wc * 32 + 4 * fq; int col0 = u.pn * BM + cl;
        asm volatile("" : "+v"(row0), "+v"(col0));
        constexpr int RB = FIRST ? 2 : 1;
#pragma unroll
        for (int ab = 0; ab < 8 / RB; ++ab) {
            const int ai = (ab * RB) >> 2, mb = (ab * RB) & 3;
            f32x4 base[RB][2][2]; f16x4 b16[RB][2][2]; f32x2 mr[RB];
            int rowb = row0 + ai * HALF + mb * 16; asm volatile("" : "+v"(rowb));
#pragma unroll
            for (int mm = 0; mm < RB; ++mm) {
                const size_t off = (size_t)(rowb + mm * 16) * DM + col0;
                if (!FIRST) mr[mm] = *(const f32x2*)(MU + (size_t)(rowb + mm * 16) * 2);
#pragma unroll
                for (int bj = 0; bj < 2; ++bj)
#pragma unroll
                    for (int n = 0; n < 2; ++n) { if (FIRST) base[mm][bj][n] = *(const f32x4*)(X + off + bj * HALF + n * 16); else b16[mm][bj][n] = *(const f16x4*)(R16 + off + bj * HALF + n * 16); }
            }
#pragma unroll
            for (int mm = 0; mm < RB; ++mm) {
                const int m = mb + mm;
                const int row = rowb + mm * 16; _Float16* rp = O16 + (size_t)row * DM + col0;
                float s = 0.f, q = 0.f;
#pragma unroll
                for (int bj = 0; bj < 2; ++bj)
#pragma unroll
                    for (int n = 0; n < 2; ++n) {
                        const int co = bj * HALF + n * 16;
                        const f32x4 gv = *(const PG8_LAS f32x4*)(slot + cl + co), bv = *(const PG8_LAS f32x4*)(slot + 256 + cl + co);
                        f32x4 bs;
                        if (FIRST) bs = base[mm][bj][n] * DN_ALPHA;
                        else bs = (from_f16x4(b16[mm][bj][n]) - mr[mm].x) * mr[mm].y * *(const PG8_LAS f32x4*)(slot + 512 + cl + co) + *(const PG8_LAS f32x4*)(slot + 768 + cl + co);
                        const f16x4 oh = to_f16x4(bs + gv * (acc[ai][bj][m][n] + bv));
                        *(f16x4*)(rp + co) = oh;
                        const f32x4 o = from_f16x4(oh);
                        s += (o[0] + o[1]) + (o[2] + o[3]); q += (o[0] * o[0] + o[1] * o[1]) + (o[2] * o[2] + o[3] * o[3]);
                    }
                s += __shfl_xor(s, 16); s += __shfl_xor(s, 32); q += __shfl_xor(q, 16); q += __shfl_xor(q, 32);
                if (fq == 0) *(f32x2*)(stats + ((size_t)row * 32 + u.pn * 4 + wc) * 2) = (f32x2){s, q};
            }
            asm volatile("" ::: "memory");
        }
    }
};

struct EpiG4 {
    static constexpr bool PERM = true, AFTER_DRAIN = false, MID = false; static constexpr int SLOT_FLOATS = 256;
    bf16_t* O; const float* bias;
    __device__ __forceinline__ void mid(f32x4 (&)[2][2][4][2], const Unit&, int, int, int, int) const {}
    __device__ __forceinline__ void preload(PG8_LAS float* slot, const Unit& u, int tid) const { if (tid < 256) slot[tid] = bias[u.pn * BM + tid]; }
    __device__ __forceinline__ void operator()(const f32x4 (&acc)[2][2][4][2], const Unit& u, int wr, int wc, int fr, int fq, const PG8_LAS float* slot) const {
        const int row0 = u.pm * BM + wr * 64 + fr, cl = wc * 64 + 8 * fq, col0 = u.pn * BM + cl;
        f32x4 bv[2][2];
#pragma unroll
        for (int bj = 0; bj < 2; ++bj)
#pragma unroll
            for (int n = 0; n < 2; ++n) bv[bj][n] = *(const PG8_LAS f32x4*)(slot + cl + bj * 32 + 4 * n);
#pragma unroll
        for (int ai = 0; ai < 2; ++ai)
#pragma unroll
            for (int m = 0; m < 4; ++m) {
                bf16_t* rowp = O + (size_t)(row0 + ai * HALF + m * 16) * DFF + col0;
#pragma unroll
                for (int bj = 0; bj < 2; ++bj) {
                    f32x4 v0 = acc[ai][bj][m][0] + bv[bj][0], v1 = acc[ai][bj][m][1] + bv[bj][1];
                    v0 = __builtin_elementwise_max(v0, (f32x4){0.f, 0.f, 0.f, 0.f}); v1 = __builtin_elementwise_max(v1, (f32x4){0.f, 0.f, 0.f, 0.f});
                    v0 = v0 * v0; v1 = v1 * v1;
                    u32x4 w; w.x = cvt_pk_bf16(v0[0], v0[1]); w.y = cvt_pk_bf16(v0[2], v0[3]); w.z = cvt_pk_bf16(v1[0], v1[1]); w.w = cvt_pk_bf16(v1[2], v1[3]);
                    *(u32x4*)(rowp + bj * 32) = w;
                }
            }
    }
};
}
namespace pg8 {
template <class Epi, class Sched, bool ALIGN_EPI = false, bool SP2 = false>
__device__ __forceinline__ void gemm_phase(PG8_LAS unsigned char* lds, const Gemm g, const Sched& S, const Epi& E) {
    const int tid = threadIdx.x, wid = __builtin_amdgcn_readfirstlane(tid >> 6), lane = tid & 63, wr = wid >> 2, wc = wid & 3, fr = lane & 15, fq = lane >> 4;
    const int K = g.K, nt = K / BK;
    unsigned voffA[2], voffB[2];
#pragma unroll
    for (int i = 0; i < 2; ++i) { int R, C; stage_rc(tid * 16 + i * 8192, R, C); const int Rb = Epi::PERM ? ((R & ~31) + perm32(R & 31)) : R;
        const int Rw = Epi::PERM ? ((R >> 5) * 64 + perm32(R & 31)) : R;
        voffA[i] = (unsigned)(R * K + C) * 2u; voffB[i] = (unsigned)(Rw * K + C) * 2u; (void)Rb; }
    const size_t kstep = (size_t)(BK * 2);
    const size_t hstep = (size_t)HALF * K * 2;
    const size_t tstep = 2 * hstep;
    const size_t hstepB = Epi::PERM ? (size_t)32 * K * 2 : hstep;
    const unsigned ldsw = (unsigned)wid * 1024u;
    const int aoff = lds_byte(wr * 64 + fr, fq * 8), boff = lds_byte(wc * 32 + fr, fq * 8);
#define PG8_SA(b, h) (((b) * 2 + (h)) * HTB)
#define PG8_SB(b, h) ((4 + (b) * 2 + (h)) * HTB)
#define PG8_STAGE(bufoff, gbase, voff) do { _Pragma("unroll") for (int _i = 0; _i < 2; ++_i) \
        __builtin_amdgcn_global_load_lds((const unsigned*)((const char*)(gbase) + (voff)[_i]), (PG8_LAS unsigned*)(lds + (bufoff) + ldsw + _i * 8192), 16, 0, 0); } while (0)
#define PG8_LDA(dst, b, h) do { _Pragma("unroll") for (int m = 0; m < 4; ++m) _Pragma("unroll") for (int k = 0; k < 2; ++k) dst[m][k] = *(const PG8_LAS bf16x8*)(lds + PG8_SA(b, h) + aoff + m * 2048 + k * 1024); } while (0)
#define PG8_LDB(dst, b, h) do { _Pragma("unroll") for (int n = 0; n < 2; ++n) _Pragma("unroll") for (int k = 0; k < 2; ++k) dst[n][k] = *(const PG8_LAS bf16x8*)(lds + PG8_SB(b, h) + boff + n * 2048 + k * 1024); } while (0)
#define PG8_MMA(ai, bj, At, Bt) do { __builtin_amdgcn_s_setprio(1); _Pragma("unroll") for (int m = 0; m < 4; ++m) _Pragma("unroll") for (int n = 0; n < 2; ++n) _Pragma("unroll") for (int k = 0; k < 2; ++k) \
        acc[ai][bj][m][n] = __builtin_amdgcn_mfma_f32_16x16x32_bf16(Bt[n][k], At[m][k], acc[ai][bj][m][n], 0, 0, 0); __builtin_amdgcn_s_setprio(0); } while (0)
#define PG8_WAIT_V(n) asm volatile("s_waitcnt vmcnt(" #n ")" ::: "memory")
#define PG8_WAIT_L(n) asm volatile("s_waitcnt lgkmcnt(" #n ")" ::: "memory")
#define PG8_BAR __builtin_amdgcn_s_barrier()
#define PG8_SCHED __builtin_amdgcn_sched_barrier(0)
    Unit cur, nxt; int ui = 0;
    if (!S.next(0, cur)) return;
    {
        Unit pu; for (int i = 0; S.next(i, pu); ++i) E.preload((PG8_LAS float*)(lds + EPI_LDS_OFF) + i * Epi::SLOT_FLOATS, pu, tid);
        asm volatile("s_waitcnt vmcnt(0) lgkmcnt(0)" ::: "memory"); __builtin_amdgcn_s_barrier(); asm volatile("" ::: "memory");
    }
    f32x4 acc[2][2][4][2];
#pragma unroll
    for (int a = 0; a < 2; ++a)
#pragma unroll
        for (int b = 0; b < 2; ++b)
#pragma unroll
            for (int m = 0; m < 4; ++m)
#pragma unroll
                for (int n = 0; n < 2; ++n) acc[a][b][m][n] = (f32x4){0.f, 0.f, 0.f, 0.f};
    bf16x8 At[4][2], B0[2][2], B1[2][2];
    const char* cA = (const char*)g.A + (size_t)cur.pm * tstep; const char* cB = (const char*)g.Bt + (size_t)cur.pn * tstep;
    S.a_ready(cur);
    if constexpr (SP2) {
        PG8_STAGE(PG8_SB(0, 0), cB, voffB); PG8_STAGE(PG8_SB(0, 1), cB + hstepB, voffB); PG8_STAGE(PG8_SA(0, 0), cA, voffA); PG8_STAGE(PG8_SA(0, 1), cA + hstep, voffA);
        if (wr == 1) PG8_BAR;
        PG8_WAIT_V(2); PG8_BAR;
        PG8_STAGE(PG8_SB(1, 0), cB + kstep, voffB); PG8_STAGE(PG8_SA(1, 0), cA + kstep, voffA); PG8_STAGE(PG8_SB(1, 1), cB + hstepB + kstep, voffB);
        PG8_WAIT_V(6); PG8_BAR;
    } else {
        PG8_STAGE(PG8_SB(0, 0), cB, voffB); PG8_STAGE(PG8_SA(0, 0), cA, voffA); PG8_STAGE(PG8_SB(0, 1), cB + hstepB, voffB); PG8_STAGE(PG8_SA(0, 1), cA + hstep, voffA);
        if (wr == 1) PG8_BAR;
        PG8_WAIT_V(4); PG8_BAR;
        PG8_STAGE(PG8_SB(1, 0), cB + kstep, voffB); PG8_STAGE(PG8_SA(1, 0), cA + kstep, voffA); PG8_STAGE(PG8_SB(1, 1), cB + hstepB + kstep, voffB);
        PG8_WAIT_V(6); PG8_BAR;
    }
    for (;;) {
        const bool has_next = S.next(ui + 1, nxt);
        const char* nA = has_next ? (const char*)g.A + (size_t)nxt.pm * tstep : cA; const char* nB = has_next ? (const char*)g.Bt + (size_t)nxt.pn * tstep : cB;
        for (int t = 0; t < nt; t += 2) {
            const bool last = (t == nt - 2);
            const char* a1 = cA + (size_t)(t + 1) * kstep;
            const char* a2 = last ? nA : cA + (size_t)(t + 2) * kstep; const char* b2 = last ? nB : cB + (size_t)(t + 2) * kstep;
            const char* a3 = a2 + kstep; const char* b3 = b2 + kstep;
            if (last && has_next) S.a_ready(nxt);
            if constexpr (Epi::MID) { if (t == (nt >> 1)) E.mid(acc, cur, wr, wc, fr, fq); }
            if constexpr (SP2) {
            PG8_LDB(B0, 0, 0); PG8_LDB(B1, 0, 1); PG8_SCHED; PG8_LDA(At, 0, 0); PG8_STAGE(PG8_SA(1, 1), a1 + hstep, voffA);
            PG8_WAIT_V(8); PG8_WAIT_L(0); PG8_BAR; PG8_MMA(0, 0, At, B0); PG8_MMA(0, 1, At, B1); PG8_BAR; PG8_SCHED;
            PG8_LDA(At, 0, 1); PG8_STAGE(PG8_SB(0, 0), b2, voffB); PG8_STAGE(PG8_SB(0, 1), b2 + hstepB, voffB); PG8_STAGE(PG8_SA(0, 0), a2, voffA);
            PG8_WAIT_V(8); PG8_WAIT_L(0); PG8_BAR; PG8_MMA(1, 0, At, B0); PG8_MMA(1, 1, At, B1); PG8_BAR; PG8_SCHED;
            PG8_LDB(B0, 1, 0); PG8_LDB(B1, 1, 1); PG8_SCHED; PG8_LDA(At, 1, 0); PG8_STAGE(PG8_SA(0, 1), a2 + hstep, voffA);
            PG8_WAIT_V(8); PG8_WAIT_L(0); PG8_BAR; PG8_MMA(0, 0, At, B0); PG8_MMA(0, 1, At, B1); PG8_BAR; PG8_SCHED;
            PG8_LDA(At, 1, 1); PG8_STAGE(PG8_SB(1, 0), b3, voffB); PG8_STAGE(PG8_SB(1, 1), b3 + hstepB, voffB); PG8_STAGE(PG8_SA(1, 0), a3, voffA);
            PG8_WAIT_V(8); PG8_WAIT_L(0); PG8_BAR; PG8_MMA(1, 0, At, B0); PG8_MMA(1, 1, At, B1); PG8_BAR; PG8_SCHED;
            } else {
            PG8_LDB(B0, 0, 0); PG8_SCHED; PG8_LDA(At, 0, 0); PG8_STAGE(PG8_SA(1, 1), a1 + hstep, voffA);
            PG8_WAIT_L(8); PG8_BAR; PG8_WAIT_L(0); PG8_MMA(0, 0, At, B0); PG8_BAR; PG8_SCHED;
            PG8_LDB(B1, 0, 1); PG8_STAGE(PG8_SB(0, 0), b2, voffB);
            PG8_BAR; PG8_WAIT_L(0); PG8_MMA(0, 1, At, B1); PG8_BAR;
            PG8_LDA(At, 0, 1); PG8_STAGE(PG8_SA(0, 0), a2, voffA);
            PG8_BAR; PG8_WAIT_L(0); PG8_MMA(1, 0, At, B0); PG8_BAR; PG8_SCHED;
            PG8_STAGE(PG8_SB(0, 1), b2 + hstepB, voffB);
            PG8_WAIT_V(6); PG8_BAR; PG8_MMA(1, 1, At, B1); PG8_BAR;
            PG8_LDB(B0, 1, 0); PG8_SCHED; PG8_LDA(At, 1, 0); PG8_STAGE(PG8_SA(0, 1), a2 + hstep, voffA);
            PG8_WAIT_L(8); PG8_BAR; PG8_WAIT_L(0); PG8_MMA(0, 0, At, B0); PG8_BAR; PG8_SCHED;
            PG8_LDB(B1, 1, 1); PG8_STAGE(PG8_SB(1, 0), b3, voffB);
            PG8_BAR; PG8_WAIT_L(0); PG8_MMA(0, 1, At, B1); PG8_BAR;
            PG8_LDA(At, 1, 1); PG8_STAGE(PG8_SA(1, 0), a3, voffA);
            PG8_BAR; PG8_WAIT_L(0); PG8_MMA(1, 0, At, B0); PG8_BAR; PG8_SCHED;
            PG8_STAGE(PG8_SB(1, 1), b3 + hstepB, voffB);
            PG8_WAIT_V(6); PG8_BAR; PG8_MMA(1, 1, At, B1); PG8_BAR;
            }
        }
        if constexpr (ALIGN_EPI) { if (wr == 0) PG8_BAR; }
        if constexpr (!Epi::AFTER_DRAIN) { E(acc, cur, wr, wc, fr, fq, (const PG8_LAS float*)(lds + EPI_LDS_OFF) + ui * Epi::SLOT_FLOATS); S.done(cur); }
        if (!has_next) break;
#pragma unroll
        for (int a = 0; a < 2; ++a)
#pragma unroll
            for (int b = 0; b < 2; ++b)
#pragma unroll
                for (int m = 0; m < 4; ++m)
#pragma unroll
                    for (int n = 0; n < 2; ++n) acc[a][b][m][n] = (f32x4){0.f, 0.f, 0.f, 0.f};
        cur = nxt; cA = nA; cB = nB; ++ui;
        if constexpr (ALIGN_EPI) { if (wr == 1) PG8_BAR; }
    }
    PG8_WAIT_V(0);
    if constexpr (!ALIGN_EPI) { if (wr == 0) PG8_BAR; }
    PG8_BAR;
    if constexpr (Epi::AFTER_DRAIN) { E.fused(acc, cur, wr, wc, fr, fq, lds, wid, lane); S.done(cur); }
#undef PG8_SA
#undef PG8_SB
#undef PG8_STAGE
#undef PG8_LDA
#undef PG8_LDB
#undef PG8_MMA
#undef PG8_WAIT_V
#undef PG8_WAIT_L
#undef PG8_BAR
#undef PG8_SCHED
}
}

constexpr size_t MiB = 1u << 20;
constexpr size_t WS_CTL = 0;
constexpr size_t WS_MOD = 1 * MiB;
constexpr size_t WS_STV = 2 * MiB;
constexpr size_t WS_ST1 = 4 * MiB;
constexpr size_t WS_ST2 = 8 * MiB;
constexpr size_t WS_MU1 = 12 * MiB;
constexpr size_t WS_HID2 = 14 * MiB;
constexpr size_t WS_SGW = 13 * MiB;
constexpr size_t WS_WIN = 16 * MiB;
constexpr size_t WS_WAB = 52 * MiB;
constexpr size_t WS_WO = 60 * MiB;
constexpr size_t WS_FILT = 68 * MiB;
constexpr size_t WS_WM2 = 68 * MiB;
constexpr size_t WS_H = 100 * MiB;
constexpr size_t WS_U = 164 * MiB;
constexpr size_t WS_V = 196 * MiB;
constexpr size_t WS_MERGED = 164 * MiB;
constexpr size_t WS_ZHT = 228 * MiB;
constexpr size_t WS_G = 324 * MiB;
constexpr size_t WS_AFF = 164 * MiB;
constexpr size_t WS_WM1 = 420 * MiB;
constexpr size_t WS_YT = 452 * MiB;
constexpr size_t WS_END = 484 * MiB;

constexpr int NWAVES = 8;
constexpr int LDS_BYTES = 163840;

#define GAS __attribute__((address_space(1)))
#define LAS __attribute__((address_space(3)))
typedef unsigned short bf16;
typedef unsigned v4u __attribute__((ext_vector_type(4)));
typedef unsigned v2u __attribute__((ext_vector_type(2)));
typedef float f32x4 __attribute__((ext_vector_type(4)));
typedef float f32x2 __attribute__((ext_vector_type(2)));
#define LDS_WAIT() asm volatile("s_waitcnt lgkmcnt(0)" ::: "memory")

__device__ __forceinline__ unsigned f2bf(float f) { unsigned u = __builtin_bit_cast(unsigned, f); return (u + 0x7fffu + ((u >> 16) & 1u)) >> 16; }
__device__ __forceinline__ unsigned pk2(float lo, float hi) { return f2bf(lo) | (f2bf(hi) << 16); }
__device__ __forceinline__ float bflo(unsigned w) { return __uint_as_float(w << 16); }
__device__ __forceinline__ float bfhi(unsigned w) { return __uint_as_float(w & 0xffff0000u); }
__device__ __forceinline__ float bf1(bf16 h) { return __uint_as_float((unsigned)h << 16); }
__device__ __forceinline__ float wave_sum(float v) {
#pragma unroll
    for (int o = 1; o < 64; o <<= 1) v += __shfl_xor(v, o);
    return v;
}

struct Args { const float* in[31]; float* out; unsigned char* ws; int ph_lo, ph_hi; };

struct Frame {
    LAS unsigned char* lds;
    int tid, lane, wave, G;
    const float* const* in; float* out; unsigned char* ws;
};
enum { I_X = 0, I_C, I_WADA, I_BADA, I_WIN, I_BIN, I_SLNG, I_SLNB, I_SW, I_SB, I_HCW, I_HCB, I_HW1, I_HB1, I_HW2, I_HB2, I_HFREQ, I_HW3, I_HSKIP,
       I_WA, I_WB, I_WO, I_BO, I_LN1G, I_LN1B, I_WM1, I_BM1, I_WM2, I_BM2, I_LN2G, I_LN2B };

__device__ __forceinline__ void transpose_matrix(Frame& F, const float* W, int K, int N, bf16* WT, int ldk, int koff, int remap_win, int first, int nblocks) {
    LAS float* tile = (LAS float*)F.lds;
    const int tid = F.tid, nblk = N / 256, nitems = (K / 64) * nblk;
    const int lr = tid >> 6, lc = tid & 63;
    const int wc = tid & 7, wn = tid >> 3;
    for (int it = first; it < nitems; it += nblocks) {
        const int kb = it / nblk, nb = it % nblk, n0 = nb * 256, k0 = kb * 64; int row0 = n0;
        if (remap_win) row0 = (n0 < 1024) ? n0 : (n0 < 2048 ? n0 - 1024 + 5120 : (n0 < 5120 ? n0 - 2048 + 6144 : n0 - 5120 + 1024));
        f32x4 v[8];
#pragma unroll
        for (int i = 0; i < 8; ++i) v[i] = *(const f32x4*)(W + (size_t)(k0 + 8 * i + lr) * N + n0 + 4 * lc);
#pragma unroll
        for (int i = 0; i < 8; ++i) *(LAS f32x4*)(tile + (8 * i + lr) * 256 + ((lc ^ i) << 2)) = v[i];
        __syncthreads();
#pragma unroll
        for (int j = 0; j < 4; ++j) { const int n = wn + 64 * j; const LAS float* sp = tile + (8 * wc) * 256 + ((((n >> 2) ^ wc) << 2) | (n & 3));
            v4u o; o.x = pk2(sp[0 * 256], sp[1 * 256]); o.y = pk2(sp[2 * 256], sp[3 * 256]); o.z = pk2(sp[4 * 256], sp[5 * 256]); o.w = pk2(sp[6 * 256], sp[7 * 256]);
            *(GAS v4u*)(WT + (size_t)(row0 + n) * ldk + koff + k0 + 8 * wc) = o; }
        __syncthreads();
    }
}

__device__ __forceinline__ void p0_mod(Frame& F) {
    LAS float* condS = (LAS float*)F.lds;
    LAS float* red = (LAS float*)(F.lds + 65536);
    const float* c = F.in[I_C]; const float* w_ada = F.in[I_WADA]; const float* b_ada = F.in[I_BADA];
    float* mod = (float*)(F.ws + WS_MOD);
    const int tid = F.tid;
    for (int item = blockIdx.x; item < MODW / 48; item += F.G) {
        for (int i = tid; i < NBATCH * DM; i += NWAVES * 64) { const float v = c[i]; condS[i] = v / (1.0f + __expf(-v)); }
        __syncthreads();
        const int cq = tid % 12, kq = tid / 12, col0 = item * 48;
        if (kq < 32) {
            f32x4 acc[8];
#pragma unroll
            for (int b = 0; b < 8; ++b) acc[b] = (f32x4){0.f, 0.f, 0.f, 0.f};
            const float* wp = w_ada + (size_t)kq * MODW + col0 + cq * 4;
            for (int k = kq; k < DM; k += 256, wp += (size_t)256 * MODW) {
                f32x4 w[8];
#pragma unroll
                for (int u = 0; u < 8; ++u) w[u] = *(const f32x4*)(wp + (size_t)(32 * u) * MODW);
#pragma unroll
                for (int u = 0; u < 8; ++u)
#pragma unroll
                    for (int b = 0; b < 8; ++b) acc[b] += w[u] * condS[b * DM + k + 32 * u];
            }
#pragma unroll
            for (int b = 0; b < 8; ++b) *(LAS f32x4*)(red + (kq * 8 + b) * 48 + cq * 4) = acc[b];
        }
        __syncthreads();
        if (tid < 384) { const int b = tid / 48, col = tid % 48; float s = 0.f;
#pragma unroll 8
          for (int k2 = 0; k2 < 32; ++k2) s += red[(k2 * 8 + b) * 48 + col];
          mod[(size_t)b * MODW + col0 + col] = s + b_ada[col0 + col]; }
        __syncthreads();
    }
}

__device__ __forceinline__ void p0_hid2(Frame& F) {
    LAS float* scr = (LAS float*)F.lds + F.wave * 128;
    const float* w1 = F.in[I_HW1]; const float* b1 = F.in[I_HB1]; const float* w2 = F.in[I_HW2]; const float* b2 = F.in[I_HB2]; const float* freq = F.in[I_HFREQ];
    float* HID2 = (float*)(F.ws + WS_HID2);
    const int lane = F.lane;
    for (int l = blockIdx.x * NWAVES + F.wave; l < SEQ; l += F.G * NWAVES) {
        const float fr = freq[lane];
        const float tl = (float)l / (float)(SEQ - 1), omega = 6.283185307179586f * (float)l / (float)SEQ;
        float f = 0.f;
        if (lane == 0) f = tl;
        else if (lane <= 16) { const float band = 1e-4f + (float)(lane - 1) * ((15.0f - 1e-4f) / 15.0f); f = cosf(band * omega); }
        else if (lane <= 32) { const float band = 1e-4f + (float)(lane - 17) * ((15.0f - 1e-4f) / 15.0f); f = -sinf(band * omega); }
        scr[lane] = f; LDS_WAIT(); asm volatile("" ::: "memory");
        float a = b1[lane];
#pragma unroll 11
        for (int i = 0; i < 33; ++i) a += scr[i] * w1[i * 64 + lane];
        scr[64 + lane] = sinf(fr * a); LDS_WAIT(); asm volatile("" ::: "memory");
        a = b2[lane];
#pragma unroll 16
        for (int i = 0; i < 64; ++i) a += scr[64 + i] * w2[i * 64 + lane];
        HID2[(size_t)l * 64 + lane] = sinf(fr * a);
        LDS_WAIT(); asm volatile("" ::: "memory");
    }
}
typedef float fl_f32x16 __attribute__((ext_vector_type(16)));
__device__ __forceinline__ void p1_filter_waves(Frame& F) {
    const int fwl = F.wave - 4;
    LAS float* hS = (LAS float*)F.lds + fwl * (32 * 65);
    const float* w3 = F.in[I_HW3]; const float* HID2 = (const float*)(F.ws + WS_HID2);
    float* FILT = (float*)(F.ws + WS_FILT);
    const int lane = F.lane, r = lane & 31, h = lane >> 5;
    const float min_decay = -3.0701134573253943f, max_decay = -15.350567286626972f;
    for (int item = blockIdx.x * 4 + fwl; item < 1024; item += F.G * 4) {
        const int pb = item >> 4, cb = item & 15, pos0 = pb * 32, col0 = cb * 256;
        {
#pragma unroll
            for (int u = 0; u < 8; ++u) { const int e = (u * 64 + lane) * 4, p = e >> 6, k = e & 63; const f32x4 v = *(const f32x4*)(HID2 + (size_t)(pos0 + p) * 64 + k);
                hS[p * 65 + k] = v[0]; hS[p * 65 + k + 1] = v[1]; hS[p * 65 + k + 2] = v[2]; hS[p * 65 + k + 3] = v[3]; }
            LDS_WAIT(); asm volatile("" ::: "memory");
        }
        fl_f32x16 acc[8];
#pragma unroll
        for (int t = 0; t < 8; ++t)
#pragma unroll
            for (int e = 0; e < 16; ++e) acc[t][e] = 0.f;
        const float* wp = w3 + (size_t)h * 4096 + col0 + r;
#pragma unroll 2
        for (int s2 = 0; s2 < 32; ++s2) {
            const float a = hS[r * 65 + 2 * s2 + h];
            float b[8];
#pragma unroll
            for (int t = 0; t < 8; ++t) b[t] = wp[(size_t)(2 * s2) * 4096 + t * 32];
#pragma unroll
            for (int t = 0; t < 8; ++t) acc[t] = __builtin_amdgcn_mfma_f32_32x32x2f32(a, b[t], acc[t], 0, 0, 0);
        }
#pragma unroll
        for (int t = 0; t < 8; ++t) {
            const int j = col0 + t * 32 + r, ch = j & 1023; const float delta = fabsf(min_decay + (float)ch * ((max_decay - min_decay) / 1023.0f));
            float* op = FILT + (size_t)j * SEQ + pos0 + 4 * h;
#pragma unroll
            for (int g = 0; g < 4; ++g) {
                f32x4 o;
#pragma unroll
                for (int e = 0; e < 4; ++e) { const float tp = (float)(pos0 + 8 * g + 4 * h + e) / (float)(SEQ - 1); o[e] = acc[t][4 * g + e] * __expf(-tp * delta); }
                *(f32x4*)(op + 8 * g) = o;
            }
        }
        LDS_WAIT(); asm volatile("" ::: "memory");
    }
}

__device__ __forceinline__ void p1_modulate(Frame& F) {
    const float* x = F.in[I_X]; const float* mod = (const float*)(F.ws + WS_MOD); bf16* H = (bf16*)(F.ws + WS_H);
    const size_t nvec = (size_t)MTOK * DM / 8, stride = (size_t)F.G * 256;
    for (size_t i0 = (size_t)blockIdx.x * 256 + F.tid; i0 < nvec; i0 += 4 * stride) {
        f32x4 xa[4], xb[4];
#pragma unroll
        for (int u = 0; u < 4; ++u) { const size_t i = i0 + u * stride; if (i < nvec) { const float* xp = x + i * 8; xa[u] = *(const f32x4*)xp; xb[u] = *(const f32x4*)(xp + 4); } }
#pragma unroll
        for (int u = 0; u < 4; ++u) { const size_t i = i0 + u * stride; if (i < nvec) {
            const int row = (int)(i >> 8), col = (int)(i & 255) * 8, b = row >> 11;
            const float* mp = mod + (size_t)b * MODW + col;
            const f32x4 sh0 = *(const f32x4*)mp, sh1 = *(const f32x4*)(mp + 4), sc0 = *(const f32x4*)(mp + DM), sc1 = *(const f32x4*)(mp + DM + 4);
            const f32x4 h0 = xa[u] * (sc0 + 1.0f) + sh0, h1 = xb[u] * (sc1 + 1.0f) + sh1;
            v4u o; o.x = pk2(h0[0], h0[1]); o.y = pk2(h0[2], h0[3]); o.z = pk2(h1[0], h1[1]); o.w = pk2(h1[2], h1[3]);
            *(v4u*)(H + i * 8) = o; } }
    }
}

typedef short sg_bf16x8 __attribute__((ext_vector_type(8)));
typedef float sg_f32x16 __attribute__((ext_vector_type(16)));
constexpr int SG_VT = 0, SG_LD = 136, SG_ST = 36864;
__device__ __forceinline__ void p3_sgu(Frame& F) {
    LAS bf16* vnT = (LAS bf16*)(F.lds + SG_VT); LAS float* stS = (LAS float*)(F.lds + SG_ST);
    const bf16* U = (const bf16*)(F.ws + WS_U); const bf16* VT = (const bf16*)(F.ws + WS_V); bf16* AB = (bf16*)(F.ws + WS_H);
    const bf16* Wb = (const bf16*)(F.ws + WS_SGW); const float* stv = (const float*)(F.ws + WS_STV);
    const float* lng = F.in[I_SLNG]; const float* lnb = F.in[I_SLNB]; const float* sb = F.in[I_SB];
    const int tid = F.tid, lane = F.lane, w = F.wave, r = lane & 31, h = lane >> 5;
    const int q0 = 32 * (w >> 1), ct0 = 2 * (w & 1);
    for (int item = blockIdx.x; item < 1024; item += F.G) {
        const int b = item >> 7, n = (item >> 3) & 15, g = item & 7, tok0 = b * SEQ + n * 128;
        f32x2 pst[16];
        if (tid < 128) { const float* sp = stv + (size_t)(tok0 + tid) * 32;
#pragma unroll
            for (int i = 0; i < 16; ++i) pst[i] = *(const f32x2*)(sp + 2 * i); }
        const int c = tid >> 2, pseg = (tid & 3) * 32, ch = g * 128 + c;
        v4u wv[4];
        { const bf16* vp = VT + (size_t)ch * MTOK + tok0 + pseg;
#pragma unroll
          for (int k = 0; k < 4; ++k) wv[k] = *(const v4u*)(vp + 8 * k); }
        const float gg = lng[ch], bb = lnb[ch];
        sg_bf16x8 af[8];
#pragma unroll
        for (int kk = 0; kk < 8; ++kk) af[kk] = *(const sg_bf16x8*)(Wb + (size_t)(g * 128 + q0 + r) * 128 + 16 * kk + 8 * h);
        bf16 uu[2][16]; float sbv[16];
#pragma unroll
        for (int rg = 0; rg < 16; ++rg) { const int q = q0 + (rg & 3) + 8 * (rg >> 2) + 4 * h; sbv[rg] = sb[g * 128 + q];
#pragma unroll
            for (int ct = 0; ct < 2; ++ct) uu[ct][rg] = U[(size_t)(tok0 + q) * SGUW + g * 128 + (ct0 + ct) * 32 + r]; }
        if (tid < 128) { float s = 0.f, q = 0.f;
#pragma unroll
            for (int i = 0; i < 16; ++i) { s += pst[i].x; q += pst[i].y; }
            const float mean = s * (1.0f / 1024.0f); float var = q * (1.0f / 1024.0f) - mean * mean; var = var > 0.f ? var : 0.f;
            *(LAS f32x2*)(stS + 2 * tid) = (f32x2){mean, 1.0f / sqrtf(var + LN_EPS)}; }
        __syncthreads();
#pragma unroll
        for (int k = 0; k < 4; ++k) {
            const float e[8] = {bflo(wv[k].x), bfhi(wv[k].x), bflo(wv[k].y), bfhi(wv[k].y), bflo(wv[k].z), bfhi(wv[k].z), bflo(wv[k].w), bfhi(wv[k].w)};
            float o[8];
#pragma unroll
            for (int i = 0; i < 8; i += 2) { const f32x4 st = *(const LAS f32x4*)(stS + 2 * (pseg + 8 * k + i));
                o[i] = (e[i] - st[0]) * st[1] * gg + bb; o[i + 1] = (e[i + 1] - st[2]) * st[3] * gg + bb; }
            v4u pk; pk.x = pk2(o[0], o[1]); pk.y = pk2(o[2], o[3]); pk.z = pk2(o[4], o[5]); pk.w = pk2(o[6], o[7]);
            *(LAS v4u*)(vnT + c * SG_LD + pseg + 8 * k) = pk; }
        __syncthreads();
        sg_f32x16 acc[2];
#pragma unroll
        for (int ct = 0; ct < 2; ++ct)
#pragma unroll
            for (int i = 0; i < 16; ++i) acc[ct][i] = 0.f;
#pragma unroll
        for (int kk = 0; kk < 8; ++kk)
#pragma unroll
            for (int ct = 0; ct < 2; ++ct) {
                const sg_bf16x8 bf = *(const LAS sg_bf16x8*)(vnT + ((ct0 + ct) * 32 + r) * SG_LD + 16 * kk + 8 * h);
                acc[ct] = __builtin_amdgcn_mfma_f32_32x32x16_bf16(af[kk], bf, acc[ct], 0, 0, 0);
            }
#pragma unroll
        for (int ct = 0; ct < 2; ++ct) {
            const int cc = (ct0 + ct) * 32 + r;
#pragma unroll
            for (int rg = 0; rg < 16; ++rg) {
                const int q = q0 + (rg & 3) + 8 * (rg >> 2) + 4 * h;
                AB[(size_t)(tok0 + q) * DM + g * 128 + cc] = (bf16)f2bf(bf1(uu[ct][rg]) * (acc[ct][rg] + sbv[rg]));
            }
        }
        __syncthreads();
    }
}

__device__ __forceinline__ float sconv(const bf16* ZHT, const float* cw, const float* cb, int ch, int b, int t) {
    const bf16* zp = ZHT + (size_t)ch * MTOK + b * SEQ;
    const float z0 = t > 0 ? bf1(zp[t - 1]) : 0.f, z1 = bf1(zp[t]), z2 = t < SEQ - 1 ? bf1(zp[t + 1]) : 0.f;
    return cw[ch] * z0 + cw[3072 + ch] * z1 + cw[6144 + ch] * z2 + cb[ch];
}
__device__ __forceinline__ void p3_hyena(Frame& F) {
    LAS float* Us = (LAS float*)F.lds;
    LAS float* KF = (LAS float*)(F.lds + 65536);
    const bf16* ZHT = (const bf16*)(F.ws + WS_ZHT); const float* FILT = (const float*)(F.ws + WS_FILT); bf16* AB = (bf16*)(F.ws + WS_H);
    const float* cw = F.in[I_HCW]; const float* cb = F.in[I_HCB]; const float* skip = F.in[I_HSKIP];
    const int tid = F.tid;
    for (int item = blockIdx.x; item < HYW; item += F.G) {
        const int c = item;
        for (int i = tid; i < NBATCH * SEQ; i += NWAVES * 64) { const int b = i >> 11, t = i & 2047; Us[t * 8 + b] = sconv(ZHT, cw, cb, c, b, t); }
        for (int n = 0; n < 2; ++n) {
            const float* hf = FILT + (size_t)((0 * 2 + n) * 1024 + c) * SEQ; const float* hb = FILT + (size_t)((1 * 2 + n) * 1024 + c) * SEQ;
            for (int i = tid; i < 4095; i += NWAVES * 64) { const int lag = i - 2047; KF[i] = lag > 0 ? hf[lag] : (lag == 0 ? hf[0] + hb[0] : hb[-lag]); }
            __syncthreads();
            f32x4 acc[4][2];
#pragma unroll
            for (int ti = 0; ti < 4; ++ti) { acc[ti][0] = (f32x4){0.f, 0.f, 0.f, 0.f}; acc[ti][1] = (f32x4){0.f, 0.f, 0.f, 0.f}; }
            const LAS float* kp = KF + tid + 2047;
            for (int s = 0; s < SEQ; ++s) {
                const f32x4 u0 = *(const LAS f32x4*)(Us + s * 8), u1 = *(const LAS f32x4*)(Us + s * 8 + 4);
#pragma unroll
                for (int ti = 0; ti < 4; ++ti) { const float kv = kp[512 * ti - s]; acc[ti][0] += u0 * kv; acc[ti][1] += u1 * kv; }
            }
            __syncthreads();
            const float sk = skip[n * 1024 + c];
#pragma unroll
            for (int ti = 0; ti < 4; ++ti) { const int t = tid + 512 * ti;
#pragma unroll
                for (int b = 0; b < 8; ++b) {
                    const float uv = Us[t * 8 + b], gate = sconv(ZHT, cw, cb, (n + 1) * 1024 + c, b, t);
                    const float y = gate * (acc[ti][b >> 2][b & 3] + sk * uv);
                    if (n == 0) Us[t * 8 + b] = y; else AB[(size_t)(b * SEQ + t) * DM + 1024 + c] = (bf16)f2bf(y);
                } }
            __syncthreads();
        }
    }
}

#ifndef HYFFT_HD
#define HYFFT_HD __device__ __forceinline__
#define HYFFT_LAS __attribute__((address_space(3)))
#endif
typedef float hy_c32 __attribute__((ext_vector_type(2)));
HYFFT_HD int hy_padi(int i) { return i + (i >> 3); }
HYFFT_HD int hy_rev(int x) { return ((x & 7) << 9) | (((x >> 3) & 7) << 6) | (((x >> 6) & 7) << 3) | ((x >> 9) & 7); }

template <bool INV> HYFFT_HD void hy_dft8(float (&re)[8], float (&im)[8]) {
    const float h = 0.70710678118654752f;
    float ar[4], ai[4], br[4], bi[4];
#pragma unroll
    for (int m = 0; m < 4; ++m) { ar[m] = re[m] + re[m + 4]; ai[m] = im[m] + im[m + 4]; br[m] = re[m] - re[m + 4]; bi[m] = im[m] - im[m + 4]; }
    { float x = br[1], y = bi[1]; if (!INV) { br[1] = h * (x + y); bi[1] = h * (y - x); } else { br[1] = h * (x - y); bi[1] = h * (y + x); } }
    { float x = br[2], y = bi[2]; if (!INV) { br[2] = y; bi[2] = -x; } else { br[2] = -y; bi[2] = x; } }
    { float x = br[3], y = bi[3]; if (!INV) { br[3] = h * (y - x); bi[3] = -h * (x + y); } else { br[3] = -h * (x + y); bi[3] = h * (x - y); } }
#pragma unroll
    for (int s = 0; s < 2; ++s) {
        float* cr = s ? br : ar; float* ci = s ? bi : ai;
        const float e0r = cr[0] + cr[2], e0i = ci[0] + ci[2], e1r = cr[0] - cr[2], e1i = ci[0] - ci[2];
        const float o0r = cr[1] + cr[3], o0i = ci[1] + ci[3]; const float dr = cr[1] - cr[3], di = ci[1] - ci[3];
        float o1r, o1i; if (!INV) { o1r = di; o1i = -dr; } else { o1r = -di; o1i = dr; }
        re[0 + s] = e0r + o0r; im[0 + s] = e0i + o0i;
        re[2 + s] = e1r + o1r; im[2 + s] = e1i + o1i;
        re[4 + s] = e0r - o0r; im[4 + s] = e0i - o0i;
        re[6 + s] = e1r - o1r; im[6 + s] = e1i - o1i;
    }
}
template <bool CONJ> HYFFT_HD void hy_twiddle(float (&re)[8], float (&im)[8], float wr, float wi) {
    if (CONJ) wi = -wi;
    const float w2r = wr * wr - wi * wi, w2i = 2.f * wr * wi;
    const float w3r = w2r * wr - w2i * wi, w3i = w2r * wi + w2i * wr;
    const float w4r = w2r * w2r - w2i * w2i, w4i = 2.f * w2r * w2i;
    const float w5r = w4r * wr - w4i * wi, w5i = w4r * wi + w4i * wr;
    const float w6r = w3r * w3r - w3i * w3i, w6i = 2.f * w3r * w3i;
    const float w7r = w4r * w3r - w4i * w3i, w7i = w4r * w3i + w4i * w3r;
    const float pr[8] = {1.f, wr, w2r, w3r, w4r, w5r, w6r, w7r}, pi[8] = {0.f, wi, w2i, w3i, w4i, w5i, w6i, w7i};
#pragma unroll
    for (int k = 1; k < 8; ++k) { const float x = re[k], y = im[k]; re[k] = x * pr[k] - y * pi[k]; im[k] = x * pi[k] + y * pr[k]; }
}
template <int L, class BP, class TP> HYFFT_HD void hy_fwd_store(BP buf, TP tw, int j, float (&re)[8], float (&im)[8]) {
    constexpr int S = L / 8; const int blk = j / S, q = j % S, base = blk * L + q;
    hy_dft8<false>(re, im);
    if (L > 8) { const hy_c32 w = tw[q * (4096 / L)]; hy_twiddle<false>(re, im, w.x, w.y); }
#pragma unroll
    for (int k = 0; k < 8; ++k) buf[hy_padi(base + k * S)] = (hy_c32){re[k], im[k]};
}
template <int L, class BP> HYFFT_HD void hy_load8(BP buf, int j, float (&re)[8], float (&im)[8]) {
    constexpr int S = L / 8; const int blk = j / S, q = j % S, base = blk * L + q;
#pragma unroll
    for (int k = 0; k < 8; ++k) { const hy_c32 v = buf[hy_padi(base + k * S)]; re[k] = v.x; im[k] = v.y; }
}
template <int L, class BP, class TP> HYFFT_HD void hy_fwd_stage(BP buf, TP tw, int j) { float re[8], im[8]; hy_load8<L>(buf, j, re, im); hy_fwd_store<L>(buf, tw, j, re, im); }
template <int L, class BP, class TP> HYFFT_HD void hy_inv_regs(BP buf, TP tw, int j, float (&re)[8], float (&im)[8]) {
    constexpr int S = L / 8; const int q = j % S;
    hy_load8<L>(buf, j, re, im);
    if (L > 8) { const hy_c32 w = tw[q * (4096 / L)]; hy_twiddle<true>(re, im, w.x, w.y); }
    hy_dft8<true>(re, im);
}
template <int L, class BP, class TP> HYFFT_HD void hy_inv_stage(BP buf, TP tw, int j) {
    constexpr int S = L / 8; const int blk = j / S, q = j % S, base = blk * L + q;
    float re[8], im[8]; hy_inv_regs<L>(buf, tw, j, re, im);
#pragma unroll
    for (int k = 0; k < 8; ++k) buf[hy_padi(base + k * S)] = (hy_c32){re[k], im[k]};
}
template <class BP, class KP> HYFFT_HD void hy_mid_stage(BP buf, KP K, int j) {
    float re[8], im[8]; hy_load8<8>(buf, j, re, im);
    hy_dft8<false>(re, im);
#pragma unroll
    for (int k = 0; k < 8; ++k) { const hy_c32 kv = K[hy_padi(8 * j + k)]; const float x = re[k], y = im[k]; re[k] = x * kv.x - y * kv.y; im[k] = x * kv.y + y * kv.x; }
    hy_dft8<true>(re, im);
#pragma unroll
    for (int k = 0; k < 8; ++k) buf[hy_padi(8 * j + k)] = (hy_c32){re[k], im[k]};
}
template <class BP> HYFFT_HD void hy_last_fwd(BP buf, int j) {
    float re[8], im[8]; hy_load8<8>(buf, j, re, im); hy_dft8<false>(re, im);
#pragma unroll
    for (int k = 0; k < 8; ++k) buf[hy_padi(8 * j + k)] = (hy_c32){re[k], im[k]};
}
template <class BP, class KP> HYFFT_HD void hy_separate(BP Z, KP K1, KP K2, int j) {
    const float sc = 0.5f / 4096.0f;
#pragma unroll
    for (int r = 0; r < 8; ++r) {
        const int p = j + 512 * r, f = hy_rev(p), g = (4096 - f) & 4095, p2 = hy_rev(g);
        const hy_c32 a = Z[hy_padi(p)], b = Z[hy_padi(p2)];
        K1[hy_padi(p)] = (hy_c32){(a.x + b.x) * sc, (a.y - b.y) * sc};
        K2[hy_padi(p)] = (hy_c32){(a.y + b.y) * sc, (b.x - a.x) * sc};
    }
}

struct Raw3 { bf16 a, b, c; };
__device__ __forceinline__ Raw3 raw3(const bf16* zp, int t) { const bf16* p = zp + t; Raw3 r; r.a = p[-1]; r.b = p[0]; r.c = p[1]; return r; }
template <bool M0, bool M7> __device__ __forceinline__ float sconv_raw(const Raw3& r, int t, float w0, float w1, float w2, float cb) {
    float z0 = bf1(r.a), z2 = bf1(r.c); const float z1 = bf1(r.b);
    if (M0) z0 = t > 0 ? z0 : 0.f;
    if (M7) z2 = t < SEQ - 1 ? z2 : 0.f;
    return w0 * z0 + w1 * z1 + w2 * z2 + cb;
}
__device__ __forceinline__ float sconv_raw_m(int m, const Raw3& r, int t, float w0, float w1, float w2, float cb) {
    return m == 0 ? sconv_raw<true, false>(r, t, w0, w1, w2, cb) : (m == 7 ? sconv_raw<false, true>(r, t, w0, w1, w2, cb) : sconv_raw<false, false>(r, t, w0, w1, w2, cb));
}
HYFFT_HD int hy16_padi(int i) { return i + (i >> 4); }
HYFFT_HD int hy16_rev(int x) { return ((x & 15) << 8) | (x & 0xF0) | ((x >> 8) & 15); }
template <bool INV> HYFFT_HD void hy16_dft4(float& r0, float& i0, float& r1, float& i1, float& r2, float& i2, float& r3, float& i3) {
    const float e0r = r0 + r2, e0i = i0 + i2, e1r = r0 - r2, e1i = i0 - i2, o0r = r1 + r3, o0i = i1 + i3, dr = r1 - r3, di = i1 - i3;
    float o1r, o1i; if (!INV) { o1r = di; o1i = -dr; } else { o1r = -di; o1i = dr; }
    r0 = e0r + o0r; i0 = e0i + o0i; r1 = e1r + o1r; i1 = e1i + o1i; r2 = e0r - o0r; i2 = e0i - o0i; r3 = e1r - o1r; i3 = e1i - o1i;
}
template <bool INV> HYFFT_HD void hy16_cmulc(float& r, float& i, float cr, float ci) { if (INV) ci = -ci; const float x = r, y = i; r = x * cr - y * ci; i = x * ci + y * cr; }
template <bool INV> HYFFT_HD void hy16_dft16(float (&re)[16], float (&im)[16]) {
    const float c1 = 0.92387953251128674f, s1 = 0.38268343236508977f, h = 0.70710678118654752f;
#pragma unroll
    for (int m2 = 0; m2 < 4; ++m2) hy16_dft4<INV>(re[m2], im[m2], re[4 + m2], im[4 + m2], re[8 + m2], im[8 + m2], re[12 + m2], im[12 + m2]);
    hy16_cmulc<INV>(re[4 * 1 + 1], im[4 * 1 + 1], c1, -s1);
    hy16_cmulc<INV>(re[4 * 2 + 1], im[4 * 2 + 1], h, -h);
    hy16_cmulc<INV>(re[4 * 3 + 1], im[4 * 3 + 1], s1, -c1);
    hy16_cmulc<INV>(re[4 * 1 + 2], im[4 * 1 + 2], h, -h);
    hy16_cmulc<INV>(re[4 * 2 + 2], im[4 * 2 + 2], 0.f, -1.f);
    hy16_cmulc<INV>(re[4 * 3 + 2], im[4 * 3 + 2], -h, -h);
    hy16_cmulc<INV>(re[4 * 1 + 3], im[4 * 1 + 3], s1, -c1);
    hy16_cmulc<INV>(re[4 * 2 + 3], im[4 * 2 + 3], -h, -h);
    hy16_cmulc<INV>(re[4 * 3 + 3], im[4 * 3 + 3], -c1, s1);
#pragma unroll
    for (int k1 = 0; k1 < 4; ++k1) hy16_dft4<INV>(re[4 * k1], im[4 * k1], re[4 * k1 + 1], im[4 * k1 + 1], re[4 * k1 + 2], im[4 * k1 + 2], re[4 * k1 + 3], im[4 * k1 + 3]);
#pragma unroll
    for (int a = 0; a < 4; ++a)
#pragma unroll
        for (int b = a + 1; b < 4; ++b) { float t = re[4 * a + b]; re[4 * a + b] = re[4 * b + a]; re[4 * b + a] = t; t = im[4 * a + b]; im[4 * a + b] = im[4 * b + a]; im[4 * b + a] = t; }
}
template <bool CONJ> HYFFT_HD void hy16_twiddle(float (&re)[16], float (&im)[16], float wr, float wi) {
    if (CONJ) wi = -wi;
    float pr[16], pi[16]; pr[1] = wr; pi[1] = wi;
#define HY16_SQ(d, a) pr[d] = pr[a] * pr[a] - pi[a] * pi[a]; pi[d] = 2.f * pr[a] * pi[a];
#define HY16_MUL(d, a, b) pr[d] = pr[a] * pr[b] - pi[a] * pi[b]; pi[d] = pr[a] * pi[b] + pi[a] * pr[b];
    HY16_SQ(2, 1) HY16_MUL(3, 2, 1) HY16_SQ(4, 2) HY16_MUL(5, 4, 1) HY16_SQ(6, 3) HY16_MUL(7, 4, 3) HY16_SQ(8, 4)
    HY16_MUL(9, 8, 1) HY16_SQ(10, 5) HY16_MUL(11, 8, 3) HY16_SQ(12, 6) HY16_MUL(13, 8, 5) HY16_SQ(14, 7) HY16_MUL(15, 8, 7)
#undef HY16_SQ
#undef HY16_MUL
#pragma unroll
    for (int k = 1; k < 16; ++k) { const float x = re[k], y = im[k]; re[k] = x * pr[k] - y * pi[k]; im[k] = x * pi[k] + y * pr[k]; }
}
template <int L, class BP> HYFFT_HD void hy16_load(BP buf, int jj, float (&re)[16], float (&im)[16]) {
    constexpr int S = L / 16; const int blk = jj / S, q = jj % S, pb = hy16_padi(blk * L + q);
#pragma unroll
    for (int k = 0; k < 16; ++k) { const hy_c32 v = buf[pb + k * (S + S / 16)]; re[k] = v.x; im[k] = v.y; }
}
template <class BP> HYFFT_HD void hy16_load1(BP buf, int jj, float (&re)[16], float (&im)[16]) {
#pragma unroll
    for (int k = 0; k < 16; ++k) { const hy_c32 v = buf[17 * jj + k]; re[k] = v.x; im[k] = v.y; }
}
template <int L, class BP> HYFFT_HD void hy16_store(BP buf, int jj, const float (&re)[16], const float (&im)[16]) {
    constexpr int S = L / 16; const int blk = jj / S, q = jj % S, pb = hy16_padi(blk * L + q);
#pragma unroll
    for (int k = 0; k < 16; ++k) buf[pb + k * (S + S / 16)] = (hy_c32){re[k], im[k]};
}
template <class BP> HYFFT_HD void hy16_store1(BP buf, int jj, const float (&re)[16], const float (&im)[16]) {
#pragma unroll
    for (int k = 0; k < 16; ++k) buf[17 * jj + k] = (hy_c32){re[k], im[k]};
}
template <int L, class BP, class TP> HYFFT_HD void hy16_fwd_store(BP buf, TP tw, int jj, float (&re)[16], float (&im)[16]) {
    constexpr int S = L / 16; const int q = jj % S;
    hy16_dft16<false>(re, im);
    { const hy_c32 w = tw[q * (4096 / L)]; hy16_twiddle<false>(re, im, w.x, w.y); }
    hy16_store<L>(buf, jj, re, im);
}
template <int L, class BP, class TP> HYFFT_HD void hy16_fwd_stage(BP buf, TP tw, int jj) { float re[16], im[16]; hy16_load<L>(buf, jj, re, im); hy16_fwd_store<L>(buf, tw, jj, re, im); }
template <int L, class BP, class TP> HYFFT_HD void hy16_inv_regs(BP buf, TP tw, int jj, float (&re)[16], float (&im)[16]) {
    constexpr int S = L / 16; const int q = jj % S;
    hy16_load<L>(buf, jj, re, im);
    { const hy_c32 w = tw[q * (4096 / L)]; hy16_twiddle<true>(re, im, w.x, w.y); }
    hy16_dft16<true>(re, im);
}
template <int L, class BP, class TP> HYFFT_HD void hy16_inv_stage(BP buf, TP tw, int jj) { float re[16], im[16]; hy16_inv_regs<L>(buf, tw, jj, re, im); hy16_store<L>(buf, jj, re, im); }
template <class BP, class KP> HYFFT_HD void hy16_mid_stage(BP buf, KP K, int jj) {
    float re[16], im[16]; hy16_load1(buf, jj, re, im);
    hy16_dft16<false>(re, im);
#pragma unroll
    for (int k = 0; k < 16; ++k) { const hy_c32 kv = K[17 * jj + k]; const float x = re[k], y = im[k]; re[k] = x * kv.x - y * kv.y; im[k] = x * kv.y + y * kv.x; }
    hy16_dft16<true>(re, im);
    hy16_store1(buf, jj, re, im);
}
template <class BP> HYFFT_HD void hy16_last_fwd(BP buf, int jj) { float re[16], im[16]; hy16_load1(buf, jj, re, im); hy16_dft16<false>(re, im); hy16_store1(buf, jj, re, im); }
template <class BP, class KP> HYFFT_HD void hy16_separate(BP Z, KP K1, KP K2, int t) {
    const float sc = 0.5f / 4096.0f;
#pragma unroll
    for (int r = 0; r < 8; ++r) {
        const int p = t + 512 * r, f = hy16_rev(p), g = (4096 - f) & 4095, p2 = hy16_rev(g);
        const hy_c32 a = Z[hy16_padi(p)], b = Z[hy16_padi(p2)];
        K1[hy16_padi(p)] = (hy_c32){(a.x + b.x) * sc, (a.y - b.y) * sc};
        K2[hy16_padi(p)] = (hy_c32){(a.y + b.y) * sc, (b.x - a.x) * sc};
    }
}
__device__ __forceinline__ void p3_hyena_fft(Frame& F) {
    const int tid0 = F.tid;
    const int half = __builtin_amdgcn_readfirstlane(tid0 >> 8);
    LAS hy_c32* BUF = (LAS hy_c32*)(F.lds + half * 34816);
    LAS hy_c32* B0 = (LAS hy_c32*)(F.lds + 0);
    LAS hy_c32* K1 = (LAS hy_c32*)(F.lds + 69632); LAS hy_c32* K2 = (LAS hy_c32*)(F.lds + 104448); LAS hy_c32* TW = (LAS hy_c32*)(F.lds + 139264);
    const bf16* ZHT = (const bf16*)(F.ws + WS_ZHT); const float* FILT = (const float*)(F.ws + WS_FILT); bf16* YT = (bf16*)(F.ws + WS_YT);
    const float* cw = F.in[I_HCW]; const float* cb = F.in[I_HCB]; const float* skip = F.in[I_HSKIP];
    if (tid0 < 256) { float sn, cs; sincosf(-6.283185307179586f * (float)tid0 / 4096.0f, &sn, &cs); TW[tid0] = (hy_c32){cs, sn}; }
    __syncthreads();
    for (int item = blockIdx.x; item < HYW; item += F.G) {
        const int c = item;
        int tid = tid0; asm volatile("" : "+v"(tid));
        int jj = tid & 255;
        float re[16], im[16];
        const bf16* zv = ZHT + (size_t)c * MTOK; const bf16* za = ZHT + (size_t)(1024 + c) * MTOK; const bf16* zb = ZHT + (size_t)(2048 + c) * MTOK;
        {
            if (half == 0) {
                const float* hf0 = FILT + (size_t)(0 * 1024 + c) * SEQ; const float* hf1 = FILT + (size_t)(1 * 1024 + c) * SEQ;
                const float* hb0 = FILT + (size_t)(2 * 1024 + c) * SEQ; const float* hb1 = FILT + (size_t)(3 * 1024 + c) * SEQ;
#pragma unroll
                for (int m = 0; m < 8; ++m) { const int i = jj + 256 * m; re[m] = hf0[i]; im[m] = hf1[i]; }
                if (jj == 0) { re[0] += hb0[0]; im[0] += hb1[0]; }
#pragma unroll
                for (int m = 8; m < 16; ++m) { const int i = jj + 256 * m; const bool z = (i == 2048); const int r = z ? 0 : 4096 - i; const float a = hb0[r], b = hb1[r]; re[m] = z ? 0.f : a; im[m] = z ? 0.f : b; }
                hy16_fwd_store<4096>(B0, TW, jj, re, im);
            }
            __syncthreads();
            if (half == 0) hy16_fwd_stage<256>(B0, TW, jj);
            __syncthreads();
            if (half == 0) hy16_last_fwd(B0, jj);
            __syncthreads();
            hy16_separate(B0, K1, K2, tid); __syncthreads();
        }
        const float vw0 = cw[c], vw1 = cw[3072 + c], vw2 = cw[6144 + c], vcb = cb[c];
        const float aw0 = cw[1024 + c], aw1 = cw[3072 + 1024 + c], aw2 = cw[6144 + 1024 + c], acb = cb[1024 + c];
        const float bw0 = cw[2048 + c], bw1 = cw[3072 + 2048 + c], bw2 = cw[6144 + 2048 + c], bcb = cb[2048 + c];
        const float sk0 = skip[c], sk1 = skip[1024 + c];
#pragma unroll 1
        for (int rd = 0; rd < 2; ++rd) {
            const int boff = (4 * rd + 2 * half) * SEQ;
            asm volatile("" : "+v"(jj));
            Raw3 rg[2][8];
            float v[2][8];
#pragma unroll
            for (int m = 0; m < 8; ++m) { const int t = jj + 256 * m;
                const Raw3 r0 = raw3(zv + boff, t), r1 = raw3(zv + boff + SEQ, t); v[0][m] = sconv_raw_m(m, r0, t, vw0, vw1, vw2, vcb); v[1][m] = sconv_raw_m(m, r1, t, vw0, vw1, vw2, vcb); }
#pragma unroll
            for (int m = 0; m < 8; ++m) { re[m] = v[0][m]; im[m] = v[1][m]; re[m + 8] = 0.f; im[m + 8] = 0.f; }
            hy16_fwd_store<4096>(BUF, TW, jj, re, im); __syncthreads();
            hy16_fwd_stage<256>(BUF, TW, jj); __syncthreads();
            hy16_mid_stage(BUF, K1, jj); __syncthreads();
#pragma unroll
            for (int m = 0; m < 8; ++m) { const int t = jj + 256 * m; rg[0][m] = raw3(za + boff, t); rg[1][m] = raw3(za + boff + SEQ, t); }
            hy16_inv_stage<256>(BUF, TW, jj); __syncthreads();
            hy16_inv_regs<4096>(BUF, TW, jj, re, im);
#pragma unroll
            for (int m = 0; m < 8; ++m) { const int t = jj + 256 * m;
                v[0][m] = sconv_raw_m(m, rg[0][m], t, aw0, aw1, aw2, acb) * (re[m] + sk0 * v[0][m]); v[1][m] = sconv_raw_m(m, rg[1][m], t, aw0, aw1, aw2, acb) * (im[m] + sk0 * v[1][m]); }
#pragma unroll
            for (int m = 0; m < 8; ++m) { re[m] = v[0][m]; im[m] = v[1][m]; re[m + 8] = 0.f; im[m + 8] = 0.f; }
            hy16_fwd_store<4096>(BUF, TW, jj, re, im); __syncthreads();
            hy16_fwd_stage<256>(BUF, TW, jj); __syncthreads();
            hy16_mid_stage(BUF, K2, jj); __syncthreads();
#pragma unroll
            for (int m = 0; m < 8; ++m) { const int t = jj + 256 * m; rg[0][m] = raw3(zb + boff, t); rg[1][m] = raw3(zb + boff + SEQ, t); }
            hy16_inv_stage<256>(BUF, TW, jj); __syncthreads();
            hy16_inv_regs<4096>(BUF, TW, jj, re, im);
#pragma unroll
            for (int m = 0; m < 8; ++m) { const int t = jj + 256 * m; bf16* yp = YT + (size_t)c * MTOK + boff + t;
                yp[0] = (bf16)f2bf(sconv_raw_m(m, rg[0][m], t, bw0, bw1, bw2, bcb) * (re[m] + sk1 * v[0][m]));
                yp[SEQ] = (bf16)f2bf(sconv_raw_m(m, rg[1][m], t, bw0, bw1, bw2, bcb) * (im[m] + sk1 * v[1][m])); }
        }
        __syncthreads();
    }
}

__device__ __forceinline__ void p3c_transpose(Frame& F) {
    LAS unsigned* tile = (LAS unsigned*)F.lds;
    const bf16* YT = (const bf16*)(F.ws + WS_YT); bf16* AB = (bf16*)(F.ws + WS_H);
    const int tid = F.tid;
    for (int it = blockIdx.x; it < MTOK / 64; it += F.G) {
        const int t0 = it * 64;
        { const int rr = tid >> 3, seg = tid & 7;
          v4u w[16];
#pragma unroll
          for (int i = 0; i < 16; ++i) w[i] = *(const v4u*)(YT + (size_t)(i * 64 + rr) * MTOK + t0 + seg * 8);
#pragma unroll
          for (int i = 0; i < 16; ++i) { const int c = i * 64 + rr, rot = (c >> 3) + (c & 3); LAS unsigned* row = tile + c * 32;
              row[(seg * 4 + 0 + rot) & 31] = w[i].x; row[(seg * 4 + 1 + rot) & 31] = w[i].y; row[(seg * 4 + 2 + rot) & 31] = w[i].z; row[(seg * 4 + 3 + rot) & 31] = w[i].w; } }
        __syncthreads();
#pragma unroll 2
        for (int k = 0; k < 8; ++k) { const int j = tid + 512 * k, tp = j >> 7, cseg = j & 127;
            unsigned d[8];
#pragma unroll
            for (int e = 0; e < 8; ++e) d[e] = tile[(8 * cseg + e) * 32 + ((tp + cseg + (e & 3)) & 31)];
            v4u lo, hi;
            lo.x = (d[0] & 0xffffu) | (d[1] << 16); lo.y = (d[2] & 0xffffu) | (d[3] << 16); lo.z = (d[4] & 0xffffu) | (d[5] << 16); lo.w = (d[6] & 0xffffu) | (d[7] << 16);
            hi.x = (d[0] >> 16) | (d[1] & 0xffff0000u); hi.y = (d[2] >> 16) | (d[3] & 0xffff0000u); hi.z = (d[4] >> 16) | (d[5] & 0xffff0000u); hi.w = (d[6] >> 16) | (d[7] & 0xffff0000u);
            bf16* dst = AB + (size_t)(t0 + 2 * tp) * DM + 1024 + 8 * cseg;
            *(v4u*)dst = lo; *(v4u*)(dst + DM) = hi; }
        __syncthreads();
    }
}

typedef _Float16 ln_f16x4 __attribute__((ext_vector_type(4)));
template <bool FINAL> __device__ __forceinline__ void ln_rows(Frame& F) {
    const _Float16* R = FINAL ? (const _Float16*)(F.ws + WS_H) : (const _Float16*)F.out;
    const float* st = (const float*)(F.ws + (FINAL ? WS_ST2 : WS_ST1)); float* MU = (float*)(F.ws + WS_MU1);
    const float* mod = (const float*)(F.ws + WS_MOD); bf16* H2 = (bf16*)(F.ws + WS_H);
    const float* lng = F.in[FINAL ? I_LN2G : I_LN1G]; const float* lnb = F.in[FINAL ? I_LN2B : I_LN1B];
    const int gw = blockIdx.x * NWAVES + F.wave, NGW = F.G * NWAVES, lane = F.lane;
    ln_f16x4 cur[8], nxt[8]; f32x2 ps = (f32x2){0.f, 0.f}, pn = (f32x2){0.f, 0.f};
    int row = gw;
    if (row < MTOK) {
#pragma unroll
        for (int j = 0; j < 8; ++j) cur[j] = *(const ln_f16x4*)(R + (size_t)row * DM + 4 * lane + 256 * j);
        if (lane < 32) ps = *(const f32x2*)(st + ((size_t)row * 32 + lane) * 2);
    }
    for (; row < MTOK; row += NGW) {
        const int rn = row + NGW;
        if (rn < MTOK) {
#pragma unroll
            for (int j = 0; j < 8; ++j) nxt[j] = *(const ln_f16x4*)(R + (size_t)rn * DM + 4 * lane + 256 * j);
            pn = (f32x2){0.f, 0.f}; if (lane < 32) pn = *(const f32x2*)(st + ((size_t)rn * 32 + lane) * 2);
        }
        const float s = wave_sum(ps.x), q = wave_sum(ps.y);
        const float mean = s * (1.0f / DM); float var = q * (1.0f / DM) - mean * mean; var = var > 0.f ? var : 0.f; const float rstd = 1.0f / sqrtf(var + LN_EPS);
        if (!FINAL && lane == 0) *(f32x2*)(MU + (size_t)row * 2) = (f32x2){mean, rstd};
        const int b = row >> 11;
#pragma unroll
        for (int j = 0; j < 8; ++j) { const int col = 4 * lane + 256 * j;
            const f32x4 v = (f32x4){(float)cur[j][0], (float)cur[j][1], (float)cur[j][2], (float)cur[j][3]};
            const f32x4 y = (v - mean) * rstd * *(const f32x4*)(lng + col) + *(const f32x4*)(lnb + col);
            if (FINAL) *(f32x4*)(F.out + (size_t)row * DM + col) = y;
            else { const float* mp = mod + (size_t)b * MODW + col; const f32x4 h = y * (*(const f32x4*)(mp + 4 * DM) + 1.0f) + *(const f32x4*)(mp + 3 * DM);
                   v2u o; o.x = pk2(h[0], h[1]); o.y = pk2(h[2], h[3]); *(v2u*)(H2 + (size_t)row * DM + col) = o; } }
#pragma unroll
        for (int j = 0; j < 8; ++j) cur[j] = nxt[j];
        ps = pn;
    }
}

typedef GAS unsigned gu32;
#define RLX_AGENT __ATOMIC_RELAXED, __HIP_MEMORY_SCOPE_AGENT
constexpr int LDSCTL_OFF = 163840 - 512, MISC_OFF = LDSCTL_OFF;
constexpr int CW_BAR = 4096;
constexpr size_t CTL_ZERO_BYTES = 65536;
#define XB_TMO      128
#define XB_XCNT(j)  (256  + 64 * (j))
#define XB_XSUB(j)  (1280 + 64 * (j))
#define XB_XGEN(j)  (2304 + 64 * (j))
#define XB_TOP      3328
#define XB_TOPGEN   3392
#define XCD_BAR_WORDS 3456
#define XB_SPIN_CAP (1u << 18)

__device__ __forceinline__ unsigned xb_ld(unsigned* p)              { return __hip_atomic_load(p, __ATOMIC_RELAXED, __HIP_MEMORY_SCOPE_AGENT); }
__device__ __forceinline__ unsigned xb_add(unsigned* p, unsigned v) { return __hip_atomic_fetch_add(p, v, __ATOMIC_RELAXED, __HIP_MEMORY_SCOPE_AGENT); }
__device__ __forceinline__ unsigned xb_xcc_id() { return (unsigned)__builtin_amdgcn_s_getreg((3 << 11) | 20) & 0xFu; }
#define XB_SPIN(cond, bar) do { unsigned _sp = 0; while (cond) { __builtin_amdgcn_s_sleep(1); \
    if ((++_sp & 255u) == 0u) { if (xb_ld(&(bar)[XB_TMO])) break; if (_sp > XB_SPIN_CAP) { atomicAdd(&(bar)[XB_TMO], 1u); break; } } } } while (0)

struct XcdBarrier {
    unsigned* bar; unsigned x;
    volatile LAS unsigned* st;
};

__device__ __forceinline__ XcdBarrier xcd_barrier_post(unsigned* bar, volatile LAS unsigned* st) {
    XcdBarrier b; b.bar = bar; b.x = xb_xcc_id(); b.st = st;
    if (threadIdx.x == 0) (void)xb_add(&bar[XB_XCNT(b.x)], 1u);
    return b;
}
__device__ __forceinline__ void xcd_barrier_complete(unsigned* bar, unsigned x, unsigned& nloc, unsigned& nx) {
    const unsigned G = gridDim.x * gridDim.y * gridDim.z;
    unsigned sum, cnt, mine, sp = 0u;
    for (;;) {
        sum = 0u; cnt = 0u; mine = 0u;
#pragma unroll
        for (unsigned j = 0; j < 16; ++j) { const unsigned c = xb_ld(&bar[XB_XCNT(j)]); sum += c; cnt += (c > 0u) ? 1u : 0u; mine = (j == x) ? c : mine; }
        if (sum == G) break;
        __builtin_amdgcn_s_sleep(1);
        if ((++sp & 255u) == 0u) { if (xb_ld(&bar[XB_TMO])) break; if (sp > XB_SPIN_CAP) { atomicAdd(&bar[XB_TMO], 1u); break; } }
    }
    nloc = mine > 0u ? mine : 1u; nx = cnt > 0u ? cnt : 1u;
}

__device__ __forceinline__ void xcd_barrier(const XcdBarrier& b) {
    asm volatile("s_waitcnt vmcnt(0)" ::: "memory");
    __syncthreads();
    if (threadIdx.x == 0) {
        unsigned* bar = b.bar;
        __builtin_amdgcn_s_waitcnt(0);
        unsigned nloc = b.st[0], nx = b.st[1];
        if (nloc == 0u) { xcd_barrier_complete(bar, b.x, nloc, nx); b.st[0] = nloc; b.st[1] = nx; }
        const unsigned old = xb_add(&bar[XB_XSUB(b.x)], 1u);
        const unsigned gen = old / nloc;
        if (old + 1u == (gen + 1u) * nloc) {
            __builtin_amdgcn_fence(__ATOMIC_RELEASE, "agent");
            asm volatile("s_waitcnt vmcnt(0)" ::: "memory");
            const unsigned og = xb_add(&bar[XB_TOP], 1u);
            const unsigned tg = og / nx;
            if (og + 1u == (tg + 1u) * nx) xb_add(&bar[XB_TOPGEN], 1u);
            else XB_SPIN(xb_ld(&bar[XB_TOPGEN]) == tg, bar);
            __builtin_amdgcn_fence(__ATOMIC_ACQUIRE, "agent");
            xb_add(&bar[XB_XGEN(b.x)], 1u);
            asm volatile("s_waitcnt vmcnt(0)" ::: "memory");
        } else {
            XB_SPIN(xb_ld(&bar[XB_XGEN(b.x)]) == gen, bar);
            __builtin_amdgcn_fence(__ATOMIC_ACQUIRE, "agent");
            asm volatile("s_waitcnt vmcnt(0)" ::: "memory");
        }
    }
    __syncthreads();
}

#define GRID_SYNC() xcd_barrier(bar)

__global__ void __launch_bounds__(NWAVES * 64, 2) fwd_megakernel(Args args) {
    extern __shared__ __attribute__((aligned(16))) unsigned char lds[];
    Frame F;
    F.lds = (LAS unsigned char*)lds;
    F.tid = threadIdx.x; F.lane = F.tid & 63; F.wave = __builtin_amdgcn_readfirstlane(F.tid >> 6); F.G = gridDim.x;
    F.in = args.in; F.out = args.out; F.ws = args.ws;
    for (int u = F.tid; u < (LDS_BYTES - LDSCTL_OFF) / 4; u += NWAVES * 64) ((LAS unsigned*)(F.lds + LDSCTL_OFF))[u] = 0u;
    __syncthreads();
    XcdBarrier bar = xcd_barrier_post((unsigned*)(args.ws + WS_CTL) + CW_BAR, (volatile LAS unsigned*)(F.lds + MISC_OFF) + 8);
    unsigned char* ws = args.ws;
    const int lo = args.ph_lo, hi = args.ph_hi;
#define IN(k) (lo <= (k) && (k) < hi)
#define BOTH(k) (IN(k) && IN((k) + 1))
    const int gw = blockIdx.x * NWAVES + F.wave, NGW = F.G * NWAVES;

    PB_START(1, F.lds);
    if (IN(0)) { { int t_ = threadIdx.x; asm volatile("" : "+v"(t_)); F.tid = t_; F.lane = t_ & 63; }
        PB_START(21, F.lds); p0_mod(F); PB_END(21, F.lds);
        PB_START(22, F.lds);
        transpose_matrix(F, F.in[I_WIN], DM, INW, (bf16*)(ws + WS_WIN), DM, 0, 1, (int)blockIdx.x, F.G);
        transpose_matrix(F, F.in[I_WA], SGUW, DM, (bf16*)(ws + WS_WAB), DM, 0, 0, (int)((blockIdx.x + 128) % F.G), F.G);
        transpose_matrix(F, F.in[I_WB], HYW, DM, (bf16*)(ws + WS_WAB), DM, 1024, 0, (int)blockIdx.x, F.G);
        transpose_matrix(F, F.in[I_WO], DM, DM, (bf16*)(ws + WS_WO), DM, 0, 0, (int)blockIdx.x, F.G);
        { const float* sw = F.in[I_SW]; bf16* sgw = (bf16*)(ws + WS_SGW);
          for (int i = blockIdx.x * (NWAVES * 64) + F.tid; i < 8 * 128 * 128 / 2; i += F.G * NWAVES * 64) { const f32x2 v = *(const f32x2*)(sw + 2 * i); *(unsigned*)(sgw + 2 * i) = pk2(v.x, v.y); } }
        __syncthreads();
        __syncthreads(); p0_hid2(F);
        PB_END(22, F.lds);
        if (BOTH(0)) GRID_SYNC();
    }
    PB_END(1, F.lds);
    PB_START(2, F.lds);
    if (IN(1)) { { int t_ = threadIdx.x; asm volatile("" : "+v"(t_)); F.tid = t_; F.lane = t_ & 63; } if (F.wave < 4) p1_modulate(F); else p1_filter_waves(F); if (BOTH(1)) GRID_SYNC(); }
    PB_END(2, F.lds);
    PB_START(3, F.lds);
    if (IN(2)) { { int t_ = threadIdx.x; asm volatile("" : "+v"(t_)); F.tid = t_; F.lane = t_ & 63; }
        { pg8::Gemm g{(const pg8::bf16_t*)(ws + WS_H), (const pg8::bf16_t*)(ws + WS_WIN), MTOK, 5120, DM}; pg8::StaticOrder S; S.init(MTOK, 5120, F.G, (int)blockIdx.x, WGM_P2A);
          pg8::EpiG1 E{(pg8::bf16_t*)(ws + WS_U), (pg8::bf16_t*)(ws + WS_G), F.in[I_BIN]};
          pg8::gemm_phase<pg8::EpiG1, pg8::StaticOrder, true, true>(F.lds, g, S, E); }
        __syncthreads();
        { pg8::Gemm g{(const pg8::bf16_t*)(ws + WS_WIN) + (size_t)5120 * DM, (const pg8::bf16_t*)(ws + WS_H), 4096, MTOK, DM}; pg8::StaticOrder S; S.init(4096, MTOK, F.G, (int)blockIdx.x, WGM_P2B);
          pg8::EpiG1T E{(pg8::bf16_t*)(ws + WS_V), (pg8::bf16_t*)(ws + WS_ZHT), F.in[I_BIN], (float*)(ws + WS_STV)};
          pg8::gemm_phase<pg8::EpiG1T, pg8::StaticOrder, true, true>(F.lds, g, S, E); }
        if (BOTH(2)) GRID_SYNC();
    }
    PB_END(3, F.lds);
    PB_START(4, F.lds);
    if (IN(3)) { { int t_ = threadIdx.x; asm volatile("" : "+v"(t_)); F.tid = t_; F.lane = t_ & 63; } __syncthreads(); PB_START(41, F.lds); p3_sgu(F); PB_END(41, F.lds); PB_START(42, F.lds); p3_hyena_fft(F); PB_END(42, F.lds); if (BOTH(3)) GRID_SYNC(); PB_START(43, F.lds); p3c_transpose(F); GRID_SYNC(); PB_END(43, F.lds); }
    PB_END(4, F.lds);
    PB_START(5, F.lds);
    if (IN(4)) { { int t_ = threadIdx.x; asm volatile("" : "+v"(t_)); F.tid = t_; F.lane = t_ & 63; }
        pg8::Gemm g{(const pg8::bf16_t*)(ws + WS_H), (const pg8::bf16_t*)(ws + WS_WAB), MTOK, DM, DM}; pg8::StaticOrder S; S.init(MTOK, DM, F.G, (int)blockIdx.x, WGM_P4);
        pg8::EpiG2 E{(const pg8::bf16_t*)(ws + WS_G), (pg8::bf16_t*)(ws + WS_MERGED)};
        pg8::gemm_phase<pg8::EpiG2, pg8::StaticOrder, true, true>(F.lds, g, S, E);
        if (BOTH(4)) GRID_SYNC();
    }
    PB_END(5, F.lds);
    PB_START(6, F.lds);
    if (IN(5)) { { int t_ = threadIdx.x; asm volatile("" : "+v"(t_)); F.tid = t_; F.lane = t_ & 63; }
        pg8::Gemm g{(const pg8::bf16_t*)(ws + WS_MERGED), (const pg8::bf16_t*)(ws + WS_WO), MTOK, DM, DM}; pg8::StaticOrder S; S.init(MTOK, DM, F.G, (int)blockIdx.x, WGM_P5);
        pg8::EpiRes<true> E{F.in[I_X], nullptr, (_Float16*)F.out, (const float*)(ws + WS_MOD) + 2 * DM, F.in[I_BO], nullptr, nullptr, nullptr, (float*)(ws + WS_ST1)};
        pg8::gemm_phase<pg8::EpiRes<true>, pg8::StaticOrder, true, true>(F.lds, g, S, E);
        if (BOTH(5)) GRID_SYNC();
    }
    PB_END(6, F.lds);
    PB_START(7, F.lds);
    if (IN(6)) { { int t_ = threadIdx.x; asm volatile("" : "+v"(t_)); F.tid = t_; F.lane = t_ & 63; }
        __syncthreads();
        ln_rows<false>(F);
        __syncthreads();
        transpose_matrix(F, F.in[I_WM1], DM, DFF, (bf16*)(ws + WS_WM1), DM, 0, 0, (int)blockIdx.x, F.G);
        transpose_matrix(F, F.in[I_WM2], DFF, DM, (bf16*)(ws + WS_WM2), DFF, 0, 0, (int)blockIdx.x, F.G);
        if (BOTH(6)) GRID_SYNC();
    }
    PB_END(7, F.lds);
    PB_START(8, F.lds);
    if (IN(7)) { { int t_ = threadIdx.x; asm volatile("" : "+v"(t_)); F.tid = t_; F.lane = t_ & 63; }
        __syncthreads();
        pg8::Gemm g{(const pg8::bf16_t*)(ws + WS_H), (const pg8::bf16_t*)(ws + WS_WM1), MTOK, DFF, DM}; pg8::StaticOrder S; S.init(MTOK, DFF, F.G, (int)blockIdx.x, WGM_P7);
        pg8::EpiG4 E{(pg8::bf16_t*)(ws + WS_AFF), F.in[I_BM1]};
        pg8::gemm_phase<pg8::EpiG4, pg8::StaticOrder, true, true>(F.lds, g, S, E);
        if (BOTH(7)) GRID_SYNC();
    }
    PB_END(8, F.lds);
    PB_START(9, F.lds);
    if (IN(8)) { { int t_ = threadIdx.x; asm volatile("" : "+v"(t_)); F.tid = t_; F.lane = t_ & 63; }
        pg8::Gemm g{(const pg8::bf16_t*)(ws + WS_AFF), (const pg8::bf16_t*)(ws + WS_WM2), MTOK, DM, DFF}; pg8::StaticOrder S; S.init(MTOK, DM, F.G, (int)blockIdx.x, WGM_P8);
        pg8::EpiRes<false> E{nullptr, (const _Float16*)F.out, (_Float16*)(ws + WS_H), (const float*)(ws + WS_MOD) + 5 * DM, F.in[I_BM2], F.in[I_LN1G], F.in[I_LN1B], (const float*)(ws + WS_MU1), (float*)(ws + WS_ST2)};
        pg8::gemm_phase<pg8::EpiRes<false>, pg8::StaticOrder, true, true>(F.lds, g, S, E);
        if (BOTH(8)) GRID_SYNC();
    }
    PB_END(9, F.lds);
    PB_START(10, F.lds);
    if (IN(9)) { { int t_ = threadIdx.x; asm volatile("" : "+v"(t_)); F.tid = t_; F.lane = t_ & 63; } ln_rows<true>(F); }
    PB_END(10, F.lds);
    if (PROBE_ID != 0 && blockIdx.x == 0 && threadIdx.x == 0) { const unsigned long long wait_ = *(volatile LAS unsigned long long*)(F.lds + PB_LDS_OFF), t0_ = __builtin_amdgcn_s_memrealtime();
        while (__builtin_amdgcn_s_memrealtime() - t0_ < wait_) __builtin_amdgcn_s_sleep(8); }
#undef IN
#undef BOTH
}

constexpr int N_PHASES = 10;
#ifndef MK_N_LAUNCHES
#define MK_N_LAUNCHES 1
#endif
extern "C" void kernel_launch(void* const* d_in, const int* in_sizes, int n_in, void* d_out, int out_size, void* d_ws, size_t ws_size, hipStream_t stream) {
    static int grid = 0;
    if (grid == 0) {
        if (n_in != 31 || in_sizes[0] != MTOK * DM || out_size != MTOK * DM || ws_size < WS_END) {
            fprintf(stderr, "kernel_launch: unexpected problem: n_in %d in0 %d out %d ws %zu (need %zu)\n", n_in, n_in > 0 ? in_sizes[0] : -1, out_size, ws_size, (size_t)WS_END); grid = -1; return; }
        int dev = 0, cus = 0, per_cu = 0;
        if (hipGetDevice(&dev) != hipSuccess || hipDeviceGetAttribute(&cus, hipDeviceAttributeMultiprocessorCount, dev) != hipSuccess) { grid = -1; return; }
        if (hipFuncSetAttribute((const void*)fwd_megakernel, hipFuncAttributeMaxDynamicSharedMemorySize, LDS_BYTES) != hipSuccess) { fprintf(stderr, "kernel_launch: hipFuncSetAttribute failed\n"); grid = -1; return; }
        if (hipOccupancyMaxActiveBlocksPerMultiprocessor(&per_cu, (const void*)fwd_megakernel, NWAVES * 64, LDS_BYTES) != hipSuccess || per_cu < 1) { fprintf(stderr, "kernel_launch: occupancy query says %d\n", per_cu); per_cu = 1; }
        (void)hipGetLastError();
        grid = cus;
    }
    if (grid < 0) return;
    if (hipMemsetAsync((char*)d_ws + WS_CTL, 0, CTL_ZERO_BYTES, stream) != hipSuccess) { fprintf(stderr, "kernel_launch: memset failed\n"); return; }
    Args a{};
    for (int i = 0; i < 31; ++i) a.in[i] = (const float*)d_in[i];
    a.out = (float*)d_out; a.ws = (unsigned char*)d_ws;
    if (MK_N_LAUNCHES == 1) {
        a.ph_lo = 0; a.ph_hi = N_PHASES;
        void* kargs[] = {&a};
        hipError_t e = hipLaunchCooperativeKernel((const void*)fwd_megakernel, dim3(grid), dim3(NWAVES * 64), kargs, LDS_BYTES, stream);
        if (e != hipSuccess) fprintf(stderr, "kernel_launch: cooperative launch failed: %s (grid %d)\n", hipGetErrorString(e), grid);
    } else {
        for (int p = 0; p < N_PHASES; ++p) { a.ph_lo = p; a.ph_hi = p + 1; hipLaunchKernelGGL(fwd_megakernel, dim3(grid), dim3(NWAVES * 64), LDS_BYTES, stream, a); }
    }
}
```

```cpp
#include <hip/hip_runtime.h>
#include <cstdio>
#include <cstdint>

#ifndef WGM_P2A
#define WGM_P2A 4
#endif
#ifndef WGM_P2B
#define WGM_P2B 4
#endif
#ifndef WGM_P4
#define WGM_P4 4
#endif
#ifndef WGM_P5
#define WGM_P5 4
#endif
#ifndef WGM_P7
#define WGM_P7 4
#endif
#ifndef WGM_P8
#define WGM_P8 4
#endif
#ifndef PROBE_ID
#define PROBE_ID 0
#endif
#define PB_LDS_OFF (163840 - 512 + 128)
#define PB_START(id, ldsp) do { if (PROBE_ID == (id) && blockIdx.x == 0 && threadIdx.x == 0) { *(volatile __attribute__((address_space(3))) unsigned long long*)((ldsp) + PB_LDS_OFF + 8) = __builtin_amdgcn_s_memrealtime(); } } while (0)
#define PB_END(id, ldsp) do { if (PROBE_ID == (id) && blockIdx.x == 0 && threadIdx.x == 0) { volatile __attribute__((address_space(3))) unsigned long long* pb_ = (volatile __attribute__((address_space(3))) unsigned long long*)((ldsp) + PB_LDS_OFF); pb_[0] += __builtin_amdgcn_s_memrealtime() - pb_[1]; } } while (0)
namespace pg8 {
#define PG8_LAS __attribute__((address_space(3)))
typedef unsigned short bf16_t;
typedef short bf16x8 __attribute__((ext_vector_type(8)));
typedef float f32x4 __attribute__((ext_vector_type(4)));
typedef unsigned u32x4 __attribute__((ext_vector_type(4)));
typedef float f32x2 __attribute__((ext_vector_type(2)));
constexpr int EPI_LDS_OFF = 131072;
constexpr int BM = 256, BK = 64, HALF = 128, HTB = HALF * BK * 2  , STAGE_BYTES = 8 * HTB, NXCD = 8, WGM = 8;

__host__ __device__ __forceinline__ int lds_byte(int r, int c) { const int st = (r >> 4) * 2 + (c >> 5), rr = r & 15, cc = c & 31, ob = rr * 64 + cc * 2; return st * 1024 + (ob ^ (((ob >> 9) & 1) << 5)); }
__host__ __device__ __forceinline__ void stage_rc(int b, int& R, int& C) { const int st = b / 1024, sb = b % 1024, swz = sb ^ (((sb >> 9) & 1) << 5); R = (st >> 1) * 16 + swz / 64; C = (st & 1) * 32 + (swz % 64) / 2; }
__host__ __device__ __forceinline__ int perm32(int rho) { const int n = rho >> 4, i = rho & 15; return 8 * (i >> 2) + 4 * n + (i & 3); }

struct Unit { int pm, pn; };
struct Gemm { const bf16_t* A; const bf16_t* Bt; int M, N, K; };

struct StaticOrder {
    int nM, nN, nwg, G, c, wgm;
    __host__ __device__ void init(int M, int N, int G_, int c_, int wgm_ = 4) { nM = M / BM; nN = N / BM; nwg = nM * nN; G = G_; c = c_; wgm = wgm_; }
    __host__ __device__ bool next(int i, Unit& u) const {
        const long L = (long)i * G + c; if (L >= nwg) return false;
        int wgid = (int)L; { const int q = nwg / NXCD, r = nwg % NXCD, xcd = wgid % NXCD, off = wgid / NXCD; wgid = (xcd < r ? xcd * (q + 1) : r * (q + 1) + (xcd - r) * q) + off; }
        const int nig = wgm * nN, gid = wgid / nig, fm = gid * wgm, gsz = (nM - fm) < wgm ? (nM - fm) : wgm;
        u.pm = fm + ((wgid % nig) % gsz); u.pn = (wgid % nig) / gsz; return true;
    }
    __device__ __forceinline__ void a_ready(const Unit&) const {}
    __device__ __forceinline__ void done(const Unit&) const {}
};

__device__ __forceinline__ unsigned cvt_pk_bf16(float lo, float hi) { unsigned r; asm volatile("v_cvt_pk_bf16_f32 %0, %1, %2" : "=v"(r) : "v"(lo), "v"(hi)); return r; }
__device__ __forceinline__ f32x2 gelu_pk(f32x2 v) {
    const f32x2 av = __builtin_elementwise_abs(v), d = av * 0.2316418882f + 1.0f;
    f32x2 t; t.x = __builtin_amdgcn_rcpf(d.x); t.y = __builtin_amdgcn_rcpf(d.y);
    f32x2 q = t * 0.5307027145f + (-0.7265760135f); q = q * t + 0.7107068705f; q = q * t + (-0.142248368f); q = q * t + 0.127414796f; q = q * t;
    const f32x2 s = (v * v) * (-0.72134752044f);
    f32x2 e; e.x = __builtin_amdgcn_exp2f(s.x); e.y = __builtin_amdgcn_exp2f(s.y);
    const f32x2 m = v * (q * e), r = v - m;
    f32x2 o; o.x = v.x < 0.f ? m.x : r.x; o.y = v.y < 0.f ? m.y : r.y; return o;
}
__device__ __forceinline__ float bf_lo(unsigned w) { return __uint_as_float(w << 16); }
__device__ __forceinline__ float bf_hi(unsigned w) { return __uint_as_float(w & 0xffff0000u); }
__device__ __forceinline__ float sigmoid_f(float x) { return __builtin_amdgcn_rcpf(1.0f + __expf(-x)); }
}

constexpr int DM = 2048, NBATCH = 8, SEQ = 2048, MTOK = NBATCH * SEQ;
constexpr int SGUW = 1024, HYW = 1024, DFF = 8192, INW = 9216, MODW = 6 * DM;
constexpr float LN_EPS = 1e-5f;
constexpr float DN_ALPHA = 1.189207115002721f;

namespace pg8 {

struct EpiG1 {
    static constexpr bool PERM = true, AFTER_DRAIN = false, MID = false; static constexpr int SLOT_FLOATS = 256;
    bf16_t* U; bf16_t* G; const float* b_in;
    __device__ __forceinline__ void mid(f32x4 (&)[2][2][4][2], const Unit&, int, int, int, int) const {}
    __device__ __forceinline__ void preload(PG8_LAS float* slot, const Unit& u, int tid) const { if (tid < 256) slot[tid] = b_in[(u.pn < 4 ? u.pn * 256 : 5120 + (u.pn - 4) * 256) + tid]; }
    __device__ __forceinline__ void operator()(const f32x4 (&acc)[2][2][4][2], const Unit& u, int wr, int wc, int fr, int fq, const PG8_LAS float* slot) const {
        const int row0 = u.pm * BM + wr * 64 + fr; const int pn = u.pn;
        int ldc, colt; bf16_t* base; const bool isu = pn < 4;
        if (isu) { base = U; ldc = SGUW; colt = pn * 256; }
        else { base = G; ldc = 2 * DM; colt = (pn - 4) * 256; }
        const int cl = wc * 64 + 8 * fq;
        f32x4 bv[2][2];
#pragma unroll
        for (int bj = 0; bj < 2; ++bj)
#pragma unroll
            for (int n = 0; n < 2; ++n) bv[bj][n] = *(const PG8_LAS f32x4*)(slot + cl + bj * 32 + 4 * n);
#pragma unroll
        for (int ai = 0; ai < 2; ++ai)
#pragma unroll
            for (int m = 0; m < 4; ++m) {
                const int row = row0 + ai * HALF + m * 16;
                bf16_t* rowp = base + (size_t)row * ldc + colt + cl;
#pragma unroll
                for (int bj = 0; bj < 2; ++bj) {
                    f32x4 v0 = acc[ai][bj][m][0] + bv[bj][0], v1 = acc[ai][bj][m][1] + bv[bj][1];
                    if (isu) {
                        f32x2 a = gelu_pk((f32x2){v0[0], v0[1]}), b = gelu_pk((f32x2){v0[2], v0[3]}), c = gelu_pk((f32x2){v1[0], v1[1]}), d = gelu_pk((f32x2){v1[2], v1[3]});
                        v0 = (f32x4){a.x, a.y, b.x, b.y}; v1 = (f32x4){c.x, c.y, d.x, d.y};
                    } else {
                        v0 = (f32x4){sigmoid_f(v0[0]), sigmoid_f(v0[1]), sigmoid_f(v0[2]), sigmoid_f(v0[3])};
                        v1 = (f32x4){sigmoid_f(v1[0]), sigmoid_f(v1[1]), sigmoid_f(v1[2]), sigmoid_f(v1[3])};
                    }
                    u32x4 w; w.x = cvt_pk_bf16(v0[0], v0[1]); w.y = cvt_pk_bf16(v0[2], v0[3]); w.z = cvt_pk_bf16(v1[0], v1[1]); w.w = cvt_pk_bf16(v1[2], v1[3]);
                    *(u32x4*)(rowp + bj * 32) = w;
                }
            }
    }
};

struct EpiG1T {
    static constexpr bool PERM = true, AFTER_DRAIN = false, MID = false;
    bf16_t* VT; bf16_t* ZHT; const float* b_in; float* statsV; static constexpr int SLOT_FLOATS = 256;
    __device__ __forceinline__ void mid(f32x4 (&)[2][2][4][2], const Unit&, int, int, int, int) const {}
    __device__ __forceinline__ void preload(PG8_LAS float* slot, const Unit& u, int tid) const { if (tid < 256) slot[tid] = b_in[1024 + u.pm * 256 + tid]; }
    __device__ __forceinline__ void operator()(const f32x4 (&acc)[2][2][4][2], const Unit& u, int wr, int wc, int fr, int fq, const PG8_LAS float* slot) const {
        const int col0 = u.pn * BM + wc * 64 + 8 * fq; const bool isv = u.pm < 4;
        const int rowt = (isv ? u.pm : u.pm - 4) * BM + wr * 64 + fr;
        bf16_t* base = isv ? VT : ZHT;
#pragma unroll
        for (int ai = 0; ai < 2; ++ai) {
            float s[2][8], q[2][8];
#pragma unroll
            for (int bj = 0; bj < 2; ++bj)
#pragma unroll
                for (int e = 0; e < 8; ++e) { s[bj][e] = 0.f; q[bj][e] = 0.f; }
#pragma unroll
            for (int m = 0; m < 4; ++m) {
                const int row = rowt + ai * HALF + m * 16; const float bb = slot[wr * 64 + fr + ai * HALF + m * 16];
                bf16_t* rowp = base + (size_t)row * MTOK + col0;
#pragma unroll
                for (int bj = 0; bj < 2; ++bj) {
                    f32x4 v0 = acc[ai][bj][m][0] + bb, v1 = acc[ai][bj][m][1] + bb;
                    if (isv) {
                        f32x2 a = gelu_pk((f32x2){v0[0], v0[1]}), b = gelu_pk((f32x2){v0[2], v0[3]}), c = gelu_pk((f32x2){v1[0], v1[1]}), d = gelu_pk((f32x2){v1[2], v1[3]});
                        v0 = (f32x4){a.x, a.y, b.x, b.y}; v1 = (f32x4){c.x, c.y, d.x, d.y};
                    }
                    u32x4 w; w.x = cvt_pk_bf16(v0[0], v0[1]); w.y = cvt_pk_bf16(v0[2], v0[3]); w.z = cvt_pk_bf16(v1[0], v1[1]); w.w = cvt_pk_bf16(v1[2], v1[3]);
                    *(u32x4*)(rowp + bj * 32) = w;
                    if (isv) {
                        const float e0 = bf_lo(w.x), e1 = bf_hi(w.x), e2 = bf_lo(w.y), e3 = bf_hi(w.y), e4 = bf_lo(w.z), e5 = bf_hi(w.z), e6 = bf_lo(w.w), e7 = bf_hi(w.w);
                        s[bj][0] += e0; s[bj][1] += e1; s[bj][2] += e2; s[bj][3] += e3; s[bj][4] += e4; s[bj][5] += e5; s[bj][6] += e6; s[bj][7] += e7;
                        q[bj][0] += e0 * e0; q[bj][1] += e1 * e1; q[bj][2] += e2 * e2; q[bj][3] += e3 * e3; q[bj][4] += e4 * e4; q[bj][5] += e5 * e5; q[bj][6] += e6 * e6; q[bj][7] += e7 * e7;
                    }
                }
            }
            if (isv) {
                const int slot = u.pm * 4 + ai * 2 + wr;
#pragma unroll
                for (int bj = 0; bj < 2; ++bj)
#pragma unroll
                    for (int e = 0; e < 8; ++e) {
                        float a = s[bj][e], b = q[bj][e];
                        a += __shfl_xor(a, 1); b += __shfl_xor(b, 1); a += __shfl_xor(a, 2); b += __shfl_xor(b, 2);
                        a += __shfl_xor(a, 4); b += __shfl_xor(b, 4); a += __shfl_xor(a, 8); b += __shfl_xor(b, 8);
                        if (fr == 0) *(f32x2*)(statsV + ((size_t)(col0 + bj * 32 + e) * 16 + slot) * 2) = (f32x2){a, b};
                    }
            }
        }
    }
};

struct EpiG2 {
    static constexpr bool PERM = true, AFTER_DRAIN = false, MID = true;
    const bf16_t* G; bf16_t* O; static constexpr int SLOT_FLOATS = 0;
    __device__ __forceinline__ void preload(PG8_LAS float*, const Unit&, int) const {}
    __device__ __forceinline__ void mid(f32x4 (&acc)[2][2][4][2], const Unit& u, int wr, int wc, int fr, int fq) const {
        int row0 = u.pm * BM + wr * 64 + fr, col0 = u.pn * BM + wc * 64 + 8 * fq;
        asm volatile("" : "+v"(row0), "+v"(col0));
#pragma unroll
        for (int ai = 0; ai < 2; ++ai)
#pragma unroll
            for (int m = 0; m < 4; ++m) {
                const bf16_t* gp = G + (size_t)(row0 + ai * HALF + m * 16) * (2 * DM) + col0;
#pragma unroll
                for (int bj = 0; bj < 2; ++bj) {
                    const u32x4 ga = *(const u32x4*)(gp + bj * 32), gb = *(const u32x4*)(gp + DM + bj * 32);
                    f32x4 r0, r1;
                    r0[0] = bf_lo(ga.x) * __builtin_amdgcn_rcpf(bf_lo(gb.x)); r0[1] = bf_hi(ga.x) * __builtin_amdgcn_rcpf(bf_hi(gb.x));
                    r0[2] = bf_lo(ga.y) * __builtin_amdgcn_rcpf(bf_lo(gb.y)); r0[3] = bf_hi(ga.y) * __builtin_amdgcn_rcpf(bf_hi(gb.y));
                    r1[0] = bf_lo(ga.z) * __builtin_amdgcn_rcpf(bf_lo(gb.z)); r1[1] = bf_hi(ga.z) * __builtin_amdgcn_rcpf(bf_hi(gb.z));
                    r1[2] = bf_lo(ga.w) * __builtin_amdgcn_rcpf(bf_lo(gb.w)); r1[3] = bf_hi(ga.w) * __builtin_amdgcn_rcpf(bf_hi(gb.w));
                    acc[ai][bj][m][0] *= r0; acc[ai][bj][m][1] *= r1;
                }
            }
    }
    __device__ __forceinline__ void operator()(const f32x4 (&acc)[2][2][4][2], const Unit& u, int wr, int wc, int fr, int fq, const PG8_LAS float*) const {
        const int row0 = u.pm * BM + wr * 64 + fr, col0 = u.pn * BM + wc * 64 + 8 * fq;
#pragma unroll
        for (int ai = 0; ai < 2; ++ai)
#pragma unroll
            for (int m = 0; m < 4; ++m) {
                const int row = row0 + ai * HALF + m * 16;
                const bf16_t* gp = G + (size_t)row * (2 * DM) + DM + col0;
                bf16_t* op = O + (size_t)row * DM + col0;
#pragma unroll
                for (int bj = 0; bj < 2; ++bj) {
                    const u32x4 gb = *(const u32x4*)(gp + bj * 32);
                    const f32x4 a0 = acc[ai][bj][m][0], a1 = acc[ai][bj][m][1];
                    u32x4 w; w.x = cvt_pk_bf16(a0[0] * bf_lo(gb.x), a0[1] * bf_hi(gb.x)); w.y = cvt_pk_bf16(a0[2] * bf_lo(gb.y), a0[3] * bf_hi(gb.y));
                    w.z = cvt_pk_bf16(a1[0] * bf_lo(gb.z), a1[1] * bf_hi(gb.z)); w.w = cvt_pk_bf16(a1[2] * bf_lo(gb.w), a1[3] * bf_hi(gb.w));
                    *(u32x4*)(op + bj * 32) = w;
                }
            }
    }
};

typedef _Float16 f16x4 __attribute__((ext_vector_type(4)));
__device__ __forceinline__ f16x4 to_f16x4(f32x4 v) { return (f16x4){(_Float16)v[0], (_Float16)v[1], (_Float16)v[2], (_Float16)v[3]}; }
__device__ __forceinline__ f32x4 from_f16x4(f16x4 v) { return (f32x4){(float)v[0], (float)v[1], (float)v[2], (float)v[3]}; }
template <bool FIRST> struct EpiRes {
    static constexpr bool PERM = false, AFTER_DRAIN = false, MID = false; static constexpr int SLOT_FLOATS = FIRST ? 512 : 1024;
    const float* X;
    const _Float16* R16;
    _Float16* O16;
    const float* gate;
    const float* bias;
    const float* lng; const float* lnb; const float* MU;
    float* stats;
    __device__ __forceinline__ void mid(f32x4 (&)[2][2][4][2], const Unit&, int, int, int, int) const {}
    __device__ __forceinline__ void preload(PG8_LAS float* slot, const Unit& u, int tid) const {
        const int c = tid & 255, col = u.pn * BM + c;
        if (tid < 256) slot[c] = gate[(size_t)(u.pm >> 3) * MODW + col]; else slot[256 + c] = bias[col];
        if (!FIRST) { if (tid < 256) slot[512 + c] = DN_ALPHA * lng[col]; else slot[768 + c] = DN_ALPHA * lnb[col]; }
    }
    __device__ __forceinline__ void operator()(const f32x4 (&acc)[2][2][4][2], const Unit& u, int wr, int wc, int fr, int fq, const PG8_LAS float* slot) const {
        int row0 = u.pm * BM + wr * 64 + fr; const int cl = wc * 32 + 4 * fq; int col0 = u.pn * BM + cl;
        asm volatile("" : "+v"(row0), "+v"(col0));
        constexpr int RB = FIRST ? 2 : 1;
#pragma unroll
        for (int ab = 0; ab < 8 / RB; ++ab) {
            const int ai = (ab * RB) >> 2, mb = (ab * RB) & 3;
            f32x4 base[RB][2][2]; f16x4 b16[RB][2][2]; f32x2 mr[RB];
            int rowb = row0 + ai * HALF + mb * 16; asm volatile("" : "+v"(rowb));
#pragma unroll
            for (int mm = 0; mm < RB; ++mm) {
                const size_t off = (size_t)(rowb + mm * 16) * DM + col0;
                if (!FIRST) mr[mm] = *(const f32x2*)(MU + (size_t)(rowb + mm * 16) * 2);
#pragma unroll
                for (int bj = 0; bj < 2; ++bj)
#pragma unroll
                    for (int n = 0; n < 2; ++n) { if (FIRST) base[mm][bj][n] = *(const f32x4*)(X + off + bj * HALF + n * 16); else b16[mm][bj][n] = *(const f16x4*)(R16 + off + bj * HALF + n * 16); }
            }
#pragma unroll
            for (int mm = 0; mm < RB; ++mm) {
                const int m = mb + mm;
                const int row = rowb + mm * 16; _Float16* rp = O16 + (size_t)row * DM + col0;
                float s = 0.f, q = 0.f;
#pragma unroll
                for (int bj = 0; bj < 2; ++bj)
#pragma unroll
                    for (int n = 0; n < 2; ++n) {
                        const int co = bj * HALF + n * 16;
                        const f32x4 gv = *(const PG8_LAS f32x4*)(slot + cl + co), bv = *(const PG8_LAS f32x4*)(slot + 256 + cl + co);
                        f32x4 bs;
                        if (FIRST) bs = base[mm][bj][n] * DN_ALPHA;
                        else bs = (from_f16x4(b16[mm][bj][n]) - mr[mm].x) * mr[mm].y * *(const PG8_LAS f32x4*)(slot + 512 + cl + co) + *(const PG8_LAS f32x4*)(slot + 768 + cl + co);
                        const f16x4 oh = to_f16x4(bs + gv * (acc[ai][bj][m][n] + bv));
                        *(f16x4*)(rp + co) = oh;
                        const f32x4 o = from_f16x4(oh);
                        s += (o[0] + o[1]) + (o[2] + o[3]); q += (o[0] * o[0] + o[1] * o[1]) + (o[2] * o[2] + o[3] * o[3]);
                    }
                s += __shfl_xor(s, 16); s += __shfl_xor(s, 32); q += __shfl_xor(q, 16); q += __shfl_xor(q, 32);
                if (fq == 0) *(f32x2*)(stats + ((size_t)row * 32 + u.pn * 4 + wc) * 2) = (f32x2){s, q};
            }
            asm volatile("" ::: "memory");
        }
    }
};

struct EpiG4 {
    static constexpr bool PERM = true, AFTER_DRAIN = false, MID = false; static constexpr int SLOT_FLOATS = 256;
    bf16_t* O; const float* bias;
    __device__ __forceinline__ void mid(f32x4 (&)[2][2][4][2], const Unit&, int, int, int, int) const {}
    __device__ __forceinline__ void preload(PG8_LAS float* slot, const Unit& u, int tid) const { if (tid < 256) slot[tid] = bias[u.pn * BM + tid]; }
    __device__ __forceinline__ void operator()(const f32x4 (&acc)[2][2][4][2], const Unit& u, int wr, int wc, int fr, int fq, const PG8_LAS float* slot) const {
        const int row0 = u.pm * BM + wr * 64 + fr, cl = wc * 64 + 8 * fq, col0 = u.pn * BM + cl;
        f32x4 bv[2][2];
#pragma unroll
        for (int bj = 0; bj < 2; ++bj)
#pragma unroll
            for (int n = 0; n < 2; ++n) bv[bj][n] = *(const PG8_LAS f32x4*)(slot + cl + bj * 32 + 4 * n);
#pragma unroll
        for (int ai = 0; ai < 2; ++ai)
#pragma unroll
            for (int m = 0; m < 4; ++m) {
                bf16_t* rowp = O + (size_t)(row0 + ai * HALF + m * 16) * DFF + col0;
#pragma unroll
                for (int bj = 0; bj < 2; ++bj) {
                    f32x4 v0 = acc[ai][bj][m][0] + bv[bj][0], v1 = acc[ai][bj][m][1] + bv[bj][1];
                    v0 = __builtin_elementwise_max(v0, (f32x4){0.f, 0.f, 0.f, 0.f}); v1 = __builtin_elementwise_max(v1, (f32x4){0.f, 0.f, 0.f, 0.f});
                    v0 = v0 * v0; v1 = v1 * v1;
                    u32x4 w; w.x = cvt_pk_bf16(v0[0], v0[1]); w.y = cvt_pk_bf16(v0[2], v0[3]); w.z = cvt_pk_bf16(v1[0], v1[1]); w.w = cvt_pk_bf16(v1[2], v1[3]);
                    *(u32x4*)(rowp + bj * 32) = w;
                }
            }
    }
};
}
namespace pg8 {
template <class Epi, class Sched, bool ALIGN_EPI = false, bool SP2 = false>
__device__ __forceinline__ void gemm_phase(PG8_LAS unsigned char* lds, const Gemm g, const Sched& S, const Epi& E) {
    const int tid = threadIdx.x, wid = __builtin_amdgcn_readfirstlane(tid >> 6), lane = tid & 63, wr = wid >> 2, wc = wid & 3, fr = lane & 15, fq = lane >> 4;
    const int K = g.K, nt = K / BK;
    unsigned voffA[2], voffB[2];
#pragma unroll
    for (int i = 0; i < 2; ++i) { int R, C; stage_rc(tid * 16 + i * 8192, R, C); const int Rb = Epi::PERM ? ((R & ~31) + perm32(R & 31)) : R;
        const int Rw = Epi::PERM ? ((R >> 5) * 64 + perm32(R & 31)) : R;
        voffA[i] = (unsigned)(R * K + C) * 2u; voffB[i] = (unsigned)(Rw * K + C) * 2u; (void)Rb; }
    const size_t kstep = (size_t)(BK * 2);
    const size_t hstep = (size_t)HALF * K * 2;
    const size_t tstep = 2 * hstep;
    const size_t hstepB = Epi::PERM ? (size_t)32 * K * 2 : hstep;
    const unsigned ldsw = (unsigned)wid * 1024u;
    const int aoff = lds_byte(wr * 64 + fr, fq * 8), boff = lds_byte(wc * 32 + fr, fq * 8);
#define PG8_SA(b, h) (((b) * 2 + (h)) * HTB)
#define PG8_SB(b, h) ((4 + (b) * 2 + (h)) * HTB)
#define PG8_STAGE(bufoff, gbase, voff) do { _Pragma("unroll") for (int _i = 0; _i < 2; ++_i) \
        __builtin_amdgcn_global_load_lds((const unsigned*)((const char*)(gbase) + (voff)[_i]), (PG8_LAS unsigned*)(lds + (bufoff) + ldsw + _i * 8192), 16, 0, 0); } while (0)
#define PG8_LDA(dst, b, h) do { _Pragma("unroll") for (int m = 0; m < 4; ++m) _Pragma("unroll") for (int k = 0; k < 2; ++k) dst[m][k] = *(const PG8_LAS bf16x8*)(lds + PG8_SA(b, h) + aoff + m * 2048 + k * 1024); } while (0)
#define PG8_LDB(dst, b, h) do { _Pragma("unroll") for (int n = 0; n < 2; ++n) _Pragma("unroll") for (int k = 0; k < 2; ++k) dst[n][k] = *(const PG8_LAS bf16x8*)(lds + PG8_SB(b, h) + boff + n * 2048 + k * 1024); } while (0)
#define PG8_MMA(ai, bj, At, Bt) do { __builtin_amdgcn_s_setprio(1); _Pragma("unroll") for (int m = 0; m < 4; ++m) _Pragma("unroll") for (int n = 0; n < 2; ++n) _Pragma("unroll") for (int k = 0; k < 2; ++k) \
        acc[ai][bj][m][n] = __builtin_amdgcn_mfma_f32_16x16x32_bf16(Bt[n][k], At[m][k], acc[ai][bj][m][n], 0, 0, 0); __builtin_amdgcn_s_setprio(0); } while (0)
#define PG8_WAIT_V(n) asm volatile("s_waitcnt vmcnt(" #n ")" ::: "memory")
#define PG8_WAIT_L(n) asm volatile("s_waitcnt lgkmcnt(" #n ")" ::: "memory")
#define PG8_BAR __builtin_amdgcn_s_barrier()
#define PG8_SCHED __builtin_amdgcn_sched_barrier(0)
    Unit cur, nxt; int ui = 0;
    if (!S.next(0, cur)) return;
    {
        Unit pu; for (int i = 0; S.next(i, pu); ++i) E.preload((PG8_LAS float*)(lds + EPI_LDS_OFF) + i * Epi::SLOT_FLOATS, pu, tid);
        asm volatile("s_waitcnt vmcnt(0) lgkmcnt(0)" ::: "memory"); __builtin_amdgcn_s_barrier(); asm volatile("" ::: "memory");
    }
    f32x4 acc[2][2][4][2];
#pragma unroll
    for (int a = 0; a < 2; ++a)
#pragma unroll
        for (int b = 0; b < 2; ++b)
#pragma unroll
            for (int m = 0; m < 4; ++m)
#pragma unroll
                for (int n = 0; n < 2; ++n) acc[a][b][m][n] = (f32x4){0.f, 0.f, 0.f, 0.f};
    bf16x8 At[4][2], B0[2][2], B1[2][2];
    const char* cA = (const char*)g.A + (size_t)cur.pm * tstep; const char* cB = (const char*)g.Bt + (size_t)cur.pn * tstep;
    S.a_ready(cur);
    if constexpr (SP2) {
        PG8_STAGE(PG8_SB(0, 0), cB, voffB); PG8_STAGE(PG8_SB(0, 1), cB + hstepB, voffB); PG8_STAGE(PG8_SA(0, 0), cA, voffA); PG8_STAGE(PG8_SA(0, 1), cA + hstep, voffA);
        if (wr == 1) PG8_BAR;
        PG8_WAIT_V(2); PG8_BAR;
        PG8_STAGE(PG8_SB(1, 0), cB + kstep, voffB); PG8_STAGE(PG8_SA(1, 0), cA + kstep, voffA); PG8_STAGE(PG8_SB(1, 1), cB + hstepB + kstep, voffB);
        PG8_WAIT_V(6); PG8_BAR;
    } else {
        PG8_STAGE(PG8_SB(0, 0), cB, voffB); PG8_STAGE(PG8_SA(0, 0), cA, voffA); PG8_STAGE(PG8_SB(0, 1), cB + hstepB, voffB); PG8_STAGE(PG8_SA(0, 1), cA + hstep, voffA);
        if (wr == 1) PG8_BAR;
        PG8_WAIT_V(4); PG8_BAR;
        PG8_STAGE(PG8_SB(1, 0), cB + kstep, voffB); PG8_STAGE(PG8_SA(1, 0), cA + kstep, voffA); PG8_STAGE(PG8_SB(1, 1), cB + hstepB + kstep, voffB);
        PG8_WAIT_V(6); PG8_BAR;
    }
    for (;;) {
        const bool has_next = S.next(ui + 1, nxt);
        const char* nA = has_next ? (const char*)g.A + (size_t)nxt.pm * tstep : cA; const char* nB = has_next ? (const char*)g.Bt + (size_t)nxt.pn * tstep : cB;
        for (int t = 0; t < nt; t += 2) {
            const bool last = (t == nt - 2);
            const char* a1 = cA + (size_t)(t + 1) * kstep;
            const char* a2 = last ? nA : cA + (size_t)(t + 2) * kstep; const char* b2 = last ? nB : cB + (size_t)(t + 2) * kstep;
            const char* a3 = a2 + kstep; const char* b3 = b2 + kstep;
            if (last && has_next) S.a_ready(nxt);
            if constexpr (Epi::MID) { if (t == (nt >> 1)) E.mid(acc, cur, wr, wc, fr, fq); }
            if constexpr (SP2) {
            PG8_LDB(B0, 0, 0); PG8_LDB(B1, 0, 1); PG8_SCHED; PG8_LDA(At, 0, 0); PG8_STAGE(PG8_SA(1, 1), a1 + hstep, voffA);
            PG8_WAIT_V(8); PG8_WAIT_L(0); PG8_BAR; PG8_MMA(0, 0, At, B0); PG8_MMA(0, 1, At, B1); PG8_BAR; PG8_SCHED;
            PG8_LDA(At, 0, 1); PG8_STAGE(PG8_SB(0, 0), b2, voffB); PG8_STAGE(PG8_SB(0, 1), b2 + hstepB, voffB); PG8_STAGE(PG8_SA(0, 0), a2, voffA);
            PG8_WAIT_V(8); PG8_WAIT_L(0); PG8_BAR; PG8_MMA(1, 0, At, B0); PG8_MMA(1, 1, At, B1); PG8_BAR; PG8_SCHED;
            PG8_LDB(B0, 1, 0); PG8_LDB(B1, 1, 1); PG8_SCHED; PG8_LDA(At, 1, 0); PG8_STAGE(PG8_SA(0, 1), a2 + hstep, voffA);
            PG8_WAIT_V(8); PG8_WAIT_L(0); PG8_BAR; PG8_MMA(0, 0, At, B0); PG8_MMA(0, 1, At, B1); PG8_BAR; PG8_SCHED;
            PG8_LDA(At, 1, 1); PG8_STAGE(PG8_SB(1, 0), b3, voffB); PG8_STAGE(PG8_SB(1, 1), b3 + hstepB, voffB); PG8_STAGE(PG8_SA(1, 0), a3, voffA);
            PG8_WAIT_V(8); PG8_WAIT_L(0); PG8_BAR; PG8_MMA(1, 0, At, B0); PG8_MMA(1, 1, At, B1); PG8_BAR; PG8_SCHED;
            } else {
            PG8_LDB(B0, 0, 0); PG8_SCHED; PG8_LDA(At, 0, 0); PG8_STAGE(PG8_SA(1, 1), a1 + hstep, voffA);
            PG8_WAIT_L(8); PG8_BAR; PG8_WAIT_L(0); PG8_MMA(0, 0, At, B0); PG8_BAR; PG8_SCHED;
            PG8_LDB(B1, 0, 1); PG8_STAGE(PG8_SB(0, 0), b2, voffB);
            PG8_BAR; PG8_WAIT_L(0); PG8_MMA(0, 1, At, B1); PG8_BAR;
            PG8_LDA(At, 0, 1); PG8_STAGE(PG8_SA(0, 0), a2, voffA);
            PG8_BAR; PG8_WAIT_L(0); PG8_MMA(1, 0, At, B0); PG8_BAR; PG8_SCHED;
            PG8_STAGE(PG8_SB(0, 1), b2 + hstepB, voffB);
            PG8_WAIT_V(6); PG8_BAR; PG8_MMA(1, 1, At, B1); PG8_BAR;
            PG8_LDB(B0, 1, 0); PG8_SCHED; PG8_LDA(At, 1, 0); PG8_STAGE(PG8_SA(0, 1), a2 + hstep, voffA);
            PG8_WAIT_L(8); PG8_BAR; PG8_WAIT_L(0); PG8_MMA(0, 0, At, B0); PG8_BAR; PG8_SCHED;
            PG8_LDB(B1, 1, 1); PG8_STAGE(PG8_SB(1, 0), b3, voffB);
            PG8_BAR; PG8_WAIT_L(0); PG8_MMA(0, 1, At, B1); PG8_BAR;
            PG8_LDA(At, 1, 1); PG8_STAGE(PG8_SA(1, 0), a3, voffA);
            PG8_BAR; PG8_WAIT_L(0); PG8_MMA(1, 0, At, B0); PG8_BAR; PG8_SCHED;
            PG8_STAGE(PG8_SB(1, 1), b3 + hstepB, voffB);
            PG8_WAIT_V(6); PG8_BAR; PG8_MMA(1, 1, At, B1); PG8_BAR;
            }
        }
        if constexpr (ALIGN_EPI) { if (wr == 0) PG8_BAR; }
        if constexpr (!Epi::AFTER_DRAIN) { E(acc, cur, wr, wc, fr, fq, (const PG8_LAS float*)(lds + EPI_LDS_OFF) + ui * Epi::SLOT_FLOATS); S.done(cur); }
        if (!has_next) break;
#pragma unroll
        for (int a = 0; a < 2; ++a)
#pragma unroll
            for (int b = 0; b < 2; ++b)
#pragma unroll
                for (int m = 0; m < 4; ++m)
#pragma unroll
                    for (int n = 0; n < 2; ++n) acc[a][b][m][n] = (f32x4){0.f, 0.f, 0.f, 0.f};
        cur = nxt; cA = nA; cB = nB; ++ui;
        if constexpr (ALIGN_EPI) { if (wr == 1) PG8_BAR; }
    }
    PG8_WAIT_V(0);
    if constexpr (!ALIGN_EPI) { if (wr == 0) PG8_BAR; }
    PG8_BAR;
    if constexpr (Epi::AFTER_DRAIN) { E.fused(acc, cur, wr, wc, fr, fq, lds, wid, lane); S.done(cur); }
#undef PG8_SA
#undef PG8_SB
#undef PG8_STAGE
#undef PG8_LDA
#undef PG8_LDB
#undef PG8_MMA
#undef PG8_WAIT_V
#undef PG8_WAIT_L
#undef PG8_BAR
#undef PG8_SCHED
}
}

constexpr size_t MiB = 1u << 20;
constexpr size_t WS_CTL = 0;
constexpr size_t WS_MOD = 1 * MiB;
constexpr size_t WS_STV = 2 * MiB;
constexpr size_t WS_ST1 = 4 * MiB;
constexpr size_t WS_ST2 = 8 * MiB;
constexpr size_t WS_MU1 = 12 * MiB;
constexpr size_t WS_HID2 = 14 * MiB;
constexpr size_t WS_SGW = 13 * MiB;
constexpr size_t WS_WIN = 16 * MiB;
constexpr size_t WS_WAB = 52 * MiB;
constexpr size_t WS_WO = 60 * MiB;
constexpr size_t WS_FILT = 68 * MiB;
constexpr size_t WS_WM2 = 68 * MiB;
constexpr size_t WS_H = 100 * MiB;
constexpr size_t WS_U = 164 * MiB;
constexpr size_t WS_V = 196 * MiB;
constexpr size_t WS_MERGED = 164 * MiB;
constexpr size_t WS_ZHT = 228 * MiB;
constexpr size_t WS_G = 324 * MiB;
constexpr size_t WS_AFF = 164 * MiB;
constexpr size_t WS_WM1 = 420 * MiB;
constexpr size_t WS_YT = 452 * MiB;
constexpr size_t WS_END = 484 * MiB;

constexpr int NWAVES = 8;
constexpr int LDS_BYTES = 163840;

#define GAS __attribute__((address_space(1)))
#define LAS __attribute__((address_space(3)))
typedef unsigned short bf16;
typedef unsigned v4u __attribute__((ext_vector_type(4)));
typedef unsigned v2u __attribute__((ext_vector_type(2)));
typedef float f32x4 __attribute__((ext_vector_type(4)));
typedef float f32x2 __attribute__((ext_vector_type(2)));
#define LDS_WAIT() asm volatile("s_waitcnt lgkmcnt(0)" ::: "memory")

__device__ __forceinline__ unsigned f2bf(float f) { unsigned u = __builtin_bit_cast(unsigned, f); return (u + 0x7fffu + ((u >> 16) & 1u)) >> 16; }
__device__ __forceinline__ unsigned pk2(float lo, float hi) { return f2bf(lo) | (f2bf(hi) << 16); }
__device__ __forceinline__ float bflo(unsigned w) { return __uint_as_float(w << 16); }
__device__ __forceinline__ float bfhi(unsigned w) { return __uint_as_float(w & 0xffff0000u); }
__device__ __forceinline__ float bf1(bf16 h) { return __uint_as_float((unsigned)h << 16); }
__device__ __forceinline__ float wave_sum(float v) {
#pragma unroll
    for (int o = 1; o < 64; o <<= 1) v += __shfl_xor(v, o);
    return v;
}

struct Args { const float* in[31]; float* out; unsigned char* ws; int ph_lo, ph_hi; };

struct Frame {
    LAS unsigned char* lds;
    int tid, lane, wave, G;
    const float* const* in; float* out; unsigned char* ws;
};
enum { I_X = 0, I_C, I_WADA, I_BADA, I_WIN, I_BIN, I_SLNG, I_SLNB, I_SW, I_SB, I_HCW, I_HCB, I_HW1, I_HB1, I_HW2, I_HB2, I_HFREQ, I_HW3, I_HSKIP,
       I_WA, I_WB, I_WO, I_BO, I_LN1G, I_LN1B, I_WM1, I_BM1, I_WM2, I_BM2, I_LN2G, I_LN2B };

__device__ __forceinline__ void transpose_matrix(Frame& F, const float* W, int K, int N, bf16* WT, int ldk, int koff, int remap_win, int first, int nblocks) {
    LAS float* tile = (LAS float*)F.lds;
    const int tid = F.tid, nblk = N / 256, nitems = (K / 64) * nblk;
    const int lr = tid >> 6, lc = tid & 63;
    const int wc = tid & 7, wn = tid >> 3;
    for (int it = first; it < nitems; it += nblocks) {
        const int kb = it / nblk, nb = it % nblk, n0 = nb * 256, k0 = kb * 64; int row0 = n0;
        if (remap_win) row0 = (n0 < 1024) ? n0 : (n0 < 2048 ? n0 - 1024 + 5120 : (n0 < 5120 ? n0 - 2048 + 6144 : n0 - 5120 + 1024));
        f32x4 v[8];
#pragma unroll
        for (int i = 0; i < 8; ++i) v[i] = *(const f32x4*)(W + (size_t)(k0 + 8 * i + lr) * N + n0 + 4 * lc);
#pragma unroll
        for (int i = 0; i < 8; ++i) *(LAS f32x4*)(tile + (8 * i + lr) * 256 + ((lc ^ i) << 2)) = v[i];
        __syncthreads();
#pragma unroll
        for (int j = 0; j < 4; ++j) { const int n = wn + 64 * j; const LAS float* sp = tile + (8 * wc) * 256 + ((((n >> 2) ^ wc) << 2) | (n & 3));
            v4u o; o.x = pk2(sp[0 * 256], sp[1 * 256]); o.y = pk2(sp[2 * 256], sp[3 * 256]); o.z = pk2(sp[4 * 256], sp[5 * 256]); o.w = pk2(sp[6 * 256], sp[7 * 256]);
            *(GAS v4u*)(WT + (size_t)(row0 + n) * ldk + koff + k0 + 8 * wc) = o; }
        __syncthreads();
    }
}

__device__ __forceinline__ void p0_mod(Frame& F) {
    LAS float* condS = (LAS float*)F.lds;
    LAS float* red = (LAS float*)(F.lds + 65536);
    const float* c = F.in[I_C]; const float* w_ada = F.in[I_WADA]; const float* b_ada = F.in[I_BADA];
    float* mod = (float*)(F.ws + WS_MOD);
    const int tid = F.tid;
    for (int item = blockIdx.x; item < MODW / 48; item += F.G) {
        for (int i = tid; i < NBATCH * DM; i += NWAVES * 64) { const float v = c[i]; condS[i] = v / (1.0f + __expf(-v)); }
        __syncthreads();
        const int cq = tid % 12, kq = tid / 12, col0 = item * 48;
        if (kq < 32) {
            f32x4 acc[8];
#pragma unroll
            for (int b = 0; b < 8; ++b) acc[b] = (f32x4){0.f, 0.f, 0.f, 0.f};
            const float* wp = w_ada + (size_t)kq * MODW + col0 + cq * 4;
            for (int k = kq; k < DM; k += 256, wp += (size_t)256 * MODW) {
                f32x4 w[8];
#pragma unroll
                for (int u = 0; u < 8; ++u) w[u] = *(const f32x4*)(wp + (size_t)(32 * u) * MODW);
#pragma unroll
                for (int u = 0; u < 8; ++u)
#pragma unroll
                    for (int b = 0; b < 8; ++b) acc[b] += w[u] * condS[b * DM + k + 32 * u];
            }
#pragma unroll
            for (int b = 0; b < 8; ++b) *(LAS f32x4*)(red + (kq * 8 + b) * 48 + cq * 4) = acc[b];
        }
        __syncthreads();
        if (tid < 384) { const int b = tid / 48, col = tid % 48; float s = 0.f;
#pragma unroll 8
          for (int k2 = 0; k2 < 32; ++k2) s += red[(k2 * 8 + b) * 48 + col];
          mod[(size_t)b * MODW + col0 + col] = s + b_ada[col0 + col]; }
        __syncthreads();
    }
}

__device__ __forceinline__ void p0_hid2(Frame& F) {
    LAS float* scr = (LAS float*)F.lds + F.wave * 128;
    const float* w1 = F.in[I_HW1]; const float* b1 = F.in[I_HB1]; const float* w2 = F.in[I_HW2]; const float* b2 = F.in[I_HB2]; const float* freq = F.in[I_HFREQ];
    float* HID2 = (float*)(F.ws + WS_HID2);
    const int lane = F.lane;
    for (int l = blockIdx.x * NWAVES + F.wave; l < SEQ; l += F.G * NWAVES) {
        const float fr = freq[lane];
        const float tl = (float)l / (float)(SEQ - 1), omega = 6.283185307179586f * (float)l / (float)SEQ;
        float f = 0.f;
        if (lane == 0) f = tl;
        else if (lane <= 16) { const float band = 1e-4f + (float)(lane - 1) * ((15.0f - 1e-4f) / 15.0f); f = cosf(band * omega); }
        else if (lane <= 32) { const float band = 1e-4f + (float)(lane - 17) * ((15.0f - 1e-4f) / 15.0f); f = -sinf(band * omega); }
        scr[lane] = f; LDS_WAIT(); asm volatile("" ::: "memory");
        float a = b1[lane];
#pragma unroll 11
        for (int i = 0; i < 33; ++i) a += scr[i] * w1[i * 64 + lane];
        scr[64 + lane] = sinf(fr * a); LDS_WAIT(); asm volatile("" ::: "memory");
        a = b2[lane];
#pragma unroll 16
        for (int i = 0; i < 64; ++i) a += scr[64 + i] * w2[i * 64 + lane];
        HID2[(size_t)l * 64 + lane] = sinf(fr * a);
        LDS_WAIT(); asm volatile("" ::: "memory");
    }
}
typedef float fl_f32x16 __attribute__((ext_vector_type(16)));
__device__ __forceinline__ void p1_filter_waves(Frame& F) {
    const int fwl = F.wave - 4;
    LAS float* hS = (LAS float*)F.lds + fwl * (32 * 65);
    const float* w3 = F.in[I_HW3]; const float* HID2 = (const float*)(F.ws + WS_HID2);
    float* FILT = (float*)(F.ws + WS_FILT);
    const int lane = F.lane, r = lane & 31, h = lane >> 5;
    const float min_decay = -3.0701134573253943f, max_decay = -15.350567286626972f;
    for (int item = blockIdx.x * 4 + fwl; item < 1024; item += F.G * 4) {
        const int pb = item >> 4, cb = item & 15, pos0 = pb * 32, col0 = cb * 256;
        {
#pragma unroll
            for (int u = 0; u < 8; ++u) { const int e = (u * 64 + lane) * 4, p = e >> 6, k = e & 63; const f32x4 v = *(const f32x4*)(HID2 + (size_t)(pos0 + p) * 64 + k);
                hS[p * 65 + k] = v[0]; hS[p * 65 + k + 1] = v[1]; hS[p * 65 + k + 2] = v[2]; hS[p * 65 + k + 3] = v[3]; }
            LDS_WAIT(); asm volatile("" ::: "memory");
        }
        fl_f32x16 acc[8];
#pragma unroll
        for (int t = 0; t < 8; ++t)
#pragma unroll
            for (int e = 0; e < 16; ++e) acc[t][e] = 0.f;
        const float* wp = w3 + (size_t)h * 4096 + col0 + r;
#pragma unroll 2
        for (int s2 = 0; s2 < 32; ++s2) {
            const float a = hS[r * 65 + 2 * s2 + h];
            float b[8];
#pragma unroll
            for (int t = 0; t < 8; ++t) b[t] = wp[(size_t)(2 * s2) * 4096 + t * 32];
#pragma unroll
            for (int t = 0; t < 8; ++t) acc[t] = __builtin_amdgcn_mfma_f32_32x32x2f32(a, b[t], acc[t], 0, 0, 0);
        }
#pragma unroll
        for (int t = 0; t < 8; ++t) {
            const int j = col0 + t * 32 + r, ch = j & 1023; const float delta = fabsf(min_decay + (float)ch * ((max_decay - min_decay) / 1023.0f));
            float* op = FILT + (size_t)j * SEQ + pos0 + 4 * h;
#pragma unroll
            for (int g = 0; g < 4; ++g) {
                f32x4 o;
#pragma unroll
                for (int e = 0; e < 4; ++e) { const float tp = (float)(pos0 + 8 * g + 4 * h + e) / (float)(SEQ - 1); o[e] = acc[t][4 * g + e] * __expf(-tp * delta); }
                *(f32x4*)(op + 8 * g) = o;
            }
        }
        LDS_WAIT(); asm volatile("" ::: "memory");
    }
}

__device__ __forceinline__ void p1_modulate(Frame& F) {
    const float* x = F.in[I_X]; const float* mod = (const float*)(F.ws + WS_MOD); bf16* H = (bf16*)(F.ws + WS_H);
    const int vcu = (F.G == 256) ? (int)((blockIdx.x & 7) * 32 + (blockIdx.x >> 3)) : (int)blockIdx.x, rpb = MTOK / F.G;
    const int col = F.tid * 8;
    for (int r0 = vcu * rpb; r0 < vcu * rpb + rpb; r0 += 4) {
        f32x4 xa[4], xb[4];
#pragma unroll
        for (int u = 0; u < 4; ++u) { const float* xp = x + (size_t)(r0 + u) * DM + col; xa[u] = *(const f32x4*)xp; xb[u] = *(const f32x4*)(xp + 4); }
        const int b = r0 >> 11; const float* mp = mod + (size_t)b * MODW + col;
        const f32x4 sh0 = *(const f32x4*)mp, sh1 = *(const f32x4*)(mp + 4), sc0 = *(const f32x4*)(mp + DM), sc1 = *(const f32x4*)(mp + DM + 4);
#pragma unroll
        for (int u = 0; u < 4; ++u) {
            const f32x4 h0 = xa[u] * (sc0 + 1.0f) + sh0, h1 = xb[u] * (sc1 + 1.0f) + sh1;
            v4u o; o.x = pk2(h0[0], h0[1]); o.y = pk2(h0[2], h0[3]); o.z = pk2(h1[0], h1[1]); o.w = pk2(h1[2], h1[3]);
            *(v4u*)(H + (size_t)(r0 + u) * DM + col) = o; }
    }
}

typedef short sg_bf16x8 __attribute__((ext_vector_type(8)));
typedef float sg_f32x16 __attribute__((ext_vector_type(16)));
constexpr int SG_VT = 0, SG_LD = 136, SG_ST = 36864;
__device__ __forceinline__ void p3_sgu(Frame& F) {
    LAS bf16* vnT = (LAS bf16*)(F.lds + SG_VT); LAS float* stS = (LAS float*)(F.lds + SG_ST);
    const bf16* U = (const bf16*)(F.ws + WS_U); const bf16* VT = (const bf16*)(F.ws + WS_V); bf16* AB = (bf16*)(F.ws + WS_H);
    const bf16* Wb = (const bf16*)(F.ws + WS_SGW); const float* stv = (const float*)(F.ws + WS_STV);
    const float* lng = F.in[I_SLNG]; const float* lnb = F.in[I_SLNB]; const float* sb = F.in[I_SB];
    const int tid = F.tid, lane = F.lane, w = F.wave, r = lane & 31, h = lane >> 5;
    const int q0 = 32 * (w >> 1), ct0 = 2 * (w & 1);
    for (int item = blockIdx.x; item < 1024; item += F.G) {
        const int b = item >> 7, n = (item >> 3) & 15, g = item & 7, tok0 = b * SEQ + n * 128;
        f32x2 pst[16];
        if (tid < 128) { const float* sp = stv + (size_t)(tok0 + tid) * 32;
#pragma unroll
            for (int i = 0; i < 16; ++i) pst[i] = *(const f32x2*)(sp + 2 * i); }
        const int c = tid >> 2, pseg = (tid & 3) * 32, ch = g * 128 + c;
        v4u wv[4];
        { const bf16* vp = VT + (size_t)ch * MTOK + tok0 + pseg;
#pragma unroll
          for (int k = 0; k < 4; ++k) wv[k] = *(const v4u*)(vp + 8 * k); }
        const float gg = lng[ch], bb = lnb[ch];
        sg_bf16x8 af[8];
#pragma unroll
        for (int kk = 0; kk < 8; ++kk) af[kk] = *(const sg_bf16x8*)(Wb + (size_t)(g * 128 + q0 + r) * 128 + 16 * kk + 8 * h);
        bf16 uu[2][16]; float sbv[16];
#pragma unroll
        for (int rg = 0; rg < 16; ++rg) { const int q = q0 + (rg & 3) + 8 * (rg >> 2) + 4 * h; sbv[rg] = sb[g * 128 + q];
#pragma unroll
            for (int ct = 0; ct < 2; ++ct) uu[ct][rg] = U[(size_t)(tok0 + q) * SGUW + g * 128 + (ct0 + ct) * 32 + r]; }
        if (tid < 128) { float s = 0.f, q = 0.f;
#pragma unroll
            for (int i = 0; i < 16; ++i) { s += pst[i].x; q += pst[i].y; }
            const float mean = s * (1.0f / 1024.0f); float var = q * (1.0f / 1024.0f) - mean * mean; var = var > 0.f ? var : 0.f;
            *(LAS f32x2*)(stS + 2 * tid) = (f32x2){mean, 1.0f / sqrtf(var + LN_EPS)}; }
        __syncthreads();
#pragma unroll
        for (int k = 0; k < 4; ++k) {
            const float e[8] = {bflo(wv[k].x), bfhi(wv[k].x), bflo(wv[k].y), bfhi(wv[k].y), bflo(wv[k].z), bfhi(wv[k].z), bflo(wv[k].w), bfhi(wv[k].w)};
            float o[8];
#pragma unroll
            for (int i = 0; i < 8; i += 2) { const f32x4 st = *(const LAS f32x4*)(stS + 2 * (pseg + 8 * k + i));
                o[i] = (e[i] - st[0]) * st[1] * gg + bb; o[i + 1] = (e[i + 1] - st[2]) * st[3] * gg + bb; }
            v4u pk; pk.x = pk2(o[0], o[1]); pk.y = pk2(o[2], o[3]); pk.z = pk2(o[4], o[5]); pk.w = pk2(o[6], o[7]);
            *(LAS v4u*)(vnT + c * SG_LD + pseg + 8 * k) = pk; }
        __syncthreads();
        sg_f32x16 acc[2];
#pragma unroll
        for (int ct = 0; ct < 2; ++ct)
#pragma unroll
            for (int i = 0; i < 16; ++i) acc[ct][i] = 0.f;
#pragma unroll
        for (int kk = 0; kk < 8; ++kk)
#pragma unroll
            for (int ct = 0; ct < 2; ++ct) {
                const sg_bf16x8 bf = *(const LAS sg_bf16x8*)(vnT + ((ct0 + ct) * 32 + r) * SG_LD + 16 * kk + 8 * h);
                acc[ct] = __builtin_amdgcn_mfma_f32_32x32x16_bf16(af[kk], bf, acc[ct], 0, 0, 0);
            }
#pragma unroll
        for (int ct = 0; ct < 2; ++ct) {
            const int cc = (ct0 + ct) * 32 + r;
#pragma unroll
            for (int rg = 0; rg < 16; ++rg) {
                const int q = q0 + (rg & 3) + 8 * (rg >> 2) + 4 * h;
                AB[(size_t)(tok0 + q) * DM + g * 128 + cc] = (bf16)f2bf(bf1(uu[ct][rg]) * (acc[ct][rg] + sbv[rg]));
            }
        }
        __syncthreads();
    }
}

__device__ __forceinline__ float sconv(const bf16* ZHT, const float* cw, const float* cb, int ch, int b, int t) {
    const bf16* zp = ZHT + (size_t)ch * MTOK + b * SEQ;
    const float z0 = t > 0 ? bf1(zp[t - 1]) : 0.f, z1 = bf1(zp[t]), z2 = t < SEQ - 1 ? bf1(zp[t + 1]) : 0.f;
    return cw[ch] * z0 + cw[3072 + ch] * z1 + cw[6144 + ch] * z2 + cb[ch];
}
__device__ __forceinline__ void p3_hyena(Frame& F) {
    LAS float* Us = (LAS float*)F.lds;
    LAS float* KF = (LAS float*)(F.lds + 65536);
    const bf16* ZHT = (const bf16*)(F.ws + WS_ZHT); const float* FILT = (const float*)(F.ws + WS_FILT); bf16* AB = (bf16*)(F.ws + WS_H);
    const float* cw = F.in[I_HCW]; const float* cb = F.in[I_HCB]; const float* skip = F.in[I_HSKIP];
    const int tid = F.tid;
    for (int item = blockIdx.x; item < HYW; item += F.G) {
        const int c = item;
        for (int i = tid; i < NBATCH * SEQ; i += NWAVES * 64) { const int b = i >> 11, t = i & 2047; Us[t * 8 + b] = sconv(ZHT, cw, cb, c, b, t); }
        for (int n = 0; n < 2; ++n) {
            const float* hf = FILT + (size_t)((0 * 2 + n) * 1024 + c) * SEQ; const float* hb = FILT + (size_t)((1 * 2 + n) * 1024 + c) * SEQ;
            for (int i = tid; i < 4095; i += NWAVES * 64) { const int lag = i - 2047; KF[i] = lag > 0 ? hf[lag] : (lag == 0 ? hf[0] + hb[0] : hb[-lag]); }
            __syncthreads();
            f32x4 acc[4][2];
#pragma unroll
            for (int ti = 0; ti < 4; ++ti) { acc[ti][0] = (f32x4){0.f, 0.f, 0.f, 0.f}; acc[ti][1] = (f32x4){0.f, 0.f, 0.f, 0.f}; }
            const LAS float* kp = KF + tid + 2047;
            for (int s = 0; s < SEQ; ++s) {
                const f32x4 u0 = *(const LAS f32x4*)(Us + s * 8), u1 = *(const LAS f32x4*)(Us + s * 8 + 4);
#pragma unroll
                for (int ti = 0; ti < 4; ++ti) { const float kv = kp[512 * ti - s]; acc[ti][0] += u0 * kv; acc[ti][1] += u1 * kv; }
            }
            __syncthreads();
            const float sk = skip[n * 1024 + c];
#pragma unroll
            for (int ti = 0; ti < 4; ++ti) { const int t = tid + 512 * ti;
#pragma unroll
                for (int b = 0; b < 8; ++b) {
                    const float uv = Us[t * 8 + b], gate = sconv(ZHT, cw, cb, (n + 1) * 1024 + c, b, t);
                    const float y = gate * (acc[ti][b >> 2][b & 3] + sk * uv);
                    if (n == 0) Us[t * 8 + b] = y; else AB[(size_t)(b * SEQ + t) * DM + 1024 + c] = (bf16)f2bf(y);
                } }
            __syncthreads();
        }
    }
}

#ifndef HYFFT_HD
#define HYFFT_HD __device__ __forceinline__
#define HYFFT_LAS __attribute__((address_space(3)))
#endif
typedef float hy_c32 __attribute__((ext_vector_type(2)));
HYFFT_HD int hy_padi(int i) { return i + (i >> 3); }
HYFFT_HD int hy_rev(int x) { return ((x & 7) << 9) | (((x >> 3) & 7) << 6) | (((x >> 6) & 7) << 3) | ((x >> 9) & 7); }

template <bool INV> HYFFT_HD void hy_dft8(float (&re)[8], float (&im)[8]) {
    const float h = 0.70710678118654752f;
    float ar[4], ai[4], br[4], bi[4];
#pragma unroll
    for (int m = 0; m < 4; ++m) { ar[m] = re[m] + re[m + 4]; ai[m] = im[m] + im[m + 4]; br[m] = re[m] - re[m + 4]; bi[m] = im[m] - im[m + 4]; }
    { float x = br[1], y = bi[1]; if (!INV) { br[1] = h * (x + y); bi[1] = h * (y - x); } else { br[1] = h * (x - y); bi[1] = h * (y + x); } }
    { float x = br[2], y = bi[2]; if (!INV) { br[2] = y; bi[2] = -x; } else { br[2] = -y; bi[2] = x; } }
    { float x = br[3], y = bi[3]; if (!INV) { br[3] = h * (y - x); bi[3] = -h * (x + y); } else { br[3] = -h * (x + y); bi[3] = h * (x - y); } }
#pragma unroll
    for (int s = 0; s < 2; ++s) {
        float* cr = s ? br : ar; float* ci = s ? bi : ai;
        const float e0r = cr[0] + cr[2], e0i = ci[0] + ci[2], e1r = cr[0] - cr[2], e1i = ci[0] - ci[2];
        const float o0r = cr[1] + cr[3], o0i = ci[1] + ci[3]; const float dr = cr[1] - cr[3], di = ci[1] - ci[3];
        float o1r, o1i; if (!INV) { o1r = di; o1i = -dr; } else { o1r = -di; o1i = dr; }
        re[0 + s] = e0r + o0r; im[0 + s] = e0i + o0i;
        re[2 + s] = e1r + o1r; im[2 + s] = e1i + o1i;
        re[4 + s] = e0r - o0r; im[4 + s] = e0i - o0i;
        re[6 + s] = e1r - o1r; im[6 + s] = e1i - o1i;
    }
}
template <bool CONJ> HYFFT_HD void hy_twiddle(float (&re)[8], float (&im)[8], float wr, float wi) {
    if (CONJ) wi = -wi;
    const float w2r = wr * wr - wi * wi, w2i = 2.f * wr * wi;
    const float w3r = w2r * wr - w2i * wi, w3i = w2r * wi + w2i * wr;
    const float w4r = w2r * w2r - w2i * w2i, w4i = 2.f * w2r * w2i;
    const float w5r = w4r * wr - w4i * wi, w5i = w4r * wi + w4i * wr;
    const float w6r = w3r * w3r - w3i * w3i, w6i = 2.f * w3r * w3i;
    const float w7r = w4r * w3r - w4i * w3i, w7i = w4r * w3i + w4i * w3r;
    const float pr[8] = {1.f, wr, w2r, w3r, w4r, w5r, w6r, w7r}, pi[8] = {0.f, wi, w2i, w3i, w4i, w5i, w6i, w7i};
#pragma unroll
    for (int k = 1; k < 8; ++k) { const float x = re[k], y = im[k]; re[k] = x * pr[k] - y * pi[k]; im[k] = x * pi[k] + y * pr[k]; }
}
template <int L, class BP, class TP> HYFFT_HD void hy_fwd_store(BP buf, TP tw, int j, float (&re)[8], float (&im)[8]) {
    constexpr int S = L / 8; const int blk = j / S, q = j % S, base = blk * L + q;
    hy_dft8<false>(re, im);
    if (L > 8) { const hy_c32 w = tw[q * (4096 / L)]; hy_twiddle<false>(re, im, w.x, w.y); }
#pragma unroll
    for (int k = 0; k < 8; ++k) buf[hy_padi(base + k * S)] = (hy_c32){re[k], im[k]};
}
template <int L, class BP> HYFFT_HD void hy_load8(BP buf, int j, float (&re)[8], float (&im)[8]) {
    constexpr int S = L / 8; const int blk = j / S, q = j % S, base = blk * L + q;
#pragma unroll
    for (int k = 0; k < 8; ++k) { const hy_c32 v = buf[hy_padi(base + k * S)]; re[k] = v.x; im[k] = v.y; }
}
template <int L, class BP, class TP> HYFFT_HD void hy_fwd_stage(BP buf, TP tw, int j) { float re[8], im[8]; hy_load8<L>(buf, j, re, im); hy_fwd_store<L>(buf, tw, j, re, im); }
template <int L, class BP, class TP> HYFFT_HD void hy_inv_regs(BP buf, TP tw, int j, float (&re)[8], float (&im)[8]) {
    constexpr int S = L / 8; const int q = j % S;
    hy_load8<L>(buf, j, re, im);
    if (L > 8) { const hy_c32 w = tw[q * (4096 / L)]; hy_twiddle<true>(re, im, w.x, w.y); }
    hy_dft8<true>(re, im);
}
template <int L, class BP, class TP> HYFFT_HD void hy_inv_stage(BP buf, TP tw, int j) {
    constexpr int S = L / 8; const int blk = j / S, q = j % S, base = blk * L + q;
    float re[8], im[8]; hy_inv_regs<L>(buf, tw, j, re, im);
#pragma unroll
    for (int k = 0; k < 8; ++k) buf[hy_padi(base + k * S)] = (hy_c32){re[k], im[k]};
}
template <class BP, class KP> HYFFT_HD void hy_mid_stage(BP buf, KP K, int j) {
    float re[8], im[8]; hy_load8<8>(buf, j, re, im);
    hy_dft8<false>(re, im);
#pragma unroll
    for (int k = 0; k < 8; ++k) { const hy_c32 kv = K[hy_padi(8 * j + k)]; const float x = re[k], y = im[k]; re[k] = x * kv.x - y * kv.y; im[k] = x * kv.y + y * kv.x; }
    hy_dft8<true>(re, im);
#pragma unroll
    for (int k = 0; k < 8; ++k) buf[hy_padi(8 * j + k)] = (hy_c32){re[k], im[k]};
}
template <class BP> HYFFT_HD void hy_last_fwd(BP buf, int j) {
    float re[8], im[8]; hy_load8<8>(buf, j, re, im); hy_dft8<false>(re, im);
#pragma unroll
    for (int k = 0; k < 8; ++k) buf[hy_padi(8 * j + k)] = (hy_c32){re[k], im[k]};
}
template <class BP, class KP> HYFFT_HD void hy_separate(BP Z, KP K1, KP K2, int j) {
    const float sc = 0.5f / 4096.0f;
#pragma unroll
    for (int r = 0; r < 8; ++r) {
        const int p = j + 512 * r, f = hy_rev(p), g = (4096 - f) & 4095, p2 = hy_rev(g);
        const hy_c32 a = Z[hy_padi(p)], b = Z[hy_padi(p2)];
        K1[hy_padi(p)] = (hy_c32){(a.x + b.x) * sc, (a.y - b.y) * sc};
        K2[hy_padi(p)] = (hy_c32){(a.y + b.y) * sc, (b.x - a.x) * sc};
    }
}

struct Raw3 { bf16 a, b, c; };
__device__ __forceinline__ Raw3 raw3(const bf16* zp, int t) { const bf16* p = zp + t; Raw3 r; r.a = p[-1]; r.b = p[0]; r.c = p[1]; return r; }
template <bool M0, bool M7> __device__ __forceinline__ float sconv_raw(const Raw3& r, int t, float w0, float w1, float w2, float cb) {
    float z0 = bf1(r.a), z2 = bf1(r.c); const float z1 = bf1(r.b);
    if (M0) z0 = t > 0 ? z0 : 0.f;
    if (M7) z2 = t < SEQ - 1 ? z2 : 0.f;
    return w0 * z0 + w1 * z1 + w2 * z2 + cb;
}
__device__ __forceinline__ float sconv_raw_m(int m, const Raw3& r, int t, float w0, float w1, float w2, float cb) {
    return m == 0 ? sconv_raw<true, false>(r, t, w0, w1, w2, cb) : (m == 7 ? sconv_raw<false, true>(r, t, w0, w1, w2, cb) : sconv_raw<false, false>(r, t, w0, w1, w2, cb));
}
HYFFT_HD int hy16_padi(int i) { return i + (i >> 4); }
HYFFT_HD int hy16_rev(int x) { return ((x & 15) << 8) | (x & 0xF0) | ((x >> 8) & 15); }
template <bool INV> HYFFT_HD void hy16_dft4(float& r0, float& i0, float& r1, float& i1, float& r2, float& i2, float& r3, float& i3) {
    const float e0r = r0 + r2, e0i = i0 + i2, e1r = r0 - r2, e1i = i0 - i2, o0r = r1 + r3, o0i = i1 + i3, dr = r1 - r3, di = i1 - i3;
    float o1r, o1i; if (!INV) { o1r = di; o1i = -dr; } else { o1r = -di; o1i = dr; }
    r0 = e0r + o0r; i0 = e0i + o0i; r1 = e1r + o1r; i1 = e1i + o1i; r2 = e0r - o0r; i2 = e0i - o0i; r3 = e1r - o1r; i3 = e1i - o1i;
}
template <bool INV> HYFFT_HD void hy16_cmulc(float& r, float& i, float cr, float ci) { if (INV) ci = -ci; const float x = r, y = i; r = x * cr - y * ci; i = x * ci + y * cr; }
template <bool INV> HYFFT_HD void hy16_dft16(float (&re)[16], float (&im)[16]) {
    const float c1 = 0.92387953251128674f, s1 = 0.38268343236508977f, h = 0.70710678118654752f;
#pragma unroll
    for (int m2 = 0; m2 < 4; ++m2) hy16_dft4<INV>(re[m2], im[m2], re[4 + m2], im[4 + m2], re[8 + m2], im[8 + m2], re[12 + m2], im[12 + m2]);
    hy16_cmulc<INV>(re[4 * 1 + 1], im[4 * 1 + 1], c1, -s1);
    hy16_cmulc<INV>(re[4 * 2 + 1], im[4 * 2 + 1], h, -h);
    hy16_cmulc<INV>(re[4 * 3 + 1], im[4 * 3 + 1], s1, -c1);
    hy16_cmulc<INV>(re[4 * 1 + 2], im[4 * 1 + 2], h, -h);
    hy16_cmulc<INV>(re[4 * 2 + 2], im[4 * 2 + 2], 0.f, -1.f);
    hy16_cmulc<INV>(re[4 * 3 + 2], im[4 * 3 + 2], -h, -h);
    hy16_cmulc<INV>(re[4 * 1 + 3], im[4 * 1 + 3], s1, -c1);
    hy16_cmulc<INV>(re[4 * 2 + 3], im[4 * 2 + 3], -h, -h);
    hy16_cmulc<INV>(re[4 * 3 + 3], im[4 * 3 + 3], -c1, s1);
#pragma unroll
    for (int k1 = 0; k1 < 4; ++k1) hy16_dft4<INV>(re[4 * k1], im[4 * k1], re[4 * k1 + 1], im[4 * k1 + 1], re[4 * k1 + 2], im[4 * k1 + 2], re[4 * k1 + 3], im[4 * k1 + 3]);
#pragma unroll
    for (int a = 0; a < 4; ++a)
#pragma unroll
        for (int b = a + 1; b < 4; ++b) { float t = re[4 * a + b]; re[4 * a + b] = re[4 * b + a]; re[4 * b + a] = t; t = im[4 * a + b]; im[4 * a + b] = im[4 * b + a]; im[4 * b + a] = t; }
}
template <bool CONJ> HYFFT_HD void hy16_twiddle(float (&re)[16], float (&im)[16], float wr, float wi) {
    if (CONJ) wi = -wi;
    float pr[16], pi[16]; pr[1] = wr; pi[1] = wi;
#define HY16_SQ(d, a) pr[d] = pr[a] * pr[a] - pi[a] * pi[a]; pi[d] = 2.f * pr[a] * pi[a];
#define HY16_MUL(d, a, b) pr[d] = pr[a] * pr[b] - pi[a] * pi[b]; pi[d] = pr[a] * pi[b] + pi[a] * pr[b];
    HY16_SQ(2, 1) HY16_MUL(3, 2, 1) HY16_SQ(4, 2) HY16_MUL(5, 4, 1) HY16_SQ(6, 3) HY16_MUL(7, 4, 3) HY16_SQ(8, 4)
    HY16_MUL(9, 8, 1) HY16_SQ(10, 5) HY16_MUL(11, 8, 3) HY16_SQ(12, 6) HY16_MUL(13, 8, 5) HY16_SQ(14, 7) HY16_MUL(15, 8, 7)
#undef HY16_SQ
#undef HY16_MUL
#pragma unroll
    for (int k = 1; k < 16; ++k) { const float x = re[k], y = im[k]; re[k] = x * pr[k] - y * pi[k]; im[k] = x * pi[k] + y * pr[k]; }
}
template <int L, class BP> HYFFT_HD void hy16_load(BP buf, int jj, float (&re)[16], float (&im)[16]) {
    constexpr int S = L / 16; const int blk = jj / S, q = jj % S, pb = hy16_padi(blk * L + q);
#pragma unroll
    for (int k = 0; k < 16; ++k) { const hy_c32 v = buf[pb + k * (S + S / 16)]; re[k] = v.x; im[k] = v.y; }
}
template <class BP> HYFFT_HD void hy16_load1(BP buf, int jj, float (&re)[16], float (&im)[16]) {
#pragma unroll
    for (int k = 0; k < 16; ++k) { const hy_c32 v = buf[17 * jj + k]; re[k] = v.x; im[k] = v.y; }
}
template <int L, class BP> HYFFT_HD void hy16_store(BP buf, int jj, const float (&re)[16], const float (&im)[16]) {
    constexpr int S = L / 16; const int blk = jj / S, q = jj % S, pb = hy16_padi(blk * L + q);
#pragma unroll
    for (int k = 0; k < 16; ++k) buf[pb + k * (S + S / 16)] = (hy_c32){re[k], im[k]};
}
template <class BP> HYFFT_HD void hy16_store1(BP buf, int jj, const float (&re)[16], const float (&im)[16]) {
#pragma unroll
    for (int k = 0; k < 16; ++k) buf[17 * jj + k] = (hy_c32){re[k], im[k]};
}
template <int L, class BP, class TP> HYFFT_HD void hy16_fwd_store(BP buf, TP tw, int jj, float (&re)[16], float (&im)[16]) {
    constexpr int S = L / 16; const int q = jj % S;
    hy16_dft16<false>(re, im);
    { const hy_c32 w = tw[q * (4096 / L)]; hy16_twiddle<false>(re, im, w.x, w.y); }
    hy16_store<L>(buf, jj, re, im);
}
template <int L, class BP, class TP> HYFFT_HD void hy16_fwd_stage(BP buf, TP tw, int jj) { float re[16], im[16]; hy16_load<L>(buf, jj, re, im); hy16_fwd_store<L>(buf, tw, jj, re, im); }
template <int L, class BP, class TP> HYFFT_HD void hy16_inv_regs(BP buf, TP tw, int jj, float (&re)[16], float (&im)[16]) {
    constexpr int S = L / 16; const int q = jj % S;
    hy16_load<L>(buf, jj, re, im);
    { const hy_c32 w = tw[q * (4096 / L)]; hy16_twiddle<true>(re, im, w.x, w.y); }
    hy16_dft16<true>(re, im);
}
template <int L, class BP, class TP> HYFFT_HD void hy16_inv_stage(BP buf, TP tw, int jj) { float re[16], im[16]; hy16_inv_regs<L>(buf, tw, jj, re, im); hy16_store<L>(buf, jj, re, im); }
template <class BP, class KP> HYFFT_HD void hy16_mid_stage(BP buf, KP K, int jj) {
    float re[16], im[16]; hy16_load1(buf, jj, re, im);
    hy16_dft16<false>(re, im);
#pragma unroll
    for (int k = 0; k < 16; ++k) { const hy_c32 kv = K[17 * jj + k]; const float x = re[k], y = im[k]; re[k] = x * kv.x - y * kv.y; im[k] = x * kv.y + y * kv.x; }
    hy16_dft16<true>(re, im);
    hy16_store1(buf, jj, re, im);
}
template <class BP> HYFFT_HD void hy16_last_fwd(BP buf, int jj) { float re[16], im[16]; hy16_load1(buf, jj, re, im); hy16_dft16<false>(re, im); hy16_store1(buf, jj, re, im); }
template <class BP, class KP> HYFFT_HD void hy16_separate(BP Z, KP K1, KP K2, int t) {
    const float sc = 0.5f / 4096.0f;
#pragma unroll
    for (int r = 0; r < 8; ++r) {
        const int p = t + 512 * r, f = hy16_rev(p), g = (4096 - f) & 4095, p2 = hy16_rev(g);
        const hy_c32 a = Z[hy16_padi(p)], b = Z[hy16_padi(p2)];
        K1[hy16_padi(p)] = (hy_c32){(a.x + b.x) * sc, (a.y - b.y) * sc};
        K2[hy16_padi(p)] = (hy_c32){(a.y + b.y) * sc, (b.x - a.x) * sc};
    }
}
__device__ __forceinline__ void p3_hyena_fft(Frame& F) {
    const int tid0 = F.tid;
    const int half = __builtin_amdgcn_readfirstlane(tid0 >> 8);
    LAS hy_c32* BUF = (LAS hy_c32*)(F.lds + half * 34816);
    LAS hy_c32* B0 = (LAS hy_c32*)(F.lds + 0);
    LAS hy_c32* K1 = (LAS hy_c32*)(F.lds + 69632); LAS hy_c32* K2 = (LAS hy_c32*)(F.lds + 104448); LAS hy_c32* TW = (LAS hy_c32*)(F.lds + 139264);
    const bf16* ZHT = (const bf16*)(F.ws + WS_ZHT); const float* FILT = (const float*)(F.ws + WS_FILT); bf16* YT = (bf16*)(F.ws + WS_YT);
    const float* cw = F.in[I_HCW]; const float* cb = F.in[I_HCB]; const float* skip = F.in[I_HSKIP];
    if (tid0 < 256) { float sn, cs; sincosf(-6.283185307179586f * (float)tid0 / 4096.0f, &sn, &cs); TW[tid0] = (hy_c32){cs, sn}; }
    __syncthreads();
    for (int item = blockIdx.x; item < HYW; item += F.G) {
        const int c = item;
        int tid = tid0; asm volatile("" : "+v"(tid));
        int jj = tid & 255;
        float re[16], im[16];
        const bf16* zv = ZHT + (size_t)c * MTOK; const bf16* za = ZHT + (size_t)(1024 + c) * MTOK; const bf16* zb = ZHT + (size_t)(2048 + c) * MTOK;
        {
            if (half == 0) {
                const float* hf0 = FILT + (size_t)(0 * 1024 + c) * SEQ; const float* hf1 = FILT + (size_t)(1 * 1024 + c) * SEQ;
                const float* hb0 = FILT + (size_t)(2 * 1024 + c) * SEQ; const float* hb1 = FILT + (size_t)(3 * 1024 + c) * SEQ;
#pragma unroll
                for (int m = 0; m < 8; ++m) { const int i = jj + 256 * m; re[m] = hf0[i]; im[m] = hf1[i]; }
                if (jj == 0) { re[0] += hb0[0]; im[0] += hb1[0]; }
#pragma unroll
                for (int m = 8; m < 16; ++m) { const int i = jj + 256 * m; const bool z = (i == 2048); const int r = z ? 0 : 4096 - i; const float a = hb0[r], b = hb1[r]; re[m] = z ? 0.f : a; im[m] = z ? 0.f : b; }
                hy16_fwd_store<4096>(B0, TW, jj, re, im);
            }
            __syncthreads();
            if (half == 0) hy16_fwd_stage<256>(B0, TW, jj);
            __syncthreads();
            if (half == 0) hy16_last_fwd(B0, jj);
            __syncthreads();
            hy16_separate(B0, K1, K2, tid); __syncthreads();
        }
        const float vw0 = cw[c], vw1 = cw[3072 + c], vw2 = cw[6144 + c], vcb = cb[c];
        const float aw0 = cw[1024 + c], aw1 = cw[3072 + 1024 + c], aw2 = cw[6144 + 1024 + c], acb = cb[1024 + c];
        const float bw0 = cw[2048 + c], bw1 = cw[3072 + 2048 + c], bw2 = cw[6144 + 2048 + c], bcb = cb[2048 + c];
        const float sk0 = skip[c], sk1 = skip[1024 + c];
#pragma unroll 1
        for (int rd = 0; rd < 2; ++rd) {
            const int boff = (4 * rd + 2 * half) * SEQ;
            asm volatile("" : "+v"(jj));
            Raw3 rg[2][8];
            float v[2][8];
#pragma unroll
            for (int m = 0; m < 8; ++m) { const int t = jj + 256 * m;
                const Raw3 r0 = raw3(zv + boff, t), r1 = raw3(zv + boff + SEQ, t); v[0][m] = sconv_raw_m(m, r0, t, vw0, vw1, vw2, vcb); v[1][m] = sconv_raw_m(m, r1, t, vw0, vw1, vw2, vcb); }
#pragma unroll
            for (int m = 0; m < 8; ++m) { re[m] = v[0][m]; im[m] = v[1][m]; re[m + 8] = 0.f; im[m + 8] = 0.f; }
            hy16_fwd_store<4096>(BUF, TW, jj, re, im); __syncthreads();
            hy16_fwd_stage<256>(BUF, TW, jj); __syncthreads();
            hy16_mid_stage(BUF, K1, jj); __syncthreads();
#pragma unroll
            for (int m = 0; m < 8; ++m) { const int t = jj + 256 * m; rg[0][m] = raw3(za + boff, t); rg[1][m] = raw3(za + boff + SEQ, t); }
            hy16_inv_stage<256>(BUF, TW, jj); __syncthreads();
            hy16_inv_regs<4096>(BUF, TW, jj, re, im);
#pragma unroll
            for (int m = 0; m < 8; ++m) { const int t = jj + 256 * m;
                v[0][m] = sconv_raw_m(m, rg[0][m], t, aw0, aw1, aw2, acb) * (re[m] + sk0 * v[0][m]); v[1][m] = sconv_raw_m(m, rg[1][m], t, aw0, aw1, aw2, acb) * (im[m] + sk0 * v[1][m]); }
#pragma unroll
            for (int m = 0; m < 8; ++m) { re[m] = v[0][m]; im[m] = v[1][m]; re[m + 8] = 0.f; im[m + 8] = 0.f; }
            hy16_fwd_store<4096>(BUF, TW, jj, re, im); __syncthreads();
            hy16_fwd_stage<256>(BUF, TW, jj); __syncthreads();
            hy16_mid_stage(BUF, K2, jj); __syncthreads();
#pragma unroll
            for (int m = 0; m < 8; ++m) { const int t = jj + 256 * m; rg[0][m] = raw3(zb + boff, t); rg[1][m] = raw3(zb + boff + SEQ, t); }
            hy16_inv_stage<256>(BUF, TW, jj); __syncthreads();
            hy16_inv_regs<4096>(BUF, TW, jj, re, im);
#pragma unroll
            for (int m = 0; m < 8; ++m) { const int t = jj + 256 * m; bf16* yp = YT + (size_t)c * MTOK + boff + t;
                yp[0] = (bf16)f2bf(sconv_raw_m(m, rg[0][m], t, bw0, bw1, bw2, bcb) * (re[m] + sk1 * v[0][m]));
                yp[SEQ] = (bf16)f2bf(sconv_raw_m(m, rg[1][m], t, bw0, bw1, bw2, bcb) * (im[m] + sk1 * v[1][m])); }
        }
        __syncthreads();
    }
}

__device__ __forceinline__ void p3c_transpose(Frame& F) {
    LAS unsigned* tile = (LAS unsigned*)F.lds;
    const bf16* YT = (const bf16*)(F.ws + WS_YT); bf16* AB = (bf16*)(F.ws + WS_H);
    const int tid = F.tid;
    for (int it = blockIdx.x; it < MTOK / 64; it += F.G) {
        const int t0 = it * 64;
        { const int rr = tid >> 3, seg = tid & 7;
          v4u w[16];
#pragma unroll
          for (int i = 0; i < 16; ++i) w[i] = *(const v4u*)(YT + (size_t)(i * 64 + rr) * MTOK + t0 + seg * 8);
#pragma unroll
          for (int i = 0; i < 16; ++i) { const int c = i * 64 + rr, rot = (c >> 3) + (c & 3); LAS unsigned* row = tile + c * 32;
              row[(seg * 4 + 0 + rot) & 31] = w[i].x; row[(seg * 4 + 1 + rot) & 31] = w[i].y; row[(seg * 4 + 2 + rot) & 31] = w[i].z; row[(seg * 4 + 3 + rot) & 31] = w[i].w; } }
        __syncthreads();
#pragma unroll 2
        for (int k = 0; k < 8; ++k) { const int j = tid + 512 * k, tp = j >> 7, cseg = j & 127;
            unsigned d[8];
#pragma unroll
            for (int e = 0; e < 8; ++e) d[e] = tile[(8 * cseg + e) * 32 + ((tp + cseg + (e & 3)) & 31)];
            v4u lo, hi;
            lo.x = (d[0] & 0xffffu) | (d[1] << 16); lo.y = (d[2] & 0xffffu) | (d[3] << 16); lo.z = (d[4] & 0xffffu) | (d[5] << 16); lo.w = (d[6] & 0xffffu) | (d[7] << 16);
            hi.x = (d[0] >> 16) | (d[1] & 0xffff0000u); hi.y = (d[2] >> 16) | (d[3] & 0xffff0000u); hi.z = (d[4] >> 16) | (d[5] & 0xffff0000u); hi.w = (d[6] >> 16) | (d[7] & 0xffff0000u);
            bf16* dst = AB + (size_t)(t0 + 2 * tp) * DM + 1024 + 8 * cseg;
            *(v4u*)dst = lo; *(v4u*)(dst + DM) = hi; }
        __syncthreads();
    }
}

typedef _Float16 ln_f16x4 __attribute__((ext_vector_type(4)));
template <bool FINAL> __device__ __forceinline__ void ln_rows(Frame& F) {
    const _Float16* R = FINAL ? (const _Float16*)(F.ws + WS_H) : (const _Float16*)F.out;
    const float* st = (const float*)(F.ws + (FINAL ? WS_ST2 : WS_ST1)); float* MU = (float*)(F.ws + WS_MU1);
    const float* mod = (const float*)(F.ws + WS_MOD); bf16* H2 = (bf16*)(F.ws + WS_H);
    const float* lng = F.in[FINAL ? I_LN2G : I_LN1G]; const float* lnb = F.in[FINAL ? I_LN2B : I_LN1B];
    const int lane = F.lane, vcu = (F.G == 256) ? (int)((blockIdx.x & 7) * 32 + (blockIdx.x >> 3)) : (int)blockIdx.x;
    const int rpb = MTOK / F.G, rend = vcu * rpb + rpb, NGW = NWAVES;
    ln_f16x4 cur[8], nxt[8]; f32x2 ps = (f32x2){0.f, 0.f}, pn = (f32x2){0.f, 0.f};
    int row = vcu * rpb + F.wave;
    if (row < rend) {
#pragma unroll
        for (int j = 0; j < 8; ++j) cur[j] = *(const ln_f16x4*)(R + (size_t)row * DM + 4 * lane + 256 * j);
        if (lane < 32) ps = *(const f32x2*)(st + ((size_t)row * 32 + lane) * 2);
    }
    for (; row < rend; row += NGW) {
        const int rn = row + NGW;
        if (rn < rend) {
#pragma unroll
            for (int j = 0; j < 8; ++j) nxt[j] = *(const ln_f16x4*)(R + (size_t)rn * DM + 4 * lane + 256 * j);
            pn = (f32x2){0.f, 0.f}; if (lane < 32) pn = *(const f32x2*)(st + ((size_t)rn * 32 + lane) * 2);
        }
        const float s = wave_sum(ps.x), q = wave_sum(ps.y);
        const float mean = s * (1.0f / DM); float var = q * (1.0f / DM) - mean * mean; var = var > 0.f ? var : 0.f; const float rstd = 1.0f / sqrtf(var + LN_EPS);
        if (!FINAL && lane == 0) *(f32x2*)(MU + (size_t)row * 2) = (f32x2){mean, rstd};
        const int b = row >> 11;
#pragma unroll
        for (int j = 0; j < 8; ++j) { const int col = 4 * lane + 256 * j;
            const f32x4 v = (f32x4){(float)cur[j][0], (float)cur[j][1], (float)cur[j][2], (float)cur[j][3]};
            const f32x4 y = (v - mean) * rstd * *(const f32x4*)(lng + col) + *(const f32x4*)(lnb + col);
            if (FINAL) *(f32x4*)(F.out + (size_t)row * DM + col) = y;
            else { const float* mp = mod + (size_t)b * MODW + col; const f32x4 h = y * (*(const f32x4*)(mp + 4 * DM) + 1.0f) + *(const f32x4*)(mp + 3 * DM);
                   v2u o; o.x = pk2(h[0], h[1]); o.y = pk2(h[2], h[3]); *(v2u*)(H2 + (size_t)row * DM + col) = o; } }
#pragma unroll
        for (int j = 0; j < 8; ++j) cur[j] = nxt[j];
        ps = pn;
    }
}

typedef GAS unsigned gu32;
#define RLX_AGENT __ATOMIC_RELAXED, __HIP_MEMORY_SCOPE_AGENT
constexpr int LDSCTL_OFF = 163840 - 512, MISC_OFF = LDSCTL_OFF;
constexpr int CW_BAR = 4096;
constexpr size_t CTL_ZERO_BYTES = 65536;
#define XB_TMO      128
#define XB_XCNT(j)  (256  + 64 * (j))
#define XB_XSUB(j)  (1280 + 64 * (j))
#define XB_XGEN(j)  (2304 + 64 * (j))
#define XB_TOP      3328
#define XB_TOPGEN   3392
#define XCD_BAR_WORDS 3456
#define XB_SPIN_CAP (1u << 18)

__device__ __forceinline__ unsigned xb_ld(unsigned* p)              { return __hip_atomic_load(p, __ATOMIC_RELAXED, __HIP_MEMORY_SCOPE_AGENT); }
__device__ __forceinline__ unsigned xb_add(unsigned* p, unsigned v) { return __hip_atomic_fetch_add(p, v, __ATOMIC_RELAXED, __HIP_MEMORY_SCOPE_AGENT); }
__device__ __forceinline__ unsigned xb_xcc_id() { return (unsigned)__builtin_amdgcn_s_getreg((3 << 11) | 20) & 0xFu; }
#define XB_SPIN(cond, bar) do { unsigned _sp = 0; while (cond) { __builtin_amdgcn_s_sleep(1); \
    if ((++_sp & 255u) == 0u) { if (xb_ld(&(bar)[XB_TMO])) break; if (_sp > XB_SPIN_CAP) { atomicAdd(&(bar)[XB_TMO], 1u); break; } } } } while (0)

struct XcdBarrier {
    unsigned* bar; unsigned x;
    volatile LAS unsigned* st;
};

__device__ __forceinline__ XcdBarrier xcd_barrier_post(unsigned* bar, volatile LAS unsigned* st) {
    XcdBarrier b; b.bar = bar; b.x = xb_xcc_id(); b.st = st;
    if (threadIdx.x == 0) (void)xb_add(&bar[XB_XCNT(b.x)], 1u);
    return b;
}
__device__ __forceinline__ void xcd_barrier_complete(unsigned* bar, unsigned x, unsigned& nloc, unsigned& nx) {
    const unsigned G = gridDim.x * gridDim.y * gridDim.z;
    unsigned sum, cnt, mine, sp = 0u;
    for (;;) {
        sum = 0u; cnt = 0u; mine = 0u;
#pragma unroll
        for (unsigned j = 0; j < 16; ++j) { const unsigned c = xb_ld(&bar[XB_XCNT(j)]); sum += c; cnt += (c > 0u) ? 1u : 0u; mine = (j == x) ? c : mine; }
        if (sum == G) break;
        __builtin_amdgcn_s_sleep(1);
        if ((++sp & 255u) == 0u) { if (xb_ld(&bar[XB_TMO])) break; if (sp > XB_SPIN_CAP) { atomicAdd(&bar[XB_TMO], 1u); break; } }
    }
    nloc = mine > 0u ? mine : 1u; nx = cnt > 0u ? cnt : 1u;
}

__device__ __forceinline__ void xcd_barrier(const XcdBarrier& b) {
    asm volatile("s_waitcnt vmcnt(0)" ::: "memory");
    __syncthreads();
    if (threadIdx.x == 0) {
        unsigned* bar = b.bar;
        __builtin_amdgcn_s_waitcnt(0);
        unsigned nloc = b.st[0], nx = b.st[1];
        if (nloc == 0u) { xcd_barrier_complete(bar, b.x, nloc, nx); b.st[0] = nloc; b.st[1] = nx; }
        const unsigned old = xb_add(&bar[XB_XSUB(b.x)], 1u);
        const unsigned gen = old / nloc;
        if (old + 1u == (gen + 1u) * nloc) {
            __builtin_amdgcn_fence(__ATOMIC_RELEASE, "agent");
            asm volatile("s_waitcnt vmcnt(0)" ::: "memory");
            const unsigned og = xb_add(&bar[XB_TOP], 1u);
            const unsigned tg = og / nx;
            if (og + 1u == (tg + 1u) * nx) xb_add(&bar[XB_TOPGEN], 1u);
            else XB_SPIN(xb_ld(&bar[XB_TOPGEN]) == tg, bar);
            __builtin_amdgcn_fence(__ATOMIC_ACQUIRE, "agent");
            xb_add(&bar[XB_XGEN(b.x)], 1u);
            asm volatile("s_waitcnt vmcnt(0)" ::: "memory");
        } else {
            XB_SPIN(xb_ld(&bar[XB_XGEN(b.x)]) == gen, bar);
            __builtin_amdgcn_fence(__ATOMIC_ACQUIRE, "agent");
            asm volatile("s_waitcnt vmcnt(0)" ::: "memory");
        }
    }
    __syncthreads();
}

#define GRID_SYNC() xcd_barrier(bar)

__global__ void __launch_bounds__(NWAVES * 64, 2) fwd_megakernel(Args args) {
    extern __shared__ __attribute__((aligned(16))) unsigned char lds[];
    Frame F;
    F.lds = (LAS unsigned char*)lds;
    F.tid = threadIdx.x; F.lane = F.tid & 63; F.wave = __builtin_amdgcn_readfirstlane(F.tid >> 6); F.G = gridDim.x;
    F.in = args.in; F.out = args.out; F.ws = args.ws;
    for (int u = F.tid; u < (LDS_BYTES - LDSCTL_OFF) / 4; u += NWAVES * 64) ((LAS unsigned*)(F.lds + LDSCTL_OFF))[u] = 0u;
    __syncthreads();
    XcdBarrier bar = xcd_barrier_post((unsigned*)(args.ws + WS_CTL) + CW_BAR, (volatile LAS unsigned*)(F.lds + MISC_OFF) + 8);
    unsigned char* ws = args.ws;
    const int lo = args.ph_lo, hi = args.ph_hi;
#define IN(k) (lo <= (k) && (k) < hi)
#define BOTH(k) (IN(k) && IN((k) + 1))
    const int gw = blockIdx.x * NWAVES + F.wave, NGW = F.G * NWAVES;

    PB_START(1, F.lds);
    if (IN(0)) { { int t_ = threadIdx.x; asm volatile("" : "+v"(t_)); F.tid = t_; F.lane = t_ & 63; }
        PB_START(21, F.lds); p0_mod(F); PB_END(21, F.lds);
        PB_START(22, F.lds);
        transpose_matrix(F, F.in[I_WIN], DM, INW, (bf16*)(ws + WS_WIN), DM, 0, 1, (int)blockIdx.x, F.G);
        transpose_matrix(F, F.in[I_WA], SGUW, DM, (bf16*)(ws + WS_WAB), DM, 0, 0, (int)((blockIdx.x + 128) % F.G), F.G);
        transpose_matrix(F, F.in[I_WB], HYW, DM, (bf16*)(ws + WS_WAB), DM, 1024, 0, (int)blockIdx.x, F.G);
        transpose_matrix(F, F.in[I_WO], DM, DM, (bf16*)(ws + WS_WO), DM, 0, 0, (int)blockIdx.x, F.G);
        { const float* sw = F.in[I_SW]; bf16* sgw = (bf16*)(ws + WS_SGW);
          for (int i = blockIdx.x * (NWAVES * 64) + F.tid; i < 8 * 128 * 128 / 2; i += F.G * NWAVES * 64) { const f32x2 v = *(const f32x2*)(sw + 2 * i); *(unsigned*)(sgw + 2 * i) = pk2(v.x, v.y); } }
        __syncthreads();
        __syncthreads(); p0_hid2(F);
        PB_END(22, F.lds);
        if (BOTH(0)) GRID_SYNC();
    }
    PB_END(1, F.lds);
    PB_START(2, F.lds);
    if (IN(1)) { { int t_ = threadIdx.x; asm volatile("" : "+v"(t_)); F.tid = t_; F.lane = t_ & 63; } if (F.wave < 4) p1_modulate(F); else p1_filter_waves(F); if (BOTH(1)) GRID_SYNC(); }
    PB_END(2, F.lds);
    PB_START(3, F.lds);
    if (IN(2)) { { int t_ = threadIdx.x; asm volatile("" : "+v"(t_)); F.tid = t_; F.lane = t_ & 63; }
        { pg8::Gemm g{(const pg8::bf16_t*)(ws + WS_H), (const pg8::bf16_t*)(ws + WS_WIN), MTOK, 5120, DM}; pg8::StaticOrder S; S.init(MTOK, 5120, F.G, (int)blockIdx.x, WGM_P2A);
          pg8::EpiG1 E{(pg8::bf16_t*)(ws + WS_U), (pg8::bf16_t*)(ws + WS_G), F.in[I_BIN]};
          pg8::gemm_phase<pg8::EpiG1, pg8::StaticOrder, true, true>(F.lds, g, S, E); }
        __syncthreads();
        { pg8::Gemm g{(const pg8::bf16_t*)(ws + WS_WIN) + (size_t)5120 * DM, (const pg8::bf16_t*)(ws + WS_H), 4096, MTOK, DM}; pg8::StaticOrder S; S.init(4096, MTOK, F.G, (int)blockIdx.x, WGM_P2B);
          pg8::EpiG1T E{(pg8::bf16_t*)(ws + WS_V), (pg8::bf16_t*)(ws + WS_ZHT), F.in[I_BIN], (float*)(ws + WS_STV)};
          pg8::gemm_phase<pg8::EpiG1T, pg8::StaticOrder, true, true>(F.lds, g, S, E); }
        if (BOTH(2)) GRID_SYNC();
    }
    PB_END(3, F.lds);
    PB_START(4, F.lds);
    if (IN(3)) { { int t_ = threadIdx.x; asm volatile("" : "+v"(t_)); F.tid = t_; F.lane = t_ & 63; } __syncthreads(); PB_START(41, F.lds); p3_sgu(F); PB_END(41, F.lds); PB_START(42, F.lds); p3_hyena_fft(F); PB_END(42, F.lds); if (BOTH(3)) GRID_SYNC(); PB_START(43, F.lds); p3c_transpose(F); GRID_SYNC(); PB_END(43, F.lds); }
    PB_END(4, F.lds);
    PB_START(5, F.lds);
    if (IN(4)) { { int t_ = threadIdx.x; asm volatile("" : "+v"(t_)); F.tid = t_; F.lane = t_ & 63; }
        pg8::Gemm g{(const pg8::bf16_t*)(ws + WS_H), (const pg8::bf16_t*)(ws + WS_WAB), MTOK, DM, DM}; pg8::StaticOrder S; S.init(MTOK, DM, F.G, (int)blockIdx.x, WGM_P4);
        pg8::EpiG2 E{(const pg8::bf16_t*)(ws + WS_G), (pg8::bf16_t*)(ws + WS_MERGED)};
        pg8::gemm_phase<pg8::EpiG2, pg8::StaticOrder, true, true>(F.lds, g, S, E);
        if (BOTH(4)) GRID_SYNC();
    }
    PB_END(5, F.lds);
    PB_START(6, F.lds);
    if (IN(5)) { { int t_ = threadIdx.x; asm volatile("" : "+v"(t_)); F.tid = t_; F.lane = t_ & 63; }
        pg8::Gemm g{(const pg8::bf16_t*)(ws + WS_MERGED), (const pg8::bf16_t*)(ws + WS_WO), MTOK, DM, DM}; pg8::StaticOrder S; S.init(MTOK, DM, F.G, (int)blockIdx.x, WGM_P5);
        pg8::EpiRes<true> E{F.in[I_X], nullptr, (_Float16*)F.out, (const float*)(ws + WS_MOD) + 2 * DM, F.in[I_BO], nullptr, nullptr, nullptr, (float*)(ws + WS_ST1)};
        pg8::gemm_phase<pg8::EpiRes<true>, pg8::StaticOrder, true, true>(F.lds, g, S, E);
        if (BOTH(5)) GRID_SYNC();
    }
    PB_END(6, F.lds);
    PB_START(7, F.lds);
    if (IN(6)) { { int t_ = threadIdx.x; asm volatile("" : "+v"(t_)); F.tid = t_; F.lane = t_ & 63; }
        __syncthreads();
        ln_rows<false>(F);
        __syncthreads();
        transpose_matrix(F, F.in[I_WM1], DM, DFF, (bf16*)(ws + WS_WM1), DM, 0, 0, (int)blockIdx.x, F.G);
        transpose_matrix(F, F.in[I_WM2], DFF, DM, (bf16*)(ws + WS_WM2), DFF, 0, 0, (int)blockIdx.x, F.G);
        if (BOTH(6)) GRID_SYNC();
    }
    PB_END(7, F.lds);
    PB_START(8, F.lds);
    if (IN(7)) { { int t_ = threadIdx.x; asm volatile("" : "+v"(t_)); F.tid = t_; F.lane = t_ & 63; }
        __syncthreads();
        pg8::Gemm g{(const pg8::bf16_t*)(ws + WS_H), (const pg8::bf16_t*)(ws + WS_WM1), MTOK, DFF, DM}; pg8::StaticOrder S; S.init(MTOK, DFF, F.G, (int)blockIdx.x, WGM_P7);
        pg8::EpiG4 E{(pg8::bf16_t*)(ws + WS_AFF), F.in[I_BM1]};
        pg8::gemm_phase<pg8::EpiG4, pg8::StaticOrder, true, true>(F.lds, g, S, E);
        if (BOTH(7)) GRID_SYNC();
    }
    PB_END(8, F.lds);
    PB_START(9, F.lds);
    if (IN(8)) { { int t_ = threadIdx.x; asm volatile("" : "+v"(t_)); F.tid = t_; F.lane = t_ & 63; }
        pg8::Gemm g{(const pg8::bf16_t*)(ws + WS_AFF), (const pg8::bf16_t*)(ws + WS_WM2), MTOK, DM, DFF}; pg8::StaticOrder S; S.init(MTOK, DM, F.G, (int)blockIdx.x, WGM_P8);
        pg8::EpiRes<false> E{nullptr, (const _Float16*)F.out, (_Float16*)(ws + WS_H), (const float*)(ws + WS_MOD) + 5 * DM, F.in[I_BM2], F.in[I_LN1G], F.in[I_LN1B], (const float*)(ws + WS_MU1), (float*)(ws + WS_ST2)};
        pg8::gemm_phase<pg8::EpiRes<false>, pg8::StaticOrder, true, true>(F.lds, g, S, E);
        if (BOTH(8)) GRID_SYNC();
    }
    PB_END(9, F.lds);
    PB_START(10, F.lds);
    if (IN(9)) { { int t_ = threadIdx.x; asm volatile("" : "+v"(t_)); F.tid = t_; F.lane = t_ & 63; } ln_rows<true>(F); }
    PB_END(10, F.lds);
    if (PROBE_ID != 0 && blockIdx.x == 0 && threadIdx.x == 0) { const unsigned long long wait_ = *(volatile LAS unsigned long long*)(F.lds + PB_LDS_OFF), t0_ = __builtin_amdgcn_s_memrealtime();
        while (__builtin_amdgcn_s_memrealtime() - t0_ < wait_) __builtin_amdgcn_s_sleep(8); }
#undef IN
#undef BOTH
}

constexpr int N_PHASES = 10;
#ifndef MK_N_LAUNCHES
#define MK_N_LAUNCHES 1
#endif
extern "C" void kernel_launch(void* const* d_in, const int* in_sizes, int n_in, void* d_out, int out_size, void* d_ws, size_t ws_size, hipStream_t stream) {
    static int grid = 0;
    if (grid == 0) {
        if (n_in != 31 || in_sizes[0] != MTOK * DM || out_size != MTOK * DM || ws_size < WS_END) {
            fprintf(stderr, "kernel_launch: unexpected problem: n_in %d in0 %d out %d ws %zu (need %zu)\n", n_in, n_in > 0 ? in_sizes[0] : -1, out_size, ws_size, (size_t)WS_END); grid = -1; return; }
        int dev = 0, cus = 0, per_cu = 0;
        if (hipGetDevice(&dev) != hipSuccess || hipDeviceGetAttribute(&cus, hipDeviceAttributeMultiprocessorCount, dev) != hipSuccess) { grid = -1; return; }
        if (hipFuncSetAttribute((const void*)fwd_megakernel, hipFuncAttributeMaxDynamicSharedMemorySize, LDS_BYTES) != hipSuccess) { fprintf(stderr, "kernel_launch: hipFuncSetAttribute failed\n"); grid = -1; return; }
        if (hipOccupancyMaxActiveBlocksPerMultiprocessor(&per_cu, (const void*)fwd_megakernel, NWAVES * 64, LDS_BYTES) != hipSuccess || per_cu < 1) { fprintf(stderr, "kernel_launch: occupancy query says %d\n", per_cu); per_cu = 1; }
        (void)hipGetLastError();
        grid = cus;
    }
    if (grid < 0) return;
    if (hipMemsetAsync((char*)d_ws + WS_CTL, 0, CTL_ZERO_BYTES, stream) != hipSuccess) { fprintf(stderr, "kernel_launch: memset failed\n"); return; }
    Args a{};
    for (int i = 0; i < 31; ++i) a.in[i] = (const float*)d_in[i];
    a.out = (float*)d_out; a.ws = (unsigned char*)d_ws;
    if (MK_N_LAUNCHES == 1) {
        a.ph_lo = 0; a.ph_hi = N_PHASES;
        void* kargs[] = {&a};
        hipError_t e = hipLaunchCooperativeKernel((const void*)fwd_megakernel, dim3(grid), dim3(NWAVES * 64), kargs, LDS_BYTES, stream);
        if (e != hipSuccess) fprintf(stderr, "kernel_launch: cooperative launch failed: %s (grid %d)\n", hipGetErrorString(e), grid);
    } else {
        for (int p = 0; p < N_PHASES; ++p) { a.ph_lo = p; a.ph_hi = p + 1; hipLaunchKernelGGL(fwd_megakernel, dim3(grid), dim3(NWAVES * 64), LDS_BYTES, stream, a); }
    }
}
```

```cpp
#include <hip/hip_runtime.h>
#include <cstdio>
#include <cstdint>

#ifndef WGM_P2A
#define WGM_P2A 4
#endif
#ifndef WGM_P2B
#define WGM_P2B 4
#endif
#ifndef WGM_P4
#define WGM_P4 4
#endif
#ifndef WGM_P5
#define WGM_P5 4
#endif
#ifndef WGM_P7
#define WGM_P7 4
#endif
#ifndef WGM_P8
#define WGM_P8 4
#endif
#ifndef PROBE_ID
#define PROBE_ID 0
#endif
#define PB_LDS_OFF (163840 - 512 + 128)
#define PB_START(id, ldsp) do { if (PROBE_ID == (id) && blockIdx.x == 0 && threadIdx.x == 0) { *(volatile __attribute__((address_space(3))) unsigned long long*)((ldsp) + PB_LDS_OFF + 8) = __builtin_amdgcn_s_memrealtime(); } } while (0)
#define PB_END(id, ldsp) do { if (PROBE_ID == (id) && blockIdx.x == 0 && threadIdx.x == 0) { volatile __attribute__((address_space(3))) unsigned long long* pb_ = (volatile __attribute__((address_space(3))) unsigned long long*)((ldsp) + PB_LDS_OFF); pb_[0] += __builtin_amdgcn_s_memrealtime() - pb_[1]; } } while (0)
namespace pg8 {
#define PG8_LAS __attribute__((address_space(3)))
typedef unsigned short bf16_t;
typedef short bf16x8 __attribute__((ext_vector_type(8)));
typedef float f32x4 __attribute__((ext_vector_type(4)));
typedef unsigned u32x4 __attribute__((ext_vector_type(4)));
typedef float f32x2 __attribute__((ext_vector_type(2)));
constexpr int EPI_LDS_OFF = 131072;
constexpr int BM = 256, BK = 64, HALF = 128, HTB = HALF * BK * 2  , STAGE_BYTES = 8 * HTB, NXCD = 8, WGM = 8;

__host__ __device__ __forceinline__ int lds_byte(int r, int c) { const int st = (r >> 4) * 2 + (c >> 5), rr = r & 15, cc = c & 31, ob = rr * 64 + cc * 2; return st * 1024 + (ob ^ (((ob >> 9) & 1) << 5)); }
__host__ __device__ __forceinline__ void stage_rc(int b, int& R, int& C) { const int st = b / 1024, sb = b % 1024, swz = sb ^ (((sb >> 9) & 1) << 5); R = (st >> 1) * 16 + swz / 64; C = (st & 1) * 32 + (swz % 64) / 2; }
__host__ __device__ __forceinline__ int perm32(int rho) { const int n = rho >> 4, i = rho & 15; return 8 * (i >> 2) + 4 * n + (i & 3); }

struct Unit { int pm, pn; };
struct Gemm { const bf16_t* A; const bf16_t* Bt; int M, N, K; };

struct StaticOrder {
    int nM, nN, nwg, G, c, wgm;
    __host__ __device__ void init(int M, int N, int G_, int c_, int wgm_ = 4) { nM = M / BM; nN = N / BM; nwg = nM * nN; G = G_; c = c_; wgm = wgm_; }
    __host__ __device__ bool next(int i, Unit& u) const {
        const long L = (long)i * G + c; if (L >= nwg) return false;
        int wgid = (int)L; { const int q = nwg / NXCD, r = nwg % NXCD, xcd = wgid % NXCD, off = wgid / NXCD; wgid = (xcd < r ? xcd * (q + 1) : r * (q + 1) + (xcd - r) * q) + off; }
        const int nig = wgm * nN, gid = wgid / nig, fm = gid * wgm, gsz = (nM - fm) < wgm ? (nM - fm) : wgm;
        u.pm = fm + ((wgid % nig) % gsz); u.pn = (wgid % nig) / gsz; return true;
    }
    __device__ __forceinline__ void a_ready(const Unit&) const {}
    __device__ __forceinline__ void done(const Unit&) const {}
};

struct SwapOrder {
    int c, G;
    __host__ __device__ bool next(int i, Unit& u) const {
        if (G != 256) { const int L = i * G + c; if (L >= 1024) return false; u.pm = L & 15; u.pn = L >> 4; return true; }
        if (i >= 4) return false; const int x = c & 7, j = c >> 3; u.pm = 4 * i + (j & 3); u.pn = 8 * x + (j >> 2); return true; }
    __device__ __forceinline__ void a_ready(const Unit&) const {}
    __device__ __forceinline__ void done(const Unit&) const {}
};
__device__ __forceinline__ unsigned cvt_pk_bf16(float lo, float hi) { unsigned r; asm volatile("v_cvt_pk_bf16_f32 %0, %1, %2" : "=v"(r) : "v"(lo), "v"(hi)); return r; }
__device__ __forceinline__ f32x2 gelu_pk(f32x2 v) {
    const f32x2 av = __builtin_elementwise_abs(v), d = av * 0.2316418882f + 1.0f;
    f32x2 t; t.x = __builtin_amdgcn_rcpf(d.x); t.y = __builtin_amdgcn_rcpf(d.y);
    f32x2 q = t * 0.5307027145f + (-0.7265760135f); q = q * t + 0.7107068705f; q = q * t + (-0.142248368f); q = q * t + 0.127414796f; q = q * t;
    const f32x2 s = (v * v) * (-0.72134752044f);
    f32x2 e; e.x = __builtin_amdgcn_exp2f(s.x); e.y = __builtin_amdgcn_exp2f(s.y);
    const f32x2 m = v * (q * e), r = v - m;
    f32x2 o; o.x = v.x < 0.f ? m.x : r.x; o.y = v.y < 0.f ? m.y : r.y; return o;
}
__device__ __forceinline__ float bf_lo(unsigned w) { return __uint_as_float(w << 16); }
__device__ __forceinline__ float bf_hi(unsigned w) { return __uint_as_float(w & 0xffff0000u); }
__device__ __forceinline__ float sigmoid_f(float x) { return __builtin_amdgcn_rcpf(1.0f + __expf(-x)); }
}

constexpr int DM = 2048, NBATCH = 8, SEQ = 2048, MTOK = NBATCH * SEQ;
constexpr int SGUW = 1024, HYW = 1024, DFF = 8192, INW = 9216, MODW = 6 * DM;
constexpr float LN_EPS = 1e-5f;
constexpr float DN_ALPHA = 1.189207115002721f;

namespace pg8 {

struct EpiG1 {
    static constexpr bool PERM = true, AFTER_DRAIN = false, MID = false; static constexpr int SLOT_FLOATS = 256;
    bf16_t* U; bf16_t* G; const float* b_in;
    __device__ __forceinline__ void mid(f32x4 (&)[2][2][4][2], const Unit&, int, int, int, int) const {}
    __device__ __forceinline__ void preload(PG8_LAS float* slot, const Unit& u, int tid) const { if (tid < 256) slot[tid] = b_in[(u.pn < 4 ? u.pn * 256 : 5120 + (u.pn - 4) * 256) + tid]; }
    __device__ __forceinline__ void operator()(const f32x4 (&acc)[2][2][4][2], const Unit& u, int wr, int wc, int fr, int fq, const PG8_LAS float* slot) const {
        const int row0 = u.pm * BM + wr * 64 + fr; const int pn = u.pn;
        int ldc, colt; bf16_t* base; const bool isu = pn < 4;
        if (isu) { base = U; ldc = SGUW; colt = pn * 256; }
        else { base = G; ldc = 2 * DM; colt = (pn - 4) * 256; }
        const int cl = wc * 64 + 8 * fq;
        f32x4 bv[2][2];
#pragma unroll
        for (int bj = 0; bj < 2; ++bj)
#pragma unroll
            for (int n = 0; n < 2; ++n) bv[bj][n] = *(const PG8_LAS f32x4*)(slot + cl + bj * 32 + 4 * n);
#pragma unroll
        for (int ai = 0; ai < 2; ++ai)
#pragma unroll
            for (int m = 0; m < 4; ++m) {
                const int row = row0 + ai * HALF + m * 16;
                bf16_t* rowp = base + (size_t)row * ldc + colt + cl;
#pragma unroll
                for (int bj = 0; bj < 2; ++bj) {
                    f32x4 v0 = acc[ai][bj][m][0] + bv[bj][0], v1 = acc[ai][bj][m][1] + bv[bj][1];
                    if (isu) {
                        f32x2 a = gelu_pk((f32x2){v0[0], v0[1]}), b = gelu_pk((f32x2){v0[2], v0[3]}), c = gelu_pk((f32x2){v1[0], v1[1]}), d = gelu_pk((f32x2){v1[2], v1[3]});
                        v0 = (f32x4){a.x, a.y, b.x, b.y}; v1 = (f32x4){c.x, c.y, d.x, d.y};
                    } else {
                        v0 = (f32x4){sigmoid_f(v0[0]), sigmoid_f(v0[1]), sigmoid_f(v0[2]), sigmoid_f(v0[3])};
                        v1 = (f32x4){sigmoid_f(v1[0]), sigmoid_f(v1[1]), sigmoid_f(v1[2]), sigmoid_f(v1[3])};
                    }
                    u32x4 w; w.x = cvt_pk_bf16(v0[0], v0[1]); w.y = cvt_pk_bf16(v0[2], v0[3]); w.z = cvt_pk_bf16(v1[0], v1[1]); w.w = cvt_pk_bf16(v1[2], v1[3]);
                    *(u32x4*)(rowp + bj * 32) = w;
                }
            }
    }
};

struct EpiG1T {
    static constexpr bool PERM = true, AFTER_DRAIN = false, MID = false;
    bf16_t* VT; bf16_t* ZHT; const float* b_in; float* statsV; static constexpr int SLOT_FLOATS = 256;
    __device__ __forceinline__ void mid(f32x4 (&)[2][2][4][2], const Unit&, int, int, int, int) const {}
    __device__ __forceinline__ void preload(PG8_LAS float* slot, const Unit& u, int tid) const { if (tid < 256) slot[tid] = b_in[1024 + u.pm * 256 + tid]; }
    __device__ __forceinline__ void operator()(const f32x4 (&acc)[2][2][4][2], const Unit& u, int wr, int wc, int fr, int fq, const PG8_LAS float* slot) const {
        const int col0 = u.pn * BM + wc * 64 + 8 * fq; const bool isv = u.pm < 4;
        const int rowt = (isv ? u.pm : u.pm - 4) * BM + wr * 64 + fr;
        bf16_t* base = isv ? VT : ZHT;
#pragma unroll
        for (int ai = 0; ai < 2; ++ai) {
            float s[2][8], q[2][8];
#pragma unroll
            for (int bj = 0; bj < 2; ++bj)
#pragma unroll
                for (int e = 0; e < 8; ++e) { s[bj][e] = 0.f; q[bj][e] = 0.f; }
#pragma unroll
            for (int m = 0; m < 4; ++m) {
                const int row = rowt + ai * HALF + m * 16; const float bb = slot[wr * 64 + fr + ai * HALF + m * 16];
                bf16_t* rowp = base + (size_t)row * MTOK + col0;
#pragma unroll
                for (int bj = 0; bj < 2; ++bj) {
                    f32x4 v0 = acc[ai][bj][m][0] + bb, v1 = acc[ai][bj][m][1] + bb;
                    if (isv) {
                        f32x2 a = gelu_pk((f32x2){v0[0], v0[1]}), b = gelu_pk((f32x2){v0[2], v0[3]}), c = gelu_pk((f32x2){v1[0], v1[1]}), d = gelu_pk((f32x2){v1[2], v1[3]});
                        v0 = (f32x4){a.x, a.y, b.x, b.y}; v1 = (f32x4){c.x, c.y, d.x, d.y};
                    }
                    u32x4 w; w.x = cvt_pk_bf16(v0[0], v0[1]); w.y = cvt_pk_bf16(v0[2], v0[3]); w.z = cvt_pk_bf16(v1[0], v1[1]); w.w = cvt_pk_bf16(v1[2], v1[3]);
                    *(u32x4*)(rowp + bj * 32) = w;
                    if (isv) {
                        const float e0 = bf_lo(w.x), e1 = bf_hi(w.x), e2 = bf_lo(w.y), e3 = bf_hi(w.y), e4 = bf_lo(w.z), e5 = bf_hi(w.z), e6 = bf_lo(w.w), e7 = bf_hi(w.w);
                        s[bj][0] += e0; s[bj][1] += e1; s[bj][2] += e2; s[bj][3] += e3; s[bj][4] += e4; s[bj][5] += e5; s[bj][6] += e6; s[bj][7] += e7;
                        q[bj][0] += e0 * e0; q[bj][1] += e1 * e1; q[bj][2] += e2 * e2; q[bj][3] += e3 * e3; q[bj][4] += e4 * e4; q[bj][5] += e5 * e5; q[bj][6] += e6 * e6; q[bj][7] += e7 * e7;
                    }
                }
            }
            if (isv) {
                const int slot = u.pm * 4 + ai * 2 + wr;
#pragma unroll
                for (int bj = 0; bj < 2; ++bj)
#pragma unroll
                    for (int e = 0; e < 8; ++e) {
                        float a = s[bj][e], b = q[bj][e];
                        a += __shfl_xor(a, 1); b += __shfl_xor(b, 1); a += __shfl_xor(a, 2); b += __shfl_xor(b, 2);
                        a += __shfl_xor(a, 4); b += __shfl_xor(b, 4); a += __shfl_xor(a, 8); b += __shfl_xor(b, 8);
                        if (fr == 0) *(f32x2*)(statsV + ((size_t)(col0 + bj * 32 + e) * 16 + slot) * 2) = (f32x2){a, b};
                    }
            }
        }
    }
};

struct EpiG2 {
    static constexpr bool PERM = true, AFTER_DRAIN = false, MID = true;
    const bf16_t* G; bf16_t* O; static constexpr int SLOT_FLOATS = 0;
    __device__ __forceinline__ void preload(PG8_LAS float*, const Unit&, int) const {}
    __device__ __forceinline__ void mid(f32x4 (&acc)[2][2][4][2], const Unit& u, int wr, int wc, int fr, int fq) const {
        int row0 = u.pm * BM + wr * 64 + fr, col0 = u.pn * BM + wc * 64 + 8 * fq;
        asm volatile("" : "+v"(row0), "+v"(col0));
#pragma unroll
        for (int ai = 0; ai < 2; ++ai)
#pragma unroll
            for (int m = 0; m < 4; ++m) {
                const bf16_t* gp = G + (size_t)(row0 + ai * HALF + m * 16) * (2 * DM) + col0;
#pragma unroll
                for (int bj = 0; bj < 2; ++bj) {
                    const u32x4 ga = *(const u32x4*)(gp + bj * 32), gb = *(const u32x4*)(gp + DM + bj * 32);
                    f32x4 r0, r1;
                    r0[0] = bf_lo(ga.x) * __builtin_amdgcn_rcpf(bf_lo(gb.x)); r0[1] = bf_hi(ga.x) * __builtin_amdgcn_rcpf(bf_hi(gb.x));
                    r0[2] = bf_lo(ga.y) * __builtin_amdgcn_rcpf(bf_lo(gb.y)); r0[3] = bf_hi(ga.y) * __builtin_amdgcn_rcpf(bf_hi(gb.y));
                    r1[0] = bf_lo(ga.z) * __builtin_amdgcn_rcpf(bf_lo(gb.z)); r1[1] = bf_hi(ga.z) * __builtin_amdgcn_rcpf(bf_hi(gb.z));
                    r1[2] = bf_lo(ga.w) * __builtin_amdgcn_rcpf(bf_lo(gb.w)); r1[3] = bf_hi(ga.w) * __builtin_amdgcn_rcpf(bf_hi(gb.w));
                    acc[ai][bj][m][0] *= r0; acc[ai][bj][m][1] *= r1;
                }
            }
    }
    __device__ __forceinline__ void operator()(const f32x4 (&acc)[2][2][4][2], const Unit& u, int wr, int wc, int fr, int fq, const PG8_LAS float*) const {
        const int row0 = u.pm * BM + wr * 64 + fr, col0 = u.pn * BM + wc * 64 + 8 * fq;
#pragma unroll
        for (int ai = 0; ai < 2; ++ai)
#pragma unroll
            for (int m = 0; m < 4; ++m) {
                const int row = row0 + ai * HALF + m * 16;
                const bf16_t* gp = G + (size_t)row * (2 * DM) + DM + col0;
                bf16_t* op = O + (size_t)row * DM + col0;
#pragma unroll
                for (int bj = 0; bj < 2; ++bj) {
                    const u32x4 gb = *(const u32x4*)(gp + bj * 32);
                    const f32x4 a0 = acc[ai][bj][m][0], a1 = acc[ai][bj][m][1];
                    u32x4 w; w.x = cvt_pk_bf16(a0[0] * bf_lo(gb.x), a0[1] * bf_hi(gb.x)); w.y = cvt_pk_bf16(a0[2] * bf_lo(gb.y), a0[3] * bf_hi(gb.y));
                    w.z = cvt_pk_bf16(a1[0] * bf_lo(gb.z), a1[1] * bf_hi(gb.z)); w.w = cvt_pk_bf16(a1[2] * bf_lo(gb.w), a1[3] * bf_hi(gb.w));
                    *(u32x4*)(op + bj * 32) = w;
                }
            }
    }
};

typedef _Float16 f16x4 __attribute__((ext_vector_type(4)));
__device__ __forceinline__ f16x4 to_f16x4(f32x4 v) { return (f16x4){(_Float16)v[0], (_Float16)v[1], (_Float16)v[2], (_Float16)v[3]}; }
__device__ __forceinline__ f32x4 from_f16x4(f16x4 v) { return (f32x4){(float)v[0], (float)v[1], (float)v[2], (float)v[3]}; }
template <bool FIRST> struct EpiRes {
    static constexpr bool PERM = false, AFTER_DRAIN = false, MID = false; static constexpr int SLOT_FLOATS = FIRST ? 512 : 1024;
    const float* X;
    const _Float16* R16;
    _Float16* O16;
    const float* gate;
    const float* bias;
    const float* lng; const float* lnb; const float* MU;
    float* stats;
    __device__ __forceinline__ void mid(f32x4 (&)[2][2][4][2], const Unit&, int, int, int, int) const {}
    __device__ __forceinline__ void preload(PG8_LAS float* slot, const Unit& u, int tid) const {
        const int c = tid & 255, col = u.pn * BM + c;
        if (tid < 256) slot[c] = gate[(size_t)(u.pm >> 3) * MODW + col]; else slot[256 + c] = bias[col];
        if (!FIRST) { if (tid < 256) slot[512 + c] = DN_ALPHA * lng[col]; else slot[768 + c] = DN_ALPHA * lnb[col]; }
    }
    __device__ __forceinline__ void operator()(const f32x4 (&acc)[2][2][4][2], const Unit& u, int wr, int wc, int fr, int fq, const PG8_LAS float* slot) const {
        int row0 = u.pm * BM + wr * 64 + fr; const int cl = wc * 32 + 4 * fq; int col0 = u.pn * BM + cl;
        asm volatile("" : "+v"(row0), "+v"(col0));
        constexpr int RB = FIRST ? 2 : 1;
#pragma unroll
        for (int ab = 0; ab < 8 / RB; ++ab) {
            const int ai = (ab * RB) >> 2, mb = (ab * RB) & 3;
            f32x4 base[RB][2][2]; f16x4 b16[RB][2][2]; f32x2 mr[RB];
            int rowb = row0 + ai * HALF + mb * 16; asm volatile("" : "+v"(rowb));
#pragma unroll
            for (int mm = 0; mm < RB; ++mm) {
                const size_t off = (size_t)(rowb + mm * 16) * DM + col0;
                if (!FIRST) mr[mm] = *(const f32x2*)(MU + (size_t)(rowb + mm * 16) * 2);
#pragma unroll
                for (int bj = 0; bj < 2; ++bj)
#pragma unroll
                    for (int n = 0; n < 2; ++n) { if (FIRST) base[mm][bj][n] = *(const f32x4*)(X + off + bj * HALF + n * 16); else b16[mm][bj][n] = *(const f16x4*)(R16 + off + bj * HALF + n * 16); }
            }
#pragma unroll
            for (int mm = 0; mm < RB; ++mm) {
                const int m = mb + mm;
                const int row = rowb + mm * 16; _Float16* rp = O16 + (size_t)row * DM + col0;
                float s = 0.f, q = 0.f;
#pragma unroll
                for (int bj = 0; bj < 2; ++bj)
#pragma unroll
                    for (int n = 0; n < 2; ++n) {
                        const int co = bj * HALF + n * 16;
                        const f32x4 gv = *(const PG8_LAS f32x4*)(slot + cl + co), bv = *(const PG8_LAS f32x4*)(slot + 256 + cl + co);
                        f32x4 bs;
                        if (FIRST) bs = base[mm][bj][n] * DN_ALPHA;
                        else bs = (from_f16x4(b16[mm][bj][n]) - mr[mm].x) * mr[mm].y * *(const PG8_LAS f32x4*)(slot + 512 + cl + co) + *(const PG8_LAS f32x4*)(slot + 768 + cl + co);
                        const f16x4 oh = to_f16x4(bs + gv * (acc[ai][bj][m][n] + bv));
                        *(f16x4*)(rp + co) = oh;
                        const f32x4 o = from_f16x4(oh);
                        s += (o[0] + o[1]) + (o[2] + o[3]); q += (o[0] * o[0] + o[1] * o[1]) + (o[2] * o[2] + o[3] * o[3]);
                    }
                s += __shfl_xor(s, 16); s += __shfl_xor(s, 32); q += __shfl_xor(q, 16); q += __shfl_xor(q, 32);
                if (fq == 0) *(f32x2*)(stats + ((size_t)row * 32 + u.pn * 4 + wc) * 2) = (f32x2){s, q};
            }
            asm volatile("" ::: "memory");
        }
    }
};

struct EpiG4 {
    static constexpr bool PERM = true, AFTER_DRAIN = false, MID = false; static constexpr int SLOT_FLOATS = 256;
    bf16_t* O; const float* bias;
    __device__ __forceinline__ void mid(f32x4 (&)[2][2][4][2], const Unit&, int, int, int, int) const {}
    __device__ __forceinline__ void preload(PG8_LAS float* slot, const Unit& u, int tid) const { if (tid < 256) slot[tid] = bias[u.pn * BM + tid]; }
    __device__ __forceinline__ void operator()(const f32x4 (&acc)[2][2][4][2], const Unit& u, int wr, int wc, int fr, int fq, const PG8_LAS float* slot) const {
        const int row0 = u.pm * BM + wr * 64 + fr, cl = wc * 64 + 8 * fq, col0 = u.pn * BM + cl;
        f32x4 bv[2][2];
#pragma unroll
        for (int bj = 0; bj < 2; ++bj)
#pragma unroll
            for (int n = 0; n < 2; ++n) bv[bj][n] = *(const PG8_LAS f32x4*)(slot + cl + bj * 32 + 4 * n);
#pragma unroll
        for (int ai = 0; ai < 2; ++ai)
#pragma unroll
            for (int m = 0; m < 4; ++m) {
                bf16_t* rowp = O + (size_t)(row0 + ai * HALF + m * 16) * DFF + col0;
#pragma unroll
                for (int bj = 0; bj < 2; ++bj) {
                    f32x4 v0 = acc[ai][bj][m][0] + bv[bj][0], v1 = acc[ai][bj][m][1] + bv[bj][1];
                    v0 = __builtin_elementwise_max(v0, (f32x4){0.f, 0.f, 0.f, 0.f}); v1 = __builtin_elementwise_max(v1, (f32x4){0.f, 0.f, 0.f, 0.f});
                    v0 = v0 * v0; v1 = v1 * v1;
                    u32x4 w; w.x = cvt_pk_bf16(v0[0], v0[1]); w.y = cvt_pk_bf16(v0[2], v0[3]); w.z = cvt_pk_bf16(v1[0], v1[1]); w.w = cvt_pk_bf16(v1[2], v1[3]);
                    *(u32x4*)(rowp + bj * 32) = w;
                }
            }
    }
};
}
namespace pg8 {
template <class Epi, class Sched, bool ALIGN_EPI = false, bool SP2 = false>
__device__ __forceinline__ void gemm_phase(PG8_LAS unsigned char* lds, const Gemm g, const Sched& S, const Epi& E) {
    const int tid = threadIdx.x, wid = __builtin_amdgcn_readfirstlane(tid >> 6), lane = tid & 63, wr = wid >> 2, wc = wid & 3, fr = lane & 15, fq = lane >> 4;
    const int K = g.K, nt = K / BK;
    unsigned voffA[2], voffB[2];
#pragma unroll
    for (int i = 0; i < 2; ++i) { int R, C; stage_rc(tid * 16 + i * 8192, R, C); const int Rb = Epi::PERM ? ((R & ~31) + perm32(R & 31)) : R;
        const int Rw = Epi::PERM ? ((R >> 5) * 64 + perm32(R & 31)) : R;
        voffA[i] = (unsigned)(R * K + C) * 2u; voffB[i] = (unsigned)(Rw * K + C) * 2u; (void)Rb; }
    const size_t kstep = (size_t)(BK * 2);
    const size_t hstep = (size_t)HALF * K * 2;
    const size_t tstep = 2 * hstep;
    const size_t hstepB = Epi::PERM ? (size_t)32 * K * 2 : hstep;
    const unsigned ldsw = (unsigned)wid * 1024u;
    const int aoff = lds_byte(wr * 64 + fr, fq * 8), boff = lds_byte(wc * 32 + fr, fq * 8);
#define PG8_SA(b, h) (((b) * 2 + (h)) * HTB)
#define PG8_SB(b, h) ((4 + (b) * 2 + (h)) * HTB)
#define PG8_STAGE(bufoff, gbase, voff) do { _Pragma("unroll") for (int _i = 0; _i < 2; ++_i) \
        __builtin_amdgcn_global_load_lds((const unsigned*)((const char*)(gbase) + (voff)[_i]), (PG8_LAS unsigned*)(lds + (bufoff) + ldsw + _i * 8192), 16, 0, 0); } while (0)
#define PG8_LDA(dst, b, h) do { _Pragma("unroll") for (int m = 0; m < 4; ++m) _Pragma("unroll") for (int k = 0; k < 2; ++k) dst[m][k] = *(const PG8_LAS bf16x8*)(lds + PG8_SA(b, h) + aoff + m * 2048 + k * 1024); } while (0)
#define PG8_LDB(dst, b, h) do { _Pragma("unroll") for (int n = 0; n < 2; ++n) _Pragma("unroll") for (int k = 0; k < 2; ++k) dst[n][k] = *(const PG8_LAS bf16x8*)(lds + PG8_SB(b, h) + boff + n * 2048 + k * 1024); } while (0)
#define PG8_MMA(ai, bj, At, Bt) do { __builtin_amdgcn_s_setprio(1); _Pragma("unroll") for (int m = 0; m < 4; ++m) _Pragma("unroll") for (int n = 0; n < 2; ++n) _Pragma("unroll") for (int k = 0; k < 2; ++k) \
        acc[ai][bj][m][n] = __builtin_amdgcn_mfma_f32_16x16x32_bf16(Bt[n][k], At[m][k], acc[ai][bj][m][n], 0, 0, 0); __builtin_amdgcn_s_setprio(0); } while (0)
#define PG8_WAIT_V(n) asm volatile("s_waitcnt vmcnt(" #n ")" ::: "memory")
#define PG8_WAIT_L(n) asm volatile("s_waitcnt lgkmcnt(" #n ")" ::: "memory")
#define PG8_BAR __builtin_amdgcn_s_barrier()
#define PG8_SCHED __builtin_amdgcn_sched_barrier(0)
    Unit cur, nxt; int ui = 0;
    if (!S.next(0, cur)) return;
    {
        Unit pu; for (int i = 0; S.next(i, pu); ++i) E.preload((PG8_LAS float*)(lds + EPI_LDS_OFF) + i * Epi::SLOT_FLOATS, pu, tid);
        asm volatile("s_waitcnt vmcnt(0) lgkmcnt(0)" ::: "memory"); __builtin_amdgcn_s_barrier(); asm volatile("" ::: "memory");
    }
    f32x4 acc[2][2][4][2];
#pragma unroll
    for (int a = 0; a < 2; ++a)
#pragma unroll
        for (int b = 0; b < 2; ++b)
#pragma unroll
            for (int m = 0; m < 4; ++m)
#pragma unroll
                for (int n = 0; n < 2; ++n) acc[a][b][m][n] = (f32x4){0.f, 0.f, 0.f, 0.f};
    bf16x8 At[4][2], B0[2][2], B1[2][2];
    const char* cA = (const char*)g.A + (size_t)cur.pm * tstep; const char* cB = (const char*)g.Bt + (size_t)cur.pn * tstep;
    S.a_ready(cur);
    if constexpr (SP2) {
        PG8_STAGE(PG8_SB(0, 0), cB, voffB); PG8_STAGE(PG8_SB(0, 1), cB + hstepB, voffB); PG8_STAGE(PG8_SA(0, 0), cA, voffA); PG8_STAGE(PG8_SA(0, 1), cA + hstep, voffA);
        if (wr == 1) PG8_BAR;
        PG8_WAIT_V(2); PG8_BAR;
        PG8_STAGE(PG8_SB(1, 0), cB + kstep, voffB); PG8_STAGE(PG8_SA(1, 0), cA + kstep, voffA); PG8_STAGE(PG8_SB(1, 1), cB + hstepB + kstep, voffB);
        PG8_WAIT_V(6); PG8_BAR;
    } else {
        PG8_STAGE(PG8_SB(0, 0), cB, voffB); PG8_STAGE(PG8_SA(0, 0), cA, voffA); PG8_STAGE(PG8_SB(0, 1), cB + hstepB, voffB); PG8_STAGE(PG8_SA(0, 1), cA + hstep, voffA);
        if (wr == 1) PG8_BAR;
        PG8_WAIT_V(4); PG8_BAR;
        PG8_STAGE(PG8_SB(1, 0), cB + kstep, voffB); PG8_STAGE(PG8_SA(1, 0), cA + kstep, voffA); PG8_STAGE(PG8_SB(1, 1), cB + hstepB + kstep, voffB);
        PG8_WAIT_V(6); PG8_BAR;
    }
    for (;;) {
        const bool has_next = S.next(ui + 1, nxt);
        const char* nA = has_next ? (const char*)g.A + (size_t)nxt.pm * tstep : cA; const char* nB = has_next ? (const char*)g.Bt + (size_t)nxt.pn * tstep : cB;
        for (int t = 0; t < nt; t += 2) {
            const bool last = (t == nt - 2);
            const char* a1 = cA + (size_t)(t + 1) * kstep;
            const char* a2 = last ? nA : cA + (size_t)(t + 2) * kstep; const char* b2 = last ? nB : cB + (size_t)(t + 2) * kstep;
            const char* a3 = a2 + kstep; const char* b3 = b2 + kstep;
            if (last && has_next) S.a_ready(nxt);
            if constexpr (Epi::MID) { if (t == (nt >> 1)) E.mid(acc, cur, wr, wc, fr, fq); }
            if constexpr (SP2) {
            PG8_LDB(B0, 0, 0); PG8_LDB(B1, 0, 1); PG8_SCHED; PG8_LDA(At, 0, 0); PG8_STAGE(PG8_SA(1, 1), a1 + hstep, voffA);
            PG8_WAIT_V(8); PG8_WAIT_L(0); PG8_BAR; PG8_MMA(0, 0, At, B0); PG8_MMA(0, 1, At, B1); PG8_BAR; PG8_SCHED;
            PG8_LDA(At, 0, 1); PG8_STAGE(PG8_SB(0, 0), b2, voffB); PG8_STAGE(PG8_SB(0, 1), b2 + hstepB, voffB); PG8_STAGE(PG8_SA(0, 0), a2, voffA);
            PG8_WAIT_V(8); PG8_WAIT_L(0); PG8_BAR; PG8_MMA(1, 0, At, B0); PG8_MMA(1, 1, At, B1); PG8_BAR; PG8_SCHED;
            PG8_LDB(B0, 1, 0); PG8_LDB(B1, 1, 1); PG8_SCHED; PG8_LDA(At, 1, 0); PG8_STAGE(PG8_SA(0, 1), a2 + hstep, voffA);
            PG8_WAIT_V(8); PG8_WAIT_L(0); PG8_BAR; PG8_MMA(0, 0, At, B0); PG8_MMA(0, 1, At, B1); PG8_BAR; PG8_SCHED;
            PG8_LDA(At, 1, 1); PG8_STAGE(PG8_SB(1, 0), b3, voffB); PG8_STAGE(PG8_SB(1, 1), b3 + hstepB, voffB); PG8_STAGE(PG8_SA(1, 0), a3, voffA);
            PG8_WAIT_V(8); PG8_WAIT_L(0); PG8_BAR; PG8_MMA(1, 0, At, B0); PG8_MMA(1, 1, At, B1); PG8_BAR; PG8_SCHED;
            } else {
            PG8_LDB(B0, 0, 0); PG8_SCHED; PG8_LDA(At, 0, 0); PG8_STAGE(PG8_SA(1, 1), a1 + hstep, voffA);
            PG8_WAIT_L(8); PG8_BAR; PG8_WAIT_L(0); PG8_MMA(0, 0, At, B0); PG8_BAR; PG8_SCHED;
            PG8_LDB(B1, 0, 1); PG8_STAGE(PG8_SB(0, 0), b2, voffB);
            PG8_BAR; PG8_WAIT_L(0); PG8_MMA(0, 1, At, B1); PG8_BAR;
            PG8_LDA(At, 0, 1); PG8_STAGE(PG8_SA(0, 0), a2, voffA);
            PG8_BAR; PG8_WAIT_L(0); PG8_MMA(1, 0, At, B0); PG8_BAR; PG8_SCHED;
            PG8_STAGE(PG8_SB(0, 1), b2 + hstepB, voffB);
            PG8_WAIT_V(6); PG8_BAR; PG8_MMA(1, 1, At, B1); PG8_BAR;
            PG8_LDB(B0, 1, 0); PG8_SCHED; PG8_LDA(At, 1, 0); PG8_STAGE(PG8_SA(0, 1), a2 + hstep, voffA);
            PG8_WAIT_L(8); PG8_BAR; PG8_WAIT_L(0); PG8_MMA(0, 0, At, B0); PG8_BAR; PG8_SCHED;
            PG8_LDB(B1, 1, 1); PG8_STAGE(PG8_SB(1, 0), b3, voffB);
            PG8_BAR; PG8_WAIT_L(0); PG8_MMA(0, 1, At, B1); PG8_BAR;
            PG8_LDA(At, 1, 1); PG8_STAGE(PG8_SA(1, 0), a3, voffA);
            PG8_BAR; PG8_WAIT_L(0); PG8_MMA(1, 0, At, B0); PG8_BAR; PG8_SCHED;
            PG8_STAGE(PG8_SB(1, 1), b3 + hstepB, voffB);
            PG8_WAIT_V(6); PG8_BAR; PG8_MMA(1, 1, At, B1); PG8_BAR;
            }
        }
        if constexpr (ALIGN_EPI) { if (wr == 0) PG8_BAR; }
        if constexpr (!Epi::AFTER_DRAIN) { E(acc, cur, wr, wc, fr, fq, (const PG8_LAS float*)(lds + EPI_LDS_OFF) + ui * Epi::SLOT_FLOATS); S.done(cur); }
        if (!has_next) break;
#pragma unroll
        for (int a = 0; a < 2; ++a)
#pragma unroll
            for (int b = 0; b < 2; ++b)
#pragma unroll
                for (int m = 0; m < 4; ++m)
#pragma unroll
                    for (int n = 0; n < 2; ++n) acc[a][b][m][n] = (f32x4){0.f, 0.f, 0.f, 0.f};
        cur = nxt; cA = nA; cB = nB; ++ui;
        if constexpr (ALIGN_EPI) { if (wr == 1) PG8_BAR; }
    }
    PG8_WAIT_V(0);
    if constexpr (!ALIGN_EPI) { if (wr == 0) PG8_BAR; }
    PG8_BAR;
    if constexpr (Epi::AFTER_DRAIN) { E.fused(acc, cur, wr, wc, fr, fq, lds, wid, lane); S.done(cur); }
#undef PG8_SA
#undef PG8_SB
#undef PG8_STAGE
#undef PG8_LDA
#undef PG8_LDB
#undef PG8_MMA
#undef PG8_WAIT_V
#undef PG8_WAIT_L
#undef PG8_BAR
#undef PG8_SCHED
}
}

constexpr size_t MiB = 1u << 20;
constexpr size_t WS_CTL = 0;
constexpr size_t WS_MOD = 1 * MiB;
constexpr size_t WS_STV = 2 * MiB;
constexpr size_t WS_ST1 = 4 * MiB;
constexpr size_t WS_ST2 = 8 * MiB;
constexpr size_t WS_MU1 = 12 * MiB;
constexpr size_t WS_HID2 = 14 * MiB;
constexpr size_t WS_SGW = 13 * MiB;
constexpr size_t WS_WIN = 16 * MiB;
constexpr size_t WS_WAB = 52 * MiB;
constexpr size_t WS_WO = 60 * MiB;
constexpr size_t WS_FILT = 68 * MiB;
constexpr size_t WS_WM2 = 68 * MiB;
constexpr size_t WS_H = 100 * MiB;
constexpr size_t WS_U = 164 * MiB;
constexpr size_t WS_V = 196 * MiB;
constexpr size_t WS_MERGED = 164 * MiB;
constexpr size_t WS_ZHT = 228 * MiB;
constexpr size_t WS_G = 324 * MiB;
constexpr size_t WS_AFF = 164 * MiB;
constexpr size_t WS_WM1 = 420 * MiB;
constexpr size_t WS_YT = 452 * MiB;
constexpr size_t WS_END = 484 * MiB;

constexpr int NWAVES = 8;
constexpr int LDS_BYTES = 163840;

#define GAS __attribute__((address_space(1)))
#define LAS __attribute__((address_space(3)))
typedef unsigned short bf16;
typedef unsigned v4u __attribute__((ext_vector_type(4)));
typedef unsigned v2u __attribute__((ext_vector_type(2)));
typedef float f32x4 __attribute__((ext_vector_type(4)));
typedef float f32x2 __attribute__((ext_vector_type(2)));
#define LDS_WAIT() asm volatile("s_waitcnt lgkmcnt(0)" ::: "memory")

__device__ __forceinline__ unsigned f2bf(float f) { unsigned u = __builtin_bit_cast(unsigned, f); return (u + 0x7fffu + ((u >> 16) & 1u)) >> 16; }
__device__ __forceinline__ unsigned pk2(float lo, float hi) { return f2bf(lo) | (f2bf(hi) << 16); }
__device__ __forceinline__ float bflo(unsigned w) { return __uint_as_float(w << 16); }
__device__ __forceinline__ float bfhi(unsigned w) { return __uint_as_float(w & 0xffff0000u); }
__device__ __forceinline__ float bf1(bf16 h) { return __uint_as_float((unsigned)h << 16); }
__device__ __forceinline__ float wave_sum(float v) {
#pragma unroll
    for (int o = 1; o < 64; o <<= 1) v += __shfl_xor(v, o);
    return v;
}

struct Args { const float* in[31]; float* out; unsigned char* ws; int ph_lo, ph_hi; };

struct Frame {
    LAS unsigned char* lds;
    int tid, lane, wave, G;
    const float* const* in; float* out; unsigned char* ws;
};
enum { I_X = 0, I_C, I_WADA, I_BADA, I_WIN, I_BIN, I_SLNG, I_SLNB, I_SW, I_SB, I_HCW, I_HCB, I_HW1, I_HB1, I_HW2, I_HB2, I_HFREQ, I_HW3, I_HSKIP,
       I_WA, I_WB, I_WO, I_BO, I_LN1G, I_LN1B, I_WM1, I_BM1, I_WM2, I_BM2, I_LN2G, I_LN2B };

__device__ __forceinline__ void transpose_matrix(Frame& F, const float* W, int K, int N, bf16* WT, int ldk, int koff, int remap_win, int first, int nblocks) {
    LAS float* tile = (LAS float*)F.lds;
    const int tid = F.tid, nblk = N / 256, nitems = (K / 64) * nblk;
    const int lr = tid >> 6, lc = tid & 63;
    const int wc = tid & 7, wn = tid >> 3;
    for (int it = first; it < nitems; it += nblocks) {
        const int kb = it / nblk, nb = it % nblk, n0 = nb * 256, k0 = kb * 64; int row0 = n0;
        if (remap_win) row0 = (n0 < 1024) ? n0 : (n0 < 2048 ? n0 - 1024 + 5120 : (n0 < 5120 ? n0 - 2048 + 6144 : n0 - 5120 + 1024));
        f32x4 v[8];
#pragma unroll
        for (int i = 0; i < 8; ++i) v[i] = *(const f32x4*)(W + (size_t)(k0 + 8 * i + lr) * N + n0 + 4 * lc);
#pragma unroll
        for (int i = 0; i < 8; ++i) *(LAS f32x4*)(tile + (8 * i + lr) * 256 + ((lc ^ i) << 2)) = v[i];
        __syncthreads();
#pragma unroll
        for (int j = 0; j < 4; ++j) { const int n = wn + 64 * j; const LAS float* sp = tile + (8 * wc) * 256 + ((((n >> 2) ^ wc) << 2) | (n & 3));
            v4u o; o.x = pk2(sp[0 * 256], sp[1 * 256]); o.y = pk2(sp[2 * 256], sp[3 * 256]); o.z = pk2(sp[4 * 256], sp[5 * 256]); o.w = pk2(sp[6 * 256], sp[7 * 256]);
            *(GAS v4u*)(WT + (size_t)(row0 + n) * ldk + koff + k0 + 8 * wc) = o; }
        __syncthreads();
    }
}

__device__ __forceinline__ void p0_mod(Frame& F) {
    LAS float* condS = (LAS float*)F.lds;
    LAS float* red = (LAS float*)(F.lds + 65536);
    const float* c = F.in[I_C]; const float* w_ada = F.in[I_WADA]; const float* b_ada = F.in[I_BADA];
    float* mod = (float*)(F.ws + WS_MOD);
    const int tid = F.tid;
    for (int item = blockIdx.x; item < MODW / 48; item += F.G) {
        for (int i = tid; i < NBATCH * DM; i += NWAVES * 64) { const float v = c[i]; condS[i] = v / (1.0f + __expf(-v)); }
        __syncthreads();
        const int cq = tid % 12, kq = tid / 12, col0 = item * 48;
        if (kq < 32) {
            f32x4 acc[8];
#pragma unroll
            for (int b = 0; b < 8; ++b) acc[b] = (f32x4){0.f, 0.f, 0.f, 0.f};
            const float* wp = w_ada + (size_t)kq * MODW + col0 + cq * 4;
            for (int k = kq; k < DM; k += 256, wp += (size_t)256 * MODW) {
                f32x4 w[8];
#pragma unroll
                for (int u = 0; u < 8; ++u) w[u] = *(const f32x4*)(wp + (size_t)(32 * u) * MODW);
#pragma unroll
                for (int u = 0; u < 8; ++u)
#pragma unroll
                    for (int b = 0; b < 8; ++b) acc[b] += w[u] * condS[b * DM + k + 32 * u];
            }
#pragma unroll
            for (int b = 0; b < 8; ++b) *(LAS f32x4*)(red + (kq * 8 + b) * 48 + cq * 4) = acc[b];
        }
        __syncthreads();
        if (tid < 384) { const int b = tid / 48, col = tid % 48; float s = 0.f;
#pragma unroll 8
          for (int k2 = 0; k2 < 32; ++k2) s += red[(k2 * 8 + b) * 48 + col];
          mod[(size_t)b * MODW + col0 + col] = s + b_ada[col0 + col]; }
        __syncthreads();
    }
}

__device__ __forceinline__ void p0_hid2(Frame& F) {
    LAS float* scr = (LAS float*)F.lds + F.wave * 128;
    const float* w1 = F.in[I_HW1]; const float* b1 = F.in[I_HB1]; const float* w2 = F.in[I_HW2]; const float* b2 = F.in[I_HB2]; const float* freq = F.in[I_HFREQ];
    float* HID2 = (float*)(F.ws + WS_HID2);
    const int lane = F.lane;
    for (int l = blockIdx.x * NWAVES + F.wave; l < SEQ; l += F.G * NWAVES) {
        const float fr = freq[lane];
        const float tl = (float)l / (float)(SEQ - 1), omega = 6.283185307179586f * (float)l / (float)SEQ;
        float f = 0.f;
        if (lane == 0) f = tl;
        else if (lane <= 16) { const float band = 1e-4f + (float)(lane - 1) * ((15.0f - 1e-4f) / 15.0f); f = cosf(band * omega); }
        else if (lane <= 32) { const float band = 1e-4f + (float)(lane - 17) * ((15.0f - 1e-4f) / 15.0f); f = -sinf(band * omega); }
        scr[lane] = f; LDS_WAIT(); asm volatile("" ::: "memory");
        float a = b1[lane];
#pragma unroll 11
        for (int i = 0; i < 33; ++i) a += scr[i] * w1[i * 64 + lane];
        scr[64 + lane] = sinf(fr * a); LDS_WAIT(); asm volatile("" ::: "memory");
        a = b2[lane];
#pragma unroll 16
        for (int i = 0; i < 64; ++i) a += scr[64 + i] * w2[i * 64 + lane];
        HID2[(size_t)l * 64 + lane] = sinf(fr * a);
        LDS_WAIT(); asm volatile("" ::: "memory");
    }
}
typedef float fl_f32x16 __attribute__((ext_vector_type(16)));
__device__ __forceinline__ void p1_filter_waves(Frame& F) {
    const int fwl = F.wave - 4;
    LAS float* hS = (LAS float*)F.lds + fwl * (32 * 65);
    const float* w3 = F.in[I_HW3]; const float* HID2 = (const float*)(F.ws + WS_HID2);
    float* FILT = (float*)(F.ws + WS_FILT);
    const int lane = F.lane, r = lane & 31, h = lane >> 5;
    const float min_decay = -3.0701134573253943f, max_decay = -15.350567286626972f;
    for (int item = blockIdx.x * 4 + fwl; item < 1024; item += F.G * 4) {
        const int pb = item >> 4, cb = item & 15, pos0 = pb * 32, col0 = cb * 256;
        {
#pragma unroll
            for (int u = 0; u < 8; ++u) { const int e = (u * 64 + lane) * 4, p = e >> 6, k = e & 63; const f32x4 v = *(const f32x4*)(HID2 + (size_t)(pos0 + p) * 64 + k);
                hS[p * 65 + k] = v[0]; hS[p * 65 + k + 1] = v[1]; hS[p * 65 + k + 2] = v[2]; hS[p * 65 + k + 3] = v[3]; }
            LDS_WAIT(); asm volatile("" ::: "memory");
        }
        fl_f32x16 acc[8];
#pragma unroll
        for (int t = 0; t < 8; ++t)
#pragma unroll
            for (int e = 0; e < 16; ++e) acc[t][e] = 0.f;
        const float* wp = w3 + (size_t)h * 4096 + col0 + r;
#pragma unroll 2
        for (int s2 = 0; s2 < 32; ++s2) {
            const float a = hS[r * 65 + 2 * s2 + h];
            float b[8];
#pragma unroll
            for (int t = 0; t < 8; ++t) b[t] = wp[(size_t)(2 * s2) * 4096 + t * 32];
#pragma unroll
            for (int t = 0; t < 8; ++t) acc[t] = __builtin_amdgcn_mfma_f32_32x32x2f32(a, b[t], acc[t], 0, 0, 0);
        }
#pragma unroll
        for (int t = 0; t < 8; ++t) {
            const int j = col0 + t * 32 + r, ch = j & 1023; const float delta = fabsf(min_decay + (float)ch * ((max_decay - min_decay) / 1023.0f));
            float* op = FILT + (size_t)j * SEQ + pos0 + 4 * h;
#pragma unroll
            for (int g = 0; g < 4; ++g) {
                f32x4 o;
#pragma unroll
                for (int e = 0; e < 4; ++e) { const float tp = (float)(pos0 + 8 * g + 4 * h + e) / (float)(SEQ - 1); o[e] = acc[t][4 * g + e] * __expf(-tp * delta); }
                *(f32x4*)(op + 8 * g) = o;
            }
        }
        LDS_WAIT(); asm volatile("" ::: "memory");
    }
}

__device__ __forceinline__ void p1_modulate(Frame& F) {
    const float* x = F.in[I_X]; const float* mod = (const float*)(F.ws + WS_MOD); bf16* H = (bf16*)(F.ws + WS_H);
    const int vcu = (F.G == 256) ? (int)((blockIdx.x & 7) * 32 + (blockIdx.x >> 3)) : (int)blockIdx.x, rpb = MTOK / F.G;
    const int col = F.tid * 8;
    for (int r0 = vcu * rpb; r0 < vcu * rpb + rpb; r0 += 4) {
        f32x4 xa[4], xb[4];
#pragma unroll
        for (int u = 0; u < 4; ++u) { const float* xp = x + (size_t)(r0 + u) * DM + col; xa[u] = *(const f32x4*)xp; xb[u] = *(const f32x4*)(xp + 4); }
        const int b = r0 >> 11; const float* mp = mod + (size_t)b * MODW + col;
        const f32x4 sh0 = *(const f32x4*)mp, sh1 = *(const f32x4*)(mp + 4), sc0 = *(const f32x4*)(mp + DM), sc1 = *(const f32x4*)(mp + DM + 4);
#pragma unroll
        for (int u = 0; u < 4; ++u) {
            const f32x4 h0 = xa[u] * (sc0 + 1.0f) + sh0, h1 = xb[u] * (sc1 + 1.0f) + sh1;
            v4u o; o.x = pk2(h0[0], h0[1]); o.y = pk2(h0[2], h0[3]); o.z = pk2(h1[0], h1[1]); o.w = pk2(h1[2], h1[3]);
            *(v4u*)(H + (size_t)(r0 + u) * DM + col) = o; }
    }
}

typedef short sg_bf16x8 __attribute__((ext_vector_type(8)));
typedef float sg_f32x16 __attribute__((ext_vector_type(16)));
constexpr int SG_VT = 0, SG_LD = 136, SG_ST = 36864;
__device__ __forceinline__ void p3_sgu(Frame& F) {
    LAS bf16* vnT = (LAS bf16*)(F.lds + SG_VT); LAS float* stS = (LAS float*)(F.lds + SG_ST);
    const bf16* U = (const bf16*)(F.ws + WS_U); const bf16* VT = (const bf16*)(F.ws + WS_V); bf16* AB = (bf16*)(F.ws + WS_H);
    const bf16* Wb = (const bf16*)(F.ws + WS_SGW); const float* stv = (const float*)(F.ws + WS_STV);
    const float* lng = F.in[I_SLNG]; const float* lnb = F.in[I_SLNB]; const float* sb = F.in[I_SB];
    const int tid = F.tid, lane = F.lane, w = F.wave, r = lane & 31, h = lane >> 5;
    const int q0 = 32 * (w >> 1), ct0 = 2 * (w & 1);
    const int vcu0 = (F.G == 256) ? (int)((blockIdx.x & 7) * 32 + (blockIdx.x >> 3)) : (int)blockIdx.x;
    for (int item = vcu0; item < 1024; item += F.G) {
        const int itx = (F.G == 256) ? ((item & 255) >> 5) * 128 + (item >> 8) * 32 + (item & 31) : item;
        const int b = itx >> 7, n = (itx >> 3) & 15, g = itx & 7, tok0 = b * SEQ + n * 128;
        f32x2 pst[16];
        if (tid < 128) { const float* sp = stv + (size_t)(tok0 + tid) * 32;
#pragma unroll
            for (int i = 0; i < 16; ++i) pst[i] = *(const f32x2*)(sp + 2 * i); }
        const int c = tid >> 2, pseg = (tid & 3) * 32, ch = g * 128 + c;
        v4u wv[4];
        { const bf16* vp = VT + (size_t)ch * MTOK + tok0 + pseg;
#pragma unroll
          for (int k = 0; k < 4; ++k) wv[k] = *(const v4u*)(vp + 8 * k); }
        const float gg = lng[ch], bb = lnb[ch];
        sg_bf16x8 af[8];
#pragma unroll
        for (int kk = 0; kk < 8; ++kk) af[kk] = *(const sg_bf16x8*)(Wb + (size_t)(g * 128 + q0 + r) * 128 + 16 * kk + 8 * h);
        bf16 uu[2][16]; float sbv[16];
#pragma unroll
        for (int rg = 0; rg < 16; ++rg) { const int q = q0 + (rg & 3) + 8 * (rg >> 2) + 4 * h; sbv[rg] = sb[g * 128 + q];
#pragma unroll
            for (int ct = 0; ct < 2; ++ct) uu[ct][rg] = U[(size_t)(tok0 + q) * SGUW + g * 128 + (ct0 + ct) * 32 + r]; }
        if (tid < 128) { float s = 0.f, q = 0.f;
#pragma unroll
            for (int i = 0; i < 16; ++i) { s += pst[i].x; q += pst[i].y; }
            const float mean = s * (1.0f / 1024.0f); float var = q * (1.0f / 1024.0f) - mean * mean; var = var > 0.f ? var : 0.f;
            *(LAS f32x2*)(stS + 2 * tid) = (f32x2){mean, 1.0f / sqrtf(var + LN_EPS)}; }
        __syncthreads();
#pragma unroll
        for (int k = 0; k < 4; ++k) {
            const float e[8] = {bflo(wv[k].x), bfhi(wv[k].x), bflo(wv[k].y), bfhi(wv[k].y), bflo(wv[k].z), bfhi(wv[k].z), bflo(wv[k].w), bfhi(wv[k].w)};
            float o[8];
#pragma unroll
            for (int i = 0; i < 8; i += 2) { const f32x4 st = *(const LAS f32x4*)(stS + 2 * (pseg + 8 * k + i));
                o[i] = (e[i] - st[0]) * st[1] * gg + bb; o[i + 1] = (e[i + 1] - st[2]) * st[3] * gg + bb; }
            v4u pk; pk.x = pk2(o[0], o[1]); pk.y = pk2(o[2], o[3]); pk.z = pk2(o[4], o[5]); pk.w = pk2(o[6], o[7]);
            *(LAS v4u*)(vnT + c * SG_LD + pseg + 8 * k) = pk; }
        __syncthreads();
        sg_f32x16 acc[2];
#pragma unroll
        for (int ct = 0; ct < 2; ++ct)
#pragma unroll
            for (int i = 0; i < 16; ++i) acc[ct][i] = 0.f;
#pragma unroll
        for (int kk = 0; kk < 8; ++kk)
#pragma unroll
            for (int ct = 0; ct < 2; ++ct) {
                const sg_bf16x8 bf = *(const LAS sg_bf16x8*)(vnT + ((ct0 + ct) * 32 + r) * SG_LD + 16 * kk + 8 * h);
                acc[ct] = __builtin_amdgcn_mfma_f32_32x32x16_bf16(af[kk], bf, acc[ct], 0, 0, 0);
            }
#pragma unroll
        for (int ct = 0; ct < 2; ++ct) {
            const int cc = (ct0 + ct) * 32 + r;
#pragma unroll
            for (int rg = 0; rg < 16; ++rg) {
                const int q = q0 + (rg & 3) + 8 * (rg >> 2) + 4 * h;
                AB[(size_t)(tok0 + q) * DM + g * 128 + cc] = (bf16)f2bf(bf1(uu[ct][rg]) * (acc[ct][rg] + sbv[rg]));
            }
        }
        __syncthreads();
    }
}

__device__ __forceinline__ float sconv(const bf16* ZHT, const float* cw, const float* cb, int ch, int b, int t) {
    const bf16* zp = ZHT + (size_t)ch * MTOK + b * SEQ;
    const float z0 = t > 0 ? bf1(zp[t - 1]) : 0.f, z1 = bf1(zp[t]), z2 = t < SEQ - 1 ? bf1(zp[t + 1]) : 0.f;
    return cw[ch] * z0 + cw[3072 + ch] * z1 + cw[6144 + ch] * z2 + cb[ch];
}
__device__ __forceinline__ void p3_hyena(Frame& F) {
    LAS float* Us = (LAS float*)F.lds;
    LAS float* KF = (LAS float*)(F.lds + 65536);
    const bf16* ZHT = (const bf16*)(F.ws + WS_ZHT); const float* FILT = (const float*)(F.ws + WS_FILT); bf16* AB = (bf16*)(F.ws + WS_H);
    const float* cw = F.in[I_HCW]; const float* cb = F.in[I_HCB]; const float* skip = F.in[I_HSKIP];
    const int tid = F.tid;
    for (int item = blockIdx.x; item < HYW; item += F.G) {
        const int c = item;
        for (int i = tid; i < NBATCH * SEQ; i += NWAVES * 64) { const int b = i >> 11, t = i & 2047; Us[t * 8 + b] = sconv(ZHT, cw, cb, c, b, t); }
        for (int n = 0; n < 2; ++n) {
            const float* hf = FILT + (size_t)((0 * 2 + n) * 1024 + c) * SEQ; const float* hb = FILT + (size_t)((1 * 2 + n) * 1024 + c) * SEQ;
            for (int i = tid; i < 4095; i += NWAVES * 64) { const int lag = i - 2047; KF[i] = lag > 0 ? hf[lag] : (lag == 0 ? hf[0] + hb[0] : hb[-lag]); }
            __syncthreads();
            f32x4 acc[4][2];
#pragma unroll
            for (int ti = 0; ti < 4; ++ti) { acc[ti][0] = (f32x4){0.f, 0.f, 0.f, 0.f}; acc[ti][1] = (f32x4){0.f, 0.f, 0.f, 0.f}; }
            const LAS float* kp = KF + tid + 2047;
            for (int s = 0; s < SEQ; ++s) {
                const f32x4 u0 = *(const LAS f32x4*)(Us + s * 8), u1 = *(const LAS f32x4*)(Us + s * 8 + 4);
#pragma unroll
                for (int ti = 0; ti < 4; ++ti) { const float kv = kp[512 * ti - s]; acc[ti][0] += u0 * kv; acc[ti][1] += u1 * kv; }
            }
            __syncthreads();
            const float sk = skip[n * 1024 + c];
#pragma unroll
            for (int ti = 0; ti < 4; ++ti) { const int t = tid + 512 * ti;
#pragma unroll
                for (int b = 0; b < 8; ++b) {
                    const float uv = Us[t * 8 + b], gate = sconv(ZHT, cw, cb, (n + 1) * 1024 + c, b, t);
                    const float y = gate * (acc[ti][b >> 2][b & 3] + sk * uv);
                    if (n == 0) Us[t * 8 + b] = y; else AB[(size_t)(b * SEQ + t) * DM + 1024 + c] = (bf16)f2bf(y);
                } }
            __syncthreads();
        }
    }
}

#ifndef HYFFT_HD
#define HYFFT_HD __device__ __forceinline__
#define HYFFT_LAS __attribute__((address_space(3)))
#endif
typedef float hy_c32 __attribute__((ext_vector_type(2)));
HYFFT_HD int hy_padi(int i) { return i + (i >> 3); }
HYFFT_HD int hy_rev(int x) { return ((x & 7) << 9) | (((x >> 3) & 7) << 6) | (((x >> 6) & 7) << 3) | ((x >> 9) & 7); }

template <bool INV> HYFFT_HD void hy_dft8(float (&re)[8], float (&im)[8]) {
    const float h = 0.70710678118654752f;
    float ar[4], ai[4], br[4], bi[4];
#pragma unroll
    for (int m = 0; m < 4; ++m) { ar[m] = re[m] + re[m + 4]; ai[m] = im[m] + im[m + 4]; br[m] = re[m] - re[m + 4]; bi[m] = im[m] - im[m + 4]; }
    { float x = br[1], y = bi[1]; if (!INV) { br[1] = h * (x + y); bi[1] = h * (y - x); } else { br[1] = h * (x - y); bi[1] = h * (y + x); } }
    { float x = br[2], y = bi[2]; if (!INV) { br[2] = y; bi[2] = -x; } else { br[2] = -y; bi[2] = x; } }
    { float x = br[3], y = bi[3]; if (!INV) { br[3] = h * (y - x); bi[3] = -h * (x + y); } else { br[3] = -h * (x + y); bi[3] = h * (x - y); } }
#pragma unroll
    for (int s = 0; s < 2; ++s) {
        float* cr = s ? br : ar; float* ci = s ? bi : ai;
        const float e0r = cr[0] + cr[2], e0i = ci[0] + ci[2], e1r = cr[0] - cr[2], e1i = ci[0] - ci[2];
        const float o0r = cr[1] + cr[3], o0i = ci[1] + ci[3]; const float dr = cr[1] - cr[3], di = ci[1] - ci[3];
        float o1r, o1i; if (!INV) { o1r = di; o1i = -dr; } else { o1r = -di; o1i = dr; }
        re[0 + s] = e0r + o0r; im[0 + s] = e0i + o0i;
        re[2 + s] = e1r + o1r; im[2 + s] = e1i + o1i;
        re[4 + s] = e0r - o0r; im[4 + s] = e0i - o0i;
        re[6 + s] = e1r - o1r; im[6 + s] = e1i - o1i;
    }
}
template <bool CONJ> HYFFT_HD void hy_twiddle(float (&re)[8], float (&im)[8], float wr, float wi) {
    if (CONJ) wi = -wi;
    const float w2r = wr * wr - wi * wi, w2i = 2.f * wr * wi;
    const float w3r = w2r * wr - w2i * wi, w3i = w2r * wi + w2i * wr;
    const float w4r = w2r * w2r - w2i * w2i, w4i = 2.f * w2r * w2i;
    const float w5r = w4r * wr - w4i * wi, w5i = w4r * wi + w4i * wr;
    const float w6r = w3r * w3r - w3i * w3i, w6i = 2.f * w3r * w3i;
    const float w7r = w4r * w3r - w4i * w3i, w7i = w4r * w3i + w4i * w3r;
    const float pr[8] = {1.f, wr, w2r, w3r, w4r, w5r, w6r, w7r}, pi[8] = {0.f, wi, w2i, w3i, w4i, w5i, w6i, w7i};
#pragma unroll
    for (int k = 1; k < 8; ++k) { const float x = re[k], y = im[k]; re[k] = x * pr[k] - y * pi[k]; im[k] = x * pi[k] + y * pr[k]; }
}
template <int L, class BP, class TP> HYFFT_HD void hy_fwd_store(BP buf, TP tw, int j, float (&re)[8], float (&im)[8]) {
    constexpr int S = L / 8; const int blk = j / S, q = j % S, base = blk * L + q;
    hy_dft8<false>(re, im);
    if (L > 8) { const hy_c32 w = tw[q * (4096 / L)]; hy_twiddle<false>(re, im, w.x, w.y); }
#pragma unroll
    for (int k = 0; k < 8; ++k) buf[hy_padi(base + k * S)] = (hy_c32){re[k], im[k]};
}
template <int L, class BP> HYFFT_HD void hy_load8(BP buf, int j, float (&re)[8], float (&im)[8]) {
    constexpr int S = L / 8; const int blk = j / S, q = j % S, base = blk * L + q;
#pragma unroll
    for (int k = 0; k < 8; ++k) { const hy_c32 v = buf[hy_padi(base + k * S)]; re[k] = v.x; im[k] = v.y; }
}
template <int L, class BP, class TP> HYFFT_HD void hy_fwd_stage(BP buf, TP tw, int j) { float re[8], im[8]; hy_load8<L>(buf, j, re, im); hy_fwd_store<L>(buf, tw, j, re, im); }
template <int L, class BP, class TP> HYFFT_HD void hy_inv_regs(BP buf, TP tw, int j, float (&re)[8], float (&im)[8]) {
    constexpr int S = L / 8; const int q = j % S;
    hy_load8<L>(buf, j, re, im);
    if (L > 8) { const hy_c32 w = tw[q * (4096 / L)]; hy_twiddle<true>(re, im, w.x, w.y); }
    hy_dft8<true>(re, im);
}
template <int L, class BP, class TP> HYFFT_HD void hy_inv_stage(BP buf, TP tw, int j) {
    constexpr int S = L / 8; const int blk = j / S, q = j % S, base = blk * L + q;
    float re[8], im[8]; hy_inv_regs<L>(buf, tw, j, re, im);
#pragma unroll
    for (int k = 0; k < 8; ++k) buf[hy_padi(base + k * S)] = (hy_c32){re[k], im[k]};
}
template <class BP, class KP> HYFFT_HD void hy_mid_stage(BP buf, KP K, int j) {
    float re[8], im[8]; hy_load8<8>(buf, j, re, im);
    hy_dft8<false>(re, im);
#pragma unroll
    for (int k = 0; k < 8; ++k) { const hy_c32 kv = K[hy_padi(8 * j + k)]; const float x = re[k], y = im[k]; re[k] = x * kv.x - y * kv.y; im[k] = x * kv.y + y * kv.x; }
    hy_dft8<true>(re, im);
#pragma unroll
    for (int k = 0; k < 8; ++k) buf[hy_padi(8 * j + k)] = (hy_c32){re[k], im[k]};
}
template <class BP> HYFFT_HD void hy_last_fwd(BP buf, int j) {
    float re[8], im[8]; hy_load8<8>(buf, j, re, im); hy_dft8<false>(re, im);
#pragma unroll
    for (int k = 0; k < 8; ++k) buf[hy_padi(8 * j + k)] = (hy_c32){re[k], im[k]};
}
template <class BP, class KP> HYFFT_HD void hy_separate(BP Z, KP K1, KP K2, int j) {
    const float sc = 0.5f / 4096.0f;
#pragma unroll
    for (int r = 0; r < 8; ++r) {
        const int p = j + 512 * r, f = hy_rev(p), g = (4096 - f) & 4095, p2 = hy_rev(g);
        const hy_c32 a = Z[hy_padi(p)], b = Z[hy_padi(p2)];
        K1[hy_padi(p)] = (hy_c32){(a.x + b.x) * sc, (a.y - b.y) * sc};
        K2[hy_padi(p)] = (hy_c32){(a.y + b.y) * sc, (b.x - a.x) * sc};
    }
}

struct Raw3 { bf16 a, b, c; };
__device__ __forceinline__ Raw3 raw3(const bf16* zp, int t) { const bf16* p = zp + t; Raw3 r; r.a = p[-1]; r.b = p[0]; r.c = p[1]; return r; }
template <bool M0, bool M7> __device__ __forceinline__ float sconv_raw(const Raw3& r, int t, float w0, float w1, float w2, float cb) {
    float z0 = bf1(r.a), z2 = bf1(r.c); const float z1 = bf1(r.b);
    if (M0) z0 = t > 0 ? z0 : 0.f;
    if (M7) z2 = t < SEQ - 1 ? z2 : 0.f;
    return w0 * z0 + w1 * z1 + w2 * z2 + cb;
}
__device__ __forceinline__ float sconv_raw_m(int m, const Raw3& r, int t, float w0, float w1, float w2, float cb) {
    return m == 0 ? sconv_raw<true, false>(r, t, w0, w1, w2, cb) : (m == 7 ? sconv_raw<false, true>(r, t, w0, w1, w2, cb) : sconv_raw<false, false>(r, t, w0, w1, w2, cb));
}
HYFFT_HD int hy16_padi(int i) { return i + (i >> 4); }
HYFFT_HD int hy16_rev(int x) { return ((x & 15) << 8) | (x & 0xF0) | ((x >> 8) & 15); }
template <bool INV> HYFFT_HD void hy16_dft4(float& r0, float& i0, float& r1, float& i1, float& r2, float& i2, float& r3, float& i3) {
    const float e0r = r0 + r2, e0i = i0 + i2, e1r = r0 - r2, e1i = i0 - i2, o0r = r1 + r3, o0i = i1 + i3, dr = r1 - r3, di = i1 - i3;
    float o1r, o1i; if (!INV) { o1r = di; o1i = -dr; } else { o1r = -di; o1i = dr; }
    r0 = e0r + o0r; i0 = e0i + o0i; r1 = e1r + o1r; i1 = e1i + o1i; r2 = e0r - o0r; i2 = e0i - o0i; r3 = e1r - o1r; i3 = e1i - o1i;
}
template <bool INV> HYFFT_HD void hy16_cmulc(float& r, float& i, float cr, float ci) { if (INV) ci = -ci; const float x = r, y = i; r = x * cr - y * ci; i = x * ci + y * cr; }
template <bool INV> HYFFT_HD void hy16_dft16(float (&re)[16], float (&im)[16]) {
    const float c1 = 0.92387953251128674f, s1 = 0.38268343236508977f, h = 0.70710678118654752f;
#pragma unroll
    for (int m2 = 0; m2 < 4; ++m2) hy16_dft4<INV>(re[m2], im[m2], re[4 + m2], im[4 + m2], re[8 + m2], im[8 + m2], re[12 + m2], im[12 + m2]);
    hy16_cmulc<INV>(re[4 * 1 + 1], im[4 * 1 + 1], c1, -s1);
    hy16_cmulc<INV>(re[4 * 2 + 1], im[4 * 2 + 1], h, -h);
    hy16_cmulc<INV>(re[4 * 3 + 1], im[4 * 3 + 1], s1, -c1);
    hy16_cmulc<INV>(re[4 * 1 + 2], im[4 * 1 + 2], h, -h);
    hy16_cmulc<INV>(re[4 * 2 + 2], im[4 * 2 + 2], 0.f, -1.f);
    hy16_cmulc<INV>(re[4 * 3 + 2], im[4 * 3 + 2], -h, -h);
    hy16_cmulc<INV>(re[4 * 1 + 3], im[4 * 1 + 3], s1, -c1);
    hy16_cmulc<INV>(re[4 * 2 + 3], im[4 * 2 + 3], -h, -h);
    hy16_cmulc<INV>(re[4 * 3 + 3], im[4 * 3 + 3], -c1, s1);
#pragma unroll
    for (int k1 = 0; k1 < 4; ++k1) hy16_dft4<INV>(re[4 * k1], im[4 * k1], re[4 * k1 + 1], im[4 * k1 + 1], re[4 * k1 + 2], im[4 * k1 + 2], re[4 * k1 + 3], im[4 * k1 + 3]);
#pragma unroll
    for (int a = 0; a < 4; ++a)
#pragma unroll
        for (int b = a + 1; b < 4; ++b) { float t = re[4 * a + b]; re[4 * a + b] = re[4 * b + a]; re[4 * b + a] = t; t = im[4 * a + b]; im[4 * a + b] = im[4 * b + a]; im[4 * b + a] = t; }
}
template <bool CONJ> HYFFT_HD void hy16_twiddle(float (&re)[16], float (&im)[16], float wr, float wi) {
    if (CONJ) wi = -wi;
    float pr[16], pi[16]; pr[1] = wr; pi[1] = wi;
#define HY16_SQ(d, a) pr[d] = pr[a] * pr[a] - pi[a] * pi[a]; pi[d] = 2.f * pr[a] * pi[a];
#define HY16_MUL(d, a, b) pr[d] = pr[a] * pr[b] - pi[a] * pi[b]; pi[d] = pr[a] * pi[b] + pi[a] * pr[b];
    HY16_SQ(2, 1) HY16_MUL(3, 2, 1) HY16_SQ(4, 2) HY16_MUL(5, 4, 1) HY16_SQ(6, 3) HY16_MUL(7, 4, 3) HY16_SQ(8, 4)
    HY16_MUL(9, 8, 1) HY16_SQ(10, 5) HY16_MUL(11, 8, 3) HY16_SQ(12, 6) HY16_MUL(13, 8, 5) HY16_SQ(14, 7) HY16_MUL(15, 8, 7)
#undef HY16_SQ
#undef HY16_MUL
#pragma unroll
    for (int k = 1; k < 16; ++k) { const float x = re[k], y = im[k]; re[k] = x * pr[k] - y * pi[k]; im[k] = x * pi[k] + y * pr[k]; }
}
template <int L, class BP> HYFFT_HD void hy16_load(BP buf, int jj, float (&re)[16], float (&im)[16]) {
    constexpr int S = L / 16; const int blk = jj / S, q = jj % S, pb = hy16_padi(blk * L + q);
#pragma unroll
    for (int k = 0; k < 16; ++k) { const hy_c32 v = buf[pb + k * (S + S / 16)]; re[k] = v.x; im[k] = v.y; }
}
template <class BP> HYFFT_HD void hy16_load1(BP buf, int jj, float (&re)[16], float (&im)[16]) {
#pragma unroll
    for (int k = 0; k < 16; ++k) { const hy_c32 v = buf[17 * jj + k]; re[k] = v.x; im[k] = v.y; }
}
template <int L, class BP> HYFFT_HD void hy16_store(BP buf, int jj, const float (&re)[16], const float (&im)[16]) {
    constexpr int S = L / 16; const int blk = jj / S, q = jj % S, pb = hy16_padi(blk * L + q);
#pragma unroll
    for (int k = 0; k < 16; ++k) buf[pb + k * (S + S / 16)] = (hy_c32){re[k], im[k]};
}
template <class BP> HYFFT_HD void hy16_store1(BP buf, int jj, const float (&re)[16], const float (&im)[16]) {
#pragma unroll
    for (int k = 0; k < 16; ++k) buf[17 * jj + k] = (hy_c32){re[k], im[k]};
}
template <int L, class BP, class TP> HYFFT_HD void hy16_fwd_store(BP buf, TP tw, int jj, float (&re)[16], float (&im)[16]) {
    constexpr int S = L / 16; const int q = jj % S;
    hy16_dft16<false>(re, im);
    { const hy_c32 w = tw[q * (4096 / L)]; hy16_twiddle<false>(re, im, w.x, w.y); }
    hy16_store<L>(buf, jj, re, im);
}
template <int L, class BP, class TP> HYFFT_HD void hy16_fwd_stage(BP buf, TP tw, int jj) { float re[16], im[16]; hy16_load<L>(buf, jj, re, im); hy16_fwd_store<L>(buf, tw, jj, re, im); }
template <int L, class BP, class TP> HYFFT_HD void hy16_inv_regs(BP buf, TP tw, int jj, float (&re)[16], float (&im)[16]) {
    constexpr int S = L / 16; const int q = jj % S;
    hy16_load<L>(buf, jj, re, im);
    { const hy_c32 w = tw[q * (4096 / L)]; hy16_twiddle<true>(re, im, w.x, w.y); }
    hy16_dft16<true>(re, im);
}
template <int L, class BP, class TP> HYFFT_HD void hy16_inv_stage(BP buf, TP tw, int jj) { float re[16], im[16]; hy16_inv_regs<L>(buf, tw, jj, re, im); hy16_store<L>(buf, jj, re, im); }
template <class BP, class KP> HYFFT_HD void hy16_mid_stage(BP buf, KP K, int jj) {
    float re[16], im[16]; hy16_load1(buf, jj, re, im);
    hy16_dft16<false>(re, im);
#pragma unroll
    for (int k = 0; k < 16; ++k) { const hy_c32 kv = K[17 * jj + k]; const float x = re[k], y = im[k]; re[k] = x * kv.x - y * kv.y; im[k] = x * kv.y + y * kv.x; }
    hy16_dft16<true>(re, im);
    hy16_store1(buf, jj, re, im);
}
template <class BP> HYFFT_HD void hy16_last_fwd(BP buf, int jj) { float re[16], im[16]; hy16_load1(buf, jj, re, im); hy16_dft16<false>(re, im); hy16_store1(buf, jj, re, im); }
template <class BP, class KP> HYFFT_HD void hy16_separate(BP Z, KP K1, KP K2, int t) {
    const float sc = 0.5f / 4096.0f;
#pragma unroll
    for (int r = 0; r < 8; ++r) {
        const int p = t + 512 * r, f = hy16_rev(p), g = (4096 - f) & 4095, p2 = hy16_rev(g);
        const hy_c32 a = Z[hy16_padi(p)], b = Z[hy16_padi(p2)];
        K1[hy16_padi(p)] = (hy_c32){(a.x + b.x) * sc, (a.y - b.y) * sc};
        K2[hy16_padi(p)] = (hy_c32){(a.y + b.y) * sc, (b.x - a.x) * sc};
    }
}
__device__ __forceinline__ void p3_hyena_fft(Frame& F) {
    const int tid0 = F.tid;
    const int half = __builtin_amdgcn_readfirstlane(tid0 >> 8);
    LAS hy_c32* BUF = (LAS hy_c32*)(F.lds + half * 34816);
    LAS hy_c32* B0 = (LAS hy_c32*)(F.lds + 0);
    LAS hy_c32* K1 = (LAS hy_c32*)(F.lds + 69632); LAS hy_c32* K2 = (LAS hy_c32*)(F.lds + 104448); LAS hy_c32* TW = (LAS hy_c32*)(F.lds + 139264);
    const bf16* ZHT = (const bf16*)(F.ws + WS_ZHT); const float* FILT = (const float*)(F.ws + WS_FILT); bf16* YT = (bf16*)(F.ws + WS_YT);
    const float* cw = F.in[I_HCW]; const float* cb = F.in[I_HCB]; const float* skip = F.in[I_HSKIP];
    if (tid0 < 256) { float sn, cs; sincosf(-6.283185307179586f * (float)tid0 / 4096.0f, &sn, &cs); TW[tid0] = (hy_c32){cs, sn}; }
    __syncthreads();
    for (int item = blockIdx.x; item < HYW; item += F.G) {
        const int c = item;
        int tid = tid0; asm volatile("" : "+v"(tid));
        int jj = tid & 255;
        float re[16], im[16];
        const bf16* zv = ZHT + (size_t)c * MTOK; const bf16* za = ZHT + (size_t)(1024 + c) * MTOK; const bf16* zb = ZHT + (size_t)(2048 + c) * MTOK;
        {
            if (half == 0) {
                const float* hf0 = FILT + (size_t)(0 * 1024 + c) * SEQ; const float* hf1 = FILT + (size_t)(1 * 1024 + c) * SEQ;
                const float* hb0 = FILT + (size_t)(2 * 1024 + c) * SEQ; const float* hb1 = FILT + (size_t)(3 * 1024 + c) * SEQ;
#pragma unroll
                for (int m = 0; m < 8; ++m) { const int i = jj + 256 * m; re[m] = hf0[i]; im[m] = hf1[i]; }
                if (jj == 0) { re[0] += hb0[0]; im[0] += hb1[0]; }
#pragma unroll
                for (int m = 8; m < 16; ++m) { const int i = jj + 256 * m; const bool z = (i == 2048); const int r = z ? 0 : 4096 - i; const float a = hb0[r], b = hb1[r]; re[m] = z ? 0.f : a; im[m] = z ? 0.f : b; }
                hy16_fwd_store<4096>(B0, TW, jj, re, im);
            }
            __syncthreads();
            if (half == 0) hy16_fwd_stage<256>(B0, TW, jj);
            __syncthreads();
            if (half == 0) hy16_last_fwd(B0, jj);
            __syncthreads();
            hy16_separate(B0, K1, K2, tid); __syncthreads();
        }
        const float vw0 = cw[c], vw1 = cw[3072 + c], vw2 = cw[6144 + c], vcb = cb[c];
        const float aw0 = cw[1024 + c], aw1 = cw[3072 + 1024 + c], aw2 = cw[6144 + 1024 + c], acb = cb[1024 + c];
        const float bw0 = cw[2048 + c], bw1 = cw[3072 + 2048 + c], bw2 = cw[6144 + 2048 + c], bcb = cb[2048 + c];
        const float sk0 = skip[c], sk1 = skip[1024 + c];
#pragma unroll 1
        for (int rd = 0; rd < 2; ++rd) {
            const int boff = (4 * rd + 2 * half) * SEQ;
            asm volatile("" : "+v"(jj));
            Raw3 rg[2][8];
            float v[2][8];
#pragma unroll
            for (int m = 0; m < 8; ++m) { const int t = jj + 256 * m;
                const Raw3 r0 = raw3(zv + boff, t), r1 = raw3(zv + boff + SEQ, t); v[0][m] = sconv_raw_m(m, r0, t, vw0, vw1, vw2, vcb); v[1][m] = sconv_raw_m(m, r1, t, vw0, vw1, vw2, vcb); }
#pragma unroll
            for (int m = 0; m < 8; ++m) { re[m] = v[0][m]; im[m] = v[1][m]; re[m + 8] = 0.f; im[m + 8] = 0.f; }
            hy16_fwd_store<4096>(BUF, TW, jj, re, im); __syncthreads();
            hy16_fwd_stage<256>(BUF, TW, jj); __syncthreads();
            hy16_mid_stage(BUF, K1, jj); __syncthreads();
#pragma unroll
            for (int m = 0; m < 8; ++m) { const int t = jj + 256 * m; rg[0][m] = raw3(za + boff, t); rg[1][m] = raw3(za + boff + SEQ, t); }
            hy16_inv_stage<256>(BUF, TW, jj); __syncthreads();
            hy16_inv_regs<4096>(BUF, TW, jj, re, im);
#pragma unroll
            for (int m = 0; m < 8; ++m) { const int t = jj + 256 * m;
                v[0][m] = sconv_raw_m(m, rg[0][m], t, aw0, aw1, aw2, acb) * (re[m] + sk0 * v[0][m]); v[1][m] = sconv_raw_m(m, rg[1][m], t, aw0, aw1, aw2, acb) * (im[m] + sk0 * v[1][m]); }
#pragma unroll
            for (int m = 0; m < 8; ++m) { re[m] = v[0][m]; im[m] = v[1][m]; re[m + 8] = 0.f; im[m + 8] = 0.f; }
            hy16_fwd_store<4096>(BUF, TW, jj, re, im); __syncthreads();
            hy16_fwd_stage<256>(BUF, TW, jj); __syncthreads();
            hy16_mid_stage(BUF, K2, jj); __syncthreads();
#pragma unroll
            for (int m = 0; m < 8; ++m) { const int t = jj + 256 * m; rg[0][m] = raw3(zb + boff, t); rg[1][m] = raw3(zb + boff + SEQ, t); }
            hy16_inv_stage<256>(BUF, TW, jj); __syncthreads();
            hy16_inv_regs<4096>(BUF, TW, jj, re, im);
#pragma unroll
            for (int m = 0; m < 8; ++m) { const int t = jj + 256 * m; bf16* yp = YT + (size_t)c * MTOK + boff + t;
                yp[0] = (bf16)f2bf(sconv_raw_m(m, rg[0][m], t, bw0, bw1, bw2, bcb) * (re[m] + sk1 * v[0][m]));
                yp[SEQ] = (bf16)f2bf(sconv_raw_m(m, rg[1][m], t, bw0, bw1, bw2, bcb) * (im[m] + sk1 * v[1][m])); }
        }
        __syncthreads();
    }
}

__device__ __forceinline__ void p3c_transpose(Frame& F) {
    LAS unsigned* tile = (LAS unsigned*)F.lds;
    const bf16* YT = (const bf16*)(F.ws + WS_YT); bf16* AB = (bf16*)(F.ws + WS_H);
    const int tid = F.tid;
    const int vcu0 = (F.G == 256) ? (int)((blockIdx.x & 7) * 32 + (blockIdx.x >> 3)) : (int)blockIdx.x;
    for (int it = vcu0; it < MTOK / 64; it += F.G) {
        const int t0 = it * 64;
        { const int rr = tid >> 3, seg = tid & 7;
          v4u w[16];
#pragma unroll
          for (int i = 0; i < 16; ++i) w[i] = *(const v4u*)(YT + (size_t)(i * 64 + rr) * MTOK + t0 + seg * 8);
#pragma unroll
          for (int i = 0; i < 16; ++i) { const int c = i * 64 + rr, rot = (c >> 3) + (c & 3); LAS unsigned* row = tile + c * 32;
              row[(seg * 4 + 0 + rot) & 31] = w[i].x; row[(seg * 4 + 1 + rot) & 31] = w[i].y; row[(seg * 4 + 2 + rot) & 31] = w[i].z; row[(seg * 4 + 3 + rot) & 31] = w[i].w; } }
        __syncthreads();
#pragma unroll 2
        for (int k = 0; k < 8; ++k) { const int j = tid + 512 * k, tp = j >> 7, cseg = j & 127;
            unsigned d[8];
#pragma unroll
            for (int e = 0; e < 8; ++e) d[e] = tile[(8 * cseg + e) * 32 + ((tp + cseg + (e & 3)) & 31)];
            v4u lo, hi;
            lo.x = (d[0] & 0xffffu) | (d[1] << 16); lo.y = (d[2] & 0xffffu) | (d[3] << 16); lo.z = (d[4] & 0xffffu) | (d[5] << 16); lo.w = (d[6] & 0xffffu) | (d[7] << 16);
            hi.x = (d[0] >> 16) | (d[1] & 0xffff0000u); hi.y = (d[2] >> 16) | (d[3] & 0xffff0000u); hi.z = (d[4] >> 16) | (d[5] & 0xffff0000u); hi.w = (d[6] >> 16) | (d[7] & 0xffff0000u);
            bf16* dst = AB + (size_t)(t0 + 2 * tp) * DM + 1024 + 8 * cseg;
            *(v4u*)dst = lo; *(v4u*)(dst + DM) = hi; }
        __syncthreads();
    }
}

typedef _Float16 ln_f16x4 __attribute__((ext_vector_type(4)));
template <bool FINAL> __device__ __forceinline__ void ln_rows(Frame& F) {
    const _Float16* R = FINAL ? (const _Float16*)(F.ws + WS_H) : (const _Float16*)F.out;
    const float* st = (const float*)(F.ws + (FINAL ? WS_ST2 : WS_ST1)); float* MU = (float*)(F.ws + WS_MU1);
    const float* mod = (const float*)(F.ws + WS_MOD); bf16* H2 = (bf16*)(F.ws + WS_H);
    const float* lng = F.in[FINAL ? I_LN2G : I_LN1G]; const float* lnb = F.in[FINAL ? I_LN2B : I_LN1B];
    const int lane = F.lane, vcu = (F.G == 256) ? (int)((blockIdx.x & 7) * 32 + (blockIdx.x >> 3)) : (int)blockIdx.x;
    const int rpb = MTOK / F.G, rend = vcu * rpb + rpb, NGW = NWAVES;
    ln_f16x4 cur[8], nxt[8]; f32x2 ps = (f32x2){0.f, 0.f}, pn = (f32x2){0.f, 0.f};
    int row = vcu * rpb + F.wave;
    if (row < rend) {
#pragma unroll
        for (int j = 0; j < 8; ++j) cur[j] = *(const ln_f16x4*)(R + (size_t)row * DM + 4 * lane + 256 * j);
        if (lane < 32) ps = *(const f32x2*)(st + ((size_t)row * 32 + lane) * 2);
    }
    for (; row < rend; row += NGW) {
        const int rn = row + NGW;
        if (rn < rend) {
#pragma unroll
            for (int j = 0; j < 8; ++j) nxt[j] = *(const ln_f16x4*)(R + (size_t)rn * DM + 4 * lane + 256 * j);
            pn = (f32x2){0.f, 0.f}; if (lane < 32) pn = *(const f32x2*)(st + ((size_t)rn * 32 + lane) * 2);
        }
        const float s = wave_sum(ps.x), q = wave_sum(ps.y);
        const float mean = s * (1.0f / DM); float var = q * (1.0f / DM) - mean * mean; var = var > 0.f ? var : 0.f; const float rstd = 1.0f / sqrtf(var + LN_EPS);
        if (!FINAL && lane == 0) *(f32x2*)(MU + (size_t)row * 2) = (f32x2){mean, rstd};
        const int b = row >> 11;
#pragma unroll
        for (int j = 0; j < 8; ++j) { const int col = 4 * lane + 256 * j;
            const f32x4 v = (f32x4){(float)cur[j][0], (float)cur[j][1], (float)cur[j][2], (float)cur[j][3]};
            const f32x4 y = (v - mean) * rstd * *(const f32x4*)(lng + col) + *(const f32x4*)(lnb + col);
            if (FINAL) *(f32x4*)(F.out + (size_t)row * DM + col) = y;
            else { const float* mp = mod + (size_t)b * MODW + col; const f32x4 h = y * (*(const f32x4*)(mp + 4 * DM) + 1.0f) + *(const f32x4*)(mp + 3 * DM);
                   v2u o; o.x = pk2(h[0], h[1]); o.y = pk2(h[2], h[3]); *(v2u*)(H2 + (size_t)row * DM + col) = o; } }
#pragma unroll
        for (int j = 0; j < 8; ++j) cur[j] = nxt[j];
        ps = pn;
    }
}

typedef GAS unsigned gu32;
#define RLX_AGENT __ATOMIC_RELAXED, __HIP_MEMORY_SCOPE_AGENT
constexpr int LDSCTL_OFF = 163840 - 512, MISC_OFF = LDSCTL_OFF;
constexpr int CW_BAR = 4096;
constexpr size_t CTL_ZERO_BYTES = 65536;
#define XB_TMO      128
#define XB_XCNT(j)  (256  + 64 * (j))
#define XB_XSUB(j)  (1280 + 64 * (j))
#define XB_XGEN(j)  (2304 + 64 * (j))
#define XB_TOP      3328
#define XB_TOPGEN   3392
#define XCD_BAR_WORDS 3456
#define XB_SPIN_CAP (1u << 18)

__device__ __forceinline__ unsigned xb_ld(unsigned* p)              { return __hip_atomic_load(p, __ATOMIC_RELAXED, __HIP_MEMORY_SCOPE_AGENT); }
__device__ __forceinline__ unsigned xb_add(unsigned* p, unsigned v) { return __hip_atomic_fetch_add(p, v, __ATOMIC_RELAXED, __HIP_MEMORY_SCOPE_AGENT); }
__device__ __forceinline__ unsigned xb_xcc_id() { return (unsigned)__builtin_amdgcn_s_getreg((3 << 11) | 20) & 0xFu; }
#define XB_SPIN(cond, bar) do { unsigned _sp = 0; while (cond) { __builtin_amdgcn_s_sleep(1); \
    if ((++_sp & 255u) == 0u) { if (xb_ld(&(bar)[XB_TMO])) break; if (_sp > XB_SPIN_CAP) { atomicAdd(&(bar)[XB_TMO], 1u); break; } } } } while (0)

struct XcdBarrier {
    unsigned* bar; unsigned x;
    volatile LAS unsigned* st;
};

__device__ __forceinline__ XcdBarrier xcd_barrier_post(unsigned* bar, volatile LAS unsigned* st) {
    XcdBarrier b; b.bar = bar; b.x = xb_xcc_id(); b.st = st;
    if (threadIdx.x == 0) (void)xb_add(&bar[XB_XCNT(b.x)], 1u);
    return b;
}
__device__ __forceinline__ void xcd_barrier_complete(unsigned* bar, unsigned x, unsigned& nloc, unsigned& nx) {
    const unsigned G = gridDim.x * gridDim.y * gridDim.z;
    unsigned sum, cnt, mine, sp = 0u;
    for (;;) {
        sum = 0u; cnt = 0u; mine = 0u;
#pragma unroll
        for (unsigned j = 0; j < 16; ++j) { const unsigned c = xb_ld(&bar[XB_XCNT(j)]); sum += c; cnt += (c > 0u) ? 1u : 0u; mine = (j == x) ? c : mine; }
        if (sum == G) break;
        __builtin_amdgcn_s_sleep(1);
        if ((++sp & 255u) == 0u) { if (xb_ld(&bar[XB_TMO])) break; if (sp > XB_SPIN_CAP) { atomicAdd(&bar[XB_TMO], 1u); break; } }
    }
    nloc = mine > 0u ? mine : 1u; nx = cnt > 0u ? cnt : 1u;
}

__device__ __forceinline__ void xcd_barrier(const XcdBarrier& b) {
    asm volatile("s_waitcnt vmcnt(0)" ::: "memory");
    __syncthreads();
    if (threadIdx.x == 0) {
        unsigned* bar = b.bar;
        __builtin_amdgcn_s_waitcnt(0);
        unsigned nloc = b.st[0], nx = b.st[1];
        if (nloc == 0u) { xcd_barrier_complete(bar, b.x, nloc, nx); b.st[0] = nloc; b.st[1] = nx; }
        const unsigned old = xb_add(&bar[XB_XSUB(b.x)], 1u);
        const unsigned gen = old / nloc;
        if (old + 1u == (gen + 1u) * nloc) {
            __builtin_amdgcn_fence(__ATOMIC_RELEASE, "agent");
            asm volatile("s_waitcnt vmcnt(0)" ::: "memory");
            const unsigned og = xb_add(&bar[XB_TOP], 1u);
            const unsigned tg = og / nx;
            if (og + 1u == (tg + 1u) * nx) xb_add(&bar[XB_TOPGEN], 1u);
            else XB_SPIN(xb_ld(&bar[XB_TOPGEN]) == tg, bar);
            __builtin_amdgcn_fence(__ATOMIC_ACQUIRE, "agent");
            xb_add(&bar[XB_XGEN(b.x)], 1u);
            asm volatile("s_waitcnt vmcnt(0)" ::: "memory");
        } else {
            XB_SPIN(xb_ld(&bar[XB_XGEN(b.x)]) == gen, bar);
            __builtin_amdgcn_fence(__ATOMIC_ACQUIRE, "agent");
            asm volatile("s_waitcnt vmcnt(0)" ::: "memory");
        }
    }
    __syncthreads();
}

#define GRID_SYNC() xcd_barrier(bar)

__global__ void __launch_bounds__(NWAVES * 64, 2) fwd_megakernel(Args args) {
    extern __shared__ __attribute__((aligned(16))) unsigned char lds[];
    Frame F;
    F.lds = (LAS unsigned char*)lds;
    F.tid = threadIdx.x; F.lane = F.tid & 63; F.wave = __builtin_amdgcn_readfirstlane(F.tid >> 6); F.G = gridDim.x;
    F.in = args.in; F.out = args.out; F.ws = args.ws;
    for (int u = F.tid; u < (LDS_BYTES - LDSCTL_OFF) / 4; u += NWAVES * 64) ((LAS unsigned*)(F.lds + LDSCTL_OFF))[u] = 0u;
    __syncthreads();
    XcdBarrier bar = xcd_barrier_post((unsigned*)(args.ws + WS_CTL) + CW_BAR, (volatile LAS unsigned*)(F.lds + MISC_OFF) + 8);
    unsigned char* ws = args.ws;
    const int lo = args.ph_lo, hi = args.ph_hi;
#define IN(k) (lo <= (k) && (k) < hi)
#define BOTH(k) (IN(k) && IN((k) + 1))
    const int gw = blockIdx.x * NWAVES + F.wave, NGW = F.G * NWAVES;

    PB_START(1, F.lds);
    if (IN(0)) { { int t_ = threadIdx.x; asm volatile("" : "+v"(t_)); F.tid = t_; F.lane = t_ & 63; }
        PB_START(21, F.lds); p0_mod(F); PB_END(21, F.lds);
        PB_START(22, F.lds);
        transpose_matrix(F, F.in[I_WIN], DM, INW, (bf16*)(ws + WS_WIN), DM, 0, 1, (int)blockIdx.x, F.G);
        transpose_matrix(F, F.in[I_WA], SGUW, DM, (bf16*)(ws + WS_WAB), DM, 0, 0, (int)((blockIdx.x + 128) % F.G), F.G);
        transpose_matrix(F, F.in[I_WB], HYW, DM, (bf16*)(ws + WS_WAB), DM, 1024, 0, (int)blockIdx.x, F.G);
        transpose_matrix(F, F.in[I_WO], DM, DM, (bf16*)(ws + WS_WO), DM, 0, 0, (int)blockIdx.x, F.G);
        { const float* sw = F.in[I_SW]; bf16* sgw = (bf16*)(ws + WS_SGW);
          for (int i = blockIdx.x * (NWAVES * 64) + F.tid; i < 8 * 128 * 128 / 2; i += F.G * NWAVES * 64) { const f32x2 v = *(const f32x2*)(sw + 2 * i); *(unsigned*)(sgw + 2 * i) = pk2(v.x, v.y); } }
        __syncthreads();
        __syncthreads(); p0_hid2(F);
        PB_END(22, F.lds);
        if (BOTH(0)) GRID_SYNC();
    }
    PB_END(1, F.lds);
    PB_START(2, F.lds);
    if (IN(1)) { { int t_ = threadIdx.x; asm volatile("" : "+v"(t_)); F.tid = t_; F.lane = t_ & 63; } if (F.wave < 4) p1_modulate(F); else p1_filter_waves(F); if (BOTH(1)) GRID_SYNC(); }
    PB_END(2, F.lds);
    PB_START(3, F.lds);
    if (IN(2)) { { int t_ = threadIdx.x; asm volatile("" : "+v"(t_)); F.tid = t_; F.lane = t_ & 63; }
        { pg8::Gemm g{(const pg8::bf16_t*)(ws + WS_H), (const pg8::bf16_t*)(ws + WS_WIN), MTOK, 5120, DM}; pg8::StaticOrder S; S.init(MTOK, 5120, F.G, (int)blockIdx.x, WGM_P2A);
          pg8::EpiG1 E{(pg8::bf16_t*)(ws + WS_U), (pg8::bf16_t*)(ws + WS_G), F.in[I_BIN]};
          pg8::gemm_phase<pg8::EpiG1, pg8::StaticOrder, true, true>(F.lds, g, S, E); }
        __syncthreads();
        { pg8::Gemm g{(const pg8::bf16_t*)(ws + WS_WIN) + (size_t)5120 * DM, (const pg8::bf16_t*)(ws + WS_H), 4096, MTOK, DM}; pg8::StaticOrder S; S.init(4096, MTOK, F.G, (int)blockIdx.x, WGM_P2B);
          pg8::EpiG1T E{(pg8::bf16_t*)(ws + WS_V), (pg8::bf16_t*)(ws + WS_ZHT), F.in[I_BIN], (float*)(ws + WS_STV)};
          pg8::SwapOrder S2{(int)blockIdx.x, F.G}; pg8::gemm_phase<pg8::EpiG1T, pg8::SwapOrder, true, true>(F.lds, g, S2, E); (void)S; }
        if (BOTH(2)) GRID_SYNC();
    }
    PB_END(3, F.lds);
    PB_START(4, F.lds);
    if (IN(3)) { { int t_ = threadIdx.x; asm volatile("" : "+v"(t_)); F.tid = t_; F.lane = t_ & 63; } __syncthreads(); PB_START(41, F.lds); p3_sgu(F); PB_END(41, F.lds); PB_START(42, F.lds); p3_hyena_fft(F); PB_END(42, F.lds); if (BOTH(3)) GRID_SYNC(); PB_START(43, F.lds); p3c_transpose(F); GRID_SYNC(); PB_END(43, F.lds); }
    PB_END(4, F.lds);
    PB_START(5, F.lds);
    if (IN(4)) { { int t_ = threadIdx.x; asm volatile("" : "+v"(t_)); F.tid = t_; F.lane = t_ & 63; }
        pg8::Gemm g{(const pg8::bf16_t*)(ws + WS_H), (const pg8::bf16_t*)(ws + WS_WAB), MTOK, DM, DM}; pg8::StaticOrder S; S.init(MTOK, DM, F.G, (int)blockIdx.x, WGM_P4);
        pg8::EpiG2 E{(const pg8::bf16_t*)(ws + WS_G), (pg8::bf16_t*)(ws + WS_MERGED)};
        pg8::gemm_phase<pg8::EpiG2, pg8::StaticOrder, true, true>(F.lds, g, S, E);
        if (BOTH(4)) GRID_SYNC();
    }
    PB_END(5, F.lds);
    PB_START(6, F.lds);
    if (IN(5)) { { int t_ = threadIdx.x; asm volatile("" : "+v"(t_)); F.tid = t_; F.lane = t_ & 63; }
        pg8::Gemm g{(const pg8::bf16_t*)(ws + WS_MERGED), (const pg8::bf16_t*)(ws + WS_WO), MTOK, DM, DM}; pg8::StaticOrder S; S.init(MTOK, DM, F.G, (int)blockIdx.x, WGM_P5);
        pg8::EpiRes<true> E{F.in[I_X], nullptr, (_Float16*)F.out, (const float*)(ws + WS_MOD) + 2 * DM, F.in[I_BO], nullptr, nullptr, nullptr, (float*)(ws + WS_ST1)};
        pg8::gemm_phase<pg8::EpiRes<true>, pg8::StaticOrder, true, true>(F.lds, g, S, E);
        if (BOTH(5)) GRID_SYNC();
    }
    PB_END(6, F.lds);
    PB_START(7, F.lds);
    if (IN(6)) { { int t_ = threadIdx.x; asm volatile("" : "+v"(t_)); F.tid = t_; F.lane = t_ & 63; }
        __syncthreads();
        ln_rows<false>(F);
        __syncthreads();
        transpose_matrix(F, F.in[I_WM1], DM, DFF, (bf16*)(ws + WS_WM1), DM, 0, 0, (int)blockIdx.x, F.G);
        transpose_matrix(F, F.in[I_WM2], DFF, DM, (bf16*)(ws + WS_WM2), DFF, 0, 0, (int)blockIdx.x, F.G);
        if (BOTH(6)) GRID_SYNC();
    }
    PB_END(7, F.lds);
    PB_START(8, F.lds);
    if (IN(7)) { { int t_ = threadIdx.x; asm volatile("" : "+v"(t_)); F.tid = t_; F.lane = t_ & 63; }
        __syncthreads();
        pg8::Gemm g{(const pg8::bf16_t*)(ws + WS_H), (const pg8::bf16_t*)(ws + WS_WM1), MTOK, DFF, DM}; pg8::StaticOrder S; S.init(MTOK, DFF, F.G, (int)blockIdx.x, WGM_P7);
        pg8::EpiG4 E{(pg8::bf16_t*)(ws + WS_AFF), F.in[I_BM1]};
        pg8::gemm_phase<pg8::EpiG4, pg8::StaticOrder, true, true>(F.lds, g, S, E);
        if (BOTH(7)) GRID_SYNC();
    }
    PB_END(8, F.lds);
    PB_START(9, F.lds);
    if (IN(8)) { { int t_ = threadIdx.x; asm volatile("" : "+v"(t_)); F.tid = t_; F.lane = t_ & 63; }
        pg8::Gemm g{(const pg8::bf16_t*)(ws + WS_AFF), (const pg8::bf16_t*)(ws + WS_WM2), MTOK, DM, DFF}; pg8::StaticOrder S; S.init(MTOK, DM, F.G, (int)blockIdx.x, WGM_P8);
        pg8::EpiRes<false> E{nullptr, (const _Float16*)F.out, (_Float16*)(ws + WS_H), (const float*)(ws + WS_MOD) + 5 * DM, F.in[I_BM2], F.in[I_LN1G], F.in[I_LN1B], (const float*)(ws + WS_MU1), (float*)(ws + WS_ST2)};
        pg8::gemm_phase<pg8::EpiRes<false>, pg8::StaticOrder, true, true>(F.lds, g, S, E);
        if (BOTH(8)) GRID_SYNC();
    }
    PB_END(9, F.lds);
    PB_START(10, F.lds);
    if (IN(9)) { { int t_ = threadIdx.x; asm volatile("" : "+v"(t_)); F.tid = t_; F.lane = t_ & 63; } ln_rows<true>(F); }
    PB_END(10, F.lds);
    if (PROBE_ID != 0 && blockIdx.x == 0 && threadIdx.x == 0) { const unsigned long long wait_ = *(volatile LAS unsigned long long*)(F.lds + PB_LDS_OFF), t0_ = __builtin_amdgcn_s_memrealtime();
        while (__builtin_amdgcn_s_memrealtime() - t0_ < wait_) __builtin_amdgcn_s_sleep(8); }
#undef IN
#undef BOTH
}

constexpr int N_PHASES = 10;
#ifndef MK_N_LAUNCHES
#define MK_N_LAUNCHES 1
#endif
extern "C" void kernel_launch(void* const* d_in, const int* in_sizes, int n_in, void* d_out, int out_size, void* d_ws, size_t ws_size, hipStream_t stream) {
    static int grid = 0;
    if (grid == 0) {
        if (n_in != 31 || in_sizes[0] != MTOK * DM || out_size != MTOK * DM || ws_size < WS_END) {
            fprintf(stderr, "kernel_launch: unexpected problem: n_in %d in0 %d out %d ws %zu (need %zu)\n", n_in, n_in > 0 ? in_sizes[0] : -1, out_size, ws_size, (size_t)WS_END); grid = -1; return; }
        int dev = 0, cus = 0, per_cu = 0;
        if (hipGetDevice(&dev) != hipSuccess || hipDeviceGetAttribute(&cus, hipDeviceAttributeMultiprocessorCount, dev) != hipSuccess) { grid = -1; return; }
        if (hipFuncSetAttribute((const void*)fwd_megakernel, hipFuncAttributeMaxDynamicSharedMemorySize, LDS_BYTES) != hipSuccess) { fprintf(stderr, "kernel_launch: hipFuncSetAttribute failed\n"); grid = -1; return; }
        if (hipOccupancyMaxActiveBlocksPerMultiprocessor(&per_cu, (const void*)fwd_megakernel, NWAVES * 64, LDS_BYTES) != hipSuccess || per_cu < 1) { fprintf(stderr, "kernel_launch: occupancy query says %d\n", per_cu); per_cu = 1; }
        (void)hipGetLastError();
        grid = cus;
    }
    if (grid < 0) return;
    if (hipMemsetAsync((char*)d_ws + WS_CTL, 0, CTL_ZERO_BYTES, stream) != hipSuccess) { fprintf(stderr, "kernel_launch: memset failed\n"); return; }
    Args a{};
    for (int i = 0; i < 31; ++i) a.in[i] = (const float*)d_in[i];
    a.out = (float*)d_out; a.ws = (unsigned char*)d_ws;
    if (MK_N_LAUNCHES == 1) {
        a.ph_lo = 0; a.ph_hi = N_PHASES;
        void* kargs[] = {&a};
        hipError_t e = hipLaunchCooperativeKernel((const void*)fwd_megakernel, dim3(grid), dim3(NWAVES * 64), kargs, LDS_BYTES, stream);
        if (e != hipSuccess) fprintf(stderr, "kernel_launch: cooperative launch failed: %s (grid %d)\n", hipGetErrorString(e), grid);
    } else {
        for (int p = 0; p < N_PHASES; ++p) { a.ph_lo = p; a.ph_hi = p + 1; hipLaunchKernelGGL(fwd_megakernel, dim3(grid), dim3(NWAVES * 64), LDS_BYTES, stream, a); }
    }
}
```
